# Optimizing an MI355X kernel written in HIP

```python
import jax, jax.numpy as jnp
from jax import lax
import numpy as np

D_MODEL = 1024
BATCH = 32
SEQ = 2048
DEPTH = 4

N_A_LAYERS = DEPTH // 2
N_B_LAYERS = DEPTH - N_A_LAYERS
N_DENSE_LAYERS = (DEPTH + 1) // 2
N_MOE_LAYERS = DEPTH // 2

A_HEADS = 8
A_HEAD_DIM = D_MODEL // A_HEADS
A_WIDTH = A_HEADS * A_HEAD_DIM
A_CHUNK = 32

B_HEADS = 16
B_KV_HEADS = 4
B_GROUP = B_HEADS // B_KV_HEADS
B_HEAD_DIM = D_MODEL // B_HEADS
CMP_BLOCK = 32
CMP_STRIDE = 16
CMP_HIDDEN = 256
SEL_BLOCK = 32
N_SELECT = 8
WINDOW = 512
Q_BLOCK = 64
N_BRANCH = 3

D_FF = 2816
N_EXPERTS = 8
TOP_K = 2
D_FF_EXPERT = 3584

NORM_EPS = 1e-6
SEL_BIG = 1e9
TINY = 1e-30

kernel_name = "yoco_hgrn2_nsa_moe_trunk"


def rms_norm(x, g):
    xf = x.astype(jnp.float32)
    y = xf * lax.rsqrt(jnp.mean(xf * xf, axis=-1, keepdims=True) + NORM_EPS)
    return (y * g.astype(jnp.float32)).astype(x.dtype)


def masked_softmax(s, mask):
    s = jnp.where(mask, s, -jnp.inf)
    m = jnp.max(s, axis=-1, keepdims=True)
    m = jnp.where(jnp.isfinite(m), m, 0.0)
    e = jnp.exp(s - m)
    return e / jnp.maximum(jnp.sum(e, axis=-1, keepdims=True), TINY)


def alibi_slopes(n):
    return np.array([2.0 ** (-8.0 * (h + 1) / n) for h in range(n)], dtype=np.float32)


def hgrn2_lower_bounds(lb_logits):
    lb = jnp.cumsum(jax.nn.softmax(lb_logits.astype(jnp.float32), axis=0), axis=0)
    return lb - lb[0:1]


def hgrn2_chunk_scan(q, k, v, logf):
    B, H, S, dk = q.shape
    dv = v.shape[-1]
    nc = S // A_CHUNK

    def to_chunks(a):
        return a.reshape(B, H, nc, A_CHUNK, a.shape[-1]).transpose(2, 0, 1, 3, 4)

    causal = jnp.tril(jnp.ones((A_CHUNK, A_CHUNK), dtype=bool))[:, :, None]

    def step(state, inp):
        qc, kc, vc, lf = inp
        cum = jnp.cumsum(lf, axis=2)
        o_inter = jnp.einsum('bhtk,bhkv->bhtv', qc * jnp.exp(cum), state)
        diff = cum[:, :, :, None, :] - cum[:, :, None, :, :]
        decay = jnp.exp(jnp.where(causal, diff, -jnp.inf))
        scores = jnp.einsum('bhtk,bhsk,bhtsk->bhts', qc, kc, decay)
        o = o_inter + jnp.einsum('bhts,bhsv->bhtv', scores, vc)
        last = cum[:, :, -1:, :]
        new_state = (jnp.exp(last[:, :, 0, :])[..., None] * state
                     + jnp.einsum('bhsk,bhsv->bhkv', kc * jnp.exp(last - cum), vc))
        return new_state, o

    state0 = jnp.zeros((B, H, dk, dv), jnp.float32)
    _, o = lax.scan(step, state0, (to_chunks(q), to_chunks(k), to_chunks(v), to_chunks(logf)))
    return o.transpose(1, 2, 0, 3, 4).reshape(B, H, S, dv)


def hgrn2_mixer(xn, w_in, w_out, g_norm, lb):
    B, S, _ = xn.shape
    q, f, i, g = jnp.split(xn @ w_in, 4, axis=-1)
    f32 = f.astype(jnp.float32)
    logf = jnp.logaddexp(jnp.log(lb), jnp.log1p(-lb) + jax.nn.log_sigmoid(f32))
    key = (1.0 - lb) * jax.nn.sigmoid(-f32)

    def heads(a):
        return a.reshape(B, S, A_HEADS, A_HEAD_DIM).transpose(0, 2, 1, 3).astype(jnp.float32)

    o = hgrn2_chunk_scan(heads(jax.nn.silu(q)), heads(key), heads(i), heads(logf))
    o = rms_norm(o.transpose(0, 2, 1, 3), g_norm).reshape(B, S, A_WIDTH).astype(xn.dtype)
    return (o * jax.nn.silu(g)) @ w_out


def compress_blocks(a, pos, w1, w2):
    B, S = a.shape[:2]
    n_cmp = (S - CMP_BLOCK) // CMP_STRIDE + 1
    idx = np.arange(n_cmp)[:, None] * CMP_STRIDE + np.arange(CMP_BLOCK)[None, :]
    blocks = a[:, idx] + pos[None, None, :, None, :]
    blocks = blocks.transpose(0, 3, 1, 2, 4).reshape(B, B_KV_HEADS, n_cmp, CMP_BLOCK * B_HEAD_DIM)
    return jax.nn.silu(blocks @ w1) @ w2


def nsa_shared_kv(h, kv_norm, kv_w, cmp_pos_k, cmp_w1_k, cmp_w2_k, cmp_pos_v, cmp_w1_v, cmp_w2_v, k_norm):
    B, S, _ = h.shape
    hn = rms_norm(h, kv_norm)
    kv = (hn @ kv_w).reshape(B, S, 6, B_KV_HEADS, B_HEAD_DIM)
    k_c, v_c, k_s, v_s, k_w, v_w = (kv[:, :, 0], kv[:, :, 1], kv[:, :, 2], kv[:, :, 3], kv[:, :, 4], kv[:, :, 5])
    kc = rms_norm(compress_blocks(k_c, cmp_pos_k, cmp_w1_k, cmp_w2_k), k_norm[0])
    vc = compress_blocks(v_c, cmp_pos_v, cmp_w1_v, cmp_w2_v)
    n_sel = S // SEL_BLOCK
    ks = rms_norm(k_s, k_norm[1]).transpose(0, 2, 1, 3).reshape(B, B_KV_HEADS, n_sel, SEL_BLOCK * B_HEAD_DIM)
    vs = v_s.transpose(0, 2, 1, 3).reshape(B, B_KV_HEADS, n_sel, SEL_BLOCK * B_HEAD_DIM)
    pad = ((0, 0), (0, 0), (WINDOW, 0), (0, 0))
    kw = jnp.pad(rms_norm(k_w, k_norm[2]).transpose(0, 2, 1, 3), pad)
    vw = jnp.pad(v_w.transpose(0, 2, 1, 3), pad)
    return kc, vc, ks, vs, kw, vw


def nsa_mixer(xn, w_in, w_out, q_norm, kc, vc, ks, vs, kw, vw):
    B, S, _ = xn.shape
    dh = B_HEAD_DIM
    scale = dh ** -0.5
    n_cmp = kc.shape[2]
    n_sel = S // SEL_BLOCK
    n_pick = min(N_SELECT, n_sel)
    n_qb = S // Q_BLOCK
    c_start = np.arange(n_cmp) * CMP_STRIDE
    c_end = jnp.asarray(c_start + CMP_BLOCK - 1)
    j_sel = np.arange(n_sel)
    overlap = jnp.asarray(((c_start[:, None] < (j_sel[None, :] + 1) * SEL_BLOCK)
                           & (c_start[:, None] + CMP_BLOCK > j_sel[None, :] * SEL_BLOCK)).astype(np.float32))
    j_sel = jnp.asarray(j_sel)
    slopes = jnp.asarray(alibi_slopes(B_HEADS).reshape(B_KV_HEADS, B_GROUP))[None, None, :, :, None]
    gather = jax.vmap(jax.vmap(lambda a, i: a[i]))

    proj = xn @ w_in
    q = rms_norm(proj[..., :B_HEADS * dh].reshape(B, S, B_HEADS, dh), q_norm)
    gates = jax.nn.sigmoid(proj[..., B_HEADS * dh:].astype(jnp.float32)).astype(xn.dtype)
    q_blocks = jnp.moveaxis(q.reshape(B, n_qb, Q_BLOCK, B_KV_HEADS, B_GROUP, dh), 1, 0)
    g_blocks = jnp.moveaxis(gates.reshape(B, n_qb, Q_BLOCK, B_KV_HEADS, B_GROUP, N_BRANCH), 1, 0)

    def block(args):
        qb, gb, blk = args
        t = blk * Q_BLOCK + jnp.arange(Q_BLOCK)
        dist_c = t[:, None] - c_end[None, :]
        s_c = (jnp.einsum('bqghd,bgcd->bqghc', qb, kc, preferred_element_type=jnp.float32) * scale
               - slopes * dist_c.astype(jnp.float32)[None, :, None, None, :])
        p_c = masked_softmax(s_c, (dist_c >= 0)[None, :, None, None, :])
        o_c = jnp.einsum('bqghc,bgcd->bqghd', p_c.astype(vc.dtype), vc)
        imp = jnp.einsum('bqghc,cj->bqgj', p_c, overlap)
        valid = j_sel[None, :] * SEL_BLOCK <= t[:, None]
        cur = t // SEL_BLOCK
        forced = valid & ((j_sel[None, :] == 0) | (j_sel[None, :] == cur[:, None]) | (j_sel[None, :] == cur[:, None] - 1))
        score = jnp.where(forced[None, :, None, :], SEL_BIG, jnp.where(valid[None, :, None, :], imp, -SEL_BIG))
        vals, idx = lax.top_k(score, n_pick)
        sel_ok = vals > -0.5 * SEL_BIG
        idx_bg = idx.transpose(0, 2, 1, 3).reshape(B, B_KV_HEADS, Q_BLOCK * n_pick)
        k_sel = gather(ks, idx_bg).reshape(B, B_KV_HEADS, Q_BLOCK, n_pick * SEL_BLOCK, dh)
        v_sel = gather(vs, idx_bg).reshape(B, B_KV_HEADS, Q_BLOCK, n_pick * SEL_BLOCK, dh)
        pos_sel = idx[..., None] * SEL_BLOCK + jnp.arange(SEL_BLOCK)
        ok_sel = (sel_ok[..., None] & (pos_sel <= t[None, :, None, None, None])).reshape(B, Q_BLOCK, B_KV_HEADS, -1)
        dist_s = (t[None, :, None, None] - pos_sel.reshape(B, Q_BLOCK, B_KV_HEADS, -1)).astype(jnp.float32)
        s_s = (jnp.einsum('bqghd,bgqkd->bqghk', qb, k_sel, preferred_element_type=jnp.float32) * scale
               - slopes * dist_s[:, :, :, None, :])
        p_s = masked_softmax(s_s, ok_sel[:, :, :, None, :])
        o_s = jnp.einsum('bqghk,bgqkd->bqghd', p_s.astype(v_sel.dtype), v_sel)
        k_win = lax.dynamic_slice_in_dim(kw, blk * Q_BLOCK, WINDOW + Q_BLOCK, axis=2)
        v_win = lax.dynamic_slice_in_dim(vw, blk * Q_BLOCK, WINDOW + Q_BLOCK, axis=2)
        pos_w = blk * Q_BLOCK - WINDOW + jnp.arange(WINDOW + Q_BLOCK)
        dist_w = t[:, None] - pos_w[None, :]
        mask_w = (pos_w[None, :] >= 0) & (dist_w >= 0) & (dist_w < WINDOW)
        s_w = (jnp.einsum('bqghd,bgkd->bqghk', qb, k_win, preferred_element_type=jnp.float32) * scale
               - slopes * dist_w.astype(jnp.float32)[None, :, None, None, :])
        p_w = masked_softmax(s_w, mask_w[None, :, None, None, :])
        o_w = jnp.einsum('bqghk,bgkd->bqghd', p_w.astype(v_win.dtype), v_win)
        return gb[..., 0:1] * o_c + gb[..., 1:2] * o_s + gb[..., 2:3] * o_w

    o = lax.map(block, (q_blocks, g_blocks, jnp.arange(n_qb)))
    o = jnp.moveaxis(o, 0, 1).reshape(B, S, B_HEADS * dh)
    return o @ w_out


def swiglu(xn, w_gu, w_down):
    gate, up = jnp.split(xn @ w_gu, 2, axis=-1)
    return (jax.nn.silu(gate) * up) @ w_down


def moe_swiglu(xn, w_router, w_gu, w_down):
    logits = (xn @ w_router).astype(jnp.float32)
    vals, idx = lax.top_k(logits, TOP_K)
    wts = jax.nn.softmax(vals, axis=-1)
    combine = jnp.sum(jax.nn.one_hot(idx, N_EXPERTS, dtype=jnp.float32) * wts[..., None], axis=-2).astype(xn.dtype)
    out = jnp.zeros_like(xn)
    for e in range(N_EXPERTS):
        out = out + combine[..., e:e + 1] * swiglu(xn, w_gu[e], w_down[e])
    return out


def _normal(key, shape, scale):
    return jax.random.normal(key, shape, jnp.float32) * scale


def setup_inputs(seed: int = 0) -> dict:
    key = jax.random.key(seed)
    ks = jax.random.split(key, 25)
    dh = B_HEAD_DIM
    kv_cols = 6 * B_KV_HEADS * dh
    nsa_cols = B_HEADS * dh + N_BRANCH * B_HEADS
    return {
        "x": _normal(ks[0], (BATCH, SEQ, D_MODEL), 1.0),
        "norm_mix": 1.0 + _normal(ks[1], (DEPTH, D_MODEL), 0.02),
        "norm_ffn": 1.0 + _normal(ks[2], (DEPTH, D_MODEL), 0.02),
        "hgrn_w_in": _normal(ks[3], (N_A_LAYERS, D_MODEL, 4 * A_WIDTH), D_MODEL ** -0.5),
        "hgrn_w_out": _normal(ks[4], (N_A_LAYERS, A_WIDTH, D_MODEL), A_WIDTH ** -0.5),
        "hgrn_g_norm": 1.0 + _normal(ks[5], (N_A_LAYERS, A_HEAD_DIM), 0.02),
        "hgrn_lb_logits": _normal(ks[6], (N_A_LAYERS, A_WIDTH), 0.5),
        "kv_norm": 1.0 + _normal(ks[7], (D_MODEL,), 0.02),
        "kv_w": _normal(ks[8], (D_MODEL, kv_cols), D_MODEL ** -0.5),
        "cmp_pos_k": _normal(ks[9], (CMP_BLOCK, dh), 0.1),
        "cmp_w1_k": _normal(ks[10], (CMP_BLOCK * dh, CMP_HIDDEN), (CMP_BLOCK * dh) ** -0.5),
        "cmp_w2_k": _normal(ks[11], (CMP_HIDDEN, dh), CMP_HIDDEN ** -0.5),
        "cmp_pos_v": _normal(ks[12], (CMP_BLOCK, dh), 0.1),
        "cmp_w1_v": _normal(ks[13], (CMP_BLOCK * dh, CMP_HIDDEN), (CMP_BLOCK * dh) ** -0.5),
        "cmp_w2_v": _normal(ks[14], (CMP_HIDDEN, dh), CMP_HIDDEN ** -0.5),
        "k_norm": 1.0 + _normal(ks[15], (N_BRANCH, dh), 0.02),
        "nsa_w_in": _normal(ks[16], (N_B_LAYERS, D_MODEL, nsa_cols), D_MODEL ** -0.5),
        "nsa_w_out": _normal(ks[17], (N_B_LAYERS, B_HEADS * dh, D_MODEL), (B_HEADS * dh) ** -0.5),
        "nsa_q_norm": 1.0 + _normal(ks[18], (N_B_LAYERS, dh), 0.02),
        "ffn_w_gu": _normal(ks[19], (N_DENSE_LAYERS, D_MODEL, 2 * D_FF), D_MODEL ** -0.5),
        "ffn_w_down": _normal(ks[20], (N_DENSE_LAYERS, D_FF, D_MODEL), D_FF ** -0.5),
        "moe_router": _normal(ks[21], (N_MOE_LAYERS, D_MODEL, N_EXPERTS), D_MODEL ** -0.5),
        "moe_w_gu": _normal(ks[22], (N_MOE_LAYERS, N_EXPERTS, D_MODEL, 2 * D_FF_EXPERT), D_MODEL ** -0.5),
        "moe_w_down": _normal(ks[23], (N_MOE_LAYERS, N_EXPERTS, D_FF_EXPERT, D_MODEL), D_FF_EXPERT ** -0.5),
    }


def reference(x, norm_mix, norm_ffn, hgrn_w_in, hgrn_w_out, hgrn_g_norm, hgrn_lb_logits,
              kv_norm, kv_w, cmp_pos_k, cmp_w1_k, cmp_w2_k, cmp_pos_v, cmp_w1_v, cmp_w2_v, k_norm,
              nsa_w_in, nsa_w_out, nsa_q_norm, ffn_w_gu, ffn_w_down, moe_router, moe_w_gu, moe_w_down):
    lower_bounds = hgrn2_lower_bounds(hgrn_lb_logits)
    h = x
    kc = vc = ks = vs = kw = vw = None
    for layer in range(DEPTH):
        xn = rms_norm(h, norm_mix[layer])
        if layer < N_A_LAYERS:
            h = h + hgrn2_mixer(xn, hgrn_w_in[layer], hgrn_w_out[layer], hgrn_g_norm[layer], lower_bounds[layer])
        else:
            if layer == N_A_LAYERS:
                kc, vc, ks, vs, kw, vw = nsa_shared_kv(h, kv_norm, kv_w, cmp_pos_k, cmp_w1_k, cmp_w2_k,
                                                       cmp_pos_v, cmp_w1_v, cmp_w2_v, k_norm)
            j = layer - N_A_LAYERS
            h = h + nsa_mixer(xn, nsa_w_in[j], nsa_w_out[j], nsa_q_norm[j], kc, vc, ks, vs, kw, vw)
        xn = rms_norm(h, norm_ffn[layer])
        if layer % 2 == 0:
            h = h + swiglu(xn, ffn_w_gu[layer // 2], ffn_w_down[layer // 2])
        else:
            h = h + moe_swiglu(xn, moe_router[layer // 2], moe_w_gu[layer // 2], moe_w_down[layer // 2])
    return h
```

```cpp
#include <hip/hip_runtime.h>
#include <cstdio>
#include <cstdint>

#ifndef MK_SINGLE
#define MK_SINGLE 1
#endif

namespace pg8 {
#define PG8_LAS __attribute__((address_space(3)))
typedef unsigned short bf16_t;
typedef short bf16x8 __attribute__((ext_vector_type(8)));
typedef float f32x4 __attribute__((ext_vector_type(4)));
typedef unsigned u32x4 __attribute__((ext_vector_type(4)));
constexpr int BM = 256, BK = 64, HALF = 128, HTB = HALF * BK * 2  , STAGE_BYTES = 8 * HTB, NXCD = 8, WGM = 8;

__host__ __device__ __forceinline__ int lds_byte(int r, int c) { const int st = (r >> 4) * 2 + (c >> 5), rr = r & 15, cc = c & 31, ob = rr * 64 + cc * 2; return st * 1024 + (ob ^ (((ob >> 9) & 1) << 5)); }
__host__ __device__ __forceinline__ void stage_rc(int b, int& R, int& C) { const int st = b / 1024, sb = b % 1024, swz = sb ^ (((sb >> 9) & 1) << 5); R = (st >> 1) * 16 + swz / 64; C = (st & 1) * 32 + (swz % 64) / 2; }
__host__ __device__ __forceinline__ int perm32(int rho) { const int n = rho >> 4, i = rho & 15; return 8 * (i >> 2) + 4 * n + (i & 3); }

struct Unit { int pm, pn, e; };
struct Gemm { const bf16_t* A; const bf16_t* Bt; int K; int lda; size_t estride; };

struct GenOrder {
    int nM, nN, nwg, G, c; const int* tile_e;
    __device__ void init(int nM_, int nN_, int G_, int c_, const int* te) { nM = nM_; nN = nN_; nwg = nM * nN; G = G_; c = c_; tile_e = te; }
    __device__ bool next(int i, Unit& u) const {
        const long L = (long)i * G + c; if (L >= nwg) return false;
        int wgid = (int)L; { const int q = nwg / NXCD, r = nwg % NXCD, xcd = wgid % NXCD, off = wgid / NXCD; wgid = (xcd < r ? xcd * (q + 1) : r * (q + 1) + (xcd - r) * q) + off; }
        const int nig = WGM * nN, gid = wgid / nig, fm = gid * WGM, gsz = (nM - fm) < WGM ? (nM - fm) : WGM;
        u.pm = fm + ((wgid % nig) % gsz); u.pn = (wgid % nig) / gsz; u.e = tile_e ? tile_e[u.pm] : 0; return true;
    }
    __device__ __forceinline__ void a_ready(const Unit&) const {}
    __device__ __forceinline__ void done(const Unit&) const {}
};

__device__ __forceinline__ unsigned cvt_pk_bf16(float lo, float hi) { unsigned r; asm volatile("v_cvt_pk_bf16_f32 %0, %1, %2" : "=v"(r) : "v"(lo), "v"(hi)); return r; }
__device__ __forceinline__ float silu_f(float v) { return v * __builtin_amdgcn_rcpf(1.0f + __expf(-v)); }

struct EpiBf16 {
    static constexpr bool PERM = true, AFTER_DRAIN = false;
    bf16_t* O; int ldc; const float* bias; int act; int bias_es;
    __device__ __forceinline__ void operator()(const f32x4 (&acc)[2][2][4][2], const Unit& u, int wr, int wc, int fr, int fq) const {
        const int row0 = u.pm * BM + wr * 64 + fr, col0 = u.pn * BM + wc * 32 + 8 * fq;
        f32x4 bv[2][2];
#pragma unroll
        for (int bj = 0; bj < 2; ++bj)
#pragma unroll
            for (int n = 0; n < 2; ++n) bv[bj][n] = bias ? *(const f32x4*)(bias + u.e * bias_es + col0 + bj * HALF + 4 * n) : (f32x4){0.f, 0.f, 0.f, 0.f};
#pragma unroll
        for (int ai = 0; ai < 2; ++ai)
#pragma unroll
            for (int m = 0; m < 4; ++m) { bf16_t* rowp = O + (size_t)(row0 + ai * HALF + m * 16) * ldc + col0;
#pragma unroll
                for (int bj = 0; bj < 2; ++bj) { f32x4 v0 = acc[ai][bj][m][0] + bv[bj][0], v1 = acc[ai][bj][m][1] + bv[bj][1];
                    if (act == 1) {
#pragma unroll
                        for (int i = 0; i < 4; ++i) { v0[i] = silu_f(v0[i]); v1[i] = silu_f(v1[i]); } }
                    u32x4 w; w.x = cvt_pk_bf16(v0[0], v0[1]); w.y = cvt_pk_bf16(v0[2], v0[3]); w.z = cvt_pk_bf16(v1[0], v1[1]); w.w = cvt_pk_bf16(v1[2], v1[3]);
                    *(u32x4*)(rowp + bj * HALF) = w; } }
    }
};
struct EpiRes {
    static constexpr bool PERM = false, AFTER_DRAIN = false;
    const float* base; float* out; int ldc;
    __device__ __forceinline__ void operator()(const f32x4 (&acc)[2][2][4][2], const Unit& u, int wr, int wc, int fr, int fq) const {
        const int row0 = u.pm * BM + wr * 64 + fr, col0 = u.pn * BM + wc * 32 + 4 * fq;
#pragma unroll
        for (int ai = 0; ai < 2; ++ai)
#pragma unroll
            for (int m = 0; m < 4; ++m) { const size_t off = (size_t)(row0 + ai * HALF + m * 16) * ldc + col0;
#pragma unroll
                for (int bj = 0; bj < 2; ++bj)
#pragma unroll
                    for (int n = 0; n < 2; ++n) { const f32x4 b = *(const f32x4*)(base + off + bj * HALF + n * 16); *(f32x4*)(out + off + bj * HALF + n * 16) = b + acc[ai][bj][m][n]; } }
    }
};
struct EpiSwiGLU {
    static constexpr bool PERM = true, AFTER_DRAIN = false;
    bf16_t* O; int ldc;
    __device__ __forceinline__ void operator()(const f32x4 (&acc)[2][2][4][2], const Unit& u, int wr, int wc, int fr, int fq) const {
        const int row0 = u.pm * BM + wr * 64 + fr, col0 = u.pn * HALF + wc * 32 + 8 * fq;
#pragma unroll
        for (int ai = 0; ai < 2; ++ai)
#pragma unroll
            for (int m = 0; m < 4; ++m) { bf16_t* rowp = O + (size_t)(row0 + ai * HALF + m * 16) * ldc + col0;
                f32x4 v0, v1;
#pragma unroll
                for (int i = 0; i < 4; ++i) { v0[i] = silu_f(acc[ai][0][m][0][i]) * acc[ai][1][m][0][i]; v1[i] = silu_f(acc[ai][0][m][1][i]) * acc[ai][1][m][1][i]; }
                u32x4 w; w.x = cvt_pk_bf16(v0[0], v0[1]); w.y = cvt_pk_bf16(v0[2], v0[3]); w.z = cvt_pk_bf16(v1[0], v1[1]); w.w = cvt_pk_bf16(v1[2], v1[3]);
                *(u32x4*)rowp = w; }
    }
};
__device__ __forceinline__ float logf_gate(float x, float la, float l1) {
    const float ls = fminf(x, 0.f) - __logf(1.0f + __expf(-fabsf(x)));
    const float b = l1 + ls;
    if (la == -INFINITY) return b;
    const float mx = fmaxf(la, b), d = fabsf(la - b);
    return mx + __logf(1.0f + __expf(-d));
}
struct EpiHgrnIn {
    static constexpr bool PERM = true, AFTER_DRAIN = false;
    unsigned char* ws; int layer;
    static constexpr size_t O_PQ = 580ull << 20, O_PI = O_PQ + (128ull << 20), O_PG = O_PQ + (256ull << 20), O_LF = O_PQ + (384ull << 20), O_LA = 1ull << 20, O_L1 = O_LA + 8192;
    __device__ __forceinline__ void operator()(const f32x4 (&acc)[2][2][4][2], const Unit& u, int wr, int wc, int fr, int fq) const {
        const int quarter = u.pn >> 2;
        const int row0 = u.pm * BM + wr * 64 + fr, col0 = (u.pn & 3) * BM + wc * 32 + 8 * fq;
        if (quarter == 1) {
            const float* la = (const float*)(ws + O_LA) + layer * 1024; const float* l1 = (const float*)(ws + O_L1) + layer * 1024; float* LF = (float*)(ws + O_LF);
            f32x4 A0[2][2], A1[2][2];
#pragma unroll
            for (int bj = 0; bj < 2; ++bj)
#pragma unroll
                for (int n = 0; n < 2; ++n) { A0[bj][n] = *(const f32x4*)(la + col0 + bj * HALF + 4 * n); A1[bj][n] = *(const f32x4*)(l1 + col0 + bj * HALF + 4 * n); }
#pragma unroll
            for (int ai = 0; ai < 2; ++ai)
#pragma unroll
                for (int m = 0; m < 4; ++m) { float* rowp = LF + (size_t)(row0 + ai * HALF + m * 16) * 1024 + col0;
#pragma unroll
                    for (int bj = 0; bj < 2; ++bj)
#pragma unroll
                        for (int n = 0; n < 2; ++n) { f32x4 o;
#pragma unroll
                            for (int i = 0; i < 4; ++i) o[i] = logf_gate(acc[ai][bj][m][n][i], A0[bj][n][i], A1[bj][n][i]);
                            *(f32x4*)(rowp + bj * HALF + 4 * n) = o; } }
        } else {
            bf16_t* O = (bf16_t*)(ws + (quarter == 0 ? O_PQ : (quarter == 2 ? O_PI : O_PG)));
#pragma unroll
            for (int ai = 0; ai < 2; ++ai)
#pragma unroll
                for (int m = 0; m < 4; ++m) { bf16_t* rowp = O + (size_t)(row0 + ai * HALF + m * 16) * 1024 + col0;
#pragma unroll
                    for (int bj = 0; bj < 2; ++bj) { f32x4 v0 = acc[ai][bj][m][0], v1 = acc[ai][bj][m][1];
                        if (quarter != 2) {
#pragma unroll
                            for (int i = 0; i < 4; ++i) { v0[i] = silu_f(v0[i]); v1[i] = silu_f(v1[i]); } }
                        u32x4 w; w.x = cvt_pk_bf16(v0[0], v0[1]); w.y = cvt_pk_bf16(v0[2], v0[3]); w.z = cvt_pk_bf16(v1[0], v1[1]); w.w = cvt_pk_bf16(v1[2], v1[3]);
                        *(u32x4*)(rowp + bj * HALF) = w; } }
        }
    }
};

template <class Epi, class Sched, bool ALIGN_EPI = false, bool SP2 = false>
__device__ __forceinline__ void gemm_phase(PG8_LAS unsigned char* lds, const Gemm g, const Sched& S, const Epi& E) {
    int tid_ = threadIdx.x; asm volatile("" : "+v"(tid_));
    const int tid = tid_, wid = __builtin_amdgcn_readfirstlane(tid >> 6), lane = tid & 63, wr = wid >> 2, wc = wid & 3, fr = lane & 15, fq = lane >> 4;
    const int K = g.K, nt = K / BK, lda = g.lda;
    unsigned voffA[2], voffB[2];
#pragma unroll
    for (int i = 0; i < 2; ++i) { int R, C; stage_rc(tid * 16 + i * 8192, R, C); const int Rb = Epi::PERM ? ((R & ~31) + perm32(R & 31)) : R;
        voffA[i] = (unsigned)(R * lda + C) * 2u; voffB[i] = (unsigned)(Rb * K + C) * 2u; }
    const size_t kstep = (size_t)(BK * 2);
    const size_t hstep = (size_t)HALF * K * 2;
    const size_t tstep = 2 * hstep;
    const size_t hstepA = (size_t)HALF * lda * 2, tstepA = 2 * hstepA;
    const unsigned ldsw = (unsigned)wid * 1024u;
    const int aoff = lds_byte(wr * 64 + fr, fq * 8), boff = lds_byte(wc * 32 + fr, fq * 8);
#define PG8_SA(b, h) (((b) * 2 + (h)) * HTB)
#define PG8_SB(b, h) ((4 + (b) * 2 + (h)) * HTB)
#define PG8_STAGE(bufoff, gbase, voff) do { _Pragma("unroll") for (int _i = 0; _i < 2; ++_i) \
        __builtin_amdgcn_global_load_lds((const unsigned*)((const char*)(gbase) + (voff)[_i]), (PG8_LAS unsigned*)(lds + (bufoff) + ldsw + _i * 8192), 16, 0, 0); } while (0)
#define PG8_LDA(dst, b, h) do { _Pragma("unroll") for (int m = 0; m < 4; ++m) _Pragma("unroll") for (int k = 0; k < 2; ++k) dst[m][k] = *(const PG8_LAS bf16x8*)(lds + PG8_SA(b, h) + aoff + m * 2048 + k * 1024); } while (0)
#define PG8_LDB(dst, b, h) do { _Pragma("unroll") for (int n = 0; n < 2; ++n) _Pragma("unroll") for (int k = 0; k < 2; ++k) dst[n][k] = *(const PG8_LAS bf16x8*)(lds + PG8_SB(b, h) + boff + n * 2048 + k * 1024); } while (0)
#define PG8_MMA(ai, bj, At, Bt) do { __builtin_amdgcn_s_setprio(1); _Pragma("unroll") for (int m = 0; m < 4; ++m) _Pragma("unroll") for (int n = 0; n < 2; ++n) _Pragma("unroll") for (int k = 0; k < 2; ++k) \
        acc[ai][bj][m][n] = __builtin_amdgcn_mfma_f32_16x16x32_bf16(Bt[n][k], At[m][k], acc[ai][bj][m][n], 0, 0, 0); __builtin_amdgcn_s_setprio(0); } while (0)
#define PG8_WAIT_V(n) asm volatile("s_waitcnt vmcnt(" #n ")" ::: "memory")
#define PG8_WAIT_L(n) asm volatile("s_waitcnt lgkmcnt(" #n ")" ::: "memory")
#define PG8_BAR __builtin_amdgcn_s_barrier()
#define PG8_SCHED __builtin_amdgcn_sched_barrier(0)
    Unit cur, nxt; int ui = 0;
    if (!S.next(0, cur)) return;
    f32x4 acc[2][2][4][2];
#pragma unroll
    for (int a = 0; a < 2; ++a)
#pragma unroll
        for (int b = 0; b < 2; ++b)
#pragma unroll
            for (int m = 0; m < 4; ++m)
#pragma unroll
                for (int n = 0; n < 2; ++n) acc[a][b][m][n] = (f32x4){0.f, 0.f, 0.f, 0.f};
    bf16x8 At[4][2], B0[2][2], B1[2][2];
    const char* cA = (const char*)g.A + (size_t)cur.pm * tstepA; const char* cB = (const char*)g.Bt + (size_t)cur.e * g.estride + (size_t)cur.pn * tstep;
    S.a_ready(cur);
    if constexpr (SP2) {
        PG8_STAGE(PG8_SB(0, 0), cB, voffB); PG8_STAGE(PG8_SB(0, 1), cB + hstep, voffB); PG8_STAGE(PG8_SA(0, 0), cA, voffA); PG8_STAGE(PG8_SA(0, 1), cA + hstepA, voffA);
        if (wr == 1) PG8_BAR;
        PG8_WAIT_V(2); PG8_BAR;
        PG8_STAGE(PG8_SB(1, 0), cB + kstep, voffB); PG8_STAGE(PG8_SA(1, 0), cA + kstep, voffA); PG8_STAGE(PG8_SB(1, 1), cB + hstep + kstep, voffB);
        PG8_WAIT_V(6); PG8_BAR;
    } else {
        PG8_STAGE(PG8_SB(0, 0), cB, voffB); PG8_STAGE(PG8_SA(0, 0), cA, voffA); PG8_STAGE(PG8_SB(0, 1), cB + hstep, voffB); PG8_STAGE(PG8_SA(0, 1), cA + hstepA, voffA);
        if (wr == 1) PG8_BAR;
        PG8_WAIT_V(4); PG8_BAR;
        PG8_STAGE(PG8_SB(1, 0), cB + kstep, voffB); PG8_STAGE(PG8_SA(1, 0), cA + kstep, voffA); PG8_STAGE(PG8_SB(1, 1), cB + hstep + kstep, voffB);
        PG8_WAIT_V(6); PG8_BAR;
    }
    for (;;) {
        const bool has_next = S.next(ui + 1, nxt);
        const char* nA = has_next ? (const char*)g.A + (size_t)nxt.pm * tstepA : cA; const char* nB = has_next ? (const char*)g.Bt + (size_t)nxt.e * g.estride + (size_t)nxt.pn * tstep : cB;
        for (int t = 0; t < nt; t += 2) {
            const bool last = (t == nt - 2);
            const char* a1 = cA + (size_t)(t + 1) * kstep;
            const char* a2 = last ? nA : cA + (size_t)(t + 2) * kstep; const char* b2 = last ? nB : cB + (size_t)(t + 2) * kstep;
            const char* a3 = a2 + kstep; const char* b3 = b2 + kstep;
            if (last && has_next) S.a_ready(nxt);
            if constexpr (SP2) {
            PG8_LDB(B0, 0, 0); PG8_LDB(B1, 0, 1); PG8_SCHED; PG8_LDA(At, 0, 0); PG8_STAGE(PG8_SA(1, 1), a1 + hstepA, voffA);
            PG8_WAIT_V(8); PG8_WAIT_L(0); PG8_BAR; PG8_MMA(0, 0, At, B0); PG8_MMA(0, 1, At, B1); PG8_BAR; PG8_SCHED;
            PG8_LDA(At, 0, 1); PG8_STAGE(PG8_SB(0, 0), b2, voffB); PG8_STAGE(PG8_SB(0, 1), b2 + hstep, voffB); PG8_STAGE(PG8_SA(0, 0), a2, voffA);
            PG8_WAIT_V(8); PG8_WAIT_L(0); PG8_BAR; PG8_MMA(1, 0, At, B0); PG8_MMA(1, 1, At, B1); PG8_BAR; PG8_SCHED;
            PG8_LDB(B0, 1, 0); PG8_LDB(B1, 1, 1); PG8_SCHED; PG8_LDA(At, 1, 0); PG8_STAGE(PG8_SA(0, 1), a2 + hstepA, voffA);
            PG8_WAIT_V(8); PG8_WAIT_L(0); PG8_BAR; PG8_MMA(0, 0, At, B0); PG8_MMA(0, 1, At, B1); PG8_BAR; PG8_SCHED;
            PG8_LDA(At, 1, 1); PG8_STAGE(PG8_SB(1, 0), b3, voffB); PG8_STAGE(PG8_SB(1, 1), b3 + hstep, voffB); PG8_STAGE(PG8_SA(1, 0), a3, voffA);
            PG8_WAIT_V(8); PG8_WAIT_L(0); PG8_BAR; PG8_MMA(1, 0, At, B0); PG8_MMA(1, 1, At, B1); PG8_BAR; PG8_SCHED;
            } else {
            PG8_LDB(B0, 0, 0); PG8_SCHED; PG8_LDA(At, 0, 0); PG8_STAGE(PG8_SA(1, 1), a1 + hstepA, voffA);
            PG8_WAIT_L(8); PG8_BAR; PG8_WAIT_L(0); PG8_MMA(0, 0, At, B0); PG8_BAR; PG8_SCHED;
            PG8_LDB(B1, 0, 1); PG8_STAGE(PG8_SB(0, 0), b2, voffB);
            PG8_BAR; PG8_WAIT_L(0); PG8_MMA(0, 1, At, B1); PG8_BAR;
            PG8_LDA(At, 0, 1); PG8_STAGE(PG8_SA(0, 0), a2, voffA);
            PG8_BAR; PG8_WAIT_L(0); PG8_MMA(1, 0, At, B0); PG8_BAR; PG8_SCHED;
            PG8_STAGE(PG8_SB(0, 1), b2 + hstep, voffB);
            PG8_WAIT_V(6); PG8_BAR; PG8_MMA(1, 1, At, B1); PG8_BAR;
            PG8_LDB(B0, 1, 0); PG8_SCHED; PG8_LDA(At, 1, 0); PG8_STAGE(PG8_SA(0, 1), a2 + hstepA, voffA);
            PG8_WAIT_L(8); PG8_BAR; PG8_WAIT_L(0); PG8_MMA(0, 0, At, B0); PG8_BAR; PG8_SCHED;
            PG8_LDB(B1, 1, 1); PG8_STAGE(PG8_SB(1, 0), b3, voffB);
            PG8_BAR; PG8_WAIT_L(0); PG8_MMA(0, 1, At, B1); PG8_BAR;
            PG8_LDA(At, 1, 1); PG8_STAGE(PG8_SA(1, 0), a3, voffA);
            PG8_BAR; PG8_WAIT_L(0); PG8_MMA(1, 0, At, B0); PG8_BAR; PG8_SCHED;
            PG8_STAGE(PG8_SB(1, 1), b3 + hstep, voffB);
            PG8_WAIT_V(6); PG8_BAR; PG8_MMA(1, 1, At, B1); PG8_BAR;
            }
        }
        if constexpr (ALIGN_EPI) { if (wr == 0) PG8_BAR; }
        if constexpr (!Epi::AFTER_DRAIN) { E(acc, cur, wr, wc, fr, fq); S.done(cur); }
        if (!has_next) break;
#pragma unroll
        for (int a = 0; a < 2; ++a)
#pragma unroll
            for (int b = 0; b < 2; ++b)
#pragma unroll
                for (int m = 0; m < 4; ++m)
#pragma unroll
                    for (int n = 0; n < 2; ++n) acc[a][b][m][n] = (f32x4){0.f, 0.f, 0.f, 0.f};
        cur = nxt; cA = nA; cB = nB; ++ui;
        if constexpr (ALIGN_EPI) { if (wr == 1) PG8_BAR; }
    }
    PG8_WAIT_V(0);
    if constexpr (!ALIGN_EPI) { if (wr == 0) PG8_BAR; }
    PG8_BAR;
    if constexpr (Epi::AFTER_DRAIN) { E.fused(acc, cur, wr, wc, fr, fq, lds, wid, lane); S.done(cur); }
#undef PG8_SA
#undef PG8_SB
#undef PG8_STAGE
#undef PG8_LDA
#undef PG8_LDB
#undef PG8_MMA
#undef PG8_WAIT_V
#undef PG8_WAIT_L
#undef PG8_BAR
#undef PG8_SCHED
}
}

constexpr int NT = 65536, DM = 1024, NBATCH = 32, SEQ = 2048;
constexpr int DFF = 2816, DFE = 3584, NEXP = 8;
constexpr int MOE_ROWS = 133120;
constexpr float EPS = 1e-6f;
constexpr size_t MiB = 1u << 20;
constexpr size_t WS_CTL = 0, CTL_ZERO_BYTES = 1 * MiB;
constexpr size_t WS_LA = 1 * MiB;
constexpr size_t WS_L1 = WS_LA + 8192;
constexpr size_t WS_CB = WS_LA + 16384;
constexpr size_t WS_RCNT = WS_LA + 32768;
constexpr size_t WS_RTAB = WS_LA + 65536;
constexpr size_t WS_ROUTE = 2 * MiB;
constexpr size_t WS_SLOT = 3 * MiB;
constexpr size_t WS_SELM = 4 * MiB;
constexpr size_t WS_GATES = 8 * MiB;
constexpr size_t WS_KC = 20 * MiB;
constexpr size_t WS_VCT = 22 * MiB;
constexpr size_t WS_HC = 24 * MiB;
constexpr size_t WS_W = 48 * MiB;
constexpr size_t W_HIN = WS_W, W_HOUT = WS_W + 16 * MiB, W_KVQ = WS_W + 20 * MiB, W_Q3 = WS_W + 26 * MiB, W_CMP1 = WS_W + 29 * MiB, W_NOUT = WS_W + 31 * MiB,
                 W_FGU = WS_W + 35 * MiB, W_FDN = WS_W + 57 * MiB, W_MGU = WS_W + 68 * MiB, W_MDN = WS_W + 292 * MiB;
constexpr size_t WS_XN = 452 * MiB;
constexpr size_t WS_R = 580 * MiB;
constexpr size_t R_PQ = WS_R, R_PI = WS_R + 128 * MiB, R_PG = WS_R + 256 * MiB, R_LF = WS_R + 384 * MiB, R_O2 = WS_R + 640 * MiB;
constexpr size_t R_HF = WS_R + 256 * MiB;
constexpr size_t R_KS = WS_R, R_KW = WS_R + 32 * MiB, R_VST = WS_R + 64 * MiB, R_VWT = WS_R + 96 * MiB, R_KCR = WS_R + 128 * MiB, R_VCR = WS_R + 160 * MiB;
constexpr size_t R_QKV = WS_R + 256 * MiB;
constexpr size_t R_Q = WS_R + 608 * MiB, R_O = WS_R + 736 * MiB;
constexpr size_t R_XP = WS_R, R_HM = WS_R + 260 * MiB;
constexpr size_t WS_NEED = R_HM + (size_t)MOE_ROWS * DFE * 2;
static_assert(WS_NEED <= 1792 * MiB, "workspace map");
static_assert(W_MDN + 112 * MiB <= WS_XN, "weights map");
static_assert(pg8::EpiHgrnIn::O_PQ == R_PQ && pg8::EpiHgrnIn::O_PI == R_PI && pg8::EpiHgrnIn::O_PG == R_PG && pg8::EpiHgrnIn::O_LF == R_LF && pg8::EpiHgrnIn::O_LA == WS_LA && pg8::EpiHgrnIn::O_L1 == WS_L1, "EpiHgrnIn offsets");

constexpr int LDS_BYTES = 147456;
constexpr int MISC_OFF = 131072 + 320;
constexpr int NWAVES = 8;

#define GAS __attribute__((address_space(1)))
#define LAS __attribute__((address_space(3)))
typedef unsigned short bf16;
typedef unsigned v4u __attribute__((ext_vector_type(4)));
typedef unsigned v2u __attribute__((ext_vector_type(2)));
typedef float f32x4 __attribute__((ext_vector_type(4)));
#define LDS_WAIT() asm volatile("s_waitcnt lgkmcnt(0)" ::: "memory")
__device__ __forceinline__ unsigned f2bf(float f) { unsigned u = __builtin_bit_cast(unsigned, f); return (u + 0x7fffu + ((u >> 16) & 1u)) >> 16; }
__device__ __forceinline__ unsigned pk2(float lo, float hi) { return f2bf(lo) | (f2bf(hi) << 16); }
__device__ __forceinline__ float bf2f(unsigned b) { return __builtin_bit_cast(float, b << 16); }
__device__ __forceinline__ float bflo(unsigned w) { return __builtin_bit_cast(float, w << 16); }
__device__ __forceinline__ float bfhi(unsigned w) { return __builtin_bit_cast(float, w & 0xffff0000u); }
__device__ __forceinline__ float wave_sum(float v) {
#pragma unroll
    for (int o = 32; o >= 1; o >>= 1) v += __shfl_xor(v, o);
    return v;
}
__device__ __forceinline__ float wave_max(float v) {
#pragma unroll
    for (int o = 32; o >= 1; o >>= 1) v = fmaxf(v, __shfl_xor(v, o));
    return v;
}

#define XB_TMO      128
#define XB_XCNT(j)  (256  + 64 * (j))
#define XB_XSUB(j)  (1280 + 64 * (j))
#define XB_XGEN(j)  (2304 + 64 * (j))
#define XB_TOP      3328
#define XB_TOPGEN   3392
#define XCD_BAR_WORDS 3456
#define XB_SPIN_CAP (1u << 22)
__device__ __forceinline__ unsigned xb_ld(unsigned* p)              { return __hip_atomic_load(p, __ATOMIC_RELAXED, __HIP_MEMORY_SCOPE_AGENT); }
__device__ __forceinline__ unsigned xb_add(unsigned* p, unsigned v) { return __hip_atomic_fetch_add(p, v, __ATOMIC_RELAXED, __HIP_MEMORY_SCOPE_AGENT); }
__device__ __forceinline__ unsigned xb_xcc_id() { return (unsigned)__builtin_amdgcn_s_getreg((3 << 11) | 20) & 0xFu; }
#define XB_SPIN(cond, bar) do { unsigned _sp = 0; while (cond) { __builtin_amdgcn_s_sleep(1); \
    if ((++_sp & 255u) == 0u) { if (xb_ld(&(bar)[XB_TMO])) break; if (_sp > XB_SPIN_CAP) { atomicAdd(&(bar)[XB_TMO], 1u); break; } } } } while (0)
struct XcdBarrier { unsigned* bar; unsigned x; volatile LAS unsigned* st; };
__device__ __forceinline__ XcdBarrier xcd_barrier_post(unsigned* bar, volatile LAS unsigned* st) {
    XcdBarrier b; b.bar = bar; b.x = xb_xcc_id(); b.st = st;
    if (threadIdx.x == 0) (void)xb_add(&bar[XB_XCNT(b.x)], 1u);
    return b;
}
__device__ __forceinline__ void xcd_barrier_complete(unsigned* bar, unsigned x, unsigned& nloc, unsigned& nx) {
    const unsigned G = gridDim.x * gridDim.y * gridDim.z;
    unsigned sum, cnt, mine, sp = 0u;
    for (;;) {
        sum = 0u; cnt = 0u; mine = 0u;
#pragma unroll
        for (unsigned j = 0; j < 16; ++j) { const unsigned c = xb_ld(&bar[XB_XCNT(j)]); sum += c; cnt += (c > 0u) ? 1u : 0u; mine = (j == x) ? c : mine; }
        if (sum == G) break;
        __builtin_amdgcn_s_sleep(1);
        if ((++sp & 255u) == 0u) { if (xb_ld(&bar[XB_TMO])) break; if (sp > XB_SPIN_CAP) { atomicAdd(&bar[XB_TMO], 1u); break; } }
    }
    nloc = mine > 0u ? mine : 1u; nx = cnt > 0u ? cnt : 1u;
}
__device__ __forceinline__ void xcd_barrier(const XcdBarrier& b) {
    asm volatile("s_waitcnt vmcnt(0)" ::: "memory");
    __syncthreads();
    if (threadIdx.x == 0) {
        unsigned* bar = b.bar;
        __builtin_amdgcn_s_waitcnt(0);
        unsigned nloc = b.st[0], nx = b.st[1];
        if (nloc == 0u) { xcd_barrier_complete(bar, b.x, nloc, nx); b.st[0] = nloc; b.st[1] = nx; }
        const unsigned old = xb_add(&bar[XB_XSUB(b.x)], 1u);
        const unsigned gen = old / nloc;
        if (old + 1u == (gen + 1u) * nloc) {
            __builtin_amdgcn_fence(__ATOMIC_RELEASE, "agent");
            asm volatile("s_waitcnt vmcnt(0)" ::: "memory");
            const unsigned og = xb_add(&bar[XB_TOP], 1u);
            const unsigned tg = og / nx;
            if (og + 1u == (tg + 1u) * nx) xb_add(&bar[XB_TOPGEN], 1u);
            else XB_SPIN(xb_ld(&bar[XB_TOPGEN]) == tg, bar);
            __builtin_amdgcn_fence(__ATOMIC_ACQUIRE, "agent");
            xb_add(&bar[XB_XGEN(b.x)], 1u);
            asm volatile("s_waitcnt vmcnt(0)" ::: "memory");
        } else {
            XB_SPIN(xb_ld(&bar[XB_XGEN(b.x)]) == gen, bar);
            __builtin_amdgcn_fence(__ATOMIC_ACQUIRE, "agent");
            asm volatile("s_waitcnt vmcnt(0)" ::: "memory");
        }
    }
    __syncthreads();
}

struct Ctx {
    LAS unsigned char* lds;
    int tid, lane, wave, G, bid;
    float* out; unsigned char* ws;
    __device__ __forceinline__ const float* inp(int i) const {
        const __attribute__((address_space(4))) unsigned char* kp = (const __attribute__((address_space(4))) unsigned char*)__builtin_amdgcn_kernarg_segment_ptr();
        asm volatile("" : "+s"(kp));
        return ((const float* const __attribute__((address_space(4)))*)kp)[i];
    }
};
enum { I_X = 0, I_NMIX, I_NFFN, I_HWIN, I_HWOUT, I_HGN, I_HLB, I_KVN, I_KVW, I_CPK, I_CW1K, I_CW2K, I_CPV, I_CW1V, I_CW2V, I_KN, I_NWIN, I_NWOUT, I_NQN, I_FGU, I_FDN, I_MR, I_MGU, I_MDN };

constexpr int MAXJOB = 64;
struct JobTab { unsigned long long src[MAXJOB], gain[MAXJOB], dst[MAXJOB]; int K[MAXJOB], Nsrc[MAXJOB], npb[MAXJOB], F[MAXJOB], rowoff[MAXJOB], istart[MAXJOB + 1]; int njobs; };
__device__ __forceinline__ void add_job(LAS JobTab* J, const float* src, const float* gain, bf16* dst, int K, int Nsrc, int Npad, int F, int rowoff) {
    const int j = J->njobs; J->src[j] = (unsigned long long)src; J->gain[j] = (unsigned long long)gain; J->dst[j] = (unsigned long long)dst;
    J->K[j] = K; J->Nsrc[j] = Nsrc; J->npb[j] = Npad / 32; J->F[j] = F; J->rowoff[j] = rowoff; J->istart[j + 1] = J->istart[j] + (K / 64) * (Npad / 32); J->njobs = j + 1;
}
__device__ __forceinline__ void transpose_item(const float* W, int K, int Nsrc, const float* gain, bf16* WT, int dstrow0, int k0, int n0, LAS float* scr, int lane) {
    const int n = n0 + (lane & 31); const bool okn = n < Nsrc;
#pragma unroll 8
    for (int i = 0; i < 32; ++i) { const int kk = 2 * i + (lane >> 5); float v = okn ? W[(size_t)(k0 + kk) * Nsrc + n] : 0.f; if (gain) v *= gain[k0 + kk]; scr[kk * 33 + (lane & 31)] = v; }
    LDS_WAIT();
    const int c = lane & 7;
#pragma unroll
    for (int j = 0; j < 4; ++j) { const int nn = (lane >> 3) + 8 * j; const LAS float* s = scr + (8 * c) * 33 + nn;
        v4u o; o.x = pk2(s[0 * 33], s[1 * 33]); o.y = pk2(s[2 * 33], s[3 * 33]); o.z = pk2(s[4 * 33], s[5 * 33]); o.w = pk2(s[6 * 33], s[7 * 33]);
        *(v4u*)(WT + (size_t)(dstrow0 + nn) * K + k0 + 8 * c) = o; }
    LDS_WAIT();
}
__device__ __forceinline__ void norm_row_store(const f32x4 (&v)[4], bf16* orow, int lane) {
    float s = 0.f;
#pragma unroll
    for (int j = 0; j < 4; ++j) s += (v[j].x * v[j].x + v[j].y * v[j].y) + (v[j].z * v[j].z + v[j].w * v[j].w);
    const float rstd = rsqrtf(wave_sum(s) * (1.f / DM) + EPS);
    v2u* o8 = (v2u*)orow + lane;
#pragma unroll
    for (int j = 0; j < 4; ++j) { v2u w; w.x = pk2(v[j].x * rstd, v[j].y * rstd); w.y = pk2(v[j].z * rstd, v[j].w * rstd); o8[64 * j] = w; }
}
__device__ __forceinline__ void p_prologue(Ctx& C) {
    LAS JobTab* J = (LAS JobTab*)(C.lds + 69632);
    unsigned char* ws = C.ws;
    if (C.tid == 0) {
        J->njobs = 0; J->istart[0] = 0;
        for (int l = 0; l < 2; ++l) add_job(J, C.inp(I_HWIN) + (size_t)l * 1024 * 4096, C.inp(I_NMIX) + l * 1024, (bf16*)(ws + W_HIN) + (size_t)l * 4096 * 1024, 1024, 4096, 4096, 0, 0);
        for (int l = 0; l < 2; ++l) add_job(J, C.inp(I_HWOUT) + (size_t)l * 1024 * 1024, nullptr, (bf16*)(ws + W_HOUT) + (size_t)l * 1024 * 1024, 1024, 1024, 1024, 0, 0);
        add_job(J, C.inp(I_KVW), C.inp(I_KVN), (bf16*)(ws + W_KVQ), 1024, 1536, 1536, 0, 0);
        add_job(J, C.inp(I_NWIN), C.inp(I_NMIX) + 2048, (bf16*)(ws + W_KVQ), 1024, 1072, 1280, 0, 1536);
        add_job(J, C.inp(I_NWIN) + (size_t)1024 * 1072, C.inp(I_NMIX) + 3072, (bf16*)(ws + W_Q3), 1024, 1072, 1280, 0, 0);
        add_job(J, C.inp(I_CW1K), nullptr, (bf16*)(ws + W_CMP1), 2048, 256, 256, 0, 0);
        add_job(J, C.inp(I_CW1V), nullptr, (bf16*)(ws + W_CMP1) + (size_t)256 * 2048, 2048, 256, 256, 0, 0);
        for (int l = 0; l < 2; ++l) add_job(J, C.inp(I_NWOUT) + (size_t)l * 1024 * 1024, nullptr, (bf16*)(ws + W_NOUT) + (size_t)l * 1024 * 1024, 1024, 1024, 1024, 0, 0);
        for (int l = 0; l < 2; ++l) add_job(J, C.inp(I_FGU) + (size_t)l * 1024 * 2 * DFF, C.inp(I_NFFN) + (2 * l) * 1024, (bf16*)(ws + W_FGU) + (size_t)l * 2 * DFF * 1024, 1024, 2 * DFF, 2 * DFF, DFF, 0);
        for (int l = 0; l < 2; ++l) add_job(J, C.inp(I_FDN) + (size_t)l * DFF * 1024, nullptr, (bf16*)(ws + W_FDN) + (size_t)l * 1024 * DFF, DFF, 1024, 1024, 0, 0);
        for (int l = 0; l < 16; ++l) add_job(J, C.inp(I_MGU) + (size_t)l * 1024 * 2 * DFE, C.inp(I_NFFN) + (2 * (l >> 3) + 1) * 1024, (bf16*)(ws + W_MGU) + (size_t)l * 2 * DFE * 1024, 1024, 2 * DFE, 2 * DFE, DFE, 0);
        for (int l = 0; l < 16; ++l) add_job(J, C.inp(I_MDN) + (size_t)l * DFE * 1024, nullptr, (bf16*)(ws + W_MDN) + (size_t)l * 1024 * DFE, DFE, 1024, 1024, 0, 0);
    }
    __syncthreads();
    LAS float* scr = (LAS float*)(C.lds + C.wave * 8704);
    const int gw = C.bid * NWAVES + C.wave, NGW = C.G * NWAVES;
    const int nj = J->njobs, total = J->istart[nj];
    for (int it = gw; it < total; it += NGW) {
        int j = 0; while (j + 1 < nj && J->istart[j + 1] <= it) ++j;
        const int r = it - J->istart[j], npb = J->npb[j], kb = r / npb, nb = r % npb, n0 = 32 * nb, F = J->F[j];
        int drow = J->rowoff[j] + n0;
        if (F) drow = (n0 < F) ? 256 * (n0 / 128) + (n0 % 128) : 256 * ((n0 - F) / 128) + 128 + ((n0 - F) % 128);
        transpose_item((const float*)J->src[j], J->K[j], J->Nsrc[j], (const float*)J->gain[j], (bf16*)J->dst[j], drow, 64 * kb, n0, scr, C.lane);
    }
    { const int gt = C.bid * 512 + C.tid;
      if (gt < 1024) { const float a0 = C.inp(I_HLB)[gt], a1 = C.inp(I_HLB)[1024 + gt]; const float mx = fmaxf(a0, a1), e0 = expf(a0 - mx), e1 = expf(a1 - mx), s = e0 + e1;
          const float s0 = e0 / s, s1 = e1 / s, lb1 = (s0 + s1) - s0;
          float* la = (float*)(ws + WS_LA); float* l1 = (float*)(ws + WS_L1);
          la[gt] = -INFINITY; l1[gt] = 0.f; la[1024 + gt] = logf(lb1); l1[1024 + gt] = log1pf(-lb1); } }
    if (C.bid == 0 && C.tid < 128) ((int*)(ws + WS_RTAB))[2048 + C.tid] = C.tid >> 6;
    if (C.bid == (C.G > 1 ? 1 : 0)) { const int which = C.tid >> 8, j = C.tid & 255; const float* pos = C.inp(which ? I_CPV : I_CPK); const float* w1 = C.inp(which ? I_CW1V : I_CW1K);
        float a = 0.f; for (int i = 0; i < 2048; ++i) a += pos[i] * w1[(size_t)i * 256 + j];
        ((float*)(ws + WS_CB))[which * 256 + j] = a; }
    for (int c = C.bid; c < 256; c += C.G)
        for (int i = 0; i < 32; ++i) { const int row = c * 256 + C.wave * 32 + i; const f32x4* xr = (const f32x4*)(C.inp(I_X) + (size_t)row * DM) + C.lane; f32x4 v[4];
#pragma unroll
            for (int j = 0; j < 4; ++j) v[j] = xr[64 * j];
            norm_row_store(v, (bf16*)(ws + WS_XN) + (size_t)row * DM, C.lane); }
}

template <bool MOE_ADD, bool ROUTER, bool WRITE_XN>
__device__ __forceinline__ void p_norm(Ctx& C, const float* rw, const float* rgain) {
    unsigned char* ws = C.ws;
    LAS int* cnt8 = (LAS int*)(C.lds + 1024);
    const bf16* Y = (const bf16*)(ws + R_XP);
    const int4* route = (const int4*)(ws + WS_ROUTE); const int2* slot = (const int2*)(ws + WS_SLOT);
    for (int c = C.bid; c < 256; c += C.G) {
        if (ROUTER) { __syncthreads(); if (C.tid < 8) cnt8[C.tid] = 0; __syncthreads(); }
        for (int i = 0; i < 32; ++i) {
            const int row = c * 256 + C.wave * 32 + i;
            float* hr = C.out + (size_t)row * DM; f32x4 v[4];
#pragma unroll
            for (int j = 0; j < 4; ++j) v[j] = ((const f32x4*)hr + C.lane)[64 * j];
            if (MOE_ADD) {
                const int4 rt = route[row]; const int2 sl = slot[row]; const float w0 = __builtin_bit_cast(float, rt.y), w1 = __builtin_bit_cast(float, rt.z);
                const v2u* y0 = (const v2u*)(Y + (size_t)sl.x * DM) + C.lane; const v2u* y1 = (const v2u*)(Y + (size_t)sl.y * DM) + C.lane;
#pragma unroll
                for (int j = 0; j < 4; ++j) { const v2u a = y0[64 * j], b = y1[64 * j];
                    v[j].x += w0 * bflo(a.x) + w1 * bflo(b.x); v[j].y += w0 * bfhi(a.x) + w1 * bfhi(b.x); v[j].z += w0 * bflo(a.y) + w1 * bflo(b.y); v[j].w += w0 * bfhi(a.y) + w1 * bfhi(b.y);
                    ((f32x4*)hr + C.lane)[64 * j] = v[j]; }
            }
            if (WRITE_XN || ROUTER) {
                float s = 0.f;
#pragma unroll
                for (int j = 0; j < 4; ++j) s += (v[j].x * v[j].x + v[j].y * v[j].y) + (v[j].z * v[j].z + v[j].w * v[j].w);
                const float rstd = rsqrtf(wave_sum(s) * (1.f / DM) + EPS);
                if (WRITE_XN) { v2u* o8 = (v2u*)((bf16*)(ws + WS_XN) + (size_t)row * DM) + C.lane;
#pragma unroll
                    for (int j = 0; j < 4; ++j) { v2u w; w.x = pk2(v[j].x * rstd, v[j].y * rstd); w.y = pk2(v[j].z * rstd, v[j].w * rstd); o8[64 * j] = w; } }
                if (ROUTER) {
                    float lg[8];
#pragma unroll
                    for (int e = 0; e < 8; ++e) lg[e] = 0.f;
#pragma unroll
                    for (int j = 0; j < 4; ++j) { const int k0 = 4 * C.lane + 256 * j; const f32x4 g4 = *(const f32x4*)(rgain + k0);
#pragma unroll
                        for (int q = 0; q < 4; ++q) { const float xv = v[j][q] * rstd * g4[q]; const f32x4 wa = *(const f32x4*)(rw + (size_t)(k0 + q) * 8), wb = *(const f32x4*)(rw + (size_t)(k0 + q) * 8 + 4);
                            lg[0] += xv * wa.x; lg[1] += xv * wa.y; lg[2] += xv * wa.z; lg[3] += xv * wa.w; lg[4] += xv * wb.x; lg[5] += xv * wb.y; lg[6] += xv * wb.z; lg[7] += xv * wb.w; } }
#pragma unroll
                    for (int e = 0; e < 8; ++e) lg[e] = wave_sum(lg[e]);
                    int e0 = 0; float v0 = lg[0];
#pragma unroll
                    for (int e = 1; e < 8; ++e) if (lg[e] > v0) { v0 = lg[e]; e0 = e; }
                    int e1 = -1; float v1 = -INFINITY;
#pragma unroll
                    for (int e = 0; e < 8; ++e) if (e != e0 && (e1 < 0 || lg[e] > v1)) { v1 = lg[e]; e1 = e; }
                    const float ex = expf(v1 - v0), w0 = 1.f / (1.f + ex), w1 = ex / (1.f + ex);
                    if (C.lane == 0) { ((int4*)(ws + WS_ROUTE))[row] = make_int4(e0 | (e1 << 8), __builtin_bit_cast(int, w0), __builtin_bit_cast(int, w1), 0);
                        atomicAdd((int*)&cnt8[e0], 1); atomicAdd((int*)&cnt8[e1], 1); }
                }
            }
        }
        if (ROUTER) { __syncthreads(); if (C.tid < 8) ((int*)(ws + WS_RCNT))[c * 8 + C.tid] = cnt8[C.tid]; }
    }
}

__device__ __forceinline__ void p_gather(Ctx& C) {
    unsigned char* ws = C.ws;
    LAS int* tot = (LAS int*)(C.lds + 0);
    LAS int* pre = tot + 8;
    LAS int* base = tot + 16;
    LAS int* ee = tot + 32;
    LAS int* sl = tot + 32 + 256;
    const int* rcnt = (const int*)(ws + WS_RCNT);
    const int4* route = (const int4*)(ws + WS_ROUTE);
    for (int c = C.bid; c < 256; c += C.G) {
        __syncthreads();
        { const int e = C.wave; int t = 0, p = 0;
          for (int i = C.lane; i < 256; i += 64) { const int v = rcnt[i * 8 + e]; t += v; if (i < c) p += v; }
#pragma unroll
          for (int o = 32; o >= 1; o >>= 1) { t += __shfl_xor(t, o); p += __shfl_xor(p, o); }
          if (C.lane == 0) { tot[e] = t; pre[e] = p; } }
        if (C.tid < 256) ee[C.tid] = route[c * 256 + C.tid].x;
        __syncthreads();
        if (C.tid == 0) { int off = 0; for (int e = 0; e < 8; ++e) { base[e] = off + pre[e]; const int nt = (tot[e] + 255) >> 8;
                if (c == 0) { int* te = (int*)(ws + WS_RTAB); for (int q = 0; q < nt; ++q) te[(off >> 8) + q] = e; }
                off += nt << 8; }
            if (c == 0) ((int*)(ws + WS_RTAB))[1024] = off >> 8; }
        __syncthreads();
        if (C.tid < 8) { const int e = C.tid; int r = base[e];
            for (int i = 0; i < 256; ++i) { const int pk = ee[i]; if ((pk & 255) == e) sl[2 * i] = r++; if ((pk >> 8) == e) sl[2 * i + 1] = r++; } }
        __syncthreads();
        if (C.tid < 256) ((int2*)(ws + WS_SLOT))[c * 256 + C.tid] = make_int2(sl[2 * C.tid], sl[2 * C.tid + 1]);
        for (int i = 0; i < 32; ++i) { const int tl = C.wave * 32 + i, row = c * 256 + tl;
            const v4u* src = (const v4u*)((const bf16*)(ws + WS_XN) + (size_t)row * DM) + C.lane; const v4u a = src[0], b = src[64];
            v4u* d0 = (v4u*)((bf16*)(ws + R_XP) + (size_t)sl[2 * tl] * DM) + C.lane; v4u* d1 = (v4u*)((bf16*)(ws + R_XP) + (size_t)sl[2 * tl + 1] * DM) + C.lane;
            d0[0] = a; d0[64] = b; d1[0] = a; d1[64] = b; }
    }
}

__device__ __forceinline__ void p_scan_naive(Ctx& C, int layer) {
    unsigned char* ws = C.ws;
    const bf16* Pq = (const bf16*)(ws + R_PQ); const bf16* Pi = (const bf16*)(ws + R_PI); const bf16* Pg = (const bf16*)(ws + R_PG); const float* LF = (const float*)(ws + R_LF);
    bf16* O2 = (bf16*)(ws + R_O2);
    const float* gn = C.inp(I_HGN) + layer * 128;
    LAS float* qs = (LAS float*)(C.lds);
    LAS float* fs = qs + 4096; LAS float* ks = fs + 4096; LAS float* vs = ks + 4096;
    LAS float* po = vs + 4096;
    const int v = C.tid & 127, kq = C.tid >> 7;
    for (int bh = C.bid; bh < 256; bh += C.G) {
        const int b = bh >> 3, h = bh & 7;
        float S[32];
#pragma unroll
        for (int j = 0; j < 32; ++j) S[j] = 0.f;
        for (int t0 = 0; t0 < SEQ; t0 += 32) {
            __syncthreads();
            { const int tok = C.tid >> 4, part = C.tid & 15; const size_t off = (size_t)(b * SEQ + t0 + tok) * DM + h * 128 + part * 8;
              const v4u q8 = *(const v4u*)(Pq + off), i8 = *(const v4u*)(Pi + off); const f32x4 f0 = *(const f32x4*)(LF + off), f1 = *(const f32x4*)(LF + off + 4);
              LAS float* d = qs + tok * 128 + part * 8;
              d[0] = bflo(q8.x); d[1] = bfhi(q8.x); d[2] = bflo(q8.y); d[3] = bfhi(q8.y); d[4] = bflo(q8.z); d[5] = bfhi(q8.z); d[6] = bflo(q8.w); d[7] = bfhi(q8.w);
              d = vs + tok * 128 + part * 8;
              d[0] = bflo(i8.x); d[1] = bfhi(i8.x); d[2] = bflo(i8.y); d[3] = bfhi(i8.y); d[4] = bflo(i8.z); d[5] = bfhi(i8.z); d[6] = bflo(i8.w); d[7] = bfhi(i8.w);
              LAS float* df = fs + tok * 128 + part * 8; LAS float* dk = ks + tok * 128 + part * 8;
#pragma unroll
              for (int j = 0; j < 4; ++j) { const float fa = expf(f0[j]), fb = expf(f1[j]); df[j] = fa; dk[j] = 1.f - fa; df[4 + j] = fb; dk[4 + j] = 1.f - fb; } }
            __syncthreads();
            for (int tt = 0; tt < 32; ++tt) {
                const float vv = vs[tt * 128 + v]; float a = 0.f;
                const LAS float* fr = fs + tt * 128 + kq * 32; const LAS float* kr = ks + tt * 128 + kq * 32; const LAS float* qr = qs + tt * 128 + kq * 32;
#pragma unroll
                for (int j = 0; j < 32; ++j) { S[j] = fr[j] * S[j] + kr[j] * vv; a += qr[j] * S[j]; }
                po[(tt * 4 + kq) * 128 + v] = a;
            }
            __syncthreads();
            { const int tok = C.tid >> 4, part = C.tid & 15; float o[8]; float ss = 0.f;
#pragma unroll
              for (int j = 0; j < 8; ++j) { const int vv = part * 8 + j; o[j] = (po[(tok * 4 + 0) * 128 + vv] + po[(tok * 4 + 1) * 128 + vv]) + (po[(tok * 4 + 2) * 128 + vv] + po[(tok * 4 + 3) * 128 + vv]); ss += o[j] * o[j]; }
              ss += __shfl_xor(ss, 1); ss += __shfl_xor(ss, 2); ss += __shfl_xor(ss, 4); ss += __shfl_xor(ss, 8);
              const float rstd = rsqrtf(ss * (1.f / 128.f) + EPS);
              const size_t off = (size_t)(b * SEQ + t0 + tok) * DM + h * 128 + part * 8; const v4u g8 = *(const v4u*)(Pg + off);
              const float gg[8] = {bflo(g8.x), bfhi(g8.x), bflo(g8.y), bfhi(g8.y), bflo(g8.z), bfhi(g8.z), bflo(g8.w), bfhi(g8.w)};
              float r[8];
#pragma unroll
              for (int j = 0; j < 8; ++j) r[j] = o[j] * rstd * gn[part * 8 + j] * gg[j];
              v4u w; w.x = pk2(r[0], r[1]); w.y = pk2(r[2], r[3]); w.z = pk2(r[4], r[5]); w.w = pk2(r[6], r[7]);
              *(v4u*)(O2 + off) = w; }
        }
    }
}

__device__ __forceinline__ void p_post(Ctx& C, int has_kv, int ld, int j_layer) {
    unsigned char* ws = C.ws;
    const bf16* raw = (const bf16*)(ws + R_QKV);
    const float* kn = C.inp(I_KN); const float* qn = C.inp(I_NQN) + j_layer * 64;
    const int l = C.lane;
    for (int c = C.bid; c < 256; c += C.G)
        for (int i = 0; i < 32; ++i) {
            const int row = c * 256 + C.wave * 32 + i, b = row >> 11, t = row & 2047;
            const bf16* rr = raw + (size_t)row * ld;
            if (has_kv) {
#pragma unroll
                for (int g = 0; g < 4; ++g) {
                    const size_t tok = ((size_t)(b * 4 + g) * SEQ + t) * 64 + l, tr = ((size_t)(b * 4 + g) * 64 + l) * SEQ + t;
                    ((bf16*)(ws + R_KCR))[tok] = rr[0 * 256 + g * 64 + l];
                    ((bf16*)(ws + R_VCR))[tok] = rr[1 * 256 + g * 64 + l];
                    { const float x = bf2f(rr[2 * 256 + g * 64 + l]); const float rs = rsqrtf(wave_sum(x * x) * (1.f / 64.f) + EPS); ((bf16*)(ws + R_KS))[tok] = (bf16)f2bf(x * rs * kn[64 + l]); }
                    ((bf16*)(ws + R_VST))[tr] = rr[3 * 256 + g * 64 + l];
                    { const float x = bf2f(rr[4 * 256 + g * 64 + l]); const float rs = rsqrtf(wave_sum(x * x) * (1.f / 64.f) + EPS); ((bf16*)(ws + R_KW))[tok] = (bf16)f2bf(x * rs * kn[128 + l]); }
                    ((bf16*)(ws + R_VWT))[tr] = rr[5 * 256 + g * 64 + l];
                }
            }
            const int qo = has_kv ? 1536 : 0;
#pragma unroll 4
            for (int h = 0; h < 16; ++h) { const float x = bf2f(rr[qo + h * 64 + l]); const float rs = rsqrtf(wave_sum(x * x) * (1.f / 64.f) + EPS);
                ((bf16*)(ws + R_Q))[(size_t)row * DM + h * 64 + l] = (bf16)f2bf(x * rs * qn[l] * 0.125f); }
            if (l < 48) { const float x = bf2f(rr[qo + 1024 + l]); ((float*)(ws + WS_GATES))[(size_t)row * 48 + l] = 1.f / (1.f + expf(-x)); }
        }
}

__device__ __forceinline__ void p_cmp2(Ctx& C) {
    unsigned char* ws = C.ws;
    const bf16* Hk = (const bf16*)(ws + WS_HC); const bf16* Hv = Hk + (size_t)16384 * 256;
    const float* w2k = C.inp(I_CW2K); const float* w2v = C.inp(I_CW2V); const float* kn = C.inp(I_KN);
    LAS float* hk = (LAS float*)(C.lds + C.wave * 2048); LAS float* hv = hk + 256;
    const int l = C.lane, gw = C.bid * NWAVES + C.wave, NGW = C.G * NWAVES;
    for (int r = gw; r < 16384; r += NGW) {
        const int bg = r >> 7, c = r & 127;
        { const v2u a = *((const v2u*)(Hk + (size_t)r * 256) + l), bq = *((const v2u*)(Hv + (size_t)r * 256) + l);
          hk[4 * l] = bflo(a.x); hk[4 * l + 1] = bfhi(a.x); hk[4 * l + 2] = bflo(a.y); hk[4 * l + 3] = bfhi(a.y);
          hv[4 * l] = bflo(bq.x); hv[4 * l + 1] = bfhi(bq.x); hv[4 * l + 2] = bflo(bq.y); hv[4 * l + 3] = bfhi(bq.y); }
        LDS_WAIT();
        float ak = 0.f, av = 0.f;
#pragma unroll 8
        for (int j = 0; j < 256; ++j) { ak += hk[j] * w2k[j * 64 + l]; av += hv[j] * w2v[j * 64 + l]; }
        if (c == 127) { ak = 0.f; av = 0.f; }
        const float rs = rsqrtf(wave_sum(ak * ak) * (1.f / 64.f) + EPS);
        ((bf16*)(ws + WS_KC))[(size_t)r * 64 + l] = (bf16)f2bf(ak * rs * kn[l]);
        ((bf16*)(ws + WS_VCT))[((size_t)bg * 64 + l) * 128 + c] = (bf16)f2bf(av);
        LDS_WAIT();
    }
}

__device__ __forceinline__ void dot4(const bf16* krow, const LAS float* qf, float (&s)[4]) {
    s[0] = s[1] = s[2] = s[3] = 0.f;
#pragma unroll 1
    for (int ch = 0; ch < 8; ++ch) { const v4u k8 = ((const v4u*)krow)[ch];
        const float kk[8] = {bflo(k8.x), bfhi(k8.x), bflo(k8.y), bfhi(k8.y), bflo(k8.z), bfhi(k8.z), bflo(k8.w), bfhi(k8.w)};
#pragma unroll
        for (int h = 0; h < 4; ++h) { const f32x4 qa = *(const LAS f32x4*)(qf + h * 64 + ch * 8), qb = *(const LAS f32x4*)(qf + h * 64 + ch * 8 + 4);
            s[h] += (qa.x * kk[0] + qa.y * kk[1]) + (qa.z * kk[2] + qa.w * kk[3]) + (qb.x * kk[4] + qb.y * kk[5]) + (qb.z * kk[6] + qb.w * kk[7]); } }
}
__device__ __forceinline__ void p_attn_naive(Ctx& C) {
    unsigned char* ws = C.ws;
    const bf16* Q = (const bf16*)(ws + R_Q); const float* GT = (const float*)(ws + WS_GATES);
    const bf16* KC = (const bf16*)(ws + WS_KC); const bf16* VCT = (const bf16*)(ws + WS_VCT);
    const bf16* KS = (const bf16*)(ws + R_KS); const bf16* VST = (const bf16*)(ws + R_VST); const bf16* KW = (const bf16*)(ws + R_KW); const bf16* VWT = (const bf16*)(ws + R_VWT);
    bf16* O = (bf16*)(ws + R_O);
    LAS float* qf = (LAS float*)(C.lds + C.wave * 12288);
    LAS float* pb = qf + 256;
    LAS float* ps = pb + 2048;
    const int l = C.lane, gw = C.bid * NWAVES + C.wave, NGW = C.G * NWAVES;
    for (int task = gw; task < NT * 4; task += NGW) {
        const int t = task & 2047, bg = task >> 11, g = bg & 3, b = bg >> 2, row = b * SEQ + t;
        float slope[4];
#pragma unroll
        for (int h = 0; h < 4; ++h) slope[h] = exp2f(-0.5f * (float)(g * 4 + h + 1));
        { const v2u q4 = *((const v2u*)(Q + (size_t)row * DM + g * 256) + l); qf[4 * l] = bflo(q4.x); qf[4 * l + 1] = bfhi(q4.x); qf[4 * l + 2] = bflo(q4.y); qf[4 * l + 3] = bfhi(q4.y); }
        LDS_WAIT();
        float oc[4] = {0.f, 0.f, 0.f, 0.f};
        {
            float sc[2][4]; bool ok[2];
#pragma unroll
            for (int ci = 0; ci < 2; ++ci) { const int c = l + 64 * ci; ok[ci] = (c < 127) && (16 * c + 31 <= t);
                dot4(KC + ((size_t)bg * 128 + c) * 64, qf, sc[ci]);
#pragma unroll
                for (int h = 0; h < 4; ++h) sc[ci][h] = ok[ci] ? sc[ci][h] - slope[h] * (float)(t - 16 * c - 31) : -INFINITY; }
            float psum[2] = {0.f, 0.f};
#pragma unroll
            for (int h = 0; h < 4; ++h) { float mx = wave_max(fmaxf(sc[0][h], sc[1][h])); if (mx == -INFINITY) mx = 0.f;
                const float e0 = ok[0] ? expf(sc[0][h] - mx) : 0.f, e1 = ok[1] ? expf(sc[1][h] - mx) : 0.f; const float den = fmaxf(wave_sum(e0 + e1), 1e-30f);
                const float p0 = e0 / den, p1 = e1 / den; pb[h * 512 + l] = p0; pb[h * 512 + 64 + l] = p1; psum[0] += p0; psum[1] += p1; }
            ps[l] = psum[0]; ps[64 + l] = psum[1];
            LDS_WAIT();
            const bf16* vr = VCT + ((size_t)bg * 64 + l) * 128;
#pragma unroll 2
            for (int c0 = 0; c0 < 128; c0 += 8) { const v4u v8 = *(const v4u*)(vr + c0);
                const float vv[8] = {bflo(v8.x), bfhi(v8.x), bflo(v8.y), bfhi(v8.y), bflo(v8.z), bfhi(v8.z), bflo(v8.w), bfhi(v8.w)};
#pragma unroll
                for (int i = 0; i < 8; ++i)
#pragma unroll
                    for (int h = 0; h < 4; ++h) oc[h] += pb[h * 512 + c0 + i] * vv[i]; }
        }
        unsigned long long mask;
        {
            const int j = l; const float imp = (j > 0 ? ps[2 * j - 1] : 0.f) + ps[2 * j] + ps[2 * j + 1];
            const bool valid = 32 * j <= t; const int cur = t >> 5; const bool forced = valid && (j == 0 || j == cur || j == cur - 1);
            float score = forced ? 1e9f : (valid ? imp : -1e9f); bool sel = false;
            for (int r = 0; r < 8; ++r) { float best = score; int bi = l;
#pragma unroll
                for (int o = 32; o >= 1; o >>= 1) { const float ov = __shfl_xor(best, o); const int oi = __shfl_xor(bi, o); if (ov > best || (ov == best && oi < bi)) { best = ov; bi = oi; } }
                if (l == bi) { if (best > -0.5e9f) sel = true; score = -INFINITY; } }
            mask = __ballot(sel);
            if (l == 0) ((unsigned long long*)(ws + WS_SELM))[(size_t)row * 4 + g] = mask;
        }
        LDS_WAIT();
        float os[4] = {0.f, 0.f, 0.f, 0.f};
        {
            unsigned long long m = mask; const int half = l >> 5, ll = l & 31;
#pragma unroll 1
            for (int it = 0; it < 4; ++it) { int ja = -1, jb = -1; if (m) { ja = __builtin_ctzll(m); m &= m - 1; } if (m) { jb = __builtin_ctzll(m); m &= m - 1; }
                const int myj = half ? jb : ja; const int pos = 32 * myj + ll; const bool ok = (myj >= 0) && (pos <= t);
                float s[4]; dot4(KS + ((size_t)bg * SEQ + (ok ? pos : 0)) * 64, qf, s);
#pragma unroll
                for (int h = 0; h < 4; ++h) pb[h * 512 + (2 * it + half) * 32 + ll] = ok ? s[h] - slope[h] * (float)(t - pos) : -INFINITY; }
            LDS_WAIT();
#pragma unroll
            for (int h = 0; h < 4; ++h) { float x[4]; float mx = -INFINITY;
#pragma unroll
                for (int i = 0; i < 4; ++i) { x[i] = pb[h * 512 + l + 64 * i]; mx = fmaxf(mx, x[i]); }
                mx = wave_max(mx); if (mx == -INFINITY) mx = 0.f; float sm = 0.f;
#pragma unroll
                for (int i = 0; i < 4; ++i) { x[i] = (x[i] == -INFINITY) ? 0.f : expf(x[i] - mx); sm += x[i]; }
                const float den = fmaxf(wave_sum(sm), 1e-30f);
#pragma unroll
                for (int i = 0; i < 4; ++i) pb[h * 512 + l + 64 * i] = x[i] / den; }
            LDS_WAIT();
            m = mask; const bf16* vr = VST + ((size_t)bg * 64 + l) * SEQ;
            for (int it = 0; it < 8; ++it) { if (!m) break; const int j = __builtin_ctzll(m); m &= m - 1;
#pragma unroll
                for (int c0 = 0; c0 < 32; c0 += 8) { const v4u v8 = *(const v4u*)(vr + 32 * j + c0);
                    const float vv[8] = {bflo(v8.x), bfhi(v8.x), bflo(v8.y), bfhi(v8.y), bflo(v8.z), bfhi(v8.z), bflo(v8.w), bfhi(v8.w)};
#pragma unroll
                    for (int i = 0; i < 8; ++i)
#pragma unroll
                        for (int h = 0; h < 4; ++h) os[h] += pb[h * 512 + it * 32 + c0 + i] * vv[i]; } }
        }
        LDS_WAIT();
        float ow[4] = {0.f, 0.f, 0.f, 0.f};
        {
#pragma unroll 1
            for (int i = 0; i < 8; ++i) { const int slot = l + 64 * i, pos = t - 511 + slot; const bool ok = pos >= 0;
                float s[4]; dot4(KW + ((size_t)bg * SEQ + (ok ? pos : 0)) * 64, qf, s);
#pragma unroll
                for (int h = 0; h < 4; ++h) pb[h * 512 + slot] = ok ? s[h] - slope[h] * (float)(511 - slot) : -INFINITY; }
            LDS_WAIT();
#pragma unroll
            for (int h = 0; h < 4; ++h) { float x[8]; float mx = -INFINITY;
#pragma unroll
                for (int i = 0; i < 8; ++i) { x[i] = pb[h * 512 + l + 64 * i]; mx = fmaxf(mx, x[i]); }
                mx = wave_max(mx); float sm = 0.f;
#pragma unroll
                for (int i = 0; i < 8; ++i) { x[i] = (x[i] == -INFINITY) ? 0.f : expf(x[i] - mx); sm += x[i]; }
                const float den = fmaxf(wave_sum(sm), 1e-30f);
#pragma unroll
                for (int i = 0; i < 8; ++i) pb[h * 512 + l + 64 * i] = x[i] / den; }
            LDS_WAIT();
            const bf16* vr = VWT + ((size_t)bg * 64 + l) * SEQ; const int s0 = t >= 511 ? 0 : 511 - t;
            for (int slot = s0; slot < 512; ++slot) { const float vv = bf2f(vr[t - 511 + slot]);
#pragma unroll
                for (int h = 0; h < 4; ++h) ow[h] += pb[h * 512 + slot] * vv; }
        }
        LDS_WAIT();
#pragma unroll
        for (int h = 0; h < 4; ++h) { const float* gp = GT + (size_t)row * 48 + (g * 4 + h) * 3;
            O[(size_t)row * DM + g * 256 + h * 64 + l] = (bf16)f2bf(gp[0] * oc[h] + gp[1] * os[h] + gp[2] * ow[h]); }
    }
}

struct Args { const float* in[24]; float* out; unsigned char* ws; int ph_lo, ph_hi; };
constexpr int N_PHASES = 35;

__global__ void __launch_bounds__(NWAVES * 64, 2) yoco_fwd(Args args) {
    extern __shared__ __attribute__((aligned(16))) unsigned char lds_raw[];
    Ctx C;
    C.lds = (LAS unsigned char*)lds_raw;
    C.tid = threadIdx.x; C.lane = C.tid & 63; C.wave = __builtin_amdgcn_readfirstlane(C.tid >> 6);
    C.G = gridDim.x; C.bid = blockIdx.x;
    C.out = args.out; C.ws = args.ws;
    unsigned char* ws = args.ws;
    volatile LAS unsigned* MISC = (volatile LAS unsigned*)(C.lds + MISC_OFF);
    if (C.tid < 32) MISC[C.tid] = 0u;
    __syncthreads();
    XcdBarrier bar = xcd_barrier_post((unsigned*)(ws + WS_CTL) + 4096, MISC + 8);
    const int lo = args.ph_lo, hi = args.ph_hi;
    int pid = 0;
#define PH_BEGIN { const bool run_ = (pid >= lo && pid < hi); ++pid; if (run_) { asm volatile("" : "+v"(C.tid), "+v"(C.lane));
#define PH_END   if (pid < hi) xcd_barrier(bar); } }
    PG8_LAS unsigned char* ring = (PG8_LAS unsigned char*)lds_raw;
    const bf16* XN = (const bf16*)(ws + WS_XN);
    const int* RTAB = (const int*)(ws + WS_RTAB);

    PH_BEGIN p_prologue(C); PH_END

#pragma unroll 1
    for (int L = 0; L < 4; ++L) {
        const int li = L >> 1;
        if (L < 2) {
            PH_BEGIN { pg8::Gemm g{XN, (const bf16*)(ws + W_HIN) + (size_t)L * 4096 * 1024, 1024, 1024, 0}; pg8::GenOrder S; S.init(256, 16, C.G, C.bid, nullptr);
                pg8::EpiHgrnIn E{ws, L};
                pg8::gemm_phase<pg8::EpiHgrnIn, pg8::GenOrder, true, true>(ring, g, S, E); } PH_END
            PH_BEGIN p_scan_naive(C, L); PH_END
        } else {
            PH_BEGIN { const bool first = (L == 2); pg8::Gemm g{XN, (const bf16*)(ws + (first ? W_KVQ : W_Q3)), 1024, 1024, 0}; pg8::GenOrder S; S.init(256, first ? 11 : 5, C.G, C.bid, nullptr);
                pg8::EpiBf16 E{(bf16*)(ws + R_QKV), first ? 2816 : 1280, nullptr, 0, 0};
                pg8::gemm_phase<pg8::EpiBf16, pg8::GenOrder, true, true>(ring, g, S, E); } PH_END
            PH_BEGIN p_post(C, L == 2 ? 1 : 0, L == 2 ? 2816 : 1280, L - 2); PH_END
            if (L == 2) {
                PH_BEGIN { pg8::Gemm g{(const bf16*)(ws + R_KCR), (const bf16*)(ws + W_CMP1), 2048, 1024, (size_t)256 * 2048 * 2}; pg8::GenOrder S; S.init(128, 1, C.G, C.bid, RTAB + 2048);
                    pg8::EpiBf16 E{(bf16*)(ws + WS_HC), 256, (const float*)(ws + WS_CB), 1, 256};
                    pg8::gemm_phase<pg8::EpiBf16, pg8::GenOrder, true, true>(ring, g, S, E); } PH_END
                PH_BEGIN p_cmp2(C); PH_END
            }
            PH_BEGIN p_attn_naive(C); PH_END
        }
        PH_BEGIN { pg8::Gemm g{(const bf16*)(ws + (L < 2 ? R_O2 : R_O)), (const bf16*)(ws + (L < 2 ? W_HOUT : W_NOUT)) + (size_t)(L & 1) * 1024 * 1024, 1024, 1024, 0};
            pg8::GenOrder S; S.init(256, 4, C.G, C.bid, nullptr);
            pg8::EpiRes E{L == 0 ? C.inp(I_X) : C.out, C.out, 1024};
            pg8::gemm_phase<pg8::EpiRes, pg8::GenOrder, true, true>(ring, g, S, E); } PH_END
        PH_BEGIN { if (L & 1) p_norm<false, true, true>(C, C.inp(I_MR) + (size_t)li * 1024 * 8, C.inp(I_NFFN) + L * 1024); else p_norm<false, false, true>(C, nullptr, nullptr); } PH_END
        if (L & 1) { PH_BEGIN p_gather(C); PH_END }
        PH_BEGIN { const bool moe = (L & 1) != 0;
            pg8::Gemm g{moe ? (const bf16*)(ws + R_XP) : XN, moe ? (const bf16*)(ws + W_MGU) + (size_t)li * 8 * 2 * DFE * 1024 : (const bf16*)(ws + W_FGU) + (size_t)li * 2 * DFF * 1024, 1024, 1024, moe ? (size_t)2 * DFE * 1024 * 2 : 0};
            pg8::GenOrder S; S.init(moe ? RTAB[1024] : 256, moe ? 28 : 22, C.G, C.bid, moe ? RTAB : nullptr);
            pg8::EpiSwiGLU E{(bf16*)(ws + (moe ? R_HM : R_HF)), moe ? DFE : DFF};
            pg8::gemm_phase<pg8::EpiSwiGLU, pg8::GenOrder, true, true>(ring, g, S, E); } PH_END
        if (!(L & 1)) {
            PH_BEGIN { pg8::Gemm g{(const bf16*)(ws + R_HF), (const bf16*)(ws + W_FDN) + (size_t)li * 1024 * DFF, DFF, DFF, 0}; pg8::GenOrder S; S.init(256, 4, C.G, C.bid, nullptr);
                pg8::EpiRes E{C.out, C.out, 1024};
                pg8::gemm_phase<pg8::EpiRes, pg8::GenOrder, true, true>(ring, g, S, E); } PH_END
            PH_BEGIN p_norm<false, false, true>(C, nullptr, nullptr); PH_END
        } else {
            PH_BEGIN { pg8::Gemm g{(const bf16*)(ws + R_HM), (const bf16*)(ws + W_MDN) + (size_t)li * 8 * 1024 * DFE, DFE, DFE, (size_t)1024 * DFE * 2}; pg8::GenOrder S; S.init(RTAB[1024], 4, C.G, C.bid, RTAB);
                pg8::EpiBf16 E{(bf16*)(ws + R_XP), 1024, nullptr, 0, 0};
                pg8::gemm_phase<pg8::EpiBf16, pg8::GenOrder, true, true>(ring, g, S, E); } PH_END
            PH_BEGIN { if (L == 1) p_norm<true, false, true>(C, nullptr, nullptr); else p_norm<true, false, false>(C, nullptr, nullptr); } PH_END
        }
    }
#undef PH_BEGIN
#undef PH_END
}

extern "C" void kernel_launch(void* const* d_in, const int* in_sizes, int n_in, void* d_out, int out_size, void* d_ws, size_t ws_size, hipStream_t stream) {
    static int grid = 0;
    if (grid == 0) {
        if (n_in != 24 || in_sizes[0] != NT * DM || out_size != NT * DM || ws_size < WS_NEED) { fprintf(stderr, "kernel_launch: unexpected shapes / workspace (n_in %d, ws %zu, need %zu)\n", n_in, ws_size, (size_t)WS_NEED); grid = -1; return; }
        int dev = 0, cus = 0;
        if (hipGetDevice(&dev) != hipSuccess || hipDeviceGetAttribute(&cus, hipDeviceAttributeMultiprocessorCount, dev) != hipSuccess) { grid = -1; return; }
        if (hipFuncSetAttribute((const void*)yoco_fwd, hipFuncAttributeMaxDynamicSharedMemorySize, LDS_BYTES) != hipSuccess) { fprintf(stderr, "kernel_launch: hipFuncSetAttribute failed\n"); grid = -1; return; }
        int per_cu = 0;
        if (hipOccupancyMaxActiveBlocksPerMultiprocessor(&per_cu, (const void*)yoco_fwd, NWAVES * 64, LDS_BYTES) != hipSuccess || per_cu < 1) { fprintf(stderr, "kernel_launch: occupancy query says %d\n", per_cu); }
        (void)hipGetLastError();
        grid = cus;
    }
    if (grid < 0) return;
    (void)hipMemsetAsync((char*)d_ws + WS_CTL, 0, CTL_ZERO_BYTES, stream);
    Args a{};
    for (int i = 0; i < 24; ++i) a.in[i] = (const float*)d_in[i];
    a.out = (float*)d_out; a.ws = (unsigned char*)d_ws;
#if MK_SINGLE
    a.ph_lo = 0; a.ph_hi = N_PHASES;
    hipLaunchKernelGGL(yoco_fwd, dim3(grid), dim3(NWAVES * 64), LDS_BYTES, stream, a);
#else
    for (int k = 0; k < N_PHASES; ++k) { a.ph_lo = k; a.ph_hi = k + 1; hipLaunchKernelGGL(yoco_fwd, dim3(grid), dim3(NWAVES * 64), LDS_BYTES, stream, a); }
#endif
}
```

```cpp
#include <hip/hip_runtime.h>
#include <cstdio>
#include <cstdint>

#ifndef MK_SINGLE
#define MK_SINGLE 1
#endif

namespace pg8 {
#define PG8_LAS __attribute__((address_space(3)))
typedef unsigned short bf16_t;
typedef short bf16x8 __attribute__((ext_vector_type(8)));
typedef float f32x4 __attribute__((ext_vector_type(4)));
typedef unsigned u32x4 __attribute__((ext_vector_type(4)));
constexpr int BM = 256, BK = 64, HALF = 128, HTB = HALF * BK * 2  , STAGE_BYTES = 8 * HTB, NXCD = 8, WGM = 8;

__host__ __device__ __forceinline__ int lds_byte(int r, int c) { const int st = (r >> 4) * 2 + (c >> 5), rr = r & 15, cc = c & 31, ob = rr * 64 + cc * 2; return st * 1024 + (ob ^ (((ob >> 9) & 1) << 5)); }
__host__ __device__ __forceinline__ void stage_rc(int b, int& R, int& C) { const int st = b / 1024, sb = b % 1024, swz = sb ^ (((sb >> 9) & 1) << 5); R = (st >> 1) * 16 + swz / 64; C = (st & 1) * 32 + (swz % 64) / 2; }
__host__ __device__ __forceinline__ int perm32(int rho) { const int n = rho >> 4, i = rho & 15; return 8 * (i >> 2) + 4 * n + (i & 3); }

struct Unit { int pm, pn, e; };
struct Gemm { const bf16_t* A; const bf16_t* Bt; int K; int lda; size_t estride; };

struct GenOrder {
    int nM, nN, nwg, G, c; const int* tile_e;
    __device__ void init(int nM_, int nN_, int G_, int c_, const int* te) { nM = nM_; nN = nN_; nwg = nM * nN; G = G_; c = c_; tile_e = te; }
    __device__ bool next(int i, Unit& u) const {
        const long L = (long)i * G + c; if (L >= nwg) return false;
        int wgid = (int)L; { const int q = nwg / NXCD, r = nwg % NXCD, xcd = wgid % NXCD, off = wgid / NXCD; wgid = (xcd < r ? xcd * (q + 1) : r * (q + 1) + (xcd - r) * q) + off; }
        const int nig = WGM * nN, gid = wgid / nig, fm = gid * WGM, gsz = (nM - fm) < WGM ? (nM - fm) : WGM;
        u.pm = fm + ((wgid % nig) % gsz); u.pn = (wgid % nig) / gsz; u.e = tile_e ? tile_e[u.pm] : 0; return true;
    }
    __device__ __forceinline__ void a_ready(const Unit&) const {}
    __device__ __forceinline__ void done(const Unit&) const {}
};

__device__ __forceinline__ unsigned cvt_pk_bf16(float lo, float hi) { unsigned r; asm volatile("v_cvt_pk_bf16_f32 %0, %1, %2" : "=v"(r) : "v"(lo), "v"(hi)); return r; }
__device__ __forceinline__ float silu_f(float v) { return v * __builtin_amdgcn_rcpf(1.0f + __expf(-v)); }

struct EpiBf16 {
    static constexpr bool PERM = true, AFTER_DRAIN = false;
    bf16_t* O; int ldc; const float* bias; int act; int bias_es;
    __device__ __forceinline__ void operator()(const f32x4 (&acc)[2][2][4][2], const Unit& u, int wr, int wc, int fr, int fq) const {
        const int row0 = u.pm * BM + wr * 64 + fr, col0 = u.pn * BM + wc * 32 + 8 * fq;
        f32x4 bv[2][2];
#pragma unroll
        for (int bj = 0; bj < 2; ++bj)
#pragma unroll
            for (int n = 0; n < 2; ++n) bv[bj][n] = bias ? *(const f32x4*)(bias + u.e * bias_es + col0 + bj * HALF + 4 * n) : (f32x4){0.f, 0.f, 0.f, 0.f};
#pragma unroll
        for (int ai = 0; ai < 2; ++ai)
#pragma unroll
            for (int m = 0; m < 4; ++m) { bf16_t* rowp = O + (size_t)(row0 + ai * HALF + m * 16) * ldc + col0;
#pragma unroll
                for (int bj = 0; bj < 2; ++bj) { f32x4 v0 = acc[ai][bj][m][0] + bv[bj][0], v1 = acc[ai][bj][m][1] + bv[bj][1];
                    if (act == 1) {
#pragma unroll
                        for (int i = 0; i < 4; ++i) { v0[i] = silu_f(v0[i]); v1[i] = silu_f(v1[i]); } }
                    u32x4 w; w.x = cvt_pk_bf16(v0[0], v0[1]); w.y = cvt_pk_bf16(v0[2], v0[3]); w.z = cvt_pk_bf16(v1[0], v1[1]); w.w = cvt_pk_bf16(v1[2], v1[3]);
                    *(u32x4*)(rowp + bj * HALF) = w; } }
    }
};
struct EpiRes {
    static constexpr bool PERM = false, AFTER_DRAIN = false;
    const float* base; float* out; int ldc;
    __device__ __forceinline__ void operator()(const f32x4 (&acc)[2][2][4][2], const Unit& u, int wr, int wc, int fr, int fq) const {
        const int row0 = u.pm * BM + wr * 64 + fr, col0 = u.pn * BM + wc * 32 + 4 * fq;
#pragma unroll
        for (int ai = 0; ai < 2; ++ai)
#pragma unroll
            for (int m = 0; m < 4; ++m) { const size_t off = (size_t)(row0 + ai * HALF + m * 16) * ldc + col0;
#pragma unroll
                for (int bj = 0; bj < 2; ++bj)
#pragma unroll
                    for (int n = 0; n < 2; ++n) { const f32x4 b = *(const f32x4*)(base + off + bj * HALF + n * 16); *(f32x4*)(out + off + bj * HALF + n * 16) = b + acc[ai][bj][m][n]; } }
    }
};
struct EpiSwiGLU {
    static constexpr bool PERM = true, AFTER_DRAIN = false;
    bf16_t* O; int ldc;
    __device__ __forceinline__ void operator()(const f32x4 (&acc)[2][2][4][2], const Unit& u, int wr, int wc, int fr, int fq) const {
        const int row0 = u.pm * BM + wr * 64 + fr, col0 = u.pn * HALF + wc * 32 + 8 * fq;
#pragma unroll
        for (int ai = 0; ai < 2; ++ai)
#pragma unroll
            for (int m = 0; m < 4; ++m) { bf16_t* rowp = O + (size_t)(row0 + ai * HALF + m * 16) * ldc + col0;
                f32x4 v0, v1;
#pragma unroll
                for (int i = 0; i < 4; ++i) { v0[i] = silu_f(acc[ai][0][m][0][i]) * acc[ai][1][m][0][i]; v1[i] = silu_f(acc[ai][0][m][1][i]) * acc[ai][1][m][1][i]; }
                u32x4 w; w.x = cvt_pk_bf16(v0[0], v0[1]); w.y = cvt_pk_bf16(v0[2], v0[3]); w.z = cvt_pk_bf16(v1[0], v1[1]); w.w = cvt_pk_bf16(v1[2], v1[3]);
                *(u32x4*)rowp = w; }
    }
};
__device__ __forceinline__ float logf_gate(float x, float la, float l1) {
    const float ls = fminf(x, 0.f) - __logf(1.0f + __expf(-fabsf(x)));
    const float b = l1 + ls;
    if (la == -INFINITY) return b;
    const float mx = fmaxf(la, b), d = fabsf(la - b);
    return mx + __logf(1.0f + __expf(-d));
}
struct EpiHgrnIn {
    static constexpr bool PERM = true, AFTER_DRAIN = false;
    unsigned char* ws; int layer;
    static constexpr size_t O_PQ = 580ull << 20, O_PI = O_PQ + (128ull << 20), O_PG = O_PQ + (256ull << 20), O_LF = O_PQ + (384ull << 20), O_LA = 1ull << 20, O_L1 = O_LA + 8192;
    __device__ __forceinline__ void operator()(const f32x4 (&acc)[2][2][4][2], const Unit& u, int wr, int wc, int fr, int fq) const {
        const int quarter = u.pn >> 2;
        const int row0 = u.pm * BM + wr * 64 + fr, col0 = (u.pn & 3) * BM + wc * 32 + 8 * fq;
        if (quarter == 1) {
            const float* la = (const float*)(ws + O_LA) + layer * 1024; const float* l1 = (const float*)(ws + O_L1) + layer * 1024; float* LF = (float*)(ws + O_LF);
            f32x4 A0[2][2], A1[2][2];
#pragma unroll
            for (int bj = 0; bj < 2; ++bj)
#pragma unroll
                for (int n = 0; n < 2; ++n) { A0[bj][n] = *(const f32x4*)(la + col0 + bj * HALF + 4 * n); A1[bj][n] = *(const f32x4*)(l1 + col0 + bj * HALF + 4 * n); }
#pragma unroll
            for (int ai = 0; ai < 2; ++ai)
#pragma unroll
                for (int m = 0; m < 4; ++m) { float* rowp = LF + (size_t)(row0 + ai * HALF + m * 16) * 1024 + col0;
#pragma unroll
                    for (int bj = 0; bj < 2; ++bj)
#pragma unroll
                        for (int n = 0; n < 2; ++n) { f32x4 o;
#pragma unroll
                            for (int i = 0; i < 4; ++i) o[i] = logf_gate(acc[ai][bj][m][n][i], A0[bj][n][i], A1[bj][n][i]);
                            *(f32x4*)(rowp + bj * HALF + 4 * n) = o; } }
        } else {
            bf16_t* O = (bf16_t*)(ws + (quarter == 0 ? O_PQ : (quarter == 2 ? O_PI : O_PG)));
#pragma unroll
            for (int ai = 0; ai < 2; ++ai)
#pragma unroll
                for (int m = 0; m < 4; ++m) { bf16_t* rowp = O + (size_t)(row0 + ai * HALF + m * 16) * 1024 + col0;
#pragma unroll
                    for (int bj = 0; bj < 2; ++bj) { f32x4 v0 = acc[ai][bj][m][0], v1 = acc[ai][bj][m][1];
                        if (quarter != 2) {
#pragma unroll
                            for (int i = 0; i < 4; ++i) { v0[i] = silu_f(v0[i]); v1[i] = silu_f(v1[i]); } }
                        u32x4 w; w.x = cvt_pk_bf16(v0[0], v0[1]); w.y = cvt_pk_bf16(v0[2], v0[3]); w.z = cvt_pk_bf16(v1[0], v1[1]); w.w = cvt_pk_bf16(v1[2], v1[3]);
                        *(u32x4*)(rowp + bj * HALF) = w; } }
        }
    }
};

template <class Epi, class Sched, bool ALIGN_EPI = false, bool SP2 = false>
__device__ __forceinline__ void gemm_phase(PG8_LAS unsigned char* lds, const Gemm g, const Sched& S, const Epi& E, const int wave_id) {
    int lane_; asm volatile("v_mbcnt_lo_u32_b32 %0, -1, 0\n\tv_mbcnt_hi_u32_b32 %0, -1, %0" : "=v"(lane_));
    const int wid = wave_id, lane = lane_, tid = wid * 64 + lane, wr = wid >> 2, wc = wid & 3, fr = lane & 15, fq = lane >> 4;
    const int K = g.K, nt = K / BK, lda = g.lda;
    unsigned voffA[2], voffB[2];
#pragma unroll
    for (int i = 0; i < 2; ++i) { int R, C; stage_rc(tid * 16 + i * 8192, R, C); const int Rb = Epi::PERM ? ((R & ~31) + perm32(R & 31)) : R;
        voffA[i] = (unsigned)(R * lda + C) * 2u; voffB[i] = (unsigned)(Rb * K + C) * 2u; }
    const size_t kstep = (size_t)(BK * 2);
    const size_t hstep = (size_t)HALF * K * 2;
    const size_t tstep = 2 * hstep;
    const size_t hstepA = (size_t)HALF * lda * 2, tstepA = 2 * hstepA;
    const unsigned ldsw = (unsigned)wid * 1024u;
    const int aoff = lds_byte(wr * 64 + fr, fq * 8), boff = lds_byte(wc * 32 + fr, fq * 8);
#define PG8_SA(b, h) (((b) * 2 + (h)) * HTB)
#define PG8_SB(b, h) ((4 + (b) * 2 + (h)) * HTB)
#define PG8_STAGE(bufoff, gbase, voff) do { _Pragma("unroll") for (int _i = 0; _i < 2; ++_i) \
        __builtin_amdgcn_global_load_lds((const unsigned*)((const char*)(gbase) + (voff)[_i]), (PG8_LAS unsigned*)(lds + (bufoff) + ldsw + _i * 8192), 16, 0, 0); } while (0)
#define PG8_LDA(dst, b, h) do { _Pragma("unroll") for (int m = 0; m < 4; ++m) _Pragma("unroll") for (int k = 0; k < 2; ++k) dst[m][k] = *(const PG8_LAS bf16x8*)(lds + PG8_SA(b, h) + aoff + m * 2048 + k * 1024); } while (0)
#define PG8_LDB(dst, b, h) do { _Pragma("unroll") for (int n = 0; n < 2; ++n) _Pragma("unroll") for (int k = 0; k < 2; ++k) dst[n][k] = *(const PG8_LAS bf16x8*)(lds + PG8_SB(b, h) + boff + n * 2048 + k * 1024); } while (0)
#define PG8_MMA(ai, bj, At, Bt) do { __builtin_amdgcn_s_setprio(1); _Pragma("unroll") for (int m = 0; m < 4; ++m) _Pragma("unroll") for (int n = 0; n < 2; ++n) _Pragma("unroll") for (int k = 0; k < 2; ++k) \
        acc[ai][bj][m][n] = __builtin_amdgcn_mfma_f32_16x16x32_bf16(Bt[n][k], At[m][k], acc[ai][bj][m][n], 0, 0, 0); __builtin_amdgcn_s_setprio(0); } while (0)
#define PG8_WAIT_V(n) asm volatile("s_waitcnt vmcnt(" #n ")" ::: "memory")
#define PG8_WAIT_L(n) asm volatile("s_waitcnt lgkmcnt(" #n ")" ::: "memory")
#define PG8_BAR __builtin_amdgcn_s_barrier()
#define PG8_SCHED __builtin_amdgcn_sched_barrier(0)
    Unit cur, nxt; int ui = 0;
    if (!S.next(0, cur)) return;
    f32x4 acc[2][2][4][2];
#pragma unroll
    for (int a = 0; a < 2; ++a)
#pragma unroll
        for (int b = 0; b < 2; ++b)
#pragma unroll
            for (int m = 0; m < 4; ++m)
#pragma unroll
                for (int n = 0; n < 2; ++n) acc[a][b][m][n] = (f32x4){0.f, 0.f, 0.f, 0.f};
    bf16x8 At[4][2], B0[2][2], B1[2][2];
    const char* cA = (const char*)g.A + (size_t)cur.pm * tstepA; const char* cB = (const char*)g.Bt + (size_t)cur.e * g.estride + (size_t)cur.pn * tstep;
    S.a_ready(cur);
    if constexpr (SP2) {
        PG8_STAGE(PG8_SB(0, 0), cB, voffB); PG8_STAGE(PG8_SB(0, 1), cB + hstep, voffB); PG8_STAGE(PG8_SA(0, 0), cA, voffA); PG8_STAGE(PG8_SA(0, 1), cA + hstepA, voffA);
        if (wr == 1) PG8_BAR;
        PG8_WAIT_V(2); PG8_BAR;
        PG8_STAGE(PG8_SB(1, 0), cB + kstep, voffB); PG8_STAGE(PG8_SA(1, 0), cA + kstep, voffA); PG8_STAGE(PG8_SB(1, 1), cB + hstep + kstep, voffB);
        PG8_WAIT_V(6); PG8_BAR;
    } else {
        PG8_STAGE(PG8_SB(0, 0), cB, voffB); PG8_STAGE(PG8_SA(0, 0), cA, voffA); PG8_STAGE(PG8_SB(0, 1), cB + hstep, voffB); PG8_STAGE(PG8_SA(0, 1), cA + hstepA, voffA);
        if (wr == 1) PG8_BAR;
        PG8_WAIT_V(4); PG8_BAR;
        PG8_STAGE(PG8_SB(1, 0), cB + kstep, voffB); PG8_STAGE(PG8_SA(1, 0), cA + kstep, voffA); PG8_STAGE(PG8_SB(1, 1), cB + hstep + kstep, voffB);
        PG8_WAIT_V(6); PG8_BAR;
    }
    for (;;) {
        const bool has_next = S.next(ui + 1, nxt);
        const char* nA = has_next ? (const char*)g.A + (size_t)nxt.pm * tstepA : cA; const char* nB = has_next ? (const char*)g.Bt + (size_t)nxt.e * g.estride + (size_t)nxt.pn * tstep : cB;
        for (int t = 0; t < nt; t += 2) {
            const bool last = (t == nt - 2);
            const char* a1 = cA + (size_t)(t + 1) * kstep;
            const char* a2 = last ? nA : cA + (size_t)(t + 2) * kstep; const char* b2 = last ? nB : cB + (size_t)(t + 2) * kstep;
            const char* a3 = a2 + kstep; const char* b3 = b2 + kstep;
            if (last && has_next) S.a_ready(nxt);
            if constexpr (SP2) {
            PG8_LDB(B0, 0, 0); PG8_LDB(B1, 0, 1); PG8_SCHED; PG8_LDA(At, 0, 0); PG8_STAGE(PG8_SA(1, 1), a1 + hstepA, voffA);
            PG8_WAIT_V(8); PG8_WAIT_L(0); PG8_BAR; PG8_MMA(0, 0, At, B0); PG8_MMA(0, 1, At, B1); PG8_BAR; PG8_SCHED;
            PG8_LDA(At, 0, 1); PG8_STAGE(PG8_SB(0, 0), b2, voffB); PG8_STAGE(PG8_SB(0, 1), b2 + hstep, voffB); PG8_STAGE(PG8_SA(0, 0), a2, voffA);
            PG8_WAIT_V(8); PG8_WAIT_L(0); PG8_BAR; PG8_MMA(1, 0, At, B0); PG8_MMA(1, 1, At, B1); PG8_BAR; PG8_SCHED;
            PG8_LDB(B0, 1, 0); PG8_LDB(B1, 1, 1); PG8_SCHED; PG8_LDA(At, 1, 0); PG8_STAGE(PG8_SA(0, 1), a2 + hstepA, voffA);
            PG8_WAIT_V(8); PG8_WAIT_L(0); PG8_BAR; PG8_MMA(0, 0, At, B0); PG8_MMA(0, 1, At, B1); PG8_BAR; PG8_SCHED;
            PG8_LDA(At, 1, 1); PG8_STAGE(PG8_SB(1, 0), b3, voffB); PG8_STAGE(PG8_SB(1, 1), b3 + hstep, voffB); PG8_STAGE(PG8_SA(1, 0), a3, voffA);
            PG8_WAIT_V(8); PG8_WAIT_L(0); PG8_BAR; PG8_MMA(1, 0, At, B0); PG8_MMA(1, 1, At, B1); PG8_BAR; PG8_SCHED;
            } else {
            PG8_LDB(B0, 0, 0); PG8_SCHED; PG8_LDA(At, 0, 0); PG8_STAGE(PG8_SA(1, 1), a1 + hstepA, voffA);
            PG8_WAIT_L(8); PG8_BAR; PG8_WAIT_L(0); PG8_MMA(0, 0, At, B0); PG8_BAR; PG8_SCHED;
            PG8_LDB(B1, 0, 1); PG8_STAGE(PG8_SB(0, 0), b2, voffB);
            PG8_BAR; PG8_WAIT_L(0); PG8_MMA(0, 1, At, B1); PG8_BAR;
            PG8_LDA(At, 0, 1); PG8_STAGE(PG8_SA(0, 0), a2, voffA);
            PG8_BAR; PG8_WAIT_L(0); PG8_MMA(1, 0, At, B0); PG8_BAR; PG8_SCHED;
            PG8_STAGE(PG8_SB(0, 1), b2 + hstep, voffB);
            PG8_WAIT_V(6); PG8_BAR; PG8_MMA(1, 1, At, B1); PG8_BAR;
            PG8_LDB(B0, 1, 0); PG8_SCHED; PG8_LDA(At, 1, 0); PG8_STAGE(PG8_SA(0, 1), a2 + hstepA, voffA);
            PG8_WAIT_L(8); PG8_BAR; PG8_WAIT_L(0); PG8_MMA(0, 0, At, B0); PG8_BAR; PG8_SCHED;
            PG8_LDB(B1, 1, 1); PG8_STAGE(PG8_SB(1, 0), b3, voffB);
            PG8_BAR; PG8_WAIT_L(0); PG8_MMA(0, 1, At, B1); PG8_BAR;
            PG8_LDA(At, 1, 1); PG8_STAGE(PG8_SA(1, 0), a3, voffA);
            PG8_BAR; PG8_WAIT_L(0); PG8_MMA(1, 0, At, B0); PG8_BAR; PG8_SCHED;
            PG8_STAGE(PG8_SB(1, 1), b3 + hstep, voffB);
            PG8_WAIT_V(6); PG8_BAR; PG8_MMA(1, 1, At, B1); PG8_BAR;
            }
        }
        if constexpr (ALIGN_EPI) { if (wr == 0) PG8_BAR; }
        if constexpr (!Epi::AFTER_DRAIN) { E(acc, cur, wr, wc, fr, fq); S.done(cur); }
        if (!has_next) break;
#pragma unroll
        for (int a = 0; a < 2; ++a)
#pragma unroll
            for (int b = 0; b < 2; ++b)
#pragma unroll
                for (int m = 0; m < 4; ++m)
#pragma unroll
                    for (int n = 0; n < 2; ++n) acc[a][b][m][n] = (f32x4){0.f, 0.f, 0.f, 0.f};
        cur = nxt; cA = nA; cB = nB; ++ui;
        if constexpr (ALIGN_EPI) { if (wr == 1) PG8_BAR; }
    }
    PG8_WAIT_V(0);
    if constexpr (!ALIGN_EPI) { if (wr == 0) PG8_BAR; }
    PG8_BAR;
    if constexpr (Epi::AFTER_DRAIN) { E.fused(acc, cur, wr, wc, fr, fq, lds, wid, lane); S.done(cur); }
#undef PG8_SA
#undef PG8_SB
#undef PG8_STAGE
#undef PG8_LDA
#undef PG8_LDB
#undef PG8_MMA
#undef PG8_WAIT_V
#undef PG8_WAIT_L
#undef PG8_BAR
#undef PG8_SCHED
}
}

constexpr int NT = 65536, DM = 1024, NBATCH = 32, SEQ = 2048;
constexpr int DFF = 2816, DFE = 3584, NEXP = 8;
constexpr int MOE_ROWS = 133120;
constexpr float EPS = 1e-6f;
constexpr size_t MiB = 1u << 20;
constexpr size_t WS_CTL = 0, CTL_ZERO_BYTES = 1 * MiB;
constexpr size_t WS_LA = 1 * MiB;
constexpr size_t WS_L1 = WS_LA + 8192;
constexpr size_t WS_CB = WS_LA + 16384;
constexpr size_t WS_RCNT = WS_LA + 32768;
constexpr size_t WS_RTAB = WS_LA + 65536;
constexpr size_t WS_ROUTE = 2 * MiB;
constexpr size_t WS_SLOT = 3 * MiB;
constexpr size_t WS_SELM = 4 * MiB;
constexpr size_t WS_GATES = 8 * MiB;
constexpr size_t WS_KC = 20 * MiB;
constexpr size_t WS_VCT = 22 * MiB;
constexpr size_t WS_HC = 24 * MiB;
constexpr size_t WS_W = 48 * MiB;
constexpr size_t W_HIN = WS_W, W_HOUT = WS_W + 16 * MiB, W_KVQ = WS_W + 20 * MiB, W_Q3 = WS_W + 26 * MiB, W_CMP1 = WS_W + 29 * MiB, W_NOUT = WS_W + 31 * MiB,
                 W_FGU = WS_W + 35 * MiB, W_FDN = WS_W + 57 * MiB, W_MGU = WS_W + 68 * MiB, W_MDN = WS_W + 292 * MiB;
constexpr size_t WS_XN = 452 * MiB;
constexpr size_t WS_R = 580 * MiB;
constexpr size_t R_PQ = WS_R, R_PI = WS_R + 128 * MiB, R_PG = WS_R + 256 * MiB, R_LF = WS_R + 384 * MiB, R_O2 = WS_R + 640 * MiB;
constexpr size_t R_HF = WS_R + 256 * MiB;
constexpr size_t R_KS = WS_R, R_KW = WS_R + 32 * MiB, R_VST = WS_R + 64 * MiB, R_VWT = WS_R + 96 * MiB, R_KCR = WS_R + 128 * MiB, R_VCR = WS_R + 160 * MiB;
constexpr size_t R_QKV = WS_R + 256 * MiB;
constexpr size_t R_Q = WS_R + 608 * MiB, R_O = WS_R + 736 * MiB;
constexpr size_t R_XP = WS_R, R_HM = WS_R + 260 * MiB;
constexpr size_t WS_NEED = R_HM + (size_t)MOE_ROWS * DFE * 2;
static_assert(WS_NEED <= 1792 * MiB, "workspace map");
static_assert(W_MDN + 112 * MiB <= WS_XN, "weights map");
static_assert(pg8::EpiHgrnIn::O_PQ == R_PQ && pg8::EpiHgrnIn::O_PI == R_PI && pg8::EpiHgrnIn::O_PG == R_PG && pg8::EpiHgrnIn::O_LF == R_LF && pg8::EpiHgrnIn::O_LA == WS_LA && pg8::EpiHgrnIn::O_L1 == WS_L1, "EpiHgrnIn offsets");

constexpr int LDS_BYTES = 147456;
constexpr int MISC_OFF = 131072 + 320;
constexpr int NWAVES = 8;

#define GAS __attribute__((address_space(1)))
#define LAS __attribute__((address_space(3)))
typedef unsigned short bf16;
typedef unsigned v4u __attribute__((ext_vector_type(4)));
typedef unsigned v2u __attribute__((ext_vector_type(2)));
typedef float f32x4 __attribute__((ext_vector_type(4)));
#define LDS_WAIT() asm volatile("s_waitcnt lgkmcnt(0)" ::: "memory")
__device__ __forceinline__ unsigned f2bf(float f) { unsigned u = __builtin_bit_cast(unsigned, f); return (u + 0x7fffu + ((u >> 16) & 1u)) >> 16; }
__device__ __forceinline__ unsigned pk2(float lo, float hi) { return f2bf(lo) | (f2bf(hi) << 16); }
__device__ __forceinline__ float bf2f(unsigned b) { return __builtin_bit_cast(float, b << 16); }
__device__ __forceinline__ float bflo(unsigned w) { return __builtin_bit_cast(float, w << 16); }
__device__ __forceinline__ float bfhi(unsigned w) { return __builtin_bit_cast(float, w & 0xffff0000u); }
__device__ __forceinline__ float wave_sum(float v) {
#pragma unroll
    for (int o = 32; o >= 1; o >>= 1) v += __shfl_xor(v, o);
    return v;
}
__device__ __forceinline__ float wave_max(float v) {
#pragma unroll
    for (int o = 32; o >= 1; o >>= 1) v = fmaxf(v, __shfl_xor(v, o));
    return v;
}

#define XB_TMO      128
#define XB_XCNT(j)  (256  + 64 * (j))
#define XB_XSUB(j)  (1280 + 64 * (j))
#define XB_XGEN(j)  (2304 + 64 * (j))
#define XB_TOP      3328
#define XB_TOPGEN   3392
#define XCD_BAR_WORDS 3456
#define XB_SPIN_CAP (1u << 22)
__device__ __forceinline__ unsigned xb_ld(unsigned* p)              { return __hip_atomic_load(p, __ATOMIC_RELAXED, __HIP_MEMORY_SCOPE_AGENT); }
__device__ __forceinline__ unsigned xb_add(unsigned* p, unsigned v) { return __hip_atomic_fetch_add(p, v, __ATOMIC_RELAXED, __HIP_MEMORY_SCOPE_AGENT); }
__device__ __forceinline__ unsigned xb_xcc_id() { return (unsigned)__builtin_amdgcn_s_getreg((3 << 11) | 20) & 0xFu; }
#define XB_SPIN(cond, bar) do { unsigned _sp = 0; while (cond) { __builtin_amdgcn_s_sleep(1); \
    if ((++_sp & 255u) == 0u) { if (xb_ld(&(bar)[XB_TMO])) break; if (_sp > XB_SPIN_CAP) { atomicAdd(&(bar)[XB_TMO], 1u); break; } } } } while (0)
struct XcdBarrier { unsigned* bar; unsigned x; volatile LAS unsigned* st; };
__device__ __forceinline__ XcdBarrier xcd_barrier_post(unsigned* bar, volatile LAS unsigned* st) {
    XcdBarrier b; b.bar = bar; b.x = xb_xcc_id(); b.st = st;
    if (threadIdx.x == 0) (void)xb_add(&bar[XB_XCNT(b.x)], 1u);
    return b;
}
__device__ __forceinline__ void xcd_barrier_complete(unsigned* bar, unsigned x, unsigned& nloc, unsigned& nx) {
    const unsigned G = gridDim.x * gridDim.y * gridDim.z;
    unsigned sum, cnt, mine, sp = 0u;
    for (;;) {
        sum = 0u; cnt = 0u; mine = 0u;
#pragma unroll
        for (unsigned j = 0; j < 16; ++j) { const unsigned c = xb_ld(&bar[XB_XCNT(j)]); sum += c; cnt += (c > 0u) ? 1u : 0u; mine = (j == x) ? c : mine; }
        if (sum == G) break;
        __builtin_amdgcn_s_sleep(1);
        if ((++sp & 255u) == 0u) { if (xb_ld(&bar[XB_TMO])) break; if (sp > XB_SPIN_CAP) { atomicAdd(&bar[XB_TMO], 1u); break; } }
    }
    nloc = mine > 0u ? mine : 1u; nx = cnt > 0u ? cnt : 1u;
}
__device__ __forceinline__ void xcd_barrier(const XcdBarrier& b) {
    asm volatile("s_waitcnt vmcnt(0)" ::: "memory");
    __syncthreads();
    if (threadIdx.x == 0) {
        unsigned* bar = b.bar; unsigned bx_ = b.x; asm volatile("" : "+s"(bar), "+s"(bx_));
        __builtin_amdgcn_s_waitcnt(0);
        unsigned nloc = b.st[0], nx = b.st[1];
        if (nloc == 0u) { xcd_barrier_complete(bar, bx_, nloc, nx); b.st[0] = nloc; b.st[1] = nx; }
        const unsigned old = xb_add(&bar[XB_XSUB(bx_)], 1u);
        const unsigned gen = old / nloc;
        if (old + 1u == (gen + 1u) * nloc) {
            __builtin_amdgcn_fence(__ATOMIC_RELEASE, "agent");
            asm volatile("s_waitcnt vmcnt(0)" ::: "memory");
            const unsigned og = xb_add(&bar[XB_TOP], 1u);
            const unsigned tg = og / nx;
            if (og + 1u == (tg + 1u) * nx) xb_add(&bar[XB_TOPGEN], 1u);
            else XB_SPIN(xb_ld(&bar[XB_TOPGEN]) == tg, bar);
            __builtin_amdgcn_fence(__ATOMIC_ACQUIRE, "agent");
            xb_add(&bar[XB_XGEN(bx_)], 1u);
            asm volatile("s_waitcnt vmcnt(0)" ::: "memory");
        } else {
            XB_SPIN(xb_ld(&bar[XB_XGEN(bx_)]) == gen, bar);
            __builtin_amdgcn_fence(__ATOMIC_ACQUIRE, "agent");
            asm volatile("s_waitcnt vmcnt(0)" ::: "memory");
        }
    }
    __syncthreads();
}

struct Ctx {
    LAS unsigned char* lds;
    int tid, lane, wave, G, bid;
    float* out; unsigned char* ws;
    __device__ __forceinline__ const float* inp(int i) const {
        const __attribute__((address_space(4))) unsigned char* kp = (const __attribute__((address_space(4))) unsigned char*)__builtin_amdgcn_kernarg_segment_ptr();
        asm volatile("" : "+s"(kp));
        return ((const float* const __attribute__((address_space(4)))*)kp)[i];
    }
};
enum { I_X = 0, I_NMIX, I_NFFN, I_HWIN, I_HWOUT, I_HGN, I_HLB, I_KVN, I_KVW, I_CPK, I_CW1K, I_CW2K, I_CPV, I_CW1V, I_CW2V, I_KN, I_NWIN, I_NWOUT, I_NQN, I_FGU, I_FDN, I_MR, I_MGU, I_MDN };

constexpr int MAXJOB = 64;
struct JobTab { unsigned long long src[MAXJOB], gain[MAXJOB], dst[MAXJOB]; int K[MAXJOB], Nsrc[MAXJOB], npb[MAXJOB], F[MAXJOB], rowoff[MAXJOB], istart[MAXJOB + 1]; int njobs; };
__device__ __forceinline__ void add_job(LAS JobTab* J, const float* src, const float* gain, bf16* dst, int K, int Nsrc, int Npad, int F, int rowoff) {
    const int j = J->njobs; J->src[j] = (unsigned long long)src; J->gain[j] = (unsigned long long)gain; J->dst[j] = (unsigned long long)dst;
    J->K[j] = K; J->Nsrc[j] = Nsrc; J->npb[j] = Npad / 32; J->F[j] = F; J->rowoff[j] = rowoff; J->istart[j + 1] = J->istart[j] + (K / 64) * (Npad / 32); J->njobs = j + 1;
}
__device__ __forceinline__ void transpose_item(const float* W, int K, int Nsrc, const float* gain, bf16* WT, int dstrow0, int k0, int n0, LAS float* scr, int lane) {
    const int n = n0 + (lane & 31); const bool okn = n < Nsrc;
#pragma unroll 8
    for (int i = 0; i < 32; ++i) { const int kk = 2 * i + (lane >> 5); float v = okn ? W[(size_t)(k0 + kk) * Nsrc + n] : 0.f; if (gain) v *= gain[k0 + kk]; scr[kk * 33 + (lane & 31)] = v; }
    LDS_WAIT();
    const int c = lane & 7;
#pragma unroll
    for (int j = 0; j < 4; ++j) { const int nn = (lane >> 3) + 8 * j; const LAS float* s = scr + (8 * c) * 33 + nn;
        v4u o; o.x = pk2(s[0 * 33], s[1 * 33]); o.y = pk2(s[2 * 33], s[3 * 33]); o.z = pk2(s[4 * 33], s[5 * 33]); o.w = pk2(s[6 * 33], s[7 * 33]);
        *(v4u*)(WT + (size_t)(dstrow0 + nn) * K + k0 + 8 * c) = o; }
    LDS_WAIT();
}
__device__ __forceinline__ void norm_row_store(const f32x4 (&v)[4], bf16* orow, int lane) {
    float s = 0.f;
#pragma unroll
    for (int j = 0; j < 4; ++j) s += (v[j].x * v[j].x + v[j].y * v[j].y) + (v[j].z * v[j].z + v[j].w * v[j].w);
    const float rstd = rsqrtf(wave_sum(s) * (1.f / DM) + EPS);
    v2u* o8 = (v2u*)orow + lane;
#pragma unroll
    for (int j = 0; j < 4; ++j) { v2u w; w.x = pk2(v[j].x * rstd, v[j].y * rstd); w.y = pk2(v[j].z * rstd, v[j].w * rstd); o8[64 * j] = w; }
}
__device__ __forceinline__ void p_prologue(Ctx& C) {
    LAS JobTab* J = (LAS JobTab*)(C.lds + 69632);
    unsigned char* ws = C.ws;
    if (C.tid == 0) {
        J->njobs = 0; J->istart[0] = 0;
        for (int l = 0; l < 2; ++l) add_job(J, C.inp(I_HWIN) + (size_t)l * 1024 * 4096, C.inp(I_NMIX) + l * 1024, (bf16*)(ws + W_HIN) + (size_t)l * 4096 * 1024, 1024, 4096, 4096, 0, 0);
        for (int l = 0; l < 2; ++l) add_job(J, C.inp(I_HWOUT) + (size_t)l * 1024 * 1024, nullptr, (bf16*)(ws + W_HOUT) + (size_t)l * 1024 * 1024, 1024, 1024, 1024, 0, 0);
        add_job(J, C.inp(I_KVW), C.inp(I_KVN), (bf16*)(ws + W_KVQ), 1024, 1536, 1536, 0, 0);
        add_job(J, C.inp(I_NWIN), C.inp(I_NMIX) + 2048, (bf16*)(ws + W_KVQ), 1024, 1072, 1280, 0, 1536);
        add_job(J, C.inp(I_NWIN) + (size_t)1024 * 1072, C.inp(I_NMIX) + 3072, (bf16*)(ws + W_Q3), 1024, 1072, 1280, 0, 0);
        add_job(J, C.inp(I_CW1K), nullptr, (bf16*)(ws + W_CMP1), 2048, 256, 256, 0, 0);
        add_job(J, C.inp(I_CW1V), nullptr, (bf16*)(ws + W_CMP1) + (size_t)256 * 2048, 2048, 256, 256, 0, 0);
        for (int l = 0; l < 2; ++l) add_job(J, C.inp(I_NWOUT) + (size_t)l * 1024 * 1024, nullptr, (bf16*)(ws + W_NOUT) + (size_t)l * 1024 * 1024, 1024, 1024, 1024, 0, 0);
        for (int l = 0; l < 2; ++l) add_job(J, C.inp(I_FGU) + (size_t)l * 1024 * 2 * DFF, C.inp(I_NFFN) + (2 * l) * 1024, (bf16*)(ws + W_FGU) + (size_t)l * 2 * DFF * 1024, 1024, 2 * DFF, 2 * DFF, DFF, 0);
        for (int l = 0; l < 2; ++l) add_job(J, C.inp(I_FDN) + (size_t)l * DFF * 1024, nullptr, (bf16*)(ws + W_FDN) + (size_t)l * 1024 * DFF, DFF, 1024, 1024, 0, 0);
        for (int l = 0; l < 16; ++l) add_job(J, C.inp(I_MGU) + (size_t)l * 1024 * 2 * DFE, C.inp(I_NFFN) + (2 * (l >> 3) + 1) * 1024, (bf16*)(ws + W_MGU) + (size_t)l * 2 * DFE * 1024, 1024, 2 * DFE, 2 * DFE, DFE, 0);
        for (int l = 0; l < 16; ++l) add_job(J, C.inp(I_MDN) + (size_t)l * DFE * 1024, nullptr, (bf16*)(ws + W_MDN) + (size_t)l * 1024 * DFE, DFE, 1024, 1024, 0, 0);
    }
    __syncthreads();
    LAS float* scr = (LAS float*)(C.lds + C.wave * 8704);
    const int gw = C.bid * NWAVES + C.wave, NGW = C.G * NWAVES;
    const int nj = J->njobs, total = J->istart[nj];
    for (int it = gw; it < total; it += NGW) {
        int j = 0; while (j + 1 < nj && J->istart[j + 1] <= it) ++j;
        const int r = it - J->istart[j], npb = J->npb[j], kb = r / npb, nb = r % npb, n0 = 32 * nb, F = J->F[j];
        int drow = J->rowoff[j] + n0;
        if (F) drow = (n0 < F) ? 256 * (n0 / 128) + (n0 % 128) : 256 * ((n0 - F) / 128) + 128 + ((n0 - F) % 128);
        transpose_item((const float*)J->src[j], J->K[j], J->Nsrc[j], (const float*)J->gain[j], (bf16*)J->dst[j], drow, 64 * kb, n0, scr, C.lane);
    }
    { const int gt = C.bid * 512 + C.tid;
      if (gt < 1024) { const float a0 = C.inp(I_HLB)[gt], a1 = C.inp(I_HLB)[1024 + gt]; const float mx = fmaxf(a0, a1), e0 = expf(a0 - mx), e1 = expf(a1 - mx), s = e0 + e1;
          const float s0 = e0 / s, s1 = e1 / s, lb1 = (s0 + s1) - s0;
          float* la = (float*)(ws + WS_LA); float* l1 = (float*)(ws + WS_L1);
          la[gt] = -INFINITY; l1[gt] = 0.f; la[1024 + gt] = logf(lb1); l1[1024 + gt] = log1pf(-lb1); } }
    if (C.bid == 0 && C.tid < 128) ((int*)(ws + WS_RTAB))[2048 + C.tid] = C.tid >> 6;
    if (C.bid == (C.G > 1 ? 1 : 0)) { const int which = C.tid >> 8, j = C.tid & 255; const float* pos = C.inp(which ? I_CPV : I_CPK); const float* w1 = C.inp(which ? I_CW1V : I_CW1K);
        float a = 0.f; for (int i = 0; i < 2048; ++i) a += pos[i] * w1[(size_t)i * 256 + j];
        ((float*)(ws + WS_CB))[which * 256 + j] = a; }
    for (int c = C.bid; c < 256; c += C.G)
        for (int i = 0; i < 32; ++i) { const int row = c * 256 + C.wave * 32 + i; const f32x4* xr = (const f32x4*)(C.inp(I_X) + (size_t)row * DM) + C.lane; f32x4 v[4];
#pragma unroll
            for (int j = 0; j < 4; ++j) v[j] = xr[64 * j];
            norm_row_store(v, (bf16*)(ws + WS_XN) + (size_t)row * DM, C.lane); }
}

template <bool MOE_ADD, bool ROUTER, bool WRITE_XN>
__device__ __forceinline__ void p_norm(Ctx& C, const float* rw, const float* rgain) {
    unsigned char* ws = C.ws;
    LAS int* cnt8 = (LAS int*)(C.lds + 1024);
    const bf16* Y = (const bf16*)(ws + R_XP);
    const int4* route = (const int4*)(ws + WS_ROUTE); const int2* slot = (const int2*)(ws + WS_SLOT);
    for (int c = C.bid; c < 256; c += C.G) {
        if (ROUTER) { __syncthreads(); if (C.tid < 8) cnt8[C.tid] = 0; __syncthreads(); }
        for (int i = 0; i < 32; ++i) {
            const int row = c * 256 + C.wave * 32 + i;
            float* hr = C.out + (size_t)row * DM; f32x4 v[4];
#pragma unroll
            for (int j = 0; j < 4; ++j) v[j] = ((const f32x4*)hr + C.lane)[64 * j];
            if (MOE_ADD) {
                const int4 rt = route[row]; const int2 sl = slot[row]; const float w0 = __builtin_bit_cast(float, rt.y), w1 = __builtin_bit_cast(float, rt.z);
                const v2u* y0 = (const v2u*)(Y + (size_t)sl.x * DM) + C.lane; const v2u* y1 = (const v2u*)(Y + (size_t)sl.y * DM) + C.lane;
#pragma unroll
                for (int j = 0; j < 4; ++j) { const v2u a = y0[64 * j], b = y1[64 * j];
                    v[j].x += w0 * bflo(a.x) + w1 * bflo(b.x); v[j].y += w0 * bfhi(a.x) + w1 * bfhi(b.x); v[j].z += w0 * bflo(a.y) + w1 * bflo(b.y); v[j].w += w0 * bfhi(a.y) + w1 * bfhi(b.y);
                    ((f32x4*)hr + C.lane)[64 * j] = v[j]; }
            }
            if (WRITE_XN || ROUTER) {
                float s = 0.f;
#pragma unroll
                for (int j = 0; j < 4; ++j) s += (v[j].x * v[j].x + v[j].y * v[j].y) + (v[j].z * v[j].z + v[j].w * v[j].w);
                const float rstd = rsqrtf(wave_sum(s) * (1.f / DM) + EPS);
                if (WRITE_XN) { v2u* o8 = (v2u*)((bf16*)(ws + WS_XN) + (size_t)row * DM) + C.lane;
#pragma unroll
                    for (int j = 0; j < 4; ++j) { v2u w; w.x = pk2(v[j].x * rstd, v[j].y * rstd); w.y = pk2(v[j].z * rstd, v[j].w * rstd); o8[64 * j] = w; } }
                if (ROUTER) {
                    float lg[8];
#pragma unroll
                    for (int e = 0; e < 8; ++e) lg[e] = 0.f;
#pragma unroll
                    for (int j = 0; j < 4; ++j) { const int k0 = 4 * C.lane + 256 * j; const f32x4 g4 = *(const f32x4*)(rgain + k0);
#pragma unroll
                        for (int q = 0; q < 4; ++q) { const float xv = v[j][q] * rstd * g4[q]; const f32x4 wa = *(const f32x4*)(rw + (size_t)(k0 + q) * 8), wb = *(const f32x4*)(rw + (size_t)(k0 + q) * 8 + 4);
                            lg[0] += xv * wa.x; lg[1] += xv * wa.y; lg[2] += xv * wa.z; lg[3] += xv * wa.w; lg[4] += xv * wb.x; lg[5] += xv * wb.y; lg[6] += xv * wb.z; lg[7] += xv * wb.w; } }
#pragma unroll
                    for (int e = 0; e < 8; ++e) lg[e] = wave_sum(lg[e]);
                    int e0 = 0; float v0 = lg[0];
#pragma unroll
                    for (int e = 1; e < 8; ++e) if (lg[e] > v0) { v0 = lg[e]; e0 = e; }
                    int e1 = -1; float v1 = -INFINITY;
#pragma unroll
                    for (int e = 0; e < 8; ++e) if (e != e0 && (e1 < 0 || lg[e] > v1)) { v1 = lg[e]; e1 = e; }
                    const float ex = expf(v1 - v0), w0 = 1.f / (1.f + ex), w1 = ex / (1.f + ex);
                    if (C.lane == 0) { ((int4*)(ws + WS_ROUTE))[row] = make_int4(e0 | (e1 << 8), __builtin_bit_cast(int, w0), __builtin_bit_cast(int, w1), 0);
                        atomicAdd((int*)&cnt8[e0], 1); atomicAdd((int*)&cnt8[e1], 1); }
                }
            }
        }
        if (ROUTER) { __syncthreads(); if (C.tid < 8) ((int*)(ws + WS_RCNT))[c * 8 + C.tid] = cnt8[C.tid]; }
    }
}

__device__ __forceinline__ void p_gather(Ctx& C) {
    unsigned char* ws = C.ws;
    LAS int* tot = (LAS int*)(C.lds + 0);
    LAS int* pre = tot + 8;
    LAS int* base = tot + 16;
    LAS int* ee = tot + 32;
    LAS int* sl = tot + 32 + 256;
    const int* rcnt = (const int*)(ws + WS_RCNT);
    const int4* route = (const int4*)(ws + WS_ROUTE);
    for (int c = C.bid; c < 256; c += C.G) {
        __syncthreads();
        { const int e = C.wave; int t = 0, p = 0;
          for (int i = C.lane; i < 256; i += 64) { const int v = rcnt[i * 8 + e]; t += v; if (i < c) p += v; }
#pragma unroll
          for (int o = 32; o >= 1; o >>= 1) { t += __shfl_xor(t, o); p += __shfl_xor(p, o); }
          if (C.lane == 0) { tot[e] = t; pre[e] = p; } }
        if (C.tid < 256) ee[C.tid] = route[c * 256 + C.tid].x;
        __syncthreads();
        if (C.tid == 0) { int off = 0; for (int e = 0; e < 8; ++e) { base[e] = off + pre[e]; const int nt = (tot[e] + 255) >> 8;
                if (c == 0) { int* te = (int*)(ws + WS_RTAB); for (int q = 0; q < nt; ++q) te[(off >> 8) + q] = e; }
                off += nt << 8; }
            if (c == 0) ((int*)(ws + WS_RTAB))[1024] = off >> 8; }
        __syncthreads();
        if (C.tid < 8) { const int e = C.tid; int r = base[e];
            for (int i = 0; i < 256; ++i) { const int pk = ee[i]; if ((pk & 255) == e) sl[2 * i] = r++; if ((pk >> 8) == e) sl[2 * i + 1] = r++; } }
        __syncthreads();
        if (C.tid < 256) ((int2*)(ws + WS_SLOT))[c * 256 + C.tid] = make_int2(sl[2 * C.tid], sl[2 * C.tid + 1]);
        for (int i = 0; i < 32; ++i) { const int tl = C.wave * 32 + i, row = c * 256 + tl;
            const v4u* src = (const v4u*)((const bf16*)(ws + WS_XN) + (size_t)row * DM) + C.lane; const v4u a = src[0], b = src[64];
            v4u* d0 = (v4u*)((bf16*)(ws + R_XP) + (size_t)sl[2 * tl] * DM) + C.lane; v4u* d1 = (v4u*)((bf16*)(ws + R_XP) + (size_t)sl[2 * tl + 1] * DM) + C.lane;
            d0[0] = a; d0[64] = b; d1[0] = a; d1[64] = b; }
    }
}

__device__ __forceinline__ void p_scan_naive(Ctx& C, int layer) {
    unsigned char* ws = C.ws;
    const bf16* Pq = (const bf16*)(ws + R_PQ); const bf16* Pi = (const bf16*)(ws + R_PI); const bf16* Pg = (const bf16*)(ws + R_PG); const float* LF = (const float*)(ws + R_LF);
    bf16* O2 = (bf16*)(ws + R_O2);
    const float* gn = C.inp(I_HGN) + layer * 128;
    LAS float* qs = (LAS float*)(C.lds);
    LAS float* fs = qs + 4096; LAS float* ks = fs + 4096; LAS float* vs = ks + 4096;
    LAS float* po = vs + 4096;
    const int v = C.tid & 127, kq = C.tid >> 7;
    for (int bh = C.bid; bh < 256; bh += C.G) {
        const int b = bh >> 3, h = bh & 7;
        float S[32];
#pragma unroll
        for (int j = 0; j < 32; ++j) S[j] = 0.f;
        for (int t0 = 0; t0 < SEQ; t0 += 32) {
            __syncthreads();
            { const int tok = C.tid >> 4, part = C.tid & 15; const size_t off = (size_t)(b * SEQ + t0 + tok) * DM + h * 128 + part * 8;
              const v4u q8 = *(const v4u*)(Pq + off), i8 = *(const v4u*)(Pi + off); const f32x4 f0 = *(const f32x4*)(LF + off), f1 = *(const f32x4*)(LF + off + 4);
              LAS float* d = qs + tok * 128 + part * 8;
              d[0] = bflo(q8.x); d[1] = bfhi(q8.x); d[2] = bflo(q8.y); d[3] = bfhi(q8.y); d[4] = bflo(q8.z); d[5] = bfhi(q8.z); d[6] = bflo(q8.w); d[7] = bfhi(q8.w);
              d = vs + tok * 128 + part * 8;
              d[0] = bflo(i8.x); d[1] = bfhi(i8.x); d[2] = bflo(i8.y); d[3] = bfhi(i8.y); d[4] = bflo(i8.z); d[5] = bfhi(i8.z); d[6] = bflo(i8.w); d[7] = bfhi(i8.w);
              LAS float* df = fs + tok * 128 + part * 8; LAS float* dk = ks + tok * 128 + part * 8;
#pragma unroll
              for (int j = 0; j < 4; ++j) { const float fa = expf(f0[j]), fb = expf(f1[j]); df[j] = fa; dk[j] = 1.f - fa; df[4 + j] = fb; dk[4 + j] = 1.f - fb; } }
            __syncthreads();
            for (int tt = 0; tt < 32; ++tt) {
                const float vv = vs[tt * 128 + v]; float a = 0.f;
                const LAS float* fr = fs + tt * 128 + kq * 32; const LAS float* kr = ks + tt * 128 + kq * 32; const LAS float* qr = qs + tt * 128 + kq * 32;
#pragma unroll
                for (int j = 0; j < 32; ++j) { S[j] = fr[j] * S[j] + kr[j] * vv; a += qr[j] * S[j]; }
                po[(tt * 4 + kq) * 128 + v] = a;
            }
            __syncthreads();
            { const int tok = C.tid >> 4, part = C.tid & 15; float o[8]; float ss = 0.f;
#pragma unroll
              for (int j = 0; j < 8; ++j) { const int vv = part * 8 + j; o[j] = (po[(tok * 4 + 0) * 128 + vv] + po[(tok * 4 + 1) * 128 + vv]) + (po[(tok * 4 + 2) * 128 + vv] + po[(tok * 4 + 3) * 128 + vv]); ss += o[j] * o[j]; }
              ss += __shfl_xor(ss, 1); ss += __shfl_xor(ss, 2); ss += __shfl_xor(ss, 4); ss += __shfl_xor(ss, 8);
              const float rstd = rsqrtf(ss * (1.f / 128.f) + EPS);
              const size_t off = (size_t)(b * SEQ + t0 + tok) * DM + h * 128 + part * 8; const v4u g8 = *(const v4u*)(Pg + off);
              const float gg[8] = {bflo(g8.x), bfhi(g8.x), bflo(g8.y), bfhi(g8.y), bflo(g8.z), bfhi(g8.z), bflo(g8.w), bfhi(g8.w)};
              float r[8];
#pragma unroll
              for (int j = 0; j < 8; ++j) r[j] = o[j] * rstd * gn[part * 8 + j] * gg[j];
              v4u w; w.x = pk2(r[0], r[1]); w.y = pk2(r[2], r[3]); w.z = pk2(r[4], r[5]); w.w = pk2(r[6], r[7]);
              *(v4u*)(O2 + off) = w; }
        }
    }
}

__device__ __forceinline__ void p_post(Ctx& C, int has_kv, int ld, int j_layer) {
    unsigned char* ws = C.ws;
    const bf16* raw = (const bf16*)(ws + R_QKV);
    const float* kn = C.inp(I_KN); const float* qn = C.inp(I_NQN) + j_layer * 64;
    const int l = C.lane;
    for (int c = C.bid; c < 256; c += C.G)
        for (int i = 0; i < 32; ++i) {
            const int row = c * 256 + C.wave * 32 + i, b = row >> 11, t = row & 2047;
            const bf16* rr = raw + (size_t)row * ld;
            if (has_kv) {
#pragma unroll
                for (int g = 0; g < 4; ++g) {
                    const size_t tok = ((size_t)(b * 4 + g) * SEQ + t) * 64 + l, tr = (((size_t)(b * 4 + g) * 64 + (t >> 5)) * 64 + l) * 32 + (t & 31);
                    ((bf16*)(ws + R_KCR))[tok] = rr[0 * 256 + g * 64 + l];
                    ((bf16*)(ws + R_VCR))[tok] = rr[1 * 256 + g * 64 + l];
                    { const float x = bf2f(rr[2 * 256 + g * 64 + l]); const float rs = rsqrtf(wave_sum(x * x) * (1.f / 64.f) + EPS); ((bf16*)(ws + R_KS))[tok] = (bf16)f2bf(x * rs * kn[64 + l]); }
                    ((bf16*)(ws + R_VST))[tr] = rr[3 * 256 + g * 64 + l];
                    { const float x = bf2f(rr[4 * 256 + g * 64 + l]); const float rs = rsqrtf(wave_sum(x * x) * (1.f / 64.f) + EPS); ((bf16*)(ws + R_KW))[tok] = (bf16)f2bf(x * rs * kn[128 + l]); }
                    ((bf16*)(ws + R_VWT))[tr] = rr[5 * 256 + g * 64 + l];
                }
            }
            const int qo = has_kv ? 1536 : 0;
#pragma unroll 4
            for (int h = 0; h < 16; ++h) { const float x = bf2f(rr[qo + h * 64 + l]); const float rs = rsqrtf(wave_sum(x * x) * (1.f / 64.f) + EPS);
                ((bf16*)(ws + R_Q))[(size_t)row * DM + h * 64 + l] = (bf16)f2bf(x * rs * qn[l] * (0.125f * 1.4426950408889634f)); }
            if (l < 48) { const float x = bf2f(rr[qo + 1024 + l]); ((float*)(ws + WS_GATES))[(size_t)row * 48 + l] = 1.f / (1.f + expf(-x)); }
        }
}

__device__ __forceinline__ void p_cmp2(Ctx& C) {
    unsigned char* ws = C.ws;
    const bf16* Hk = (const bf16*)(ws + WS_HC); const bf16* Hv = Hk + (size_t)16384 * 256;
    const float* w2k = C.inp(I_CW2K); const float* w2v = C.inp(I_CW2V); const float* kn = C.inp(I_KN);
    LAS float* hk = (LAS float*)(C.lds + C.wave * 2048); LAS float* hv = hk + 256;
    const int l = C.lane, gw = C.bid * NWAVES + C.wave, NGW = C.G * NWAVES;
    for (int r = gw; r < 16384; r += NGW) {
        const int bg = r >> 7, c = r & 127;
        { const v2u a = *((const v2u*)(Hk + (size_t)r * 256) + l), bq = *((const v2u*)(Hv + (size_t)r * 256) + l);
          hk[4 * l] = bflo(a.x); hk[4 * l + 1] = bfhi(a.x); hk[4 * l + 2] = bflo(a.y); hk[4 * l + 3] = bfhi(a.y);
          hv[4 * l] = bflo(bq.x); hv[4 * l + 1] = bfhi(bq.x); hv[4 * l + 2] = bflo(bq.y); hv[4 * l + 3] = bfhi(bq.y); }
        LDS_WAIT();
        float ak = 0.f, av = 0.f;
#pragma unroll 8
        for (int j = 0; j < 256; ++j) { ak += hk[j] * w2k[j * 64 + l]; av += hv[j] * w2v[j * 64 + l]; }
        if (c == 127) { ak = 0.f; av = 0.f; }
        const float rs = rsqrtf(wave_sum(ak * ak) * (1.f / 64.f) + EPS);
        ((bf16*)(ws + WS_KC))[(size_t)r * 64 + l] = (bf16)f2bf(ak * rs * kn[l]);
        ((bf16*)(ws + WS_VCT))[(((size_t)bg * 4 + (c >> 5)) * 64 + l) * 32 + (c & 31)] = (bf16)f2bf(av);
        LDS_WAIT();
    }
}

typedef short bf16x8v __attribute__((ext_vector_type(8)));
#define MFMA16(a, b, c) __builtin_amdgcn_mfma_f32_16x16x32_bf16((a), (b), (c), 0, 0, 0)
constexpr float LOG2E = 1.4426950408889634f;
template <int MODE>
__device__ __forceinline__ void attn_step(const bf16* __restrict__ Kb, const bf16* __restrict__ Vb, unsigned koff, unsigned voff, int k0, int trel, bool tokok, int cmax,
                                          const bf16x8v (&qf)[2][2], float (&m)[2], float (&ls)[2], f32x4 (&o)[2][4], const float (&sl2)[2], int q4) {
    const char* kblk = (const char*)(Kb + (size_t)k0 * 64); const char* vblk = (const char*)(Vb + (size_t)k0 * 64);
    bf16x8v ka[2], kb[2], vf[4];
#pragma unroll
    for (int ks = 0; ks < 2; ++ks) { ka[ks] = *(const bf16x8v*)(kblk + koff + 64 * ks); kb[ks] = *(const bf16x8v*)(kblk + koff + 512 + 64 * ks); }
#pragma unroll
    for (int dt = 0; dt < 4; ++dt) vf[dt] = *(const bf16x8v*)(vblk + voff + 1024 * dt);
    constexpr int DMUL = (MODE == 0) ? 16 : 1;
    float dist[8]; bool ok[8];
#pragma unroll
    for (int i = 0; i < 8; ++i) { const int kk = 8 * q4 + i; const int d = trel - DMUL * kk; dist[i] = (float)d;
        ok[i] = (MODE == 0) ? (k0 + kk <= cmax) : (MODE == 1 ? (tokok && d >= 0) : (d >= 0 && d < 512)); }
#pragma unroll
    for (int h = 0; h < 2; ++h) {
        f32x4 sa = {0.f, 0.f, 0.f, 0.f}, sb = {0.f, 0.f, 0.f, 0.f};
        sa = MFMA16(ka[0], qf[h][0], sa); sb = MFMA16(kb[0], qf[h][0], sb); sa = MFMA16(ka[1], qf[h][1], sa); sb = MFMA16(kb[1], qf[h][1], sb);
        float s[8]; float mx = -1e30f;
#pragma unroll
        for (int i = 0; i < 8; ++i) { const float raw = i < 4 ? sa[i] : sb[i - 4]; s[i] = raw - sl2[h] * dist[i]; mx = ok[i] ? fmaxf(mx, s[i]) : mx; }
        mx = fmaxf(mx, __shfl_xor(mx, 16)); mx = fmaxf(mx, __shfl_xor(mx, 32));
        const float mnew = fmaxf(m[h], mx), alpha = __builtin_amdgcn_exp2f(m[h] - mnew); m[h] = mnew;
        float p[8]; float psum = 0.f;
#pragma unroll
        for (int i = 0; i < 8; ++i) { p[i] = ok[i] ? __builtin_amdgcn_exp2f(s[i] - mnew) : 0.f; psum += p[i]; }
        ls[h] = ls[h] * alpha + psum;
        bf16x8v pf; { const unsigned w0 = pg8::cvt_pk_bf16(p[0], p[1]), w1 = pg8::cvt_pk_bf16(p[2], p[3]), w2 = pg8::cvt_pk_bf16(p[4], p[5]), w3 = pg8::cvt_pk_bf16(p[6], p[7]);
            const v4u w = {w0, w1, w2, w3}; pf = __builtin_bit_cast(bf16x8v, w); }
#pragma unroll
        for (int dt = 0; dt < 4; ++dt) { o[h][dt] = o[h][dt] * alpha; o[h][dt] = MFMA16(vf[dt], pf, o[h][dt]); }
    }
}
constexpr int PSW = 132;
__device__ __forceinline__ void p_attn_fast(Ctx& C, unsigned* queue) {
    unsigned char* ws = C.ws;
    const bf16* Q = (const bf16*)(ws + R_Q); const float* GT = (const float*)(ws + WS_GATES);
    const bf16* KC = (const bf16*)(ws + WS_KC); const bf16* VCT = (const bf16*)(ws + WS_VCT);
    const bf16* KS = (const bf16*)(ws + R_KS); const bf16* VST = (const bf16*)(ws + R_VST); const bf16* KW = (const bf16*)(ws + R_KW); const bf16* VWT = (const bf16*)(ws + R_VWT);
    bf16* O = (bf16*)(ws + R_O);
    LAS float* psl = (LAS float*)(C.lds + C.wave * (16 * PSW * 4));
    const int l = C.lane, r16 = l & 15, q4 = l >> 4;
    const unsigned koff = (unsigned)(((8 * (r16 >> 2) + (r16 & 3)) * 64 + 8 * q4) * 2), voff = (unsigned)((r16 * 32 + 8 * q4) * 2);
    for (;;) {
        unsigned u = 0; if (l == 0) u = __hip_atomic_fetch_add(queue, 1u, __ATOMIC_RELAXED, __HIP_MEMORY_SCOPE_AGENT);
        u = (unsigned)__builtin_amdgcn_readfirstlane((int)u);
        if (u >= 16384u) break;
        const int bg = (int)(u >> 7), tile = 127 - (int)(u & 127), g = bg & 3, b = bg >> 2, t0 = tile * 16, t = t0 + r16, row = b * SEQ + t;
        const float* gtp = GT + (size_t)row * 48 + g * 12;
        bf16* orow = O + (size_t)row * DM + g * 256 + 4 * q4;
        bf16x8v qf[2][2]; float sl2[2]; float m[2], ls[2]; f32x4 o[2][4];
#define ATT_LOADQ(hp) do { _Pragma("unroll") for (int h = 0; h < 2; ++h) { sl2[h] = exp2f(-0.5f * (float)(g * 4 + 2 * (hp) + h + 1)) * LOG2E; \
            _Pragma("unroll") for (int ks = 0; ks < 2; ++ks) qf[h][ks] = *(const bf16x8v*)(Q + (size_t)row * DM + (g * 4 + 2 * (hp) + h) * 64 + 32 * ks + 8 * q4); } } while (0)
#define ATT_RESET() do { _Pragma("unroll") for (int h = 0; h < 2; ++h) { m[h] = -1e30f; ls[h] = 0.f; _Pragma("unroll") for (int dt = 0; dt < 4; ++dt) o[h][dt] = (f32x4){0.f, 0.f, 0.f, 0.f}; } } while (0)
        const int cmax = t >= 31 ? (((t - 31) >> 4) < 126 ? ((t - 31) >> 4) : 126) : -1;
        const bf16* KCb = KC + (size_t)bg * 128 * 64; const bf16* VCb = VCT + (size_t)bg * 128 * 64;
        const int ncs = ((t0 + 15 - 31) >> 4) < 0 ? 0 : ((((t0 + 15 - 31) >> 4) < 126 ? ((t0 + 15 - 31) >> 4) : 126) >> 5) + 1;
#pragma unroll 1
        for (int hp = 0; hp < 2; ++hp) {
            ATT_LOADQ(hp); ATT_RESET();
            for (int st = 0; st < ncs; ++st) attn_step<0>(KCb, VCb, koff, voff, 32 * st, t - 31 - 16 * 32 * st, true, cmax, qf, m, ls, o, sl2, q4);
#pragma unroll
            for (int h = 0; h < 2; ++h) { float lt = ls[h]; lt += __shfl_xor(lt, 16); lt += __shfl_xor(lt, 32); ls[h] = lt;
                const float sc_ = lt > 0.f ? gtp[(2 * hp + h) * 3 + 0] / lt : 0.f;
#pragma unroll
                for (int dt = 0; dt < 4; ++dt) { const f32x4 r_ = o[h][dt] * sc_; v2u w; w.x = pg8::cvt_pk_bf16(r_[0], r_[1]); w.y = pg8::cvt_pk_bf16(r_[2], r_[3]);
                    *(v2u*)(orow + (2 * hp + h) * 64 + 16 * dt) = w; } }
            float ps[4][8];
#pragma unroll
            for (int st = 0; st < 4; ++st)
#pragma unroll
                for (int i = 0; i < 8; ++i) ps[st][i] = 0.f;
#pragma unroll
            for (int st = 0; st < 4; ++st) {
                if (st < ncs) {
                    const int k0 = 32 * st; const char* kblk = (const char*)(KCb + (size_t)k0 * 64);
                    bf16x8v ka[2], kb[2];
#pragma unroll
                    for (int ks = 0; ks < 2; ++ks) { ka[ks] = *(const bf16x8v*)(kblk + koff + 64 * ks); kb[ks] = *(const bf16x8v*)(kblk + koff + 512 + 64 * ks); }
#pragma unroll
                    for (int h = 0; h < 2; ++h) {
                        f32x4 sa = {0.f, 0.f, 0.f, 0.f}, sb = {0.f, 0.f, 0.f, 0.f};
                        sa = MFMA16(ka[0], qf[h][0], sa); sb = MFMA16(kb[0], qf[h][0], sb); sa = MFMA16(ka[1], qf[h][1], sa); sb = MFMA16(kb[1], qf[h][1], sb);
                        const float inv = ls[h] > 0.f ? 1.f / ls[h] : 0.f;
#pragma unroll
                        for (int i = 0; i < 8; ++i) { const int c = k0 + 8 * q4 + i; const float raw = i < 4 ? sa[i] : sb[i - 4];
                            const float s = raw - sl2[h] * (float)(t - 31 - 16 * c); ps[st][i] += (c <= cmax) ? __builtin_amdgcn_exp2f(s - m[h]) * inv : 0.f; }
                    }
                }
            }
#pragma unroll
            for (int st = 0; st < 4; ++st) { LAS f32x4* p0 = (LAS f32x4*)(psl + r16 * PSW + 32 * st + 8 * q4);
                f32x4 a = {ps[st][0], ps[st][1], ps[st][2], ps[st][3]}, bq = {ps[st][4], ps[st][5], ps[st][6], ps[st][7]};
                if (hp) { a = a + p0[0]; bq = bq + p0[1]; }
                p0[0] = a; p0[1] = bq; }
            LDS_WAIT();
        }
        unsigned mlo, mhi;
        {
            float sc[16]; const LAS float* pr = psl + r16 * PSW + 32 * q4; const int cur = t >> 5;
            float prev = q4 > 0 ? pr[-1] : 0.f;
#pragma unroll
            for (int jj = 0; jj < 16; ++jj) { const float a = pr[2 * jj], bq = pr[2 * jj + 1]; const float imp = prev + a + bq; prev = bq;
                const int j = 16 * q4 + jj; const bool valid = 32 * j <= t; const bool forced = valid && (j == 0 || j == cur || j == cur - 1);
                sc[jj] = forced ? 1e9f : (valid ? imp : -1e9f); }
            unsigned my = 0u;
            for (int r = 0; r < 8; ++r) {
                float best = sc[0]; int bi = 0;
#pragma unroll
                for (int jj = 1; jj < 16; ++jj) if (sc[jj] > best) { best = sc[jj]; bi = jj; }
                bi += 16 * q4;
#pragma unroll
                for (int sh = 16; sh <= 32; sh <<= 1) { const float ov = __shfl_xor(best, sh); const int oi = __shfl_xor(bi, sh); if (ov > best || (ov == best && oi < bi)) { best = ov; bi = oi; } }
                if ((bi >> 4) == q4) { const int jj0 = bi & 15; if (best > -0.5e9f) my |= 1u << jj0;
#pragma unroll
                    for (int jj = 0; jj < 16; ++jj) if (jj == jj0) sc[jj] = -INFINITY; }
            }
            mlo = (q4 == 0 ? my : 0u) | (q4 == 1 ? my << 16 : 0u); mhi = (q4 == 2 ? my : 0u) | (q4 == 3 ? my << 16 : 0u);
            mlo |= __shfl_xor(mlo, 16); mlo |= __shfl_xor(mlo, 32); mhi |= __shfl_xor(mhi, 16); mhi |= __shfl_xor(mhi, 32);
        }
        LDS_WAIT();
        unsigned ulo = mlo, uhi = mhi;
#pragma unroll
        for (int sh = 1; sh <= 8; sh <<= 1) { ulo |= __shfl_xor(ulo, sh); uhi |= __shfl_xor(uhi, sh); }
        const unsigned long long un0 = ((unsigned long long)(unsigned)__builtin_amdgcn_readfirstlane((int)uhi) << 32) | (unsigned)__builtin_amdgcn_readfirstlane((int)ulo);
        const unsigned long long mine = ((unsigned long long)mhi << 32) | mlo;
#pragma unroll 1
        for (int hp = 0; hp < 2; ++hp) {
            ATT_LOADQ(hp);
            f32x4 oacc[2][4];
            {
                const bf16* Kb = KS + (size_t)bg * SEQ * 64; const bf16* Vb = VST + (size_t)bg * SEQ * 64;
                ATT_RESET();
                unsigned long long un = un0;
                while (un) { const int j = __builtin_ctzll(un); un &= un - 1;
                    attn_step<1>(Kb, Vb, koff, voff, 32 * j, t - 32 * j, ((mine >> j) & 1ull) != 0ull, 0, qf, m, ls, o, sl2, q4); }
#pragma unroll
                for (int h = 0; h < 2; ++h) { float lt = ls[h]; lt += __shfl_xor(lt, 16); lt += __shfl_xor(lt, 32); const float sc_ = lt > 0.f ? gtp[(2 * hp + h) * 3 + 1] / lt : 0.f;
#pragma unroll
                    for (int dt = 0; dt < 4; ++dt) oacc[h][dt] = o[h][dt] * sc_; }
            }
            {
                const bf16* Kb = KW + (size_t)bg * SEQ * 64; const bf16* Vb = VWT + (size_t)bg * SEQ * 64;
                const int sb = t0 >= 511 ? (t0 - 511) >> 5 : 0, se = t0 >> 5;
                ATT_RESET();
                for (int st = sb; st <= se; ++st) attn_step<2>(Kb, Vb, koff, voff, 32 * st, t - 32 * st, true, 0, qf, m, ls, o, sl2, q4);
#pragma unroll
                for (int h = 0; h < 2; ++h) { float lt = ls[h]; lt += __shfl_xor(lt, 16); lt += __shfl_xor(lt, 32); const float sc_ = lt > 0.f ? gtp[(2 * hp + h) * 3 + 2] / lt : 0.f;
#pragma unroll
                    for (int dt = 0; dt < 4; ++dt) oacc[h][dt] = oacc[h][dt] + o[h][dt] * sc_; }
            }
#pragma unroll
            for (int h = 0; h < 2; ++h)
#pragma unroll
                for (int dt = 0; dt < 4; ++dt) { v2u* op = (v2u*)(orow + (2 * hp + h) * 64 + 16 * dt); const v2u c_ = *op; const f32x4 r_ = oacc[h][dt];
                    v2u w; w.x = pg8::cvt_pk_bf16(r_[0] + bflo(c_.x), r_[1] + bfhi(c_.x)); w.y = pg8::cvt_pk_bf16(r_[2] + bflo(c_.y), r_[3] + bfhi(c_.y)); *op = w; }
        }
#undef ATT_LOADQ
#undef ATT_RESET
    }
}

#define PH_BEGIN { const bool run_ = (pid >= lo && pid < hi); ++pid; if (run_) { { int ln_; asm volatile("v_mbcnt_lo_u32_b32 %0, -1, 0\n\tv_mbcnt_hi_u32_b32 %0, -1, %0" : "=v"(ln_)); C.lane = ln_; C.tid = C.wave * 64 + ln_; }
#define PH_END   if (pid < hi) xcd_barrier(bar); } }
#define XN ((const bf16*)(ws + WS_XN))
#define RTAB ((const int*)(ws + WS_RTAB))

template <int L>
__device__ __forceinline__ void run_layer(Ctx& C, const XcdBarrier& bar, int& pid, const int lo, const int hi, PG8_LAS unsigned char* ring) {
    unsigned char* const ws = C.ws;

        const int li = L >> 1;
        if (L < 2) {
            PH_BEGIN { pg8::Gemm g{XN, (const bf16*)(ws + W_HIN) + (size_t)L * 4096 * 1024, 1024, 1024, 0}; pg8::GenOrder S; S.init(256, 16, C.G, C.bid, nullptr);
                pg8::EpiHgrnIn E{ws, L};
                pg8::gemm_phase<pg8::EpiHgrnIn, pg8::GenOrder, true, true>(ring, g, S, E, C.wave); } PH_END
            PH_BEGIN p_scan_naive(C, L); PH_END
        } else {
            PH_BEGIN { const bool first = (L == 2); pg8::Gemm g{XN, (const bf16*)(ws + (first ? W_KVQ : W_Q3)), 1024, 1024, 0}; pg8::GenOrder S; S.init(256, first ? 11 : 5, C.G, C.bid, nullptr);
                pg8::EpiBf16 E{(bf16*)(ws + R_QKV), first ? 2816 : 1280, nullptr, 0, 0};
                pg8::gemm_phase<pg8::EpiBf16, pg8::GenOrder, true, true>(ring, g, S, E, C.wave); } PH_END
            PH_BEGIN p_post(C, L == 2 ? 1 : 0, L == 2 ? 2816 : 1280, L - 2); PH_END
            if (L == 2) {
                PH_BEGIN { pg8::Gemm g{(const bf16*)(ws + R_KCR), (const bf16*)(ws + W_CMP1), 2048, 1024, (size_t)256 * 2048 * 2}; pg8::GenOrder S; S.init(128, 1, C.G, C.bid, RTAB + 2048);
                    pg8::EpiBf16 E{(bf16*)(ws + WS_HC), 256, (const float*)(ws + WS_CB), 1, 256};
                    pg8::gemm_phase<pg8::EpiBf16, pg8::GenOrder, true, true>(ring, g, S, E, C.wave); } PH_END
                PH_BEGIN p_cmp2(C); PH_END
            }
            PH_BEGIN p_attn_fast(C, (unsigned*)(ws + WS_CTL) + 8192 + 64 * (L - 2)); PH_END
        }
        PH_BEGIN { pg8::Gemm g{(const bf16*)(ws + (L < 2 ? R_O2 : R_O)), (const bf16*)(ws + (L < 2 ? W_HOUT : W_NOUT)) + (size_t)(L & 1) * 1024 * 1024, 1024, 1024, 0};
            pg8::GenOrder S; S.init(256, 4, C.G, C.bid, nullptr);
            pg8::EpiRes E{L == 0 ? C.inp(I_X) : C.out, C.out, 1024};
            pg8::gemm_phase<pg8::EpiRes, pg8::GenOrder, true, true>(ring, g, S, E, C.wave); } PH_END
        PH_BEGIN { if (L & 1) p_norm<false, true, true>(C, C.inp(I_MR) + (size_t)li * 1024 * 8, C.inp(I_NFFN) + L * 1024); else p_norm<false, false, true>(C, nullptr, nullptr); } PH_END
        if (L & 1) { PH_BEGIN p_gather(C); PH_END }
        PH_BEGIN { const bool moe = (L & 1) != 0;
            pg8::Gemm g{moe ? (const bf16*)(ws + R_XP) : XN, moe ? (const bf16*)(ws + W_MGU) + (size_t)li * 8 * 2 * DFE * 1024 : (const bf16*)(ws + W_FGU) + (size_t)li * 2 * DFF * 1024, 1024, 1024, moe ? (size_t)2 * DFE * 1024 * 2 : 0};
            pg8::GenOrder S; S.init(moe ? RTAB[1024] : 256, moe ? 28 : 22, C.G, C.bid, moe ? RTAB : nullptr);
            pg8::EpiSwiGLU E{(bf16*)(ws + (moe ? R_HM : R_HF)), moe ? DFE : DFF};
            pg8::gemm_phase<pg8::EpiSwiGLU, pg8::GenOrder, true, true>(ring, g, S, E, C.wave); } PH_END
        if (!(L & 1)) {
            PH_BEGIN { pg8::Gemm g{(const bf16*)(ws + R_HF), (const bf16*)(ws + W_FDN) + (size_t)li * 1024 * DFF, DFF, DFF, 0}; pg8::GenOrder S; S.init(256, 4, C.G, C.bid, nullptr);
                pg8::EpiRes E{C.out, C.out, 1024};
                pg8::gemm_phase<pg8::EpiRes, pg8::GenOrder, true, true>(ring, g, S, E, C.wave); } PH_END
            PH_BEGIN p_norm<false, false, true>(C, nullptr, nullptr); PH_END
        } else {
            PH_BEGIN { pg8::Gemm g{(const bf16*)(ws + R_HM), (const bf16*)(ws + W_MDN) + (size_t)li * 8 * 1024 * DFE, DFE, DFE, (size_t)1024 * DFE * 2}; pg8::GenOrder S; S.init(RTAB[1024], 4, C.G, C.bid, RTAB);
                pg8::EpiBf16 E{(bf16*)(ws + R_XP), 1024, nullptr, 0, 0};
                pg8::gemm_phase<pg8::EpiBf16, pg8::GenOrder, true, true>(ring, g, S, E, C.wave); } PH_END
            PH_BEGIN { if (L == 1) p_norm<true, false, true>(C, nullptr, nullptr); else p_norm<true, false, false>(C, nullptr, nullptr); } PH_END
        }
    }

struct Args { const float* in[24]; float* out; unsigned char* ws; int ph_lo, ph_hi; };
constexpr int N_PHASES = 35;

__global__ void __launch_bounds__(NWAVES * 64, 2) yoco_fwd(Args args) {
    extern __shared__ __attribute__((aligned(16))) unsigned char lds_raw[];
    Ctx C;
    C.lds = (LAS unsigned char*)lds_raw;
    C.wave = __builtin_amdgcn_readfirstlane((int)(threadIdx.x >> 6)); C.tid = threadIdx.x; C.lane = C.tid & 63;
    C.G = gridDim.x; C.bid = blockIdx.x;
    C.out = args.out; C.ws = args.ws;
    unsigned char* const ws = args.ws;
    volatile LAS unsigned* MISC = (volatile LAS unsigned*)(C.lds + MISC_OFF);
    if (C.tid < 32) MISC[C.tid] = 0u;
    __syncthreads();
    XcdBarrier bar = xcd_barrier_post((unsigned*)(ws + WS_CTL) + 4096, MISC + 8);
    const int lo = args.ph_lo, hi = args.ph_hi;
    int pid = 0;
    PG8_LAS unsigned char* ring = (PG8_LAS unsigned char*)lds_raw;
    PH_BEGIN p_prologue(C); PH_END

    run_layer<0>(C, bar, pid, lo, hi, ring); run_layer<1>(C, bar, pid, lo, hi, ring); run_layer<2>(C, bar, pid, lo, hi, ring); run_layer<3>(C, bar, pid, lo, hi, ring);
#undef PH_BEGIN
#undef PH_END
#undef XN
#undef RTAB
}

extern "C" void kernel_launch(void* const* d_in, const int* in_sizes, int n_in, void* d_out, int out_size, void* d_ws, size_t ws_size, hipStream_t stream) {
    static int grid = 0;
    if (grid == 0) {
        if (n_in != 24 || in_sizes[0] != NT * DM || out_size != NT * DM || ws_size < WS_NEED) { fprintf(stderr, "kernel_launch: unexpected shapes / workspace (n_in %d, ws %zu, need %zu)\n", n_in, ws_size, (size_t)WS_NEED); grid = -1; return; }
        int dev = 0, cus = 0;
        if (hipGetDevice(&dev) != hipSuccess || hipDeviceGetAttribute(&cus, hipDeviceAttributeMultiprocessorCount, dev) != hipSuccess) { grid = -1; return; }
        if (hipFuncSetAttribute((const void*)yoco_fwd, hipFuncAttributeMaxDynamicSharedMemorySize, LDS_BYTES) != hipSuccess) { fprintf(stderr, "kernel_launch: hipFuncSetAttribute failed\n"); grid = -1; return; }
        int per_cu = 0;
        if (hipOccupancyMaxActiveBlocksPerMultiprocessor(&per_cu, (const void*)yoco_fwd, NWAVES * 64, LDS_BYTES) != hipSuccess || per_cu < 1) { fprintf(stderr, "kernel_launch: occupancy query says %d\n", per_cu); }
        (void)hipGetLastError();
        grid = cus;
    }
    if (grid < 0) return;
    (void)hipMemsetAsync((char*)d_ws + WS_CTL, 0, CTL_ZERO_BYTES, stream);
    Args a{};
    for (int i = 0; i < 24; ++i) a.in[i] = (const float*)d_in[i];
    a.out = (float*)d_out; a.ws = (unsigned char*)d_ws;
#if MK_SINGLE
    a.ph_lo = 0; a.ph_hi = N_PHASES;
    hipLaunchKernelGGL(yoco_fwd, dim3(grid), dim3(NWAVES * 64), LDS_BYTES, stream, a);
#else
    for (int k = 0; k < N_PHASES; ++k) { a.ph_lo = k; a.ph_hi = k + 1; hipLaunchKernelGGL(yoco_fwd, dim3(grid), dim3(NWAVES * 64), LDS_BYTES, stream, a); }
#endif
}
```

```cpp
#include <hip/hip_runtime.h>
#include <cstdio>
#include <cstdint>

#ifndef MK_SINGLE
#define MK_SINGLE 1
#endif

namespace pg8 {
#define PG8_LAS __attribute__((address_space(3)))
typedef unsigned short bf16_t;
typedef short bf16x8 __attribute__((ext_vector_type(8)));
typedef float f32x4 __attribute__((ext_vector_type(4)));
typedef unsigned u32x4 __attribute__((ext_vector_type(4)));
constexpr int BM = 256, BK = 64, HALF = 128, HTB = HALF * BK * 2  , STAGE_BYTES = 8 * HTB, NXCD = 8, WGM = 8;

__host__ __device__ __forceinline__ int lds_byte(int r, int c) { const int st = (r >> 4) * 2 + (c >> 5), rr = r & 15, cc = c & 31, ob = rr * 64 + cc * 2; return st * 1024 + (ob ^ (((ob >> 9) & 1) << 5)); }
__host__ __device__ __forceinline__ void stage_rc(int b, int& R, int& C) { const int st = b / 1024, sb = b % 1024, swz = sb ^ (((sb >> 9) & 1) << 5); R = (st >> 1) * 16 + swz / 64; C = (st & 1) * 32 + (swz % 64) / 2; }
__host__ __device__ __forceinline__ int perm32(int rho) { const int n = rho >> 4, i = rho & 15; return 8 * (i >> 2) + 4 * n + (i & 3); }

struct Unit { int pm, pn, e; };
struct Gemm { const bf16_t* A; const bf16_t* Bt; int K; int lda; size_t estride; };

struct GenOrder {
    int nM, nN, nwg, G, c; const int* tile_e;
    __device__ void init(int nM_, int nN_, int G_, int c_, const int* te) { nM = nM_; nN = nN_; nwg = nM * nN; G = G_; c = c_; tile_e = te; }
    __device__ bool next(int i, Unit& u) const {
        const long L = (long)i * G + c; if (L >= nwg) return false;
        int wgid = (int)L; { const int q = nwg / NXCD, r = nwg % NXCD, xcd = wgid % NXCD, off = wgid / NXCD; wgid = (xcd < r ? xcd * (q + 1) : r * (q + 1) + (xcd - r) * q) + off; }
        const int nig = WGM * nN, gid = wgid / nig, fm = gid * WGM, gsz = (nM - fm) < WGM ? (nM - fm) : WGM;
        u.pm = fm + ((wgid % nig) % gsz); u.pn = (wgid % nig) / gsz; u.e = tile_e ? tile_e[u.pm] : 0; return true;
    }
    __device__ __forceinline__ void a_ready(const Unit&) const {}
    __device__ __forceinline__ void done(const Unit&) const {}
};

__device__ __forceinline__ unsigned cvt_pk_bf16(float lo, float hi) { unsigned r; asm volatile("v_cvt_pk_bf16_f32 %0, %1, %2" : "=v"(r) : "v"(lo), "v"(hi)); return r; }
__device__ __forceinline__ float silu_f(float v) { return v * __builtin_amdgcn_rcpf(1.0f + __expf(-v)); }

struct EpiBf16 {
    static constexpr bool PERM = true, AFTER_DRAIN = false;
    bf16_t* O; int ldc; const float* bias; int act; int bias_es;
    __device__ __forceinline__ void operator()(const f32x4 (&acc)[2][2][4][2], const Unit& u, int wr, int wc, int fr, int fq) const {
        const int row0 = u.pm * BM + wr * 64 + fr, col0 = u.pn * BM + wc * 32 + 8 * fq;
        f32x4 bv[2][2];
#pragma unroll
        for (int bj = 0; bj < 2; ++bj)
#pragma unroll
            for (int n = 0; n < 2; ++n) bv[bj][n] = bias ? *(const f32x4*)(bias + u.e * bias_es + col0 + bj * HALF + 4 * n) : (f32x4){0.f, 0.f, 0.f, 0.f};
#pragma unroll
        for (int ai = 0; ai < 2; ++ai)
#pragma unroll
            for (int m = 0; m < 4; ++m) { bf16_t* rowp = O + (size_t)(row0 + ai * HALF + m * 16) * ldc + col0;
#pragma unroll
                for (int bj = 0; bj < 2; ++bj) { f32x4 v0 = acc[ai][bj][m][0] + bv[bj][0], v1 = acc[ai][bj][m][1] + bv[bj][1];
                    if (act == 1) {
#pragma unroll
                        for (int i = 0; i < 4; ++i) { v0[i] = silu_f(v0[i]); v1[i] = silu_f(v1[i]); } }
                    u32x4 w; w.x = cvt_pk_bf16(v0[0], v0[1]); w.y = cvt_pk_bf16(v0[2], v0[3]); w.z = cvt_pk_bf16(v1[0], v1[1]); w.w = cvt_pk_bf16(v1[2], v1[3]);
                    *(u32x4*)(rowp + bj * HALF) = w; } }
    }
};
struct EpiRes {
    static constexpr bool PERM = false, AFTER_DRAIN = false;
    const float* base; float* out; int ldc;
    __device__ __forceinline__ void operator()(const f32x4 (&acc)[2][2][4][2], const Unit& u, int wr, int wc, int fr, int fq) const {
        const int row0 = u.pm * BM + wr * 64 + fr, col0 = u.pn * BM + wc * 32 + 4 * fq;
#pragma unroll
        for (int ai = 0; ai < 2; ++ai)
#pragma unroll
            for (int m = 0; m < 4; ++m) { const size_t off = (size_t)(row0 + ai * HALF + m * 16) * ldc + col0;
#pragma unroll
                for (int bj = 0; bj < 2; ++bj)
#pragma unroll
                    for (int n = 0; n < 2; ++n) { const f32x4 b = *(const f32x4*)(base + off + bj * HALF + n * 16); *(f32x4*)(out + off + bj * HALF + n * 16) = b + acc[ai][bj][m][n]; } }
    }
};
struct EpiSwiGLU {
    static constexpr bool PERM = true, AFTER_DRAIN = false;
    bf16_t* O; int ldc;
    __device__ __forceinline__ void operator()(const f32x4 (&acc)[2][2][4][2], const Unit& u, int wr, int wc, int fr, int fq) const {
        const int row0 = u.pm * BM + wr * 64 + fr, col0 = u.pn * HALF + wc * 32 + 8 * fq;
#pragma unroll
        for (int ai = 0; ai < 2; ++ai)
#pragma unroll
            for (int m = 0; m < 4; ++m) { bf16_t* rowp = O + (size_t)(row0 + ai * HALF + m * 16) * ldc + col0;
                f32x4 v0, v1;
#pragma unroll
                for (int i = 0; i < 4; ++i) { v0[i] = silu_f(acc[ai][0][m][0][i]) * acc[ai][1][m][0][i]; v1[i] = silu_f(acc[ai][0][m][1][i]) * acc[ai][1][m][1][i]; }
                u32x4 w; w.x = cvt_pk_bf16(v0[0], v0[1]); w.y = cvt_pk_bf16(v0[2], v0[3]); w.z = cvt_pk_bf16(v1[0], v1[1]); w.w = cvt_pk_bf16(v1[2], v1[3]);
                *(u32x4*)rowp = w; }
    }
};
__device__ __forceinline__ float logf_gate(float x, float la, float l1) {
    const float ls = fminf(x, 0.f) - __logf(1.0f + __expf(-fabsf(x)));
    const float b = l1 + ls;
    if (la == -INFINITY) return b;
    const float mx = fmaxf(la, b), d = fabsf(la - b);
    return mx + __logf(1.0f + __expf(-d));
}
struct EpiHgrnIn {
    static constexpr bool PERM = true, AFTER_DRAIN = false;
    unsigned char* ws; int layer;
    static constexpr size_t O_PQ = 580ull << 20, O_PI = O_PQ + (128ull << 20), O_PG = O_PQ + (256ull << 20), O_LF = O_PQ + (384ull << 20), O_LA = 1ull << 20, O_L1 = O_LA + 8192;
    __device__ __forceinline__ void operator()(const f32x4 (&acc)[2][2][4][2], const Unit& u, int wr, int wc, int fr, int fq) const {
        const int quarter = u.pn >> 2;
        const int row0 = u.pm * BM + wr * 64 + fr, col0 = (u.pn & 3) * BM + wc * 32 + 8 * fq;
        if (quarter == 1) {
            const float* la = (const float*)(ws + O_LA) + layer * 1024; const float* l1 = (const float*)(ws + O_L1) + layer * 1024; float* LF = (float*)(ws + O_LF);
            f32x4 A0[2][2], A1[2][2];
#pragma unroll
            for (int bj = 0; bj < 2; ++bj)
#pragma unroll
                for (int n = 0; n < 2; ++n) { A0[bj][n] = *(const f32x4*)(la + col0 + bj * HALF + 4 * n); A1[bj][n] = *(const f32x4*)(l1 + col0 + bj * HALF + 4 * n); }
#pragma unroll
            for (int ai = 0; ai < 2; ++ai)
#pragma unroll
                for (int m = 0; m < 4; ++m) { float* rowp = LF + (size_t)(row0 + ai * HALF + m * 16) * 1024 + col0;
#pragma unroll
                    for (int bj = 0; bj < 2; ++bj)
#pragma unroll
                        for (int n = 0; n < 2; ++n) { f32x4 o;
#pragma unroll
                            for (int i = 0; i < 4; ++i) o[i] = logf_gate(acc[ai][bj][m][n][i], A0[bj][n][i], A1[bj][n][i]);
                            *(f32x4*)(rowp + bj * HALF + 4 * n) = o; } }
        } else {
            bf16_t* O = (bf16_t*)(ws + (quarter == 0 ? O_PQ : (quarter == 2 ? O_PI : O_PG)));
#pragma unroll
            for (int ai = 0; ai < 2; ++ai)
#pragma unroll
                for (int m = 0; m < 4; ++m) { bf16_t* rowp = O + (size_t)(row0 + ai * HALF + m * 16) * 1024 + col0;
#pragma unroll
                    for (int bj = 0; bj < 2; ++bj) { f32x4 v0 = acc[ai][bj][m][0], v1 = acc[ai][bj][m][1];
                        if (quarter != 2) {
#pragma unroll
                            for (int i = 0; i < 4; ++i) { v0[i] = silu_f(v0[i]); v1[i] = silu_f(v1[i]); } }
                        u32x4 w; w.x = cvt_pk_bf16(v0[0], v0[1]); w.y = cvt_pk_bf16(v0[2], v0[3]); w.z = cvt_pk_bf16(v1[0], v1[1]); w.w = cvt_pk_bf16(v1[2], v1[3]);
                        *(u32x4*)(rowp + bj * HALF) = w; } }
        }
    }
};

template <class Epi, class Sched, bool ALIGN_EPI = false, bool SP2 = false>
__device__ __forceinline__ void gemm_phase(PG8_LAS unsigned char* lds, const Gemm g, const Sched& S, const Epi& E, const int wave_id) {
    int lane_; asm volatile("v_mbcnt_lo_u32_b32 %0, -1, 0\n\tv_mbcnt_hi_u32_b32 %0, -1, %0" : "=v"(lane_));
    const int wid = wave_id, lane = lane_, tid = wid * 64 + lane, wr = wid >> 2, wc = wid & 3, fr = lane & 15, fq = lane >> 4;
    const int K = g.K, nt = K / BK, lda = g.lda;
    unsigned voffA[2], voffB[2];
#pragma unroll
    for (int i = 0; i < 2; ++i) { int R, C; stage_rc(tid * 16 + i * 8192, R, C); const int Rb = Epi::PERM ? ((R & ~31) + perm32(R & 31)) : R;
        voffA[i] = (unsigned)(R * lda + C) * 2u; voffB[i] = (unsigned)(Rb * K + C) * 2u; }
    const size_t kstep = (size_t)(BK * 2);
    const size_t hstep = (size_t)HALF * K * 2;
    const size_t tstep = 2 * hstep;
    const size_t hstepA = (size_t)HALF * lda * 2, tstepA = 2 * hstepA;
    const unsigned ldsw = (unsigned)wid * 1024u;
    const int aoff = lds_byte(wr * 64 + fr, fq * 8), boff = lds_byte(wc * 32 + fr, fq * 8);
#define PG8_SA(b, h) (((b) * 2 + (h)) * HTB)
#define PG8_SB(b, h) ((4 + (b) * 2 + (h)) * HTB)
#define PG8_STAGE(bufoff, gbase, voff) do { _Pragma("unroll") for (int _i = 0; _i < 2; ++_i) \
        __builtin_amdgcn_global_load_lds((const unsigned*)((const char*)(gbase) + (voff)[_i]), (PG8_LAS unsigned*)(lds + (bufoff) + ldsw + _i * 8192), 16, 0, 0); } while (0)
#define PG8_LDA(dst, b, h) do { _Pragma("unroll") for (int m = 0; m < 4; ++m) _Pragma("unroll") for (int k = 0; k < 2; ++k) dst[m][k] = *(const PG8_LAS bf16x8*)(lds + PG8_SA(b, h) + aoff + m * 2048 + k * 1024); } while (0)
#define PG8_LDB(dst, b, h) do { _Pragma("unroll") for (int n = 0; n < 2; ++n) _Pragma("unroll") for (int k = 0; k < 2; ++k) dst[n][k] = *(const PG8_LAS bf16x8*)(lds + PG8_SB(b, h) + boff + n * 2048 + k * 1024); } while (0)
#define PG8_MMA(ai, bj, At, Bt) do { __builtin_amdgcn_s_setprio(1); _Pragma("unroll") for (int m = 0; m < 4; ++m) _Pragma("unroll") for (int n = 0; n < 2; ++n) _Pragma("unroll") for (int k = 0; k < 2; ++k) \
        acc[ai][bj][m][n] = __builtin_amdgcn_mfma_f32_16x16x32_bf16(Bt[n][k], At[m][k], acc[ai][bj][m][n], 0, 0, 0); __builtin_amdgcn_s_setprio(0); } while (0)
#define PG8_WAIT_V(n) asm volatile("s_waitcnt vmcnt(" #n ")" ::: "memory")
#define PG8_WAIT_L(n) asm volatile("s_waitcnt lgkmcnt(" #n ")" ::: "memory")
#define PG8_BAR __builtin_amdgcn_s_barrier()
#define PG8_SCHED __builtin_amdgcn_sched_barrier(0)
    Unit cur, nxt; int ui = 0;
    if (!S.next(0, cur)) return;
    f32x4 acc[2][2][4][2];
#pragma unroll
    for (int a = 0; a < 2; ++a)
#pragma unroll
        for (int b = 0; b < 2; ++b)
#pragma unroll
            for (int m = 0; m < 4; ++m)
#pragma unroll
                for (int n = 0; n < 2; ++n) acc[a][b][m][n] = (f32x4){0.f, 0.f, 0.f, 0.f};
    bf16x8 At[4][2], B0[2][2], B1[2][2];
    const char* cA = (const char*)g.A + (size_t)cur.pm * tstepA; const char* cB = (const char*)g.Bt + (size_t)cur.e * g.estride + (size_t)cur.pn * tstep;
    S.a_ready(cur);
    if constexpr (SP2) {
        PG8_STAGE(PG8_SB(0, 0), cB, voffB); PG8_STAGE(PG8_SB(0, 1), cB + hstep, voffB); PG8_STAGE(PG8_SA(0, 0), cA, voffA); PG8_STAGE(PG8_SA(0, 1), cA + hstepA, voffA);
        if (wr == 1) PG8_BAR;
        PG8_WAIT_V(2); PG8_BAR;
        PG8_STAGE(PG8_SB(1, 0), cB + kstep, voffB); PG8_STAGE(PG8_SA(1, 0), cA + kstep, voffA); PG8_STAGE(PG8_SB(1, 1), cB + hstep + kstep, voffB);
        PG8_WAIT_V(6); PG8_BAR;
    } else {
        PG8_STAGE(PG8_SB(0, 0), cB, voffB); PG8_STAGE(PG8_SA(0, 0), cA, voffA); PG8_STAGE(PG8_SB(0, 1), cB + hstep, voffB); PG8_STAGE(PG8_SA(0, 1), cA + hstepA, voffA);
        if (wr == 1) PG8_BAR;
        PG8_WAIT_V(4); PG8_BAR;
        PG8_STAGE(PG8_SB(1, 0), cB + kstep, voffB); PG8_STAGE(PG8_SA(1, 0), cA + kstep, voffA); PG8_STAGE(PG8_SB(1, 1), cB + hstep + kstep, voffB);
        PG8_WAIT_V(6); PG8_BAR;
    }
    for (;;) {
        const bool has_next = S.next(ui + 1, nxt);
        const char* nA = has_next ? (const char*)g.A + (size_t)nxt.pm * tstepA : cA; const char* nB = has_next ? (const char*)g.Bt + (size_t)nxt.e * g.estride + (size_t)nxt.pn * tstep : cB;
        for (int t = 0; t < nt; t += 2) {
            const bool last = (t == nt - 2);
            const char* a1 = cA + (size_t)(t + 1) * kstep;
            const char* a2 = last ? nA : cA + (size_t)(t + 2) * kstep; const char* b2 = last ? nB : cB + (size_t)(t + 2) * kstep;
            const char* a3 = a2 + kstep; const char* b3 = b2 + kstep;
            if (last && has_next) S.a_ready(nxt);
            if constexpr (SP2) {
            PG8_LDB(B0, 0, 0); PG8_LDB(B1, 0, 1); PG8_SCHED; PG8_LDA(At, 0, 0); PG8_STAGE(PG8_SA(1, 1), a1 + hstepA, voffA);
            PG8_WAIT_V(8); PG8_WAIT_L(0); PG8_BAR; PG8_MMA(0, 0, At, B0); PG8_MMA(0, 1, At, B1); PG8_BAR; PG8_SCHED;
            PG8_LDA(At, 0, 1); PG8_STAGE(PG8_SB(0, 0), b2, voffB); PG8_STAGE(PG8_SB(0, 1), b2 + hstep, voffB); PG8_STAGE(PG8_SA(0, 0), a2, voffA);
            PG8_WAIT_V(8); PG8_WAIT_L(0); PG8_BAR; PG8_MMA(1, 0, At, B0); PG8_MMA(1, 1, At, B1); PG8_BAR; PG8_SCHED;
            PG8_LDB(B0, 1, 0); PG8_LDB(B1, 1, 1); PG8_SCHED; PG8_LDA(At, 1, 0); PG8_STAGE(PG8_SA(0, 1), a2 + hstepA, voffA);
            PG8_WAIT_V(8); PG8_WAIT_L(0); PG8_BAR; PG8_MMA(0, 0, At, B0); PG8_MMA(0, 1, At, B1); PG8_BAR; PG8_SCHED;
            PG8_LDA(At, 1, 1); PG8_STAGE(PG8_SB(1, 0), b3, voffB); PG8_STAGE(PG8_SB(1, 1), b3 + hstep, voffB); PG8_STAGE(PG8_SA(1, 0), a3, voffA);
            PG8_WAIT_V(8); PG8_WAIT_L(0); PG8_BAR; PG8_MMA(1, 0, At, B0); PG8_MMA(1, 1, At, B1); PG8_BAR; PG8_SCHED;
            } else {
            PG8_LDB(B0, 0, 0); PG8_SCHED; PG8_LDA(At, 0, 0); PG8_STAGE(PG8_SA(1, 1), a1 + hstepA, voffA);
            PG8_WAIT_L(8); PG8_BAR; PG8_WAIT_L(0); PG8_MMA(0, 0, At, B0); PG8_BAR; PG8_SCHED;
            PG8_LDB(B1, 0, 1); PG8_STAGE(PG8_SB(0, 0), b2, voffB);
            PG8_BAR; PG8_WAIT_L(0); PG8_MMA(0, 1, At, B1); PG8_BAR;
            PG8_LDA(At, 0, 1); PG8_STAGE(PG8_SA(0, 0), a2, voffA);
            PG8_BAR; PG8_WAIT_L(0); PG8_MMA(1, 0, At, B0); PG8_BAR; PG8_SCHED;
            PG8_STAGE(PG8_SB(0, 1), b2 + hstep, voffB);
            PG8_WAIT_V(6); PG8_BAR; PG8_MMA(1, 1, At, B1); PG8_BAR;
            PG8_LDB(B0, 1, 0); PG8_SCHED; PG8_LDA(At, 1, 0); PG8_STAGE(PG8_SA(0, 1), a2 + hstepA, voffA);
            PG8_WAIT_L(8); PG8_BAR; PG8_WAIT_L(0); PG8_MMA(0, 0, At, B0); PG8_BAR; PG8_SCHED;
            PG8_LDB(B1, 1, 1); PG8_STAGE(PG8_SB(1, 0), b3, voffB);
            PG8_BAR; PG8_WAIT_L(0); PG8_MMA(0, 1, At, B1); PG8_BAR;
            PG8_LDA(At, 1, 1); PG8_STAGE(PG8_SA(1, 0), a3, voffA);
            PG8_BAR; PG8_WAIT_L(0); PG8_MMA(1, 0, At, B0); PG8_BAR; PG8_SCHED;
            PG8_STAGE(PG8_SB(1, 1), b3 + hstep, voffB);
            PG8_WAIT_V(6); PG8_BAR; PG8_MMA(1, 1, At, B1); PG8_BAR;
            }
        }
        if constexpr (ALIGN_EPI) { if (wr == 0) PG8_BAR; }
        if constexpr (!Epi::AFTER_DRAIN) { E(acc, cur, wr, wc, fr, fq); S.done(cur); }
        if (!has_next) break;
#pragma unroll
        for (int a = 0; a < 2; ++a)
#pragma unroll
            for (int b = 0; b < 2; ++b)
#pragma unroll
                for (int m = 0; m < 4; ++m)
#pragma unroll
                    for (int n = 0; n < 2; ++n) acc[a][b][m][n] = (f32x4){0.f, 0.f, 0.f, 0.f};
        cur = nxt; cA = nA; cB = nB; ++ui;
        if constexpr (ALIGN_EPI) { if (wr == 1) PG8_BAR; }
    }
    PG8_WAIT_V(0);
    if constexpr (!ALIGN_EPI) { if (wr == 0) PG8_BAR; }
    PG8_BAR;
    if constexpr (Epi::AFTER_DRAIN) { E.fused(acc, cur, wr, wc, fr, fq, lds, wid, lane); S.done(cur); }
#undef PG8_SA
#undef PG8_SB
#undef PG8_STAGE
#undef PG8_LDA
#undef PG8_LDB
#undef PG8_MMA
#undef PG8_WAIT_V
#undef PG8_WAIT_L
#undef PG8_BAR
#undef PG8_SCHED
}
}

constexpr int NT = 65536, DM = 1024, NBATCH = 32, SEQ = 2048;
constexpr int DFF = 2816, DFE = 3584, NEXP = 8;
constexpr int MOE_ROWS = 133120;
constexpr float EPS = 1e-6f;
constexpr size_t MiB = 1u << 20;
constexpr size_t WS_CTL = 0, CTL_ZERO_BYTES = 1 * MiB;
constexpr size_t WS_LA = 1 * MiB;
constexpr size_t WS_L1 = WS_LA + 8192;
constexpr size_t WS_CB = WS_LA + 16384;
constexpr size_t WS_RCNT = WS_LA + 32768;
constexpr size_t WS_RTAB = WS_LA + 65536;
constexpr size_t WS_ROUTE = 2 * MiB;
constexpr size_t WS_SLOT = 3 * MiB;
constexpr size_t WS_SELM = 4 * MiB;
constexpr size_t WS_GATES = 8 * MiB;
constexpr size_t WS_KC = 20 * MiB;
constexpr size_t WS_VCT = 22 * MiB;
constexpr size_t WS_HC = 24 * MiB;
constexpr size_t WS_W = 48 * MiB;
constexpr size_t W_HIN = WS_W, W_HOUT = WS_W + 16 * MiB, W_KVQ = WS_W + 20 * MiB, W_Q3 = WS_W + 26 * MiB, W_CMP1 = WS_W + 29 * MiB, W_NOUT = WS_W + 31 * MiB,
                 W_FGU = WS_W + 35 * MiB, W_FDN = WS_W + 57 * MiB, W_MGU = WS_W + 68 * MiB, W_MDN = WS_W + 292 * MiB;
constexpr size_t WS_XN = 452 * MiB;
constexpr size_t WS_R = 580 * MiB;
constexpr size_t R_PQ = WS_R, R_PI = WS_R + 128 * MiB, R_PG = WS_R + 256 * MiB, R_LF = WS_R + 384 * MiB, R_O2 = WS_R + 640 * MiB;
constexpr size_t R_HF = WS_R + 256 * MiB;
constexpr size_t R_KS = WS_R, R_KW = WS_R + 32 * MiB, R_VST = WS_R + 64 * MiB, R_VWT = WS_R + 96 * MiB, R_KCR = WS_R + 128 * MiB, R_VCR = WS_R + 160 * MiB;
constexpr size_t R_QKV = WS_R + 256 * MiB;
constexpr size_t R_Q = WS_R + 608 * MiB, R_O = WS_R + 736 * MiB;
constexpr size_t R_XP = WS_R, R_HM = WS_R + 260 * MiB;
constexpr size_t WS_NEED = R_HM + (size_t)MOE_ROWS * DFE * 2;
static_assert(WS_NEED <= 1792 * MiB, "workspace map");
static_assert(W_MDN + 112 * MiB <= WS_XN, "weights map");
static_assert(pg8::EpiHgrnIn::O_PQ == R_PQ && pg8::EpiHgrnIn::O_PI == R_PI && pg8::EpiHgrnIn::O_PG == R_PG && pg8::EpiHgrnIn::O_LF == R_LF && pg8::EpiHgrnIn::O_LA == WS_LA && pg8::EpiHgrnIn::O_L1 == WS_L1, "EpiHgrnIn offsets");

constexpr int LDS_BYTES = 147456;
constexpr int MISC_OFF = 131072 + 320;
constexpr int NWAVES = 8;

#define GAS __attribute__((address_space(1)))
#define LAS __attribute__((address_space(3)))
typedef unsigned short bf16;
typedef unsigned v4u __attribute__((ext_vector_type(4)));
typedef unsigned v2u __attribute__((ext_vector_type(2)));
typedef float f32x4 __attribute__((ext_vector_type(4)));
#define LDS_WAIT() asm volatile("s_waitcnt lgkmcnt(0)" ::: "memory")
__device__ __forceinline__ unsigned f2bf(float f) { unsigned u = __builtin_bit_cast(unsigned, f); return (u + 0x7fffu + ((u >> 16) & 1u)) >> 16; }
__device__ __forceinline__ unsigned pk2(float lo, float hi) { return f2bf(lo) | (f2bf(hi) << 16); }
__device__ __forceinline__ float bf2f(unsigned b) { return __builtin_bit_cast(float, b << 16); }
__device__ __forceinline__ float bflo(unsigned w) { return __builtin_bit_cast(float, w << 16); }
__device__ __forceinline__ float bfhi(unsigned w) { return __builtin_bit_cast(float, w & 0xffff0000u); }
__device__ __forceinline__ float wave_sum(float v) {
#pragma unroll
    for (int o = 32; o >= 1; o >>= 1) v += __shfl_xor(v, o);
    return v;
}
__device__ __forceinline__ float wave_max(float v) {
#pragma unroll
    for (int o = 32; o >= 1; o >>= 1) v = fmaxf(v, __shfl_xor(v, o));
    return v;
}

#define XB_TMO      128
#define XB_XCNT(j)  (256  + 64 * (j))
#define XB_XSUB(j)  (1280 + 64 * (j))
#define XB_XGEN(j)  (2304 + 64 * (j))
#define XB_TOP      3328
#define XB_TOPGEN   3392
#define XCD_BAR_WORDS 3456
#define XB_SPIN_CAP (1u << 22)
__device__ __forceinline__ unsigned xb_ld(unsigned* p)              { return __hip_atomic_load(p, __ATOMIC_RELAXED, __HIP_MEMORY_SCOPE_AGENT); }
__device__ __forceinline__ unsigned xb_add(unsigned* p, unsigned v) { return __hip_atomic_fetch_add(p, v, __ATOMIC_RELAXED, __HIP_MEMORY_SCOPE_AGENT); }
__device__ __forceinline__ unsigned xb_xcc_id() { return (unsigned)__builtin_amdgcn_s_getreg((3 << 11) | 20) & 0xFu; }
#define XB_SPIN(cond, bar) do { unsigned _sp = 0; while (cond) { __builtin_amdgcn_s_sleep(1); \
    if ((++_sp & 255u) == 0u) { if (xb_ld(&(bar)[XB_TMO])) break; if (_sp > XB_SPIN_CAP) { atomicAdd(&(bar)[XB_TMO], 1u); break; } } } } while (0)
struct XcdBarrier { unsigned* bar; unsigned x; volatile LAS unsigned* st; };
__device__ __forceinline__ XcdBarrier xcd_barrier_post(unsigned* bar, volatile LAS unsigned* st) {
    XcdBarrier b; b.bar = bar; b.x = xb_xcc_id(); b.st = st;
    if (threadIdx.x == 0) (void)xb_add(&bar[XB_XCNT(b.x)], 1u);
    return b;
}
__device__ __forceinline__ void xcd_barrier_complete(unsigned* bar, unsigned x, unsigned& nloc, unsigned& nx) {
    const unsigned G = gridDim.x * gridDim.y * gridDim.z;
    unsigned sum, cnt, mine, sp = 0u;
    for (;;) {
        sum = 0u; cnt = 0u; mine = 0u;
#pragma unroll
        for (unsigned j = 0; j < 16; ++j) { const unsigned c = xb_ld(&bar[XB_XCNT(j)]); sum += c; cnt += (c > 0u) ? 1u : 0u; mine = (j == x) ? c : mine; }
        if (sum == G) break;
        __builtin_amdgcn_s_sleep(1);
        if ((++sp & 255u) == 0u) { if (xb_ld(&bar[XB_TMO])) break; if (sp > XB_SPIN_CAP) { atomicAdd(&bar[XB_TMO], 1u); break; } }
    }
    nloc = mine > 0u ? mine : 1u; nx = cnt > 0u ? cnt : 1u;
}
__device__ __forceinline__ void xcd_barrier(const XcdBarrier& b) {
    asm volatile("s_waitcnt vmcnt(0)" ::: "memory");
    __syncthreads();
    if (threadIdx.x == 0) {
        unsigned* bar = b.bar; unsigned bx_ = b.x; asm volatile("" : "+s"(bar), "+s"(bx_));
        __builtin_amdgcn_s_waitcnt(0);
        unsigned nloc = b.st[0], nx = b.st[1];
        if (nloc == 0u) { xcd_barrier_complete(bar, bx_, nloc, nx); b.st[0] = nloc; b.st[1] = nx; }
        const unsigned old = xb_add(&bar[XB_XSUB(bx_)], 1u);
        const unsigned gen = old / nloc;
        if (old + 1u == (gen + 1u) * nloc) {
            __builtin_amdgcn_fence(__ATOMIC_RELEASE, "agent");
            asm volatile("s_waitcnt vmcnt(0)" ::: "memory");
            const unsigned og = xb_add(&bar[XB_TOP], 1u);
            const unsigned tg = og / nx;
            if (og + 1u == (tg + 1u) * nx) xb_add(&bar[XB_TOPGEN], 1u);
            else XB_SPIN(xb_ld(&bar[XB_TOPGEN]) == tg, bar);
            __builtin_amdgcn_fence(__ATOMIC_ACQUIRE, "agent");
            xb_add(&bar[XB_XGEN(bx_)], 1u);
            asm volatile("s_waitcnt vmcnt(0)" ::: "memory");
        } else {
            XB_SPIN(xb_ld(&bar[XB_XGEN(bx_)]) == gen, bar);
            __builtin_amdgcn_fence(__ATOMIC_ACQUIRE, "agent");
            asm volatile("s_waitcnt vmcnt(0)" ::: "memory");
        }
    }
    __syncthreads();
}

struct Ctx {
    LAS unsigned char* lds;
    int tid, lane, wave, G, bid;
    float* out; unsigned char* ws;
    __device__ __forceinline__ const float* inp(int i) const {
        const __attribute__((address_space(4))) unsigned char* kp = (const __attribute__((address_space(4))) unsigned char*)__builtin_amdgcn_kernarg_segment_ptr();
        asm volatile("" : "+s"(kp));
        return ((const float* const __attribute__((address_space(4)))*)kp)[i];
    }
};
enum { I_X = 0, I_NMIX, I_NFFN, I_HWIN, I_HWOUT, I_HGN, I_HLB, I_KVN, I_KVW, I_CPK, I_CW1K, I_CW2K, I_CPV, I_CW1V, I_CW2V, I_KN, I_NWIN, I_NWOUT, I_NQN, I_FGU, I_FDN, I_MR, I_MGU, I_MDN };

constexpr int MAXJOB = 64;
struct JobTab { unsigned long long src[MAXJOB], gain[MAXJOB], dst[MAXJOB]; int K[MAXJOB], Nsrc[MAXJOB], npb[MAXJOB], F[MAXJOB], rowoff[MAXJOB], istart[MAXJOB + 1]; int njobs; };
__device__ __forceinline__ void add_job(LAS JobTab* J, const float* src, const float* gain, bf16* dst, int K, int Nsrc, int Npad, int F, int rowoff) {
    const int j = J->njobs; J->src[j] = (unsigned long long)src; J->gain[j] = (unsigned long long)gain; J->dst[j] = (unsigned long long)dst;
    J->K[j] = K; J->Nsrc[j] = Nsrc; J->npb[j] = Npad / 32; J->F[j] = F; J->rowoff[j] = rowoff; J->istart[j + 1] = J->istart[j] + (K / 64) * (Npad / 32); J->njobs = j + 1;
}
__device__ __forceinline__ void transpose_item(const float* W, int K, int Nsrc, const float* gain, bf16* WT, int dstrow0, int k0, int n0, LAS float* scr, int lane) {
    const int n = n0 + (lane & 31); const bool okn = n < Nsrc;
#pragma unroll 8
    for (int i = 0; i < 32; ++i) { const int kk = 2 * i + (lane >> 5); float v = okn ? W[(size_t)(k0 + kk) * Nsrc + n] : 0.f; if (gain) v *= gain[k0 + kk]; scr[kk * 33 + (lane & 31)] = v; }
    LDS_WAIT();
    const int c = lane & 7;
#pragma unroll
    for (int j = 0; j < 4; ++j) { const int nn = (lane >> 3) + 8 * j; const LAS float* s = scr + (8 * c) * 33 + nn;
        v4u o; o.x = pk2(s[0 * 33], s[1 * 33]); o.y = pk2(s[2 * 33], s[3 * 33]); o.z = pk2(s[4 * 33], s[5 * 33]); o.w = pk2(s[6 * 33], s[7 * 33]);
        *(v4u*)(WT + (size_t)(dstrow0 + nn) * K + k0 + 8 * c) = o; }
    LDS_WAIT();
}
__device__ __forceinline__ void norm_row_store(const f32x4 (&v)[4], bf16* orow, int lane) {
    float s = 0.f;
#pragma unroll
    for (int j = 0; j < 4; ++j) s += (v[j].x * v[j].x + v[j].y * v[j].y) + (v[j].z * v[j].z + v[j].w * v[j].w);
    const float rstd = rsqrtf(wave_sum(s) * (1.f / DM) + EPS);
    v2u* o8 = (v2u*)orow + lane;
#pragma unroll
    for (int j = 0; j < 4; ++j) { v2u w; w.x = pk2(v[j].x * rstd, v[j].y * rstd); w.y = pk2(v[j].z * rstd, v[j].w * rstd); o8[64 * j] = w; }
}
__device__ __forceinline__ void p_prologue(Ctx& C) {
    LAS JobTab* J = (LAS JobTab*)(C.lds + 69632);
    unsigned char* ws = C.ws;
    if (C.tid == 0) {
        J->njobs = 0; J->istart[0] = 0;
        for (int l = 0; l < 2; ++l) add_job(J, C.inp(I_HWIN) + (size_t)l * 1024 * 4096, C.inp(I_NMIX) + l * 1024, (bf16*)(ws + W_HIN) + (size_t)l * 4096 * 1024, 1024, 4096, 4096, 0, 0);
        for (int l = 0; l < 2; ++l) add_job(J, C.inp(I_HWOUT) + (size_t)l * 1024 * 1024, nullptr, (bf16*)(ws + W_HOUT) + (size_t)l * 1024 * 1024, 1024, 1024, 1024, 0, 0);
        add_job(J, C.inp(I_KVW), C.inp(I_KVN), (bf16*)(ws + W_KVQ), 1024, 1536, 1536, 0, 0);
        add_job(J, C.inp(I_NWIN), C.inp(I_NMIX) + 2048, (bf16*)(ws + W_KVQ), 1024, 1072, 1280, 0, 1536);
        add_job(J, C.inp(I_NWIN) + (size_t)1024 * 1072, C.inp(I_NMIX) + 3072, (bf16*)(ws + W_Q3), 1024, 1072, 1280, 0, 0);
        add_job(J, C.inp(I_CW1K), nullptr, (bf16*)(ws + W_CMP1), 2048, 256, 256, 0, 0);
        add_job(J, C.inp(I_CW1V), nullptr, (bf16*)(ws + W_CMP1) + (size_t)256 * 2048, 2048, 256, 256, 0, 0);
        for (int l = 0; l < 2; ++l) add_job(J, C.inp(I_NWOUT) + (size_t)l * 1024 * 1024, nullptr, (bf16*)(ws + W_NOUT) + (size_t)l * 1024 * 1024, 1024, 1024, 1024, 0, 0);
        for (int l = 0; l < 2; ++l) add_job(J, C.inp(I_FGU) + (size_t)l * 1024 * 2 * DFF, C.inp(I_NFFN) + (2 * l) * 1024, (bf16*)(ws + W_FGU) + (size_t)l * 2 * DFF * 1024, 1024, 2 * DFF, 2 * DFF, DFF, 0);
        for (int l = 0; l < 2; ++l) add_job(J, C.inp(I_FDN) + (size_t)l * DFF * 1024, nullptr, (bf16*)(ws + W_FDN) + (size_t)l * 1024 * DFF, DFF, 1024, 1024, 0, 0);
        for (int l = 0; l < 16; ++l) add_job(J, C.inp(I_MGU) + (size_t)l * 1024 * 2 * DFE, C.inp(I_NFFN) + (2 * (l >> 3) + 1) * 1024, (bf16*)(ws + W_MGU) + (size_t)l * 2 * DFE * 1024, 1024, 2 * DFE, 2 * DFE, DFE, 0);
        for (int l = 0; l < 16; ++l) add_job(J, C.inp(I_MDN) + (size_t)l * DFE * 1024, nullptr, (bf16*)(ws + W_MDN) + (size_t)l * 1024 * DFE, DFE, 1024, 1024, 0, 0);
    }
    __syncthreads();
    LAS float* scr = (LAS float*)(C.lds + C.wave * 8704);
    const int gw = C.bid * NWAVES + C.wave, NGW = C.G * NWAVES;
    const int nj = J->njobs, total = J->istart[nj];
    for (int it = gw; it < total; it += NGW) {
        int j = 0; while (j + 1 < nj && J->istart[j + 1] <= it) ++j;
        const int r = it - J->istart[j], npb = J->npb[j], kb = r / npb, nb = r % npb, n0 = 32 * nb, F = J->F[j];
        int drow = J->rowoff[j] + n0;
        if (F) drow = (n0 < F) ? 256 * (n0 / 128) + (n0 % 128) : 256 * ((n0 - F) / 128) + 128 + ((n0 - F) % 128);
        transpose_item((const float*)J->src[j], J->K[j], J->Nsrc[j], (const float*)J->gain[j], (bf16*)J->dst[j], drow, 64 * kb, n0, scr, C.lane);
    }
    { const int gt = C.bid * 512 + C.tid;
      if (gt < 1024) { const float a0 = C.inp(I_HLB)[gt], a1 = C.inp(I_HLB)[1024 + gt]; const float mx = fmaxf(a0, a1), e0 = expf(a0 - mx), e1 = expf(a1 - mx), s = e0 + e1;
          const float s0 = e0 / s, s1 = e1 / s, lb1 = (s0 + s1) - s0;
          float* la = (float*)(ws + WS_LA); float* l1 = (float*)(ws + WS_L1);
          la[gt] = -INFINITY; l1[gt] = 0.f; la[1024 + gt] = logf(lb1); l1[1024 + gt] = log1pf(-lb1); } }
    if (C.bid == 0 && C.tid < 128) ((int*)(ws + WS_RTAB))[2048 + C.tid] = C.tid >> 6;
    if (C.bid == (C.G > 1 ? 1 : 0)) { const int which = C.tid >> 8, j = C.tid & 255; const float* pos = C.inp(which ? I_CPV : I_CPK); const float* w1 = C.inp(which ? I_CW1V : I_CW1K);
        float a = 0.f; for (int i = 0; i < 2048; ++i) a += pos[i] * w1[(size_t)i * 256 + j];
        ((float*)(ws + WS_CB))[which * 256 + j] = a; }
    for (int c = C.bid; c < 256; c += C.G)
        for (int i = 0; i < 32; ++i) { const int row = c * 256 + C.wave * 32 + i; const f32x4* xr = (const f32x4*)(C.inp(I_X) + (size_t)row * DM) + C.lane; f32x4 v[4];
#pragma unroll
            for (int j = 0; j < 4; ++j) v[j] = xr[64 * j];
            norm_row_store(v, (bf16*)(ws + WS_XN) + (size_t)row * DM, C.lane); }
}

template <bool MOE_ADD, bool ROUTER, bool WRITE_XN>
__device__ __forceinline__ void p_norm(Ctx& C, const float* rw, const float* rgain) {
    unsigned char* ws = C.ws;
    LAS int* cnt8 = (LAS int*)(C.lds + 1024);
    const bf16* Y = (const bf16*)(ws + R_XP);
    const int4* route = (const int4*)(ws + WS_ROUTE); const int2* slot = (const int2*)(ws + WS_SLOT);
    for (int c = C.bid; c < 256; c += C.G) {
        if (ROUTER) { __syncthreads(); if (C.tid < 8) cnt8[C.tid] = 0; __syncthreads(); }
        for (int i = 0; i < 32; ++i) {
            const int row = c * 256 + C.wave * 32 + i;
            float* hr = C.out + (size_t)row * DM; f32x4 v[4];
#pragma unroll
            for (int j = 0; j < 4; ++j) v[j] = ((const f32x4*)hr + C.lane)[64 * j];
            if (MOE_ADD) {
                const int4 rt = route[row]; const int2 sl = slot[row]; const float w0 = __builtin_bit_cast(float, rt.y), w1 = __builtin_bit_cast(float, rt.z);
                const v2u* y0 = (const v2u*)(Y + (size_t)sl.x * DM) + C.lane; const v2u* y1 = (const v2u*)(Y + (size_t)sl.y * DM) + C.lane;
#pragma unroll
                for (int j = 0; j < 4; ++j) { const v2u a = y0[64 * j], b = y1[64 * j];
                    v[j].x += w0 * bflo(a.x) + w1 * bflo(b.x); v[j].y += w0 * bfhi(a.x) + w1 * bfhi(b.x); v[j].z += w0 * bflo(a.y) + w1 * bflo(b.y); v[j].w += w0 * bfhi(a.y) + w1 * bfhi(b.y);
                    ((f32x4*)hr + C.lane)[64 * j] = v[j]; }
            }
            if (WRITE_XN || ROUTER) {
                float s = 0.f;
#pragma unroll
                for (int j = 0; j < 4; ++j) s += (v[j].x * v[j].x + v[j].y * v[j].y) + (v[j].z * v[j].z + v[j].w * v[j].w);
                const float rstd = rsqrtf(wave_sum(s) * (1.f / DM) + EPS);
                if (WRITE_XN) { v2u* o8 = (v2u*)((bf16*)(ws + WS_XN) + (size_t)row * DM) + C.lane;
#pragma unroll
                    for (int j = 0; j < 4; ++j) { v2u w; w.x = pk2(v[j].x * rstd, v[j].y * rstd); w.y = pk2(v[j].z * rstd, v[j].w * rstd); o8[64 * j] = w; } }
                if (ROUTER) {
                    float lg[8];
#pragma unroll
                    for (int e = 0; e < 8; ++e) lg[e] = 0.f;
#pragma unroll
                    for (int j = 0; j < 4; ++j) { const int k0 = 4 * C.lane + 256 * j; const f32x4 g4 = *(const f32x4*)(rgain + k0);
#pragma unroll
                        for (int q = 0; q < 4; ++q) { const float xv = v[j][q] * rstd * g4[q]; const f32x4 wa = *(const f32x4*)(rw + (size_t)(k0 + q) * 8), wb = *(const f32x4*)(rw + (size_t)(k0 + q) * 8 + 4);
                            lg[0] += xv * wa.x; lg[1] += xv * wa.y; lg[2] += xv * wa.z; lg[3] += xv * wa.w; lg[4] += xv * wb.x; lg[5] += xv * wb.y; lg[6] += xv * wb.z; lg[7] += xv * wb.w; } }
#pragma unroll
                    for (int e = 0; e < 8; ++e) lg[e] = wave_sum(lg[e]);
                    int e0 = 0; float v0 = lg[0];
#pragma unroll
                    for (int e = 1; e < 8; ++e) if (lg[e] > v0) { v0 = lg[e]; e0 = e; }
                    int e1 = -1; float v1 = -INFINITY;
#pragma unroll
                    for (int e = 0; e < 8; ++e) if (e != e0 && (e1 < 0 || lg[e] > v1)) { v1 = lg[e]; e1 = e; }
                    const float ex = expf(v1 - v0), w0 = 1.f / (1.f + ex), w1 = ex / (1.f + ex);
                    if (C.lane == 0) { ((int4*)(ws + WS_ROUTE))[row] = make_int4(e0 | (e1 << 8), __builtin_bit_cast(int, w0), __builtin_bit_cast(int, w1), 0);
                        atomicAdd((int*)&cnt8[e0], 1); atomicAdd((int*)&cnt8[e1], 1); }
                }
            }
        }
        if (ROUTER) { __syncthreads(); if (C.tid < 8) ((int*)(ws + WS_RCNT))[c * 8 + C.tid] = cnt8[C.tid]; }
    }
}

__device__ __forceinline__ void p_gather(Ctx& C) {
    unsigned char* ws = C.ws;
    LAS int* tot = (LAS int*)(C.lds + 0);
    LAS int* pre = tot + 8;
    LAS int* base = tot + 16;
    LAS int* ee = tot + 32;
    LAS int* sl = tot + 32 + 256;
    const int* rcnt = (const int*)(ws + WS_RCNT);
    const int4* route = (const int4*)(ws + WS_ROUTE);
    for (int c = C.bid; c < 256; c += C.G) {
        __syncthreads();
        { const int e = C.wave; int t = 0, p = 0;
          for (int i = C.lane; i < 256; i += 64) { const int v = rcnt[i * 8 + e]; t += v; if (i < c) p += v; }
#pragma unroll
          for (int o = 32; o >= 1; o >>= 1) { t += __shfl_xor(t, o); p += __shfl_xor(p, o); }
          if (C.lane == 0) { tot[e] = t; pre[e] = p; } }
        if (C.tid < 256) ee[C.tid] = route[c * 256 + C.tid].x;
        __syncthreads();
        if (C.tid == 0) { int off = 0; for (int e = 0; e < 8; ++e) { base[e] = off + pre[e]; const int nt = (tot[e] + 255) >> 8;
                if (c == 0) { int* te = (int*)(ws + WS_RTAB); for (int q = 0; q < nt; ++q) te[(off >> 8) + q] = e; }
                off += nt << 8; }
            if (c == 0) ((int*)(ws + WS_RTAB))[1024] = off >> 8; }
        __syncthreads();
        if (C.tid < 8) { const int e = C.tid; int r = base[e];
            for (int i = 0; i < 256; ++i) { const int pk = ee[i]; if ((pk & 255) == e) sl[2 * i] = r++; if ((pk >> 8) == e) sl[2 * i + 1] = r++; } }
        __syncthreads();
        if (C.tid < 256) ((int2*)(ws + WS_SLOT))[c * 256 + C.tid] = make_int2(sl[2 * C.tid], sl[2 * C.tid + 1]);
        for (int i = 0; i < 32; ++i) { const int tl = C.wave * 32 + i, row = c * 256 + tl;
            const v4u* src = (const v4u*)((const bf16*)(ws + WS_XN) + (size_t)row * DM) + C.lane; const v4u a = src[0], b = src[64];
            v4u* d0 = (v4u*)((bf16*)(ws + R_XP) + (size_t)sl[2 * tl] * DM) + C.lane; v4u* d1 = (v4u*)((bf16*)(ws + R_XP) + (size_t)sl[2 * tl + 1] * DM) + C.lane;
            d0[0] = a; d0[64] = b; d1[0] = a; d1[64] = b; }
    }
}

__device__ __forceinline__ void p_post(Ctx& C, int has_kv, int ld, int j_layer) {
    unsigned char* ws = C.ws;
    const bf16* raw = (const bf16*)(ws + R_QKV);
    const float* kn = C.inp(I_KN); const float* qn = C.inp(I_NQN) + j_layer * 64;
    const int l = C.lane;
    for (int c = C.bid; c < 256; c += C.G)
        for (int i = 0; i < 32; ++i) {
            const int row = c * 256 + C.wave * 32 + i, b = row >> 11, t = row & 2047;
            const bf16* rr = raw + (size_t)row * ld;
            if (has_kv) {
#pragma unroll
                for (int g = 0; g < 4; ++g) {
                    const size_t tok = ((size_t)(b * 4 + g) * SEQ + t) * 64 + l, tr = (((size_t)(b * 4 + g) * 64 + (t >> 5)) * 64 + l) * 32 + (t & 31);
                    ((bf16*)(ws + R_KCR))[tok] = rr[0 * 256 + g * 64 + l];
                    ((bf16*)(ws + R_VCR))[tok] = rr[1 * 256 + g * 64 + l];
                    { const float x = bf2f(rr[2 * 256 + g * 64 + l]); const float rs = rsqrtf(wave_sum(x * x) * (1.f / 64.f) + EPS); ((bf16*)(ws + R_KS))[tok] = (bf16)f2bf(x * rs * kn[64 + l]); }
                    ((bf16*)(ws + R_VST))[tr] = rr[3 * 256 + g * 64 + l];
                    { const float x = bf2f(rr[4 * 256 + g * 64 + l]); const float rs = rsqrtf(wave_sum(x * x) * (1.f / 64.f) + EPS); ((bf16*)(ws + R_KW))[tok] = (bf16)f2bf(x * rs * kn[128 + l]); }
                    ((bf16*)(ws + R_VWT))[tr] = rr[5 * 256 + g * 64 + l];
                }
            }
            const int qo = has_kv ? 1536 : 0;
#pragma unroll 4
            for (int h = 0; h < 16; ++h) { const float x = bf2f(rr[qo + h * 64 + l]); const float rs = rsqrtf(wave_sum(x * x) * (1.f / 64.f) + EPS);
                ((bf16*)(ws + R_Q))[(size_t)row * DM + h * 64 + l] = (bf16)f2bf(x * rs * qn[l] * (0.125f * 1.4426950408889634f)); }
            if (l < 48) { const float x = bf2f(rr[qo + 1024 + l]); ((float*)(ws + WS_GATES))[(size_t)row * 48 + l] = 1.f / (1.f + expf(-x)); }
        }
}

__device__ __forceinline__ void p_cmp2(Ctx& C) {
    unsigned char* ws = C.ws;
    const bf16* Hk = (const bf16*)(ws + WS_HC); const bf16* Hv = Hk + (size_t)16384 * 256;
    const float* w2k = C.inp(I_CW2K); const float* w2v = C.inp(I_CW2V); const float* kn = C.inp(I_KN);
    LAS float* hk = (LAS float*)(C.lds + C.wave * 2048); LAS float* hv = hk + 256;
    const int l = C.lane, gw = C.bid * NWAVES + C.wave, NGW = C.G * NWAVES;
    for (int r = gw; r < 16384; r += NGW) {
        const int bg = r >> 7, c = r & 127;
        { const v2u a = *((const v2u*)(Hk + (size_t)r * 256) + l), bq = *((const v2u*)(Hv + (size_t)r * 256) + l);
          hk[4 * l] = bflo(a.x); hk[4 * l + 1] = bfhi(a.x); hk[4 * l + 2] = bflo(a.y); hk[4 * l + 3] = bfhi(a.y);
          hv[4 * l] = bflo(bq.x); hv[4 * l + 1] = bfhi(bq.x); hv[4 * l + 2] = bflo(bq.y); hv[4 * l + 3] = bfhi(bq.y); }
        LDS_WAIT();
        float ak = 0.f, av = 0.f;
#pragma unroll 8
        for (int j = 0; j < 256; ++j) { ak += hk[j] * w2k[j * 64 + l]; av += hv[j] * w2v[j * 64 + l]; }
        if (c == 127) { ak = 0.f; av = 0.f; }
        const float rs = rsqrtf(wave_sum(ak * ak) * (1.f / 64.f) + EPS);
        ((bf16*)(ws + WS_KC))[(size_t)r * 64 + l] = (bf16)f2bf(ak * rs * kn[l]);
        ((bf16*)(ws + WS_VCT))[(((size_t)bg * 4 + (c >> 5)) * 64 + l) * 32 + (c & 31)] = (bf16)f2bf(av);
        LDS_WAIT();
    }
}

typedef short bf16x8v __attribute__((ext_vector_type(8)));
#define MFMA16(a, b, c) __builtin_amdgcn_mfma_f32_16x16x32_bf16((a), (b), (c), 0, 0, 0)
constexpr float LOG2E = 1.4426950408889634f;
template <int MODE>
__device__ __forceinline__ void attn_step(const bf16* __restrict__ Kb, const bf16* __restrict__ Vb, unsigned koff, unsigned voff, int k0, int trel, bool tokok, int cmax,
                                          const bf16x8v (&qf)[2][2], float (&m)[2], float (&ls)[2], f32x4 (&o)[2][4], const float (&sl2)[2], int q4) {
    const char* kblk = (const char*)(Kb + (size_t)k0 * 64); const char* vblk = (const char*)(Vb + (size_t)k0 * 64);
    bf16x8v ka[2], kb[2], vf[4];
#pragma unroll
    for (int ks = 0; ks < 2; ++ks) { ka[ks] = *(const bf16x8v*)(kblk + koff + 64 * ks); kb[ks] = *(const bf16x8v*)(kblk + koff + 512 + 64 * ks); }
#pragma unroll
    for (int dt = 0; dt < 4; ++dt) vf[dt] = *(const bf16x8v*)(vblk + voff + 1024 * dt);
    constexpr int DMUL = (MODE == 0) ? 16 : 1;
    float dist[8]; bool ok[8];
#pragma unroll
    for (int i = 0; i < 8; ++i) { const int kk = 8 * q4 + i; const int d = trel - DMUL * kk; dist[i] = (float)d;
        ok[i] = (MODE == 0) ? (k0 + kk <= cmax) : (MODE == 1 ? (tokok && d >= 0) : (d >= 0 && d < 512)); }
#pragma unroll
    for (int h = 0; h < 2; ++h) {
        f32x4 sa = {0.f, 0.f, 0.f, 0.f}, sb = {0.f, 0.f, 0.f, 0.f};
        sa = MFMA16(ka[0], qf[h][0], sa); sb = MFMA16(kb[0], qf[h][0], sb); sa = MFMA16(ka[1], qf[h][1], sa); sb = MFMA16(kb[1], qf[h][1], sb);
        float s[8]; float mx = -1e30f;
#pragma unroll
        for (int i = 0; i < 8; ++i) { const float raw = i < 4 ? sa[i] : sb[i - 4]; s[i] = raw - sl2[h] * dist[i]; mx = ok[i] ? fmaxf(mx, s[i]) : mx; }
        mx = fmaxf(mx, __shfl_xor(mx, 16)); mx = fmaxf(mx, __shfl_xor(mx, 32));
        const float mnew = fmaxf(m[h], mx), alpha = __builtin_amdgcn_exp2f(m[h] - mnew); m[h] = mnew;
        float p[8]; float psum = 0.f;
#pragma unroll
        for (int i = 0; i < 8; ++i) { p[i] = ok[i] ? __builtin_amdgcn_exp2f(s[i] - mnew) : 0.f; psum += p[i]; }
        ls[h] = ls[h] * alpha + psum;
        bf16x8v pf; { const unsigned w0 = pg8::cvt_pk_bf16(p[0], p[1]), w1 = pg8::cvt_pk_bf16(p[2], p[3]), w2 = pg8::cvt_pk_bf16(p[4], p[5]), w3 = pg8::cvt_pk_bf16(p[6], p[7]);
            const v4u w = {w0, w1, w2, w3}; pf = __builtin_bit_cast(bf16x8v, w); }
#pragma unroll
        for (int dt = 0; dt < 4; ++dt) { o[h][dt] = o[h][dt] * alpha; o[h][dt] = MFMA16(vf[dt], pf, o[h][dt]); }
    }
}
constexpr int PSW = 132;
__device__ __forceinline__ void p_attn_fast(Ctx& C, unsigned* queue) {
    unsigned char* ws = C.ws;
    const bf16* Q = (const bf16*)(ws + R_Q); const float* GT = (const float*)(ws + WS_GATES);
    const bf16* KC = (const bf16*)(ws + WS_KC); const bf16* VCT = (const bf16*)(ws + WS_VCT);
    const bf16* KS = (const bf16*)(ws + R_KS); const bf16* VST = (const bf16*)(ws + R_VST); const bf16* KW = (const bf16*)(ws + R_KW); const bf16* VWT = (const bf16*)(ws + R_VWT);
    bf16* O = (bf16*)(ws + R_O);
    LAS float* psl = (LAS float*)(C.lds + C.wave * (16 * PSW * 4));
    const int l = C.lane, r16 = l & 15, q4 = l >> 4;
    const unsigned koff = (unsigned)(((8 * (r16 >> 2) + (r16 & 3)) * 64 + 8 * q4) * 2), voff = (unsigned)((r16 * 32 + 8 * q4) * 2);
    for (;;) {
        unsigned u = 0; if (l == 0) u = __hip_atomic_fetch_add(queue, 1u, __ATOMIC_RELAXED, __HIP_MEMORY_SCOPE_AGENT);
        u = (unsigned)__builtin_amdgcn_readfirstlane((int)u);
        if (u >= 16384u) break;
        const int bg = (int)(u >> 7), tile = 127 - (int)(u & 127), g = bg & 3, b = bg >> 2, t0 = tile * 16, t = t0 + r16, row = b * SEQ + t;
        const float* gtp = GT + (size_t)row * 48 + g * 12;
        bf16* orow = O + (size_t)row * DM + g * 256 + 4 * q4;
        bf16x8v qf[2][2]; float sl2[2]; float m[2], ls[2]; f32x4 o[2][4];
#define ATT_LOADQ(hp) do { _Pragma("unroll") for (int h = 0; h < 2; ++h) { sl2[h] = exp2f(-0.5f * (float)(g * 4 + 2 * (hp) + h + 1)) * LOG2E; \
            _Pragma("unroll") for (int ks = 0; ks < 2; ++ks) qf[h][ks] = *(const bf16x8v*)(Q + (size_t)row * DM + (g * 4 + 2 * (hp) + h) * 64 + 32 * ks + 8 * q4); } } while (0)
#define ATT_RESET() do { _Pragma("unroll") for (int h = 0; h < 2; ++h) { m[h] = -1e30f; ls[h] = 0.f; _Pragma("unroll") for (int dt = 0; dt < 4; ++dt) o[h][dt] = (f32x4){0.f, 0.f, 0.f, 0.f}; } } while (0)
        const int cmax = t >= 31 ? (((t - 31) >> 4) < 126 ? ((t - 31) >> 4) : 126) : -1;
        const bf16* KCb = KC + (size_t)bg * 128 * 64; const bf16* VCb = VCT + (size_t)bg * 128 * 64;
        const int ncs = ((t0 + 15 - 31) >> 4) < 0 ? 0 : ((((t0 + 15 - 31) >> 4) < 126 ? ((t0 + 15 - 31) >> 4) : 126) >> 5) + 1;
#pragma unroll 1
        for (int hp = 0; hp < 2; ++hp) {
            ATT_LOADQ(hp); ATT_RESET();
            for (int st = 0; st < ncs; ++st) attn_step<0>(KCb, VCb, koff, voff, 32 * st, t - 31 - 16 * 32 * st, true, cmax, qf, m, ls, o, sl2, q4);
#pragma unroll
            for (int h = 0; h < 2; ++h) { float lt = ls[h]; lt += __shfl_xor(lt, 16); lt += __shfl_xor(lt, 32); ls[h] = lt;
                const float sc_ = lt > 0.f ? gtp[(2 * hp + h) * 3 + 0] / lt : 0.f;
#pragma unroll
                for (int dt = 0; dt < 4; ++dt) { const f32x4 r_ = o[h][dt] * sc_; v2u w; w.x = pg8::cvt_pk_bf16(r_[0], r_[1]); w.y = pg8::cvt_pk_bf16(r_[2], r_[3]);
                    *(v2u*)(orow + (2 * hp + h) * 64 + 16 * dt) = w; } }
            float ps[4][8];
#pragma unroll
            for (int st = 0; st < 4; ++st)
#pragma unroll
                for (int i = 0; i < 8; ++i) ps[st][i] = 0.f;
#pragma unroll
            for (int st = 0; st < 4; ++st) {
                if (st < ncs) {
                    const int k0 = 32 * st; const char* kblk = (const char*)(KCb + (size_t)k0 * 64);
                    bf16x8v ka[2], kb[2];
#pragma unroll
                    for (int ks = 0; ks < 2; ++ks) { ka[ks] = *(const bf16x8v*)(kblk + koff + 64 * ks); kb[ks] = *(const bf16x8v*)(kblk + koff + 512 + 64 * ks); }
#pragma unroll
                    for (int h = 0; h < 2; ++h) {
                        f32x4 sa = {0.f, 0.f, 0.f, 0.f}, sb = {0.f, 0.f, 0.f, 0.f};
                        sa = MFMA16(ka[0], qf[h][0], sa); sb = MFMA16(kb[0], qf[h][0], sb); sa = MFMA16(ka[1], qf[h][1], sa); sb = MFMA16(kb[1], qf[h][1], sb);
                        const float inv = ls[h] > 0.f ? 1.f / ls[h] : 0.f;
#pragma unroll
                        for (int i = 0; i < 8; ++i) { const int c = k0 + 8 * q4 + i; const float raw = i < 4 ? sa[i] : sb[i - 4];
                            const float s = raw - sl2[h] * (float)(t - 31 - 16 * c); ps[st][i] += (c <= cmax) ? __builtin_amdgcn_exp2f(s - m[h]) * inv : 0.f; }
                    }
                }
            }
#pragma unroll
            for (int st = 0; st < 4; ++st) { LAS f32x4* p0 = (LAS f32x4*)(psl + r16 * PSW + 32 * st + 8 * q4);
                f32x4 a = {ps[st][0], ps[st][1], ps[st][2], ps[st][3]}, bq = {ps[st][4], ps[st][5], ps[st][6], ps[st][7]};
                if (hp) { a = a + p0[0]; bq = bq + p0[1]; }
                p0[0] = a; p0[1] = bq; }
            LDS_WAIT();
        }
        unsigned mlo, mhi;
        {
            float sc[16]; const LAS float* pr = psl + r16 * PSW + 32 * q4; const int cur = t >> 5;
            float prev = q4 > 0 ? pr[-1] : 0.f;
#pragma unroll
            for (int jj = 0; jj < 16; ++jj) { const float a = pr[2 * jj], bq = pr[2 * jj + 1]; const float imp = prev + a + bq; prev = bq;
                const int j = 16 * q4 + jj; const bool valid = 32 * j <= t; const bool forced = valid && (j == 0 || j == cur || j == cur - 1);
                sc[jj] = forced ? 1e9f : (valid ? imp : -1e9f); }
            unsigned my = 0u;
            for (int r = 0; r < 8; ++r) {
                float best = sc[0]; int bi = 0;
#pragma unroll
                for (int jj = 1; jj < 16; ++jj) if (sc[jj] > best) { best = sc[jj]; bi = jj; }
                bi += 16 * q4;
#pragma unroll
                for (int sh = 16; sh <= 32; sh <<= 1) { const float ov = __shfl_xor(best, sh); const int oi = __shfl_xor(bi, sh); if (ov > best || (ov == best && oi < bi)) { best = ov; bi = oi; } }
                if ((bi >> 4) == q4) { const int jj0 = bi & 15; if (best > -0.5e9f) my |= 1u << jj0;
#pragma unroll
                    for (int jj = 0; jj < 16; ++jj) if (jj == jj0) sc[jj] = -INFINITY; }
            }
            mlo = (q4 == 0 ? my : 0u) | (q4 == 1 ? my << 16 : 0u); mhi = (q4 == 2 ? my : 0u) | (q4 == 3 ? my << 16 : 0u);
            mlo |= __shfl_xor(mlo, 16); mlo |= __shfl_xor(mlo, 32); mhi |= __shfl_xor(mhi, 16); mhi |= __shfl_xor(mhi, 32);
        }
        LDS_WAIT();
        unsigned ulo = mlo, uhi = mhi;
#pragma unroll
        for (int sh = 1; sh <= 8; sh <<= 1) { ulo |= __shfl_xor(ulo, sh); uhi |= __shfl_xor(uhi, sh); }
        const unsigned long long un0 = ((unsigned long long)(unsigned)__builtin_amdgcn_readfirstlane((int)uhi) << 32) | (unsigned)__builtin_amdgcn_readfirstlane((int)ulo);
        const unsigned long long mine = ((unsigned long long)mhi << 32) | mlo;
#pragma unroll 1
        for (int hp = 0; hp < 2; ++hp) {
            ATT_LOADQ(hp);
            f32x4 oacc[2][4];
            {
                const bf16* Kb = KS + (size_t)bg * SEQ * 64; const bf16* Vb = VST + (size_t)bg * SEQ * 64;
                ATT_RESET();
                unsigned long long un = un0;
                while (un) { const int j = __builtin_ctzll(un); un &= un - 1;
                    attn_step<1>(Kb, Vb, koff, voff, 32 * j, t - 32 * j, ((mine >> j) & 1ull) != 0ull, 0, qf, m, ls, o, sl2, q4); }
#pragma unroll
                for (int h = 0; h < 2; ++h) { float lt = ls[h]; lt += __shfl_xor(lt, 16); lt += __shfl_xor(lt, 32); const float sc_ = lt > 0.f ? gtp[(2 * hp + h) * 3 + 1] / lt : 0.f;
#pragma unroll
                    for (int dt = 0; dt < 4; ++dt) oacc[h][dt] = o[h][dt] * sc_; }
            }
            {
                const bf16* Kb = KW + (size_t)bg * SEQ * 64; const bf16* Vb = VWT + (size_t)bg * SEQ * 64;
                const int sb = t0 >= 511 ? (t0 - 511) >> 5 : 0, se = t0 >> 5;
                ATT_RESET();
                for (int st = sb; st <= se; ++st) attn_step<2>(Kb, Vb, koff, voff, 32 * st, t - 32 * st, true, 0, qf, m, ls, o, sl2, q4);
#pragma unroll
                for (int h = 0; h < 2; ++h) { float lt = ls[h]; lt += __shfl_xor(lt, 16); lt += __shfl_xor(lt, 32); const float sc_ = lt > 0.f ? gtp[(2 * hp + h) * 3 + 2] / lt : 0.f;
#pragma unroll
                    for (int dt = 0; dt < 4; ++dt) oacc[h][dt] = oacc[h][dt] + o[h][dt] * sc_; }
            }
#pragma unroll
            for (int h = 0; h < 2; ++h)
#pragma unroll
                for (int dt = 0; dt < 4; ++dt) { v2u* op = (v2u*)(orow + (2 * hp + h) * 64 + 16 * dt); const v2u c_ = *op; const f32x4 r_ = oacc[h][dt];
                    v2u w; w.x = pg8::cvt_pk_bf16(r_[0] + bflo(c_.x), r_[1] + bfhi(c_.x)); w.y = pg8::cvt_pk_bf16(r_[2] + bflo(c_.y), r_[3] + bfhi(c_.y)); *op = w; }
        }
#undef ATT_LOADQ
#undef ATT_RESET
    }
}

constexpr int SCQ = 272, SCT = 144;
constexpr int LQ_ = 0, LK_ = 17408, LKT_ = 34816, LVT_ = 53248, LP_ = 71680, LO_ = 80896, LE_ = 114688, LT_ = 115712;
__device__ __forceinline__ void p_scan_fast(Ctx& C, int layer) {
    unsigned char* ws = C.ws;
    const bf16* Pq = (const bf16*)(ws + R_PQ); const bf16* Pi = (const bf16*)(ws + R_PI); const bf16* Pg = (const bf16*)(ws + R_PG); const float* LF = (const float*)(ws + R_LF);
    bf16* O2 = (bf16*)(ws + R_O2);
    const float* gn = C.inp(I_HGN) + layer * 128;
    LAS unsigned char* L = C.lds;
    const int tid = C.tid, lane = C.lane, w = C.wave, r16 = lane & 15, q4 = lane >> 4, k = tid & 127, seg = tid >> 7;
    LAS float* tot = (LAS float*)(L + LT_); LAS float* eref = (LAS float*)(L + LE_); LAS float* elr = eref + 128;
    { const int tile = tid >> 8, e = tid & 255, row = e >> 4, col = e & 15;
      *(LAS bf16*)(L + LP_ + ((tile ? 32 : 0) + row) * SCT + ((tile ? 48 : 16) + col) * 2) = 0; }
    for (int bh = C.bid; bh < 256; bh += C.G) {
        const int b = bh >> 3, h = bh & 7;
        const size_t base = (size_t)(b * SEQ) * DM + h * 128;
        f32x4 S[8];
#pragma unroll
        for (int i = 0; i < 8; ++i) S[i] = (f32x4){0.f, 0.f, 0.f, 0.f};
        bf16 qv[16], vv[16]; float lf[16];
#define SC_LOAD(t0) do { _Pragma("unroll") for (int i = 0; i < 16; ++i) { const size_t off = base + (size_t)((t0) + 16 * seg + i) * DM + k; qv[i] = Pq[off]; vv[i] = Pi[off]; lf[i] = LF[off]; } } while (0)
        SC_LOAD(0);
#pragma unroll 1
        for (int c = 0; c < SEQ / 64; ++c) {
            const int t0 = c * 64;
            float cs[16]; { float run = 0.f;
#pragma unroll
                for (int i = 0; i < 16; ++i) { run += lf[i]; cs[i] = run; }
                tot[seg * 128 + k] = run; }
            __syncthreads();
            { const float a0 = tot[k], a1 = tot[128 + k], a2 = tot[256 + k], a3 = tot[384 + k];
              const float off = seg == 0 ? 0.f : (seg == 1 ? a0 : (seg == 2 ? a0 + a1 : a0 + a1 + a2)), ref = a0 + a1, last = ref + a2 + a3;
              unsigned kt[16];
#pragma unroll
              for (int i = 0; i < 16; ++i) { const float d = off + cs[i] - ref; const float qt = bf2f(qv[i]) * __expf(fminf(d, 80.f)), ktv = (1.f - __expf(lf[i])) * __expf(fminf(-d, 80.f));
                  const int s = 16 * seg + i; kt[i] = f2bf(ktv);
                  *(LAS bf16*)(L + LQ_ + s * SCQ + k * 2) = (bf16)f2bf(qt); *(LAS bf16*)(L + LK_ + s * SCQ + k * 2) = (bf16)kt[i]; }
              v4u w0, w1, x0, x1;
              w0.x = kt[0] | (kt[1] << 16); w0.y = kt[2] | (kt[3] << 16); w0.z = kt[4] | (kt[5] << 16); w0.w = kt[6] | (kt[7] << 16);
              w1.x = kt[8] | (kt[9] << 16); w1.y = kt[10] | (kt[11] << 16); w1.z = kt[12] | (kt[13] << 16); w1.w = kt[14] | (kt[15] << 16);
              x0.x = vv[0] | ((unsigned)vv[1] << 16); x0.y = vv[2] | ((unsigned)vv[3] << 16); x0.z = vv[4] | ((unsigned)vv[5] << 16); x0.w = vv[6] | ((unsigned)vv[7] << 16);
              x1.x = vv[8] | ((unsigned)vv[9] << 16); x1.y = vv[10] | ((unsigned)vv[11] << 16); x1.z = vv[12] | ((unsigned)vv[13] << 16); x1.w = vv[14] | ((unsigned)vv[15] << 16);
              *(LAS v4u*)(L + LKT_ + k * SCT + seg * 32) = w0; *(LAS v4u*)(L + LKT_ + k * SCT + seg * 32 + 16) = w1;
              *(LAS v4u*)(L + LVT_ + k * SCT + seg * 32) = x0; *(LAS v4u*)(L + LVT_ + k * SCT + seg * 32 + 16) = x1;
              if (seg == 0) { eref[k] = __expf(ref); elr[k] = __expf(last - ref); } }
            __syncthreads();
            if (c + 1 < SEQ / 64) SC_LOAD(t0 + 64);
#pragma unroll 1
            for (int ti = w; ti < 10; ti += 8) {
                const int rt = ti < 1 ? 0 : (ti < 3 ? 1 : (ti < 6 ? 2 : 3)), ct = ti - (rt * (rt + 1)) / 2;
                f32x4 acc = {0.f, 0.f, 0.f, 0.f};
#pragma unroll
                for (int p = 0; p < 4; ++p) { const bf16x8v a = *(const LAS bf16x8v*)(L + LQ_ + (16 * rt + r16) * SCQ + (32 * p + 8 * q4) * 2), bq = *(const LAS bf16x8v*)(L + LK_ + (16 * ct + r16) * SCQ + (32 * p + 8 * q4) * 2);
                    acc = MFMA16(a, bq, acc); }
#pragma unroll
                for (int i = 0; i < 4; ++i) { const int t = 16 * rt + 4 * q4 + i, s = 16 * ct + r16; *(LAS bf16*)(L + LP_ + t * SCT + s * 2) = (bf16)f2bf(s <= t ? acc[i] : 0.f); }
            }
            __syncthreads();
            bf16x8v sfrag[4]; f32x4 e8[4][2];
#pragma unroll
            for (int p = 0; p < 4; ++p) { e8[p][0] = *(const LAS f32x4*)(eref + 32 * p + 8 * q4); e8[p][1] = *(const LAS f32x4*)(eref + 32 * p + 8 * q4 + 4);
                S[2 * p] = S[2 * p] * e8[p][0]; S[2 * p + 1] = S[2 * p + 1] * e8[p][1];
                const v4u wv = {pg8::cvt_pk_bf16(S[2 * p][0], S[2 * p][1]), pg8::cvt_pk_bf16(S[2 * p][2], S[2 * p][3]), pg8::cvt_pk_bf16(S[2 * p + 1][0], S[2 * p + 1][1]), pg8::cvt_pk_bf16(S[2 * p + 1][2], S[2 * p + 1][3])};
                sfrag[p] = __builtin_bit_cast(bf16x8v, wv); }
            bf16x8v vfr[2];
#pragma unroll
            for (int ss = 0; ss < 2; ++ss) vfr[ss] = *(const LAS bf16x8v*)(L + LVT_ + (16 * w + r16) * SCT + (32 * ss + 8 * q4) * 2);
#pragma unroll
            for (int rt = 0; rt < 4; ++rt) { f32x4 o = {0.f, 0.f, 0.f, 0.f};
#pragma unroll
                for (int p = 0; p < 4; ++p) { const bf16x8v a = *(const LAS bf16x8v*)(L + LQ_ + (16 * rt + r16) * SCQ + (32 * p + 8 * q4) * 2); o = MFMA16(a, sfrag[p], o); }
#pragma unroll
                for (int ss = 0; ss < 2; ++ss) if (ss <= rt / 2) { const bf16x8v a = *(const LAS bf16x8v*)(L + LP_ + (16 * rt + r16) * SCT + (32 * ss + 8 * q4) * 2); o = MFMA16(a, vfr[ss], o); }
#pragma unroll
                for (int i = 0; i < 4; ++i) *(LAS float*)(L + LO_ + (16 * rt + 4 * q4 + i) * 528 + (16 * w + r16) * 4) = o[i]; }
#pragma unroll
            for (int p = 0; p < 4; ++p)
#pragma unroll
                for (int ab = 0; ab < 2; ++ab) { const int krow = 32 * p + 8 * (r16 >> 2) + (r16 & 3) + 4 * ab;
#pragma unroll
                    for (int ss = 0; ss < 2; ++ss) { const bf16x8v a = *(const LAS bf16x8v*)(L + LKT_ + krow * SCT + (32 * ss + 8 * q4) * 2); S[2 * p + ab] = MFMA16(a, vfr[ss], S[2 * p + ab]); } }
#pragma unroll
            for (int p = 0; p < 4; ++p) { const f32x4 l0 = *(const LAS f32x4*)(elr + 32 * p + 8 * q4), l1 = *(const LAS f32x4*)(elr + 32 * p + 8 * q4 + 4); S[2 * p] = S[2 * p] * l0; S[2 * p + 1] = S[2 * p + 1] * l1; }
            __syncthreads();
#pragma unroll
            for (int rep = 0; rep < 2; ++rep) { const int tok = (tid >> 4) + 32 * rep, part = tid & 15;
                const f32x4 oa = *(const LAS f32x4*)(L + LO_ + tok * 528 + part * 32), ob = *(const LAS f32x4*)(L + LO_ + tok * 528 + part * 32 + 16);
                float ss = (oa.x * oa.x + oa.y * oa.y) + (oa.z * oa.z + oa.w * oa.w) + (ob.x * ob.x + ob.y * ob.y) + (ob.z * ob.z + ob.w * ob.w);
                ss += __shfl_xor(ss, 1); ss += __shfl_xor(ss, 2); ss += __shfl_xor(ss, 4); ss += __shfl_xor(ss, 8);
                const float rstd = rsqrtf(ss * (1.f / 128.f) + EPS);
                const size_t off = base + (size_t)(t0 + tok) * DM + part * 8; const v4u g8 = *(const v4u*)(Pg + off);
                const f32x4 ga = *(const f32x4*)(gn + part * 8), gb = *(const f32x4*)(gn + part * 8 + 4);
                v4u wv; wv.x = pk2(oa.x * rstd * ga.x * bflo(g8.x), oa.y * rstd * ga.y * bfhi(g8.x)); wv.y = pk2(oa.z * rstd * ga.z * bflo(g8.y), oa.w * rstd * ga.w * bfhi(g8.y));
                wv.z = pk2(ob.x * rstd * gb.x * bflo(g8.z), ob.y * rstd * gb.y * bfhi(g8.z)); wv.w = pk2(ob.z * rstd * gb.z * bflo(g8.w), ob.w * rstd * gb.w * bfhi(g8.w));
                *(v4u*)(O2 + off) = wv; }
        }
#undef SC_LOAD
        __syncthreads();
    }
}

#define PH_BEGIN { const bool run_ = (pid >= lo && pid < hi); ++pid; if (run_) { { int ln_; asm volatile("v_mbcnt_lo_u32_b32 %0, -1, 0\n\tv_mbcnt_hi_u32_b32 %0, -1, %0" : "=v"(ln_)); C.lane = ln_; C.tid = C.wave * 64 + ln_; }
#define PH_END   if (pid < hi) xcd_barrier(bar); } }
#define XN ((const bf16*)(ws + WS_XN))
#define RTAB ((const int*)(ws + WS_RTAB))

template <int L>
__device__ __forceinline__ void run_layer(Ctx& C, const XcdBarrier& bar, int& pid, const int lo, const int hi, PG8_LAS unsigned char* ring) {
    unsigned char* const ws = C.ws;

        const int li = L >> 1;
        if (L < 2) {
            PH_BEGIN { pg8::Gemm g{XN, (const bf16*)(ws + W_HIN) + (size_t)L * 4096 * 1024, 1024, 1024, 0}; pg8::GenOrder S; S.init(256, 16, C.G, C.bid, nullptr);
                pg8::EpiHgrnIn E{ws, L};
                pg8::gemm_phase<pg8::EpiHgrnIn, pg8::GenOrder, true, true>(ring, g, S, E, C.wave); } PH_END
            PH_BEGIN p_scan_fast(C, L); PH_END
        } else {
            PH_BEGIN { const bool first = (L == 2); pg8::Gemm g{XN, (const bf16*)(ws + (first ? W_KVQ : W_Q3)), 1024, 1024, 0}; pg8::GenOrder S; S.init(256, first ? 11 : 5, C.G, C.bid, nullptr);
                pg8::EpiBf16 E{(bf16*)(ws + R_QKV), first ? 2816 : 1280, nullptr, 0, 0};
                pg8::gemm_phase<pg8::EpiBf16, pg8::GenOrder, true, true>(ring, g, S, E, C.wave); } PH_END
            PH_BEGIN p_post(C, L == 2 ? 1 : 0, L == 2 ? 2816 : 1280, L - 2); PH_END
            if (L == 2) {
                PH_BEGIN { pg8::Gemm g{(const bf16*)(ws + R_KCR), (const bf16*)(ws + W_CMP1), 2048, 1024, (size_t)256 * 2048 * 2}; pg8::GenOrder S; S.init(128, 1, C.G, C.bid, RTAB + 2048);
                    pg8::EpiBf16 E{(bf16*)(ws + WS_HC), 256, (const float*)(ws + WS_CB), 1, 256};
                    pg8::gemm_phase<pg8::EpiBf16, pg8::GenOrder, true, true>(ring, g, S, E, C.wave); } PH_END
                PH_BEGIN p_cmp2(C); PH_END
            }
            PH_BEGIN p_attn_fast(C, (unsigned*)(ws + WS_CTL) + 8192 + 64 * (L - 2)); PH_END
        }
        PH_BEGIN { pg8::Gemm g{(const bf16*)(ws + (L < 2 ? R_O2 : R_O)), (const bf16*)(ws + (L < 2 ? W_HOUT : W_NOUT)) + (size_t)(L & 1) * 1024 * 1024, 1024, 1024, 0};
            pg8::GenOrder S; S.init(256, 4, C.G, C.bid, nullptr);
            pg8::EpiRes E{L == 0 ? C.inp(I_X) : C.out, C.out, 1024};
            pg8::gemm_phase<pg8::EpiRes, pg8::GenOrder, true, true>(ring, g, S, E, C.wave); } PH_END
        PH_BEGIN { if (L & 1) p_norm<false, true, true>(C, C.inp(I_MR) + (size_t)li * 1024 * 8, C.inp(I_NFFN) + L * 1024); else p_norm<false, false, true>(C, nullptr, nullptr); } PH_END
        if (L & 1) { PH_BEGIN p_gather(C); PH_END }
        PH_BEGIN { const bool moe = (L & 1) != 0;
            pg8::Gemm g{moe ? (const bf16*)(ws + R_XP) : XN, moe ? (const bf16*)(ws + W_MGU) + (size_t)li * 8 * 2 * DFE * 1024 : (const bf16*)(ws + W_FGU) + (size_t)li * 2 * DFF * 1024, 1024, 1024, moe ? (size_t)2 * DFE * 1024 * 2 : 0};
            pg8::GenOrder S; S.init(moe ? RTAB[1024] : 256, moe ? 28 : 22, C.G, C.bid, moe ? RTAB : nullptr);
            pg8::EpiSwiGLU E{(bf16*)(ws + (moe ? R_HM : R_HF)), moe ? DFE : DFF};
            pg8::gemm_phase<pg8::EpiSwiGLU, pg8::GenOrder, true, true>(ring, g, S, E, C.wave); } PH_END
        if (!(L & 1)) {
            PH_BEGIN { pg8::Gemm g{(const bf16*)(ws + R_HF), (const bf16*)(ws + W_FDN) + (size_t)li * 1024 * DFF, DFF, DFF, 0}; pg8::GenOrder S; S.init(256, 4, C.G, C.bid, nullptr);
                pg8::EpiRes E{C.out, C.out, 1024};
                pg8::gemm_phase<pg8::EpiRes, pg8::GenOrder, true, true>(ring, g, S, E, C.wave); } PH_END
            PH_BEGIN p_norm<false, false, true>(C, nullptr, nullptr); PH_END
        } else {
            PH_BEGIN { pg8::Gemm g{(const bf16*)(ws + R_HM), (const bf16*)(ws + W_MDN) + (size_t)li * 8 * 1024 * DFE, DFE, DFE, (size_t)1024 * DFE * 2}; pg8::GenOrder S; S.init(RTAB[1024], 4, C.G, C.bid, RTAB);
                pg8::EpiBf16 E{(bf16*)(ws + R_XP), 1024, nullptr, 0, 0};
                pg8::gemm_phase<pg8::EpiBf16, pg8::GenOrder, true, true>(ring, g, S, E, C.wave); } PH_END
            PH_BEGIN { if (L == 1) p_norm<true, false, true>(C, nullptr, nullptr); else p_norm<true, false, false>(C, nullptr, nullptr); } PH_END
        }
    }

struct Args { const float* in[24]; float* out; unsigned char* ws; int ph_lo, ph_hi; };
constexpr int N_PHASES = 35;

__global__ void __launch_bounds__(NWAVES * 64, 2) yoco_fwd(Args args) {
    extern __shared__ __attribute__((aligned(16))) unsigned char lds_raw[];
    Ctx C;
    C.lds = (LAS unsigned char*)lds_raw;
    C.wave = __builtin_amdgcn_readfirstlane((int)(threadIdx.x >> 6)); C.tid = threadIdx.x; C.lane = C.tid & 63;
    C.G = gridDim.x; C.bid = blockIdx.x;
    C.out = args.out; C.ws = args.ws;
    unsigned char* const ws = args.ws;
    volatile LAS unsigned* MISC = (volatile LAS unsigned*)(C.lds + MISC_OFF);
    if (C.tid < 32) MISC[C.tid] = 0u;
    __syncthreads();
    XcdBarrier bar = xcd_barrier_post((unsigned*)(ws + WS_CTL) + 4096, MISC + 8);
    const int lo = args.ph_lo, hi = args.ph_hi;
    int pid = 0;
    PG8_LAS unsigned char* ring = (PG8_LAS unsigned char*)lds_raw;
    PH_BEGIN p_prologue(C); PH_END

    run_layer<0>(C, bar, pid, lo, hi, ring); run_layer<1>(C, bar, pid, lo, hi, ring); run_layer<2>(C, bar, pid, lo, hi, ring); run_layer<3>(C, bar, pid, lo, hi, ring);
#undef PH_BEGIN
#undef PH_END
#undef XN
#undef RTAB
}

extern "C" void kernel_launch(void* const* d_in, const int* in_sizes, int n_in, void* d_out, int out_size, void* d_ws, size_t ws_size, hipStream_t stream) {
    static int grid = 0;
    if (grid == 0) {
        if (n_in != 24 || in_sizes[0] != NT * DM || out_size != NT * DM || ws_size < WS_NEED) { fprintf(stderr, "kernel_launch: unexpected shapes / workspace (n_in %d, ws %zu, need %zu)\n", n_in, ws_size, (size_t)WS_NEED); grid = -1; return; }
        int dev = 0, cus = 0;
        if (hipGetDevice(&dev) != hipSuccess || hipDeviceGetAttribute(&cus, hipDeviceAttributeMultiprocessorCount, dev) != hipSuccess) { grid = -1; return; }
        if (hipFuncSetAttribute((const void*)yoco_fwd, hipFuncAttributeMaxDynamicSharedMemorySize, LDS_BYTES) != hipSuccess) { fprintf(stderr, "kernel_launch: hipFuncSetAttribute failed\n"); grid = -1; return; }
        int per_cu = 0;
        if (hipOccupancyMaxActiveBlocksPerMultiprocessor(&per_cu, (const void*)yoco_fwd, NWAVES * 64, LDS_BYTES) != hipSuccess || per_cu < 1) { fprintf(stderr, "kernel_launch: occupancy query says %d\n", per_cu); }
        (void)hipGetLastError();
        grid = cus;
    }
    if (grid < 0) return;
    (void)hipMemsetAsync((char*)d_ws + WS_CTL, 0, CTL_ZERO_BYTES, stream);
    Args a{};
    for (int i = 0; i < 24; ++i) a.in[i] = (const float*)d_in[i];
    a.out = (float*)d_out; a.ws = (unsigned char*)d_ws;
#if MK_SINGLE
    a.ph_lo = 0; a.ph_hi = N_PHASES;
    hipLaunchKernelGGL(yoco_fwd, dim3(grid), dim3(NWAVES * 64), LDS_BYTES, stream, a);
#else
    for (int k = 0; k < N_PHASES; ++k) { a.ph_lo = k; a.ph_hi = k + 1; hipLaunchKernelGGL(yoco_fwd, dim3(grid), dim3(NWAVES * 64), LDS_BYTES, stream, a); }
#endif
}
```

```cpp
#include <hip/hip_runtime.h>
#include <cstdio>
#include <cstdint>

#ifndef PROBE_DUP
#define PROBE_DUP 0
#endif
#ifndef MK_SINGLE
#define MK_SINGLE 1
#endif

namespace pg8 {
#define PG8_LAS __attribute__((address_space(3)))
typedef unsigned short bf16_t;
typedef short bf16x8 __attribute__((ext_vector_type(8)));
typedef float f32x4 __attribute__((ext_vector_type(4)));
typedef unsigned u32x4 __attribute__((ext_vector_type(4)));
constexpr int BM = 256, BK = 64, HALF = 128, HTB = HALF * BK * 2  , STAGE_BYTES = 8 * HTB, NXCD = 8, WGM = 8;

__host__ __device__ __forceinline__ int lds_byte(int r, int c) { const int st = (r >> 4) * 2 + (c >> 5), rr = r & 15, cc = c & 31, ob = rr * 64 + cc * 2; return st * 1024 + (ob ^ (((ob >> 9) & 1) << 5)); }
__host__ __device__ __forceinline__ void stage_rc(int b, int& R, int& C) { const int st = b / 1024, sb = b % 1024, swz = sb ^ (((sb >> 9) & 1) << 5); R = (st >> 1) * 16 + swz / 64; C = (st & 1) * 32 + (swz % 64) / 2; }
__host__ __device__ __forceinline__ int perm32(int rho) { const int n = rho >> 4, i = rho & 15; return 8 * (i >> 2) + 4 * n + (i & 3); }

struct Unit { int pm, pn, e; };
struct Gemm { const bf16_t* A; const bf16_t* Bt; int K; int lda; size_t estride; };

struct GenOrder {
    int nM, nN, nwg, G, c; const int* tile_e;
    __device__ void init(int nM_, int nN_, int G_, int c_, const int* te) { nM = nM_; nN = nN_; nwg = nM * nN; G = G_; c = c_; tile_e = te; }
    __device__ bool next(int i, Unit& u) const {
        const long L = (long)i * G + c; if (L >= nwg) return false;
        int wgid = (int)L; { const int q = nwg / NXCD, r = nwg % NXCD, xcd = wgid % NXCD, off = wgid / NXCD; wgid = (xcd < r ? xcd * (q + 1) : r * (q + 1) + (xcd - r) * q) + off; }
        const int nig = WGM * nN, gid = wgid / nig, fm = gid * WGM, gsz = (nM - fm) < WGM ? (nM - fm) : WGM;
        u.pm = fm + ((wgid % nig) % gsz); u.pn = (wgid % nig) / gsz; u.e = tile_e ? tile_e[u.pm] : 0; return true;
    }
    __device__ __forceinline__ void a_ready(const Unit&) const {}
    __device__ __forceinline__ void done(const Unit&) const {}
};

__device__ __forceinline__ unsigned cvt_pk_bf16(float lo, float hi) { unsigned r; asm volatile("v_cvt_pk_bf16_f32 %0, %1, %2" : "=v"(r) : "v"(lo), "v"(hi)); return r; }
__device__ __forceinline__ float silu_f(float v) { return v * __builtin_amdgcn_rcpf(1.0f + __expf(-v)); }

struct EpiBf16 {
    static constexpr bool PERM = true, AFTER_DRAIN = false;
    bf16_t* O; int ldc; const float* bias; int act; int bias_es;
    __device__ __forceinline__ void operator()(const f32x4 (&acc)[2][2][4][2], const Unit& u, int wr, int wc, int fr, int fq) const {
        const int row0 = u.pm * BM + wr * 64 + fr, col0 = u.pn * BM + wc * 32 + 8 * fq;
        f32x4 bv[2][2];
#pragma unroll
        for (int bj = 0; bj < 2; ++bj)
#pragma unroll
            for (int n = 0; n < 2; ++n) bv[bj][n] = bias ? *(const f32x4*)(bias + u.e * bias_es + col0 + bj * HALF + 4 * n) : (f32x4){0.f, 0.f, 0.f, 0.f};
#pragma unroll
        for (int ai = 0; ai < 2; ++ai)
#pragma unroll
            for (int m = 0; m < 4; ++m) { bf16_t* rowp = O + (size_t)(row0 + ai * HALF + m * 16) * ldc + col0;
#pragma unroll
                for (int bj = 0; bj < 2; ++bj) { f32x4 v0 = acc[ai][bj][m][0] + bv[bj][0], v1 = acc[ai][bj][m][1] + bv[bj][1];
                    if (act == 1) {
#pragma unroll
                        for (int i = 0; i < 4; ++i) { v0[i] = silu_f(v0[i]); v1[i] = silu_f(v1[i]); } }
                    u32x4 w; w.x = cvt_pk_bf16(v0[0], v0[1]); w.y = cvt_pk_bf16(v0[2], v0[3]); w.z = cvt_pk_bf16(v1[0], v1[1]); w.w = cvt_pk_bf16(v1[2], v1[3]);
                    *(u32x4*)(rowp + bj * HALF) = w; } }
    }
};
struct EpiRes {
    static constexpr bool PERM = false, AFTER_DRAIN = false;
    const float* base; float* out; int ldc;
    __device__ __forceinline__ void operator()(const f32x4 (&acc)[2][2][4][2], const Unit& u, int wr, int wc, int fr, int fq) const {
        const int row0 = u.pm * BM + wr * 64 + fr, col0 = u.pn * BM + wc * 32 + 4 * fq;
#pragma unroll
        for (int ai = 0; ai < 2; ++ai)
#pragma unroll
            for (int m = 0; m < 4; ++m) { const size_t off = (size_t)(row0 + ai * HALF + m * 16) * ldc + col0;
#pragma unroll
                for (int bj = 0; bj < 2; ++bj)
#pragma unroll
                    for (int n = 0; n < 2; ++n) { const f32x4 b = *(const f32x4*)(base + off + bj * HALF + n * 16); *(f32x4*)(out + off + bj * HALF + n * 16) = b + acc[ai][bj][m][n]; } }
    }
};
struct EpiSwiGLU {
    static constexpr bool PERM = true, AFTER_DRAIN = false;
    bf16_t* O; int ldc;
    __device__ __forceinline__ void operator()(const f32x4 (&acc)[2][2][4][2], const Unit& u, int wr, int wc, int fr, int fq) const {
        const int row0 = u.pm * BM + wr * 64 + fr, col0 = u.pn * HALF + wc * 32 + 8 * fq;
#pragma unroll
        for (int ai = 0; ai < 2; ++ai)
#pragma unroll
            for (int m = 0; m < 4; ++m) { bf16_t* rowp = O + (size_t)(row0 + ai * HALF + m * 16) * ldc + col0;
                f32x4 v0, v1;
#pragma unroll
                for (int i = 0; i < 4; ++i) { v0[i] = silu_f(acc[ai][0][m][0][i]) * acc[ai][1][m][0][i]; v1[i] = silu_f(acc[ai][0][m][1][i]) * acc[ai][1][m][1][i]; }
                u32x4 w; w.x = cvt_pk_bf16(v0[0], v0[1]); w.y = cvt_pk_bf16(v0[2], v0[3]); w.z = cvt_pk_bf16(v1[0], v1[1]); w.w = cvt_pk_bf16(v1[2], v1[3]);
                *(u32x4*)rowp = w; }
    }
};
__device__ __forceinline__ float logf_gate(float x, float la, float l1) {
    const float ls = fminf(x, 0.f) - __logf(1.0f + __expf(-fabsf(x)));
    const float b = l1 + ls;
    if (la == -INFINITY) return b;
    const float mx = fmaxf(la, b), d = fabsf(la - b);
    return mx + __logf(1.0f + __expf(-d));
}
struct EpiHgrnIn {
    static constexpr bool PERM = true, AFTER_DRAIN = false;
    unsigned char* ws; int layer;
    static constexpr size_t O_PQ = 580ull << 20, O_PI = O_PQ + (128ull << 20), O_PG = O_PQ + (256ull << 20), O_LF = O_PQ + (384ull << 20), O_LA = 1ull << 20, O_L1 = O_LA + 8192;
    __device__ __forceinline__ void operator()(const f32x4 (&acc)[2][2][4][2], const Unit& u, int wr, int wc, int fr, int fq) const {
        const int quarter = u.pn >> 2;
        const int row0 = u.pm * BM + wr * 64 + fr, col0 = (u.pn & 3) * BM + wc * 32 + 8 * fq;
        if (quarter == 1) {
            const float* la = (const float*)(ws + O_LA) + layer * 1024; const float* l1 = (const float*)(ws + O_L1) + layer * 1024; float* LF = (float*)(ws + O_LF);
            f32x4 A0[2][2], A1[2][2];
#pragma unroll
            for (int bj = 0; bj < 2; ++bj)
#pragma unroll
                for (int n = 0; n < 2; ++n) { A0[bj][n] = *(const f32x4*)(la + col0 + bj * HALF + 4 * n); A1[bj][n] = *(const f32x4*)(l1 + col0 + bj * HALF + 4 * n); }
#pragma unroll
            for (int ai = 0; ai < 2; ++ai)
#pragma unroll
                for (int m = 0; m < 4; ++m) { float* rowp = LF + (size_t)(row0 + ai * HALF + m * 16) * 1024 + col0;
#pragma unroll
                    for (int bj = 0; bj < 2; ++bj)
#pragma unroll
                        for (int n = 0; n < 2; ++n) { f32x4 o;
#pragma unroll
                            for (int i = 0; i < 4; ++i) o[i] = logf_gate(acc[ai][bj][m][n][i], A0[bj][n][i], A1[bj][n][i]);
                            *(f32x4*)(rowp + bj * HALF + 4 * n) = o; } }
        } else {
            bf16_t* O = (bf16_t*)(ws + (quarter == 0 ? O_PQ : (quarter == 2 ? O_PI : O_PG)));
#pragma unroll
            for (int ai = 0; ai < 2; ++ai)
#pragma unroll
                for (int m = 0; m < 4; ++m) { bf16_t* rowp = O + (size_t)(row0 + ai * HALF + m * 16) * 1024 + col0;
#pragma unroll
                    for (int bj = 0; bj < 2; ++bj) { f32x4 v0 = acc[ai][bj][m][0], v1 = acc[ai][bj][m][1];
                        if (quarter != 2) {
#pragma unroll
                            for (int i = 0; i < 4; ++i) { v0[i] = silu_f(v0[i]); v1[i] = silu_f(v1[i]); } }
                        u32x4 w; w.x = cvt_pk_bf16(v0[0], v0[1]); w.y = cvt_pk_bf16(v0[2], v0[3]); w.z = cvt_pk_bf16(v1[0], v1[1]); w.w = cvt_pk_bf16(v1[2], v1[3]);
                        *(u32x4*)(rowp + bj * HALF) = w; } }
        }
    }
};

template <class Epi, class Sched, bool ALIGN_EPI = false, bool SP2 = false>
__device__ __forceinline__ void gemm_phase(PG8_LAS unsigned char* lds, const Gemm g, const Sched& S, const Epi& E, const int wave_id) {
    int lane_; asm volatile("v_mbcnt_lo_u32_b32 %0, -1, 0\n\tv_mbcnt_hi_u32_b32 %0, -1, %0" : "=v"(lane_));
    const int wid = wave_id, lane = lane_, tid = wid * 64 + lane, wr = wid >> 2, wc = wid & 3, fr = lane & 15, fq = lane >> 4;
    const int K = g.K, nt = K / BK, lda = g.lda;
    unsigned voffA[2], voffB[2];
#pragma unroll
    for (int i = 0; i < 2; ++i) { int R, C; stage_rc(tid * 16 + i * 8192, R, C); const int Rb = Epi::PERM ? ((R & ~31) + perm32(R & 31)) : R;
        voffA[i] = (unsigned)(R * lda + C) * 2u; voffB[i] = (unsigned)(Rb * K + C) * 2u; }
    const size_t kstep = (size_t)(BK * 2);
    const size_t hstep = (size_t)HALF * K * 2;
    const size_t tstep = 2 * hstep;
    const size_t hstepA = (size_t)HALF * lda * 2, tstepA = 2 * hstepA;
    const unsigned ldsw = (unsigned)wid * 1024u;
    const int aoff = lds_byte(wr * 64 + fr, fq * 8), boff = lds_byte(wc * 32 + fr, fq * 8);
#define PG8_SA(b, h) (((b) * 2 + (h)) * HTB)
#define PG8_SB(b, h) ((4 + (b) * 2 + (h)) * HTB)
#define PG8_STAGE(bufoff, gbase, voff) do { _Pragma("unroll") for (int _i = 0; _i < 2; ++_i) \
        __builtin_amdgcn_global_load_lds((const unsigned*)((const char*)(gbase) + (voff)[_i]), (PG8_LAS unsigned*)(lds + (bufoff) + ldsw + _i * 8192), 16, 0, 0); } while (0)
#define PG8_LDA(dst, b, h) do { _Pragma("unroll") for (int m = 0; m < 4; ++m) _Pragma("unroll") for (int k = 0; k < 2; ++k) dst[m][k] = *(const PG8_LAS bf16x8*)(lds + PG8_SA(b, h) + aoff + m * 2048 + k * 1024); } while (0)
#define PG8_LDB(dst, b, h) do { _Pragma("unroll") for (int n = 0; n < 2; ++n) _Pragma("unroll") for (int k = 0; k < 2; ++k) dst[n][k] = *(const PG8_LAS bf16x8*)(lds + PG8_SB(b, h) + boff + n * 2048 + k * 1024); } while (0)
#define PG8_MMA(ai, bj, At, Bt) do { __builtin_amdgcn_s_setprio(1); _Pragma("unroll") for (int m = 0; m < 4; ++m) _Pragma("unroll") for (int n = 0; n < 2; ++n) _Pragma("unroll") for (int k = 0; k < 2; ++k) \
        acc[ai][bj][m][n] = __builtin_amdgcn_mfma_f32_16x16x32_bf16(Bt[n][k], At[m][k], acc[ai][bj][m][n], 0, 0, 0); __builtin_amdgcn_s_setprio(0); } while (0)
#define PG8_WAIT_V(n) asm volatile("s_waitcnt vmcnt(" #n ")" ::: "memory")
#define PG8_WAIT_L(n) asm volatile("s_waitcnt lgkmcnt(" #n ")" ::: "memory")
#define PG8_BAR __builtin_amdgcn_s_barrier()
#define PG8_SCHED __builtin_amdgcn_sched_barrier(0)
    Unit cur, nxt; int ui = 0;
    if (!S.next(0, cur)) return;
    f32x4 acc[2][2][4][2];
#pragma unroll
    for (int a = 0; a < 2; ++a)
#pragma unroll
        for (int b = 0; b < 2; ++b)
#pragma unroll
            for (int m = 0; m < 4; ++m)
#pragma unroll
                for (int n = 0; n < 2; ++n) acc[a][b][m][n] = (f32x4){0.f, 0.f, 0.f, 0.f};
    bf16x8 At[4][2], B0[2][2], B1[2][2];
    const char* cA = (const char*)g.A + (size_t)cur.pm * tstepA; const char* cB = (const char*)g.Bt + (size_t)cur.e * g.estride + (size_t)cur.pn * tstep;
    S.a_ready(cur);
    if constexpr (SP2) {
        PG8_STAGE(PG8_SB(0, 0), cB, voffB); PG8_STAGE(PG8_SB(0, 1), cB + hstep, voffB); PG8_STAGE(PG8_SA(0, 0), cA, voffA); PG8_STAGE(PG8_SA(0, 1), cA + hstepA, voffA);
        if (wr == 1) PG8_BAR;
        PG8_WAIT_V(2); PG8_BAR;
        PG8_STAGE(PG8_SB(1, 0), cB + kstep, voffB); PG8_STAGE(PG8_SA(1, 0), cA + kstep, voffA); PG8_STAGE(PG8_SB(1, 1), cB + hstep + kstep, voffB);
        PG8_WAIT_V(6); PG8_BAR;
    } else {
        PG8_STAGE(PG8_SB(0, 0), cB, voffB); PG8_STAGE(PG8_SA(0, 0), cA, voffA); PG8_STAGE(PG8_SB(0, 1), cB + hstep, voffB); PG8_STAGE(PG8_SA(0, 1), cA + hstepA, voffA);
        if (wr == 1) PG8_BAR;
        PG8_WAIT_V(4); PG8_BAR;
        PG8_STAGE(PG8_SB(1, 0), cB + kstep, voffB); PG8_STAGE(PG8_SA(1, 0), cA + kstep, voffA); PG8_STAGE(PG8_SB(1, 1), cB + hstep + kstep, voffB);
        PG8_WAIT_V(6); PG8_BAR;
    }
    for (;;) {
        const bool has_next = S.next(ui + 1, nxt);
        const char* nA = has_next ? (const char*)g.A + (size_t)nxt.pm * tstepA : cA; const char* nB = has_next ? (const char*)g.Bt + (size_t)nxt.e * g.estride + (size_t)nxt.pn * tstep : cB;
        for (int t = 0; t < nt; t += 2) {
            const bool last = (t == nt - 2);
            const char* a1 = cA + (size_t)(t + 1) * kstep;
            const char* a2 = last ? nA : cA + (size_t)(t + 2) * kstep; const char* b2 = last ? nB : cB + (size_t)(t + 2) * kstep;
            const char* a3 = a2 + kstep; const char* b3 = b2 + kstep;
            if (last && has_next) S.a_ready(nxt);
            if constexpr (SP2) {
            PG8_LDB(B0, 0, 0); PG8_LDB(B1, 0, 1); PG8_SCHED; PG8_LDA(At, 0, 0); PG8_STAGE(PG8_SA(1, 1), a1 + hstepA, voffA);
            PG8_WAIT_V(8); PG8_WAIT_L(0); PG8_BAR; PG8_MMA(0, 0, At, B0); PG8_MMA(0, 1, At, B1); PG8_BAR; PG8_SCHED;
            PG8_LDA(At, 0, 1); PG8_STAGE(PG8_SB(0, 0), b2, voffB); PG8_STAGE(PG8_SB(0, 1), b2 + hstep, voffB); PG8_STAGE(PG8_SA(0, 0), a2, voffA);
            PG8_WAIT_V(8); PG8_WAIT_L(0); PG8_BAR; PG8_MMA(1, 0, At, B0); PG8_MMA(1, 1, At, B1); PG8_BAR; PG8_SCHED;
            PG8_LDB(B0, 1, 0); PG8_LDB(B1, 1, 1); PG8_SCHED; PG8_LDA(At, 1, 0); PG8_STAGE(PG8_SA(0, 1), a2 + hstepA, voffA);
            PG8_WAIT_V(8); PG8_WAIT_L(0); PG8_BAR; PG8_MMA(0, 0, At, B0); PG8_MMA(0, 1, At, B1); PG8_BAR; PG8_SCHED;
            PG8_LDA(At, 1, 1); PG8_STAGE(PG8_SB(1, 0), b3, voffB); PG8_STAGE(PG8_SB(1, 1), b3 + hstep, voffB); PG8_STAGE(PG8_SA(1, 0), a3, voffA);
            PG8_WAIT_V(8); PG8_WAIT_L(0); PG8_BAR; PG8_MMA(1, 0, At, B0); PG8_MMA(1, 1, At, B1); PG8_BAR; PG8_SCHED;
            } else {
            PG8_LDB(B0, 0, 0); PG8_SCHED; PG8_LDA(At, 0, 0); PG8_STAGE(PG8_SA(1, 1), a1 + hstepA, voffA);
            PG8_WAIT_L(8); PG8_BAR; PG8_WAIT_L(0); PG8_MMA(0, 0, At, B0); PG8_BAR; PG8_SCHED;
            PG8_LDB(B1, 0, 1); PG8_STAGE(PG8_SB(0, 0), b2, voffB);
            PG8_BAR; PG8_WAIT_L(0); PG8_MMA(0, 1, At, B1); PG8_BAR;
            PG8_LDA(At, 0, 1); PG8_STAGE(PG8_SA(0, 0), a2, voffA);
            PG8_BAR; PG8_WAIT_L(0); PG8_MMA(1, 0, At, B0); PG8_BAR; PG8_SCHED;
            PG8_STAGE(PG8_SB(0, 1), b2 + hstep, voffB);
            PG8_WAIT_V(6); PG8_BAR; PG8_MMA(1, 1, At, B1); PG8_BAR;
            PG8_LDB(B0, 1, 0); PG8_SCHED; PG8_LDA(At, 1, 0); PG8_STAGE(PG8_SA(0, 1), a2 + hstepA, voffA);
            PG8_WAIT_L(8); PG8_BAR; PG8_WAIT_L(0); PG8_MMA(0, 0, At, B0); PG8_BAR; PG8_SCHED;
            PG8_LDB(B1, 1, 1); PG8_STAGE(PG8_SB(1, 0), b3, voffB);
            PG8_BAR; PG8_WAIT_L(0); PG8_MMA(0, 1, At, B1); PG8_BAR;
            PG8_LDA(At, 1, 1); PG8_STAGE(PG8_SA(1, 0), a3, voffA);
            PG8_BAR; PG8_WAIT_L(0); PG8_MMA(1, 0, At, B0); PG8_BAR; PG8_SCHED;
            PG8_STAGE(PG8_SB(1, 1), b3 + hstep, voffB);
            PG8_WAIT_V(6); PG8_BAR; PG8_MMA(1, 1, At, B1); PG8_BAR;
            }
        }
        if constexpr (ALIGN_EPI) { if (wr == 0) PG8_BAR; }
        if constexpr (!Epi::AFTER_DRAIN) { E(acc, cur, wr, wc, fr, fq); S.done(cur); }
        if (!has_next) break;
#pragma unroll
        for (int a = 0; a < 2; ++a)
#pragma unroll
            for (int b = 0; b < 2; ++b)
#pragma unroll
                for (int m = 0; m < 4; ++m)
#pragma unroll
                    for (int n = 0; n < 2; ++n) acc[a][b][m][n] = (f32x4){0.f, 0.f, 0.f, 0.f};
        cur = nxt; cA = nA; cB = nB; ++ui;
        if constexpr (ALIGN_EPI) { if (wr == 1) PG8_BAR; }
    }
    PG8_WAIT_V(0);
    if constexpr (!ALIGN_EPI) { if (wr == 0) PG8_BAR; }
    PG8_BAR;
    if constexpr (Epi::AFTER_DRAIN) { E.fused(acc, cur, wr, wc, fr, fq, lds, wid, lane); S.done(cur); }
#undef PG8_SA
#undef PG8_SB
#undef PG8_STAGE
#undef PG8_LDA
#undef PG8_LDB
#undef PG8_MMA
#undef PG8_WAIT_V
#undef PG8_WAIT_L
#undef PG8_BAR
#undef PG8_SCHED
}
}

constexpr int NT = 65536, DM = 1024, NBATCH = 32, SEQ = 2048;
constexpr int DFF = 2816, DFE = 3584, NEXP = 8;
constexpr int MOE_ROWS = 133120;
constexpr float EPS = 1e-6f;
constexpr size_t MiB = 1u << 20;
constexpr size_t WS_CTL = 0, CTL_ZERO_BYTES = 1 * MiB;
constexpr size_t WS_LA = 1 * MiB;
constexpr size_t WS_L1 = WS_LA + 8192;
constexpr size_t WS_CB = WS_LA + 16384;
constexpr size_t WS_RCNT = WS_LA + 32768;
constexpr size_t WS_RTAB = WS_LA + 65536;
constexpr size_t WS_ROUTE = 2 * MiB;
constexpr size_t WS_SLOT = 3 * MiB;
constexpr size_t WS_SELM = 4 * MiB;
constexpr size_t WS_GATES = 8 * MiB;
constexpr size_t WS_KC = 20 * MiB;
constexpr size_t WS_VCT = 22 * MiB;
constexpr size_t WS_HC = 24 * MiB;
constexpr size_t WS_W = 48 * MiB;
constexpr size_t W_HIN = WS_W, W_HOUT = WS_W + 16 * MiB, W_KVQ = WS_W + 20 * MiB, W_Q3 = WS_W + 26 * MiB, W_CMP1 = WS_W + 29 * MiB, W_NOUT = WS_W + 31 * MiB,
                 W_FGU = WS_W + 35 * MiB, W_FDN = WS_W + 57 * MiB, W_MGU = WS_W + 68 * MiB, W_MDN = WS_W + 292 * MiB;
constexpr size_t WS_XN = 452 * MiB;
constexpr size_t WS_R = 580 * MiB;
constexpr size_t R_PQ = WS_R, R_PI = WS_R + 128 * MiB, R_PG = WS_R + 256 * MiB, R_LF = WS_R + 384 * MiB, R_O2 = WS_R + 640 * MiB;
constexpr size_t R_HF = WS_R + 256 * MiB;
constexpr size_t R_KS = WS_R, R_KW = WS_R + 32 * MiB, R_VST = WS_R + 64 * MiB, R_VWT = WS_R + 96 * MiB, R_KCR = WS_R + 128 * MiB, R_VCR = WS_R + 160 * MiB;
constexpr size_t R_QKV = WS_R + 256 * MiB;
constexpr size_t R_Q = WS_R + 608 * MiB, R_O = WS_R + 736 * MiB;
constexpr size_t R_XP = WS_R, R_HM = WS_R + 260 * MiB;
constexpr size_t WS_NEED = R_HM + (size_t)MOE_ROWS * DFE * 2;
static_assert(WS_NEED <= 1792 * MiB, "workspace map");
static_assert(W_MDN + 112 * MiB <= WS_XN, "weights map");
static_assert(pg8::EpiHgrnIn::O_PQ == R_PQ && pg8::EpiHgrnIn::O_PI == R_PI && pg8::EpiHgrnIn::O_PG == R_PG && pg8::EpiHgrnIn::O_LF == R_LF && pg8::EpiHgrnIn::O_LA == WS_LA && pg8::EpiHgrnIn::O_L1 == WS_L1, "EpiHgrnIn offsets");

constexpr int LDS_BYTES = 147456;
constexpr int MISC_OFF = 131072 + 320;
constexpr int NWAVES = 8;

#define GAS __attribute__((address_space(1)))
#define LAS __attribute__((address_space(3)))
typedef unsigned short bf16;
typedef unsigned v4u __attribute__((ext_vector_type(4)));
typedef unsigned v2u __attribute__((ext_vector_type(2)));
typedef float f32x4 __attribute__((ext_vector_type(4)));
#define LDS_WAIT() asm volatile("s_waitcnt lgkmcnt(0)" ::: "memory")
__device__ __forceinline__ unsigned f2bf(float f) { unsigned u = __builtin_bit_cast(unsigned, f); return (u + 0x7fffu + ((u >> 16) & 1u)) >> 16; }
__device__ __forceinline__ unsigned pk2(float lo, float hi) { return f2bf(lo) | (f2bf(hi) << 16); }
__device__ __forceinline__ float bf2f(unsigned b) { return __builtin_bit_cast(float, b << 16); }
__device__ __forceinline__ float bflo(unsigned w) { return __builtin_bit_cast(float, w << 16); }
__device__ __forceinline__ float bfhi(unsigned w) { return __builtin_bit_cast(float, w & 0xffff0000u); }
__device__ __forceinline__ float wave_sum(float v) {
#pragma unroll
    for (int o = 32; o >= 1; o >>= 1) v += __shfl_xor(v, o);
    return v;
}
__device__ __forceinline__ float wave_max(float v) {
#pragma unroll
    for (int o = 32; o >= 1; o >>= 1) v = fmaxf(v, __shfl_xor(v, o));
    return v;
}

#define XB_TMO      128
#define XB_XCNT(j)  (256  + 64 * (j))
#define XB_XSUB(j)  (1280 + 64 * (j))
#define XB_XGEN(j)  (2304 + 64 * (j))
#define XB_TOP      3328
#define XB_TOPGEN   3392
#define XCD_BAR_WORDS 3456
#define XB_SPIN_CAP (1u << 22)
__device__ __forceinline__ unsigned xb_ld(unsigned* p)              { return __hip_atomic_load(p, __ATOMIC_RELAXED, __HIP_MEMORY_SCOPE_AGENT); }
__device__ __forceinline__ unsigned xb_add(unsigned* p, unsigned v) { return __hip_atomic_fetch_add(p, v, __ATOMIC_RELAXED, __HIP_MEMORY_SCOPE_AGENT); }
__device__ __forceinline__ unsigned xb_xcc_id() { return (unsigned)__builtin_amdgcn_s_getreg((3 << 11) | 20) & 0xFu; }
#define XB_SPIN(cond, bar) do { unsigned _sp = 0; while (cond) { __builtin_amdgcn_s_sleep(1); \
    if ((++_sp & 255u) == 0u) { if (xb_ld(&(bar)[XB_TMO])) break; if (_sp > XB_SPIN_CAP) { atomicAdd(&(bar)[XB_TMO], 1u); break; } } } } while (0)
struct XcdBarrier { unsigned* bar; unsigned x; volatile LAS unsigned* st; };
__device__ __forceinline__ XcdBarrier xcd_barrier_post(unsigned* bar, volatile LAS unsigned* st) {
    XcdBarrier b; b.bar = bar; b.x = xb_xcc_id(); b.st = st;
    if (threadIdx.x == 0) (void)xb_add(&bar[XB_XCNT(b.x)], 1u);
    return b;
}
__device__ __forceinline__ void xcd_barrier_complete(unsigned* bar, unsigned x, unsigned& nloc, unsigned& nx) {
    const unsigned G = gridDim.x * gridDim.y * gridDim.z;
    unsigned sum, cnt, mine, sp = 0u;
    for (;;) {
        sum = 0u; cnt = 0u; mine = 0u;
#pragma unroll
        for (unsigned j = 0; j < 16; ++j) { const unsigned c = xb_ld(&bar[XB_XCNT(j)]); sum += c; cnt += (c > 0u) ? 1u : 0u; mine = (j == x) ? c : mine; }
        if (sum == G) break;
        __builtin_amdgcn_s_sleep(1);
        if ((++sp & 255u) == 0u) { if (xb_ld(&bar[XB_TMO])) break; if (sp > XB_SPIN_CAP) { atomicAdd(&bar[XB_TMO], 1u); break; } }
    }
    nloc = mine > 0u ? mine : 1u; nx = cnt > 0u ? cnt : 1u;
}
__device__ __forceinline__ void xcd_barrier(const XcdBarrier& b) {
    asm volatile("s_waitcnt vmcnt(0)" ::: "memory");
    __syncthreads();
    if (threadIdx.x == 0) {
        unsigned* bar = b.bar; unsigned bx_ = b.x; asm volatile("" : "+s"(bar), "+s"(bx_));
        __builtin_amdgcn_s_waitcnt(0);
        unsigned nloc = b.st[0], nx = b.st[1];
        if (nloc == 0u) { xcd_barrier_complete(bar, bx_, nloc, nx); b.st[0] = nloc; b.st[1] = nx; }
        const unsigned old = xb_add(&bar[XB_XSUB(bx_)], 1u);
        const unsigned gen = old / nloc;
        if (old + 1u == (gen + 1u) * nloc) {
            __builtin_amdgcn_fence(__ATOMIC_RELEASE, "agent");
            asm volatile("s_waitcnt vmcnt(0)" ::: "memory");
            const unsigned og = xb_add(&bar[XB_TOP], 1u);
            const unsigned tg = og / nx;
            if (og + 1u == (tg + 1u) * nx) xb_add(&bar[XB_TOPGEN], 1u);
            else XB_SPIN(xb_ld(&bar[XB_TOPGEN]) == tg, bar);
            __builtin_amdgcn_fence(__ATOMIC_ACQUIRE, "agent");
            xb_add(&bar[XB_XGEN(bx_)], 1u);
            asm volatile("s_waitcnt vmcnt(0)" ::: "memory");
        } else {
            XB_SPIN(xb_ld(&bar[XB_XGEN(bx_)]) == gen, bar);
            __builtin_amdgcn_fence(__ATOMIC_ACQUIRE, "agent");
            asm volatile("s_waitcnt vmcnt(0)" ::: "memory");
        }
    }
    __syncthreads();
}

struct Ctx {
    LAS unsigned char* lds;
    int tid, lane, wave, G, bid;
    float* out; unsigned char* ws;
    __device__ __forceinline__ const float* inp(int i) const {
        const __attribute__((address_space(4))) unsigned char* kp = (const __attribute__((address_space(4))) unsigned char*)__builtin_amdgcn_kernarg_segment_ptr();
        asm volatile("" : "+s"(kp));
        return ((const float* const __attribute__((address_space(4)))*)kp)[i];
    }
};
enum { I_X = 0, I_NMIX, I_NFFN, I_HWIN, I_HWOUT, I_HGN, I_HLB, I_KVN, I_KVW, I_CPK, I_CW1K, I_CW2K, I_CPV, I_CW1V, I_CW2V, I_KN, I_NWIN, I_NWOUT, I_NQN, I_FGU, I_FDN, I_MR, I_MGU, I_MDN };

constexpr int MAXJOB = 64;
struct JobTab { unsigned long long src[MAXJOB], gain[MAXJOB], dst[MAXJOB]; int K[MAXJOB], Nsrc[MAXJOB], npb[MAXJOB], F[MAXJOB], rowoff[MAXJOB], istart[MAXJOB + 1]; int njobs; };
__device__ __forceinline__ void add_job(LAS JobTab* J, const float* src, const float* gain, bf16* dst, int K, int Nsrc, int Npad, int F, int rowoff) {
    const int j = J->njobs; J->src[j] = (unsigned long long)src; J->gain[j] = (unsigned long long)gain; J->dst[j] = (unsigned long long)dst;
    J->K[j] = K; J->Nsrc[j] = Nsrc; J->npb[j] = Npad / 32; J->F[j] = F; J->rowoff[j] = rowoff; J->istart[j + 1] = J->istart[j] + (K / 64) * (Npad / 32); J->njobs = j + 1;
}
__device__ __forceinline__ void transpose_item(const float* W, int K, int Nsrc, const float* gain, bf16* WT, int dstrow0, int k0, int n0, LAS float* scr, int lane) {
    const int c4 = lane & 7, kr = lane >> 3, n = n0 + 4 * c4; const bool okn = n < Nsrc;
    f32x4 v[8];
#pragma unroll
    for (int i = 0; i < 8; ++i) { const int kk = 8 * i + kr; v[i] = okn ? *(const f32x4*)(W + (size_t)(k0 + kk) * Nsrc + n) : (f32x4){0.f, 0.f, 0.f, 0.f}; }
#pragma unroll
    for (int i = 0; i < 8; ++i) { const int kk = 8 * i + kr; if (gain) v[i] = v[i] * gain[k0 + kk]; *(LAS f32x4*)(scr + kk * 36 + 4 * c4) = v[i]; }
    LDS_WAIT();
    const int c = lane & 7;
#pragma unroll
    for (int j = 0; j < 4; ++j) { const int nn = (lane >> 3) + 8 * j; const LAS float* s = scr + (8 * c) * 36 + nn;
        v4u o; o.x = pk2(s[0 * 36], s[1 * 36]); o.y = pk2(s[2 * 36], s[3 * 36]); o.z = pk2(s[4 * 36], s[5 * 36]); o.w = pk2(s[6 * 36], s[7 * 36]);
        *(v4u*)(WT + (size_t)(dstrow0 + nn) * K + k0 + 8 * c) = o; }
    LDS_WAIT();
}
__device__ __forceinline__ void norm_row_store(const f32x4 (&v)[4], bf16* orow, int lane) {
    float s = 0.f;
#pragma unroll
    for (int j = 0; j < 4; ++j) s += (v[j].x * v[j].x + v[j].y * v[j].y) + (v[j].z * v[j].z + v[j].w * v[j].w);
    const float rstd = rsqrtf(wave_sum(s) * (1.f / DM) + EPS);
    v2u* o8 = (v2u*)orow + lane;
#pragma unroll
    for (int j = 0; j < 4; ++j) { v2u w; w.x = pk2(v[j].x * rstd, v[j].y * rstd); w.y = pk2(v[j].z * rstd, v[j].w * rstd); o8[64 * j] = w; }
}
__device__ __forceinline__ void p_prologue(Ctx& C) {
    LAS JobTab* J = (LAS JobTab*)(C.lds + 73728);
    unsigned char* ws = C.ws;
    if (C.tid == 0) {
        J->njobs = 0; J->istart[0] = 0;
        for (int l = 0; l < 2; ++l) add_job(J, C.inp(I_HWIN) + (size_t)l * 1024 * 4096, C.inp(I_NMIX) + l * 1024, (bf16*)(ws + W_HIN) + (size_t)l * 4096 * 1024, 1024, 4096, 4096, 0, 0);
        for (int l = 0; l < 2; ++l) add_job(J, C.inp(I_HWOUT) + (size_t)l * 1024 * 1024, nullptr, (bf16*)(ws + W_HOUT) + (size_t)l * 1024 * 1024, 1024, 1024, 1024, 0, 0);
        add_job(J, C.inp(I_KVW), C.inp(I_KVN), (bf16*)(ws + W_KVQ), 1024, 1536, 1536, 0, 0);
        add_job(J, C.inp(I_NWIN), C.inp(I_NMIX) + 2048, (bf16*)(ws + W_KVQ), 1024, 1072, 1280, 0, 1536);
        add_job(J, C.inp(I_NWIN) + (size_t)1024 * 1072, C.inp(I_NMIX) + 3072, (bf16*)(ws + W_Q3), 1024, 1072, 1280, 0, 0);
        add_job(J, C.inp(I_CW1K), nullptr, (bf16*)(ws + W_CMP1), 2048, 256, 256, 0, 0);
        add_job(J, C.inp(I_CW1V), nullptr, (bf16*)(ws + W_CMP1) + (size_t)256 * 2048, 2048, 256, 256, 0, 0);
        for (int l = 0; l < 2; ++l) add_job(J, C.inp(I_NWOUT) + (size_t)l * 1024 * 1024, nullptr, (bf16*)(ws + W_NOUT) + (size_t)l * 1024 * 1024, 1024, 1024, 1024, 0, 0);
        for (int l = 0; l < 2; ++l) add_job(J, C.inp(I_FGU) + (size_t)l * 1024 * 2 * DFF, C.inp(I_NFFN) + (2 * l) * 1024, (bf16*)(ws + W_FGU) + (size_t)l * 2 * DFF * 1024, 1024, 2 * DFF, 2 * DFF, DFF, 0);
        for (int l = 0; l < 2; ++l) add_job(J, C.inp(I_FDN) + (size_t)l * DFF * 1024, nullptr, (bf16*)(ws + W_FDN) + (size_t)l * 1024 * DFF, DFF, 1024, 1024, 0, 0);
        for (int l = 0; l < 16; ++l) add_job(J, C.inp(I_MGU) + (size_t)l * 1024 * 2 * DFE, C.inp(I_NFFN) + (2 * (l >> 3) + 1) * 1024, (bf16*)(ws + W_MGU) + (size_t)l * 2 * DFE * 1024, 1024, 2 * DFE, 2 * DFE, DFE, 0);
        for (int l = 0; l < 16; ++l) add_job(J, C.inp(I_MDN) + (size_t)l * DFE * 1024, nullptr, (bf16*)(ws + W_MDN) + (size_t)l * 1024 * DFE, DFE, 1024, 1024, 0, 0);
    }
    __syncthreads();
    LAS float* scr = (LAS float*)(C.lds + C.wave * 9216);
    const int gw = C.bid * NWAVES + C.wave, NGW = C.G * NWAVES;
    const int nj = J->njobs, total = J->istart[nj];
    for (int it = gw; it < total; it += NGW) {
        int j = 0; while (j + 1 < nj && J->istart[j + 1] <= it) ++j;
        const int r = it - J->istart[j], npb = J->npb[j], kb = r / npb, nb = r % npb, n0 = 32 * nb, F = J->F[j];
        int drow = J->rowoff[j] + n0;
        if (F) drow = (n0 < F) ? 256 * (n0 / 128) + (n0 % 128) : 256 * ((n0 - F) / 128) + 128 + ((n0 - F) % 128);
        transpose_item((const float*)J->src[j], J->K[j], J->Nsrc[j], (const float*)J->gain[j], (bf16*)J->dst[j], drow, 64 * kb, n0, scr, C.lane);
    }
    { const int gt = C.bid * 512 + C.tid;
      if (gt < 1024) { const float a0 = C.inp(I_HLB)[gt], a1 = C.inp(I_HLB)[1024 + gt]; const float mx = fmaxf(a0, a1), e0 = expf(a0 - mx), e1 = expf(a1 - mx), s = e0 + e1;
          const float s0 = e0 / s, s1 = e1 / s, lb1 = (s0 + s1) - s0;
          float* la = (float*)(ws + WS_LA); float* l1 = (float*)(ws + WS_L1);
          la[gt] = -INFINITY; l1[gt] = 0.f; la[1024 + gt] = logf(lb1); l1[1024 + gt] = log1pf(-lb1); } }
    if (C.bid == 0 && C.tid < 128) ((int*)(ws + WS_RTAB))[2048 + C.tid] = C.tid >> 6;
    if (C.bid == (C.G > 1 ? 1 : 0)) { const int which = C.tid >> 8, j = C.tid & 255; const float* pos = C.inp(which ? I_CPV : I_CPK); const float* w1 = C.inp(which ? I_CW1V : I_CW1K);
        float a = 0.f; for (int i = 0; i < 2048; ++i) a += pos[i] * w1[(size_t)i * 256 + j];
        ((float*)(ws + WS_CB))[which * 256 + j] = a; }
    for (int c = C.bid; c < 256; c += C.G)
        for (int i = 0; i < 32; i += 4) { f32x4 v[4][4]; const float* xb = C.inp(I_X);
#pragma unroll
            for (int r = 0; r < 4; ++r) { const f32x4* xr = (const f32x4*)(xb + (size_t)(c * 256 + C.wave * 32 + i + r) * DM) + C.lane;
#pragma unroll
                for (int j = 0; j < 4; ++j) v[r][j] = xr[64 * j]; }
#pragma unroll
            for (int r = 0; r < 4; ++r) norm_row_store(v[r], (bf16*)(ws + WS_XN) + (size_t)(c * 256 + C.wave * 32 + i + r) * DM, C.lane); }
}

template <bool MOE_ADD, bool ROUTER, bool WRITE_XN>
__device__ __forceinline__ void p_norm(Ctx& C, const float* rw, const float* rgain) {
    unsigned char* ws = C.ws;
    LAS int* cnt8 = (LAS int*)(C.lds + 1024);
    const bf16* Y = (const bf16*)(ws + R_XP);
    const int4* route = (const int4*)(ws + WS_ROUTE); const int2* slot = (const int2*)(ws + WS_SLOT);
    constexpr int NR = (MOE_ADD || ROUTER) ? 2 : 4;
    for (int c = C.bid; c < 256; c += C.G) {
        if (ROUTER) { __syncthreads(); if (C.tid < 8) cnt8[C.tid] = 0; __syncthreads(); }
#pragma unroll 1
        for (int i = 0; i < 32; i += NR) {
            f32x4 v[NR][4];
#pragma unroll
            for (int r = 0; r < NR; ++r) { const float* hr = C.out + (size_t)(c * 256 + C.wave * 32 + i + r) * DM;
#pragma unroll
                for (int j = 0; j < 4; ++j) v[r][j] = ((const f32x4*)hr + C.lane)[64 * j]; }
            if (MOE_ADD) {
#pragma unroll
                for (int r = 0; r < NR; ++r) { const int row = c * 256 + C.wave * 32 + i + r; float* hr = C.out + (size_t)row * DM;
                    const int4 rt = route[row]; const int2 sl = slot[row]; const float w0 = __builtin_bit_cast(float, rt.y), w1 = __builtin_bit_cast(float, rt.z);
                    const v2u* y0 = (const v2u*)(Y + (size_t)sl.x * DM) + C.lane; const v2u* y1 = (const v2u*)(Y + (size_t)sl.y * DM) + C.lane;
#pragma unroll
                    for (int j = 0; j < 4; ++j) { const v2u a = y0[64 * j], b = y1[64 * j];
                        v[r][j].x += w0 * bflo(a.x) + w1 * bflo(b.x); v[r][j].y += w0 * bfhi(a.x) + w1 * bfhi(b.x); v[r][j].z += w0 * bflo(a.y) + w1 * bflo(b.y); v[r][j].w += w0 * bfhi(a.y) + w1 * bfhi(b.y);
                        ((f32x4*)hr + C.lane)[64 * j] = v[r][j]; } }
            }
            if (WRITE_XN || ROUTER) {
#pragma unroll
                for (int r = 0; r < NR; ++r) { const int row = c * 256 + C.wave * 32 + i + r;
                    float s = 0.f;
#pragma unroll
                    for (int j = 0; j < 4; ++j) s += (v[r][j].x * v[r][j].x + v[r][j].y * v[r][j].y) + (v[r][j].z * v[r][j].z + v[r][j].w * v[r][j].w);
                    const float rstd = rsqrtf(wave_sum(s) * (1.f / DM) + EPS);
                    if (WRITE_XN) { v2u* o8 = (v2u*)((bf16*)(ws + WS_XN) + (size_t)row * DM) + C.lane;
#pragma unroll
                        for (int j = 0; j < 4; ++j) { v2u w; w.x = pk2(v[r][j].x * rstd, v[r][j].y * rstd); w.y = pk2(v[r][j].z * rstd, v[r][j].w * rstd); o8[64 * j] = w; } }
                    if (ROUTER) {
                        float lg[8];
#pragma unroll
                        for (int e = 0; e < 8; ++e) lg[e] = 0.f;
#pragma unroll
                        for (int j = 0; j < 4; ++j) { const int k0 = 4 * C.lane + 256 * j; const f32x4 g4 = *(const f32x4*)(rgain + k0);
#pragma unroll
                            for (int q = 0; q < 4; ++q) { const float xv = v[r][j][q] * rstd * g4[q]; const f32x4 wa = *(const f32x4*)(rw + (size_t)(k0 + q) * 8), wb = *(const f32x4*)(rw + (size_t)(k0 + q) * 8 + 4);
                                lg[0] += xv * wa.x; lg[1] += xv * wa.y; lg[2] += xv * wa.z; lg[3] += xv * wa.w; lg[4] += xv * wb.x; lg[5] += xv * wb.y; lg[6] += xv * wb.z; lg[7] += xv * wb.w; } }
#pragma unroll
                        for (int e = 0; e < 8; ++e) lg[e] = wave_sum(lg[e]);
                        int e0 = 0; float v0 = lg[0];
#pragma unroll
                        for (int e = 1; e < 8; ++e) if (lg[e] > v0) { v0 = lg[e]; e0 = e; }
                        int e1 = -1; float v1 = -INFINITY;
#pragma unroll
                        for (int e = 0; e < 8; ++e) if (e != e0 && (e1 < 0 || lg[e] > v1)) { v1 = lg[e]; e1 = e; }
                        const float ex = expf(v1 - v0), w0 = 1.f / (1.f + ex), w1 = ex / (1.f + ex);
                        if (C.lane == 0) { ((int4*)(ws + WS_ROUTE))[row] = make_int4(e0 | (e1 << 8), __builtin_bit_cast(int, w0), __builtin_bit_cast(int, w1), 0);
                            atomicAdd((int*)&cnt8[e0], 1); atomicAdd((int*)&cnt8[e1], 1); }
                    }
                }
            }
        }
        if (ROUTER) { __syncthreads(); if (C.tid < 8) ((int*)(ws + WS_RCNT))[c * 8 + C.tid] = cnt8[C.tid]; }
    }
}

__device__ __forceinline__ void p_gather(Ctx& C) {
    unsigned char* ws = C.ws;
    LAS int* tot = (LAS int*)(C.lds + 0);
    LAS int* pre = tot + 8;
    LAS int* base = tot + 16;
    LAS int* ee = tot + 32;
    LAS int* sl = tot + 32 + 256;
    const int* rcnt = (const int*)(ws + WS_RCNT);
    const int4* route = (const int4*)(ws + WS_ROUTE);
    for (int c = C.bid; c < 256; c += C.G) {
        __syncthreads();
        { const int e = C.wave; int t = 0, p = 0;
          for (int i = C.lane; i < 256; i += 64) { const int v = rcnt[i * 8 + e]; t += v; if (i < c) p += v; }
#pragma unroll
          for (int o = 32; o >= 1; o >>= 1) { t += __shfl_xor(t, o); p += __shfl_xor(p, o); }
          if (C.lane == 0) { tot[e] = t; pre[e] = p; } }
        if (C.tid < 256) ee[C.tid] = route[c * 256 + C.tid].x;
        __syncthreads();
        if (C.tid == 0) { int off = 0; for (int e = 0; e < 8; ++e) { base[e] = off + pre[e]; const int nt = (tot[e] + 255) >> 8;
                if (c == 0) { int* te = (int*)(ws + WS_RTAB); for (int q = 0; q < nt; ++q) te[(off >> 8) + q] = e; }
                off += nt << 8; }
            if (c == 0) ((int*)(ws + WS_RTAB))[1024] = off >> 8; }
        __syncthreads();
        if (C.tid < 8) { const int e = C.tid; int r = base[e];
            for (int i = 0; i < 256; ++i) { const int pk = ee[i]; if ((pk & 255) == e) sl[2 * i] = r++; if ((pk >> 8) == e) sl[2 * i + 1] = r++; } }
        __syncthreads();
        if (C.tid < 256) ((int2*)(ws + WS_SLOT))[c * 256 + C.tid] = make_int2(sl[2 * C.tid], sl[2 * C.tid + 1]);
        for (int i = 0; i < 32; ++i) { const int tl = C.wave * 32 + i, row = c * 256 + tl;
            const v4u* src = (const v4u*)((const bf16*)(ws + WS_XN) + (size_t)row * DM) + C.lane; const v4u a = src[0], b = src[64];
            v4u* d0 = (v4u*)((bf16*)(ws + R_XP) + (size_t)sl[2 * tl] * DM) + C.lane; v4u* d1 = (v4u*)((bf16*)(ws + R_XP) + (size_t)sl[2 * tl + 1] * DM) + C.lane;
            d0[0] = a; d0[64] = b; d1[0] = a; d1[64] = b; }
    }
}

__device__ __forceinline__ void p_post_kv(Ctx& C) {
    unsigned char* ws = C.ws;
    const bf16* raw = (const bf16*)(ws + R_QKV);
    const float* kn = C.inp(I_KN);
    LAS unsigned char* tl = C.lds + C.wave * 4608;
    const int l = C.lane, c8 = l & 7, r8 = l >> 3, gw = C.bid * NWAVES + C.wave, NGW = C.G * NWAVES;
    for (int it = gw; it < 128 * 64; it += NGW) {
        const int bg = it >> 6, blk = it & 63, b = bg >> 2, g = bg & 3;
        const bf16* rb = raw + (size_t)(b * SEQ + blk * 32) * 2816 + g * 64 + 8 * c8;
        const size_t dst0 = ((size_t)bg * SEQ + blk * 32) * 64 + 8 * c8;
#pragma unroll
        for (int j = 0; j < 6; ++j) {
            v4u x[4];
#pragma unroll
            for (int i = 0; i < 4; ++i) x[i] = *(const v4u*)(rb + (size_t)(r8 + 8 * i) * 2816 + j * 256);
            if (j == 0 || j == 1) {
                bf16* d = (bf16*)(ws + (j == 0 ? R_KCR : R_VCR)) + dst0;
#pragma unroll
                for (int i = 0; i < 4; ++i) *(v4u*)(d + (size_t)(r8 + 8 * i) * 64) = x[i];
            } else if (j == 2 || j == 4) {
                bf16* d = (bf16*)(ws + (j == 2 ? R_KS : R_KW)) + dst0; const float* gk = kn + (j == 2 ? 64 : 128) + 8 * c8;
                const f32x4 ga = *(const f32x4*)gk, gb = *(const f32x4*)(gk + 4);
#pragma unroll
                for (int i = 0; i < 4; ++i) { const float f[8] = {bflo(x[i].x), bfhi(x[i].x), bflo(x[i].y), bfhi(x[i].y), bflo(x[i].z), bfhi(x[i].z), bflo(x[i].w), bfhi(x[i].w)};
                    float ss = (f[0] * f[0] + f[1] * f[1]) + (f[2] * f[2] + f[3] * f[3]) + (f[4] * f[4] + f[5] * f[5]) + (f[6] * f[6] + f[7] * f[7]);
                    ss += __shfl_xor(ss, 1); ss += __shfl_xor(ss, 2); ss += __shfl_xor(ss, 4);
                    const float rs = rsqrtf(ss * (1.f / 64.f) + EPS);
                    v4u o; o.x = pk2(f[0] * rs * ga.x, f[1] * rs * ga.y); o.y = pk2(f[2] * rs * ga.z, f[3] * rs * ga.w); o.z = pk2(f[4] * rs * gb.x, f[5] * rs * gb.y); o.w = pk2(f[6] * rs * gb.z, f[7] * rs * gb.w);
                    *(v4u*)(d + (size_t)(r8 + 8 * i) * 64) = o; }
            } else {
#pragma unroll
                for (int i = 0; i < 4; ++i) *(LAS v4u*)(tl + (r8 + 8 * i) * 144 + 16 * c8) = x[i];
                LDS_WAIT();
                unsigned wv[16];
#pragma unroll
                for (int t2 = 0; t2 < 16; ++t2) { const unsigned lo = *(const LAS bf16*)(tl + (2 * t2) * 144 + 2 * l), hi = *(const LAS bf16*)(tl + (2 * t2 + 1) * 144 + 2 * l); wv[t2] = lo | (hi << 16); }
                bf16* d = (bf16*)(ws + (j == 3 ? R_VST : R_VWT)) + (((size_t)bg * 64 + blk) * 64 + l) * 32;
#pragma unroll
                for (int q = 0; q < 4; ++q) { const v4u o = {wv[4 * q], wv[4 * q + 1], wv[4 * q + 2], wv[4 * q + 3]}; *(v4u*)(d + 8 * q) = o; }
                LDS_WAIT();
            }
        }
    }
}

__device__ __forceinline__ void p_cmp2(Ctx& C) {
    unsigned char* ws = C.ws;
    const bf16* Hk = (const bf16*)(ws + WS_HC); const bf16* Hv = Hk + (size_t)16384 * 256;
    const float* w2k = C.inp(I_CW2K); const float* w2v = C.inp(I_CW2V); const float* kn = C.inp(I_KN);
    LAS float* hk = (LAS float*)(C.lds + C.wave * 2048); LAS float* hv = hk + 256;
    const int l = C.lane, gw = C.bid * NWAVES + C.wave, NGW = C.G * NWAVES;
    for (int r = gw; r < 16384; r += NGW) {
        const int bg = r >> 7, c = r & 127;
        { const v2u a = *((const v2u*)(Hk + (size_t)r * 256) + l), bq = *((const v2u*)(Hv + (size_t)r * 256) + l);
          hk[4 * l] = bflo(a.x); hk[4 * l + 1] = bfhi(a.x); hk[4 * l + 2] = bflo(a.y); hk[4 * l + 3] = bfhi(a.y);
          hv[4 * l] = bflo(bq.x); hv[4 * l + 1] = bfhi(bq.x); hv[4 * l + 2] = bflo(bq.y); hv[4 * l + 3] = bfhi(bq.y); }
        LDS_WAIT();
        float ak = 0.f, av = 0.f;
#pragma unroll 8
        for (int j = 0; j < 256; ++j) { ak += hk[j] * w2k[j * 64 + l]; av += hv[j] * w2v[j * 64 + l]; }
        if (c == 127) { ak = 0.f; av = 0.f; }
        const float rs = rsqrtf(wave_sum(ak * ak) * (1.f / 64.f) + EPS);
        ((bf16*)(ws + WS_KC))[(size_t)r * 64 + l] = (bf16)f2bf(ak * rs * kn[l]);
        ((bf16*)(ws + WS_VCT))[(((size_t)bg * 4 + (c >> 5)) * 64 + l) * 32 + (c & 31)] = (bf16)f2bf(av);
        LDS_WAIT();
    }
}

typedef short bf16x8v __attribute__((ext_vector_type(8)));
#define MFMA16(a, b, c) __builtin_amdgcn_mfma_f32_16x16x32_bf16((a), (b), (c), 0, 0, 0)
constexpr float LOG2E = 1.4426950408889634f;
template <int MODE>
__device__ __forceinline__ void attn_step(const bf16* __restrict__ Kb, const bf16* __restrict__ Vb, unsigned koff, unsigned voff, int k0, int trel, bool tokok, int cmax,
                                          const bf16x8v (&qf)[2][2], float (&m)[2], float (&ls)[2], f32x4 (&o)[2][4], const float (&sl2)[2], int q4) {
    const char* kblk = (const char*)(Kb + (size_t)k0 * 64); const char* vblk = (const char*)(Vb + (size_t)k0 * 64);
    bf16x8v ka[2], kb[2], vf[4];
#pragma unroll
    for (int ks = 0; ks < 2; ++ks) { ka[ks] = *(const bf16x8v*)(kblk + koff + 64 * ks); kb[ks] = *(const bf16x8v*)(kblk + koff + 512 + 64 * ks); }
#pragma unroll
    for (int dt = 0; dt < 4; ++dt) vf[dt] = *(const bf16x8v*)(vblk + voff + 1024 * dt);
    constexpr int DMUL = (MODE == 0) ? 16 : 1;
    float dist[8]; bool ok[8];
#pragma unroll
    for (int i = 0; i < 8; ++i) { const int kk = 8 * q4 + i; const int d = trel - DMUL * kk; dist[i] = (float)d;
        ok[i] = (MODE == 0) ? (k0 + kk <= cmax) : (MODE == 1 ? (tokok && d >= 0) : (d >= 0 && d < 512)); }
#pragma unroll
    for (int h = 0; h < 2; ++h) {
        f32x4 sa = {0.f, 0.f, 0.f, 0.f}, sb = {0.f, 0.f, 0.f, 0.f};
        sa = MFMA16(ka[0], qf[h][0], sa); sb = MFMA16(kb[0], qf[h][0], sb); sa = MFMA16(ka[1], qf[h][1], sa); sb = MFMA16(kb[1], qf[h][1], sb);
        float s[8]; float mx = -1e30f;
#pragma unroll
        for (int i = 0; i < 8; ++i) { const float raw = i < 4 ? sa[i] : sb[i - 4]; s[i] = raw - sl2[h] * dist[i]; mx = ok[i] ? fmaxf(mx, s[i]) : mx; }
        mx = fmaxf(mx, __shfl_xor(mx, 16)); mx = fmaxf(mx, __shfl_xor(mx, 32));
        const float mnew = fmaxf(m[h], mx), alpha = __builtin_amdgcn_exp2f(m[h] - mnew); m[h] = mnew;
        float p[8]; float psum = 0.f;
#pragma unroll
        for (int i = 0; i < 8; ++i) { p[i] = ok[i] ? __builtin_amdgcn_exp2f(s[i] - mnew) : 0.f; psum += p[i]; }
        ls[h] = ls[h] * alpha + psum;
        bf16x8v pf; { const unsigned w0 = pg8::cvt_pk_bf16(p[0], p[1]), w1 = pg8::cvt_pk_bf16(p[2], p[3]), w2 = pg8::cvt_pk_bf16(p[4], p[5]), w3 = pg8::cvt_pk_bf16(p[6], p[7]);
            const v4u w = {w0, w1, w2, w3}; pf = __builtin_bit_cast(bf16x8v, w); }
#pragma unroll
        for (int dt = 0; dt < 4; ++dt) { o[h][dt] = o[h][dt] * alpha; o[h][dt] = MFMA16(vf[dt], pf, o[h][dt]); }
    }
}
constexpr int PSW = 132;
__device__ __forceinline__ void p_attn_fast(Ctx& C, unsigned* queue, const int ld, const int qo, const float* qn) {
    unsigned char* ws = C.ws;
    const bf16* Qraw = (const bf16*)(ws + R_QKV);
    const bf16* KC = (const bf16*)(ws + WS_KC); const bf16* VCT = (const bf16*)(ws + WS_VCT);
    const bf16* KS = (const bf16*)(ws + R_KS); const bf16* VST = (const bf16*)(ws + R_VST); const bf16* KW = (const bf16*)(ws + R_KW); const bf16* VWT = (const bf16*)(ws + R_VWT);
    bf16* O = (bf16*)(ws + R_O);
    LAS float* psl = (LAS float*)(C.lds + C.wave * (16 * PSW * 4));
    const int l = C.lane, r16 = l & 15, q4 = l >> 4;
    const unsigned koff = (unsigned)(((8 * (r16 >> 2) + (r16 & 3)) * 64 + 8 * q4) * 2), voff = (unsigned)((r16 * 32 + 8 * q4) * 2);
    for (;;) {
        unsigned u = 0; if (l == 0) u = __hip_atomic_fetch_add(queue, 1u, __ATOMIC_RELAXED, __HIP_MEMORY_SCOPE_AGENT);
        u = (unsigned)__builtin_amdgcn_readfirstlane((int)u);
        if (u >= 16384u) break;
        const int bg = (int)(u >> 7), tile = 127 - (int)(u & 127), g = bg & 3, b = bg >> 2, t0 = tile * 16, t = t0 + r16, row = b * SEQ + t;
        const bf16* qrow = Qraw + (size_t)row * ld + qo; const bf16* gtp = qrow + 1024 + g * 12;
#define ATT_GATE(idx) (1.f / (1.f + __expf(-bf2f(gtp[(idx)]))))
        bf16* orow = O + (size_t)row * DM + g * 256 + 4 * q4;
        bf16x8v qf[2][2]; float sl2[2]; float m[2], ls[2]; f32x4 o[2][4];
#define ATT_LOADQ(hp) do { _Pragma("unroll") for (int h = 0; h < 2; ++h) { sl2[h] = exp2f(-0.5f * (float)(g * 4 + 2 * (hp) + h + 1)) * LOG2E; \
            float xq_[2][8]; float ssq_ = 0.f; \
            _Pragma("unroll") for (int ks = 0; ks < 2; ++ks) { const v4u r_ = *(const v4u*)(qrow + (g * 4 + 2 * (hp) + h) * 64 + 32 * ks + 8 * q4); \
                xq_[ks][0] = bflo(r_.x); xq_[ks][1] = bfhi(r_.x); xq_[ks][2] = bflo(r_.y); xq_[ks][3] = bfhi(r_.y); xq_[ks][4] = bflo(r_.z); xq_[ks][5] = bfhi(r_.z); xq_[ks][6] = bflo(r_.w); xq_[ks][7] = bfhi(r_.w); \
                _Pragma("unroll") for (int j_ = 0; j_ < 8; ++j_) ssq_ += xq_[ks][j_] * xq_[ks][j_]; } \
            ssq_ += __shfl_xor(ssq_, 16); ssq_ += __shfl_xor(ssq_, 32); \
            const float rq_ = rsqrtf(ssq_ * (1.f / 64.f) + EPS) * (0.125f * LOG2E); \
            _Pragma("unroll") for (int ks = 0; ks < 2; ++ks) { const f32x4 ga_ = *(const f32x4*)(qn + 32 * ks + 8 * q4), gb_ = *(const f32x4*)(qn + 32 * ks + 8 * q4 + 4); \
                const v4u w_ = {pg8::cvt_pk_bf16(xq_[ks][0] * rq_ * ga_.x, xq_[ks][1] * rq_ * ga_.y), pg8::cvt_pk_bf16(xq_[ks][2] * rq_ * ga_.z, xq_[ks][3] * rq_ * ga_.w), \
                                pg8::cvt_pk_bf16(xq_[ks][4] * rq_ * gb_.x, xq_[ks][5] * rq_ * gb_.y), pg8::cvt_pk_bf16(xq_[ks][6] * rq_ * gb_.z, xq_[ks][7] * rq_ * gb_.w)}; \
                qf[h][ks] = __builtin_bit_cast(bf16x8v, w_); } } } while (0)
#define ATT_RESET() do { _Pragma("unroll") for (int h = 0; h < 2; ++h) { m[h] = -1e30f; ls[h] = 0.f; _Pragma("unroll") for (int dt = 0; dt < 4; ++dt) o[h][dt] = (f32x4){0.f, 0.f, 0.f, 0.f}; } } while (0)
        const int cmax = t >= 31 ? (((t - 31) >> 4) < 126 ? ((t - 31) >> 4) : 126) : -1;
        const bf16* KCb = KC + (size_t)bg * 128 * 64; const bf16* VCb = VCT + (size_t)bg * 128 * 64;
        const int ncs = ((t0 + 15 - 31) >> 4) < 0 ? 0 : ((((t0 + 15 - 31) >> 4) < 126 ? ((t0 + 15 - 31) >> 4) : 126) >> 5) + 1;
#pragma unroll 1
        for (int hp = 0; hp < 2; ++hp) {
            ATT_LOADQ(hp); ATT_RESET();
            for (int st = 0; st < ncs; ++st) attn_step<0>(KCb, VCb, koff, voff, 32 * st, t - 31 - 16 * 32 * st, true, cmax, qf, m, ls, o, sl2, q4);
#pragma unroll
            for (int h = 0; h < 2; ++h) { float lt = ls[h]; lt += __shfl_xor(lt, 16); lt += __shfl_xor(lt, 32); ls[h] = lt;
                const float sc_ = lt > 0.f ? ATT_GATE((2 * hp + h) * 3 + 0) / lt : 0.f;
#pragma unroll
                for (int dt = 0; dt < 4; ++dt) { const f32x4 r_ = o[h][dt] * sc_; v2u w; w.x = pg8::cvt_pk_bf16(r_[0], r_[1]); w.y = pg8::cvt_pk_bf16(r_[2], r_[3]);
                    *(v2u*)(orow + (2 * hp + h) * 64 + 16 * dt) = w; } }
            float ps[4][8];
#pragma unroll
            for (int st = 0; st < 4; ++st)
#pragma unroll
                for (int i = 0; i < 8; ++i) ps[st][i] = 0.f;
#pragma unroll
            for (int st = 0; st < 4; ++st) {
                if (st < ncs) {
                    const int k0 = 32 * st; const char* kblk = (const char*)(KCb + (size_t)k0 * 64);
                    bf16x8v ka[2], kb[2];
#pragma unroll
                    for (int ks = 0; ks < 2; ++ks) { ka[ks] = *(const bf16x8v*)(kblk + koff + 64 * ks); kb[ks] = *(const bf16x8v*)(kblk + koff + 512 + 64 * ks); }
#pragma unroll
                    for (int h = 0; h < 2; ++h) {
                        f32x4 sa = {0.f, 0.f, 0.f, 0.f}, sb = {0.f, 0.f, 0.f, 0.f};
                        sa = MFMA16(ka[0], qf[h][0], sa); sb = MFMA16(kb[0], qf[h][0], sb); sa = MFMA16(ka[1], qf[h][1], sa); sb = MFMA16(kb[1], qf[h][1], sb);
                        const float inv = ls[h] > 0.f ? 1.f / ls[h] : 0.f;
#pragma unroll
                        for (int i = 0; i < 8; ++i) { const int c = k0 + 8 * q4 + i; const float raw = i < 4 ? sa[i] : sb[i - 4];
                            const float s = raw - sl2[h] * (float)(t - 31 - 16 * c); ps[st][i] += (c <= cmax) ? __builtin_amdgcn_exp2f(s - m[h]) * inv : 0.f; }
                    }
                }
            }
#pragma unroll
            for (int st = 0; st < 4; ++st) { LAS f32x4* p0 = (LAS f32x4*)(psl + r16 * PSW + 32 * st + 8 * q4);
                f32x4 a = {ps[st][0], ps[st][1], ps[st][2], ps[st][3]}, bq = {ps[st][4], ps[st][5], ps[st][6], ps[st][7]};
                if (hp) { a = a + p0[0]; bq = bq + p0[1]; }
                p0[0] = a; p0[1] = bq; }
            LDS_WAIT();
        }
        unsigned mlo, mhi;
        {
            float sc[16]; const LAS float* pr = psl + r16 * PSW + 32 * q4; const int cur = t >> 5;
            float prev = q4 > 0 ? pr[-1] : 0.f;
#pragma unroll
            for (int jj = 0; jj < 16; ++jj) { const float a = pr[2 * jj], bq = pr[2 * jj + 1]; const float imp = prev + a + bq; prev = bq;
                const int j = 16 * q4 + jj; const bool valid = 32 * j <= t; const bool forced = valid && (j == 0 || j == cur || j == cur - 1);
                sc[jj] = forced ? 1e9f : (valid ? imp : -1e9f); }
            unsigned my = 0u;
            for (int r = 0; r < 8; ++r) {
                float best = sc[0]; int bi = 0;
#pragma unroll
                for (int jj = 1; jj < 16; ++jj) if (sc[jj] > best) { best = sc[jj]; bi = jj; }
                bi += 16 * q4;
#pragma unroll
                for (int sh = 16; sh <= 32; sh <<= 1) { const float ov = __shfl_xor(best, sh); const int oi = __shfl_xor(bi, sh); if (ov > best || (ov == best && oi < bi)) { best = ov; bi = oi; } }
                if ((bi >> 4) == q4) { const int jj0 = bi & 15; if (best > -0.5e9f) my |= 1u << jj0;
#pragma unroll
                    for (int jj = 0; jj < 16; ++jj) if (jj == jj0) sc[jj] = -INFINITY; }
            }
            mlo = (q4 == 0 ? my : 0u) | (q4 == 1 ? my << 16 : 0u); mhi = (q4 == 2 ? my : 0u) | (q4 == 3 ? my << 16 : 0u);
            mlo |= __shfl_xor(mlo, 16); mlo |= __shfl_xor(mlo, 32); mhi |= __shfl_xor(mhi, 16); mhi |= __shfl_xor(mhi, 32);
        }
        LDS_WAIT();
        unsigned ulo = mlo, uhi = mhi;
#pragma unroll
        for (int sh = 1; sh <= 8; sh <<= 1) { ulo |= __shfl_xor(ulo, sh); uhi |= __shfl_xor(uhi, sh); }
        const unsigned long long un0 = ((unsigned long long)(unsigned)__builtin_amdgcn_readfirstlane((int)uhi) << 32) | (unsigned)__builtin_amdgcn_readfirstlane((int)ulo);
        const unsigned long long mine = ((unsigned long long)mhi << 32) | mlo;
#pragma unroll 1
        for (int hp = 0; hp < 2; ++hp) {
            ATT_LOADQ(hp);
            f32x4 oacc[2][4];
            {
                const bf16* Kb = KS + (size_t)bg * SEQ * 64; const bf16* Vb = VST + (size_t)bg * SEQ * 64;
                ATT_RESET();
                unsigned long long un = un0;
                while (un) { const int j = __builtin_ctzll(un); un &= un - 1;
                    attn_step<1>(Kb, Vb, koff, voff, 32 * j, t - 32 * j, ((mine >> j) & 1ull) != 0ull, 0, qf, m, ls, o, sl2, q4); }
#pragma unroll
                for (int h = 0; h < 2; ++h) { float lt = ls[h]; lt += __shfl_xor(lt, 16); lt += __shfl_xor(lt, 32); const float sc_ = lt > 0.f ? ATT_GATE((2 * hp + h) * 3 + 1) / lt : 0.f;
#pragma unroll
                    for (int dt = 0; dt < 4; ++dt) oacc[h][dt] = o[h][dt] * sc_; }
            }
            {
                const bf16* Kb = KW + (size_t)bg * SEQ * 64; const bf16* Vb = VWT + (size_t)bg * SEQ * 64;
                const int sb = t0 >= 511 ? (t0 - 511) >> 5 : 0, se = t0 >> 5;
                ATT_RESET();
                for (int st = sb; st <= se; ++st) attn_step<2>(Kb, Vb, koff, voff, 32 * st, t - 32 * st, true, 0, qf, m, ls, o, sl2, q4);
#pragma unroll
                for (int h = 0; h < 2; ++h) { float lt = ls[h]; lt += __shfl_xor(lt, 16); lt += __shfl_xor(lt, 32); const float sc_ = lt > 0.f ? ATT_GATE((2 * hp + h) * 3 + 2) / lt : 0.f;
#pragma unroll
                    for (int dt = 0; dt < 4; ++dt) oacc[h][dt] = oacc[h][dt] + o[h][dt] * sc_; }
            }
#pragma unroll
            for (int h = 0; h < 2; ++h)
#pragma unroll
                for (int dt = 0; dt < 4; ++dt) { v2u* op = (v2u*)(orow + (2 * hp + h) * 64 + 16 * dt); const v2u c_ = *op; const f32x4 r_ = oacc[h][dt];
                    v2u w; w.x = pg8::cvt_pk_bf16(r_[0] + bflo(c_.x), r_[1] + bfhi(c_.x)); w.y = pg8::cvt_pk_bf16(r_[2] + bflo(c_.y), r_[3] + bfhi(c_.y)); *op = w; }
        }
#undef ATT_LOADQ
#undef ATT_RESET
#undef ATT_GATE
    }
}

constexpr int SCQ = 272, SCT = 144;
constexpr int LQ_ = 0, LK_ = 17408, LKT_ = 34816, LVT_ = 53248, LP_ = 71680, LO_ = 80896, LE_ = 114688, LT_ = 115712;
__device__ __forceinline__ void p_scan_fast(Ctx& C, int layer) {
    unsigned char* ws = C.ws;
    const bf16* Pq = (const bf16*)(ws + R_PQ); const bf16* Pi = (const bf16*)(ws + R_PI); const bf16* Pg = (const bf16*)(ws + R_PG); const float* LF = (const float*)(ws + R_LF);
    bf16* O2 = (bf16*)(ws + R_O2);
    const float* gn = C.inp(I_HGN) + layer * 128;
    LAS unsigned char* L = C.lds;
    const int tid = C.tid, lane = C.lane, w = C.wave, r16 = lane & 15, q4 = lane >> 4, k = tid & 127, seg = tid >> 7;
    LAS float* tot = (LAS float*)(L + LT_); LAS float* eref = (LAS float*)(L + LE_); LAS float* elr = eref + 128;
    { const int tile = tid >> 8, e = tid & 255, row = e >> 4, col = e & 15;
      *(LAS bf16*)(L + LP_ + ((tile ? 32 : 0) + row) * SCT + ((tile ? 48 : 16) + col) * 2) = 0; }
    for (int bh = C.bid; bh < 256; bh += C.G) {
        const int b = bh >> 3, h = bh & 7;
        const size_t base = (size_t)(b * SEQ) * DM + h * 128;
        f32x4 S[8];
#pragma unroll
        for (int i = 0; i < 8; ++i) S[i] = (f32x4){0.f, 0.f, 0.f, 0.f};
        bf16 qv[16], vv[16]; float lf[16];
#define SC_LOAD(t0) do { _Pragma("unroll") for (int i = 0; i < 16; ++i) { const size_t off = base + (size_t)((t0) + 16 * seg + i) * DM + k; qv[i] = Pq[off]; vv[i] = Pi[off]; lf[i] = LF[off]; } } while (0)
        SC_LOAD(0);
#pragma unroll 1
        for (int c = 0; c < SEQ / 64; ++c) {
            const int t0 = c * 64;
            float cs[16]; { float run = 0.f;
#pragma unroll
                for (int i = 0; i < 16; ++i) { run += lf[i]; cs[i] = run; }
                tot[seg * 128 + k] = run; }
            __syncthreads();
            { const float a0 = tot[k], a1 = tot[128 + k], a2 = tot[256 + k], a3 = tot[384 + k];
              const float off = seg == 0 ? 0.f : (seg == 1 ? a0 : (seg == 2 ? a0 + a1 : a0 + a1 + a2)), ref = a0 + a1, last = ref + a2 + a3;
              unsigned kt[16];
#pragma unroll
              for (int i = 0; i < 16; ++i) { const float d = off + cs[i] - ref; const float qt = bf2f(qv[i]) * __expf(fminf(d, 80.f)), ktv = (1.f - __expf(lf[i])) * __expf(fminf(-d, 80.f));
                  const int s = 16 * seg + i; kt[i] = f2bf(ktv);
                  *(LAS bf16*)(L + LQ_ + s * SCQ + k * 2) = (bf16)f2bf(qt); *(LAS bf16*)(L + LK_ + s * SCQ + k * 2) = (bf16)kt[i]; }
              v4u w0, w1, x0, x1;
              w0.x = kt[0] | (kt[1] << 16); w0.y = kt[2] | (kt[3] << 16); w0.z = kt[4] | (kt[5] << 16); w0.w = kt[6] | (kt[7] << 16);
              w1.x = kt[8] | (kt[9] << 16); w1.y = kt[10] | (kt[11] << 16); w1.z = kt[12] | (kt[13] << 16); w1.w = kt[14] | (kt[15] << 16);
              x0.x = vv[0] | ((unsigned)vv[1] << 16); x0.y = vv[2] | ((unsigned)vv[3] << 16); x0.z = vv[4] | ((unsigned)vv[5] << 16); x0.w = vv[6] | ((unsigned)vv[7] << 16);
              x1.x = vv[8] | ((unsigned)vv[9] << 16); x1.y = vv[10] | ((unsigned)vv[11] << 16); x1.z = vv[12] | ((unsigned)vv[13] << 16); x1.w = vv[14] | ((unsigned)vv[15] << 16);
              *(LAS v4u*)(L + LKT_ + k * SCT + seg * 32) = w0; *(LAS v4u*)(L + LKT_ + k * SCT + seg * 32 + 16) = w1;
              *(LAS v4u*)(L + LVT_ + k * SCT + seg * 32) = x0; *(LAS v4u*)(L + LVT_ + k * SCT + seg * 32 + 16) = x1;
              if (seg == 0) { eref[k] = __expf(ref); elr[k] = __expf(last - ref); } }
            __syncthreads();
            if (c + 1 < SEQ / 64) SC_LOAD(t0 + 64);
#pragma unroll 1
            for (int ti = w; ti < 10; ti += 8) {
                const int rt = ti < 1 ? 0 : (ti < 3 ? 1 : (ti < 6 ? 2 : 3)), ct = ti - (rt * (rt + 1)) / 2;
                f32x4 acc = {0.f, 0.f, 0.f, 0.f};
#pragma unroll
                for (int p = 0; p < 4; ++p) { const bf16x8v a = *(const LAS bf16x8v*)(L + LQ_ + (16 * rt + r16) * SCQ + (32 * p + 8 * q4) * 2), bq = *(const LAS bf16x8v*)(L + LK_ + (16 * ct + r16) * SCQ + (32 * p + 8 * q4) * 2);
                    acc = MFMA16(a, bq, acc); }
#pragma unroll
                for (int i = 0; i < 4; ++i) { const int t = 16 * rt + 4 * q4 + i, s = 16 * ct + r16; *(LAS bf16*)(L + LP_ + t * SCT + s * 2) = (bf16)f2bf(s <= t ? acc[i] : 0.f); }
            }
            __syncthreads();
            bf16x8v sfrag[4]; f32x4 e8[4][2];
#pragma unroll
            for (int p = 0; p < 4; ++p) { e8[p][0] = *(const LAS f32x4*)(eref + 32 * p + 8 * q4); e8[p][1] = *(const LAS f32x4*)(eref + 32 * p + 8 * q4 + 4);
                S[2 * p] = S[2 * p] * e8[p][0]; S[2 * p + 1] = S[2 * p + 1] * e8[p][1];
                const v4u wv = {pg8::cvt_pk_bf16(S[2 * p][0], S[2 * p][1]), pg8::cvt_pk_bf16(S[2 * p][2], S[2 * p][3]), pg8::cvt_pk_bf16(S[2 * p + 1][0], S[2 * p + 1][1]), pg8::cvt_pk_bf16(S[2 * p + 1][2], S[2 * p + 1][3])};
                sfrag[p] = __builtin_bit_cast(bf16x8v, wv); }
            bf16x8v vfr[2];
#pragma unroll
            for (int ss = 0; ss < 2; ++ss) vfr[ss] = *(const LAS bf16x8v*)(L + LVT_ + (16 * w + r16) * SCT + (32 * ss + 8 * q4) * 2);
#pragma unroll
            for (int rt = 0; rt < 4; ++rt) { f32x4 o = {0.f, 0.f, 0.f, 0.f};
#pragma unroll
                for (int p = 0; p < 4; ++p) { const bf16x8v a = *(const LAS bf16x8v*)(L + LQ_ + (16 * rt + r16) * SCQ + (32 * p + 8 * q4) * 2); o = MFMA16(a, sfrag[p], o); }
#pragma unroll
                for (int ss = 0; ss < 2; ++ss) if (ss <= rt / 2) { const bf16x8v a = *(const LAS bf16x8v*)(L + LP_ + (16 * rt + r16) * SCT + (32 * ss + 8 * q4) * 2); o = MFMA16(a, vfr[ss], o); }
#pragma unroll
                for (int i = 0; i < 4; ++i) *(LAS float*)(L + LO_ + (16 * rt + 4 * q4 + i) * 528 + (16 * w + r16) * 4) = o[i]; }
#pragma unroll
            for (int p = 0; p < 4; ++p)
#pragma unroll
                for (int ab = 0; ab < 2; ++ab) { const int krow = 32 * p + 8 * (r16 >> 2) + (r16 & 3) + 4 * ab;
#pragma unroll
                    for (int ss = 0; ss < 2; ++ss) { const bf16x8v a = *(const LAS bf16x8v*)(L + LKT_ + krow * SCT + (32 * ss + 8 * q4) * 2); S[2 * p + ab] = MFMA16(a, vfr[ss], S[2 * p + ab]); } }
#pragma unroll
            for (int p = 0; p < 4; ++p) { const f32x4 l0 = *(const LAS f32x4*)(elr + 32 * p + 8 * q4), l1 = *(const LAS f32x4*)(elr + 32 * p + 8 * q4 + 4); S[2 * p] = S[2 * p] * l0; S[2 * p + 1] = S[2 * p + 1] * l1; }
            __syncthreads();
#pragma unroll
            for (int rep = 0; rep < 2; ++rep) { const int tok = (tid >> 4) + 32 * rep, part = tid & 15;
                const f32x4 oa = *(const LAS f32x4*)(L + LO_ + tok * 528 + part * 32), ob = *(const LAS f32x4*)(L + LO_ + tok * 528 + part * 32 + 16);
                float ss = (oa.x * oa.x + oa.y * oa.y) + (oa.z * oa.z + oa.w * oa.w) + (ob.x * ob.x + ob.y * ob.y) + (ob.z * ob.z + ob.w * ob.w);
                ss += __shfl_xor(ss, 1); ss += __shfl_xor(ss, 2); ss += __shfl_xor(ss, 4); ss += __shfl_xor(ss, 8);
                const float rstd = rsqrtf(ss * (1.f / 128.f) + EPS);
                const size_t off = base + (size_t)(t0 + tok) * DM + part * 8; const v4u g8 = *(const v4u*)(Pg + off);
                const f32x4 ga = *(const f32x4*)(gn + part * 8), gb = *(const f32x4*)(gn + part * 8 + 4);
                v4u wv; wv.x = pk2(oa.x * rstd * ga.x * bflo(g8.x), oa.y * rstd * ga.y * bfhi(g8.x)); wv.y = pk2(oa.z * rstd * ga.z * bflo(g8.y), oa.w * rstd * ga.w * bfhi(g8.y));
                wv.z = pk2(ob.x * rstd * gb.x * bflo(g8.z), ob.y * rstd * gb.y * bfhi(g8.z)); wv.w = pk2(ob.z * rstd * gb.z * bflo(g8.w), ob.w * rstd * gb.w * bfhi(g8.w));
                *(v4u*)(O2 + off) = wv; }
        }
#undef SC_LOAD
        __syncthreads();
    }
}

#define PH_BEGIN { const bool run_ = (pid >= lo && pid < hi); ++pid; if (run_) { { int ln_; asm volatile("v_mbcnt_lo_u32_b32 %0, -1, 0\n\tv_mbcnt_hi_u32_b32 %0, -1, %0" : "=v"(ln_)); C.lane = ln_; C.tid = C.wave * 64 + ln_; }
#define PH_END   if (pid < hi) xcd_barrier(bar); } }
#define XN ((const bf16*)(ws + WS_XN))
#define RTAB ((const int*)(ws + WS_RTAB))

template <int L>
__device__ __forceinline__ void run_layer(Ctx& C, const XcdBarrier& bar, int& pid, const int lo, const int hi, PG8_LAS unsigned char* ring) {
    unsigned char* const ws = C.ws;

        const int li = L >> 1;
        if (L < 2) {
            PH_BEGIN { pg8::Gemm g{XN, (const bf16*)(ws + W_HIN) + (size_t)L * 4096 * 1024, 1024, 1024, 0}; pg8::GenOrder S; S.init(256, 16, C.G, C.bid, nullptr);
                pg8::EpiHgrnIn E{ws, L};
                pg8::gemm_phase<pg8::EpiHgrnIn, pg8::GenOrder, true, true>(ring, g, S, E, C.wave); } PH_END
            PH_BEGIN p_scan_fast(C, L); PH_END
            if (PROBE_DUP & 16) { PH_BEGIN p_scan_fast(C, L); PH_END }
        } else {
            PH_BEGIN { const bool first = (L == 2); pg8::Gemm g{XN, (const bf16*)(ws + (first ? W_KVQ : W_Q3)), 1024, 1024, 0}; pg8::GenOrder S; S.init(256, first ? 11 : 5, C.G, C.bid, nullptr);
                pg8::EpiBf16 E{(bf16*)(ws + R_QKV), first ? 2816 : 1280, nullptr, 0, 0};
                pg8::gemm_phase<pg8::EpiBf16, pg8::GenOrder, true, true>(ring, g, S, E, C.wave); } PH_END
            if (L == 2) {
                PH_BEGIN p_post_kv(C); PH_END
                if (PROBE_DUP & 8) { PH_BEGIN p_post_kv(C); PH_END }
                PH_BEGIN { pg8::Gemm g{(const bf16*)(ws + R_KCR), (const bf16*)(ws + W_CMP1), 2048, 1024, (size_t)256 * 2048 * 2}; pg8::GenOrder S; S.init(128, 1, C.G, C.bid, RTAB + 2048);
                    pg8::EpiBf16 E{(bf16*)(ws + WS_HC), 256, (const float*)(ws + WS_CB), 1, 256};
                    pg8::gemm_phase<pg8::EpiBf16, pg8::GenOrder, true, true>(ring, g, S, E, C.wave); } PH_END
                PH_BEGIN p_cmp2(C); PH_END
            if (PROBE_DUP & 32) { PH_BEGIN p_cmp2(C); PH_END }
            }
            PH_BEGIN p_attn_fast(C, (unsigned*)(ws + WS_CTL) + 8192 + 64 * (L - 2), L == 2 ? 2816 : 1280, L == 2 ? 1536 : 0, C.inp(I_NQN) + (L - 2) * 64); PH_END
            if (PROBE_DUP & 1) { PH_BEGIN p_attn_fast(C, (unsigned*)(ws + WS_CTL) + 8192 + 64 * (L - 2) + 256, L == 2 ? 2816 : 1280, L == 2 ? 1536 : 0, C.inp(I_NQN) + (L - 2) * 64); PH_END }
        }
        PH_BEGIN { pg8::Gemm g{(const bf16*)(ws + (L < 2 ? R_O2 : R_O)), (const bf16*)(ws + (L < 2 ? W_HOUT : W_NOUT)) + (size_t)(L & 1) * 1024 * 1024, 1024, 1024, 0};
            pg8::GenOrder S; S.init(256, 4, C.G, C.bid, nullptr);
            pg8::EpiRes E{L == 0 ? C.inp(I_X) : C.out, C.out, 1024};
            pg8::gemm_phase<pg8::EpiRes, pg8::GenOrder, true, true>(ring, g, S, E, C.wave); } PH_END
        PH_BEGIN { if (L & 1) p_norm<false, true, true>(C, C.inp(I_MR) + (size_t)li * 1024 * 8, C.inp(I_NFFN) + L * 1024); else p_norm<false, false, true>(C, nullptr, nullptr); } PH_END
            if (PROBE_DUP & 4) { PH_BEGIN { if (L & 1) p_norm<false, true, true>(C, C.inp(I_MR) + (size_t)li * 1024 * 8, C.inp(I_NFFN) + L * 1024); else p_norm<false, false, true>(C, nullptr, nullptr); } PH_END }
        if (L & 1) { PH_BEGIN p_gather(C); PH_END
            if (PROBE_DUP & 32) { PH_BEGIN p_gather(C); PH_END } }
        PH_BEGIN { const bool moe = (L & 1) != 0;
            pg8::Gemm g{moe ? (const bf16*)(ws + R_XP) : XN, moe ? (const bf16*)(ws + W_MGU) + (size_t)li * 8 * 2 * DFE * 1024 : (const bf16*)(ws + W_FGU) + (size_t)li * 2 * DFF * 1024, 1024, 1024, moe ? (size_t)2 * DFE * 1024 * 2 : 0};
            pg8::GenOrder S; S.init(moe ? RTAB[1024] : 256, moe ? 28 : 22, C.G, C.bid, moe ? RTAB : nullptr);
            pg8::EpiSwiGLU E{(bf16*)(ws + (moe ? R_HM : R_HF)), moe ? DFE : DFF};
            pg8::gemm_phase<pg8::EpiSwiGLU, pg8::GenOrder, true, true>(ring, g, S, E, C.wave); } PH_END
        if (!(L & 1)) {
            PH_BEGIN { pg8::Gemm g{(const bf16*)(ws + R_HF), (const bf16*)(ws + W_FDN) + (size_t)li * 1024 * DFF, DFF, DFF, 0}; pg8::GenOrder S; S.init(256, 4, C.G, C.bid, nullptr);
                pg8::EpiRes E{C.out, C.out, 1024};
                pg8::gemm_phase<pg8::EpiRes, pg8::GenOrder, true, true>(ring, g, S, E, C.wave); } PH_END
            PH_BEGIN p_norm<false, false, true>(C, nullptr, nullptr); PH_END
            if (PROBE_DUP & 4) {             PH_BEGIN p_norm<false, false, true>(C, nullptr, nullptr); PH_END }
        } else {
            PH_BEGIN { pg8::Gemm g{(const bf16*)(ws + R_HM), (const bf16*)(ws + W_MDN) + (size_t)li * 8 * 1024 * DFE, DFE, DFE, (size_t)1024 * DFE * 2}; pg8::GenOrder S; S.init(RTAB[1024], 4, C.G, C.bid, RTAB);
                pg8::EpiBf16 E{(bf16*)(ws + R_XP), 1024, nullptr, 0, 0};
                pg8::gemm_phase<pg8::EpiBf16, pg8::GenOrder, true, true>(ring, g, S, E, C.wave); } PH_END
            PH_BEGIN { if (L == 1) p_norm<true, false, true>(C, nullptr, nullptr); else p_norm<true, false, false>(C, nullptr, nullptr); } PH_END
        }
    }

struct Args { const float* in[24]; float* out; unsigned char* ws; int ph_lo, ph_hi; };
constexpr int N_PHASES = 34;

__global__ void __launch_bounds__(NWAVES * 64, 2) yoco_fwd(Args args) {
    extern __shared__ __attribute__((aligned(16))) unsigned char lds_raw[];
    Ctx C;
    C.lds = (LAS unsigned char*)lds_raw;
    C.wave = __builtin_amdgcn_readfirstlane((int)(threadIdx.x >> 6)); C.tid = threadIdx.x; C.lane = C.tid & 63;
    C.G = gridDim.x; C.bid = blockIdx.x;
    C.out = args.out; C.ws = args.ws;
    unsigned char* const ws = args.ws;
    volatile LAS unsigned* MISC = (volatile LAS unsigned*)(C.lds + MISC_OFF);
    if (C.tid < 32) MISC[C.tid] = 0u;
    __syncthreads();
    XcdBarrier bar = xcd_barrier_post((unsigned*)(ws + WS_CTL) + 4096, MISC + 8);
    const int lo = args.ph_lo, hi = args.ph_hi;
    int pid = 0;
    PG8_LAS unsigned char* ring = (PG8_LAS unsigned char*)lds_raw;
    PH_BEGIN p_prologue(C); PH_END
            if (PROBE_DUP & 2) {     PH_BEGIN p_prologue(C); PH_END }

    run_layer<0>(C, bar, pid, lo, hi, ring); run_layer<1>(C, bar, pid, lo, hi, ring); run_layer<2>(C, bar, pid, lo, hi, ring); run_layer<3>(C, bar, pid, lo, hi, ring);
#undef PH_BEGIN
#undef PH_END
#undef XN
#undef RTAB
}

extern "C" void kernel_launch(void* const* d_in, const int* in_sizes, int n_in, void* d_out, int out_size, void* d_ws, size_t ws_size, hipStream_t stream) {
    static int grid = 0;
    if (grid == 0) {
        if (n_in != 24 || in_sizes[0] != NT * DM || out_size != NT * DM || ws_size < WS_NEED) { fprintf(stderr, "kernel_launch: unexpected shapes / workspace (n_in %d, ws %zu, need %zu)\n", n_in, ws_size, (size_t)WS_NEED); grid = -1; return; }
        int dev = 0, cus = 0;
        if (hipGetDevice(&dev) != hipSuccess || hipDeviceGetAttribute(&cus, hipDeviceAttributeMultiprocessorCount, dev) != hipSuccess) { grid = -1; return; }
        if (hipFuncSetAttribute((const void*)yoco_fwd, hipFuncAttributeMaxDynamicSharedMemorySize, LDS_BYTES) != hipSuccess) { fprintf(stderr, "kernel_launch: hipFuncSetAttribute failed\n"); grid = -1; return; }
        int per_cu = 0;
        if (hipOccupancyMaxActiveBlocksPerMultiprocessor(&per_cu, (const void*)yoco_fwd, NWAVES * 64, LDS_BYTES) != hipSuccess || per_cu < 1) { fprintf(stderr, "kernel_launch: occupancy query says %d\n", per_cu); }
        (void)hipGetLastError();
        grid = cus;
    }
    if (grid < 0) return;
    (void)hipMemsetAsync((char*)d_ws + WS_CTL, 0, CTL_ZERO_BYTES, stream);
    Args a{};
    for (int i = 0; i < 24; ++i) a.in[i] = (const float*)d_in[i];
    a.out = (float*)d_out; a.ws = (unsigned char*)d_ws;
#if MK_SINGLE
    a.ph_lo = 0; a.ph_hi = PROBE_DUP ? 1000 : N_PHASES;
    hipLaunchKernelGGL(yoco_fwd, dim3(grid), dim3(NWAVES * 64), LDS_BYTES, stream, a);
#else
    for (int k = 0; k < N_PHASES; ++k) { a.ph_lo = k; a.ph_hi = k + 1; hipLaunchKernelGGL(yoco_fwd, dim3(grid), dim3(NWAVES * 64), LDS_BYTES, stream, a); }
#endif
}
```

```cpp
#include <hip/hip_runtime.h>
#include <cstdio>
#include <cstdint>

#ifndef PROBE_DUP
#define PROBE_DUP 0
#endif
#ifndef MK_SINGLE
#define MK_SINGLE 1
#endif

namespace pg8 {
#define PG8_LAS __attribute__((address_space(3)))
typedef unsigned short bf16_t;
typedef short bf16x8 __attribute__((ext_vector_type(8)));
typedef float f32x4 __attribute__((ext_vector_type(4)));
typedef unsigned u32x4 __attribute__((ext_vector_type(4)));
constexpr int BM = 256, BK = 64, HALF = 128, HTB = HALF * BK * 2  , STAGE_BYTES = 8 * HTB, NXCD = 8, WGM = 8;

__host__ __device__ __forceinline__ int lds_byte(int r, int c) { const int st = (r >> 4) * 2 + (c >> 5), rr = r & 15, cc = c & 31, ob = rr * 64 + cc * 2; return st * 1024 + (ob ^ (((ob >> 9) & 1) << 5)); }
__host__ __device__ __forceinline__ void stage_rc(int b, int& R, int& C) { const int st = b / 1024, sb = b % 1024, swz = sb ^ (((sb >> 9) & 1) << 5); R = (st >> 1) * 16 + swz / 64; C = (st & 1) * 32 + (swz % 64) / 2; }
__host__ __device__ __forceinline__ int perm32(int rho) { const int n = rho >> 4, i = rho & 15; return 8 * (i >> 2) + 4 * n + (i & 3); }

struct Unit { int pm, pn, e; };
struct Gemm { const bf16_t* A; const bf16_t* Bt; int K; int lda; size_t estride; };

struct GenOrder {
    int nM, nN, nwg, G, c; const int* tile_e;
    __device__ void init(int nM_, int nN_, int G_, int c_, const int* te) { nM = nM_; nN = nN_; nwg = nM * nN; G = G_; c = c_; tile_e = te; }
    __device__ bool next(int i, Unit& u) const {
        const long L = (long)i * G + c; if (L >= nwg) return false;
        int wgid = (int)L; { const int q = nwg / NXCD, r = nwg % NXCD, xcd = wgid % NXCD, off = wgid / NXCD; wgid = (xcd < r ? xcd * (q + 1) : r * (q + 1) + (xcd - r) * q) + off; }
        const int nig = WGM * nN, gid = wgid / nig, fm = gid * WGM, gsz = (nM - fm) < WGM ? (nM - fm) : WGM;
        u.pm = fm + ((wgid % nig) % gsz); u.pn = (wgid % nig) / gsz; u.e = tile_e ? tile_e[u.pm] : 0; return true;
    }
    __device__ __forceinline__ void a_ready(const Unit&) const {}
    __device__ __forceinline__ void done(const Unit&) const {}
};

__device__ __forceinline__ unsigned cvt_pk_bf16(float lo, float hi) { unsigned r; asm volatile("v_cvt_pk_bf16_f32 %0, %1, %2" : "=v"(r) : "v"(lo), "v"(hi)); return r; }
__device__ __forceinline__ float silu_f(float v) { return v * __builtin_amdgcn_rcpf(1.0f + __expf(-v)); }

struct EpiBf16 {
    static constexpr bool PERM = true, AFTER_DRAIN = false;
    bf16_t* O; int ldc; const float* bias; int act; int bias_es;
    __device__ __forceinline__ void operator()(const f32x4 (&acc)[2][2][4][2], const Unit& u, int wr, int wc, int fr, int fq) const {
        const int row0 = u.pm * BM + wr * 64 + fr, col0 = u.pn * BM + wc * 32 + 8 * fq;
        f32x4 bv[2][2];
#pragma unroll
        for (int bj = 0; bj < 2; ++bj)
#pragma unroll
            for (int n = 0; n < 2; ++n) bv[bj][n] = bias ? *(const f32x4*)(bias + u.e * bias_es + col0 + bj * HALF + 4 * n) : (f32x4){0.f, 0.f, 0.f, 0.f};
#pragma unroll
        for (int ai = 0; ai < 2; ++ai)
#pragma unroll
            for (int m = 0; m < 4; ++m) { bf16_t* rowp = O + (size_t)(row0 + ai * HALF + m * 16) * ldc + col0;
#pragma unroll
                for (int bj = 0; bj < 2; ++bj) { f32x4 v0 = acc[ai][bj][m][0] + bv[bj][0], v1 = acc[ai][bj][m][1] + bv[bj][1];
                    if (act == 1) {
#pragma unroll
                        for (int i = 0; i < 4; ++i) { v0[i] = silu_f(v0[i]); v1[i] = silu_f(v1[i]); } }
                    u32x4 w; w.x = cvt_pk_bf16(v0[0], v0[1]); w.y = cvt_pk_bf16(v0[2], v0[3]); w.z = cvt_pk_bf16(v1[0], v1[1]); w.w = cvt_pk_bf16(v1[2], v1[3]);
                    *(u32x4*)(rowp + bj * HALF) = w; } }
    }
};
struct EpiRes {
    static constexpr bool PERM = false, AFTER_DRAIN = false;
    const float* base; float* out; int ldc;
    __device__ __forceinline__ void operator()(const f32x4 (&acc)[2][2][4][2], const Unit& u, int wr, int wc, int fr, int fq) const {
        const int row0 = u.pm * BM + wr * 64 + fr, col0 = u.pn * BM + wc * 32 + 4 * fq;
#pragma unroll
        for (int ai = 0; ai < 2; ++ai)
#pragma unroll
            for (int m = 0; m < 4; ++m) { const size_t off = (size_t)(row0 + ai * HALF + m * 16) * ldc + col0;
#pragma unroll
                for (int bj = 0; bj < 2; ++bj)
#pragma unroll
                    for (int n = 0; n < 2; ++n) { const f32x4 b = *(const f32x4*)(base + off + bj * HALF + n * 16); *(f32x4*)(out + off + bj * HALF + n * 16) = b + acc[ai][bj][m][n]; } }
    }
};
struct EpiSwiGLU {
    static constexpr bool PERM = true, AFTER_DRAIN = false;
    bf16_t* O; int ldc;
    __device__ __forceinline__ void operator()(const f32x4 (&acc)[2][2][4][2], const Unit& u, int wr, int wc, int fr, int fq) const {
        const int row0 = u.pm * BM + wr * 64 + fr, col0 = u.pn * HALF + wc * 32 + 8 * fq;
#pragma unroll
        for (int ai = 0; ai < 2; ++ai)
#pragma unroll
            for (int m = 0; m < 4; ++m) { bf16_t* rowp = O + (size_t)(row0 + ai * HALF + m * 16) * ldc + col0;
                f32x4 v0, v1;
#pragma unroll
                for (int i = 0; i < 4; ++i) { v0[i] = silu_f(acc[ai][0][m][0][i]) * acc[ai][1][m][0][i]; v1[i] = silu_f(acc[ai][0][m][1][i]) * acc[ai][1][m][1][i]; }
                u32x4 w; w.x = cvt_pk_bf16(v0[0], v0[1]); w.y = cvt_pk_bf16(v0[2], v0[3]); w.z = cvt_pk_bf16(v1[0], v1[1]); w.w = cvt_pk_bf16(v1[2], v1[3]);
                *(u32x4*)rowp = w; }
    }
};
__device__ __forceinline__ float logf_gate(float x, float la, float l1) {
    const float ls = fminf(x, 0.f) - __logf(1.0f + __expf(-fabsf(x)));
    const float b = l1 + ls;
    if (la == -INFINITY) return b;
    const float mx = fmaxf(la, b), d = fabsf(la - b);
    return mx + __logf(1.0f + __expf(-d));
}
struct EpiHgrnIn {
    static constexpr bool PERM = true, AFTER_DRAIN = false;
    unsigned char* ws; int layer;
    static constexpr size_t O_PQ = 580ull << 20, O_PI = O_PQ + (128ull << 20), O_PG = O_PQ + (256ull << 20), O_LF = O_PQ + (384ull << 20), O_LA = 1ull << 20, O_L1 = O_LA + 8192;
    __device__ __forceinline__ void operator()(const f32x4 (&acc)[2][2][4][2], const Unit& u, int wr, int wc, int fr, int fq) const {
        const int quarter = u.pn >> 2;
        const int row0 = u.pm * BM + wr * 64 + fr, col0 = (u.pn & 3) * BM + wc * 32 + 8 * fq;
        if (quarter == 1) {
            const float* la = (const float*)(ws + O_LA) + layer * 1024; const float* l1 = (const float*)(ws + O_L1) + layer * 1024; float* LF = (float*)(ws + O_LF);
            f32x4 A0[2][2], A1[2][2];
#pragma unroll
            for (int bj = 0; bj < 2; ++bj)
#pragma unroll
                for (int n = 0; n < 2; ++n) { A0[bj][n] = *(const f32x4*)(la + col0 + bj * HALF + 4 * n); A1[bj][n] = *(const f32x4*)(l1 + col0 + bj * HALF + 4 * n); }
#pragma unroll
            for (int ai = 0; ai < 2; ++ai)
#pragma unroll
                for (int m = 0; m < 4; ++m) { float* rowp = LF + (size_t)(row0 + ai * HALF + m * 16) * 1024 + col0;
#pragma unroll
                    for (int bj = 0; bj < 2; ++bj)
#pragma unroll
                        for (int n = 0; n < 2; ++n) { f32x4 o;
#pragma unroll
                            for (int i = 0; i < 4; ++i) o[i] = logf_gate(acc[ai][bj][m][n][i], A0[bj][n][i], A1[bj][n][i]);
                            *(f32x4*)(rowp + bj * HALF + 4 * n) = o; } }
        } else {
            bf16_t* O = (bf16_t*)(ws + (quarter == 0 ? O_PQ : (quarter == 2 ? O_PI : O_PG)));
#pragma unroll
            for (int ai = 0; ai < 2; ++ai)
#pragma unroll
                for (int m = 0; m < 4; ++m) { bf16_t* rowp = O + (size_t)(row0 + ai * HALF + m * 16) * 1024 + col0;
#pragma unroll
                    for (int bj = 0; bj < 2; ++bj) { f32x4 v0 = acc[ai][bj][m][0], v1 = acc[ai][bj][m][1];
                        if (quarter != 2) {
#pragma unroll
                            for (int i = 0; i < 4; ++i) { v0[i] = silu_f(v0[i]); v1[i] = silu_f(v1[i]); } }
                        u32x4 w; w.x = cvt_pk_bf16(v0[0], v0[1]); w.y = cvt_pk_bf16(v0[2], v0[3]); w.z = cvt_pk_bf16(v1[0], v1[1]); w.w = cvt_pk_bf16(v1[2], v1[3]);
                        *(u32x4*)(rowp + bj * HALF) = w; } }
        }
    }
};

template <class Epi, class Sched, bool ALIGN_EPI = false, bool SP2 = false>
__device__ __forceinline__ void gemm_phase(PG8_LAS unsigned char* lds, const Gemm g, const Sched& S, const Epi& E, const int wave_id) {
    int lane_; asm volatile("v_mbcnt_lo_u32_b32 %0, -1, 0\n\tv_mbcnt_hi_u32_b32 %0, -1, %0" : "=v"(lane_));
    const int wid = wave_id, lane = lane_, tid = wid * 64 + lane, wr = wid >> 2, wc = wid & 3, fr = lane & 15, fq = lane >> 4;
    const int K = g.K, nt = K / BK, lda = g.lda;
    unsigned voffA[2], voffB[2];
#pragma unroll
    for (int i = 0; i < 2; ++i) { int R, C; stage_rc(tid * 16 + i * 8192, R, C); const int Rb = Epi::PERM ? ((R & ~31) + perm32(R & 31)) : R;
        voffA[i] = (unsigned)(R * lda + C) * 2u; voffB[i] = (unsigned)(Rb * K + C) * 2u; }
    const size_t kstep = (size_t)(BK * 2);
    const size_t hstep = (size_t)HALF * K * 2;
    const size_t tstep = 2 * hstep;
    const size_t hstepA = (size_t)HALF * lda * 2, tstepA = 2 * hstepA;
    const unsigned ldsw = (unsigned)wid * 1024u;
    const int aoff = lds_byte(wr * 64 + fr, fq * 8), boff = lds_byte(wc * 32 + fr, fq * 8);
#define PG8_SA(b, h) (((b) * 2 + (h)) * HTB)
#define PG8_SB(b, h) ((4 + (b) * 2 + (h)) * HTB)
#define PG8_STAGE(bufoff, gbase, voff) do { _Pragma("unroll") for (int _i = 0; _i < 2; ++_i) \
        __builtin_amdgcn_global_load_lds((const unsigned*)((const char*)(gbase) + (voff)[_i]), (PG8_LAS unsigned*)(lds + (bufoff) + ldsw + _i * 8192), 16, 0, 0); } while (0)
#define PG8_LDA(dst, b, h) do { _Pragma("unroll") for (int m = 0; m < 4; ++m) _Pragma("unroll") for (int k = 0; k < 2; ++k) dst[m][k] = *(const PG8_LAS bf16x8*)(lds + PG8_SA(b, h) + aoff + m * 2048 + k * 1024); } while (0)
#define PG8_LDB(dst, b, h) do { _Pragma("unroll") for (int n = 0; n < 2; ++n) _Pragma("unroll") for (int k = 0; k < 2; ++k) dst[n][k] = *(const PG8_LAS bf16x8*)(lds + PG8_SB(b, h) + boff + n * 2048 + k * 1024); } while (0)
#define PG8_MMA(ai, bj, At, Bt) do { __builtin_amdgcn_s_setprio(1); _Pragma("unroll") for (int m = 0; m < 4; ++m) _Pragma("unroll") for (int n = 0; n < 2; ++n) _Pragma("unroll") for (int k = 0; k < 2; ++k) \
        acc[ai][bj][m][n] = __builtin_amdgcn_mfma_f32_16x16x32_bf16(Bt[n][k], At[m][k], acc[ai][bj][m][n], 0, 0, 0); __builtin_amdgcn_s_setprio(0); } while (0)
#define PG8_WAIT_V(n) asm volatile("s_waitcnt vmcnt(" #n ")" ::: "memory")
#define PG8_WAIT_L(n) asm volatile("s_waitcnt lgkmcnt(" #n ")" ::: "memory")
#define PG8_BAR __builtin_amdgcn_s_barrier()
#define PG8_SCHED __builtin_amdgcn_sched_barrier(0)
    Unit cur, nxt; int ui = 0;
    if (!S.next(0, cur)) return;
    f32x4 acc[2][2][4][2];
#pragma unroll
    for (int a = 0; a < 2; ++a)
#pragma unroll
        for (int b = 0; b < 2; ++b)
#pragma unroll
            for (int m = 0; m < 4; ++m)
#pragma unroll
                for (int n = 0; n < 2; ++n) acc[a][b][m][n] = (f32x4){0.f, 0.f, 0.f, 0.f};
    bf16x8 At[4][2], B0[2][2], B1[2][2];
    const char* cA = (const char*)g.A + (size_t)cur.pm * tstepA; const char* cB = (const char*)g.Bt + (size_t)cur.e * g.estride + (size_t)cur.pn * tstep;
    S.a_ready(cur);
    if constexpr (SP2) {
        PG8_STAGE(PG8_SB(0, 0), cB, voffB); PG8_STAGE(PG8_SB(0, 1), cB + hstep, voffB); PG8_STAGE(PG8_SA(0, 0), cA, voffA); PG8_STAGE(PG8_SA(0, 1), cA + hstepA, voffA);
        if (wr == 1) PG8_BAR;
        PG8_WAIT_V(2); PG8_BAR;
        PG8_STAGE(PG8_SB(1, 0), cB + kstep, voffB); PG8_STAGE(PG8_SA(1, 0), cA + kstep, voffA); PG8_STAGE(PG8_SB(1, 1), cB + hstep + kstep, voffB);
        PG8_WAIT_V(6); PG8_BAR;
    } else {
        PG8_STAGE(PG8_SB(0, 0), cB, voffB); PG8_STAGE(PG8_SA(0, 0), cA, voffA); PG8_STAGE(PG8_SB(0, 1), cB + hstep, voffB); PG8_STAGE(PG8_SA(0, 1), cA + hstepA, voffA);
        if (wr == 1) PG8_BAR;
        PG8_WAIT_V(4); PG8_BAR;
        PG8_STAGE(PG8_SB(1, 0), cB + kstep, voffB); PG8_STAGE(PG8_SA(1, 0), cA + kstep, voffA); PG8_STAGE(PG8_SB(1, 1), cB + hstep + kstep, voffB);
        PG8_WAIT_V(6); PG8_BAR;
    }
    for (;;) {
        const bool has_next = S.next(ui + 1, nxt);
        const char* nA = has_next ? (const char*)g.A + (size_t)nxt.pm * tstepA : cA; const char* nB = has_next ? (const char*)g.Bt + (size_t)nxt.e * g.estride + (size_t)nxt.pn * tstep : cB;
        for (int t = 0; t < nt; t += 2) {
            const bool last = (t == nt - 2);
            const char* a1 = cA + (size_t)(t + 1) * kstep;
            const char* a2 = last ? nA : cA + (size_t)(t + 2) * kstep; const char* b2 = last ? nB : cB + (size_t)(t + 2) * kstep;
            const char* a3 = a2 + kstep; const char* b3 = b2 + kstep;
            if (last && has_next) S.a_ready(nxt);
            if constexpr (SP2) {
            PG8_LDB(B0, 0, 0); PG8_LDB(B1, 0, 1); PG8_SCHED; PG8_LDA(At, 0, 0); PG8_STAGE(PG8_SA(1, 1), a1 + hstepA, voffA);
            PG8_WAIT_V(8); PG8_WAIT_L(0); PG8_BAR; PG8_MMA(0, 0, At, B0); PG8_MMA(0, 1, At, B1); PG8_BAR; PG8_SCHED;
            PG8_LDA(At, 0, 1); PG8_STAGE(PG8_SB(0, 0), b2, voffB); PG8_STAGE(PG8_SB(0, 1), b2 + hstep, voffB); PG8_STAGE(PG8_SA(0, 0), a2, voffA);
            PG8_WAIT_V(8); PG8_WAIT_L(0); PG8_BAR; PG8_MMA(1, 0, At, B0); PG8_MMA(1, 1, At, B1); PG8_BAR; PG8_SCHED;
            PG8_LDB(B0, 1, 0); PG8_LDB(B1, 1, 1); PG8_SCHED; PG8_LDA(At, 1, 0); PG8_STAGE(PG8_SA(0, 1), a2 + hstepA, voffA);
            PG8_WAIT_V(8); PG8_WAIT_L(0); PG8_BAR; PG8_MMA(0, 0, At, B0); PG8_MMA(0, 1, At, B1); PG8_BAR; PG8_SCHED;
            PG8_LDA(At, 1, 1); PG8_STAGE(PG8_SB(1, 0), b3, voffB); PG8_STAGE(PG8_SB(1, 1), b3 + hstep, voffB); PG8_STAGE(PG8_SA(1, 0), a3, voffA);
            PG8_WAIT_V(8); PG8_WAIT_L(0); PG8_BAR; PG8_MMA(1, 0, At, B0); PG8_MMA(1, 1, At, B1); PG8_BAR; PG8_SCHED;
            } else {
            PG8_LDB(B0, 0, 0); PG8_SCHED; PG8_LDA(At, 0, 0); PG8_STAGE(PG8_SA(1, 1), a1 + hstepA, voffA);
            PG8_WAIT_L(8); PG8_BAR; PG8_WAIT_L(0); PG8_MMA(0, 0, At, B0); PG8_BAR; PG8_SCHED;
            PG8_LDB(B1, 0, 1); PG8_STAGE(PG8_SB(0, 0), b2, voffB);
            PG8_BAR; PG8_WAIT_L(0); PG8_MMA(0, 1, At, B1); PG8_BAR;
            PG8_LDA(At, 0, 1); PG8_STAGE(PG8_SA(0, 0), a2, voffA);
            PG8_BAR; PG8_WAIT_L(0); PG8_MMA(1, 0, At, B0); PG8_BAR; PG8_SCHED;
            PG8_STAGE(PG8_SB(0, 1), b2 + hstep, voffB);
            PG8_WAIT_V(6); PG8_BAR; PG8_MMA(1, 1, At, B1); PG8_BAR;
            PG8_LDB(B0, 1, 0); PG8_SCHED; PG8_LDA(At, 1, 0); PG8_STAGE(PG8_SA(0, 1), a2 + hstepA, voffA);
            PG8_WAIT_L(8); PG8_BAR; PG8_WAIT_L(0); PG8_MMA(0, 0, At, B0); PG8_BAR; PG8_SCHED;
            PG8_LDB(B1, 1, 1); PG8_STAGE(PG8_SB(1, 0), b3, voffB);
            PG8_BAR; PG8_WAIT_L(0); PG8_MMA(0, 1, At, B1); PG8_BAR;
            PG8_LDA(At, 1, 1); PG8_STAGE(PG8_SA(1, 0), a3, voffA);
            PG8_BAR; PG8_WAIT_L(0); PG8_MMA(1, 0, At, B0); PG8_BAR; PG8_SCHED;
            PG8_STAGE(PG8_SB(1, 1), b3 + hstep, voffB);
            PG8_WAIT_V(6); PG8_BAR; PG8_MMA(1, 1, At, B1); PG8_BAR;
            }
        }
        if constexpr (ALIGN_EPI) { if (wr == 0) PG8_BAR; }
        if constexpr (!Epi::AFTER_DRAIN) { E(acc, cur, wr, wc, fr, fq); S.done(cur); }
        if (!has_next) break;
#pragma unroll
        for (int a = 0; a < 2; ++a)
#pragma unroll
            for (int b = 0; b < 2; ++b)
#pragma unroll
                for (int m = 0; m < 4; ++m)
#pragma unroll
                    for (int n = 0; n < 2; ++n) acc[a][b][m][n] = (f32x4){0.f, 0.f, 0.f, 0.f};
        cur = nxt; cA = nA; cB = nB; ++ui;
        if constexpr (ALIGN_EPI) { if (wr == 1) PG8_BAR; }
    }
    PG8_WAIT_V(0);
    if constexpr (!ALIGN_EPI) { if (wr == 0) PG8_BAR; }
    PG8_BAR;
    if constexpr (Epi::AFTER_DRAIN) { E.fused(acc, cur, wr, wc, fr, fq, lds, wid, lane); S.done(cur); }
#undef PG8_SA
#undef PG8_SB
#undef PG8_STAGE
#undef PG8_LDA
#undef PG8_LDB
#undef PG8_MMA
#undef PG8_WAIT_V
#undef PG8_WAIT_L
#undef PG8_BAR
#undef PG8_SCHED
}
}

constexpr int NT = 65536, DM = 1024, NBATCH = 32, SEQ = 2048;
constexpr int DFF = 2816, DFE = 3584, NEXP = 8;
constexpr int MOE_ROWS = 133120;
constexpr float EPS = 1e-6f;
constexpr size_t MiB = 1u << 20;
constexpr size_t WS_CTL = 0, CTL_ZERO_BYTES = 1 * MiB;
constexpr size_t WS_LA = 1 * MiB;
constexpr size_t WS_L1 = WS_LA + 8192;
constexpr size_t WS_CB = WS_LA + 16384;
constexpr size_t WS_RCNT = WS_LA + 32768;
constexpr size_t WS_RTAB = WS_LA + 65536;
constexpr size_t WS_ROUTE = 2 * MiB;
constexpr size_t WS_SLOT = 3 * MiB;
constexpr size_t WS_SELM = 4 * MiB;
constexpr size_t WS_GATES = 8 * MiB;
constexpr size_t WS_KC = 20 * MiB;
constexpr size_t WS_VCT = 22 * MiB;
constexpr size_t WS_HC = 24 * MiB;
constexpr size_t WS_W = 48 * MiB;
constexpr size_t W_HIN = WS_W, W_HOUT = WS_W + 16 * MiB, W_KVQ = WS_W + 20 * MiB, W_Q3 = WS_W + 26 * MiB, W_CMP1 = WS_W + 29 * MiB, W_NOUT = WS_W + 31 * MiB,
                 W_FGU = WS_W + 35 * MiB, W_FDN = WS_W + 57 * MiB, W_MGU = WS_W + 68 * MiB, W_MDN = WS_W + 292 * MiB;
constexpr size_t WS_XN = 452 * MiB;
constexpr size_t WS_R = 580 * MiB;
constexpr size_t R_PQ = WS_R, R_PI = WS_R + 128 * MiB, R_PG = WS_R + 256 * MiB, R_LF = WS_R + 384 * MiB, R_O2 = WS_R + 640 * MiB;
constexpr size_t R_HF = WS_R + 256 * MiB;
constexpr size_t R_KS = WS_R, R_KW = WS_R + 32 * MiB, R_VST = WS_R + 64 * MiB, R_VWT = WS_R + 96 * MiB, R_KCR = WS_R + 128 * MiB, R_VCR = WS_R + 160 * MiB;
constexpr size_t R_QKV = WS_R + 256 * MiB;
constexpr size_t R_Q = WS_R + 608 * MiB, R_O = WS_R + 736 * MiB;
constexpr size_t R_XP = WS_R, R_HM = WS_R + 260 * MiB;
constexpr size_t WS_NEED = R_HM + (size_t)MOE_ROWS * DFE * 2;
static_assert(WS_NEED <= 1792 * MiB, "workspace map");
static_assert(W_MDN + 112 * MiB <= WS_XN, "weights map");
static_assert(pg8::EpiHgrnIn::O_PQ == R_PQ && pg8::EpiHgrnIn::O_PI == R_PI && pg8::EpiHgrnIn::O_PG == R_PG && pg8::EpiHgrnIn::O_LF == R_LF && pg8::EpiHgrnIn::O_LA == WS_LA && pg8::EpiHgrnIn::O_L1 == WS_L1, "EpiHgrnIn offsets");

constexpr int LDS_BYTES = 147456;
constexpr int MISC_OFF = 131072 + 320;
constexpr int NWAVES = 8;

#define GAS __attribute__((address_space(1)))
#define LAS __attribute__((address_space(3)))
typedef unsigned short bf16;
typedef unsigned v4u __attribute__((ext_vector_type(4)));
typedef unsigned v2u __attribute__((ext_vector_type(2)));
typedef float f32x4 __attribute__((ext_vector_type(4)));
#define LDS_WAIT() asm volatile("s_waitcnt lgkmcnt(0)" ::: "memory")
__device__ __forceinline__ unsigned f2bf(float f) { unsigned u = __builtin_bit_cast(unsigned, f); return (u + 0x7fffu + ((u >> 16) & 1u)) >> 16; }
__device__ __forceinline__ unsigned pk2(float lo, float hi) { return f2bf(lo) | (f2bf(hi) << 16); }
__device__ __forceinline__ float bf2f(unsigned b) { return __builtin_bit_cast(float, b << 16); }
__device__ __forceinline__ float bflo(unsigned w) { return __builtin_bit_cast(float, w << 16); }
__device__ __forceinline__ float bfhi(unsigned w) { return __builtin_bit_cast(float, w & 0xffff0000u); }
__device__ __forceinline__ float wave_sum(float v) {
#pragma unroll
    for (int o = 32; o >= 1; o >>= 1) v += __shfl_xor(v, o);
    return v;
}
__device__ __forceinline__ float wave_max(float v) {
#pragma unroll
    for (int o = 32; o >= 1; o >>= 1) v = fmaxf(v, __shfl_xor(v, o));
    return v;
}

#define XB_TMO      128
#define XB_XCNT(j)  (256  + 64 * (j))
#define XB_XSUB(j)  (1280 + 64 * (j))
#define XB_XGEN(j)  (2304 + 64 * (j))
#define XB_TOP      3328
#define XB_TOPGEN   3392
#define XCD_BAR_WORDS 3456
#define XB_SPIN_CAP (1u << 22)
__device__ __forceinline__ unsigned xb_ld(unsigned* p)              { return __hip_atomic_load(p, __ATOMIC_RELAXED, __HIP_MEMORY_SCOPE_AGENT); }
__device__ __forceinline__ unsigned xb_add(unsigned* p, unsigned v) { return __hip_atomic_fetch_add(p, v, __ATOMIC_RELAXED, __HIP_MEMORY_SCOPE_AGENT); }
__device__ __forceinline__ unsigned xb_xcc_id() { return (unsigned)__builtin_amdgcn_s_getreg((3 << 11) | 20) & 0xFu; }
#define XB_SPIN(cond, bar) do { unsigned _sp = 0; while (cond) { __builtin_amdgcn_s_sleep(1); \
    if ((++_sp & 255u) == 0u) { if (xb_ld(&(bar)[XB_TMO])) break; if (_sp > XB_SPIN_CAP) { atomicAdd(&(bar)[XB_TMO], 1u); break; } } } } while (0)
struct XcdBarrier { unsigned* bar; unsigned x; volatile LAS unsigned* st; };
__device__ __forceinline__ XcdBarrier xcd_barrier_post(unsigned* bar, volatile LAS unsigned* st) {
    XcdBarrier b; b.bar = bar; b.x = xb_xcc_id(); b.st = st;
    if (threadIdx.x == 0) (void)xb_add(&bar[XB_XCNT(b.x)], 1u);
    return b;
}
__device__ __forceinline__ void xcd_barrier_complete(unsigned* bar, unsigned x, unsigned& nloc, unsigned& nx) {
    const unsigned G = gridDim.x * gridDim.y * gridDim.z;
    unsigned sum, cnt, mine, sp = 0u;
    for (;;) {
        sum = 0u; cnt = 0u; mine = 0u;
#pragma unroll
        for (unsigned j = 0; j < 16; ++j) { const unsigned c = xb_ld(&bar[XB_XCNT(j)]); sum += c; cnt += (c > 0u) ? 1u : 0u; mine = (j == x) ? c : mine; }
        if (sum == G) break;
        __builtin_amdgcn_s_sleep(1);
        if ((++sp & 255u) == 0u) { if (xb_ld(&bar[XB_TMO])) break; if (sp > XB_SPIN_CAP) { atomicAdd(&bar[XB_TMO], 1u); break; } }
    }
    nloc = mine > 0u ? mine : 1u; nx = cnt > 0u ? cnt : 1u;
}
__device__ __forceinline__ void xcd_barrier(const XcdBarrier& b) {
    asm volatile("s_waitcnt vmcnt(0)" ::: "memory");
    __syncthreads();
    if (threadIdx.x == 0) {
        unsigned* bar = b.bar; unsigned bx_ = b.x; asm volatile("" : "+s"(bar), "+s"(bx_));
        __builtin_amdgcn_s_waitcnt(0);
        unsigned nloc = b.st[0], nx = b.st[1];
        if (nloc == 0u) { xcd_barrier_complete(bar, bx_, nloc, nx); b.st[0] = nloc; b.st[1] = nx; }
        const unsigned old = xb_add(&bar[XB_XSUB(bx_)], 1u);
        const unsigned gen = old / nloc;
        if (old + 1u == (gen + 1u) * nloc) {
            __builtin_amdgcn_fence(__ATOMIC_RELEASE, "agent");
            asm volatile("s_waitcnt vmcnt(0)" ::: "memory");
            const unsigned og = xb_add(&bar[XB_TOP], 1u);
            const unsigned tg = og / nx;
            if (og + 1u == (tg + 1u) * nx) xb_add(&bar[XB_TOPGEN], 1u);
            else XB_SPIN(xb_ld(&bar[XB_TOPGEN]) == tg, bar);
            __builtin_amdgcn_fence(__ATOMIC_ACQUIRE, "agent");
            xb_add(&bar[XB_XGEN(bx_)], 1u);
            asm volatile("s_waitcnt vmcnt(0)" ::: "memory");
        } else {
            XB_SPIN(xb_ld(&bar[XB_XGEN(bx_)]) == gen, bar);
            __builtin_amdgcn_fence(__ATOMIC_ACQUIRE, "agent");
            asm volatile("s_waitcnt vmcnt(0)" ::: "memory");
        }
    }
    __syncthreads();
}

struct Ctx {
    LAS unsigned char* lds;
    int tid, lane, wave, G, bid;
    float* out; unsigned char* ws;
    __device__ __forceinline__ const float* inp(int i) const {
        const __attribute__((address_space(4))) unsigned char* kp = (const __attribute__((address_space(4))) unsigned char*)__builtin_amdgcn_kernarg_segment_ptr();
        asm volatile("" : "+s"(kp));
        return ((const float* const __attribute__((address_space(4)))*)kp)[i];
    }
};
enum { I_X = 0, I_NMIX, I_NFFN, I_HWIN, I_HWOUT, I_HGN, I_HLB, I_KVN, I_KVW, I_CPK, I_CW1K, I_CW2K, I_CPV, I_CW1V, I_CW2V, I_KN, I_NWIN, I_NWOUT, I_NQN, I_FGU, I_FDN, I_MR, I_MGU, I_MDN };

constexpr int MAXJOB = 64;
struct JobTab { unsigned long long src[MAXJOB], gain[MAXJOB], dst[MAXJOB]; int K[MAXJOB], Nsrc[MAXJOB], npb[MAXJOB], F[MAXJOB], rowoff[MAXJOB], istart[MAXJOB + 1]; int njobs; };
__device__ __forceinline__ void add_job(LAS JobTab* J, const float* src, const float* gain, bf16* dst, int K, int Nsrc, int Npad, int F, int rowoff) {
    const int j = J->njobs; J->src[j] = (unsigned long long)src; J->gain[j] = (unsigned long long)gain; J->dst[j] = (unsigned long long)dst;
    J->K[j] = K; J->Nsrc[j] = Nsrc; J->npb[j] = Npad / 32; J->F[j] = F; J->rowoff[j] = rowoff; J->istart[j + 1] = J->istart[j] + (K / 64) * (Npad / 32); J->njobs = j + 1;
}
__device__ __forceinline__ void transpose_item(const float* W, int K, int Nsrc, const float* gain, bf16* WT, int dstrow0, int k0, int n0, LAS float* scr, int lane) {
    const int c4 = lane & 7, kr = lane >> 3, n = n0 + 4 * c4; const bool okn = n < Nsrc;
    f32x4 v[8];
#pragma unroll
    for (int i = 0; i < 8; ++i) { const int kk = 8 * i + kr; v[i] = okn ? *(const f32x4*)(W + (size_t)(k0 + kk) * Nsrc + n) : (f32x4){0.f, 0.f, 0.f, 0.f}; }
#pragma unroll
    for (int i = 0; i < 8; ++i) { const int kk = 8 * i + kr; if (gain) v[i] = v[i] * gain[k0 + kk]; *(LAS f32x4*)(scr + kk * 36 + 4 * c4) = v[i]; }
    LDS_WAIT();
    const int c = lane & 7;
#pragma unroll
    for (int j = 0; j < 4; ++j) { const int nn = (lane >> 3) + 8 * j; const LAS float* s = scr + (8 * c) * 36 + nn;
        v4u o; o.x = pk2(s[0 * 36], s[1 * 36]); o.y = pk2(s[2 * 36], s[3 * 36]); o.z = pk2(s[4 * 36], s[5 * 36]); o.w = pk2(s[6 * 36], s[7 * 36]);
        *(v4u*)(WT + (size_t)(dstrow0 + nn) * K + k0 + 8 * c) = o; }
    LDS_WAIT();
}
__device__ __forceinline__ void norm_row_store(const f32x4 (&v)[4], bf16* orow, int lane) {
    float s = 0.f;
#pragma unroll
    for (int j = 0; j < 4; ++j) s += (v[j].x * v[j].x + v[j].y * v[j].y) + (v[j].z * v[j].z + v[j].w * v[j].w);
    const float rstd = rsqrtf(wave_sum(s) * (1.f / DM) + EPS);
    v2u* o8 = (v2u*)orow + lane;
#pragma unroll
    for (int j = 0; j < 4; ++j) { v2u w; w.x = pk2(v[j].x * rstd, v[j].y * rstd); w.y = pk2(v[j].z * rstd, v[j].w * rstd); o8[64 * j] = w; }
}
__device__ __forceinline__ void p_prologue(Ctx& C) {
    LAS JobTab* J = (LAS JobTab*)(C.lds + 73728);
    unsigned char* ws = C.ws;
    if (C.tid == 0) {
        J->njobs = 0; J->istart[0] = 0;
        for (int l = 0; l < 2; ++l) add_job(J, C.inp(I_HWIN) + (size_t)l * 1024 * 4096, C.inp(I_NMIX) + l * 1024, (bf16*)(ws + W_HIN) + (size_t)l * 4096 * 1024, 1024, 4096, 4096, 0, 0);
        for (int l = 0; l < 2; ++l) add_job(J, C.inp(I_HWOUT) + (size_t)l * 1024 * 1024, nullptr, (bf16*)(ws + W_HOUT) + (size_t)l * 1024 * 1024, 1024, 1024, 1024, 0, 0);
        add_job(J, C.inp(I_KVW), C.inp(I_KVN), (bf16*)(ws + W_KVQ), 1024, 1536, 1536, 0, 0);
        add_job(J, C.inp(I_NWIN), C.inp(I_NMIX) + 2048, (bf16*)(ws + W_KVQ), 1024, 1072, 1280, 0, 1536);
        add_job(J, C.inp(I_NWIN) + (size_t)1024 * 1072, C.inp(I_NMIX) + 3072, (bf16*)(ws + W_Q3), 1024, 1072, 1280, 0, 0);
        add_job(J, C.inp(I_CW1K), nullptr, (bf16*)(ws + W_CMP1), 2048, 256, 256, 0, 0);
        add_job(J, C.inp(I_CW1V), nullptr, (bf16*)(ws + W_CMP1) + (size_t)256 * 2048, 2048, 256, 256, 0, 0);
        for (int l = 0; l < 2; ++l) add_job(J, C.inp(I_NWOUT) + (size_t)l * 1024 * 1024, nullptr, (bf16*)(ws + W_NOUT) + (size_t)l * 1024 * 1024, 1024, 1024, 1024, 0, 0);
        for (int l = 0; l < 2; ++l) add_job(J, C.inp(I_FGU) + (size_t)l * 1024 * 2 * DFF, C.inp(I_NFFN) + (2 * l) * 1024, (bf16*)(ws + W_FGU) + (size_t)l * 2 * DFF * 1024, 1024, 2 * DFF, 2 * DFF, DFF, 0);
        for (int l = 0; l < 2; ++l) add_job(J, C.inp(I_FDN) + (size_t)l * DFF * 1024, nullptr, (bf16*)(ws + W_FDN) + (size_t)l * 1024 * DFF, DFF, 1024, 1024, 0, 0);
        for (int l = 0; l < 16; ++l) add_job(J, C.inp(I_MGU) + (size_t)l * 1024 * 2 * DFE, C.inp(I_NFFN) + (2 * (l >> 3) + 1) * 1024, (bf16*)(ws + W_MGU) + (size_t)l * 2 * DFE * 1024, 1024, 2 * DFE, 2 * DFE, DFE, 0);
        for (int l = 0; l < 16; ++l) add_job(J, C.inp(I_MDN) + (size_t)l * DFE * 1024, nullptr, (bf16*)(ws + W_MDN) + (size_t)l * 1024 * DFE, DFE, 1024, 1024, 0, 0);
    }
    __syncthreads();
    LAS float* scr = (LAS float*)(C.lds + C.wave * 9216);
    const int gw = C.bid * NWAVES + C.wave, NGW = C.G * NWAVES;
    const int nj = J->njobs, total = J->istart[nj];
    for (int it = gw; it < total; it += NGW) {
        int j = 0; while (j + 1 < nj && J->istart[j + 1] <= it) ++j;
        const int r = it - J->istart[j], npb = J->npb[j], kb = r / npb, nb = r % npb, n0 = 32 * nb, F = J->F[j];
        int drow = J->rowoff[j] + n0;
        if (F) drow = (n0 < F) ? 256 * (n0 / 128) + (n0 % 128) : 256 * ((n0 - F) / 128) + 128 + ((n0 - F) % 128);
        transpose_item((const float*)J->src[j], J->K[j], J->Nsrc[j], (const float*)J->gain[j], (bf16*)J->dst[j], drow, 64 * kb, n0, scr, C.lane);
    }
    { const int gt = C.bid * 512 + C.tid;
      if (gt < 1024) { const float a0 = C.inp(I_HLB)[gt], a1 = C.inp(I_HLB)[1024 + gt]; const float mx = fmaxf(a0, a1), e0 = expf(a0 - mx), e1 = expf(a1 - mx), s = e0 + e1;
          const float s0 = e0 / s, s1 = e1 / s, lb1 = (s0 + s1) - s0;
          float* la = (float*)(ws + WS_LA); float* l1 = (float*)(ws + WS_L1);
          la[gt] = -INFINITY; l1[gt] = 0.f; la[1024 + gt] = logf(lb1); l1[1024 + gt] = log1pf(-lb1); } }
    if (C.bid == 0 && C.tid < 128) ((int*)(ws + WS_RTAB))[2048 + C.tid] = C.tid >> 6;
    if (C.bid == (C.G > 1 ? 1 : 0)) { const int which = C.tid >> 8, j = C.tid & 255; const float* pos = C.inp(which ? I_CPV : I_CPK); const float* w1 = C.inp(which ? I_CW1V : I_CW1K);
        float a = 0.f; for (int i = 0; i < 2048; ++i) a += pos[i] * w1[(size_t)i * 256 + j];
        ((float*)(ws + WS_CB))[which * 256 + j] = a; }
    for (int c = C.bid; c < 256; c += C.G)
        for (int i = 0; i < 32; i += 4) { f32x4 v[4][4]; const float* xb = C.inp(I_X);
#pragma unroll
            for (int r = 0; r < 4; ++r) { const f32x4* xr = (const f32x4*)(xb + (size_t)(c * 256 + C.wave * 32 + i + r) * DM) + C.lane;
#pragma unroll
                for (int j = 0; j < 4; ++j) v[r][j] = xr[64 * j]; }
#pragma unroll
            for (int r = 0; r < 4; ++r) norm_row_store(v[r], (bf16*)(ws + WS_XN) + (size_t)(c * 256 + C.wave * 32 + i + r) * DM, C.lane); }
}

template <bool MOE_ADD, bool ROUTER, bool WRITE_XN>
__device__ __forceinline__ void p_norm(Ctx& C, const float* rw, const float* rgain) {
    unsigned char* ws = C.ws;
    LAS int* cnt8 = (LAS int*)(C.lds + 1024);
    const bf16* Y = (const bf16*)(ws + R_XP);
    const int4* route = (const int4*)(ws + WS_ROUTE); const int2* slot = (const int2*)(ws + WS_SLOT);
    constexpr int NR = (MOE_ADD || ROUTER) ? 2 : 4;
    for (int c = C.bid; c < 256; c += C.G) {
        if (ROUTER) { __syncthreads(); if (C.tid < 8) cnt8[C.tid] = 0; __syncthreads(); }
#pragma unroll 1
        for (int i = 0; i < 32; i += NR) {
            f32x4 v[NR][4];
#pragma unroll
            for (int r = 0; r < NR; ++r) { const float* hr = C.out + (size_t)(c * 256 + C.wave * 32 + i + r) * DM;
#pragma unroll
                for (int j = 0; j < 4; ++j) v[r][j] = ((const f32x4*)hr + C.lane)[64 * j]; }
            if (MOE_ADD) {
#pragma unroll
                for (int r = 0; r < NR; ++r) { const int row = c * 256 + C.wave * 32 + i + r; float* hr = C.out + (size_t)row * DM;
                    const int4 rt = route[row]; const int2 sl = slot[row]; const float w0 = __builtin_bit_cast(float, rt.y), w1 = __builtin_bit_cast(float, rt.z);
                    const v2u* y0 = (const v2u*)(Y + (size_t)sl.x * DM) + C.lane; const v2u* y1 = (const v2u*)(Y + (size_t)sl.y * DM) + C.lane;
#pragma unroll
                    for (int j = 0; j < 4; ++j) { const v2u a = y0[64 * j], b = y1[64 * j];
                        v[r][j].x += w0 * bflo(a.x) + w1 * bflo(b.x); v[r][j].y += w0 * bfhi(a.x) + w1 * bfhi(b.x); v[r][j].z += w0 * bflo(a.y) + w1 * bflo(b.y); v[r][j].w += w0 * bfhi(a.y) + w1 * bfhi(b.y);
                        ((f32x4*)hr + C.lane)[64 * j] = v[r][j]; } }
            }
            if (WRITE_XN || ROUTER) {
#pragma unroll
                for (int r = 0; r < NR; ++r) { const int row = c * 256 + C.wave * 32 + i + r;
                    float s = 0.f;
#pragma unroll
                    for (int j = 0; j < 4; ++j) s += (v[r][j].x * v[r][j].x + v[r][j].y * v[r][j].y) + (v[r][j].z * v[r][j].z + v[r][j].w * v[r][j].w);
                    const float rstd = rsqrtf(wave_sum(s) * (1.f / DM) + EPS);
                    if (WRITE_XN) { v2u* o8 = (v2u*)((bf16*)(ws + WS_XN) + (size_t)row * DM) + C.lane;
#pragma unroll
                        for (int j = 0; j < 4; ++j) { v2u w; w.x = pk2(v[r][j].x * rstd, v[r][j].y * rstd); w.y = pk2(v[r][j].z * rstd, v[r][j].w * rstd); o8[64 * j] = w; } }
                    if (ROUTER) {
                        float lg[8];
#pragma unroll
                        for (int e = 0; e < 8; ++e) lg[e] = 0.f;
#pragma unroll
                        for (int j = 0; j < 4; ++j) { const int k0 = 4 * C.lane + 256 * j; const f32x4 g4 = *(const f32x4*)(rgain + k0);
#pragma unroll
                            for (int q = 0; q < 4; ++q) { const float xv = v[r][j][q] * rstd * g4[q]; const f32x4 wa = *(const f32x4*)(rw + (size_t)(k0 + q) * 8), wb = *(const f32x4*)(rw + (size_t)(k0 + q) * 8 + 4);
                                lg[0] += xv * wa.x; lg[1] += xv * wa.y; lg[2] += xv * wa.z; lg[3] += xv * wa.w; lg[4] += xv * wb.x; lg[5] += xv * wb.y; lg[6] += xv * wb.z; lg[7] += xv * wb.w; } }
#pragma unroll
                        for (int e = 0; e < 8; ++e) lg[e] = wave_sum(lg[e]);
                        int e0 = 0; float v0 = lg[0];
#pragma unroll
                        for (int e = 1; e < 8; ++e) if (lg[e] > v0) { v0 = lg[e]; e0 = e; }
                        int e1 = -1; float v1 = -INFINITY;
#pragma unroll
                        for (int e = 0; e < 8; ++e) if (e != e0 && (e1 < 0 || lg[e] > v1)) { v1 = lg[e]; e1 = e; }
                        const float ex = expf(v1 - v0), w0 = 1.f / (1.f + ex), w1 = ex / (1.f + ex);
                        if (C.lane == 0) { ((int4*)(ws + WS_ROUTE))[row] = make_int4(e0 | (e1 << 8), __builtin_bit_cast(int, w0), __builtin_bit_cast(int, w1), 0);
                            atomicAdd((int*)&cnt8[e0], 1); atomicAdd((int*)&cnt8[e1], 1); }
                    }
                }
            }
        }
        if (ROUTER) { __syncthreads(); if (C.tid < 8) ((int*)(ws + WS_RCNT))[c * 8 + C.tid] = cnt8[C.tid]; }
    }
}

__device__ __forceinline__ void p_gather(Ctx& C) {
    unsigned char* ws = C.ws;
    LAS int* tot = (LAS int*)(C.lds + 0);
    LAS int* pre = tot + 8;
    LAS int* base = tot + 16;
    LAS int* ee = tot + 32;
    LAS int* sl = tot + 32 + 256;
    const int* rcnt = (const int*)(ws + WS_RCNT);
    const int4* route = (const int4*)(ws + WS_ROUTE);
    for (int c = C.bid; c < 256; c += C.G) {
        __syncthreads();
        { const int e = C.wave; int t = 0, p = 0;
          for (int i = C.lane; i < 256; i += 64) { const int v = rcnt[i * 8 + e]; t += v; if (i < c) p += v; }
#pragma unroll
          for (int o = 32; o >= 1; o >>= 1) { t += __shfl_xor(t, o); p += __shfl_xor(p, o); }
          if (C.lane == 0) { tot[e] = t; pre[e] = p; } }
        if (C.tid < 256) ee[C.tid] = route[c * 256 + C.tid].x;
        __syncthreads();
        if (C.tid == 0) { int off = 0; for (int e = 0; e < 8; ++e) { base[e] = off + pre[e]; const int nt = (tot[e] + 255) >> 8;
                if (c == 0) { int* te = (int*)(ws + WS_RTAB); for (int q = 0; q < nt; ++q) te[(off >> 8) + q] = e; }
                off += nt << 8; }
            if (c == 0) ((int*)(ws + WS_RTAB))[1024] = off >> 8; }
        __syncthreads();
        if (C.tid < 8) { const int e = C.tid; int r = base[e];
            for (int i = 0; i < 256; ++i) { const int pk = ee[i]; if ((pk & 255) == e) sl[2 * i] = r++; if ((pk >> 8) == e) sl[2 * i + 1] = r++; } }
        __syncthreads();
        if (C.tid < 256) ((int2*)(ws + WS_SLOT))[c * 256 + C.tid] = make_int2(sl[2 * C.tid], sl[2 * C.tid + 1]);
        for (int i = 0; i < 32; ++i) { const int tl = C.wave * 32 + i, row = c * 256 + tl;
            const v4u* src = (const v4u*)((const bf16*)(ws + WS_XN) + (size_t)row * DM) + C.lane; const v4u a = src[0], b = src[64];
            v4u* d0 = (v4u*)((bf16*)(ws + R_XP) + (size_t)sl[2 * tl] * DM) + C.lane; v4u* d1 = (v4u*)((bf16*)(ws + R_XP) + (size_t)sl[2 * tl + 1] * DM) + C.lane;
            d0[0] = a; d0[64] = b; d1[0] = a; d1[64] = b; }
    }
}

__device__ __forceinline__ void p_post_kv(Ctx& C) {
    unsigned char* ws = C.ws;
    const bf16* raw = (const bf16*)(ws + R_QKV);
    const float* kn = C.inp(I_KN);
    LAS unsigned char* tl = C.lds + C.wave * 4608;
    const int l = C.lane, c8 = l & 7, r8 = l >> 3, gw = C.bid * NWAVES + C.wave, NGW = C.G * NWAVES;
    for (int it = gw; it < 128 * 64; it += NGW) {
        const int bg = it >> 6, blk = it & 63, b = bg >> 2, g = bg & 3;
        const bf16* rb = raw + (size_t)(b * SEQ + blk * 32) * 2816 + g * 64 + 8 * c8;
        const size_t dst0 = ((size_t)bg * SEQ + blk * 32) * 64 + 8 * c8;
#pragma unroll
        for (int j = 0; j < 6; ++j) {
            v4u x[4];
#pragma unroll
            for (int i = 0; i < 4; ++i) x[i] = *(const v4u*)(rb + (size_t)(r8 + 8 * i) * 2816 + j * 256);
            if (j == 0 || j == 1) {
                bf16* d = (bf16*)(ws + (j == 0 ? R_KCR : R_VCR)) + dst0;
#pragma unroll
                for (int i = 0; i < 4; ++i) *(v4u*)(d + (size_t)(r8 + 8 * i) * 64) = x[i];
            } else if (j == 2 || j == 4) {
                bf16* d = (bf16*)(ws + (j == 2 ? R_KS : R_KW)) + ((size_t)bg * SEQ + blk * 32) * 64 + (c8 >> 2) * 1024 + (c8 & 3) * 8; const float* gk = kn + (j == 2 ? 64 : 128) + 8 * c8;
                const f32x4 ga = *(const f32x4*)gk, gb = *(const f32x4*)(gk + 4);
#pragma unroll
                for (int i = 0; i < 4; ++i) { const float f[8] = {bflo(x[i].x), bfhi(x[i].x), bflo(x[i].y), bfhi(x[i].y), bflo(x[i].z), bfhi(x[i].z), bflo(x[i].w), bfhi(x[i].w)};
                    float ss = (f[0] * f[0] + f[1] * f[1]) + (f[2] * f[2] + f[3] * f[3]) + (f[4] * f[4] + f[5] * f[5]) + (f[6] * f[6] + f[7] * f[7]);
                    ss += __shfl_xor(ss, 1); ss += __shfl_xor(ss, 2); ss += __shfl_xor(ss, 4);
                    const float rs = rsqrtf(ss * (1.f / 64.f) + EPS);
                    v4u o; o.x = pk2(f[0] * rs * ga.x, f[1] * rs * ga.y); o.y = pk2(f[2] * rs * ga.z, f[3] * rs * ga.w); o.z = pk2(f[4] * rs * gb.x, f[5] * rs * gb.y); o.w = pk2(f[6] * rs * gb.z, f[7] * rs * gb.w);
                    *(v4u*)(d + (size_t)(r8 + 8 * i) * 32) = o; }
            } else {
#pragma unroll
                for (int i = 0; i < 4; ++i) *(LAS v4u*)(tl + (r8 + 8 * i) * 144 + 16 * c8) = x[i];
                LDS_WAIT();
                unsigned wv[16];
#pragma unroll
                for (int t2 = 0; t2 < 16; ++t2) { const unsigned lo = *(const LAS bf16*)(tl + (2 * t2) * 144 + 2 * l), hi = *(const LAS bf16*)(tl + (2 * t2 + 1) * 144 + 2 * l); wv[t2] = lo | (hi << 16); }
                bf16* d = (bf16*)(ws + (j == 3 ? R_VST : R_VWT)) + (((size_t)bg * 64 + blk) * 64 + l) * 32;
#pragma unroll
                for (int q = 0; q < 4; ++q) { const v4u o = {wv[4 * q], wv[4 * q + 1], wv[4 * q + 2], wv[4 * q + 3]}; *(v4u*)(d + 8 * q) = o; }
                LDS_WAIT();
            }
        }
    }
}

__device__ __forceinline__ void p_cmp2(Ctx& C) {
    unsigned char* ws = C.ws;
    const bf16* Hk = (const bf16*)(ws + WS_HC); const bf16* Hv = Hk + (size_t)16384 * 256;
    const float* w2k = C.inp(I_CW2K); const float* w2v = C.inp(I_CW2V); const float* kn = C.inp(I_KN);
    LAS float* hk = (LAS float*)(C.lds + C.wave * 2048); LAS float* hv = hk + 256;
    const int l = C.lane, gw = C.bid * NWAVES + C.wave, NGW = C.G * NWAVES;
    for (int r = gw; r < 16384; r += NGW) {
        const int bg = r >> 7, c = r & 127;
        { const v2u a = *((const v2u*)(Hk + (size_t)r * 256) + l), bq = *((const v2u*)(Hv + (size_t)r * 256) + l);
          hk[4 * l] = bflo(a.x); hk[4 * l + 1] = bfhi(a.x); hk[4 * l + 2] = bflo(a.y); hk[4 * l + 3] = bfhi(a.y);
          hv[4 * l] = bflo(bq.x); hv[4 * l + 1] = bfhi(bq.x); hv[4 * l + 2] = bflo(bq.y); hv[4 * l + 3] = bfhi(bq.y); }
        LDS_WAIT();
        float ak = 0.f, av = 0.f;
#pragma unroll 8
        for (int j = 0; j < 256; ++j) { ak += hk[j] * w2k[j * 64 + l]; av += hv[j] * w2v[j * 64 + l]; }
        if (c == 127) { ak = 0.f; av = 0.f; }
        const float rs = rsqrtf(wave_sum(ak * ak) * (1.f / 64.f) + EPS);
        ((bf16*)(ws + WS_KC))[((size_t)bg * 128 + 32 * (c >> 5)) * 64 + (l >> 5) * 1024 + (c & 31) * 32 + (l & 31)] = (bf16)f2bf(ak * rs * kn[l]);
        ((bf16*)(ws + WS_VCT))[(((size_t)bg * 4 + (c >> 5)) * 64 + l) * 32 + (c & 31)] = (bf16)f2bf(av);
        LDS_WAIT();
    }
}

typedef short bf16x8v __attribute__((ext_vector_type(8)));
#define MFMA16(a, b, c) __builtin_amdgcn_mfma_f32_16x16x32_bf16((a), (b), (c), 0, 0, 0)
constexpr float LOG2E = 1.4426950408889634f;
__device__ __forceinline__ float xmax_q4(float v) {
    float t;
    asm volatile("v_mov_b32 %1, %0\n\ts_nop 1\n\tv_permlane16_swap_b32 %0, %1\n\ts_nop 1\n\tv_max_f32 %0, %0, %1\n\tv_mov_b32 %1, %0\n\ts_nop 1\n\tv_permlane32_swap_b32 %0, %1\n\ts_nop 1\n\tv_max_f32 %0, %0, %1" : "+v"(v), "=&v"(t));
    return v;
}
struct AttFrag { bf16x8v ka[2], kb[2]; };
__device__ __forceinline__ void attn_load(AttFrag& f, const bf16* __restrict__ Kb, unsigned koff, int k0) {
    const char* kblk = (const char*)(Kb + (size_t)k0 * 64);
#pragma unroll
    for (int ks = 0; ks < 2; ++ks) { f.ka[ks] = *(const bf16x8v*)(kblk + koff + 2048 * ks); f.kb[ks] = *(const bf16x8v*)(kblk + koff + 256 + 2048 * ks); }
}
template <int MODE, int PATH>
__device__ __forceinline__ void attn_step(const bf16* __restrict__ Kb, unsigned koff, const bf16* __restrict__ Vb, unsigned voff, int k0, int trel, bool tk, int cmax,
                                          const bf16x8v (&qf)[2][2], const f32x4 (&bv)[2][2], const bf16x8v ones, float (&m)[2], f32x4 (&ls)[2], f32x4 (&o)[2][4], const float (&sl2)[2], int q4) {
    AttFrag f; attn_load(f, Kb, koff, k0);
    bf16x8v vf[4]; { const char* vblk = (const char*)(Vb + (size_t)k0 * 64);
#pragma unroll
        for (int dt = 0; dt < 4; ++dt) vf[dt] = *(const bf16x8v*)(vblk + voff + 1024 * dt); }
    constexpr int DMUL = (MODE == 0) ? 16 : 1;
    const float trelf = (float)trel;
    bool ok[8];
    if (PATH == 2) {
#pragma unroll
        for (int i = 0; i < 8; ++i) { const int kk = 8 * q4 + i; const int d = trel - DMUL * kk; ok[i] = (MODE == 0) ? (k0 + kk <= cmax) : (MODE == 1 ? (tk && d >= 0) : (d >= 0 && d < 512)); } }
#pragma unroll
    for (int h = 0; h < 2; ++h) {
        f32x4 sa = MFMA16(f.ka[0], qf[h][0], bv[h][0]), sb = MFMA16(f.kb[0], qf[h][0], bv[h][1]); sa = MFMA16(f.ka[1], qf[h][1], sa); sb = MFMA16(f.kb[1], qf[h][1], sb);
        float mref = m[h] + sl2[h] * trelf;
        float mx;
        if (PATH == 2) { mx = -1e30f;
#pragma unroll
            for (int i = 0; i < 8; ++i) { const float v = i < 4 ? sa[i] : sb[i - 4]; mx = ok[i] ? fmaxf(mx, v) : mx; } }
        else { mx = fmaxf(fmaxf(fmaxf(sa[0], sa[1]), fmaxf(sa[2], sa[3])), fmaxf(fmaxf(sb[0], sb[1]), fmaxf(sb[2], sb[3]))); if (PATH == 1) mx = tk ? mx : -1e30f; }
        mx = xmax_q4(mx);
        if (__any(mx > mref + 8.f)) { const float mn = fmaxf(mref, mx), alpha = __builtin_amdgcn_exp2f(mref - mn); m[h] = mn - sl2[h] * trelf; mref = mn; ls[h] = ls[h] * alpha;
#pragma unroll
            for (int dt = 0; dt < 4; ++dt) o[h][dt] = o[h][dt] * alpha; }
        float p[8];
#pragma unroll
        for (int i = 0; i < 8; ++i) { const float e = __builtin_amdgcn_exp2f((i < 4 ? sa[i] : sb[i - 4]) - mref); p[i] = (PATH == 2) ? (ok[i] ? e : 0.f) : e; }
        unsigned w0 = pg8::cvt_pk_bf16(p[0], p[1]), w1 = pg8::cvt_pk_bf16(p[2], p[3]), w2 = pg8::cvt_pk_bf16(p[4], p[5]), w3 = pg8::cvt_pk_bf16(p[6], p[7]);
        if (PATH == 1) { w0 = tk ? w0 : 0u; w1 = tk ? w1 : 0u; w2 = tk ? w2 : 0u; w3 = tk ? w3 : 0u; }
        const v4u w = {w0, w1, w2, w3}; const bf16x8v pf = __builtin_bit_cast(bf16x8v, w);
#pragma unroll
        for (int dt = 0; dt < 4; ++dt) o[h][dt] = MFMA16(vf[dt], pf, o[h][dt]);
        ls[h] = MFMA16(ones, pf, ls[h]);
    }
}
constexpr int PSW = 132;
__device__ __forceinline__ void p_attn_fast(Ctx& C, unsigned* queue, const int ld, const int qo, const float* qn) {
    unsigned char* ws = C.ws;
    const bf16* Qraw = (const bf16*)(ws + R_QKV);
    const bf16* KC = (const bf16*)(ws + WS_KC); const bf16* VCT = (const bf16*)(ws + WS_VCT);
    const bf16* KS = (const bf16*)(ws + R_KS); const bf16* VST = (const bf16*)(ws + R_VST); const bf16* KW = (const bf16*)(ws + R_KW); const bf16* VWT = (const bf16*)(ws + R_VWT);
    bf16* O = (bf16*)(ws + R_O);
    LAS float* psl = (LAS float*)(C.lds + C.wave * (16 * PSW * 4));
    const int l = C.lane, r16 = l & 15, q4 = l >> 4;
    const unsigned koff = (unsigned)((8 * (r16 >> 2) + (r16 & 3)) * 64 + 16 * q4), voff = (unsigned)((r16 * 32 + 8 * q4) * 2);
    const v4u ones_w = {0x3f803f80u, 0x3f803f80u, 0x3f803f80u, 0x3f803f80u}; const bf16x8v ones = __builtin_bit_cast(bf16x8v, ones_w);
    int qsel = (int)(xb_xcc_id() & 7u), qtry = 0;
    for (;;) {
        unsigned u = 0; if (l == 0) u = __hip_atomic_fetch_add(queue + 64 * qsel, 1u, __ATOMIC_RELAXED, __HIP_MEMORY_SCOPE_AGENT);
        u = (unsigned)__builtin_amdgcn_readfirstlane((int)u);
        if (u >= 2048u) { if (++qtry >= 8) break; qsel = (qsel + 1) & 7; continue; }
        u = ((u >> 7) * 8 + (unsigned)qsel) * 128 + (u & 127);
        const int bg = (int)(u >> 7), tile = 127 - (int)(u & 127), g = bg & 3, b = bg >> 2, t0 = tile * 16, t = t0 + r16, row = b * SEQ + t;
        const bf16* qrow = Qraw + (size_t)row * ld + qo; const bf16* gtp = qrow + 1024 + g * 12;
#define ATT_GATE(idx) (1.f / (1.f + __expf(-bf2f(gtp[(idx)]))))
        bf16* orow = O + (size_t)row * DM + g * 256 + 4 * q4;
        bf16x8v qf[2][2]; float sl2[2]; f32x4 bv[2][2]; float m[2]; f32x4 ls[2]; f32x4 o[2][4];
#define ATT_LOADQ(hp, DM_) do { _Pragma("unroll") for (int h = 0; h < 2; ++h) { sl2[h] = exp2f(-0.5f * (float)(g * 4 + 2 * (hp) + h + 1)) * LOG2E; \
            _Pragma("unroll") for (int i_ = 0; i_ < 4; ++i_) { bv[h][0][i_] = (float)(DM_) * sl2[h] * (float)(8 * q4 + i_); bv[h][1][i_] = (float)(DM_) * sl2[h] * (float)(8 * q4 + 4 + i_); } \
            float xq_[2][8]; float ssq_ = 0.f; \
            _Pragma("unroll") for (int ks = 0; ks < 2; ++ks) { const v4u r_ = *(const v4u*)(qrow + (g * 4 + 2 * (hp) + h) * 64 + 32 * ks + 8 * q4); \
                xq_[ks][0] = bflo(r_.x); xq_[ks][1] = bfhi(r_.x); xq_[ks][2] = bflo(r_.y); xq_[ks][3] = bfhi(r_.y); xq_[ks][4] = bflo(r_.z); xq_[ks][5] = bfhi(r_.z); xq_[ks][6] = bflo(r_.w); xq_[ks][7] = bfhi(r_.w); \
                _Pragma("unroll") for (int j_ = 0; j_ < 8; ++j_) ssq_ += xq_[ks][j_] * xq_[ks][j_]; } \
            ssq_ += __shfl_xor(ssq_, 16); ssq_ += __shfl_xor(ssq_, 32); \
            const float rq_ = rsqrtf(ssq_ * (1.f / 64.f) + EPS) * (0.125f * LOG2E); \
            _Pragma("unroll") for (int ks = 0; ks < 2; ++ks) { const f32x4 ga_ = *(const f32x4*)(qn + 32 * ks + 8 * q4), gb_ = *(const f32x4*)(qn + 32 * ks + 8 * q4 + 4); \
                const v4u w_ = {pg8::cvt_pk_bf16(xq_[ks][0] * rq_ * ga_.x, xq_[ks][1] * rq_ * ga_.y), pg8::cvt_pk_bf16(xq_[ks][2] * rq_ * ga_.z, xq_[ks][3] * rq_ * ga_.w), \
                                pg8::cvt_pk_bf16(xq_[ks][4] * rq_ * gb_.x, xq_[ks][5] * rq_ * gb_.y), pg8::cvt_pk_bf16(xq_[ks][6] * rq_ * gb_.z, xq_[ks][7] * rq_ * gb_.w)}; \
                qf[h][ks] = __builtin_bit_cast(bf16x8v, w_); } } } while (0)
#define ATT_RESET() do { _Pragma("unroll") for (int h = 0; h < 2; ++h) { m[h] = -1e30f; ls[h] = (f32x4){0.f, 0.f, 0.f, 0.f}; _Pragma("unroll") for (int dt = 0; dt < 4; ++dt) o[h][dt] = (f32x4){0.f, 0.f, 0.f, 0.f}; } } while (0)
        const int cmax = t >= 31 ? (((t - 31) >> 4) < 126 ? ((t - 31) >> 4) : 126) : -1;
        const int cmax0 = t0 >= 31 ? (((t0 - 31) >> 4) < 126 ? ((t0 - 31) >> 4) : 126) : -1;
        const bf16* KCb = KC + (size_t)bg * 128 * 64; const bf16* VCb = VCT + (size_t)bg * 128 * 64;
        const int ncs = ((t0 + 15 - 31) >> 4) < 0 ? 0 : ((((t0 + 15 - 31) >> 4) < 126 ? ((t0 + 15 - 31) >> 4) : 126) >> 5) + 1;
#pragma unroll 1
        for (int hp = 0; hp < 2; ++hp) {
            ATT_LOADQ(hp, 16); ATT_RESET();
            for (int st = ncs - 1; st >= 0; --st) {
                if (32 * st + 31 <= cmax0) attn_step<0, 0>(KCb, koff, VCb, voff, 32 * st, t - 31 - 16 * 32 * st, true, cmax, qf, bv, ones, m, ls, o, sl2, q4);
                else attn_step<0, 2>(KCb, koff, VCb, voff, 32 * st, t - 31 - 16 * 32 * st, true, cmax, qf, bv, ones, m, ls, o, sl2, q4); }
#pragma unroll
            for (int h = 0; h < 2; ++h) { const float lt = ls[h][0];
                const float sc_ = lt > 0.f ? ATT_GATE((2 * hp + h) * 3 + 0) / lt : 0.f;
#pragma unroll
                for (int dt = 0; dt < 4; ++dt) { const f32x4 r_ = o[h][dt] * sc_; v2u w; w.x = pg8::cvt_pk_bf16(r_[0], r_[1]); w.y = pg8::cvt_pk_bf16(r_[2], r_[3]);
                    *(v2u*)(orow + (2 * hp + h) * 64 + 16 * dt) = w; } }
            float ps[4][8];
#pragma unroll
            for (int st = 0; st < 4; ++st)
#pragma unroll
                for (int i = 0; i < 8; ++i) ps[st][i] = 0.f;
#pragma unroll
            for (int st = 0; st < 4; ++st) {
                if (st < ncs) {
                    const int k0 = 32 * st; const char* kblk = (const char*)(KCb + (size_t)k0 * 64);
                    bf16x8v ka[2], kb[2];
#pragma unroll
                    for (int ks = 0; ks < 2; ++ks) { ka[ks] = *(const bf16x8v*)(kblk + koff + 2048 * ks); kb[ks] = *(const bf16x8v*)(kblk + koff + 256 + 2048 * ks); }
#pragma unroll
                    for (int h = 0; h < 2; ++h) {
                        f32x4 sa = MFMA16(ka[0], qf[h][0], bv[h][0]), sb = MFMA16(kb[0], qf[h][0], bv[h][1]); sa = MFMA16(ka[1], qf[h][1], sa); sb = MFMA16(kb[1], qf[h][1], sb);
                        const float lt = ls[h][0], inv = lt > 0.f ? 1.f / lt : 0.f, mref = m[h] + sl2[h] * (float)(t - 31 - 16 * k0);
#pragma unroll
                        for (int i = 0; i < 8; ++i) { const int c = k0 + 8 * q4 + i; ps[st][i] += (c <= cmax) ? __builtin_amdgcn_exp2f((i < 4 ? sa[i] : sb[i - 4]) - mref) * inv : 0.f; }
                    }
                }
            }
#pragma unroll
            for (int st = 0; st < 4; ++st) { LAS f32x4* p0 = (LAS f32x4*)(psl + r16 * PSW + 32 * st + 8 * q4);
                f32x4 a = {ps[st][0], ps[st][1], ps[st][2], ps[st][3]}, bq = {ps[st][4], ps[st][5], ps[st][6], ps[st][7]};
                if (hp) { a = a + p0[0]; bq = bq + p0[1]; }
                p0[0] = a; p0[1] = bq; }
            LDS_WAIT();
        }
        unsigned mlo, mhi;
        {
            float sc[16]; const LAS float* pr = psl + r16 * PSW + 32 * q4; const int cur = t >> 5;
            float prev = q4 > 0 ? pr[-1] : 0.f;
#pragma unroll
            for (int jj = 0; jj < 16; ++jj) { const float a = pr[2 * jj], bq = pr[2 * jj + 1]; const float imp = prev + a + bq; prev = bq;
                const int j = 16 * q4 + jj; const bool valid = 32 * j <= t; const bool forced = valid && (j == 0 || j == cur || j == cur - 1);
                sc[jj] = forced ? 1e9f : (valid ? imp : -1e9f); }
            unsigned my = 0u;
#pragma unroll 1
            for (int r = 0; r < 8; ++r) {
                float best = sc[0]; int bi = 0;
#pragma unroll
                for (int jj = 1; jj < 16; ++jj) if (sc[jj] > best) { best = sc[jj]; bi = jj; }
                bi += 16 * q4;
#pragma unroll
                for (int sh = 16; sh <= 32; sh <<= 1) { const float ov = __shfl_xor(best, sh); const int oi = __shfl_xor(bi, sh); if (ov > best || (ov == best && oi < bi)) { best = ov; bi = oi; } }
                if ((bi >> 4) == q4) { const int jj0 = bi & 15; if (best > -0.5e9f) my |= 1u << jj0;
#pragma unroll
                    for (int jj = 0; jj < 16; ++jj) if (jj == jj0) sc[jj] = -INFINITY; }
            }
            mlo = (q4 == 0 ? my : 0u) | (q4 == 1 ? my << 16 : 0u); mhi = (q4 == 2 ? my : 0u) | (q4 == 3 ? my << 16 : 0u);
            mlo |= __shfl_xor(mlo, 16); mlo |= __shfl_xor(mlo, 32); mhi |= __shfl_xor(mhi, 16); mhi |= __shfl_xor(mhi, 32);
        }
        LDS_WAIT();
        unsigned ulo = mlo, uhi = mhi;
#pragma unroll
        for (int sh = 1; sh <= 8; sh <<= 1) { ulo |= __shfl_xor(ulo, sh); uhi |= __shfl_xor(uhi, sh); }
        const unsigned long long un0 = ((unsigned long long)(unsigned)__builtin_amdgcn_readfirstlane((int)uhi) << 32) | (unsigned)__builtin_amdgcn_readfirstlane((int)ulo);
        const unsigned long long mine = ((unsigned long long)mhi << 32) | mlo;
#pragma unroll 1
        for (int hp = 0; hp < 2; ++hp) {
            ATT_LOADQ(hp, 1);
#define ATT_ADD_OUT(br) do { _Pragma("unroll") for (int h = 0; h < 2; ++h) { const float lt = ls[h][0]; const float sc_ = lt > 0.f ? ATT_GATE((2 * hp + h) * 3 + (br)) / lt : 0.f; \
            _Pragma("unroll") for (int dt = 0; dt < 4; ++dt) { v2u* op = (v2u*)(orow + (2 * hp + h) * 64 + 16 * dt); const v2u c_ = *op; const f32x4 r_ = o[h][dt] * sc_; \
                v2u w; w.x = pg8::cvt_pk_bf16(r_[0] + bflo(c_.x), r_[1] + bfhi(c_.x)); w.y = pg8::cvt_pk_bf16(r_[2] + bflo(c_.y), r_[3] + bfhi(c_.y)); *op = w; } } } while (0)
            {
                const bf16* Kb = KS + (size_t)bg * SEQ * 64; const bf16* Vb = VST + (size_t)bg * SEQ * 64;
                ATT_RESET();
                unsigned long long un = un0;
                const int cur0 = t0 >> 5;
                while (un) { const int j = 63 - __builtin_clzll(un); un &= ~(1ull << j);
                    const bool tk = ((mine >> j) & 1ull) != 0ull;
                    if (j >= cur0) attn_step<1, 2>(Kb, koff, Vb, voff, 32 * j, t - 32 * j, tk, 0, qf, bv, ones, m, ls, o, sl2, q4);
                    else if (__all(tk)) attn_step<1, 0>(Kb, koff, Vb, voff, 32 * j, t - 32 * j, true, 0, qf, bv, ones, m, ls, o, sl2, q4);
                    else attn_step<1, 1>(Kb, koff, Vb, voff, 32 * j, t - 32 * j, tk, 0, qf, bv, ones, m, ls, o, sl2, q4); }
                ATT_ADD_OUT(1);
            }
            {
                const bf16* Kb = KW + (size_t)bg * SEQ * 64; const bf16* Vb = VWT + (size_t)bg * SEQ * 64;
                const int sb = t0 >= 511 ? (t0 - 511) >> 5 : 0, se = t0 >> 5;
                ATT_RESET();
                for (int st = se; st >= sb; --st) {
                    if (32 * st + 31 <= t0 && 32 * st > t0 - 497) attn_step<2, 0>(Kb, koff, Vb, voff, 32 * st, t - 32 * st, true, 0, qf, bv, ones, m, ls, o, sl2, q4);
                    else attn_step<2, 2>(Kb, koff, Vb, voff, 32 * st, t - 32 * st, true, 0, qf, bv, ones, m, ls, o, sl2, q4); }
                ATT_ADD_OUT(2);
            }
        }
#undef ATT_ADD_OUT
#undef ATT_LOADQ
#undef ATT_RESET
#undef ATT_GATE
    }
}

constexpr int SCQ = 272, SCT = 144;
constexpr int LQ_ = 0, LK_ = 17408, LKT_ = 34816, LVT_ = 53248, LP_ = 71680, LO_ = 80896, LE_ = 114688, LT_ = 115712;
__device__ __forceinline__ void p_scan_fast(Ctx& C, int layer) {
    unsigned char* ws = C.ws;
    const bf16* Pq = (const bf16*)(ws + R_PQ); const bf16* Pi = (const bf16*)(ws + R_PI); const bf16* Pg = (const bf16*)(ws + R_PG); const float* LF = (const float*)(ws + R_LF);
    bf16* O2 = (bf16*)(ws + R_O2);
    const float* gn = C.inp(I_HGN) + layer * 128;
    LAS unsigned char* L = C.lds;
    const int tid = C.tid, lane = C.lane, w = C.wave, r16 = lane & 15, q4 = lane >> 4, k = tid & 127, seg = tid >> 7;
    LAS float* tot = (LAS float*)(L + LT_); LAS float* eref = (LAS float*)(L + LE_); LAS float* elr = eref + 128;
    { const int tile = tid >> 8, e = tid & 255, row = e >> 4, col = e & 15;
      *(LAS bf16*)(L + LP_ + ((tile ? 32 : 0) + row) * SCT + ((tile ? 48 : 16) + col) * 2) = 0; }
    for (int bh = C.bid; bh < 256; bh += C.G) {
        const int b = bh >> 3, h = bh & 7;
        const size_t base = (size_t)(b * SEQ) * DM + h * 128;
        f32x4 S[8];
#pragma unroll
        for (int i = 0; i < 8; ++i) S[i] = (f32x4){0.f, 0.f, 0.f, 0.f};
        bf16 qv[16], vv[16]; float lf[16];
#define SC_LOAD(t0) do { _Pragma("unroll") for (int i = 0; i < 16; ++i) { const size_t off = base + (size_t)((t0) + 16 * seg + i) * DM + k; qv[i] = Pq[off]; vv[i] = Pi[off]; lf[i] = LF[off]; } } while (0)
        SC_LOAD(0);
#pragma unroll 1
        for (int c = 0; c < SEQ / 64; ++c) {
            const int t0 = c * 64;
            float cs[16]; { float run = 0.f;
#pragma unroll
                for (int i = 0; i < 16; ++i) { run += lf[i]; cs[i] = run; }
                tot[seg * 128 + k] = run; }
            __syncthreads();
            { const float a0 = tot[k], a1 = tot[128 + k], a2 = tot[256 + k], a3 = tot[384 + k];
              const float off = seg == 0 ? 0.f : (seg == 1 ? a0 : (seg == 2 ? a0 + a1 : a0 + a1 + a2)), ref = a0 + a1, last = ref + a2 + a3;
              unsigned kt[16];
#pragma unroll
              for (int i = 0; i < 16; ++i) { const float d = off + cs[i] - ref; const float qt = bf2f(qv[i]) * __expf(fminf(d, 80.f)), ktv = (1.f - __expf(lf[i])) * __expf(fminf(-d, 80.f));
                  const int s = 16 * seg + i; kt[i] = f2bf(ktv);
                  *(LAS bf16*)(L + LQ_ + s * SCQ + k * 2) = (bf16)f2bf(qt); *(LAS bf16*)(L + LK_ + s * SCQ + k * 2) = (bf16)kt[i]; }
              v4u w0, w1, x0, x1;
              w0.x = kt[0] | (kt[1] << 16); w0.y = kt[2] | (kt[3] << 16); w0.z = kt[4] | (kt[5] << 16); w0.w = kt[6] | (kt[7] << 16);
              w1.x = kt[8] | (kt[9] << 16); w1.y = kt[10] | (kt[11] << 16); w1.z = kt[12] | (kt[13] << 16); w1.w = kt[14] | (kt[15] << 16);
              x0.x = vv[0] | ((unsigned)vv[1] << 16); x0.y = vv[2] | ((unsigned)vv[3] << 16); x0.z = vv[4] | ((unsigned)vv[5] << 16); x0.w = vv[6] | ((unsigned)vv[7] << 16);
              x1.x = vv[8] | ((unsigned)vv[9] << 16); x1.y = vv[10] | ((unsigned)vv[11] << 16); x1.z = vv[12] | ((unsigned)vv[13] << 16); x1.w = vv[14] | ((unsigned)vv[15] << 16);
              *(LAS v4u*)(L + LKT_ + k * SCT + seg * 32) = w0; *(LAS v4u*)(L + LKT_ + k * SCT + seg * 32 + 16) = w1;
              *(LAS v4u*)(L + LVT_ + k * SCT + seg * 32) = x0; *(LAS v4u*)(L + LVT_ + k * SCT + seg * 32 + 16) = x1;
              if (seg == 0) { eref[k] = __expf(ref); elr[k] = __expf(last - ref); } }
            __syncthreads();
            if (c + 1 < SEQ / 64) SC_LOAD(t0 + 64);
#pragma unroll 1
            for (int ti = w; ti < 10; ti += 8) {
                const int rt = ti < 1 ? 0 : (ti < 3 ? 1 : (ti < 6 ? 2 : 3)), ct = ti - (rt * (rt + 1)) / 2;
                f32x4 acc = {0.f, 0.f, 0.f, 0.f};
#pragma unroll
                for (int p = 0; p < 4; ++p) { const bf16x8v a = *(const LAS bf16x8v*)(L + LQ_ + (16 * rt + r16) * SCQ + (32 * p + 8 * q4) * 2), bq = *(const LAS bf16x8v*)(L + LK_ + (16 * ct + r16) * SCQ + (32 * p + 8 * q4) * 2);
                    acc = MFMA16(a, bq, acc); }
#pragma unroll
                for (int i = 0; i < 4; ++i) { const int t = 16 * rt + 4 * q4 + i, s = 16 * ct + r16; *(LAS bf16*)(L + LP_ + t * SCT + s * 2) = (bf16)f2bf(s <= t ? acc[i] : 0.f); }
            }
            __syncthreads();
            bf16x8v sfrag[4]; f32x4 e8[4][2];
#pragma unroll
            for (int p = 0; p < 4; ++p) { e8[p][0] = *(const LAS f32x4*)(eref + 32 * p + 8 * q4); e8[p][1] = *(const LAS f32x4*)(eref + 32 * p + 8 * q4 + 4);
                S[2 * p] = S[2 * p] * e8[p][0]; S[2 * p + 1] = S[2 * p + 1] * e8[p][1];
                const v4u wv = {pg8::cvt_pk_bf16(S[2 * p][0], S[2 * p][1]), pg8::cvt_pk_bf16(S[2 * p][2], S[2 * p][3]), pg8::cvt_pk_bf16(S[2 * p + 1][0], S[2 * p + 1][1]), pg8::cvt_pk_bf16(S[2 * p + 1][2], S[2 * p + 1][3])};
                sfrag[p] = __builtin_bit_cast(bf16x8v, wv); }
            bf16x8v vfr[2];
#pragma unroll
            for (int ss = 0; ss < 2; ++ss) vfr[ss] = *(const LAS bf16x8v*)(L + LVT_ + (16 * w + r16) * SCT + (32 * ss + 8 * q4) * 2);
#pragma unroll
            for (int rt = 0; rt < 4; ++rt) { f32x4 o = {0.f, 0.f, 0.f, 0.f};
#pragma unroll
                for (int p = 0; p < 4; ++p) { const bf16x8v a = *(const LAS bf16x8v*)(L + LQ_ + (16 * rt + r16) * SCQ + (32 * p + 8 * q4) * 2); o = MFMA16(a, sfrag[p], o); }
#pragma unroll
                for (int ss = 0; ss < 2; ++ss) if (ss <= rt / 2) { const bf16x8v a = *(const LAS bf16x8v*)(L + LP_ + (16 * rt + r16) * SCT + (32 * ss + 8 * q4) * 2); o = MFMA16(a, vfr[ss], o); }
#pragma unroll
                for (int i = 0; i < 4; ++i) *(LAS float*)(L + LO_ + (16 * rt + 4 * q4 + i) * 528 + (16 * w + r16) * 4) = o[i]; }
#pragma unroll
            for (int p = 0; p < 4; ++p)
#pragma unroll
                for (int ab = 0; ab < 2; ++ab) { const int krow = 32 * p + 8 * (r16 >> 2) + (r16 & 3) + 4 * ab;
#pragma unroll
                    for (int ss = 0; ss < 2; ++ss) { const bf16x8v a = *(const LAS bf16x8v*)(L + LKT_ + krow * SCT + (32 * ss + 8 * q4) * 2); S[2 * p + ab] = MFMA16(a, vfr[ss], S[2 * p + ab]); } }
#pragma unroll
            for (int p = 0; p < 4; ++p) { const f32x4 l0 = *(const LAS f32x4*)(elr + 32 * p + 8 * q4), l1 = *(const LAS f32x4*)(elr + 32 * p + 8 * q4 + 4); S[2 * p] = S[2 * p] * l0; S[2 * p + 1] = S[2 * p + 1] * l1; }
            __syncthreads();
#pragma unroll
            for (int rep = 0; rep < 2; ++rep) { const int tok = (tid >> 4) + 32 * rep, part = tid & 15;
                const f32x4 oa = *(const LAS f32x4*)(L + LO_ + tok * 528 + part * 32), ob = *(const LAS f32x4*)(L + LO_ + tok * 528 + part * 32 + 16);
                float ss = (oa.x * oa.x + oa.y * oa.y) + (oa.z * oa.z + oa.w * oa.w) + (ob.x * ob.x + ob.y * ob.y) + (ob.z * ob.z + ob.w * ob.w);
                ss += __shfl_xor(ss, 1); ss += __shfl_xor(ss, 2); ss += __shfl_xor(ss, 4); ss += __shfl_xor(ss, 8);
                const float rstd = rsqrtf(ss * (1.f / 128.f) + EPS);
                const size_t off = base + (size_t)(t0 + tok) * DM + part * 8; const v4u g8 = *(const v4u*)(Pg + off);
                const f32x4 ga = *(const f32x4*)(gn + part * 8), gb = *(const f32x4*)(gn + part * 8 + 4);
                v4u wv; wv.x = pk2(oa.x * rstd * ga.x * bflo(g8.x), oa.y * rstd * ga.y * bfhi(g8.x)); wv.y = pk2(oa.z * rstd * ga.z * bflo(g8.y), oa.w * rstd * ga.w * bfhi(g8.y));
                wv.z = pk2(ob.x * rstd * gb.x * bflo(g8.z), ob.y * rstd * gb.y * bfhi(g8.z)); wv.w = pk2(ob.z * rstd * gb.z * bflo(g8.w), ob.w * rstd * gb.w * bfhi(g8.w));
                *(v4u*)(O2 + off) = wv; }
        }
#undef SC_LOAD
        __syncthreads();
    }
}

#define PH_BEGIN { const bool run_ = (pid >= lo && pid < hi); ++pid; if (run_) { { int ln_; asm volatile("v_mbcnt_lo_u32_b32 %0, -1, 0\n\tv_mbcnt_hi_u32_b32 %0, -1, %0" : "=v"(ln_)); C.lane = ln_; C.tid = C.wave * 64 + ln_; }
#define PH_END   if (pid < hi) xcd_barrier(bar); } }
#define XN ((const bf16*)(ws + WS_XN))
#define RTAB ((const int*)(ws + WS_RTAB))

template <int L>
__device__ __forceinline__ void run_layer(Ctx& C, const XcdBarrier& bar, int& pid, const int lo, const int hi, PG8_LAS unsigned char* ring) {
    unsigned char* const ws = C.ws;

        const int li = L >> 1;
        if (L < 2) {
            PH_BEGIN { pg8::Gemm g{XN, (const bf16*)(ws + W_HIN) + (size_t)L * 4096 * 1024, 1024, 1024, 0}; pg8::GenOrder S; S.init(256, 16, C.G, C.bid, nullptr);
                pg8::EpiHgrnIn E{ws, L};
                pg8::gemm_phase<pg8::EpiHgrnIn, pg8::GenOrder, true, true>(ring, g, S, E, C.wave); } PH_END
            PH_BEGIN p_scan_fast(C, L); PH_END
            if (PROBE_DUP & 16) { PH_BEGIN p_scan_fast(C, L); PH_END }
        } else {
            PH_BEGIN { const bool first = (L == 2); pg8::Gemm g{XN, (const bf16*)(ws + (first ? W_KVQ : W_Q3)), 1024, 1024, 0}; pg8::GenOrder S; S.init(256, first ? 11 : 5, C.G, C.bid, nullptr);
                pg8::EpiBf16 E{(bf16*)(ws + R_QKV), first ? 2816 : 1280, nullptr, 0, 0};
                pg8::gemm_phase<pg8::EpiBf16, pg8::GenOrder, true, true>(ring, g, S, E, C.wave); } PH_END
            if (L == 2) {
                PH_BEGIN p_post_kv(C); PH_END
                if (PROBE_DUP & 8) { PH_BEGIN p_post_kv(C); PH_END }
                PH_BEGIN { pg8::Gemm g{(const bf16*)(ws + R_KCR), (const bf16*)(ws + W_CMP1), 2048, 1024, (size_t)256 * 2048 * 2}; pg8::GenOrder S; S.init(128, 1, C.G, C.bid, RTAB + 2048);
                    pg8::EpiBf16 E{(bf16*)(ws + WS_HC), 256, (const float*)(ws + WS_CB), 1, 256};
                    pg8::gemm_phase<pg8::EpiBf16, pg8::GenOrder, true, true>(ring, g, S, E, C.wave); } PH_END
                PH_BEGIN p_cmp2(C); PH_END
            if (PROBE_DUP & 32) { PH_BEGIN p_cmp2(C); PH_END }
            }
            PH_BEGIN p_attn_fast(C, (unsigned*)(ws + WS_CTL) + 8192 + 2048 * (L - 2), L == 2 ? 2816 : 1280, L == 2 ? 1536 : 0, C.inp(I_NQN) + (L - 2) * 64); PH_END
            if (PROBE_DUP & 1) { PH_BEGIN p_attn_fast(C, (unsigned*)(ws + WS_CTL) + 8192 + 2048 * (L - 2) + 1024, L == 2 ? 2816 : 1280, L == 2 ? 1536 : 0, C.inp(I_NQN) + (L - 2) * 64); PH_END }
        }
        PH_BEGIN { pg8::Gemm g{(const bf16*)(ws + (L < 2 ? R_O2 : R_O)), (const bf16*)(ws + (L < 2 ? W_HOUT : W_NOUT)) + (size_t)(L & 1) * 1024 * 1024, 1024, 1024, 0};
            pg8::GenOrder S; S.init(256, 4, C.G, C.bid, nullptr);
            pg8::EpiRes E{L == 0 ? C.inp(I_X) : C.out, C.out, 1024};
            pg8::gemm_phase<pg8::EpiRes, pg8::GenOrder, true, true>(ring, g, S, E, C.wave); } PH_END
        PH_BEGIN { if (L & 1) p_norm<false, true, true>(C, C.inp(I_MR) + (size_t)li * 1024 * 8, C.inp(I_NFFN) + L * 1024); else p_norm<false, false, true>(C, nullptr, nullptr); } PH_END
            if (PROBE_DUP & 4) { PH_BEGIN { if (L & 1) p_norm<false, true, true>(C, C.inp(I_MR) + (size_t)li * 1024 * 8, C.inp(I_NFFN) + L * 1024); else p_norm<false, false, true>(C, nullptr, nullptr); } PH_END }
        if (L & 1) { PH_BEGIN p_gather(C); PH_END
            if (PROBE_DUP & 32) { PH_BEGIN p_gather(C); PH_END } }
        PH_BEGIN { const bool moe = (L & 1) != 0;
            pg8::Gemm g{moe ? (const bf16*)(ws + R_XP) : XN, moe ? (const bf16*)(ws + W_MGU) + (size_t)li * 8 * 2 * DFE * 1024 : (const bf16*)(ws + W_FGU) + (size_t)li * 2 * DFF * 1024, 1024, 1024, moe ? (size_t)2 * DFE * 1024 * 2 : 0};
            pg8::GenOrder S; S.init(moe ? RTAB[1024] : 256, moe ? 28 : 22, C.G, C.bid, moe ? RTAB : nullptr);
            pg8::EpiSwiGLU E{(bf16*)(ws + (moe ? R_HM : R_HF)), moe ? DFE : DFF};
            pg8::gemm_phase<pg8::EpiSwiGLU, pg8::GenOrder, true, true>(ring, g, S, E, C.wave); } PH_END
        if (!(L & 1)) {
            PH_BEGIN { pg8::Gemm g{(const bf16*)(ws + R_HF), (const bf16*)(ws + W_FDN) + (size_t)li * 1024 * DFF, DFF, DFF, 0}; pg8::GenOrder S; S.init(256, 4, C.G, C.bid, nullptr);
                pg8::EpiRes E{C.out, C.out, 1024};
                pg8::gemm_phase<pg8::EpiRes, pg8::GenOrder, true, true>(ring, g, S, E, C.wave); } PH_END
            PH_BEGIN p_norm<false, false, true>(C, nullptr, nullptr); PH_END
            if (PROBE_DUP & 4) {             PH_BEGIN p_norm<false, false, true>(C, nullptr, nullptr); PH_END }
        } else {
            PH_BEGIN { pg8::Gemm g{(const bf16*)(ws + R_HM), (const bf16*)(ws + W_MDN) + (size_t)li * 8 * 1024 * DFE, DFE, DFE, (size_t)1024 * DFE * 2}; pg8::GenOrder S; S.init(RTAB[1024], 4, C.G, C.bid, RTAB);
                pg8::EpiBf16 E{(bf16*)(ws + R_XP), 1024, nullptr, 0, 0};
                pg8::gemm_phase<pg8::EpiBf16, pg8::GenOrder, true, true>(ring, g, S, E, C.wave); } PH_END
            PH_BEGIN { if (L == 1) p_norm<true, false, true>(C, nullptr, nullptr); else p_norm<true, false, false>(C, nullptr, nullptr); } PH_END
        }
    }

struct Args { const float* in[24]; float* out; unsigned char* ws; int ph_lo, ph_hi; };
constexpr int N_PHASES = 34;

__global__ void __launch_bounds__(NWAVES * 64, 2) yoco_fwd(Args args) {
    extern __shared__ __attribute__((aligned(16))) unsigned char lds_raw[];
    Ctx C;
    C.lds = (LAS unsigned char*)lds_raw;
    C.wave = __builtin_amdgcn_readfirstlane((int)(threadIdx.x >> 6)); C.tid = threadIdx.x; C.lane = C.tid & 63;
    C.G = gridDim.x; C.bid = blockIdx.x;
    C.out = args.out; C.ws = args.ws;
    unsigned char* const ws = args.ws;
    volatile LAS unsigned* MISC = (volatile LAS unsigned*)(C.lds + MISC_OFF);
    if (C.tid < 32) MISC[C.tid] = 0u;
    __syncthreads();
    XcdBarrier bar = xcd_barrier_post((unsigned*)(ws + WS_CTL) + 4096, MISC + 8);
    const int lo = args.ph_lo, hi = args.ph_hi;
    int pid = 0;
    PG8_LAS unsigned char* ring = (PG8_LAS unsigned char*)lds_raw;
    PH_BEGIN p_prologue(C); PH_END
            if (PROBE_DUP & 2) {     PH_BEGIN p_prologue(C); PH_END }

    run_layer<0>(C, bar, pid, lo, hi, ring); run_layer<1>(C, bar, pid, lo, hi, ring); run_layer<2>(C, bar, pid, lo, hi, ring); run_layer<3>(C, bar, pid, lo, hi, ring);
#undef PH_BEGIN
#undef PH_END
#undef XN
#undef RTAB
}

extern "C" void kernel_launch(void* const* d_in, const int* in_sizes, int n_in, void* d_out, int out_size, void* d_ws, size_t ws_size, hipStream_t stream) {
    static int grid = 0;
    if (grid == 0) {
        if (n_in != 24 || in_sizes[0] != NT * DM || out_size != NT * DM || ws_size < WS_NEED) { fprintf(stderr, "kernel_launch: unexpected shapes / workspace (n_in %d, ws %zu, need %zu)\n", n_in, ws_size, (size_t)WS_NEED); grid = -1; return; }
        int dev = 0, cus = 0;
        if (hipGetDevice(&dev) != hipSuccess || hipDeviceGetAttribute(&cus, hipDeviceAttributeMultiprocessorCount, dev) != hipSuccess) { grid = -1; return; }
        if (hipFuncSetAttribute((const void*)yoco_fwd, hipFuncAttributeMaxDynamicSharedMemorySize, LDS_BYTES) != hipSuccess) { fprintf(stderr, "kernel_launch: hipFuncSetAttribute failed\n"); grid = -1; return; }
        int per_cu = 0;
        if (hipOccupancyMaxActiveBlocksPerMultiprocessor(&per_cu, (const void*)yoco_fwd, NWAVES * 64, LDS_BYTES) != hipSuccess || per_cu < 1) { fprintf(stderr, "kernel_launch: occupancy query says %d\n", per_cu); }
        (void)hipGetLastError();
        grid = cus;
    }
    if (grid < 0) return;
    (void)hipMemsetAsync((char*)d_ws + WS_CTL, 0, CTL_ZERO_BYTES, stream);
    Args a{};
    for (int i = 0; i < 24; ++i) a.in[i] = (const float*)d_in[i];
    a.out = (float*)d_out; a.ws = (unsigned char*)d_ws;
#if MK_SINGLE
    a.ph_lo = 0; a.ph_hi = PROBE_DUP ? 1000 : N_PHASES;
    hipLaunchKernelGGL(yoco_fwd, dim3(grid), dim3(NWAVES * 64), LDS_BYTES, stream, a);
#else
    for (int k = 0; k < N_PHASES; ++k) { a.ph_lo = k; a.ph_hi = k + 1; hipLaunchKernelGGL(yoco_fwd, dim3(grid), dim3(NWAVES * 64), LDS_BYTES, stream, a); }
#endif
}
```

```cpp
#include <hip/hip_runtime.h>
#include <cstdio>
#include <cstdint>

#ifndef PROBE_DUP
#define PROBE_DUP 0
#endif
#ifndef MK_SINGLE
#define MK_SINGLE 1
#endif

namespace pg8 {
#define PG8_LAS __attribute__((address_space(3)))
typedef unsigned short bf16_t;
typedef short bf16x8 __attribute__((ext_vector_type(8)));
typedef float f32x4 __attribute__((ext_vector_type(4)));
typedef unsigned u32x4 __attribute__((ext_vector_type(4)));
constexpr int BM = 256, BK = 64, HALF = 128, HTB = HALF * BK * 2  , STAGE_BYTES = 8 * HTB, NXCD = 8, WGM = 8;

__host__ __device__ __forceinline__ int lds_byte(int r, int c) { const int st = (r >> 4) * 2 + (c >> 5), rr = r & 15, cc = c & 31, ob = rr * 64 + cc * 2; return st * 1024 + (ob ^ (((ob >> 9) & 1) << 5)); }
__host__ __device__ __forceinline__ void stage_rc(int b, int& R, int& C) { const int st = b / 1024, sb = b % 1024, swz = sb ^ (((sb >> 9) & 1) << 5); R = (st >> 1) * 16 + swz / 64; C = (st & 1) * 32 + (swz % 64) / 2; }
__host__ __device__ __forceinline__ int perm32(int rho) { const int n = rho >> 4, i = rho & 15; return 8 * (i >> 2) + 4 * n + (i & 3); }

struct Unit { int pm, pn, e; };
struct Gemm { const bf16_t* A; const bf16_t* Bt; int K; int lda; size_t estride; };

struct GenOrder {
    int nM, nN, nwg, G, c; const int* tile_e;
    __device__ void init(int nM_, int nN_, int G_, int c_, const int* te) { nM = nM_; nN = nN_; nwg = nM * nN; G = G_; c = c_; tile_e = te; }
    __device__ bool next(int i, Unit& u) const {
        const long L = (long)i * G + c; if (L >= nwg) return false;
        int wgid = (int)L; { const int q = nwg / NXCD, r = nwg % NXCD, xcd = wgid % NXCD, off = wgid / NXCD; wgid = (xcd < r ? xcd * (q + 1) : r * (q + 1) + (xcd - r) * q) + off; }
        const int nig = WGM * nN, gid = wgid / nig, fm = gid * WGM, gsz = (nM - fm) < WGM ? (nM - fm) : WGM;
        u.pm = fm + ((wgid % nig) % gsz); u.pn = (wgid % nig) / gsz; u.e = tile_e ? tile_e[u.pm] : 0; return true;
    }
    __device__ __forceinline__ void a_ready(const Unit&) const {}
    __device__ __forceinline__ void done(const Unit&) const {}
};

__device__ __forceinline__ unsigned cvt_pk_bf16(float lo, float hi) { unsigned r; asm volatile("v_cvt_pk_bf16_f32 %0, %1, %2" : "=v"(r) : "v"(lo), "v"(hi)); return r; }
__device__ __forceinline__ float silu_f(float v) { return v * __builtin_amdgcn_rcpf(1.0f + __expf(-v)); }
__device__ __forceinline__ float clamp448(float v) { return fminf(fmaxf(v, -448.f), 448.f); }
__device__ __forceinline__ unsigned pk4_fp8(float a, float b, float c, float d) {
    int w = __builtin_amdgcn_cvt_pk_fp8_f32(clamp448(a), clamp448(b), 0, false); w = __builtin_amdgcn_cvt_pk_fp8_f32(clamp448(c), clamp448(d), w, true); return (unsigned)w; }
constexpr float FP8_SW1 = 32.f, FP8_SW2 = 64.f, FP8_SH = 8.f;

struct EpiBf16 {
    static constexpr bool PERM = true, AFTER_DRAIN = false;
    bf16_t* O; int ldc; const float* bias; int act; int bias_es; float oscale;
    __device__ __forceinline__ void operator()(const f32x4 (&acc)[2][2][4][2], const Unit& u, int wr, int wc, int fr, int fq) const {
        const int row0 = u.pm * BM + wr * 64 + fr, col0 = u.pn * BM + wc * 32 + 8 * fq;
        f32x4 bv[2][2];
#pragma unroll
        for (int bj = 0; bj < 2; ++bj)
#pragma unroll
            for (int n = 0; n < 2; ++n) bv[bj][n] = bias ? *(const f32x4*)(bias + u.e * bias_es + col0 + bj * HALF + 4 * n) : (f32x4){0.f, 0.f, 0.f, 0.f};
#pragma unroll
        for (int ai = 0; ai < 2; ++ai)
#pragma unroll
            for (int m = 0; m < 4; ++m) { bf16_t* rowp = O + (size_t)(row0 + ai * HALF + m * 16) * ldc + col0;
#pragma unroll
                for (int bj = 0; bj < 2; ++bj) { f32x4 v0 = acc[ai][bj][m][0] * oscale + bv[bj][0], v1 = acc[ai][bj][m][1] * oscale + bv[bj][1];
                    if (act == 1) {
#pragma unroll
                        for (int i = 0; i < 4; ++i) { v0[i] = silu_f(v0[i]); v1[i] = silu_f(v1[i]); } }
                    u32x4 w; w.x = cvt_pk_bf16(v0[0], v0[1]); w.y = cvt_pk_bf16(v0[2], v0[3]); w.z = cvt_pk_bf16(v1[0], v1[1]); w.w = cvt_pk_bf16(v1[2], v1[3]);
                    *(u32x4*)(rowp + bj * HALF) = w; } }
    }
};
struct EpiRes {
    static constexpr bool PERM = false, AFTER_DRAIN = false;
    const float* base; float* out; int ldc;
    __device__ __forceinline__ void operator()(const f32x4 (&acc)[2][2][4][2], const Unit& u, int wr, int wc, int fr, int fq) const {
        const int row0 = u.pm * BM + wr * 64 + fr, col0 = u.pn * BM + wc * 32 + 4 * fq;
#pragma unroll
        for (int ai = 0; ai < 2; ++ai)
#pragma unroll
            for (int m = 0; m < 4; ++m) { const size_t off = (size_t)(row0 + ai * HALF + m * 16) * ldc + col0;
#pragma unroll
                for (int bj = 0; bj < 2; ++bj)
#pragma unroll
                    for (int n = 0; n < 2; ++n) { const f32x4 b = *(const f32x4*)(base + off + bj * HALF + n * 16); *(f32x4*)(out + off + bj * HALF + n * 16) = b + acc[ai][bj][m][n]; } }
    }
};
struct EpiSwiGLU {
    static constexpr bool PERM = true, AFTER_DRAIN = false;
    bf16_t* O; int ldc;
    __device__ __forceinline__ void operator()(const f32x4 (&acc)[2][2][4][2], const Unit& u, int wr, int wc, int fr, int fq) const {
        const int row0 = u.pm * BM + wr * 64 + fr, col0 = u.pn * HALF + wc * 32 + 8 * fq;
#pragma unroll
        for (int ai = 0; ai < 2; ++ai)
#pragma unroll
            for (int m = 0; m < 4; ++m) { bf16_t* rowp = O + (size_t)(row0 + ai * HALF + m * 16) * ldc + col0;
                f32x4 v0, v1;
#pragma unroll
                for (int i = 0; i < 4; ++i) { v0[i] = silu_f(acc[ai][0][m][0][i]) * acc[ai][1][m][0][i]; v1[i] = silu_f(acc[ai][0][m][1][i]) * acc[ai][1][m][1][i]; }
                u32x4 w; w.x = cvt_pk_bf16(v0[0], v0[1]); w.y = cvt_pk_bf16(v0[2], v0[3]); w.z = cvt_pk_bf16(v1[0], v1[1]); w.w = cvt_pk_bf16(v1[2], v1[3]);
                *(u32x4*)rowp = w; }
    }
};
struct EpiSwiGLU8 {
    static constexpr bool PERM = true, AFTER_DRAIN = false;
    unsigned char* O; int ldc;
    __device__ __forceinline__ void operator()(const f32x4 (&acc)[2][2][4][2], const Unit& u, int wr, int wc, int fr, int fq) const {
        const int row0 = u.pm * BM + wr * 64 + fr, col0 = u.pn * HALF + wc * 32 + 8 * fq; constexpr float si = 1.f / FP8_SW1;
#pragma unroll
        for (int ai = 0; ai < 2; ++ai)
#pragma unroll
            for (int m = 0; m < 4; ++m) { unsigned char* rowp = O + (size_t)(row0 + ai * HALF + m * 16) * ldc + col0;
                f32x4 v0, v1;
#pragma unroll
                for (int i = 0; i < 4; ++i) { v0[i] = silu_f(acc[ai][0][m][0][i] * si) * (acc[ai][1][m][0][i] * (si * FP8_SH)); v1[i] = silu_f(acc[ai][0][m][1][i] * si) * (acc[ai][1][m][1][i] * (si * FP8_SH)); }
                typedef unsigned u32x2 __attribute__((ext_vector_type(2))); u32x2 w; w.x = pk4_fp8(v0[0], v0[1], v0[2], v0[3]); w.y = pk4_fp8(v1[0], v1[1], v1[2], v1[3]);
                *(u32x2*)rowp = w; }
    }
};
__device__ __forceinline__ float logf_gate(float x, float la, float l1) {
    const float ls = fminf(x, 0.f) - __logf(1.0f + __expf(-fabsf(x)));
    const float b = l1 + ls;
    if (la == -INFINITY) return b;
    const float mx = fmaxf(la, b), d = fabsf(la - b);
    return mx + __logf(1.0f + __expf(-d));
}
struct EpiHgrnIn {
    static constexpr bool PERM = true, AFTER_DRAIN = false;
    unsigned char* ws; int layer;
    static constexpr size_t O_PQ = 580ull << 20, O_PI = O_PQ + (128ull << 20), O_PG = O_PQ + (256ull << 20), O_LF = O_PQ + (384ull << 20), O_LA = 1ull << 20, O_L1 = O_LA + 8192;
    __device__ __forceinline__ void operator()(const f32x4 (&acc)[2][2][4][2], const Unit& u, int wr, int wc, int fr, int fq) const {
        const int quarter = u.pn >> 2;
        const int row0 = u.pm * BM + wr * 64 + fr, col0 = (u.pn & 3) * BM + wc * 32 + 8 * fq;
        if (quarter == 1) {
            const float* la = (const float*)(ws + O_LA) + layer * 1024; const float* l1 = (const float*)(ws + O_L1) + layer * 1024; float* LF = (float*)(ws + O_LF);
            f32x4 A0[2][2], A1[2][2];
#pragma unroll
            for (int bj = 0; bj < 2; ++bj)
#pragma unroll
                for (int n = 0; n < 2; ++n) { A0[bj][n] = *(const f32x4*)(la + col0 + bj * HALF + 4 * n); A1[bj][n] = *(const f32x4*)(l1 + col0 + bj * HALF + 4 * n); }
#pragma unroll
            for (int ai = 0; ai < 2; ++ai)
#pragma unroll
                for (int m = 0; m < 4; ++m) { float* rowp = LF + (size_t)(row0 + ai * HALF + m * 16) * 1024 + col0;
#pragma unroll
                    for (int bj = 0; bj < 2; ++bj)
#pragma unroll
                        for (int n = 0; n < 2; ++n) { f32x4 o;
#pragma unroll
                            for (int i = 0; i < 4; ++i) o[i] = logf_gate(acc[ai][bj][m][n][i], A0[bj][n][i], A1[bj][n][i]);
                            *(f32x4*)(rowp + bj * HALF + 4 * n) = o; } }
        } else {
            bf16_t* O = (bf16_t*)(ws + (quarter == 0 ? O_PQ : (quarter == 2 ? O_PI : O_PG)));
#pragma unroll
            for (int ai = 0; ai < 2; ++ai)
#pragma unroll
                for (int m = 0; m < 4; ++m) { bf16_t* rowp = O + (size_t)(row0 + ai * HALF + m * 16) * 1024 + col0;
#pragma unroll
                    for (int bj = 0; bj < 2; ++bj) { f32x4 v0 = acc[ai][bj][m][0], v1 = acc[ai][bj][m][1];
                        if (quarter != 2) {
#pragma unroll
                            for (int i = 0; i < 4; ++i) { v0[i] = silu_f(v0[i]); v1[i] = silu_f(v1[i]); } }
                        u32x4 w; w.x = cvt_pk_bf16(v0[0], v0[1]); w.y = cvt_pk_bf16(v0[2], v0[3]); w.z = cvt_pk_bf16(v1[0], v1[1]); w.w = cvt_pk_bf16(v1[2], v1[3]);
                        *(u32x4*)(rowp + bj * HALF) = w; } }
        }
    }
};

template <class Epi, class Sched, bool ALIGN_EPI = false, bool SP2 = false, bool FP8 = false>
__device__ __forceinline__ void gemm_phase(PG8_LAS unsigned char* lds, const Gemm g, const Sched& S, const Epi& E, const int wave_id) {
    int lane_; asm volatile("v_mbcnt_lo_u32_b32 %0, -1, 0\n\tv_mbcnt_hi_u32_b32 %0, -1, %0" : "=v"(lane_));
    const int wid = wave_id, lane = lane_, tid = wid * 64 + lane, wr = wid >> 2, wc = wid & 3, fr = lane & 15, fq = lane >> 4;
    const int K = g.K, nt = K / BK, lda = g.lda;
    unsigned voffA[2], voffB[2];
#pragma unroll
    for (int i = 0; i < 2; ++i) { int R, C; stage_rc(tid * 16 + i * 8192, R, C); const int Rb = Epi::PERM ? ((R & ~31) + perm32(R & 31)) : R;
        voffA[i] = (unsigned)(R * lda + C) * 2u; voffB[i] = (unsigned)(Rb * K + C) * 2u; }
    const size_t kstep = (size_t)(BK * 2);
    const size_t hstep = (size_t)HALF * K * 2;
    const size_t tstep = 2 * hstep;
    const size_t hstepA = (size_t)HALF * lda * 2, tstepA = 2 * hstepA;
    const unsigned ldsw = (unsigned)wid * 1024u;
    const int aoff = lds_byte(wr * 64 + fr, fq * 8), boff = lds_byte(wc * 32 + fr, fq * 8);
#define PG8_SA(b, h) (((b) * 2 + (h)) * HTB)
#define PG8_SB(b, h) ((4 + (b) * 2 + (h)) * HTB)
#define PG8_STAGE(bufoff, gbase, voff) do { _Pragma("unroll") for (int _i = 0; _i < 2; ++_i) \
        __builtin_amdgcn_global_load_lds((const unsigned*)((const char*)(gbase) + (voff)[_i]), (PG8_LAS unsigned*)(lds + (bufoff) + ldsw + _i * 8192), 16, 0, 0); } while (0)
    typedef int i32x4_ __attribute__((ext_vector_type(4))); typedef int i32x8_ __attribute__((ext_vector_type(8)));
#define PG8_CAT(x, y) __builtin_shufflevector((x), (y), 0, 1, 2, 3, 4, 5, 6, 7)
#define PG8_LDA(dst, b, h) do { _Pragma("unroll") for (int m = 0; m < 4; ++m) { \
        if constexpr (FP8) dst##8[m] = PG8_CAT(*(const PG8_LAS i32x4_*)(lds + PG8_SA(b, h) + aoff + m * 2048), *(const PG8_LAS i32x4_*)(lds + PG8_SA(b, h) + aoff + m * 2048 + 1024)); \
        else { _Pragma("unroll") for (int k = 0; k < 2; ++k) dst[m][k] = *(const PG8_LAS bf16x8*)(lds + PG8_SA(b, h) + aoff + m * 2048 + k * 1024); } } } while (0)
#define PG8_LDB(dst, b, h) do { _Pragma("unroll") for (int n = 0; n < 2; ++n) { \
        if constexpr (FP8) dst##8[n] = PG8_CAT(*(const PG8_LAS i32x4_*)(lds + PG8_SB(b, h) + boff + n * 2048), *(const PG8_LAS i32x4_*)(lds + PG8_SB(b, h) + boff + n * 2048 + 1024)); \
        else { _Pragma("unroll") for (int k = 0; k < 2; ++k) dst[n][k] = *(const PG8_LAS bf16x8*)(lds + PG8_SB(b, h) + boff + n * 2048 + k * 1024); } } } while (0)
#define PG8_MMA(ai, bj, At, Bt) do { __builtin_amdgcn_s_setprio(1); _Pragma("unroll") for (int m = 0; m < 4; ++m) _Pragma("unroll") for (int n = 0; n < 2; ++n) { \
        if constexpr (FP8) asm volatile("v_mfma_scale_f32_16x16x128_f8f6f4 %0, %1, %2, %0, %3, %3 op_sel_hi:[0,0,0]" : "+v"(acc[ai][bj][m][n]) : "v"(Bt##8[n]), "v"(At##8[m]), "v"(f8scale_)); \
        else { _Pragma("unroll") for (int k = 0; k < 2; ++k) acc[ai][bj][m][n] = __builtin_amdgcn_mfma_f32_16x16x32_bf16(Bt[n][k], At[m][k], acc[ai][bj][m][n], 0, 0, 0); } } \
        __builtin_amdgcn_s_setprio(0); } while (0)
#define PG8_WAIT_V(n) asm volatile("s_waitcnt vmcnt(" #n ")" ::: "memory")
#define PG8_WAIT_L(n) asm volatile("s_waitcnt lgkmcnt(" #n ")" ::: "memory")
#define PG8_BAR __builtin_amdgcn_s_barrier()
#define PG8_SCHED __builtin_amdgcn_sched_barrier(0)
    Unit cur, nxt; int ui = 0;
    if (!S.next(0, cur)) return;
    f32x4 acc[2][2][4][2];
#pragma unroll
    for (int a = 0; a < 2; ++a)
#pragma unroll
        for (int b = 0; b < 2; ++b)
#pragma unroll
            for (int m = 0; m < 4; ++m)
#pragma unroll
                for (int n = 0; n < 2; ++n) acc[a][b][m][n] = (f32x4){0.f, 0.f, 0.f, 0.f};
    const int f8scale_ = 0x7f7f7f7f;
    bf16x8 At[4][2], B0[2][2], B1[2][2]; i32x8_ At8[4], B08[2], B18[2];
    const char* cA = (const char*)g.A + (size_t)cur.pm * tstepA; const char* cB = (const char*)g.Bt + (size_t)cur.e * g.estride + (size_t)cur.pn * tstep;
    S.a_ready(cur);
    if constexpr (SP2) {
        PG8_STAGE(PG8_SB(0, 0), cB, voffB); PG8_STAGE(PG8_SB(0, 1), cB + hstep, voffB); PG8_STAGE(PG8_SA(0, 0), cA, voffA); PG8_STAGE(PG8_SA(0, 1), cA + hstepA, voffA);
        if (wr == 1) PG8_BAR;
        PG8_WAIT_V(2); PG8_BAR;
        PG8_STAGE(PG8_SB(1, 0), cB + kstep, voffB); PG8_STAGE(PG8_SA(1, 0), cA + kstep, voffA); PG8_STAGE(PG8_SB(1, 1), cB + hstep + kstep, voffB);
        PG8_WAIT_V(6); PG8_BAR;
    } else {
        PG8_STAGE(PG8_SB(0, 0), cB, voffB); PG8_STAGE(PG8_SA(0, 0), cA, voffA); PG8_STAGE(PG8_SB(0, 1), cB + hstep, voffB); PG8_STAGE(PG8_SA(0, 1), cA + hstepA, voffA);
        if (wr == 1) PG8_BAR;
        PG8_WAIT_V(4); PG8_BAR;
        PG8_STAGE(PG8_SB(1, 0), cB + kstep, voffB); PG8_STAGE(PG8_SA(1, 0), cA + kstep, voffA); PG8_STAGE(PG8_SB(1, 1), cB + hstep + kstep, voffB);
        PG8_WAIT_V(6); PG8_BAR;
    }
    for (;;) {
        const bool has_next = S.next(ui + 1, nxt);
        const char* nA = has_next ? (const char*)g.A + (size_t)nxt.pm * tstepA : cA; const char* nB = has_next ? (const char*)g.Bt + (size_t)nxt.e * g.estride + (size_t)nxt.pn * tstep : cB;
        for (int t = 0; t < nt; t += 2) {
            const bool last = (t == nt - 2);
            const char* a1 = cA + (size_t)(t + 1) * kstep;
            const char* a2 = last ? nA : cA + (size_t)(t + 2) * kstep; const char* b2 = last ? nB : cB + (size_t)(t + 2) * kstep;
            const char* a3 = a2 + kstep; const char* b3 = b2 + kstep;
            if (last && has_next) S.a_ready(nxt);
            if constexpr (SP2) {
            PG8_LDB(B0, 0, 0); PG8_LDB(B1, 0, 1); PG8_SCHED; PG8_LDA(At, 0, 0); PG8_STAGE(PG8_SA(1, 1), a1 + hstepA, voffA);
            PG8_WAIT_V(8); PG8_WAIT_L(0); PG8_BAR; PG8_MMA(0, 0, At, B0); PG8_MMA(0, 1, At, B1); PG8_BAR; PG8_SCHED;
            PG8_LDA(At, 0, 1); PG8_STAGE(PG8_SB(0, 0), b2, voffB); PG8_STAGE(PG8_SB(0, 1), b2 + hstep, voffB); PG8_STAGE(PG8_SA(0, 0), a2, voffA);
            PG8_WAIT_V(8); PG8_WAIT_L(0); PG8_BAR; PG8_MMA(1, 0, At, B0); PG8_MMA(1, 1, At, B1); PG8_BAR; PG8_SCHED;
            PG8_LDB(B0, 1, 0); PG8_LDB(B1, 1, 1); PG8_SCHED; PG8_LDA(At, 1, 0); PG8_STAGE(PG8_SA(0, 1), a2 + hstepA, voffA);
            PG8_WAIT_V(8); PG8_WAIT_L(0); PG8_BAR; PG8_MMA(0, 0, At, B0); PG8_MMA(0, 1, At, B1); PG8_BAR; PG8_SCHED;
            PG8_LDA(At, 1, 1); PG8_STAGE(PG8_SB(1, 0), b3, voffB); PG8_STAGE(PG8_SB(1, 1), b3 + hstep, voffB); PG8_STAGE(PG8_SA(1, 0), a3, voffA);
            PG8_WAIT_V(8); PG8_WAIT_L(0); PG8_BAR; PG8_MMA(1, 0, At, B0); PG8_MMA(1, 1, At, B1); PG8_BAR; PG8_SCHED;
            } else {
            PG8_LDB(B0, 0, 0); PG8_SCHED; PG8_LDA(At, 0, 0); PG8_STAGE(PG8_SA(1, 1), a1 + hstepA, voffA);
            PG8_WAIT_L(8); PG8_BAR; PG8_WAIT_L(0); PG8_MMA(0, 0, At, B0); PG8_BAR; PG8_SCHED;
            PG8_LDB(B1, 0, 1); PG8_STAGE(PG8_SB(0, 0), b2, voffB);
            PG8_BAR; PG8_WAIT_L(0); PG8_MMA(0, 1, At, B1); PG8_BAR;
            PG8_LDA(At, 0, 1); PG8_STAGE(PG8_SA(0, 0), a2, voffA);
            PG8_BAR; PG8_WAIT_L(0); PG8_MMA(1, 0, At, B0); PG8_BAR; PG8_SCHED;
            PG8_STAGE(PG8_SB(0, 1), b2 + hstep, voffB);
            PG8_WAIT_V(6); PG8_BAR; PG8_MMA(1, 1, At, B1); PG8_BAR;
            PG8_LDB(B0, 1, 0); PG8_SCHED; PG8_LDA(At, 1, 0); PG8_STAGE(PG8_SA(0, 1), a2 + hstepA, voffA);
            PG8_WAIT_L(8); PG8_BAR; PG8_WAIT_L(0); PG8_MMA(0, 0, At, B0); PG8_BAR; PG8_SCHED;
            PG8_LDB(B1, 1, 1); PG8_STAGE(PG8_SB(1, 0), b3, voffB);
            PG8_BAR; PG8_WAIT_L(0); PG8_MMA(0, 1, At, B1); PG8_BAR;
            PG8_LDA(At, 1, 1); PG8_STAGE(PG8_SA(1, 0), a3, voffA);
            PG8_BAR; PG8_WAIT_L(0); PG8_MMA(1, 0, At, B0); PG8_BAR; PG8_SCHED;
            PG8_STAGE(PG8_SB(1, 1), b3 + hstep, voffB);
            PG8_WAIT_V(6); PG8_BAR; PG8_MMA(1, 1, At, B1); PG8_BAR;
            }
        }
        if constexpr (FP8) asm volatile("s_nop 15\n\ts_nop 15" ::: "memory");
        if constexpr (ALIGN_EPI) { if (wr == 0) PG8_BAR; }
        if constexpr (!Epi::AFTER_DRAIN) { E(acc, cur, wr, wc, fr, fq); S.done(cur); }
        if (!has_next) break;
#pragma unroll
        for (int a = 0; a < 2; ++a)
#pragma unroll
            for (int b = 0; b < 2; ++b)
#pragma unroll
                for (int m = 0; m < 4; ++m)
#pragma unroll
                    for (int n = 0; n < 2; ++n) acc[a][b][m][n] = (f32x4){0.f, 0.f, 0.f, 0.f};
        cur = nxt; cA = nA; cB = nB; ++ui;
        if constexpr (ALIGN_EPI) { if (wr == 1) PG8_BAR; }
    }
    PG8_WAIT_V(0);
    if constexpr (!ALIGN_EPI) { if (wr == 0) PG8_BAR; }
    PG8_BAR;
    if constexpr (Epi::AFTER_DRAIN) { E.fused(acc, cur, wr, wc, fr, fq, lds, wid, lane); S.done(cur); }
#undef PG8_SA
#undef PG8_SB
#undef PG8_STAGE
#undef PG8_LDA
#undef PG8_LDB
#undef PG8_MMA
#undef PG8_CAT
#undef PG8_WAIT_V
#undef PG8_WAIT_L
#undef PG8_BAR
#undef PG8_SCHED
}
}

constexpr int NT = 65536, DM = 1024, NBATCH = 32, SEQ = 2048;
constexpr int DFF = 2816, DFE = 3584, NEXP = 8;
constexpr int MOE_ROWS = 133120;
constexpr float EPS = 1e-6f;
constexpr size_t MiB = 1u << 20;
constexpr size_t WS_CTL = 0, CTL_ZERO_BYTES = 1 * MiB;
constexpr size_t WS_LA = 1 * MiB;
constexpr size_t WS_L1 = WS_LA + 8192;
constexpr size_t WS_CB = WS_LA + 16384;
constexpr size_t WS_RCNT = WS_LA + 32768;
constexpr size_t WS_RTAB = WS_LA + 65536;
constexpr size_t WS_ROUTE = 2 * MiB;
constexpr size_t WS_SLOT = 3 * MiB;
constexpr size_t WS_SELM = 4 * MiB;
constexpr size_t WS_GATES = 8 * MiB;
constexpr size_t WS_KC = 20 * MiB;
constexpr size_t WS_VCT = 22 * MiB;
constexpr size_t WS_HC = 24 * MiB;
constexpr size_t WS_W = 48 * MiB;
constexpr size_t W_HIN = WS_W, W_HOUT = WS_W + 16 * MiB, W_KVQ = WS_W + 20 * MiB, W_Q3 = WS_W + 26 * MiB, W_CMP1 = WS_W + 29 * MiB, W_NOUT = WS_W + 31 * MiB,
                 W_FGU = WS_W + 35 * MiB, W_FDN = WS_W + 57 * MiB, W_MGU = WS_W + 68 * MiB, W_MDN = WS_W + 292 * MiB;
constexpr size_t WS_XN = 452 * MiB;
constexpr size_t WS_R = 580 * MiB;
constexpr size_t R_PQ = WS_R, R_PI = WS_R + 128 * MiB, R_PG = WS_R + 256 * MiB, R_LF = WS_R + 384 * MiB, R_O2 = WS_R + 640 * MiB;
constexpr size_t R_HF = WS_R + 256 * MiB;
constexpr size_t R_KS = WS_R, R_KW = WS_R + 32 * MiB, R_VST = WS_R + 64 * MiB, R_VWT = WS_R + 96 * MiB, R_KCR = WS_R + 128 * MiB, R_VCR = WS_R + 160 * MiB;
constexpr size_t R_QKV = WS_R + 256 * MiB;
constexpr size_t R_Q = WS_R + 608 * MiB, R_O = WS_R + 736 * MiB;
constexpr size_t R_XP = WS_R, R_HM = WS_R + 260 * MiB;
constexpr size_t WS_NEED = R_HM + (size_t)MOE_ROWS * DFE * 2;
static_assert(WS_NEED <= 1792 * MiB, "workspace map");
static_assert(W_MDN + 112 * MiB <= WS_XN, "weights map");
static_assert(pg8::EpiHgrnIn::O_PQ == R_PQ && pg8::EpiHgrnIn::O_PI == R_PI && pg8::EpiHgrnIn::O_PG == R_PG && pg8::EpiHgrnIn::O_LF == R_LF && pg8::EpiHgrnIn::O_LA == WS_LA && pg8::EpiHgrnIn::O_L1 == WS_L1, "EpiHgrnIn offsets");

constexpr int LDS_BYTES = 147456;
constexpr int MISC_OFF = 131072 + 320;
constexpr int NWAVES = 8;

#define GAS __attribute__((address_space(1)))
#define LAS __attribute__((address_space(3)))
typedef unsigned short bf16;
typedef unsigned v4u __attribute__((ext_vector_type(4)));
typedef unsigned v2u __attribute__((ext_vector_type(2)));
typedef float f32x4 __attribute__((ext_vector_type(4)));
#define LDS_WAIT() asm volatile("s_waitcnt lgkmcnt(0)" ::: "memory")
__device__ __forceinline__ unsigned f2bf(float f) { unsigned u = __builtin_bit_cast(unsigned, f); return (u + 0x7fffu + ((u >> 16) & 1u)) >> 16; }
__device__ __forceinline__ unsigned pk2(float lo, float hi) { return f2bf(lo) | (f2bf(hi) << 16); }
__device__ __forceinline__ float bf2f(unsigned b) { return __builtin_bit_cast(float, b << 16); }
__device__ __forceinline__ float bflo(unsigned w) { return __builtin_bit_cast(float, w << 16); }
__device__ __forceinline__ float bfhi(unsigned w) { return __builtin_bit_cast(float, w & 0xffff0000u); }
__device__ __forceinline__ float wave_sum(float v) {
#pragma unroll
    for (int o = 32; o >= 1; o >>= 1) v += __shfl_xor(v, o);
    return v;
}
__device__ __forceinline__ float wave_max(float v) {
#pragma unroll
    for (int o = 32; o >= 1; o >>= 1) v = fmaxf(v, __shfl_xor(v, o));
    return v;
}

#define XB_TMO      128
#define XB_XCNT(j)  (256  + 64 * (j))
#define XB_XSUB(j)  (1280 + 64 * (j))
#define XB_XGEN(j)  (2304 + 64 * (j))
#define XB_TOP      3328
#define XB_TOPGEN   3392
#define XCD_BAR_WORDS 3456
#define XB_SPIN_CAP (1u << 22)
__device__ __forceinline__ unsigned xb_ld(unsigned* p)              { return __hip_atomic_load(p, __ATOMIC_RELAXED, __HIP_MEMORY_SCOPE_AGENT); }
__device__ __forceinline__ unsigned xb_add(unsigned* p, unsigned v) { return __hip_atomic_fetch_add(p, v, __ATOMIC_RELAXED, __HIP_MEMORY_SCOPE_AGENT); }
__device__ __forceinline__ unsigned xb_xcc_id() { return (unsigned)__builtin_amdgcn_s_getreg((3 << 11) | 20) & 0xFu; }
#define XB_SPIN(cond, bar) do { unsigned _sp = 0; while (cond) { __builtin_amdgcn_s_sleep(1); \
    if ((++_sp & 255u) == 0u) { if (xb_ld(&(bar)[XB_TMO])) break; if (_sp > XB_SPIN_CAP) { atomicAdd(&(bar)[XB_TMO], 1u); break; } } } } while (0)
struct XcdBarrier { unsigned* bar; unsigned x; volatile LAS unsigned* st; };
__device__ __forceinline__ XcdBarrier xcd_barrier_post(unsigned* bar, volatile LAS unsigned* st) {
    XcdBarrier b; b.bar = bar; b.x = xb_xcc_id(); b.st = st;
    if (threadIdx.x == 0) (void)xb_add(&bar[XB_XCNT(b.x)], 1u);
    return b;
}
__device__ __forceinline__ void xcd_barrier_complete(unsigned* bar, unsigned x, unsigned& nloc, unsigned& nx) {
    const unsigned G = gridDim.x * gridDim.y * gridDim.z;
    unsigned sum, cnt, mine, sp = 0u;
    for (;;) {
        sum = 0u; cnt = 0u; mine = 0u;
#pragma unroll
        for (unsigned j = 0; j < 16; ++j) { const unsigned c = xb_ld(&bar[XB_XCNT(j)]); sum += c; cnt += (c > 0u) ? 1u : 0u; mine = (j == x) ? c : mine; }
        if (sum == G) break;
        __builtin_amdgcn_s_sleep(1);
        if ((++sp & 255u) == 0u) { if (xb_ld(&bar[XB_TMO])) break; if (sp > XB_SPIN_CAP) { atomicAdd(&bar[XB_TMO], 1u); break; } }
    }
    nloc = mine > 0u ? mine : 1u; nx = cnt > 0u ? cnt : 1u;
}
__device__ __forceinline__ void xcd_barrier(const XcdBarrier& b) {
    asm volatile("s_waitcnt vmcnt(0)" ::: "memory");
    __syncthreads();
    if (threadIdx.x == 0) {
        unsigned* bar = b.bar; unsigned bx_ = b.x; asm volatile("" : "+s"(bar), "+s"(bx_));
        __builtin_amdgcn_s_waitcnt(0);
        unsigned nloc = b.st[0], nx = b.st[1];
        if (nloc == 0u) { xcd_barrier_complete(bar, bx_, nloc, nx); b.st[0] = nloc; b.st[1] = nx; }
        const unsigned old = xb_add(&bar[XB_XSUB(bx_)], 1u);
        const unsigned gen = old / nloc;
        if (old + 1u == (gen + 1u) * nloc) {
            __builtin_amdgcn_fence(__ATOMIC_RELEASE, "agent");
            asm volatile("s_waitcnt vmcnt(0)" ::: "memory");
            const unsigned og = xb_add(&bar[XB_TOP], 1u);
            const unsigned tg = og / nx;
            if (og + 1u == (tg + 1u) * nx) xb_add(&bar[XB_TOPGEN], 1u);
            else XB_SPIN(xb_ld(&bar[XB_TOPGEN]) == tg, bar);
            __builtin_amdgcn_fence(__ATOMIC_ACQUIRE, "agent");
            xb_add(&bar[XB_XGEN(bx_)], 1u);
            asm volatile("s_waitcnt vmcnt(0)" ::: "memory");
        } else {
            XB_SPIN(xb_ld(&bar[XB_XGEN(bx_)]) == gen, bar);
            __builtin_amdgcn_fence(__ATOMIC_ACQUIRE, "agent");
            asm volatile("s_waitcnt vmcnt(0)" ::: "memory");
        }
    }
    __syncthreads();
}

struct Ctx {
    LAS unsigned char* lds;
    int tid, lane, wave, G, bid;
    float* out; unsigned char* ws;
    __device__ __forceinline__ const float* inp(int i) const {
        const __attribute__((address_space(4))) unsigned char* kp = (const __attribute__((address_space(4))) unsigned char*)__builtin_amdgcn_kernarg_segment_ptr();
        asm volatile("" : "+s"(kp));
        return ((const float* const __attribute__((address_space(4)))*)kp)[i];
    }
};
enum { I_X = 0, I_NMIX, I_NFFN, I_HWIN, I_HWOUT, I_HGN, I_HLB, I_KVN, I_KVW, I_CPK, I_CW1K, I_CW2K, I_CPV, I_CW1V, I_CW2V, I_KN, I_NWIN, I_NWOUT, I_NQN, I_FGU, I_FDN, I_MR, I_MGU, I_MDN };

constexpr int MAXJOB = 64;
struct JobTab { unsigned long long src[MAXJOB], gain[MAXJOB], dst[MAXJOB]; int K[MAXJOB], Nsrc[MAXJOB], npb[MAXJOB], F[MAXJOB], rowoff[MAXJOB], istart[MAXJOB + 1]; float f8s[MAXJOB]; int njobs; };
__device__ __forceinline__ void add_job(LAS JobTab* J, const float* src, const float* gain, bf16* dst, int K, int Nsrc, int Npad, int F, int rowoff, float f8s = 0.f) {
    const int j = J->njobs; J->src[j] = (unsigned long long)src; J->gain[j] = (unsigned long long)gain; J->dst[j] = (unsigned long long)dst;
    J->K[j] = K; J->Nsrc[j] = Nsrc; J->npb[j] = Npad / 32; J->F[j] = F; J->rowoff[j] = rowoff; J->f8s[j] = f8s; J->istart[j + 1] = J->istart[j] + (K / 64) * (Npad / 32); J->njobs = j + 1;
}
__device__ __forceinline__ void transpose_item(const float* W, int K, int Nsrc, const float* gain, bf16* WT, int dstrow0, int k0, int n0, LAS float* scr, int lane, float f8s) {
    const int c4 = lane & 7, kr = lane >> 3, n = n0 + 4 * c4; const bool okn = n < Nsrc;
    f32x4 v[8];
#pragma unroll
    for (int i = 0; i < 8; ++i) { const int kk = 8 * i + kr; v[i] = okn ? *(const f32x4*)(W + (size_t)(k0 + kk) * Nsrc + n) : (f32x4){0.f, 0.f, 0.f, 0.f}; }
#pragma unroll
    for (int i = 0; i < 8; ++i) { const int kk = 8 * i + kr; if (gain) v[i] = v[i] * gain[k0 + kk]; *(LAS f32x4*)(scr + kk * 36 + 4 * c4) = v[i]; }
    LDS_WAIT();
    const int c = lane & 7;
#pragma unroll
    for (int j = 0; j < 4; ++j) { const int nn = (lane >> 3) + 8 * j; const LAS float* s = scr + (8 * c) * 36 + nn;
        if (f8s != 0.f) { v2u o; o.x = pg8::pk4_fp8(s[0 * 36] * f8s, s[1 * 36] * f8s, s[2 * 36] * f8s, s[3 * 36] * f8s); o.y = pg8::pk4_fp8(s[4 * 36] * f8s, s[5 * 36] * f8s, s[6 * 36] * f8s, s[7 * 36] * f8s);
            *(v2u*)((unsigned char*)WT + (size_t)(dstrow0 + nn) * K + k0 + 8 * c) = o; }
        else { v4u o; o.x = pk2(s[0 * 36], s[1 * 36]); o.y = pk2(s[2 * 36], s[3 * 36]); o.z = pk2(s[4 * 36], s[5 * 36]); o.w = pk2(s[6 * 36], s[7 * 36]);
            *(v4u*)(WT + (size_t)(dstrow0 + nn) * K + k0 + 8 * c) = o; } }
    LDS_WAIT();
}
__device__ __forceinline__ void norm_row_store(const f32x4 (&v)[4], bf16* orow, int lane) {
    float s = 0.f;
#pragma unroll
    for (int j = 0; j < 4; ++j) s += (v[j].x * v[j].x + v[j].y * v[j].y) + (v[j].z * v[j].z + v[j].w * v[j].w);
    const float rstd = rsqrtf(wave_sum(s) * (1.f / DM) + EPS);
    v2u* o8 = (v2u*)orow + lane;
#pragma unroll
    for (int j = 0; j < 4; ++j) { v2u w; w.x = pk2(v[j].x * rstd, v[j].y * rstd); w.y = pk2(v[j].z * rstd, v[j].w * rstd); o8[64 * j] = w; }
}
__device__ __forceinline__ void p_prologue(Ctx& C) {
    LAS JobTab* J = (LAS JobTab*)(C.lds + 73728);
    unsigned char* ws = C.ws;
    if (C.tid == 0) {
        J->njobs = 0; J->istart[0] = 0;
        for (int l = 0; l < 2; ++l) add_job(J, C.inp(I_HWIN) + (size_t)l * 1024 * 4096, C.inp(I_NMIX) + l * 1024, (bf16*)(ws + W_HIN) + (size_t)l * 4096 * 1024, 1024, 4096, 4096, 0, 0);
        for (int l = 0; l < 2; ++l) add_job(J, C.inp(I_HWOUT) + (size_t)l * 1024 * 1024, nullptr, (bf16*)(ws + W_HOUT) + (size_t)l * 1024 * 1024, 1024, 1024, 1024, 0, 0);
        add_job(J, C.inp(I_KVW), C.inp(I_KVN), (bf16*)(ws + W_KVQ), 1024, 1536, 1536, 0, 0);
        add_job(J, C.inp(I_NWIN), C.inp(I_NMIX) + 2048, (bf16*)(ws + W_KVQ), 1024, 1072, 1280, 0, 1536);
        add_job(J, C.inp(I_NWIN) + (size_t)1024 * 1072, C.inp(I_NMIX) + 3072, (bf16*)(ws + W_Q3), 1024, 1072, 1280, 0, 0);
        add_job(J, C.inp(I_CW1K), nullptr, (bf16*)(ws + W_CMP1), 2048, 256, 256, 0, 0);
        add_job(J, C.inp(I_CW1V), nullptr, (bf16*)(ws + W_CMP1) + (size_t)256 * 2048, 2048, 256, 256, 0, 0);
        for (int l = 0; l < 2; ++l) add_job(J, C.inp(I_NWOUT) + (size_t)l * 1024 * 1024, nullptr, (bf16*)(ws + W_NOUT) + (size_t)l * 1024 * 1024, 1024, 1024, 1024, 0, 0);
        for (int l = 0; l < 2; ++l) add_job(J, C.inp(I_FGU) + (size_t)l * 1024 * 2 * DFF, C.inp(I_NFFN) + (2 * l) * 1024, (bf16*)(ws + W_FGU) + (size_t)l * 2 * DFF * 1024, 1024, 2 * DFF, 2 * DFF, DFF, 0);
        for (int l = 0; l < 2; ++l) add_job(J, C.inp(I_FDN) + (size_t)l * DFF * 1024, nullptr, (bf16*)(ws + W_FDN) + (size_t)l * 1024 * DFF, DFF, 1024, 1024, 0, 0);
        for (int l = 0; l < 16; ++l) add_job(J, C.inp(I_MGU) + (size_t)l * 1024 * 2 * DFE, C.inp(I_NFFN) + (2 * (l >> 3) + 1) * 1024, (bf16*)(ws + W_MGU + (size_t)l * 2 * DFE * 1024), 1024, 2 * DFE, 2 * DFE, DFE, 0, pg8::FP8_SW1);
        for (int l = 0; l < 16; ++l) add_job(J, C.inp(I_MDN) + (size_t)l * DFE * 1024, nullptr, (bf16*)(ws + W_MDN + (size_t)l * 1024 * DFE), DFE, 1024, 1024, 0, 0, pg8::FP8_SW2);
    }
    __syncthreads();
    LAS float* scr = (LAS float*)(C.lds + C.wave * 9216);
    const int gw = C.bid * NWAVES + C.wave, NGW = C.G * NWAVES;
    const int nj = J->njobs, total = J->istart[nj];
    for (int it = gw; it < total; it += NGW) {
        int j = 0; while (j + 1 < nj && J->istart[j + 1] <= it) ++j;
        const int r = it - J->istart[j], npb = J->npb[j], kb = r / npb, nb = r % npb, n0 = 32 * nb, F = J->F[j];
        int drow = J->rowoff[j] + n0;
        if (F) drow = (n0 < F) ? 256 * (n0 / 128) + (n0 % 128) : 256 * ((n0 - F) / 128) + 128 + ((n0 - F) % 128);
        transpose_item((const float*)J->src[j], J->K[j], J->Nsrc[j], (const float*)J->gain[j], (bf16*)J->dst[j], drow, 64 * kb, n0, scr, C.lane, J->f8s[j]);
    }
    { const int gt = C.bid * 512 + C.tid;
      if (gt < 1024) { const float a0 = C.inp(I_HLB)[gt], a1 = C.inp(I_HLB)[1024 + gt]; const float mx = fmaxf(a0, a1), e0 = expf(a0 - mx), e1 = expf(a1 - mx), s = e0 + e1;
          const float s0 = e0 / s, s1 = e1 / s, lb1 = (s0 + s1) - s0;
          float* la = (float*)(ws + WS_LA); float* l1 = (float*)(ws + WS_L1);
          la[gt] = -INFINITY; l1[gt] = 0.f; la[1024 + gt] = logf(lb1); l1[1024 + gt] = log1pf(-lb1); } }
    if (C.bid == 0 && C.tid < 128) ((int*)(ws + WS_RTAB))[2048 + C.tid] = C.tid >> 6;
    if (C.G >= 8 && C.bid >= C.G - 8) { const int ob = (C.bid - (C.G - 8)) * 64 + C.lane, which = ob >> 8, j = ob & 255; const float* pos = C.inp(which ? I_CPV : I_CPK); const float* w1 = C.inp(which ? I_CW1V : I_CW1K);
        float a = 0.f;
#pragma unroll 8
        for (int i = C.wave * 256; i < C.wave * 256 + 256; ++i) a += pos[i] * w1[(size_t)i * 256 + j];
        __syncthreads();
        LAS float* red = (LAS float*)(C.lds + 80 * 1024); red[C.wave * 64 + C.lane] = a;
        __syncthreads();
        if (C.wave == 0) { float t = 0.f;
#pragma unroll
            for (int w = 0; w < 8; ++w) t += red[w * 64 + C.lane];
            ((float*)(ws + WS_CB))[ob] = t; } }
    for (int c = C.bid; c < 256; c += C.G)
        for (int i = 0; i < 32; i += 4) { f32x4 v[4][4]; const float* xb = C.inp(I_X);
#pragma unroll
            for (int r = 0; r < 4; ++r) { const f32x4* xr = (const f32x4*)(xb + (size_t)(c * 256 + C.wave * 32 + i + r) * DM) + C.lane;
#pragma unroll
                for (int j = 0; j < 4; ++j) v[r][j] = xr[64 * j]; }
#pragma unroll
            for (int r = 0; r < 4; ++r) norm_row_store(v[r], (bf16*)(ws + WS_XN) + (size_t)(c * 256 + C.wave * 32 + i + r) * DM, C.lane); }
}

template <bool MOE_ADD, bool ROUTER, bool WRITE_XN>
__device__ __forceinline__ void p_norm(Ctx& C, const float* rw, const float* rgain) {
    unsigned char* ws = C.ws;
    LAS int* cnt8 = (LAS int*)(C.lds + 1024);
    const bf16* Y = (const bf16*)(ws + R_XP);
    const int4* route = (const int4*)(ws + WS_ROUTE); const int2* slot = (const int2*)(ws + WS_SLOT);
    constexpr int NR = (MOE_ADD || ROUTER) ? 2 : 4;
    for (int c = C.bid; c < 256; c += C.G) {
        if (ROUTER) { __syncthreads(); if (C.tid < 8) cnt8[C.tid] = 0; __syncthreads(); }
#pragma unroll 1
        for (int i = 0; i < 32; i += NR) {
            f32x4 v[NR][4];
#pragma unroll
            for (int r = 0; r < NR; ++r) { const float* hr = C.out + (size_t)(c * 256 + C.wave * 32 + i + r) * DM;
#pragma unroll
                for (int j = 0; j < 4; ++j) v[r][j] = ((const f32x4*)hr + C.lane)[64 * j]; }
            if (MOE_ADD) {
#pragma unroll
                for (int r = 0; r < NR; ++r) { const int row = c * 256 + C.wave * 32 + i + r; float* hr = C.out + (size_t)row * DM;
                    const int4 rt = route[row]; const int2 sl = slot[row]; const float w0 = __builtin_bit_cast(float, rt.y), w1 = __builtin_bit_cast(float, rt.z);
                    const v2u* y0 = (const v2u*)(Y + (size_t)sl.x * DM) + C.lane; const v2u* y1 = (const v2u*)(Y + (size_t)sl.y * DM) + C.lane;
#pragma unroll
                    for (int j = 0; j < 4; ++j) { const v2u a = y0[64 * j], b = y1[64 * j];
                        v[r][j].x += w0 * bflo(a.x) + w1 * bflo(b.x); v[r][j].y += w0 * bfhi(a.x) + w1 * bfhi(b.x); v[r][j].z += w0 * bflo(a.y) + w1 * bflo(b.y); v[r][j].w += w0 * bfhi(a.y) + w1 * bfhi(b.y);
                        ((f32x4*)hr + C.lane)[64 * j] = v[r][j]; } }
            }
            if (WRITE_XN || ROUTER) {
#pragma unroll
                for (int r = 0; r < NR; ++r) { const int row = c * 256 + C.wave * 32 + i + r;
                    float s = 0.f;
#pragma unroll
                    for (int j = 0; j < 4; ++j) s += (v[r][j].x * v[r][j].x + v[r][j].y * v[r][j].y) + (v[r][j].z * v[r][j].z + v[r][j].w * v[r][j].w);
                    const float rstd = rsqrtf(wave_sum(s) * (1.f / DM) + EPS);
                    if (WRITE_XN && ROUTER) { unsigned* o4 = (unsigned*)(ws + WS_XN + (size_t)row * DM) + C.lane;
#pragma unroll
                        for (int j = 0; j < 4; ++j) o4[64 * j] = pg8::pk4_fp8(v[r][j].x * rstd, v[r][j].y * rstd, v[r][j].z * rstd, v[r][j].w * rstd); }
                    if (WRITE_XN && !ROUTER) { v2u* o8 = (v2u*)((bf16*)(ws + WS_XN) + (size_t)row * DM) + C.lane;
#pragma unroll
                        for (int j = 0; j < 4; ++j) { v2u w; w.x = pk2(v[r][j].x * rstd, v[r][j].y * rstd); w.y = pk2(v[r][j].z * rstd, v[r][j].w * rstd); o8[64 * j] = w; } }
                    if (ROUTER) {
                        float lg[8];
#pragma unroll
                        for (int e = 0; e < 8; ++e) lg[e] = 0.f;
#pragma unroll
                        for (int j = 0; j < 4; ++j) { const int k0 = 4 * C.lane + 256 * j; const f32x4 g4 = *(const f32x4*)(rgain + k0);
#pragma unroll
                            for (int q = 0; q < 4; ++q) { const float xv = v[r][j][q] * rstd * g4[q]; const f32x4 wa = *(const f32x4*)(rw + (size_t)(k0 + q) * 8), wb = *(const f32x4*)(rw + (size_t)(k0 + q) * 8 + 4);
                                lg[0] += xv * wa.x; lg[1] += xv * wa.y; lg[2] += xv * wa.z; lg[3] += xv * wa.w; lg[4] += xv * wb.x; lg[5] += xv * wb.y; lg[6] += xv * wb.z; lg[7] += xv * wb.w; } }
#pragma unroll
                        for (int e = 0; e < 8; ++e) lg[e] = wave_sum(lg[e]);
                        int e0 = 0; float v0 = lg[0];
#pragma unroll
                        for (int e = 1; e < 8; ++e) if (lg[e] > v0) { v0 = lg[e]; e0 = e; }
                        int e1 = -1; float v1 = -INFINITY;
#pragma unroll
                        for (int e = 0; e < 8; ++e) if (e != e0 && (e1 < 0 || lg[e] > v1)) { v1 = lg[e]; e1 = e; }
                        const float ex = expf(v1 - v0), w0 = 1.f / (1.f + ex), w1 = ex / (1.f + ex);
                        if (C.lane == 0) { ((int4*)(ws + WS_ROUTE))[row] = make_int4(e0 | (e1 << 8), __builtin_bit_cast(int, w0), __builtin_bit_cast(int, w1), 0);
                            atomicAdd((int*)&cnt8[e0], 1); atomicAdd((int*)&cnt8[e1], 1); }
                    }
                }
            }
        }
        if (ROUTER) { __syncthreads(); if (C.tid < 8) ((int*)(ws + WS_RCNT))[c * 8 + C.tid] = cnt8[C.tid]; }
    }
}

__device__ __forceinline__ void p_gather(Ctx& C) {
    unsigned char* ws = C.ws;
    LAS int* tot = (LAS int*)(C.lds + 0);
    LAS int* pre = tot + 8;
    LAS int* base = tot + 16;
    LAS int* ee = tot + 32;
    LAS int* sl = tot + 32 + 256;
    const int* rcnt = (const int*)(ws + WS_RCNT);
    const int4* route = (const int4*)(ws + WS_ROUTE);
    for (int c = C.bid; c < 256; c += C.G) {
        __syncthreads();
        { const int e = C.wave; int t = 0, p = 0;
          for (int i = C.lane; i < 256; i += 64) { const int v = rcnt[i * 8 + e]; t += v; if (i < c) p += v; }
#pragma unroll
          for (int o = 32; o >= 1; o >>= 1) { t += __shfl_xor(t, o); p += __shfl_xor(p, o); }
          if (C.lane == 0) { tot[e] = t; pre[e] = p; } }
        if (C.tid < 256) ee[C.tid] = route[c * 256 + C.tid].x;
        __syncthreads();
        if (C.tid == 0) { int off = 0; for (int e = 0; e < 8; ++e) { base[e] = off + pre[e]; const int nt = (tot[e] + 255) >> 8;
                if (c == 0) { int* te = (int*)(ws + WS_RTAB); for (int q = 0; q < nt; ++q) te[(off >> 8) + q] = e; }
                off += nt << 8; }
            if (c == 0) ((int*)(ws + WS_RTAB))[1024] = off >> 8; }
        __syncthreads();
        if (C.tid < 8) { const int e = C.tid; int r = base[e];
            for (int i = 0; i < 256; ++i) { const int pk = ee[i]; if ((pk & 255) == e) sl[2 * i] = r++; if ((pk >> 8) == e) sl[2 * i + 1] = r++; } }
        __syncthreads();
        if (C.tid < 256) ((int2*)(ws + WS_SLOT))[c * 256 + C.tid] = make_int2(sl[2 * C.tid], sl[2 * C.tid + 1]);
        for (int i = 0; i < 32; i += 4) { v4u a[4];
#pragma unroll
            for (int r = 0; r < 4; ++r) a[r] = *((const v4u*)(ws + WS_XN + (size_t)(c * 256 + C.wave * 32 + i + r) * DM) + C.lane);
#pragma unroll
            for (int r = 0; r < 4; ++r) { const int tl = C.wave * 32 + i + r;
                *((v4u*)(ws + R_XP + (size_t)sl[2 * tl] * DM) + C.lane) = a[r]; *((v4u*)(ws + R_XP + (size_t)sl[2 * tl + 1] * DM) + C.lane) = a[r]; } }
    }
}

__device__ __forceinline__ void p_post_kv(Ctx& C) {
    unsigned char* ws = C.ws;
    const bf16* raw = (const bf16*)(ws + R_QKV);
    const float* kn = C.inp(I_KN);
    LAS unsigned char* tl = C.lds + C.wave * 4608;
    const int l = C.lane, c8 = l & 7, r8 = l >> 3, gw = C.bid * NWAVES + C.wave, NGW = C.G * NWAVES;
    for (int it = gw; it < 128 * 64; it += NGW) {
        const int bg = it >> 6, blk = it & 63, b = bg >> 2, g = bg & 3;
        const bf16* rb = raw + (size_t)(b * SEQ + blk * 32) * 2816 + g * 64 + 8 * c8;
        const size_t dst0 = ((size_t)bg * SEQ + blk * 32) * 64 + 8 * c8;
#pragma unroll
        for (int j = 0; j < 6; ++j) {
            v4u x[4];
#pragma unroll
            for (int i = 0; i < 4; ++i) x[i] = *(const v4u*)(rb + (size_t)(r8 + 8 * i) * 2816 + j * 256);
            if (j == 0 || j == 1) {
                bf16* d = (bf16*)(ws + (j == 0 ? R_KCR : R_VCR)) + dst0;
#pragma unroll
                for (int i = 0; i < 4; ++i) *(v4u*)(d + (size_t)(r8 + 8 * i) * 64) = x[i];
            } else if (j == 2 || j == 4) {
                bf16* d = (bf16*)(ws + (j == 2 ? R_KS : R_KW)) + ((size_t)bg * SEQ + blk * 32) * 64 + (c8 >> 2) * 1024 + (c8 & 3) * 8; const float* gk = kn + (j == 2 ? 64 : 128) + 8 * c8;
                const f32x4 ga = *(const f32x4*)gk, gb = *(const f32x4*)(gk + 4);
#pragma unroll
                for (int i = 0; i < 4; ++i) { const float f[8] = {bflo(x[i].x), bfhi(x[i].x), bflo(x[i].y), bfhi(x[i].y), bflo(x[i].z), bfhi(x[i].z), bflo(x[i].w), bfhi(x[i].w)};
                    float ss = (f[0] * f[0] + f[1] * f[1]) + (f[2] * f[2] + f[3] * f[3]) + (f[4] * f[4] + f[5] * f[5]) + (f[6] * f[6] + f[7] * f[7]);
                    ss += __shfl_xor(ss, 1); ss += __shfl_xor(ss, 2); ss += __shfl_xor(ss, 4);
                    const float rs = rsqrtf(ss * (1.f / 64.f) + EPS);
                    v4u o; o.x = pk2(f[0] * rs * ga.x, f[1] * rs * ga.y); o.y = pk2(f[2] * rs * ga.z, f[3] * rs * ga.w); o.z = pk2(f[4] * rs * gb.x, f[5] * rs * gb.y); o.w = pk2(f[6] * rs * gb.z, f[7] * rs * gb.w);
                    *(v4u*)(d + (size_t)(r8 + 8 * i) * 32) = o; }
            } else {
#pragma unroll
                for (int i = 0; i < 4; ++i) *(LAS v4u*)(tl + (r8 + 8 * i) * 144 + 16 * c8) = x[i];
                LDS_WAIT();
                unsigned wv[16];
#pragma unroll
                for (int t2 = 0; t2 < 16; ++t2) { const unsigned lo = *(const LAS bf16*)(tl + (2 * t2) * 144 + 2 * l), hi = *(const LAS bf16*)(tl + (2 * t2 + 1) * 144 + 2 * l); wv[t2] = lo | (hi << 16); }
                bf16* d = (bf16*)(ws + (j == 3 ? R_VST : R_VWT)) + (((size_t)bg * 64 + blk) * 64 + l) * 32;
#pragma unroll
                for (int q = 0; q < 4; ++q) { const v4u o = {wv[4 * q], wv[4 * q + 1], wv[4 * q + 2], wv[4 * q + 3]}; *(v4u*)(d + 8 * q) = o; }
                LDS_WAIT();
            }
        }
    }
}

__device__ __forceinline__ void p_cmp2(Ctx& C) {
    unsigned char* ws = C.ws;
    const bf16* Hk = (const bf16*)(ws + WS_HC); const bf16* Hv = Hk + (size_t)16384 * 256;
    const float* w2k = C.inp(I_CW2K); const float* w2v = C.inp(I_CW2V); const float* kn = C.inp(I_KN);
    LAS float* hk = (LAS float*)(C.lds + C.wave * 2048); LAS float* hv = hk + 256;
    const int l = C.lane, gw = C.bid * NWAVES + C.wave, NGW = C.G * NWAVES;
    for (int r = gw; r < 16384; r += NGW) {
        const int bg = r >> 7, c = r & 127;
        { const v2u a = *((const v2u*)(Hk + (size_t)r * 256) + l), bq = *((const v2u*)(Hv + (size_t)r * 256) + l);
          hk[4 * l] = bflo(a.x); hk[4 * l + 1] = bfhi(a.x); hk[4 * l + 2] = bflo(a.y); hk[4 * l + 3] = bfhi(a.y);
          hv[4 * l] = bflo(bq.x); hv[4 * l + 1] = bfhi(bq.x); hv[4 * l + 2] = bflo(bq.y); hv[4 * l + 3] = bfhi(bq.y); }
        LDS_WAIT();
        float ak = 0.f, av = 0.f;
#pragma unroll 8
        for (int j = 0; j < 256; ++j) { ak += hk[j] * w2k[j * 64 + l]; av += hv[j] * w2v[j * 64 + l]; }
        if (c == 127) { ak = 0.f; av = 0.f; }
        const float rs = rsqrtf(wave_sum(ak * ak) * (1.f / 64.f) + EPS);
        ((bf16*)(ws + WS_KC))[((size_t)bg * 128 + 32 * (c >> 5)) * 64 + (l >> 5) * 1024 + (c & 31) * 32 + (l & 31)] = (bf16)f2bf(ak * rs * kn[l]);
        ((bf16*)(ws + WS_VCT))[(((size_t)bg * 4 + (c >> 5)) * 64 + l) * 32 + (c & 31)] = (bf16)f2bf(av);
        LDS_WAIT();
    }
}

typedef short bf16x8v __attribute__((ext_vector_type(8)));
#define MFMA16(a, b, c) __builtin_amdgcn_mfma_f32_16x16x32_bf16((a), (b), (c), 0, 0, 0)
constexpr float LOG2E = 1.4426950408889634f;
__device__ __forceinline__ float xmax_q4(float v) {
    float t;
    asm volatile("v_mov_b32 %1, %0\n\ts_nop 1\n\tv_permlane16_swap_b32 %0, %1\n\ts_nop 1\n\tv_max_f32 %0, %0, %1\n\tv_mov_b32 %1, %0\n\ts_nop 1\n\tv_permlane32_swap_b32 %0, %1\n\ts_nop 1\n\tv_max_f32 %0, %0, %1" : "+v"(v), "=&v"(t));
    return v;
}
struct AttFrag { bf16x8v ka[2], kb[2]; };
__device__ __forceinline__ void attn_load(AttFrag& f, const bf16* __restrict__ Kb, unsigned koff, int k0) {
    const char* kblk = (const char*)(Kb + (size_t)k0 * 64);
#pragma unroll
    for (int ks = 0; ks < 2; ++ks) { f.ka[ks] = *(const bf16x8v*)(kblk + koff + 2048 * ks); f.kb[ks] = *(const bf16x8v*)(kblk + koff + 256 + 2048 * ks); }
}
template <int MODE, int PATH>
__device__ __forceinline__ void attn_step(const bf16* __restrict__ Kb, unsigned koff, const bf16* __restrict__ Vb, unsigned voff, int k0, int trel, bool tk, int cmax,
                                          const bf16x8v (&qf)[2][2], const f32x4 (&bv)[2][2], const bf16x8v ones, float (&m)[2], f32x4 (&ls)[2], f32x4 (&o)[2][4], const float (&sl2)[2], int q4) {
    AttFrag f; attn_load(f, Kb, koff, k0);
    bf16x8v vf[4]; { const char* vblk = (const char*)(Vb + (size_t)k0 * 64);
#pragma unroll
        for (int dt = 0; dt < 4; ++dt) vf[dt] = *(const bf16x8v*)(vblk + voff + 1024 * dt); }
    constexpr int DMUL = (MODE == 0) ? 16 : 1;
    const float trelf = (float)trel;
    bool ok[8];
    if (PATH == 2) {
#pragma unroll
        for (int i = 0; i < 8; ++i) { const int kk = 8 * q4 + i; const int d = trel - DMUL * kk; ok[i] = (MODE == 0) ? (k0 + kk <= cmax) : (MODE == 1 ? (tk && d >= 0) : (d >= 0 && d < 512)); } }
#pragma unroll
    for (int h = 0; h < 2; ++h) {
        f32x4 sa = MFMA16(f.ka[0], qf[h][0], bv[h][0]), sb = MFMA16(f.kb[0], qf[h][0], bv[h][1]); sa = MFMA16(f.ka[1], qf[h][1], sa); sb = MFMA16(f.kb[1], qf[h][1], sb);
        float mref = m[h] + sl2[h] * trelf;
        float mx;
        if (PATH == 2) { mx = -1e30f;
#pragma unroll
            for (int i = 0; i < 8; ++i) { const float v = i < 4 ? sa[i] : sb[i - 4]; mx = ok[i] ? fmaxf(mx, v) : mx; } }
        else { mx = fmaxf(fmaxf(fmaxf(sa[0], sa[1]), fmaxf(sa[2], sa[3])), fmaxf(fmaxf(sb[0], sb[1]), fmaxf(sb[2], sb[3]))); if (PATH == 1) mx = tk ? mx : -1e30f; }
        mx = xmax_q4(mx);
        if (__any(mx > mref + 8.f)) { const float mn = fmaxf(mref, mx), alpha = __builtin_amdgcn_exp2f(mref - mn); m[h] = mn - sl2[h] * trelf; mref = mn; ls[h] = ls[h] * alpha;
#pragma unroll
            for (int dt = 0; dt < 4; ++dt) o[h][dt] = o[h][dt] * alpha; }
        float p[8];
#pragma unroll
        for (int i = 0; i < 8; ++i) { const float e = __builtin_amdgcn_exp2f((i < 4 ? sa[i] : sb[i - 4]) - mref); p[i] = (PATH == 2) ? (ok[i] ? e : 0.f) : e; }
        unsigned w0 = pg8::cvt_pk_bf16(p[0], p[1]), w1 = pg8::cvt_pk_bf16(p[2], p[3]), w2 = pg8::cvt_pk_bf16(p[4], p[5]), w3 = pg8::cvt_pk_bf16(p[6], p[7]);
        if (PATH == 1) { w0 = tk ? w0 : 0u; w1 = tk ? w1 : 0u; w2 = tk ? w2 : 0u; w3 = tk ? w3 : 0u; }
        const v4u w = {w0, w1, w2, w3}; const bf16x8v pf = __builtin_bit_cast(bf16x8v, w);
#pragma unroll
        for (int dt = 0; dt < 4; ++dt) o[h][dt] = MFMA16(vf[dt], pf, o[h][dt]);
        ls[h] = MFMA16(ones, pf, ls[h]);
    }
}
constexpr int PSW = 132;
__device__ __forceinline__ void p_attn_fast(Ctx& C, unsigned* queue, const int ld, const int qo, const float* qn) {
    unsigned char* ws = C.ws;
    const bf16* Qraw = (const bf16*)(ws + R_QKV);
    const bf16* KC = (const bf16*)(ws + WS_KC); const bf16* VCT = (const bf16*)(ws + WS_VCT);
    const bf16* KS = (const bf16*)(ws + R_KS); const bf16* VST = (const bf16*)(ws + R_VST); const bf16* KW = (const bf16*)(ws + R_KW); const bf16* VWT = (const bf16*)(ws + R_VWT);
    bf16* O = (bf16*)(ws + R_O);
    LAS float* psl = (LAS float*)(C.lds + C.wave * (16 * PSW * 4));
    const int l = C.lane, r16 = l & 15, q4 = l >> 4;
    const unsigned koff = (unsigned)((8 * (r16 >> 2) + (r16 & 3)) * 64 + 16 * q4), voff = (unsigned)((r16 * 32 + 8 * q4) * 2);
    const v4u ones_w = {0x3f803f80u, 0x3f803f80u, 0x3f803f80u, 0x3f803f80u}; const bf16x8v ones = __builtin_bit_cast(bf16x8v, ones_w);
    int qsel = (int)(xb_xcc_id() & 7u), qtry = 0;
    for (;;) {
        unsigned u = 0; if (l == 0) u = __hip_atomic_fetch_add(queue + 64 * qsel, 1u, __ATOMIC_RELAXED, __HIP_MEMORY_SCOPE_AGENT);
        u = (unsigned)__builtin_amdgcn_readfirstlane((int)u);
        if (u >= 2048u) { if (++qtry >= 8) break; qsel = (qsel + 1) & 7; continue; }
        u = ((u >> 7) * 8 + (unsigned)qsel) * 128 + (u & 127);
        const int bg = (int)(u >> 7), tile = 127 - (int)(u & 127), g = bg & 3, b = bg >> 2, t0 = tile * 16, t = t0 + r16, row = b * SEQ + t;
        const bf16* qrow = Qraw + (size_t)row * ld + qo; const bf16* gtp = qrow + 1024 + g * 12;
#define ATT_GATE(idx) (1.f / (1.f + __expf(-bf2f(gtp[(idx)]))))
        bf16* orow = O + (size_t)row * DM + g * 256 + 4 * q4;
        bf16x8v qf[2][2]; float sl2[2]; f32x4 bv[2][2]; float m[2]; f32x4 ls[2]; f32x4 o[2][4];
#define ATT_LOADQ(hp, DM_) do { _Pragma("unroll") for (int h = 0; h < 2; ++h) { sl2[h] = exp2f(-0.5f * (float)(g * 4 + 2 * (hp) + h + 1)) * LOG2E; \
            _Pragma("unroll") for (int i_ = 0; i_ < 4; ++i_) { bv[h][0][i_] = (float)(DM_) * sl2[h] * (float)(8 * q4 + i_); bv[h][1][i_] = (float)(DM_) * sl2[h] * (float)(8 * q4 + 4 + i_); } \
            float xq_[2][8]; float ssq_ = 0.f; \
            _Pragma("unroll") for (int ks = 0; ks < 2; ++ks) { const v4u r_ = *(const v4u*)(qrow + (g * 4 + 2 * (hp) + h) * 64 + 32 * ks + 8 * q4); \
                xq_[ks][0] = bflo(r_.x); xq_[ks][1] = bfhi(r_.x); xq_[ks][2] = bflo(r_.y); xq_[ks][3] = bfhi(r_.y); xq_[ks][4] = bflo(r_.z); xq_[ks][5] = bfhi(r_.z); xq_[ks][6] = bflo(r_.w); xq_[ks][7] = bfhi(r_.w); \
                _Pragma("unroll") for (int j_ = 0; j_ < 8; ++j_) ssq_ += xq_[ks][j_] * xq_[ks][j_]; } \
            ssq_ += __shfl_xor(ssq_, 16); ssq_ += __shfl_xor(ssq_, 32); \
            const float rq_ = rsqrtf(ssq_ * (1.f / 64.f) + EPS) * (0.125f * LOG2E); \
            _Pragma("unroll") for (int ks = 0; ks < 2; ++ks) { const f32x4 ga_ = *(const f32x4*)(qn + 32 * ks + 8 * q4), gb_ = *(const f32x4*)(qn + 32 * ks + 8 * q4 + 4); \
                const v4u w_ = {pg8::cvt_pk_bf16(xq_[ks][0] * rq_ * ga_.x, xq_[ks][1] * rq_ * ga_.y), pg8::cvt_pk_bf16(xq_[ks][2] * rq_ * ga_.z, xq_[ks][3] * rq_ * ga_.w), \
                                pg8::cvt_pk_bf16(xq_[ks][4] * rq_ * gb_.x, xq_[ks][5] * rq_ * gb_.y), pg8::cvt_pk_bf16(xq_[ks][6] * rq_ * gb_.z, xq_[ks][7] * rq_ * gb_.w)}; \
                qf[h][ks] = __builtin_bit_cast(bf16x8v, w_); } } } while (0)
#define ATT_RESET() do { _Pragma("unroll") for (int h = 0; h < 2; ++h) { m[h] = -1e30f; ls[h] = (f32x4){0.f, 0.f, 0.f, 0.f}; _Pragma("unroll") for (int dt = 0; dt < 4; ++dt) o[h][dt] = (f32x4){0.f, 0.f, 0.f, 0.f}; } } while (0)
        const int cmax = t >= 31 ? (((t - 31) >> 4) < 126 ? ((t - 31) >> 4) : 126) : -1;
        const int cmax0 = t0 >= 31 ? (((t0 - 31) >> 4) < 126 ? ((t0 - 31) >> 4) : 126) : -1;
        const bf16* KCb = KC + (size_t)bg * 128 * 64; const bf16* VCb = VCT + (size_t)bg * 128 * 64;
        const int ncs = ((t0 + 15 - 31) >> 4) < 0 ? 0 : ((((t0 + 15 - 31) >> 4) < 126 ? ((t0 + 15 - 31) >> 4) : 126) >> 5) + 1;
#pragma unroll 1
        for (int hp = 0; hp < 2; ++hp) {
            ATT_LOADQ(hp, 16); ATT_RESET();
            for (int st = ncs - 1; st >= 0; --st) {
                if (32 * st + 31 <= cmax0) attn_step<0, 0>(KCb, koff, VCb, voff, 32 * st, t - 31 - 16 * 32 * st, true, cmax, qf, bv, ones, m, ls, o, sl2, q4);
                else attn_step<0, 2>(KCb, koff, VCb, voff, 32 * st, t - 31 - 16 * 32 * st, true, cmax, qf, bv, ones, m, ls, o, sl2, q4); }
#pragma unroll
            for (int h = 0; h < 2; ++h) { const float lt = ls[h][0];
                const float sc_ = lt > 0.f ? ATT_GATE((2 * hp + h) * 3 + 0) / lt : 0.f;
#pragma unroll
                for (int dt = 0; dt < 4; ++dt) { const f32x4 r_ = o[h][dt] * sc_; v2u w; w.x = pg8::cvt_pk_bf16(r_[0], r_[1]); w.y = pg8::cvt_pk_bf16(r_[2], r_[3]);
                    *(v2u*)(orow + (2 * hp + h) * 64 + 16 * dt) = w; } }
            float ps[4][8];
#pragma unroll
            for (int st = 0; st < 4; ++st)
#pragma unroll
                for (int i = 0; i < 8; ++i) ps[st][i] = 0.f;
#pragma unroll
            for (int st = 0; st < 4; ++st) {
                if (st < ncs) {
                    const int k0 = 32 * st; const char* kblk = (const char*)(KCb + (size_t)k0 * 64);
                    bf16x8v ka[2], kb[2];
#pragma unroll
                    for (int ks = 0; ks < 2; ++ks) { ka[ks] = *(const bf16x8v*)(kblk + koff + 2048 * ks); kb[ks] = *(const bf16x8v*)(kblk + koff + 256 + 2048 * ks); }
#pragma unroll
                    for (int h = 0; h < 2; ++h) {
                        f32x4 sa = MFMA16(ka[0], qf[h][0], bv[h][0]), sb = MFMA16(kb[0], qf[h][0], bv[h][1]); sa = MFMA16(ka[1], qf[h][1], sa); sb = MFMA16(kb[1], qf[h][1], sb);
                        const float lt = ls[h][0], inv = lt > 0.f ? 1.f / lt : 0.f, mref = m[h] + sl2[h] * (float)(t - 31 - 16 * k0);
#pragma unroll
                        for (int i = 0; i < 8; ++i) { const int c = k0 + 8 * q4 + i; ps[st][i] += (c <= cmax) ? __builtin_amdgcn_exp2f((i < 4 ? sa[i] : sb[i - 4]) - mref) * inv : 0.f; }
                    }
                }
            }
#pragma unroll
            for (int st = 0; st < 4; ++st) { LAS f32x4* p0 = (LAS f32x4*)(psl + r16 * PSW + 32 * st + 8 * q4);
                f32x4 a = {ps[st][0], ps[st][1], ps[st][2], ps[st][3]}, bq = {ps[st][4], ps[st][5], ps[st][6], ps[st][7]};
                if (hp) { a = a + p0[0]; bq = bq + p0[1]; }
                p0[0] = a; p0[1] = bq; }
            LDS_WAIT();
        }
        unsigned mlo, mhi;
        {
            float sc[16]; const LAS float* pr = psl + r16 * PSW + 32 * q4; const int cur = t >> 5;
            float prev = q4 > 0 ? pr[-1] : 0.f;
#pragma unroll
            for (int jj = 0; jj < 16; ++jj) { const float a = pr[2 * jj], bq = pr[2 * jj + 1]; const float imp = prev + a + bq; prev = bq;
                const int j = 16 * q4 + jj; const bool valid = 32 * j <= t; const bool forced = valid && (j == 0 || j == cur || j == cur - 1);
                sc[jj] = forced ? 1e9f : (valid ? imp : -1e9f); }
            unsigned my = 0u;
#pragma unroll 1
            for (int r = 0; r < 8; ++r) {
                float best = sc[0]; int bi = 0;
#pragma unroll
                for (int jj = 1; jj < 16; ++jj) if (sc[jj] > best) { best = sc[jj]; bi = jj; }
                bi += 16 * q4;
#pragma unroll
                for (int sh = 16; sh <= 32; sh <<= 1) { const float ov = __shfl_xor(best, sh); const int oi = __shfl_xor(bi, sh); if (ov > best || (ov == best && oi < bi)) { best = ov; bi = oi; } }
                if ((bi >> 4) == q4) { const int jj0 = bi & 15; if (best > -0.5e9f) my |= 1u << jj0;
#pragma unroll
                    for (int jj = 0; jj < 16; ++jj) if (jj == jj0) sc[jj] = -INFINITY; }
            }
            mlo = (q4 == 0 ? my : 0u) | (q4 == 1 ? my << 16 : 0u); mhi = (q4 == 2 ? my : 0u) | (q4 == 3 ? my << 16 : 0u);
            mlo |= __shfl_xor(mlo, 16); mlo |= __shfl_xor(mlo, 32); mhi |= __shfl_xor(mhi, 16); mhi |= __shfl_xor(mhi, 32);
        }
        LDS_WAIT();
        unsigned ulo = mlo, uhi = mhi;
#pragma unroll
        for (int sh = 1; sh <= 8; sh <<= 1) { ulo |= __shfl_xor(ulo, sh); uhi |= __shfl_xor(uhi, sh); }
        const unsigned long long un0 = ((unsigned long long)(unsigned)__builtin_amdgcn_readfirstlane((int)uhi) << 32) | (unsigned)__builtin_amdgcn_readfirstlane((int)ulo);
        const unsigned long long mine = ((unsigned long long)mhi << 32) | mlo;
#pragma unroll 1
        for (int hp = 0; hp < 2; ++hp) {
            ATT_LOADQ(hp, 1);
#define ATT_ADD_OUT(br) do { _Pragma("unroll") for (int h = 0; h < 2; ++h) { const float lt = ls[h][0]; const float sc_ = lt > 0.f ? ATT_GATE((2 * hp + h) * 3 + (br)) / lt : 0.f; \
            _Pragma("unroll") for (int dt = 0; dt < 4; ++dt) { v2u* op = (v2u*)(orow + (2 * hp + h) * 64 + 16 * dt); const v2u c_ = *op; const f32x4 r_ = o[h][dt] * sc_; \
                v2u w; w.x = pg8::cvt_pk_bf16(r_[0] + bflo(c_.x), r_[1] + bfhi(c_.x)); w.y = pg8::cvt_pk_bf16(r_[2] + bflo(c_.y), r_[3] + bfhi(c_.y)); *op = w; } } } while (0)
            {
                const bf16* Kb = KS + (size_t)bg * SEQ * 64; const bf16* Vb = VST + (size_t)bg * SEQ * 64;
                ATT_RESET();
                unsigned long long un = un0;
                const int cur0 = t0 >> 5;
                while (un) { const int j = 63 - __builtin_clzll(un); un &= ~(1ull << j);
                    const bool tk = ((mine >> j) & 1ull) != 0ull;
                    if (j >= cur0) attn_step<1, 2>(Kb, koff, Vb, voff, 32 * j, t - 32 * j, tk, 0, qf, bv, ones, m, ls, o, sl2, q4);
                    else if (__all(tk)) attn_step<1, 0>(Kb, koff, Vb, voff, 32 * j, t - 32 * j, true, 0, qf, bv, ones, m, ls, o, sl2, q4);
                    else attn_step<1, 1>(Kb, koff, Vb, voff, 32 * j, t - 32 * j, tk, 0, qf, bv, ones, m, ls, o, sl2, q4); }
                ATT_ADD_OUT(1);
            }
            {
                const bf16* Kb = KW + (size_t)bg * SEQ * 64; const bf16* Vb = VWT + (size_t)bg * SEQ * 64;
                const int sb = t0 >= 511 ? (t0 - 511) >> 5 : 0, se = t0 >> 5;
                ATT_RESET();
                for (int st = se; st >= sb; --st) {
                    if (32 * st + 31 <= t0 && 32 * st > t0 - 497) attn_step<2, 0>(Kb, koff, Vb, voff, 32 * st, t - 32 * st, true, 0, qf, bv, ones, m, ls, o, sl2, q4);
                    else attn_step<2, 2>(Kb, koff, Vb, voff, 32 * st, t - 32 * st, true, 0, qf, bv, ones, m, ls, o, sl2, q4); }
                ATT_ADD_OUT(2);
            }
        }
#undef ATT_ADD_OUT
#undef ATT_LOADQ
#undef ATT_RESET
#undef ATT_GATE
    }
}

constexpr int SCQ = 272, SCT = 144;
constexpr int LQ_ = 0, LK_ = 17408, LKT_ = 34816, LVT_ = 53248, LP_ = 71680, LO_ = 80896, LE_ = 114688, LT_ = 115712;
__device__ __forceinline__ void p_scan_fast(Ctx& C, int layer) {
    unsigned char* ws = C.ws;
    const bf16* Pq = (const bf16*)(ws + R_PQ); const bf16* Pi = (const bf16*)(ws + R_PI); const bf16* Pg = (const bf16*)(ws + R_PG); const float* LF = (const float*)(ws + R_LF);
    bf16* O2 = (bf16*)(ws + R_O2);
    const float* gn = C.inp(I_HGN) + layer * 128;
    LAS unsigned char* L = C.lds;
    const int tid = C.tid, lane = C.lane, w = C.wave, r16 = lane & 15, q4 = lane >> 4, k = tid & 127, seg = tid >> 7;
    LAS float* tot = (LAS float*)(L + LT_); LAS float* eref = (LAS float*)(L + LE_); LAS float* elr = eref + 128;
    { const int tile = tid >> 8, e = tid & 255, row = e >> 4, col = e & 15;
      *(LAS bf16*)(L + LP_ + ((tile ? 32 : 0) + row) * SCT + ((tile ? 48 : 16) + col) * 2) = 0; }
    for (int bh = C.bid; bh < 256; bh += C.G) {
        const int b = bh >> 3, h = bh & 7;
        const size_t base = (size_t)(b * SEQ) * DM + h * 128;
        f32x4 S[8];
#pragma unroll
        for (int i = 0; i < 8; ++i) S[i] = (f32x4){0.f, 0.f, 0.f, 0.f};
        bf16 qv[16], vv[16]; float lf[16];
#define SC_LOAD(t0) do { _Pragma("unroll") for (int i = 0; i < 16; ++i) { const size_t off = base + (size_t)((t0) + 16 * seg + i) * DM + k; qv[i] = Pq[off]; vv[i] = Pi[off]; lf[i] = LF[off]; } } while (0)
        SC_LOAD(0);
#pragma unroll 1
        for (int c = 0; c < SEQ / 64; ++c) {
            const int t0 = c * 64;
            float cs[16]; { float run = 0.f;
#pragma unroll
                for (int i = 0; i < 16; ++i) { run += lf[i]; cs[i] = run; }
                tot[seg * 128 + k] = run; }
            __syncthreads();
            { const float a0 = tot[k], a1 = tot[128 + k], a2 = tot[256 + k], a3 = tot[384 + k];
              const float off = seg == 0 ? 0.f : (seg == 1 ? a0 : (seg == 2 ? a0 + a1 : a0 + a1 + a2)), ref = a0 + a1, last = ref + a2 + a3;
              unsigned kt[16];
#pragma unroll
              for (int i = 0; i < 16; ++i) { const float d = off + cs[i] - ref; const float qt = bf2f(qv[i]) * __expf(fminf(d, 80.f)), ktv = (1.f - __expf(lf[i])) * __expf(fminf(-d, 80.f));
                  const int s = 16 * seg + i; kt[i] = f2bf(ktv);
                  *(LAS bf16*)(L + LQ_ + s * SCQ + k * 2) = (bf16)f2bf(qt); *(LAS bf16*)(L + LK_ + s * SCQ + k * 2) = (bf16)kt[i]; }
              v4u w0, w1, x0, x1;
              w0.x = kt[0] | (kt[1] << 16); w0.y = kt[2] | (kt[3] << 16); w0.z = kt[4] | (kt[5] << 16); w0.w = kt[6] | (kt[7] << 16);
              w1.x = kt[8] | (kt[9] << 16); w1.y = kt[10] | (kt[11] << 16); w1.z = kt[12] | (kt[13] << 16); w1.w = kt[14] | (kt[15] << 16);
              x0.x = vv[0] | ((unsigned)vv[1] << 16); x0.y = vv[2] | ((unsigned)vv[3] << 16); x0.z = vv[4] | ((unsigned)vv[5] << 16); x0.w = vv[6] | ((unsigned)vv[7] << 16);
              x1.x = vv[8] | ((unsigned)vv[9] << 16); x1.y = vv[10] | ((unsigned)vv[11] << 16); x1.z = vv[12] | ((unsigned)vv[13] << 16); x1.w = vv[14] | ((unsigned)vv[15] << 16);
              *(LAS v4u*)(L + LKT_ + k * SCT + seg * 32) = w0; *(LAS v4u*)(L + LKT_ + k * SCT + seg * 32 + 16) = w1;
              *(LAS v4u*)(L + LVT_ + k * SCT + seg * 32) = x0; *(LAS v4u*)(L + LVT_ + k * SCT + seg * 32 + 16) = x1;
              if (seg == 0) { eref[k] = __expf(ref); elr[k] = __expf(last - ref); } }
            __syncthreads();
            if (c + 1 < SEQ / 64) SC_LOAD(t0 + 64);
#pragma unroll 1
            for (int ti = w; ti < 10; ti += 8) {
                const int rt = ti < 1 ? 0 : (ti < 3 ? 1 : (ti < 6 ? 2 : 3)), ct = ti - (rt * (rt + 1)) / 2;
                f32x4 acc = {0.f, 0.f, 0.f, 0.f};
#pragma unroll
                for (int p = 0; p < 4; ++p) { const bf16x8v a = *(const LAS bf16x8v*)(L + LQ_ + (16 * rt + r16) * SCQ + (32 * p + 8 * q4) * 2), bq = *(const LAS bf16x8v*)(L + LK_ + (16 * ct + r16) * SCQ + (32 * p + 8 * q4) * 2);
                    acc = MFMA16(a, bq, acc); }
#pragma unroll
                for (int i = 0; i < 4; ++i) { const int t = 16 * rt + 4 * q4 + i, s = 16 * ct + r16; *(LAS bf16*)(L + LP_ + t * SCT + s * 2) = (bf16)f2bf(s <= t ? acc[i] : 0.f); }
            }
            __syncthreads();
            bf16x8v sfrag[4]; f32x4 e8[4][2];
#pragma unroll
            for (int p = 0; p < 4; ++p) { e8[p][0] = *(const LAS f32x4*)(eref + 32 * p + 8 * q4); e8[p][1] = *(const LAS f32x4*)(eref + 32 * p + 8 * q4 + 4);
                S[2 * p] = S[2 * p] * e8[p][0]; S[2 * p + 1] = S[2 * p + 1] * e8[p][1];
                const v4u wv = {pg8::cvt_pk_bf16(S[2 * p][0], S[2 * p][1]), pg8::cvt_pk_bf16(S[2 * p][2], S[2 * p][3]), pg8::cvt_pk_bf16(S[2 * p + 1][0], S[2 * p + 1][1]), pg8::cvt_pk_bf16(S[2 * p + 1][2], S[2 * p + 1][3])};
                sfrag[p] = __builtin_bit_cast(bf16x8v, wv); }
            bf16x8v vfr[2];
#pragma unroll
            for (int ss = 0; ss < 2; ++ss) vfr[ss] = *(const LAS bf16x8v*)(L + LVT_ + (16 * w + r16) * SCT + (32 * ss + 8 * q4) * 2);
#pragma unroll
            for (int rt = 0; rt < 4; ++rt) { f32x4 o = {0.f, 0.f, 0.f, 0.f};
#pragma unroll
                for (int p = 0; p < 4; ++p) { const bf16x8v a = *(const LAS bf16x8v*)(L + LQ_ + (16 * rt + r16) * SCQ + (32 * p + 8 * q4) * 2); o = MFMA16(a, sfrag[p], o); }
#pragma unroll
                for (int ss = 0; ss < 2; ++ss) if (ss <= rt / 2) { const bf16x8v a = *(const LAS bf16x8v*)(L + LP_ + (16 * rt + r16) * SCT + (32 * ss + 8 * q4) * 2); o = MFMA16(a, vfr[ss], o); }
#pragma unroll
                for (int i = 0; i < 4; ++i) *(LAS float*)(L + LO_ + (16 * rt + 4 * q4 + i) * 528 + (16 * w + r16) * 4) = o[i]; }
#pragma unroll
            for (int p = 0; p < 4; ++p)
#pragma unroll
                for (int ab = 0; ab < 2; ++ab) { const int krow = 32 * p + 8 * (r16 >> 2) + (r16 & 3) + 4 * ab;
#pragma unroll
                    for (int ss = 0; ss < 2; ++ss) { const bf16x8v a = *(const LAS bf16x8v*)(L + LKT_ + krow * SCT + (32 * ss + 8 * q4) * 2); S[2 * p + ab] = MFMA16(a, vfr[ss], S[2 * p + ab]); } }
#pragma unroll
            for (int p = 0; p < 4; ++p) { const f32x4 l0 = *(const LAS f32x4*)(elr + 32 * p + 8 * q4), l1 = *(const LAS f32x4*)(elr + 32 * p + 8 * q4 + 4); S[2 * p] = S[2 * p] * l0; S[2 * p + 1] = S[2 * p + 1] * l1; }
            __syncthreads();
#pragma unroll
            for (int rep = 0; rep < 2; ++rep) { const int tok = (tid >> 4) + 32 * rep, part = tid & 15;
                const f32x4 oa = *(const LAS f32x4*)(L + LO_ + tok * 528 + part * 32), ob = *(const LAS f32x4*)(L + LO_ + tok * 528 + part * 32 + 16);
                float ss = (oa.x * oa.x + oa.y * oa.y) + (oa.z * oa.z + oa.w * oa.w) + (ob.x * ob.x + ob.y * ob.y) + (ob.z * ob.z + ob.w * ob.w);
                ss += __shfl_xor(ss, 1); ss += __shfl_xor(ss, 2); ss += __shfl_xor(ss, 4); ss += __shfl_xor(ss, 8);
                const float rstd = rsqrtf(ss * (1.f / 128.f) + EPS);
                const size_t off = base + (size_t)(t0 + tok) * DM + part * 8; const v4u g8 = *(const v4u*)(Pg + off);
                const f32x4 ga = *(const f32x4*)(gn + part * 8), gb = *(const f32x4*)(gn + part * 8 + 4);
                v4u wv; wv.x = pk2(oa.x * rstd * ga.x * bflo(g8.x), oa.y * rstd * ga.y * bfhi(g8.x)); wv.y = pk2(oa.z * rstd * ga.z * bflo(g8.y), oa.w * rstd * ga.w * bfhi(g8.y));
                wv.z = pk2(ob.x * rstd * gb.x * bflo(g8.z), ob.y * rstd * gb.y * bfhi(g8.z)); wv.w = pk2(ob.z * rstd * gb.z * bflo(g8.w), ob.w * rstd * gb.w * bfhi(g8.w));
                *(v4u*)(O2 + off) = wv; }
        }
#undef SC_LOAD
        __syncthreads();
    }
}

#define PH_BEGIN { const bool run_ = (pid >= lo && pid < hi); ++pid; if (run_) { { int ln_; asm volatile("v_mbcnt_lo_u32_b32 %0, -1, 0\n\tv_mbcnt_hi_u32_b32 %0, -1, %0" : "=v"(ln_)); C.lane = ln_; C.tid = C.wave * 64 + ln_; }
#define PH_END   if (pid < hi) xcd_barrier(bar); } }
#define XN ((const bf16*)(ws + WS_XN))
#define RTAB ((const int*)(ws + WS_RTAB))

template <int L>
__device__ __forceinline__ void run_layer(Ctx& C, const XcdBarrier& bar, int& pid, const int lo, const int hi, PG8_LAS unsigned char* ring) {
    unsigned char* const ws = C.ws;

        const int li = L >> 1;
        if (L < 2) {
            PH_BEGIN { pg8::Gemm g{XN, (const bf16*)(ws + W_HIN) + (size_t)L * 4096 * 1024, 1024, 1024, 0}; pg8::GenOrder S; S.init(256, 16, C.G, C.bid, nullptr);
                pg8::EpiHgrnIn E{ws, L};
                pg8::gemm_phase<pg8::EpiHgrnIn, pg8::GenOrder, true, true>(ring, g, S, E, C.wave); } PH_END
            PH_BEGIN p_scan_fast(C, L); PH_END
            if (PROBE_DUP & 16) { PH_BEGIN p_scan_fast(C, L); PH_END }
        } else {
            PH_BEGIN { const bool first = (L == 2); pg8::Gemm g{XN, (const bf16*)(ws + (first ? W_KVQ : W_Q3)), 1024, 1024, 0}; pg8::GenOrder S; S.init(256, first ? 11 : 5, C.G, C.bid, nullptr);
                pg8::EpiBf16 E{(bf16*)(ws + R_QKV), first ? 2816 : 1280, nullptr, 0, 0, 1.f};
                pg8::gemm_phase<pg8::EpiBf16, pg8::GenOrder, true, true>(ring, g, S, E, C.wave); } PH_END
            if (L == 2) {
                PH_BEGIN p_post_kv(C); PH_END
                if (PROBE_DUP & 8) { PH_BEGIN p_post_kv(C); PH_END }
                PH_BEGIN { pg8::Gemm g{(const bf16*)(ws + R_KCR), (const bf16*)(ws + W_CMP1), 2048, 1024, (size_t)256 * 2048 * 2}; pg8::GenOrder S; S.init(128, 1, C.G, C.bid, RTAB + 2048);
                    pg8::EpiBf16 E{(bf16*)(ws + WS_HC), 256, (const float*)(ws + WS_CB), 1, 256, 1.f};
                    pg8::gemm_phase<pg8::EpiBf16, pg8::GenOrder, true, true>(ring, g, S, E, C.wave); } PH_END
                PH_BEGIN p_cmp2(C); PH_END
            if (PROBE_DUP & 32) { PH_BEGIN p_cmp2(C); PH_END }
            }
            PH_BEGIN p_attn_fast(C, (unsigned*)(ws + WS_CTL) + 8192 + 2048 * (L - 2), L == 2 ? 2816 : 1280, L == 2 ? 1536 : 0, C.inp(I_NQN) + (L - 2) * 64); PH_END
            if (PROBE_DUP & 1) { PH_BEGIN p_attn_fast(C, (unsigned*)(ws + WS_CTL) + 8192 + 2048 * (L - 2) + 1024, L == 2 ? 2816 : 1280, L == 2 ? 1536 : 0, C.inp(I_NQN) + (L - 2) * 64); PH_END }
        }
        PH_BEGIN { pg8::Gemm g{(const bf16*)(ws + (L < 2 ? R_O2 : R_O)), (const bf16*)(ws + (L < 2 ? W_HOUT : W_NOUT)) + (size_t)(L & 1) * 1024 * 1024, 1024, 1024, 0};
            pg8::GenOrder S; S.init(256, 4, C.G, C.bid, nullptr);
            pg8::EpiRes E{L == 0 ? C.inp(I_X) : C.out, C.out, 1024};
            pg8::gemm_phase<pg8::EpiRes, pg8::GenOrder, true, true>(ring, g, S, E, C.wave); } PH_END
        PH_BEGIN { if (L & 1) p_norm<false, true, true>(C, C.inp(I_MR) + (size_t)li * 1024 * 8, C.inp(I_NFFN) + L * 1024); else p_norm<false, false, true>(C, nullptr, nullptr); } PH_END
            if (PROBE_DUP & 4) { PH_BEGIN { if (L & 1) p_norm<false, true, true>(C, C.inp(I_MR) + (size_t)li * 1024 * 8, C.inp(I_NFFN) + L * 1024); else p_norm<false, false, true>(C, nullptr, nullptr); } PH_END }
        if (L & 1) { PH_BEGIN p_gather(C); PH_END
            if (PROBE_DUP & 32) { PH_BEGIN p_gather(C); PH_END } }
        if (!(L & 1)) {
            PH_BEGIN { pg8::Gemm g{XN, (const bf16*)(ws + W_FGU) + (size_t)li * 2 * DFF * 1024, 1024, 1024, 0};
                pg8::GenOrder S; S.init(256, 22, C.G, C.bid, nullptr);
                pg8::EpiSwiGLU E{(bf16*)(ws + R_HF), DFF};
                pg8::gemm_phase<pg8::EpiSwiGLU, pg8::GenOrder, true, true>(ring, g, S, E, C.wave); } PH_END
        } else {
            PH_BEGIN { pg8::Gemm g{(const bf16*)(ws + R_XP), (const bf16*)(ws + W_MGU + (size_t)li * 8 * 2 * DFE * 1024), 512, 512, (size_t)2 * DFE * 1024};
                pg8::GenOrder S; S.init(RTAB[1024], 28, C.G, C.bid, RTAB);
                pg8::EpiSwiGLU8 E{ws + R_HM, DFE};
                pg8::gemm_phase<pg8::EpiSwiGLU8, pg8::GenOrder, true, true, true>(ring, g, S, E, C.wave); } PH_END
        }
        if (!(L & 1)) {
            PH_BEGIN { pg8::Gemm g{(const bf16*)(ws + R_HF), (const bf16*)(ws + W_FDN) + (size_t)li * 1024 * DFF, DFF, DFF, 0}; pg8::GenOrder S; S.init(256, 4, C.G, C.bid, nullptr);
                pg8::EpiRes E{C.out, C.out, 1024};
                pg8::gemm_phase<pg8::EpiRes, pg8::GenOrder, true, true>(ring, g, S, E, C.wave); } PH_END
            PH_BEGIN p_norm<false, false, true>(C, nullptr, nullptr); PH_END
            if (PROBE_DUP & 4) {             PH_BEGIN p_norm<false, false, true>(C, nullptr, nullptr); PH_END }
        } else {
            PH_BEGIN { pg8::Gemm g{(const bf16*)(ws + R_HM), (const bf16*)(ws + W_MDN + (size_t)li * 8 * 1024 * DFE), DFE / 2, DFE / 2, (size_t)1024 * DFE}; pg8::GenOrder S; S.init(RTAB[1024], 4, C.G, C.bid, RTAB);
                pg8::EpiBf16 E{(bf16*)(ws + R_XP), 1024, nullptr, 0, 0, 1.f / (pg8::FP8_SH * pg8::FP8_SW2)};
                pg8::gemm_phase<pg8::EpiBf16, pg8::GenOrder, true, true, true>(ring, g, S, E, C.wave); } PH_END
            PH_BEGIN { if (L == 1) p_norm<true, false, true>(C, nullptr, nullptr); else p_norm<true, false, false>(C, nullptr, nullptr); } PH_END
        }
    }

struct Args { const float* in[24]; float* out; unsigned char* ws; int ph_lo, ph_hi; };
constexpr int N_PHASES = 34;

__global__ void __launch_bounds__(NWAVES * 64, 2) yoco_fwd(Args args) {
    extern __shared__ __attribute__((aligned(16))) unsigned char lds_raw[];
    Ctx C;
    C.lds = (LAS unsigned char*)lds_raw;
    C.wave = __builtin_amdgcn_readfirstlane((int)(threadIdx.x >> 6)); C.tid = threadIdx.x; C.lane = C.tid & 63;
    C.G = gridDim.x; C.bid = blockIdx.x;
    C.out = args.out; C.ws = args.ws;
    unsigned char* const ws = args.ws;
    volatile LAS unsigned* MISC = (volatile LAS unsigned*)(C.lds + MISC_OFF);
    if (C.tid < 32) MISC[C.tid] = 0u;
    __syncthreads();
    XcdBarrier bar = xcd_barrier_post((unsigned*)(ws + WS_CTL) + 4096, MISC + 8);
    const int lo = args.ph_lo, hi = args.ph_hi;
    int pid = 0;
    PG8_LAS unsigned char* ring = (PG8_LAS unsigned char*)lds_raw;
    PH_BEGIN p_prologue(C); PH_END
            if (PROBE_DUP & 2) {     PH_BEGIN p_prologue(C); PH_END }

    run_layer<0>(C, bar, pid, lo, hi, ring); run_layer<1>(C, bar, pid, lo, hi, ring); run_layer<2>(C, bar, pid, lo, hi, ring); run_layer<3>(C, bar, pid, lo, hi, ring);
#undef PH_BEGIN
#undef PH_END
#undef XN
#undef RTAB
}

extern "C" void kernel_launch(void* const* d_in, const int* in_sizes, int n_in, void* d_out, int out_size, void* d_ws, size_t ws_size, hipStream_t stream) {
    static int grid = 0;
    if (grid == 0) {
        if (n_in != 24 || in_sizes[0] != NT * DM || out_size != NT * DM || ws_size < WS_NEED) { fprintf(stderr, "kernel_launch: unexpected shapes / workspace (n_in %d, ws %zu, need %zu)\n", n_in, ws_size, (size_t)WS_NEED); grid = -1; return; }
        int dev = 0, cus = 0;
        if (hipGetDevice(&dev) != hipSuccess || hipDeviceGetAttribute(&cus, hipDeviceAttributeMultiprocessorCount, dev) != hipSuccess) { grid = -1; return; }
        if (hipFuncSetAttribute((const void*)yoco_fwd, hipFuncAttributeMaxDynamicSharedMemorySize, LDS_BYTES) != hipSuccess) { fprintf(stderr, "kernel_launch: hipFuncSetAttribute failed\n"); grid = -1; return; }
        int per_cu = 0;
        if (hipOccupancyMaxActiveBlocksPerMultiprocessor(&per_cu, (const void*)yoco_fwd, NWAVES * 64, LDS_BYTES) != hipSuccess || per_cu < 1) { fprintf(stderr, "kernel_launch: occupancy query says %d\n", per_cu); }
        (void)hipGetLastError();
        grid = cus;
    }
    if (grid < 0) return;
    (void)hipMemsetAsync((char*)d_ws + WS_CTL, 0, CTL_ZERO_BYTES, stream);
    Args a{};
    for (int i = 0; i < 24; ++i) a.in[i] = (const float*)d_in[i];
    a.out = (float*)d_out; a.ws = (unsigned char*)d_ws;
#if MK_SINGLE
    a.ph_lo = 0; a.ph_hi = PROBE_DUP ? 1000 : N_PHASES;
    hipLaunchKernelGGL(yoco_fwd, dim3(grid), dim3(NWAVES * 64), LDS_BYTES, stream, a);
#else
    for (int k = 0; k < N_PHASES; ++k) { a.ph_lo = k; a.ph_hi = k + 1; hipLaunchKernelGGL(yoco_fwd, dim3(grid), dim3(NWAVES * 64), LDS_BYTES, stream, a); }
#endif
}
```

```cpp
#include <hip/hip_runtime.h>
#include <cstdio>
#include <cstdint>

#ifndef PROBE_DUP
#define PROBE_DUP 0
#endif
#ifndef MK_SINGLE
#define MK_SINGLE 1
#endif

namespace pg8 {
#define PG8_LAS __attribute__((address_space(3)))
typedef unsigned short bf16_t;
typedef short bf16x8 __attribute__((ext_vector_type(8)));
typedef float f32x4 __attribute__((ext_vector_type(4)));
typedef unsigned u32x4 __attribute__((ext_vector_type(4)));
constexpr int BM = 256, BK = 64, HALF = 128, HTB = HALF * BK * 2  , STAGE_BYTES = 8 * HTB, NXCD = 8, WGM = 8;

__host__ __device__ __forceinline__ int lds_byte(int r, int c) { const int st = (r >> 4) * 2 + (c >> 5), rr = r & 15, cc = c & 31, ob = rr * 64 + cc * 2; return st * 1024 + (ob ^ (((ob >> 9) & 1) << 5)); }
__host__ __device__ __forceinline__ void stage_rc(int b, int& R, int& C) { const int st = b / 1024, sb = b % 1024, swz = sb ^ (((sb >> 9) & 1) << 5); R = (st >> 1) * 16 + swz / 64; C = (st & 1) * 32 + (swz % 64) / 2; }
__host__ __device__ __forceinline__ int perm32(int rho) { const int n = rho >> 4, i = rho & 15; return 8 * (i >> 2) + 4 * n + (i & 3); }

struct Unit { int pm, pn, e; };
struct Gemm { const bf16_t* A; const bf16_t* Bt; int K; int lda; size_t estride; };

struct GenOrder {
    int nM, nN, nwg, G, c; const int* tile_e;
    __device__ void init(int nM_, int nN_, int G_, int c_, const int* te) { nM = nM_; nN = nN_; nwg = nM * nN; G = G_; c = c_; tile_e = te; }
    __device__ bool next(int i, Unit& u) const {
        const long L = (long)i * G + c; if (L >= nwg) return false;
        int wgid = (int)L; { const int q = nwg / NXCD, r = nwg % NXCD, xcd = wgid % NXCD, off = wgid / NXCD; wgid = (xcd < r ? xcd * (q + 1) : r * (q + 1) + (xcd - r) * q) + off; }
        const int nig = WGM * nN, gid = wgid / nig, fm = gid * WGM, gsz = (nM - fm) < WGM ? (nM - fm) : WGM;
        u.pm = fm + ((wgid % nig) % gsz); u.pn = (wgid % nig) / gsz; u.e = tile_e ? tile_e[u.pm] : 0; return true;
    }
    __device__ __forceinline__ void a_ready(const Unit&) const {}
    __device__ __forceinline__ void done(const Unit&) const {}
};

__device__ __forceinline__ unsigned cvt_pk_bf16(float lo, float hi) { unsigned r; asm volatile("v_cvt_pk_bf16_f32 %0, %1, %2" : "=v"(r) : "v"(lo), "v"(hi)); return r; }
__device__ __forceinline__ float silu_f(float v) { return v * __builtin_amdgcn_rcpf(1.0f + __expf(-v)); }
__device__ __forceinline__ float clamp448(float v) { return fminf(fmaxf(v, -448.f), 448.f); }
__device__ __forceinline__ unsigned pk4_fp8(float a, float b, float c, float d) {
    int w = __builtin_amdgcn_cvt_pk_fp8_f32(clamp448(a), clamp448(b), 0, false); w = __builtin_amdgcn_cvt_pk_fp8_f32(clamp448(c), clamp448(d), w, true); return (unsigned)w; }
constexpr float FP8_SW1 = 32.f, FP8_SW2 = 64.f, FP8_SH = 8.f;

struct EpiBf16 {
    static constexpr bool PERM = true, AFTER_DRAIN = false;
    bf16_t* O; int ldc; const float* bias; int act; int bias_es; float oscale;
    __device__ __forceinline__ void operator()(const f32x4 (&acc)[2][2][4][2], const Unit& u, int wr, int wc, int fr, int fq) const {
        const int row0 = u.pm * BM + wr * 64 + fr, col0 = u.pn * BM + wc * 32 + 8 * fq;
        f32x4 bv[2][2];
#pragma unroll
        for (int bj = 0; bj < 2; ++bj)
#pragma unroll
            for (int n = 0; n < 2; ++n) bv[bj][n] = bias ? *(const f32x4*)(bias + u.e * bias_es + col0 + bj * HALF + 4 * n) : (f32x4){0.f, 0.f, 0.f, 0.f};
#pragma unroll
        for (int ai = 0; ai < 2; ++ai)
#pragma unroll
            for (int m = 0; m < 4; ++m) { bf16_t* rowp = O + (size_t)(row0 + ai * HALF + m * 16) * ldc + col0;
#pragma unroll
                for (int bj = 0; bj < 2; ++bj) { f32x4 v0 = acc[ai][bj][m][0] * oscale + bv[bj][0], v1 = acc[ai][bj][m][1] * oscale + bv[bj][1];
                    if (act == 1) {
#pragma unroll
                        for (int i = 0; i < 4; ++i) { v0[i] = silu_f(v0[i]); v1[i] = silu_f(v1[i]); } }
                    u32x4 w; w.x = cvt_pk_bf16(v0[0], v0[1]); w.y = cvt_pk_bf16(v0[2], v0[3]); w.z = cvt_pk_bf16(v1[0], v1[1]); w.w = cvt_pk_bf16(v1[2], v1[3]);
                    *(u32x4*)(rowp + bj * HALF) = w; } }
    }
};
struct EpiRes {
    static constexpr bool PERM = false, AFTER_DRAIN = false;
    const float* base; float* out; int ldc; float oscale;
    __device__ __forceinline__ void operator()(const f32x4 (&acc)[2][2][4][2], const Unit& u, int wr, int wc, int fr, int fq) const {
        const int row0 = u.pm * BM + wr * 64 + fr, col0 = u.pn * BM + wc * 32 + 4 * fq;
#pragma unroll
        for (int ai = 0; ai < 2; ++ai)
#pragma unroll
            for (int m = 0; m < 4; ++m) { const size_t off = (size_t)(row0 + ai * HALF + m * 16) * ldc + col0;
#pragma unroll
                for (int bj = 0; bj < 2; ++bj)
#pragma unroll
                    for (int n = 0; n < 2; ++n) { const f32x4 b = *(const f32x4*)(base + off + bj * HALF + n * 16); *(f32x4*)(out + off + bj * HALF + n * 16) = b + acc[ai][bj][m][n] * oscale; } }
    }
};
struct EpiSwiGLU {
    static constexpr bool PERM = true, AFTER_DRAIN = false;
    bf16_t* O; int ldc;
    __device__ __forceinline__ void operator()(const f32x4 (&acc)[2][2][4][2], const Unit& u, int wr, int wc, int fr, int fq) const {
        const int row0 = u.pm * BM + wr * 64 + fr, col0 = u.pn * HALF + wc * 32 + 8 * fq;
#pragma unroll
        for (int ai = 0; ai < 2; ++ai)
#pragma unroll
            for (int m = 0; m < 4; ++m) { bf16_t* rowp = O + (size_t)(row0 + ai * HALF + m * 16) * ldc + col0;
                f32x4 v0, v1;
#pragma unroll
                for (int i = 0; i < 4; ++i) { v0[i] = silu_f(acc[ai][0][m][0][i]) * acc[ai][1][m][0][i]; v1[i] = silu_f(acc[ai][0][m][1][i]) * acc[ai][1][m][1][i]; }
                u32x4 w; w.x = cvt_pk_bf16(v0[0], v0[1]); w.y = cvt_pk_bf16(v0[2], v0[3]); w.z = cvt_pk_bf16(v1[0], v1[1]); w.w = cvt_pk_bf16(v1[2], v1[3]);
                *(u32x4*)rowp = w; }
    }
};
struct EpiSwiGLU8 {
    static constexpr bool PERM = true, AFTER_DRAIN = false;
    unsigned char* O; int ldc;
    __device__ __forceinline__ void operator()(const f32x4 (&acc)[2][2][4][2], const Unit& u, int wr, int wc, int fr, int fq) const {
        const int row0 = u.pm * BM + wr * 64 + fr, col0 = u.pn * HALF + wc * 32 + 8 * fq; constexpr float si = 1.f / FP8_SW1;
#pragma unroll
        for (int ai = 0; ai < 2; ++ai)
#pragma unroll
            for (int m = 0; m < 4; ++m) { unsigned char* rowp = O + (size_t)(row0 + ai * HALF + m * 16) * ldc + col0;
                f32x4 v0, v1;
#pragma unroll
                for (int i = 0; i < 4; ++i) { v0[i] = silu_f(acc[ai][0][m][0][i] * si) * (acc[ai][1][m][0][i] * (si * FP8_SH)); v1[i] = silu_f(acc[ai][0][m][1][i] * si) * (acc[ai][1][m][1][i] * (si * FP8_SH)); }
                typedef unsigned u32x2 __attribute__((ext_vector_type(2))); u32x2 w; w.x = pk4_fp8(v0[0], v0[1], v0[2], v0[3]); w.y = pk4_fp8(v1[0], v1[1], v1[2], v1[3]);
                *(u32x2*)rowp = w; }
    }
};
__device__ __forceinline__ float logf_gate(float x, float la, float l1) {
    const float ls = fminf(x, 0.f) - __logf(1.0f + __expf(-fabsf(x)));
    const float b = l1 + ls;
    if (la == -INFINITY) return b;
    const float mx = fmaxf(la, b), d = fabsf(la - b);
    return mx + __logf(1.0f + __expf(-d));
}
struct EpiHgrnIn {
    static constexpr bool PERM = true, AFTER_DRAIN = false;
    unsigned char* ws; int layer;
    static constexpr size_t O_PQ = 580ull << 20, O_PI = O_PQ + (128ull << 20), O_PG = O_PQ + (256ull << 20), O_LF = O_PQ + (384ull << 20), O_LA = 1ull << 20, O_L1 = O_LA + 8192;
    __device__ __forceinline__ void operator()(const f32x4 (&acc)[2][2][4][2], const Unit& u, int wr, int wc, int fr, int fq) const {
        const int quarter = u.pn >> 2;
        const int row0 = u.pm * BM + wr * 64 + fr, col0 = (u.pn & 3) * BM + wc * 32 + 8 * fq;
        if (quarter == 1) {
            const float* la = (const float*)(ws + O_LA) + layer * 1024; const float* l1 = (const float*)(ws + O_L1) + layer * 1024; float* LF = (float*)(ws + O_LF);
            f32x4 A0[2][2], A1[2][2];
#pragma unroll
            for (int bj = 0; bj < 2; ++bj)
#pragma unroll
                for (int n = 0; n < 2; ++n) { A0[bj][n] = *(const f32x4*)(la + col0 + bj * HALF + 4 * n); A1[bj][n] = *(const f32x4*)(l1 + col0 + bj * HALF + 4 * n); }
#pragma unroll
            for (int ai = 0; ai < 2; ++ai)
#pragma unroll
                for (int m = 0; m < 4; ++m) { float* rowp = LF + (size_t)(row0 + ai * HALF + m * 16) * 1024 + col0;
#pragma unroll
                    for (int bj = 0; bj < 2; ++bj)
#pragma unroll
                        for (int n = 0; n < 2; ++n) { f32x4 o;
#pragma unroll
                            for (int i = 0; i < 4; ++i) o[i] = logf_gate(acc[ai][bj][m][n][i], A0[bj][n][i], A1[bj][n][i]);
                            *(f32x4*)(rowp + bj * HALF + 4 * n) = o; } }
        } else {
            bf16_t* O = (bf16_t*)(ws + (quarter == 0 ? O_PQ : (quarter == 2 ? O_PI : O_PG)));
#pragma unroll
            for (int ai = 0; ai < 2; ++ai)
#pragma unroll
                for (int m = 0; m < 4; ++m) { bf16_t* rowp = O + (size_t)(row0 + ai * HALF + m * 16) * 1024 + col0;
#pragma unroll
                    for (int bj = 0; bj < 2; ++bj) { f32x4 v0 = acc[ai][bj][m][0], v1 = acc[ai][bj][m][1];
                        if (quarter != 2) {
#pragma unroll
                            for (int i = 0; i < 4; ++i) { v0[i] = silu_f(v0[i]); v1[i] = silu_f(v1[i]); } }
                        u32x4 w; w.x = cvt_pk_bf16(v0[0], v0[1]); w.y = cvt_pk_bf16(v0[2], v0[3]); w.z = cvt_pk_bf16(v1[0], v1[1]); w.w = cvt_pk_bf16(v1[2], v1[3]);
                        *(u32x4*)(rowp + bj * HALF) = w; } }
        }
    }
};

template <class Epi, class Sched, bool ALIGN_EPI = false, bool SP2 = false, bool FP8 = false>
__device__ __forceinline__ void gemm_phase(PG8_LAS unsigned char* lds, const Gemm g, const Sched& S, const Epi& E, const int wave_id) {
    int lane_; asm volatile("v_mbcnt_lo_u32_b32 %0, -1, 0\n\tv_mbcnt_hi_u32_b32 %0, -1, %0" : "=v"(lane_));
    const int wid = wave_id, lane = lane_, tid = wid * 64 + lane, wr = wid >> 2, wc = wid & 3, fr = lane & 15, fq = lane >> 4;
    const int K = g.K, nt = K / BK, lda = g.lda;
    unsigned voffA[2], voffB[2];
#pragma unroll
    for (int i = 0; i < 2; ++i) { int R, C; stage_rc(tid * 16 + i * 8192, R, C); const int Rb = Epi::PERM ? ((R & ~31) + perm32(R & 31)) : R;
        voffA[i] = (unsigned)(R * lda + C) * 2u; voffB[i] = (unsigned)(Rb * K + C) * 2u; }
    const size_t kstep = (size_t)(BK * 2);
    const size_t hstep = (size_t)HALF * K * 2;
    const size_t tstep = 2 * hstep;
    const size_t hstepA = (size_t)HALF * lda * 2, tstepA = 2 * hstepA;
    const unsigned ldsw = (unsigned)wid * 1024u;
    const int aoff = lds_byte(wr * 64 + fr, fq * 8), boff = lds_byte(wc * 32 + fr, fq * 8);
#define PG8_SA(b, h) (((b) * 2 + (h)) * HTB)
#define PG8_SB(b, h) ((4 + (b) * 2 + (h)) * HTB)
#define PG8_STAGE(bufoff, gbase, voff) do { _Pragma("unroll") for (int _i = 0; _i < 2; ++_i) \
        __builtin_amdgcn_global_load_lds((const unsigned*)((const char*)(gbase) + (voff)[_i]), (PG8_LAS unsigned*)(lds + (bufoff) + ldsw + _i * 8192), 16, 0, 0); } while (0)
    typedef int i32x4_ __attribute__((ext_vector_type(4))); typedef int i32x8_ __attribute__((ext_vector_type(8)));
#define PG8_CAT(x, y) __builtin_shufflevector((x), (y), 0, 1, 2, 3, 4, 5, 6, 7)
#define PG8_LDA(dst, b, h) do { _Pragma("unroll") for (int m = 0; m < 4; ++m) { \
        if constexpr (FP8) dst##8[m] = PG8_CAT(*(const PG8_LAS i32x4_*)(lds + PG8_SA(b, h) + aoff + m * 2048), *(const PG8_LAS i32x4_*)(lds + PG8_SA(b, h) + aoff + m * 2048 + 1024)); \
        else { _Pragma("unroll") for (int k = 0; k < 2; ++k) dst[m][k] = *(const PG8_LAS bf16x8*)(lds + PG8_SA(b, h) + aoff + m * 2048 + k * 1024); } } } while (0)
#define PG8_LDB(dst, b, h) do { _Pragma("unroll") for (int n = 0; n < 2; ++n) { \
        if constexpr (FP8) dst##8[n] = PG8_CAT(*(const PG8_LAS i32x4_*)(lds + PG8_SB(b, h) + boff + n * 2048), *(const PG8_LAS i32x4_*)(lds + PG8_SB(b, h) + boff + n * 2048 + 1024)); \
        else { _Pragma("unroll") for (int k = 0; k < 2; ++k) dst[n][k] = *(const PG8_LAS bf16x8*)(lds + PG8_SB(b, h) + boff + n * 2048 + k * 1024); } } } while (0)
#define PG8_MMA(ai, bj, At, Bt) do { __builtin_amdgcn_s_setprio(1); _Pragma("unroll") for (int m = 0; m < 4; ++m) _Pragma("unroll") for (int n = 0; n < 2; ++n) { \
        if constexpr (FP8) asm volatile("v_mfma_scale_f32_16x16x128_f8f6f4 %0, %1, %2, %0, %3, %3 op_sel_hi:[0,0,0]" : "+v"(acc[ai][bj][m][n]) : "v"(Bt##8[n]), "v"(At##8[m]), "v"(f8scale_)); \
        else { _Pragma("unroll") for (int k = 0; k < 2; ++k) acc[ai][bj][m][n] = __builtin_amdgcn_mfma_f32_16x16x32_bf16(Bt[n][k], At[m][k], acc[ai][bj][m][n], 0, 0, 0); } } \
        __builtin_amdgcn_s_setprio(0); } while (0)
#define PG8_WAIT_V(n) asm volatile("s_waitcnt vmcnt(" #n ")" ::: "memory")
#define PG8_WAIT_L(n) asm volatile("s_waitcnt lgkmcnt(" #n ")" ::: "memory")
#define PG8_BAR __builtin_amdgcn_s_barrier()
#define PG8_SCHED __builtin_amdgcn_sched_barrier(0)
    Unit cur, nxt; int ui = 0;
    if (!S.next(0, cur)) return;
    f32x4 acc[2][2][4][2];
#pragma unroll
    for (int a = 0; a < 2; ++a)
#pragma unroll
        for (int b = 0; b < 2; ++b)
#pragma unroll
            for (int m = 0; m < 4; ++m)
#pragma unroll
                for (int n = 0; n < 2; ++n) acc[a][b][m][n] = (f32x4){0.f, 0.f, 0.f, 0.f};
    const int f8scale_ = 0x7f7f7f7f;
    bf16x8 At[4][2], B0[2][2], B1[2][2]; i32x8_ At8[4], B08[2], B18[2];
    const char* cA = (const char*)g.A + (size_t)cur.pm * tstepA; const char* cB = (const char*)g.Bt + (size_t)cur.e * g.estride + (size_t)cur.pn * tstep;
    S.a_ready(cur);
    if constexpr (SP2) {
        PG8_STAGE(PG8_SB(0, 0), cB, voffB); PG8_STAGE(PG8_SB(0, 1), cB + hstep, voffB); PG8_STAGE(PG8_SA(0, 0), cA, voffA); PG8_STAGE(PG8_SA(0, 1), cA + hstepA, voffA);
        if (wr == 1) PG8_BAR;
        PG8_WAIT_V(2); PG8_BAR;
        PG8_STAGE(PG8_SB(1, 0), cB + kstep, voffB); PG8_STAGE(PG8_SA(1, 0), cA + kstep, voffA); PG8_STAGE(PG8_SB(1, 1), cB + hstep + kstep, voffB);
        PG8_WAIT_V(6); PG8_BAR;
    } else {
        PG8_STAGE(PG8_SB(0, 0), cB, voffB); PG8_STAGE(PG8_SA(0, 0), cA, voffA); PG8_STAGE(PG8_SB(0, 1), cB + hstep, voffB); PG8_STAGE(PG8_SA(0, 1), cA + hstepA, voffA);
        if (wr == 1) PG8_BAR;
        PG8_WAIT_V(4); PG8_BAR;
        PG8_STAGE(PG8_SB(1, 0), cB + kstep, voffB); PG8_STAGE(PG8_SA(1, 0), cA + kstep, voffA); PG8_STAGE(PG8_SB(1, 1), cB + hstep + kstep, voffB);
        PG8_WAIT_V(6); PG8_BAR;
    }
    for (;;) {
        const bool has_next = S.next(ui + 1, nxt);
        const char* nA = has_next ? (const char*)g.A + (size_t)nxt.pm * tstepA : cA; const char* nB = has_next ? (const char*)g.Bt + (size_t)nxt.e * g.estride + (size_t)nxt.pn * tstep : cB;
        for (int t = 0; t < nt; t += 2) {
            const bool last = (t == nt - 2);
            const char* a1 = cA + (size_t)(t + 1) * kstep;
            const char* a2 = last ? nA : cA + (size_t)(t + 2) * kstep; const char* b2 = last ? nB : cB + (size_t)(t + 2) * kstep;
            const char* a3 = a2 + kstep; const char* b3 = b2 + kstep;
            if (last && has_next) S.a_ready(nxt);
            if constexpr (SP2) {
            PG8_LDB(B0, 0, 0); PG8_LDB(B1, 0, 1); PG8_SCHED; PG8_LDA(At, 0, 0); PG8_STAGE(PG8_SA(1, 1), a1 + hstepA, voffA);
            PG8_WAIT_V(8); PG8_WAIT_L(0); PG8_BAR; PG8_MMA(0, 0, At, B0); PG8_MMA(0, 1, At, B1); PG8_BAR; PG8_SCHED;
            PG8_LDA(At, 0, 1); PG8_STAGE(PG8_SB(0, 0), b2, voffB); PG8_STAGE(PG8_SB(0, 1), b2 + hstep, voffB); PG8_STAGE(PG8_SA(0, 0), a2, voffA);
            PG8_WAIT_V(8); PG8_WAIT_L(0); PG8_BAR; PG8_MMA(1, 0, At, B0); PG8_MMA(1, 1, At, B1); PG8_BAR; PG8_SCHED;
            PG8_LDB(B0, 1, 0); PG8_LDB(B1, 1, 1); PG8_SCHED; PG8_LDA(At, 1, 0); PG8_STAGE(PG8_SA(0, 1), a2 + hstepA, voffA);
            PG8_WAIT_V(8); PG8_WAIT_L(0); PG8_BAR; PG8_MMA(0, 0, At, B0); PG8_MMA(0, 1, At, B1); PG8_BAR; PG8_SCHED;
            PG8_LDA(At, 1, 1); PG8_STAGE(PG8_SB(1, 0), b3, voffB); PG8_STAGE(PG8_SB(1, 1), b3 + hstep, voffB); PG8_STAGE(PG8_SA(1, 0), a3, voffA);
            PG8_WAIT_V(8); PG8_WAIT_L(0); PG8_BAR; PG8_MMA(1, 0, At, B0); PG8_MMA(1, 1, At, B1); PG8_BAR; PG8_SCHED;
            } else {
            PG8_LDB(B0, 0, 0); PG8_SCHED; PG8_LDA(At, 0, 0); PG8_STAGE(PG8_SA(1, 1), a1 + hstepA, voffA);
            PG8_WAIT_L(8); PG8_BAR; PG8_WAIT_L(0); PG8_MMA(0, 0, At, B0); PG8_BAR; PG8_SCHED;
            PG8_LDB(B1, 0, 1); PG8_STAGE(PG8_SB(0, 0), b2, voffB);
            PG8_BAR; PG8_WAIT_L(0); PG8_MMA(0, 1, At, B1); PG8_BAR;
            PG8_LDA(At, 0, 1); PG8_STAGE(PG8_SA(0, 0), a2, voffA);
            PG8_BAR; PG8_WAIT_L(0); PG8_MMA(1, 0, At, B0); PG8_BAR; PG8_SCHED;
            PG8_STAGE(PG8_SB(0, 1), b2 + hstep, voffB);
            PG8_WAIT_V(6); PG8_BAR; PG8_MMA(1, 1, At, B1); PG8_BAR;
            PG8_LDB(B0, 1, 0); PG8_SCHED; PG8_LDA(At, 1, 0); PG8_STAGE(PG8_SA(0, 1), a2 + hstepA, voffA);
            PG8_WAIT_L(8); PG8_BAR; PG8_WAIT_L(0); PG8_MMA(0, 0, At, B0); PG8_BAR; PG8_SCHED;
            PG8_LDB(B1, 1, 1); PG8_STAGE(PG8_SB(1, 0), b3, voffB);
            PG8_BAR; PG8_WAIT_L(0); PG8_MMA(0, 1, At, B1); PG8_BAR;
            PG8_LDA(At, 1, 1); PG8_STAGE(PG8_SA(1, 0), a3, voffA);
            PG8_BAR; PG8_WAIT_L(0); PG8_MMA(1, 0, At, B0); PG8_BAR; PG8_SCHED;
            PG8_STAGE(PG8_SB(1, 1), b3 + hstep, voffB);
            PG8_WAIT_V(6); PG8_BAR; PG8_MMA(1, 1, At, B1); PG8_BAR;
            }
        }
        if constexpr (FP8) asm volatile("s_nop 15\n\ts_nop 15" ::: "memory");
        if constexpr (ALIGN_EPI) { if (wr == 0) PG8_BAR; }
        if constexpr (!Epi::AFTER_DRAIN) { E(acc, cur, wr, wc, fr, fq); S.done(cur); }
        if (!has_next) break;
#pragma unroll
        for (int a = 0; a < 2; ++a)
#pragma unroll
            for (int b = 0; b < 2; ++b)
#pragma unroll
                for (int m = 0; m < 4; ++m)
#pragma unroll
                    for (int n = 0; n < 2; ++n) acc[a][b][m][n] = (f32x4){0.f, 0.f, 0.f, 0.f};
        cur = nxt; cA = nA; cB = nB; ++ui;
        if constexpr (ALIGN_EPI) { if (wr == 1) PG8_BAR; }
    }
    PG8_WAIT_V(0);
    if constexpr (!ALIGN_EPI) { if (wr == 0) PG8_BAR; }
    PG8_BAR;
    if constexpr (Epi::AFTER_DRAIN) { E.fused(acc, cur, wr, wc, fr, fq, lds, wid, lane); S.done(cur); }
#undef PG8_SA
#undef PG8_SB
#undef PG8_STAGE
#undef PG8_LDA
#undef PG8_LDB
#undef PG8_MMA
#undef PG8_CAT
#undef PG8_WAIT_V
#undef PG8_WAIT_L
#undef PG8_BAR
#undef PG8_SCHED
}
}

constexpr int NT = 65536, DM = 1024, NBATCH = 32, SEQ = 2048;
constexpr int DFF = 2816, DFE = 3584, NEXP = 8;
constexpr int MOE_ROWS = 133120;
constexpr float EPS = 1e-6f;
constexpr size_t MiB = 1u << 20;
constexpr size_t WS_CTL = 0, CTL_ZERO_BYTES = 1 * MiB;
constexpr size_t WS_LA = 1 * MiB;
constexpr size_t WS_L1 = WS_LA + 8192;
constexpr size_t WS_CB = WS_LA + 16384;
constexpr size_t WS_RCNT = WS_LA + 32768;
constexpr size_t WS_RTAB = WS_LA + 65536;
constexpr size_t WS_ROUTE = 2 * MiB;
constexpr size_t WS_SLOT = 3 * MiB;
constexpr size_t WS_SELM = 4 * MiB;
constexpr size_t WS_GATES = 8 * MiB;
constexpr size_t WS_KC = 20 * MiB;
constexpr size_t WS_VCT = 22 * MiB;
constexpr size_t WS_HC = 24 * MiB;
constexpr size_t WS_W = 48 * MiB;
constexpr size_t W_HIN = WS_W, W_HOUT = WS_W + 16 * MiB, W_KVQ = WS_W + 20 * MiB, W_Q3 = WS_W + 26 * MiB, W_CMP1 = WS_W + 29 * MiB, W_NOUT = WS_W + 31 * MiB,
                 W_FGU = WS_W + 35 * MiB, W_FDN = WS_W + 57 * MiB, W_MGU = WS_W + 68 * MiB, W_MDN = WS_W + 292 * MiB;
constexpr size_t WS_XN = 452 * MiB;
constexpr size_t WS_R = 580 * MiB;
constexpr size_t R_PQ = WS_R, R_PI = WS_R + 128 * MiB, R_PG = WS_R + 256 * MiB, R_LF = WS_R + 384 * MiB, R_O2 = WS_R + 640 * MiB;
constexpr size_t R_HF = WS_R + 256 * MiB;
constexpr size_t R_KS = WS_R, R_KW = WS_R + 32 * MiB, R_VST = WS_R + 64 * MiB, R_VWT = WS_R + 96 * MiB, R_KCR = WS_R + 128 * MiB, R_VCR = WS_R + 160 * MiB;
constexpr size_t R_QKV = WS_R + 256 * MiB;
constexpr size_t R_Q = WS_R + 608 * MiB, R_O = WS_R + 736 * MiB;
constexpr size_t R_XP = WS_R, R_HM = WS_R + 260 * MiB;
constexpr size_t WS_NEED = R_HM + (size_t)MOE_ROWS * DFE * 2;
static_assert(WS_NEED <= 1792 * MiB, "workspace map");
static_assert(W_MDN + 112 * MiB <= WS_XN, "weights map");
static_assert(pg8::EpiHgrnIn::O_PQ == R_PQ && pg8::EpiHgrnIn::O_PI == R_PI && pg8::EpiHgrnIn::O_PG == R_PG && pg8::EpiHgrnIn::O_LF == R_LF && pg8::EpiHgrnIn::O_LA == WS_LA && pg8::EpiHgrnIn::O_L1 == WS_L1, "EpiHgrnIn offsets");

constexpr int LDS_BYTES = 147456;
constexpr int MISC_OFF = 131072 + 320;
constexpr int NWAVES = 8;

#define GAS __attribute__((address_space(1)))
#define LAS __attribute__((address_space(3)))
typedef unsigned short bf16;
typedef unsigned v4u __attribute__((ext_vector_type(4)));
typedef unsigned v2u __attribute__((ext_vector_type(2)));
typedef float f32x4 __attribute__((ext_vector_type(4)));
#define LDS_WAIT() asm volatile("s_waitcnt lgkmcnt(0)" ::: "memory")
__device__ __forceinline__ unsigned f2bf(float f) { unsigned u = __builtin_bit_cast(unsigned, f); return (u + 0x7fffu + ((u >> 16) & 1u)) >> 16; }
__device__ __forceinline__ unsigned pk2(float lo, float hi) { return f2bf(lo) | (f2bf(hi) << 16); }
__device__ __forceinline__ float bf2f(unsigned b) { return __builtin_bit_cast(float, b << 16); }
__device__ __forceinline__ float bflo(unsigned w) { return __builtin_bit_cast(float, w << 16); }
__device__ __forceinline__ float bfhi(unsigned w) { return __builtin_bit_cast(float, w & 0xffff0000u); }
__device__ __forceinline__ float wave_sum(float v) {
#pragma unroll
    for (int o = 32; o >= 1; o >>= 1) v += __shfl_xor(v, o);
    return v;
}
__device__ __forceinline__ float wave_max(float v) {
#pragma unroll
    for (int o = 32; o >= 1; o >>= 1) v = fmaxf(v, __shfl_xor(v, o));
    return v;
}

#define XB_TMO      128
#define XB_XCNT(j)  (256  + 64 * (j))
#define XB_XSUB(j)  (1280 + 64 * (j))
#define XB_XGEN(j)  (2304 + 64 * (j))
#define XB_TOP      3328
#define XB_TOPGEN   3392
#define XCD_BAR_WORDS 3456
#define XB_SPIN_CAP (1u << 22)
__device__ __forceinline__ unsigned xb_ld(unsigned* p)              { return __hip_atomic_load(p, __ATOMIC_RELAXED, __HIP_MEMORY_SCOPE_AGENT); }
__device__ __forceinline__ unsigned xb_add(unsigned* p, unsigned v) { return __hip_atomic_fetch_add(p, v, __ATOMIC_RELAXED, __HIP_MEMORY_SCOPE_AGENT); }
__device__ __forceinline__ unsigned xb_xcc_id() { return (unsigned)__builtin_amdgcn_s_getreg((3 << 11) | 20) & 0xFu; }
#define XB_SPIN(cond, bar) do { unsigned _sp = 0; while (cond) { __builtin_amdgcn_s_sleep(1); \
    if ((++_sp & 255u) == 0u) { if (xb_ld(&(bar)[XB_TMO])) break; if (_sp > XB_SPIN_CAP) { atomicAdd(&(bar)[XB_TMO], 1u); break; } } } } while (0)
struct XcdBarrier { unsigned* bar; unsigned x; volatile LAS unsigned* st; };
__device__ __forceinline__ XcdBarrier xcd_barrier_post(unsigned* bar, volatile LAS unsigned* st) {
    XcdBarrier b; b.bar = bar; b.x = xb_xcc_id(); b.st = st;
    if (threadIdx.x == 0) (void)xb_add(&bar[XB_XCNT(b.x)], 1u);
    return b;
}
__device__ __forceinline__ void xcd_barrier_complete(unsigned* bar, unsigned x, unsigned& nloc, unsigned& nx) {
    const unsigned G = gridDim.x * gridDim.y * gridDim.z;
    unsigned sum, cnt, mine, sp = 0u;
    for (;;) {
        sum = 0u; cnt = 0u; mine = 0u;
#pragma unroll
        for (unsigned j = 0; j < 16; ++j) { const unsigned c = xb_ld(&bar[XB_XCNT(j)]); sum += c; cnt += (c > 0u) ? 1u : 0u; mine = (j == x) ? c : mine; }
        if (sum == G) break;
        __builtin_amdgcn_s_sleep(1);
        if ((++sp & 255u) == 0u) { if (xb_ld(&bar[XB_TMO])) break; if (sp > XB_SPIN_CAP) { atomicAdd(&bar[XB_TMO], 1u); break; } }
    }
    nloc = mine > 0u ? mine : 1u; nx = cnt > 0u ? cnt : 1u;
}
__device__ __forceinline__ void xcd_barrier(const XcdBarrier& b) {
    asm volatile("s_waitcnt vmcnt(0)" ::: "memory");
    __syncthreads();
    if (threadIdx.x == 0) {
        unsigned* bar = b.bar; unsigned bx_ = b.x; asm volatile("" : "+s"(bar), "+s"(bx_));
        __builtin_amdgcn_s_waitcnt(0);
        unsigned nloc = b.st[0], nx = b.st[1];
        if (nloc == 0u) { xcd_barrier_complete(bar, bx_, nloc, nx); b.st[0] = nloc; b.st[1] = nx; }
        const unsigned old = xb_add(&bar[XB_XSUB(bx_)], 1u);
        const unsigned gen = old / nloc;
        if (old + 1u == (gen + 1u) * nloc) {
            __builtin_amdgcn_fence(__ATOMIC_RELEASE, "agent");
            asm volatile("s_waitcnt vmcnt(0)" ::: "memory");
            const unsigned og = xb_add(&bar[XB_TOP], 1u);
            const unsigned tg = og / nx;
            if (og + 1u == (tg + 1u) * nx) xb_add(&bar[XB_TOPGEN], 1u);
            else XB_SPIN(xb_ld(&bar[XB_TOPGEN]) == tg, bar);
            __builtin_amdgcn_fence(__ATOMIC_ACQUIRE, "agent");
            xb_add(&bar[XB_XGEN(bx_)], 1u);
            asm volatile("s_waitcnt vmcnt(0)" ::: "memory");
        } else {
            XB_SPIN(xb_ld(&bar[XB_XGEN(bx_)]) == gen, bar);
            __builtin_amdgcn_fence(__ATOMIC_ACQUIRE, "agent");
            asm volatile("s_waitcnt vmcnt(0)" ::: "memory");
        }
    }
    __syncthreads();
}

struct Ctx {
    LAS unsigned char* lds;
    int tid, lane, wave, G, bid;
    float* out; unsigned char* ws;
    __device__ __forceinline__ const float* inp(int i) const {
        const __attribute__((address_space(4))) unsigned char* kp = (const __attribute__((address_space(4))) unsigned char*)__builtin_amdgcn_kernarg_segment_ptr();
        asm volatile("" : "+s"(kp));
        return ((const float* const __attribute__((address_space(4)))*)kp)[i];
    }
};
enum { I_X = 0, I_NMIX, I_NFFN, I_HWIN, I_HWOUT, I_HGN, I_HLB, I_KVN, I_KVW, I_CPK, I_CW1K, I_CW2K, I_CPV, I_CW1V, I_CW2V, I_KN, I_NWIN, I_NWOUT, I_NQN, I_FGU, I_FDN, I_MR, I_MGU, I_MDN };

constexpr int MAXJOB = 64;
struct JobTab { unsigned long long src[MAXJOB], gain[MAXJOB], dst[MAXJOB]; int K[MAXJOB], Nsrc[MAXJOB], npb[MAXJOB], F[MAXJOB], rowoff[MAXJOB], istart[MAXJOB + 1]; float f8s[MAXJOB]; int njobs; };
__device__ __forceinline__ void add_job(LAS JobTab* J, const float* src, const float* gain, bf16* dst, int K, int Nsrc, int Npad, int F, int rowoff, float f8s = 0.f) {
    const int j = J->njobs; J->src[j] = (unsigned long long)src; J->gain[j] = (unsigned long long)gain; J->dst[j] = (unsigned long long)dst;
    J->K[j] = K; J->Nsrc[j] = Nsrc; J->npb[j] = Npad / 32; J->F[j] = F; J->rowoff[j] = rowoff; J->f8s[j] = f8s; J->istart[j + 1] = J->istart[j] + (K / 64) * (Npad / 32); J->njobs = j + 1;
}
__device__ __forceinline__ void transpose_item(const float* W, int K, int Nsrc, const float* gain, bf16* WT, int dstrow0, int k0, int n0, LAS float* scr, int lane, float f8s) {
    const int c4 = lane & 7, kr = lane >> 3, n = n0 + 4 * c4; const bool okn = n < Nsrc;
    f32x4 v[8];
#pragma unroll
    for (int i = 0; i < 8; ++i) { const int kk = 8 * i + kr; v[i] = okn ? *(const f32x4*)(W + (size_t)(k0 + kk) * Nsrc + n) : (f32x4){0.f, 0.f, 0.f, 0.f}; }
#pragma unroll
    for (int i = 0; i < 8; ++i) { const int kk = 8 * i + kr; if (gain) v[i] = v[i] * gain[k0 + kk]; *(LAS f32x4*)(scr + kk * 36 + 4 * c4) = v[i]; }
    LDS_WAIT();
    const int c = lane & 7;
#pragma unroll
    for (int j = 0; j < 4; ++j) { const int nn = (lane >> 3) + 8 * j; const LAS float* s = scr + (8 * c) * 36 + nn;
        if (f8s != 0.f) { v2u o; o.x = pg8::pk4_fp8(s[0 * 36] * f8s, s[1 * 36] * f8s, s[2 * 36] * f8s, s[3 * 36] * f8s); o.y = pg8::pk4_fp8(s[4 * 36] * f8s, s[5 * 36] * f8s, s[6 * 36] * f8s, s[7 * 36] * f8s);
            *(v2u*)((unsigned char*)WT + (size_t)(dstrow0 + nn) * K + k0 + 8 * c) = o; }
        else { v4u o; o.x = pk2(s[0 * 36], s[1 * 36]); o.y = pk2(s[2 * 36], s[3 * 36]); o.z = pk2(s[4 * 36], s[5 * 36]); o.w = pk2(s[6 * 36], s[7 * 36]);
            *(v4u*)(WT + (size_t)(dstrow0 + nn) * K + k0 + 8 * c) = o; } }
    LDS_WAIT();
}
__device__ __forceinline__ void norm_row_store(const f32x4 (&v)[4], bf16* orow, int lane) {
    float s = 0.f;
#pragma unroll
    for (int j = 0; j < 4; ++j) s += (v[j].x * v[j].x + v[j].y * v[j].y) + (v[j].z * v[j].z + v[j].w * v[j].w);
    const float rstd = rsqrtf(wave_sum(s) * (1.f / DM) + EPS);
    v2u* o8 = (v2u*)orow + lane;
#pragma unroll
    for (int j = 0; j < 4; ++j) { v2u w; w.x = pk2(v[j].x * rstd, v[j].y * rstd); w.y = pk2(v[j].z * rstd, v[j].w * rstd); o8[64 * j] = w; }
}
__device__ __forceinline__ void p_prologue(Ctx& C) {
    LAS JobTab* J = (LAS JobTab*)(C.lds + 73728);
    unsigned char* ws = C.ws;
    if (C.tid == 0) {
        J->njobs = 0; J->istart[0] = 0;
        for (int l = 0; l < 2; ++l) add_job(J, C.inp(I_HWIN) + (size_t)l * 1024 * 4096, C.inp(I_NMIX) + l * 1024, (bf16*)(ws + W_HIN) + (size_t)l * 4096 * 1024, 1024, 4096, 4096, 0, 0);
        for (int l = 0; l < 2; ++l) add_job(J, C.inp(I_HWOUT) + (size_t)l * 1024 * 1024, nullptr, (bf16*)(ws + W_HOUT) + (size_t)l * 1024 * 1024, 1024, 1024, 1024, 0, 0);
        add_job(J, C.inp(I_KVW), C.inp(I_KVN), (bf16*)(ws + W_KVQ), 1024, 1536, 1536, 0, 0);
        add_job(J, C.inp(I_NWIN), C.inp(I_NMIX) + 2048, (bf16*)(ws + W_KVQ), 1024, 1072, 1280, 0, 1536);
        add_job(J, C.inp(I_NWIN) + (size_t)1024 * 1072, C.inp(I_NMIX) + 3072, (bf16*)(ws + W_Q3), 1024, 1072, 1280, 0, 0);
        add_job(J, C.inp(I_CW1K), nullptr, (bf16*)(ws + W_CMP1), 2048, 256, 256, 0, 0);
        add_job(J, C.inp(I_CW1V), nullptr, (bf16*)(ws + W_CMP1) + (size_t)256 * 2048, 2048, 256, 256, 0, 0);
        for (int l = 0; l < 2; ++l) add_job(J, C.inp(I_NWOUT) + (size_t)l * 1024 * 1024, nullptr, (bf16*)(ws + W_NOUT) + (size_t)l * 1024 * 1024, 1024, 1024, 1024, 0, 0);
        for (int l = 0; l < 2; ++l) add_job(J, C.inp(I_FGU) + (size_t)l * 1024 * 2 * DFF, C.inp(I_NFFN) + (2 * l) * 1024, (bf16*)(ws + W_FGU + (size_t)l * 2 * DFF * 2048), 1024, 2 * DFF, 2 * DFF, DFF, 0, l ? pg8::FP8_SW1 : 0.f);
        for (int l = 0; l < 2; ++l) add_job(J, C.inp(I_FDN) + (size_t)l * DFF * 1024, nullptr, (bf16*)(ws + W_FDN + (size_t)l * 1024 * DFF * 2), DFF, 1024, 1024, 0, 0, l ? pg8::FP8_SW2 : 0.f);
        for (int l = 0; l < 16; ++l) add_job(J, C.inp(I_MGU) + (size_t)l * 1024 * 2 * DFE, C.inp(I_NFFN) + (2 * (l >> 3) + 1) * 1024, (bf16*)(ws + W_MGU + (size_t)l * 2 * DFE * 1024), 1024, 2 * DFE, 2 * DFE, DFE, 0, pg8::FP8_SW1);
        for (int l = 0; l < 16; ++l) add_job(J, C.inp(I_MDN) + (size_t)l * DFE * 1024, nullptr, (bf16*)(ws + W_MDN + (size_t)l * 1024 * DFE), DFE, 1024, 1024, 0, 0, pg8::FP8_SW2);
    }
    __syncthreads();
    LAS float* scr = (LAS float*)(C.lds + C.wave * 9216);
    const int gw = C.bid * NWAVES + C.wave, NGW = C.G * NWAVES;
    const int nj = J->njobs, total = J->istart[nj];
    for (int it = gw; it < total; it += NGW) {
        int j = 0; while (j + 1 < nj && J->istart[j + 1] <= it) ++j;
        const int r = it - J->istart[j], npb = J->npb[j], kb = r / npb, nb = r % npb, n0 = 32 * nb, F = J->F[j];
        int drow = J->rowoff[j] + n0;
        if (F) drow = (n0 < F) ? 256 * (n0 / 128) + (n0 % 128) : 256 * ((n0 - F) / 128) + 128 + ((n0 - F) % 128);
        transpose_item((const float*)J->src[j], J->K[j], J->Nsrc[j], (const float*)J->gain[j], (bf16*)J->dst[j], drow, 64 * kb, n0, scr, C.lane, J->f8s[j]);
    }
    { const int gt = C.bid * 512 + C.tid;
      if (gt < 1024) { const float a0 = C.inp(I_HLB)[gt], a1 = C.inp(I_HLB)[1024 + gt]; const float mx = fmaxf(a0, a1), e0 = expf(a0 - mx), e1 = expf(a1 - mx), s = e0 + e1;
          const float s0 = e0 / s, s1 = e1 / s, lb1 = (s0 + s1) - s0;
          float* la = (float*)(ws + WS_LA); float* l1 = (float*)(ws + WS_L1);
          la[gt] = -INFINITY; l1[gt] = 0.f; la[1024 + gt] = logf(lb1); l1[1024 + gt] = log1pf(-lb1); } }
    if (C.bid == 0 && C.tid < 128) ((int*)(ws + WS_RTAB))[2048 + C.tid] = C.tid >> 6;
    if (C.G >= 8 && C.bid >= C.G - 8) { const int ob = (C.bid - (C.G - 8)) * 64 + C.lane, which = ob >> 8, j = ob & 255; const float* pos = C.inp(which ? I_CPV : I_CPK); const float* w1 = C.inp(which ? I_CW1V : I_CW1K);
        float a = 0.f;
#pragma unroll 8
        for (int i = C.wave * 256; i < C.wave * 256 + 256; ++i) a += pos[i] * w1[(size_t)i * 256 + j];
        __syncthreads();
        LAS float* red = (LAS float*)(C.lds + 80 * 1024); red[C.wave * 64 + C.lane] = a;
        __syncthreads();
        if (C.wave == 0) { float t = 0.f;
#pragma unroll
            for (int w = 0; w < 8; ++w) t += red[w * 64 + C.lane];
            ((float*)(ws + WS_CB))[ob] = t; } }
    for (int c = C.bid; c < 256; c += C.G)
        for (int i = 0; i < 32; i += 4) { f32x4 v[4][4]; const float* xb = C.inp(I_X);
#pragma unroll
            for (int r = 0; r < 4; ++r) { const f32x4* xr = (const f32x4*)(xb + (size_t)(c * 256 + C.wave * 32 + i + r) * DM) + C.lane;
#pragma unroll
                for (int j = 0; j < 4; ++j) v[r][j] = xr[64 * j]; }
#pragma unroll
            for (int r = 0; r < 4; ++r) norm_row_store(v[r], (bf16*)(ws + WS_XN) + (size_t)(c * 256 + C.wave * 32 + i + r) * DM, C.lane); }
}

template <bool MOE_ADD, bool ROUTER, bool WRITE_XN, bool XN_FP8 = false>
__device__ __forceinline__ void p_norm(Ctx& C, const float* rw, const float* rgain) {
    unsigned char* ws = C.ws;
    LAS int* cnt8 = (LAS int*)(C.lds + 1024);
    const bf16* Y = (const bf16*)(ws + R_XP);
    const int4* route = (const int4*)(ws + WS_ROUTE); const int2* slot = (const int2*)(ws + WS_SLOT);
    constexpr int NR = (MOE_ADD || ROUTER) ? 2 : 4;
    for (int c = C.bid; c < 256; c += C.G) {
        if (ROUTER) { __syncthreads(); if (C.tid < 8) cnt8[C.tid] = 0; __syncthreads(); }
#pragma unroll 1
        for (int i = 0; i < 32; i += NR) {
            f32x4 v[NR][4];
#pragma unroll
            for (int r = 0; r < NR; ++r) { const float* hr = C.out + (size_t)(c * 256 + C.wave * 32 + i + r) * DM;
#pragma unroll
                for (int j = 0; j < 4; ++j) v[r][j] = ((const f32x4*)hr + C.lane)[64 * j]; }
            if (MOE_ADD) {
#pragma unroll
                for (int r = 0; r < NR; ++r) { const int row = c * 256 + C.wave * 32 + i + r; float* hr = C.out + (size_t)row * DM;
                    const int4 rt = route[row]; const int2 sl = slot[row]; const float w0 = __builtin_bit_cast(float, rt.y), w1 = __builtin_bit_cast(float, rt.z);
                    const v2u* y0 = (const v2u*)(Y + (size_t)sl.x * DM) + C.lane; const v2u* y1 = (const v2u*)(Y + (size_t)sl.y * DM) + C.lane;
#pragma unroll
                    for (int j = 0; j < 4; ++j) { const v2u a = y0[64 * j], b = y1[64 * j];
                        v[r][j].x += w0 * bflo(a.x) + w1 * bflo(b.x); v[r][j].y += w0 * bfhi(a.x) + w1 * bfhi(b.x); v[r][j].z += w0 * bflo(a.y) + w1 * bflo(b.y); v[r][j].w += w0 * bfhi(a.y) + w1 * bfhi(b.y);
                        ((f32x4*)hr + C.lane)[64 * j] = v[r][j]; } }
            }
            if (WRITE_XN || ROUTER) {
#pragma unroll
                for (int r = 0; r < NR; ++r) { const int row = c * 256 + C.wave * 32 + i + r;
                    float s = 0.f;
#pragma unroll
                    for (int j = 0; j < 4; ++j) s += (v[r][j].x * v[r][j].x + v[r][j].y * v[r][j].y) + (v[r][j].z * v[r][j].z + v[r][j].w * v[r][j].w);
                    const float rstd = rsqrtf(wave_sum(s) * (1.f / DM) + EPS);
                    if (WRITE_XN && XN_FP8) { unsigned* o4 = (unsigned*)(ws + WS_XN + (size_t)row * DM) + C.lane;
#pragma unroll
                        for (int j = 0; j < 4; ++j) o4[64 * j] = pg8::pk4_fp8(v[r][j].x * rstd, v[r][j].y * rstd, v[r][j].z * rstd, v[r][j].w * rstd); }
                    if (WRITE_XN && !XN_FP8) { v2u* o8 = (v2u*)((bf16*)(ws + WS_XN) + (size_t)row * DM) + C.lane;
#pragma unroll
                        for (int j = 0; j < 4; ++j) { v2u w; w.x = pk2(v[r][j].x * rstd, v[r][j].y * rstd); w.y = pk2(v[r][j].z * rstd, v[r][j].w * rstd); o8[64 * j] = w; } }
                    if (ROUTER) {
                        float lg[8];
#pragma unroll
                        for (int e = 0; e < 8; ++e) lg[e] = 0.f;
#pragma unroll
                        for (int j = 0; j < 4; ++j) { const int k0 = 4 * C.lane + 256 * j; const f32x4 g4 = *(const f32x4*)(rgain + k0);
#pragma unroll
                            for (int q = 0; q < 4; ++q) { const float xv = v[r][j][q] * rstd * g4[q]; const f32x4 wa = *(const f32x4*)(rw + (size_t)(k0 + q) * 8), wb = *(const f32x4*)(rw + (size_t)(k0 + q) * 8 + 4);
                                lg[0] += xv * wa.x; lg[1] += xv * wa.y; lg[2] += xv * wa.z; lg[3] += xv * wa.w; lg[4] += xv * wb.x; lg[5] += xv * wb.y; lg[6] += xv * wb.z; lg[7] += xv * wb.w; } }
#pragma unroll
                        for (int e = 0; e < 8; ++e) lg[e] = wave_sum(lg[e]);
                        int e0 = 0; float v0 = lg[0];
#pragma unroll
                        for (int e = 1; e < 8; ++e) if (lg[e] > v0) { v0 = lg[e]; e0 = e; }
                        int e1 = -1; float v1 = -INFINITY;
#pragma unroll
                        for (int e = 0; e < 8; ++e) if (e != e0 && (e1 < 0 || lg[e] > v1)) { v1 = lg[e]; e1 = e; }
                        const float ex = expf(v1 - v0), w0 = 1.f / (1.f + ex), w1 = ex / (1.f + ex);
                        if (C.lane == 0) { ((int4*)(ws + WS_ROUTE))[row] = make_int4(e0 | (e1 << 8), __builtin_bit_cast(int, w0), __builtin_bit_cast(int, w1), 0);
                            atomicAdd((int*)&cnt8[e0], 1); atomicAdd((int*)&cnt8[e1], 1); }
                    }
                }
            }
        }
        if (ROUTER) { __syncthreads(); if (C.tid < 8) ((int*)(ws + WS_RCNT))[c * 8 + C.tid] = cnt8[C.tid]; }
    }
}

__device__ __forceinline__ void p_gather(Ctx& C) {
    unsigned char* ws = C.ws;
    LAS int* tot = (LAS int*)(C.lds + 0);
    LAS int* pre = tot + 8;
    LAS int* base = tot + 16;
    LAS int* ee = tot + 32;
    LAS int* sl = tot + 32 + 256;
    const int* rcnt = (const int*)(ws + WS_RCNT);
    const int4* route = (const int4*)(ws + WS_ROUTE);
    for (int c = C.bid; c < 256; c += C.G) {
        __syncthreads();
        { const int e = C.wave; int t = 0, p = 0;
          for (int i = C.lane; i < 256; i += 64) { const int v = rcnt[i * 8 + e]; t += v; if (i < c) p += v; }
#pragma unroll
          for (int o = 32; o >= 1; o >>= 1) { t += __shfl_xor(t, o); p += __shfl_xor(p, o); }
          if (C.lane == 0) { tot[e] = t; pre[e] = p; } }
        if (C.tid < 256) ee[C.tid] = route[c * 256 + C.tid].x;
        __syncthreads();
        if (C.tid == 0) { int off = 0; for (int e = 0; e < 8; ++e) { base[e] = off + pre[e]; const int nt = (tot[e] + 255) >> 8;
                if (c == 0) { int* te = (int*)(ws + WS_RTAB); for (int q = 0; q < nt; ++q) te[(off >> 8) + q] = e; }
                off += nt << 8; }
            if (c == 0) ((int*)(ws + WS_RTAB))[1024] = off >> 8; }
        __syncthreads();
        if (C.tid < 8) { const int e = C.tid; int r = base[e];
            for (int i = 0; i < 256; ++i) { const int pk = ee[i]; if ((pk & 255) == e) sl[2 * i] = r++; if ((pk >> 8) == e) sl[2 * i + 1] = r++; } }
        __syncthreads();
        if (C.tid < 256) ((int2*)(ws + WS_SLOT))[c * 256 + C.tid] = make_int2(sl[2 * C.tid], sl[2 * C.tid + 1]);
        for (int i = 0; i < 32; i += 4) { v4u a[4];
#pragma unroll
            for (int r = 0; r < 4; ++r) a[r] = *((const v4u*)(ws + WS_XN + (size_t)(c * 256 + C.wave * 32 + i + r) * DM) + C.lane);
#pragma unroll
            for (int r = 0; r < 4; ++r) { const int tl = C.wave * 32 + i + r;
                *((v4u*)(ws + R_XP + (size_t)sl[2 * tl] * DM) + C.lane) = a[r]; *((v4u*)(ws + R_XP + (size_t)sl[2 * tl + 1] * DM) + C.lane) = a[r]; } }
    }
}

__device__ __forceinline__ void p_post_kv(Ctx& C) {
    unsigned char* ws = C.ws;
    const bf16* raw = (const bf16*)(ws + R_QKV);
    const float* kn = C.inp(I_KN);
    LAS unsigned char* tl = C.lds + C.wave * 4608;
    const int l = C.lane, c8 = l & 7, r8 = l >> 3, gw = C.bid * NWAVES + C.wave, NGW = C.G * NWAVES;
    for (int it = gw; it < 128 * 64; it += NGW) {
        const int bg = it >> 6, blk = it & 63, b = bg >> 2, g = bg & 3;
        const bf16* rb = raw + (size_t)(b * SEQ + blk * 32) * 2816 + g * 64 + 8 * c8;
        const size_t dst0 = ((size_t)bg * SEQ + blk * 32) * 64 + 8 * c8;
#pragma unroll
        for (int j = 0; j < 6; ++j) {
            v4u x[4];
#pragma unroll
            for (int i = 0; i < 4; ++i) x[i] = *(const v4u*)(rb + (size_t)(r8 + 8 * i) * 2816 + j * 256);
            if (j == 0 || j == 1) {
                bf16* d = (bf16*)(ws + (j == 0 ? R_KCR : R_VCR)) + dst0;
#pragma unroll
                for (int i = 0; i < 4; ++i) *(v4u*)(d + (size_t)(r8 + 8 * i) * 64) = x[i];
            } else if (j == 2 || j == 4) {
                bf16* d = (bf16*)(ws + (j == 2 ? R_KS : R_KW)) + ((size_t)bg * SEQ + blk * 32) * 64 + (c8 >> 2) * 1024 + (c8 & 3) * 8; const float* gk = kn + (j == 2 ? 64 : 128) + 8 * c8;
                const f32x4 ga = *(const f32x4*)gk, gb = *(const f32x4*)(gk + 4);
#pragma unroll
                for (int i = 0; i < 4; ++i) { const float f[8] = {bflo(x[i].x), bfhi(x[i].x), bflo(x[i].y), bfhi(x[i].y), bflo(x[i].z), bfhi(x[i].z), bflo(x[i].w), bfhi(x[i].w)};
                    float ss = (f[0] * f[0] + f[1] * f[1]) + (f[2] * f[2] + f[3] * f[3]) + (f[4] * f[4] + f[5] * f[5]) + (f[6] * f[6] + f[7] * f[7]);
                    ss += __shfl_xor(ss, 1); ss += __shfl_xor(ss, 2); ss += __shfl_xor(ss, 4);
                    const float rs = rsqrtf(ss * (1.f / 64.f) + EPS);
                    v4u o; o.x = pk2(f[0] * rs * ga.x, f[1] * rs * ga.y); o.y = pk2(f[2] * rs * ga.z, f[3] * rs * ga.w); o.z = pk2(f[4] * rs * gb.x, f[5] * rs * gb.y); o.w = pk2(f[6] * rs * gb.z, f[7] * rs * gb.w);
                    *(v4u*)(d + (size_t)(r8 + 8 * i) * 32) = o; }
            } else {
#pragma unroll
                for (int i = 0; i < 4; ++i) *(LAS v4u*)(tl + (r8 + 8 * i) * 144 + 16 * c8) = x[i];
                LDS_WAIT();
                unsigned wv[16];
#pragma unroll
                for (int t2 = 0; t2 < 16; ++t2) { const unsigned lo = *(const LAS bf16*)(tl + (2 * t2) * 144 + 2 * l), hi = *(const LAS bf16*)(tl + (2 * t2 + 1) * 144 + 2 * l); wv[t2] = lo | (hi << 16); }
                bf16* d = (bf16*)(ws + (j == 3 ? R_VST : R_VWT)) + (((size_t)bg * 64 + blk) * 64 + l) * 32;
#pragma unroll
                for (int q = 0; q < 4; ++q) { const v4u o = {wv[4 * q], wv[4 * q + 1], wv[4 * q + 2], wv[4 * q + 3]}; *(v4u*)(d + 8 * q) = o; }
                LDS_WAIT();
            }
        }
    }
}

__device__ __forceinline__ void p_cmp2(Ctx& C) {
    unsigned char* ws = C.ws;
    const bf16* Hk = (const bf16*)(ws + WS_HC); const bf16* Hv = Hk + (size_t)16384 * 256;
    const float* w2k = C.inp(I_CW2K); const float* w2v = C.inp(I_CW2V); const float* kn = C.inp(I_KN);
    LAS float* hk = (LAS float*)(C.lds + C.wave * 2048); LAS float* hv = hk + 256;
    const int l = C.lane, gw = C.bid * NWAVES + C.wave, NGW = C.G * NWAVES;
    for (int r = gw; r < 16384; r += NGW) {
        const int bg = r >> 7, c = r & 127;
        { const v2u a = *((const v2u*)(Hk + (size_t)r * 256) + l), bq = *((const v2u*)(Hv + (size_t)r * 256) + l);
          hk[4 * l] = bflo(a.x); hk[4 * l + 1] = bfhi(a.x); hk[4 * l + 2] = bflo(a.y); hk[4 * l + 3] = bfhi(a.y);
          hv[4 * l] = bflo(bq.x); hv[4 * l + 1] = bfhi(bq.x); hv[4 * l + 2] = bflo(bq.y); hv[4 * l + 3] = bfhi(bq.y); }
        LDS_WAIT();
        float ak = 0.f, av = 0.f;
#pragma unroll 8
        for (int j = 0; j < 256; ++j) { ak += hk[j] * w2k[j * 64 + l]; av += hv[j] * w2v[j * 64 + l]; }
        if (c == 127) { ak = 0.f; av = 0.f; }
        const float rs = rsqrtf(wave_sum(ak * ak) * (1.f / 64.f) + EPS);
        ((bf16*)(ws + WS_KC))[((size_t)bg * 128 + 32 * (c >> 5)) * 64 + (l >> 5) * 1024 + (c & 31) * 32 + (l & 31)] = (bf16)f2bf(ak * rs * kn[l]);
        ((bf16*)(ws + WS_VCT))[(((size_t)bg * 4 + (c >> 5)) * 64 + l) * 32 + (c & 31)] = (bf16)f2bf(av);
        LDS_WAIT();
    }
}

typedef short bf16x8v __attribute__((ext_vector_type(8)));
#define MFMA16(a, b, c) __builtin_amdgcn_mfma_f32_16x16x32_bf16((a), (b), (c), 0, 0, 0)
constexpr float LOG2E = 1.4426950408889634f;
__device__ __forceinline__ float xmax_q4(float v) {
    float t;
    asm volatile("v_mov_b32 %1, %0\n\ts_nop 1\n\tv_permlane16_swap_b32 %0, %1\n\ts_nop 1\n\tv_max_f32 %0, %0, %1\n\tv_mov_b32 %1, %0\n\ts_nop 1\n\tv_permlane32_swap_b32 %0, %1\n\ts_nop 1\n\tv_max_f32 %0, %0, %1" : "+v"(v), "=&v"(t));
    return v;
}
struct AttFrag { bf16x8v ka[2], kb[2]; };
__device__ __forceinline__ void attn_load(AttFrag& f, const bf16* __restrict__ Kb, unsigned koff, int k0) {
    const char* kblk = (const char*)(Kb + (size_t)k0 * 64);
#pragma unroll
    for (int ks = 0; ks < 2; ++ks) { f.ka[ks] = *(const bf16x8v*)(kblk + koff + 2048 * ks); f.kb[ks] = *(const bf16x8v*)(kblk + koff + 256 + 2048 * ks); }
}
template <int MODE, int PATH>
__device__ __forceinline__ void attn_step(const bf16* __restrict__ Kb, unsigned koff, const bf16* __restrict__ Vb, unsigned voff, int k0, int trel, bool tk, int cmax,
                                          const bf16x8v (&qf)[2][2], const f32x4 (&bv)[2][2], const bf16x8v ones, float (&m)[2], f32x4 (&ls)[2], f32x4 (&o)[2][4], const float (&sl2)[2], int q4) {
    AttFrag f; attn_load(f, Kb, koff, k0);
    bf16x8v vf[4]; { const char* vblk = (const char*)(Vb + (size_t)k0 * 64);
#pragma unroll
        for (int dt = 0; dt < 4; ++dt) vf[dt] = *(const bf16x8v*)(vblk + voff + 1024 * dt); }
    constexpr int DMUL = (MODE == 0) ? 16 : 1;
    const float trelf = (float)trel;
    bool ok[8];
    if (PATH == 2) {
#pragma unroll
        for (int i = 0; i < 8; ++i) { const int kk = 8 * q4 + i; const int d = trel - DMUL * kk; ok[i] = (MODE == 0) ? (k0 + kk <= cmax) : (MODE == 1 ? (tk && d >= 0) : (d >= 0 && d < 512)); } }
#pragma unroll
    for (int h = 0; h < 2; ++h) {
        f32x4 sa = MFMA16(f.ka[0], qf[h][0], bv[h][0]), sb = MFMA16(f.kb[0], qf[h][0], bv[h][1]); sa = MFMA16(f.ka[1], qf[h][1], sa); sb = MFMA16(f.kb[1], qf[h][1], sb);
        float mref = m[h] + sl2[h] * trelf;
        float mx;
        if (PATH == 2) { mx = -1e30f;
#pragma unroll
            for (int i = 0; i < 8; ++i) { const float v = i < 4 ? sa[i] : sb[i - 4]; mx = ok[i] ? fmaxf(mx, v) : mx; } }
        else { mx = fmaxf(fmaxf(fmaxf(sa[0], sa[1]), fmaxf(sa[2], sa[3])), fmaxf(fmaxf(sb[0], sb[1]), fmaxf(sb[2], sb[3]))); if (PATH == 1) mx = tk ? mx : -1e30f; }
        mx = xmax_q4(mx);
        if (__any(mx > mref + 8.f)) { const float mn = fmaxf(mref, mx), alpha = __builtin_amdgcn_exp2f(mref - mn); m[h] = mn - sl2[h] * trelf; mref = mn; ls[h] = ls[h] * alpha;
#pragma unroll
            for (int dt = 0; dt < 4; ++dt) o[h][dt] = o[h][dt] * alpha; }
        float p[8];
#pragma unroll
        for (int i = 0; i < 8; ++i) { const float e = __builtin_amdgcn_exp2f((i < 4 ? sa[i] : sb[i - 4]) - mref); p[i] = (PATH == 2) ? (ok[i] ? e : 0.f) : e; }
        unsigned w0 = pg8::cvt_pk_bf16(p[0], p[1]), w1 = pg8::cvt_pk_bf16(p[2], p[3]), w2 = pg8::cvt_pk_bf16(p[4], p[5]), w3 = pg8::cvt_pk_bf16(p[6], p[7]);
        if (PATH == 1) { w0 = tk ? w0 : 0u; w1 = tk ? w1 : 0u; w2 = tk ? w2 : 0u; w3 = tk ? w3 : 0u; }
        const v4u w = {w0, w1, w2, w3}; const bf16x8v pf = __builtin_bit_cast(bf16x8v, w);
#pragma unroll
        for (int dt = 0; dt < 4; ++dt) o[h][dt] = MFMA16(vf[dt], pf, o[h][dt]);
        ls[h] = MFMA16(ones, pf, ls[h]);
    }
}
constexpr int PSW = 132;
__device__ __forceinline__ void p_attn_fast(Ctx& C, unsigned* queue, const int ld, const int qo, const float* qn) {
    unsigned char* ws = C.ws;
    const bf16* Qraw = (const bf16*)(ws + R_QKV);
    const bf16* KC = (const bf16*)(ws + WS_KC); const bf16* VCT = (const bf16*)(ws + WS_VCT);
    const bf16* KS = (const bf16*)(ws + R_KS); const bf16* VST = (const bf16*)(ws + R_VST); const bf16* KW = (const bf16*)(ws + R_KW); const bf16* VWT = (const bf16*)(ws + R_VWT);
    bf16* O = (bf16*)(ws + R_O);
    LAS float* psl = (LAS float*)(C.lds + C.wave * (16 * PSW * 4));
    const int l = C.lane, r16 = l & 15, q4 = l >> 4;
    const unsigned koff = (unsigned)((8 * (r16 >> 2) + (r16 & 3)) * 64 + 16 * q4), voff = (unsigned)((r16 * 32 + 8 * q4) * 2);
    const v4u ones_w = {0x3f803f80u, 0x3f803f80u, 0x3f803f80u, 0x3f803f80u}; const bf16x8v ones = __builtin_bit_cast(bf16x8v, ones_w);
    int qsel = (int)(xb_xcc_id() & 7u), qtry = 0;
    for (;;) {
        unsigned u = 0; if (l == 0) u = __hip_atomic_fetch_add(queue + 64 * qsel, 1u, __ATOMIC_RELAXED, __HIP_MEMORY_SCOPE_AGENT);
        u = (unsigned)__builtin_amdgcn_readfirstlane((int)u);
        if (u >= 2048u) { if (++qtry >= 8) break; qsel = (qsel + 1) & 7; continue; }
        u = ((u >> 7) * 8 + (unsigned)qsel) * 128 + (u & 127);
        const int bg = (int)(u >> 7), tile = 127 - (int)(u & 127), g = bg & 3, b = bg >> 2, t0 = tile * 16, t = t0 + r16, row = b * SEQ + t;
        const bf16* qrow = Qraw + (size_t)row * ld + qo; const bf16* gtp = qrow + 1024 + g * 12;
#define ATT_GATE(idx) (1.f / (1.f + __expf(-bf2f(gtp[(idx)]))))
        bf16* orow = O + (size_t)row * DM + g * 256 + 4 * q4;
        bf16x8v qf[2][2]; float sl2[2]; f32x4 bv[2][2]; float m[2]; f32x4 ls[2]; f32x4 o[2][4];
#define ATT_LOADQ(hp, DM_) do { _Pragma("unroll") for (int h = 0; h < 2; ++h) { sl2[h] = exp2f(-0.5f * (float)(g * 4 + 2 * (hp) + h + 1)) * LOG2E; \
            _Pragma("unroll") for (int i_ = 0; i_ < 4; ++i_) { bv[h][0][i_] = (float)(DM_) * sl2[h] * (float)(8 * q4 + i_); bv[h][1][i_] = (float)(DM_) * sl2[h] * (float)(8 * q4 + 4 + i_); } \
            float xq_[2][8]; float ssq_ = 0.f; \
            _Pragma("unroll") for (int ks = 0; ks < 2; ++ks) { const v4u r_ = *(const v4u*)(qrow + (g * 4 + 2 * (hp) + h) * 64 + 32 * ks + 8 * q4); \
                xq_[ks][0] = bflo(r_.x); xq_[ks][1] = bfhi(r_.x); xq_[ks][2] = bflo(r_.y); xq_[ks][3] = bfhi(r_.y); xq_[ks][4] = bflo(r_.z); xq_[ks][5] = bfhi(r_.z); xq_[ks][6] = bflo(r_.w); xq_[ks][7] = bfhi(r_.w); \
                _Pragma("unroll") for (int j_ = 0; j_ < 8; ++j_) ssq_ += xq_[ks][j_] * xq_[ks][j_]; } \
            ssq_ += __shfl_xor(ssq_, 16); ssq_ += __shfl_xor(ssq_, 32); \
            const float rq_ = rsqrtf(ssq_ * (1.f / 64.f) + EPS) * (0.125f * LOG2E); \
            _Pragma("unroll") for (int ks = 0; ks < 2; ++ks) { const f32x4 ga_ = *(const f32x4*)(qn + 32 * ks + 8 * q4), gb_ = *(const f32x4*)(qn + 32 * ks + 8 * q4 + 4); \
                const v4u w_ = {pg8::cvt_pk_bf16(xq_[ks][0] * rq_ * ga_.x, xq_[ks][1] * rq_ * ga_.y), pg8::cvt_pk_bf16(xq_[ks][2] * rq_ * ga_.z, xq_[ks][3] * rq_ * ga_.w), \
                                pg8::cvt_pk_bf16(xq_[ks][4] * rq_ * gb_.x, xq_[ks][5] * rq_ * gb_.y), pg8::cvt_pk_bf16(xq_[ks][6] * rq_ * gb_.z, xq_[ks][7] * rq_ * gb_.w)}; \
                qf[h][ks] = __builtin_bit_cast(bf16x8v, w_); } } } while (0)
#define ATT_RESET() do { _Pragma("unroll") for (int h = 0; h < 2; ++h) { m[h] = -1e30f; ls[h] = (f32x4){0.f, 0.f, 0.f, 0.f}; _Pragma("unroll") for (int dt = 0; dt < 4; ++dt) o[h][dt] = (f32x4){0.f, 0.f, 0.f, 0.f}; } } while (0)
        const int cmax = t >= 31 ? (((t - 31) >> 4) < 126 ? ((t - 31) >> 4) : 126) : -1;
        const int cmax0 = t0 >= 31 ? (((t0 - 31) >> 4) < 126 ? ((t0 - 31) >> 4) : 126) : -1;
        const bf16* KCb = KC + (size_t)bg * 128 * 64; const bf16* VCb = VCT + (size_t)bg * 128 * 64;
        const int ncs = ((t0 + 15 - 31) >> 4) < 0 ? 0 : ((((t0 + 15 - 31) >> 4) < 126 ? ((t0 + 15 - 31) >> 4) : 126) >> 5) + 1;
#pragma unroll 1
        for (int hp = 0; hp < 2; ++hp) {
            ATT_LOADQ(hp, 16); ATT_RESET();
            for (int st = ncs - 1; st >= 0; --st) {
                if (32 * st + 31 <= cmax0) attn_step<0, 0>(KCb, koff, VCb, voff, 32 * st, t - 31 - 16 * 32 * st, true, cmax, qf, bv, ones, m, ls, o, sl2, q4);
                else attn_step<0, 2>(KCb, koff, VCb, voff, 32 * st, t - 31 - 16 * 32 * st, true, cmax, qf, bv, ones, m, ls, o, sl2, q4); }
#pragma unroll
            for (int h = 0; h < 2; ++h) { const float lt = ls[h][0];
                const float sc_ = lt > 0.f ? ATT_GATE((2 * hp + h) * 3 + 0) / lt : 0.f;
#pragma unroll
                for (int dt = 0; dt < 4; ++dt) { const f32x4 r_ = o[h][dt] * sc_; v2u w; w.x = pg8::cvt_pk_bf16(r_[0], r_[1]); w.y = pg8::cvt_pk_bf16(r_[2], r_[3]);
                    *(v2u*)(orow + (2 * hp + h) * 64 + 16 * dt) = w; } }
            float ps[4][8];
#pragma unroll
            for (int st = 0; st < 4; ++st)
#pragma unroll
                for (int i = 0; i < 8; ++i) ps[st][i] = 0.f;
#pragma unroll
            for (int st = 0; st < 4; ++st) {
                if (st < ncs) {
                    const int k0 = 32 * st; const char* kblk = (const char*)(KCb + (size_t)k0 * 64);
                    bf16x8v ka[2], kb[2];
#pragma unroll
                    for (int ks = 0; ks < 2; ++ks) { ka[ks] = *(const bf16x8v*)(kblk + koff + 2048 * ks); kb[ks] = *(const bf16x8v*)(kblk + koff + 256 + 2048 * ks); }
#pragma unroll
                    for (int h = 0; h < 2; ++h) {
                        f32x4 sa = MFMA16(ka[0], qf[h][0], bv[h][0]), sb = MFMA16(kb[0], qf[h][0], bv[h][1]); sa = MFMA16(ka[1], qf[h][1], sa); sb = MFMA16(kb[1], qf[h][1], sb);
                        const float lt = ls[h][0], inv = lt > 0.f ? 1.f / lt : 0.f, mref = m[h] + sl2[h] * (float)(t - 31 - 16 * k0);
#pragma unroll
                        for (int i = 0; i < 8; ++i) { const int c = k0 + 8 * q4 + i; ps[st][i] += (c <= cmax) ? __builtin_amdgcn_exp2f((i < 4 ? sa[i] : sb[i - 4]) - mref) * inv : 0.f; }
                    }
                }
            }
#pragma unroll
            for (int st = 0; st < 4; ++st) { LAS f32x4* p0 = (LAS f32x4*)(psl + r16 * PSW + 32 * st + 8 * q4);
                f32x4 a = {ps[st][0], ps[st][1], ps[st][2], ps[st][3]}, bq = {ps[st][4], ps[st][5], ps[st][6], ps[st][7]};
                if (hp) { a = a + p0[0]; bq = bq + p0[1]; }
                p0[0] = a; p0[1] = bq; }
            LDS_WAIT();
        }
        unsigned mlo, mhi;
        {
            float sc[16]; const LAS float* pr = psl + r16 * PSW + 32 * q4; const int cur = t >> 5;
            float prev = q4 > 0 ? pr[-1] : 0.f;
#pragma unroll
            for (int jj = 0; jj < 16; ++jj) { const float a = pr[2 * jj], bq = pr[2 * jj + 1]; const float imp = prev + a + bq; prev = bq;
                const int j = 16 * q4 + jj; const bool valid = 32 * j <= t; const bool forced = valid && (j == 0 || j == cur || j == cur - 1);
                sc[jj] = forced ? 1e9f : (valid ? imp : -1e9f); }
            unsigned my = 0u;
#pragma unroll 1
            for (int r = 0; r < 8; ++r) {
                float best = sc[0]; int bi = 0;
#pragma unroll
                for (int jj = 1; jj < 16; ++jj) if (sc[jj] > best) { best = sc[jj]; bi = jj; }
                bi += 16 * q4;
#pragma unroll
                for (int sh = 16; sh <= 32; sh <<= 1) { const float ov = __shfl_xor(best, sh); const int oi = __shfl_xor(bi, sh); if (ov > best || (ov == best && oi < bi)) { best = ov; bi = oi; } }
                if ((bi >> 4) == q4) { const int jj0 = bi & 15; if (best > -0.5e9f) my |= 1u << jj0;
#pragma unroll
                    for (int jj = 0; jj < 16; ++jj) if (jj == jj0) sc[jj] = -INFINITY; }
            }
            mlo = (q4 == 0 ? my : 0u) | (q4 == 1 ? my << 16 : 0u); mhi = (q4 == 2 ? my : 0u) | (q4 == 3 ? my << 16 : 0u);
            mlo |= __shfl_xor(mlo, 16); mlo |= __shfl_xor(mlo, 32); mhi |= __shfl_xor(mhi, 16); mhi |= __shfl_xor(mhi, 32);
        }
        LDS_WAIT();
        unsigned ulo = mlo, uhi = mhi;
#pragma unroll
        for (int sh = 1; sh <= 8; sh <<= 1) { ulo |= __shfl_xor(ulo, sh); uhi |= __shfl_xor(uhi, sh); }
        const unsigned long long un0 = ((unsigned long long)(unsigned)__builtin_amdgcn_readfirstlane((int)uhi) << 32) | (unsigned)__builtin_amdgcn_readfirstlane((int)ulo);
        const unsigned long long mine = ((unsigned long long)mhi << 32) | mlo;
#pragma unroll 1
        for (int hp = 0; hp < 2; ++hp) {
            ATT_LOADQ(hp, 1);
#define ATT_ADD_OUT(br) do { _Pragma("unroll") for (int h = 0; h < 2; ++h) { const float lt = ls[h][0]; const float sc_ = lt > 0.f ? ATT_GATE((2 * hp + h) * 3 + (br)) / lt : 0.f; \
            _Pragma("unroll") for (int dt = 0; dt < 4; ++dt) { v2u* op = (v2u*)(orow + (2 * hp + h) * 64 + 16 * dt); const v2u c_ = *op; const f32x4 r_ = o[h][dt] * sc_; \
                v2u w; w.x = pg8::cvt_pk_bf16(r_[0] + bflo(c_.x), r_[1] + bfhi(c_.x)); w.y = pg8::cvt_pk_bf16(r_[2] + bflo(c_.y), r_[3] + bfhi(c_.y)); *op = w; } } } while (0)
            {
                const bf16* Kb = KS + (size_t)bg * SEQ * 64; const bf16* Vb = VST + (size_t)bg * SEQ * 64;
                ATT_RESET();
                unsigned long long un = un0;
                const int cur0 = t0 >> 5;
                while (un) { const int j = 63 - __builtin_clzll(un); un &= ~(1ull << j);
                    const bool tk = ((mine >> j) & 1ull) != 0ull;
                    if (j >= cur0) attn_step<1, 2>(Kb, koff, Vb, voff, 32 * j, t - 32 * j, tk, 0, qf, bv, ones, m, ls, o, sl2, q4);
                    else if (__all(tk)) attn_step<1, 0>(Kb, koff, Vb, voff, 32 * j, t - 32 * j, true, 0, qf, bv, ones, m, ls, o, sl2, q4);
                    else attn_step<1, 1>(Kb, koff, Vb, voff, 32 * j, t - 32 * j, tk, 0, qf, bv, ones, m, ls, o, sl2, q4); }
                ATT_ADD_OUT(1);
            }
            {
                const bf16* Kb = KW + (size_t)bg * SEQ * 64; const bf16* Vb = VWT + (size_t)bg * SEQ * 64;
                const int sb = t0 >= 511 ? (t0 - 511) >> 5 : 0, se = t0 >> 5;
                ATT_RESET();
                for (int st = se; st >= sb; --st) {
                    if (32 * st + 31 <= t0 && 32 * st > t0 - 497) attn_step<2, 0>(Kb, koff, Vb, voff, 32 * st, t - 32 * st, true, 0, qf, bv, ones, m, ls, o, sl2, q4);
                    else attn_step<2, 2>(Kb, koff, Vb, voff, 32 * st, t - 32 * st, true, 0, qf, bv, ones, m, ls, o, sl2, q4); }
                ATT_ADD_OUT(2);
            }
        }
#undef ATT_ADD_OUT
#undef ATT_LOADQ
#undef ATT_RESET
#undef ATT_GATE
    }
}

constexpr int SCQ = 272, SCT = 144;
constexpr int LQ_ = 0, LK_ = 17408, LKT_ = 34816, LVT_ = 53248, LP_ = 71680, LO_ = 80896, LE_ = 114688, LT_ = 115712;
__device__ __forceinline__ void p_scan_fast(Ctx& C, int layer) {
    unsigned char* ws = C.ws;
    const bf16* Pq = (const bf16*)(ws + R_PQ); const bf16* Pi = (const bf16*)(ws + R_PI); const bf16* Pg = (const bf16*)(ws + R_PG); const float* LF = (const float*)(ws + R_LF);
    bf16* O2 = (bf16*)(ws + R_O2);
    const float* gn = C.inp(I_HGN) + layer * 128;
    LAS unsigned char* L = C.lds;
    const int tid = C.tid, lane = C.lane, w = C.wave, r16 = lane & 15, q4 = lane >> 4, k = tid & 127, seg = tid >> 7;
    LAS float* tot = (LAS float*)(L + LT_); LAS float* eref = (LAS float*)(L + LE_); LAS float* elr = eref + 128;
    { const int tile = tid >> 8, e = tid & 255, row = e >> 4, col = e & 15;
      *(LAS bf16*)(L + LP_ + ((tile ? 32 : 0) + row) * SCT + ((tile ? 48 : 16) + col) * 2) = 0; }
    for (int bh = C.bid; bh < 256; bh += C.G) {
        const int b = bh >> 3, h = bh & 7;
        const size_t base = (size_t)(b * SEQ) * DM + h * 128;
        f32x4 S[8];
#pragma unroll
        for (int i = 0; i < 8; ++i) S[i] = (f32x4){0.f, 0.f, 0.f, 0.f};
        bf16 qv[16], vv[16]; float lf[16];
#define SC_LOAD(t0) do { _Pragma("unroll") for (int i = 0; i < 16; ++i) { const size_t off = base + (size_t)((t0) + 16 * seg + i) * DM + k; qv[i] = Pq[off]; vv[i] = Pi[off]; lf[i] = LF[off]; } } while (0)
        SC_LOAD(0);
#pragma unroll 1
        for (int c = 0; c < SEQ / 64; ++c) {
            const int t0 = c * 64;
            float cs[16]; { float run = 0.f;
#pragma unroll
                for (int i = 0; i < 16; ++i) { run += lf[i]; cs[i] = run; }
                tot[seg * 128 + k] = run; }
            __syncthreads();
            { const float a0 = tot[k], a1 = tot[128 + k], a2 = tot[256 + k], a3 = tot[384 + k];
              const float off = seg == 0 ? 0.f : (seg == 1 ? a0 : (seg == 2 ? a0 + a1 : a0 + a1 + a2)), ref = a0 + a1, last = ref + a2 + a3;
              unsigned kt[16];
#pragma unroll
              for (int i = 0; i < 16; ++i) { const float d = off + cs[i] - ref; const float qt = bf2f(qv[i]) * __expf(fminf(d, 80.f)), ktv = (1.f - __expf(lf[i])) * __expf(fminf(-d, 80.f));
                  const int s = 16 * seg + i; kt[i] = f2bf(ktv);
                  *(LAS bf16*)(L + LQ_ + s * SCQ + k * 2) = (bf16)f2bf(qt); *(LAS bf16*)(L + LK_ + s * SCQ + k * 2) = (bf16)kt[i]; }
              v4u w0, w1, x0, x1;
              w0.x = kt[0] | (kt[1] << 16); w0.y = kt[2] | (kt[3] << 16); w0.z = kt[4] | (kt[5] << 16); w0.w = kt[6] | (kt[7] << 16);
              w1.x = kt[8] | (kt[9] << 16); w1.y = kt[10] | (kt[11] << 16); w1.z = kt[12] | (kt[13] << 16); w1.w = kt[14] | (kt[15] << 16);
              x0.x = vv[0] | ((unsigned)vv[1] << 16); x0.y = vv[2] | ((unsigned)vv[3] << 16); x0.z = vv[4] | ((unsigned)vv[5] << 16); x0.w = vv[6] | ((unsigned)vv[7] << 16);
              x1.x = vv[8] | ((unsigned)vv[9] << 16); x1.y = vv[10] | ((unsigned)vv[11] << 16); x1.z = vv[12] | ((unsigned)vv[13] << 16); x1.w = vv[14] | ((unsigned)vv[15] << 16);
              *(LAS v4u*)(L + LKT_ + k * SCT + seg * 32) = w0; *(LAS v4u*)(L + LKT_ + k * SCT + seg * 32 + 16) = w1;
              *(LAS v4u*)(L + LVT_ + k * SCT + seg * 32) = x0; *(LAS v4u*)(L + LVT_ + k * SCT + seg * 32 + 16) = x1;
              if (seg == 0) { eref[k] = __expf(ref); elr[k] = __expf(last - ref); } }
            __syncthreads();
            if (c + 1 < SEQ / 64) SC_LOAD(t0 + 64);
#pragma unroll 1
            for (int ti = w; ti < 10; ti += 8) {
                const int rt = ti < 1 ? 0 : (ti < 3 ? 1 : (ti < 6 ? 2 : 3)), ct = ti - (rt * (rt + 1)) / 2;
                f32x4 acc = {0.f, 0.f, 0.f, 0.f};
#pragma unroll
                for (int p = 0; p < 4; ++p) { const bf16x8v a = *(const LAS bf16x8v*)(L + LQ_ + (16 * rt + r16) * SCQ + (32 * p + 8 * q4) * 2), bq = *(const LAS bf16x8v*)(L + LK_ + (16 * ct + r16) * SCQ + (32 * p + 8 * q4) * 2);
                    acc = MFMA16(a, bq, acc); }
#pragma unroll
                for (int i = 0; i < 4; ++i) { const int t = 16 * rt + 4 * q4 + i, s = 16 * ct + r16; *(LAS bf16*)(L + LP_ + t * SCT + s * 2) = (bf16)f2bf(s <= t ? acc[i] : 0.f); }
            }
            __syncthreads();
            bf16x8v sfrag[4]; f32x4 e8[4][2];
#pragma unroll
            for (int p = 0; p < 4; ++p) { e8[p][0] = *(const LAS f32x4*)(eref + 32 * p + 8 * q4); e8[p][1] = *(const LAS f32x4*)(eref + 32 * p + 8 * q4 + 4);
                S[2 * p] = S[2 * p] * e8[p][0]; S[2 * p + 1] = S[2 * p + 1] * e8[p][1];
                const v4u wv = {pg8::cvt_pk_bf16(S[2 * p][0], S[2 * p][1]), pg8::cvt_pk_bf16(S[2 * p][2], S[2 * p][3]), pg8::cvt_pk_bf16(S[2 * p + 1][0], S[2 * p + 1][1]), pg8::cvt_pk_bf16(S[2 * p + 1][2], S[2 * p + 1][3])};
                sfrag[p] = __builtin_bit_cast(bf16x8v, wv); }
            bf16x8v vfr[2];
#pragma unroll
            for (int ss = 0; ss < 2; ++ss) vfr[ss] = *(const LAS bf16x8v*)(L + LVT_ + (16 * w + r16) * SCT + (32 * ss + 8 * q4) * 2);
#pragma unroll
            for (int rt = 0; rt < 4; ++rt) { f32x4 o = {0.f, 0.f, 0.f, 0.f};
#pragma unroll
                for (int p = 0; p < 4; ++p) { const bf16x8v a = *(const LAS bf16x8v*)(L + LQ_ + (16 * rt + r16) * SCQ + (32 * p + 8 * q4) * 2); o = MFMA16(a, sfrag[p], o); }
#pragma unroll
                for (int ss = 0; ss < 2; ++ss) if (ss <= rt / 2) { const bf16x8v a = *(const LAS bf16x8v*)(L + LP_ + (16 * rt + r16) * SCT + (32 * ss + 8 * q4) * 2); o = MFMA16(a, vfr[ss], o); }
#pragma unroll
                for (int i = 0; i < 4; ++i) *(LAS float*)(L + LO_ + (16 * rt + 4 * q4 + i) * 528 + (16 * w + r16) * 4) = o[i]; }
#pragma unroll
            for (int p = 0; p < 4; ++p)
#pragma unroll
                for (int ab = 0; ab < 2; ++ab) { const int krow = 32 * p + 8 * (r16 >> 2) + (r16 & 3) + 4 * ab;
#pragma unroll
                    for (int ss = 0; ss < 2; ++ss) { const bf16x8v a = *(const LAS bf16x8v*)(L + LKT_ + krow * SCT + (32 * ss + 8 * q4) * 2); S[2 * p + ab] = MFMA16(a, vfr[ss], S[2 * p + ab]); } }
#pragma unroll
            for (int p = 0; p < 4; ++p) { const f32x4 l0 = *(const LAS f32x4*)(elr + 32 * p + 8 * q4), l1 = *(const LAS f32x4*)(elr + 32 * p + 8 * q4 + 4); S[2 * p] = S[2 * p] * l0; S[2 * p + 1] = S[2 * p + 1] * l1; }
            __syncthreads();
#pragma unroll
            for (int rep = 0; rep < 2; ++rep) { const int tok = (tid >> 4) + 32 * rep, part = tid & 15;
                const f32x4 oa = *(const LAS f32x4*)(L + LO_ + tok * 528 + part * 32), ob = *(const LAS f32x4*)(L + LO_ + tok * 528 + part * 32 + 16);
                float ss = (oa.x * oa.x + oa.y * oa.y) + (oa.z * oa.z + oa.w * oa.w) + (ob.x * ob.x + ob.y * ob.y) + (ob.z * ob.z + ob.w * ob.w);
                ss += __shfl_xor(ss, 1); ss += __shfl_xor(ss, 2); ss += __shfl_xor(ss, 4); ss += __shfl_xor(ss, 8);
                const float rstd = rsqrtf(ss * (1.f / 128.f) + EPS);
                const size_t off = base + (size_t)(t0 + tok) * DM + part * 8; const v4u g8 = *(const v4u*)(Pg + off);
                const f32x4 ga = *(const f32x4*)(gn + part * 8), gb = *(const f32x4*)(gn + part * 8 + 4);
                v4u wv; wv.x = pk2(oa.x * rstd * ga.x * bflo(g8.x), oa.y * rstd * ga.y * bfhi(g8.x)); wv.y = pk2(oa.z * rstd * ga.z * bflo(g8.y), oa.w * rstd * ga.w * bfhi(g8.y));
                wv.z = pk2(ob.x * rstd * gb.x * bflo(g8.z), ob.y * rstd * gb.y * bfhi(g8.z)); wv.w = pk2(ob.z * rstd * gb.z * bflo(g8.w), ob.w * rstd * gb.w * bfhi(g8.w));
                *(v4u*)(O2 + off) = wv; }
        }
#undef SC_LOAD
        __syncthreads();
    }
}

#define PH_BEGIN { const bool run_ = (pid >= lo && pid < hi); ++pid; if (run_) { { int ln_; asm volatile("v_mbcnt_lo_u32_b32 %0, -1, 0\n\tv_mbcnt_hi_u32_b32 %0, -1, %0" : "=v"(ln_)); C.lane = ln_; C.tid = C.wave * 64 + ln_; }
#define PH_END   if (pid < hi) xcd_barrier(bar); } }
#define XN ((const bf16*)(ws + WS_XN))
#define RTAB ((const int*)(ws + WS_RTAB))

template <int L>
__device__ __forceinline__ void run_layer(Ctx& C, const XcdBarrier& bar, int& pid, const int lo, const int hi, PG8_LAS unsigned char* ring) {
    unsigned char* const ws = C.ws;

        const int li = L >> 1;
        if (L < 2) {
            PH_BEGIN { pg8::Gemm g{XN, (const bf16*)(ws + W_HIN) + (size_t)L * 4096 * 1024, 1024, 1024, 0}; pg8::GenOrder S; S.init(256, 16, C.G, C.bid, nullptr);
                pg8::EpiHgrnIn E{ws, L};
                pg8::gemm_phase<pg8::EpiHgrnIn, pg8::GenOrder, true, true>(ring, g, S, E, C.wave); } PH_END
            PH_BEGIN p_scan_fast(C, L); PH_END
        } else {
            PH_BEGIN { const bool first = (L == 2); pg8::Gemm g{XN, (const bf16*)(ws + (first ? W_KVQ : W_Q3)), 1024, 1024, 0}; pg8::GenOrder S; S.init(256, first ? 11 : 5, C.G, C.bid, nullptr);
                pg8::EpiBf16 E{(bf16*)(ws + R_QKV), first ? 2816 : 1280, nullptr, 0, 0, 1.f};
                pg8::gemm_phase<pg8::EpiBf16, pg8::GenOrder, true, true>(ring, g, S, E, C.wave); } PH_END
            if (L == 2) {
                PH_BEGIN p_post_kv(C); PH_END
                PH_BEGIN { pg8::Gemm g{(const bf16*)(ws + R_KCR), (const bf16*)(ws + W_CMP1), 2048, 1024, (size_t)256 * 2048 * 2}; pg8::GenOrder S; S.init(128, 1, C.G, C.bid, RTAB + 2048);
                    pg8::EpiBf16 E{(bf16*)(ws + WS_HC), 256, (const float*)(ws + WS_CB), 1, 256, 1.f};
                    pg8::gemm_phase<pg8::EpiBf16, pg8::GenOrder, true, true>(ring, g, S, E, C.wave); } PH_END
                PH_BEGIN p_cmp2(C); PH_END
            }
            PH_BEGIN p_attn_fast(C, (unsigned*)(ws + WS_CTL) + 8192 + 2048 * (L - 2), L == 2 ? 2816 : 1280, L == 2 ? 1536 : 0, C.inp(I_NQN) + (L - 2) * 64); PH_END
        }
        PH_BEGIN { pg8::Gemm g{(const bf16*)(ws + (L < 2 ? R_O2 : R_O)), (const bf16*)(ws + (L < 2 ? W_HOUT : W_NOUT)) + (size_t)(L & 1) * 1024 * 1024, 1024, 1024, 0};
            pg8::GenOrder S; S.init(256, 4, C.G, C.bid, nullptr);
            pg8::EpiRes E{L == 0 ? C.inp(I_X) : C.out, C.out, 1024, 1.f};
            pg8::gemm_phase<pg8::EpiRes, pg8::GenOrder, true, true>(ring, g, S, E, C.wave); } PH_END
        PH_BEGIN { if (L & 1) p_norm<false, true, true, true>(C, C.inp(I_MR) + (size_t)li * 1024 * 8, C.inp(I_NFFN) + L * 1024); else if (L == 2) p_norm<false, false, true, true>(C, nullptr, nullptr); else p_norm<false, false, true, false>(C, nullptr, nullptr); } PH_END
        if (L & 1) { PH_BEGIN p_gather(C); PH_END }
        if (L == 0) {
            PH_BEGIN { pg8::Gemm g{XN, (const bf16*)(ws + W_FGU), 1024, 1024, 0};
                pg8::GenOrder S; S.init(256, 22, C.G, C.bid, nullptr);
                pg8::EpiSwiGLU E{(bf16*)(ws + R_HF), DFF};
                pg8::gemm_phase<pg8::EpiSwiGLU, pg8::GenOrder, true, true>(ring, g, S, E, C.wave); } PH_END
            PH_BEGIN { pg8::Gemm g{(const bf16*)(ws + R_HF), (const bf16*)(ws + W_FDN), DFF, DFF, 0}; pg8::GenOrder S; S.init(256, 4, C.G, C.bid, nullptr);
                pg8::EpiRes E{C.out, C.out, 1024, 1.f};
                pg8::gemm_phase<pg8::EpiRes, pg8::GenOrder, true, true>(ring, g, S, E, C.wave); } PH_END
            PH_BEGIN p_norm<false, false, true>(C, nullptr, nullptr); PH_END
        } else {
        PH_BEGIN { const bool moe = (L & 1) != 0;
            pg8::Gemm g{(const bf16*)(ws + (moe ? R_XP : WS_XN)), (const bf16*)(ws + (moe ? W_MGU + (size_t)li * 8 * 2 * DFE * 1024 : W_FGU + (size_t)li * 2 * DFF * 2048)), 512, 512, moe ? (size_t)2 * DFE * 1024 : 0};
            pg8::GenOrder S; S.init(moe ? RTAB[1024] : 256, moe ? 28 : 22, C.G, C.bid, moe ? RTAB : nullptr);
            pg8::EpiSwiGLU8 E{ws + (moe ? R_HM : R_HF), moe ? DFE : DFF};
            pg8::gemm_phase<pg8::EpiSwiGLU8, pg8::GenOrder, true, true, true>(ring, g, S, E, C.wave); } PH_END
        if (!(L & 1)) {
            PH_BEGIN { pg8::Gemm g{(const bf16*)(ws + R_HF), (const bf16*)(ws + W_FDN + (size_t)li * 1024 * DFF * 2), DFF / 2, DFF / 2, 0}; pg8::GenOrder S; S.init(256, 4, C.G, C.bid, nullptr);
                pg8::EpiRes E{C.out, C.out, 1024, 1.f / (pg8::FP8_SH * pg8::FP8_SW2)};
                pg8::gemm_phase<pg8::EpiRes, pg8::GenOrder, true, true, true>(ring, g, S, E, C.wave); } PH_END
            PH_BEGIN p_norm<false, false, true>(C, nullptr, nullptr); PH_END
        } else {
            PH_BEGIN { pg8::Gemm g{(const bf16*)(ws + R_HM), (const bf16*)(ws + W_MDN + (size_t)li * 8 * 1024 * DFE), DFE / 2, DFE / 2, (size_t)1024 * DFE}; pg8::GenOrder S; S.init(RTAB[1024], 4, C.G, C.bid, RTAB);
                pg8::EpiBf16 E{(bf16*)(ws + R_XP), 1024, nullptr, 0, 0, 1.f / (pg8::FP8_SH * pg8::FP8_SW2)};
                pg8::gemm_phase<pg8::EpiBf16, pg8::GenOrder, true, true, true>(ring, g, S, E, C.wave); } PH_END
            PH_BEGIN { if (L == 1) p_norm<true, false, true>(C, nullptr, nullptr); else p_norm<true, false, false>(C, nullptr, nullptr); } PH_END
        }
        }
    }

struct Args { const float* in[24]; float* out; unsigned char* ws; int ph_lo, ph_hi; };
constexpr int N_PHASES = 34;

__global__ void __launch_bounds__(NWAVES * 64, 2) yoco_fwd(Args args) {
    extern __shared__ __attribute__((aligned(16))) unsigned char lds_raw[];
    Ctx C;
    C.lds = (LAS unsigned char*)lds_raw;
    C.wave = __builtin_amdgcn_readfirstlane((int)(threadIdx.x >> 6)); C.tid = threadIdx.x; C.lane = C.tid & 63;
    C.G = gridDim.x; C.bid = blockIdx.x;
    C.out = args.out; C.ws = args.ws;
    unsigned char* const ws = args.ws;
    volatile LAS unsigned* MISC = (volatile LAS unsigned*)(C.lds + MISC_OFF);
    if (C.tid < 32) MISC[C.tid] = 0u;
    __syncthreads();
    XcdBarrier bar = xcd_barrier_post((unsigned*)(ws + WS_CTL) + 4096, MISC + 8);
    const int lo = args.ph_lo, hi = args.ph_hi;
    int pid = 0;
    PG8_LAS unsigned char* ring = (PG8_LAS unsigned char*)lds_raw;
    PH_BEGIN p_prologue(C); PH_END

    run_layer<0>(C, bar, pid, lo, hi, ring); run_layer<1>(C, bar, pid, lo, hi, ring); run_layer<2>(C, bar, pid, lo, hi, ring); run_layer<3>(C, bar, pid, lo, hi, ring);
#undef PH_BEGIN
#undef PH_END
#undef XN
#undef RTAB
}

extern "C" void kernel_launch(void* const* d_in, const int* in_sizes, int n_in, void* d_out, int out_size, void* d_ws, size_t ws_size, hipStream_t stream) {
    static int grid = 0;
    if (grid == 0) {
        if (n_in != 24 || in_sizes[0] != NT * DM || out_size != NT * DM || ws_size < WS_NEED) { fprintf(stderr, "kernel_launch: unexpected shapes / workspace (n_in %d, ws %zu, need %zu)\n", n_in, ws_size, (size_t)WS_NEED); grid = -1; return; }
        int dev = 0, cus = 0;
        if (hipGetDevice(&dev) != hipSuccess || hipDeviceGetAttribute(&cus, hipDeviceAttributeMultiprocessorCount, dev) != hipSuccess) { grid = -1; return; }
        if (hipFuncSetAttribute((const void*)yoco_fwd, hipFuncAttributeMaxDynamicSharedMemorySize, LDS_BYTES) != hipSuccess) { fprintf(stderr, "kernel_launch: hipFuncSetAttribute failed\n"); grid = -1; return; }
        int per_cu = 0;
        if (hipOccupancyMaxActiveBlocksPerMultiprocessor(&per_cu, (const void*)yoco_fwd, NWAVES * 64, LDS_BYTES) != hipSuccess || per_cu < 1) { fprintf(stderr, "kernel_launch: occupancy query says %d\n", per_cu); }
        (void)hipGetLastError();
        grid = cus;
    }
    if (grid < 0) return;
    (void)hipMemsetAsync((char*)d_ws + WS_CTL, 0, CTL_ZERO_BYTES, stream);
    Args a{};
    for (int i = 0; i < 24; ++i) a.in[i] = (const float*)d_in[i];
    a.out = (float*)d_out; a.ws = (unsigned char*)d_ws;
#if MK_SINGLE
    a.ph_lo = 0; a.ph_hi = PROBE_DUP ? 1000 : N_PHASES;
    hipLaunchKernelGGL(yoco_fwd, dim3(grid), dim3(NWAVES * 64), LDS_BYTES, stream, a);
#else
    for (int k = 0; k < N_PHASES; ++k) { a.ph_lo = k; a.ph_hi = k + 1; hipLaunchKernelGGL(yoco_fwd, dim3(grid), dim3(NWAVES * 64), LDS_BYTES, stream, a); }
#endif
}
```

```cpp
#include <hip/hip_runtime.h>
#include <cstdio>
#include <cstdint>

#ifndef PROBE_DUP
#define PROBE_DUP 0
#endif
#ifndef MK_SINGLE
#define MK_SINGLE 1
#endif

namespace pg8 {
#define PG8_LAS __attribute__((address_space(3)))
typedef unsigned short bf16_t;
typedef short bf16x8 __attribute__((ext_vector_type(8)));
typedef float f32x4 __attribute__((ext_vector_type(4)));
typedef unsigned u32x4 __attribute__((ext_vector_type(4)));
constexpr int BM = 256, BK = 64, HALF = 128, HTB = HALF * BK * 2  , STAGE_BYTES = 8 * HTB, NXCD = 8, WGM = 8;

__host__ __device__ __forceinline__ int lds_byte(int r, int c) { const int st = (r >> 4) * 2 + (c >> 5), rr = r & 15, cc = c & 31, ob = rr * 64 + cc * 2; return st * 1024 + (ob ^ (((ob >> 9) & 1) << 5)); }
__host__ __device__ __forceinline__ void stage_rc(int b, int& R, int& C) { const int st = b / 1024, sb = b % 1024, swz = sb ^ (((sb >> 9) & 1) << 5); R = (st >> 1) * 16 + swz / 64; C = (st & 1) * 32 + (swz % 64) / 2; }
__host__ __device__ __forceinline__ int perm32(int rho) { const int n = rho >> 4, i = rho & 15; return 8 * (i >> 2) + 4 * n + (i & 3); }

struct Unit { int pm, pn, e; };
struct Gemm { const bf16_t* A; const bf16_t* Bt; int K; int lda; size_t estride; };

struct GenOrder {
    int nM, nN, nwg, G, c; const int* tile_e;
    __device__ void init(int nM_, int nN_, int G_, int c_, const int* te) { nM = nM_; nN = nN_; nwg = nM * nN; G = G_; c = c_; tile_e = te; }
    __device__ bool next(int i, Unit& u) const {
        const long L = (long)i * G + c; if (L >= nwg) return false;
        int wgid = (int)L; { const int q = nwg / NXCD, r = nwg % NXCD, xcd = wgid % NXCD, off = wgid / NXCD; wgid = (xcd < r ? xcd * (q + 1) : r * (q + 1) + (xcd - r) * q) + off; }
        const int nig = WGM * nN, gid = wgid / nig, fm = gid * WGM, gsz = (nM - fm) < WGM ? (nM - fm) : WGM;
        u.pm = fm + ((wgid % nig) % gsz); u.pn = (wgid % nig) / gsz; u.e = tile_e ? tile_e[u.pm] : 0; return true;
    }
    __device__ __forceinline__ void a_ready(const Unit&) const {}
    __device__ __forceinline__ void done(const Unit&) const {}
};

__device__ __forceinline__ unsigned cvt_pk_bf16(float lo, float hi) { unsigned r; asm volatile("v_cvt_pk_bf16_f32 %0, %1, %2" : "=v"(r) : "v"(lo), "v"(hi)); return r; }
__device__ __forceinline__ float silu_f(float v) { return v * __builtin_amdgcn_rcpf(1.0f + __expf(-v)); }
__device__ __forceinline__ float clamp448(float v) { return fminf(fmaxf(v, -448.f), 448.f); }
__device__ __forceinline__ unsigned pk4_fp8(float a, float b, float c, float d) {
    int w = __builtin_amdgcn_cvt_pk_fp8_f32(clamp448(a), clamp448(b), 0, false); w = __builtin_amdgcn_cvt_pk_fp8_f32(clamp448(c), clamp448(d), w, true); return (unsigned)w; }
constexpr float FP8_SW1 = 32.f, FP8_SW2 = 64.f, FP8_SH = 8.f;

struct EpiBf16 {
    static constexpr bool PERM = true, AFTER_DRAIN = false;
    bf16_t* O; int ldc; const float* bias; int act; int bias_es; float oscale;
    __device__ __forceinline__ void operator()(const f32x4 (&acc)[2][2][4][2], const Unit& u, int wr, int wc, int fr, int fq) const {
        const int row0 = u.pm * BM + wr * 64 + fr, col0 = u.pn * BM + wc * 32 + 8 * fq;
        f32x4 bv[2][2];
#pragma unroll
        for (int bj = 0; bj < 2; ++bj)
#pragma unroll
            for (int n = 0; n < 2; ++n) bv[bj][n] = bias ? *(const f32x4*)(bias + u.e * bias_es + col0 + bj * HALF + 4 * n) : (f32x4){0.f, 0.f, 0.f, 0.f};
#pragma unroll
        for (int ai = 0; ai < 2; ++ai)
#pragma unroll
            for (int m = 0; m < 4; ++m) { bf16_t* rowp = O + (size_t)(row0 + ai * HALF + m * 16) * ldc + col0;
#pragma unroll
                for (int bj = 0; bj < 2; ++bj) { f32x4 v0 = acc[ai][bj][m][0] * oscale + bv[bj][0], v1 = acc[ai][bj][m][1] * oscale + bv[bj][1];
                    if (act == 1) {
#pragma unroll
                        for (int i = 0; i < 4; ++i) { v0[i] = silu_f(v0[i]); v1[i] = silu_f(v1[i]); } }
                    u32x4 w; w.x = cvt_pk_bf16(v0[0], v0[1]); w.y = cvt_pk_bf16(v0[2], v0[3]); w.z = cvt_pk_bf16(v1[0], v1[1]); w.w = cvt_pk_bf16(v1[2], v1[3]);
                    *(u32x4*)(rowp + bj * HALF) = w; } }
    }
};
struct EpiRes {
    static constexpr bool PERM = false, AFTER_DRAIN = false;
    const float* base; float* out; int ldc; float oscale;
    __device__ __forceinline__ void operator()(const f32x4 (&acc)[2][2][4][2], const Unit& u, int wr, int wc, int fr, int fq) const {
        const int row0 = u.pm * BM + wr * 64 + fr, col0 = u.pn * BM + wc * 32 + 4 * fq;
#pragma unroll
        for (int ai = 0; ai < 2; ++ai)
#pragma unroll
            for (int m = 0; m < 4; ++m) { const size_t off = (size_t)(row0 + ai * HALF + m * 16) * ldc + col0;
#pragma unroll
                for (int bj = 0; bj < 2; ++bj)
#pragma unroll
                    for (int n = 0; n < 2; ++n) { const f32x4 b = *(const f32x4*)(base + off + bj * HALF + n * 16); *(f32x4*)(out + off + bj * HALF + n * 16) = b + acc[ai][bj][m][n] * oscale; } }
    }
};
struct EpiSwiGLU {
    static constexpr bool PERM = true, AFTER_DRAIN = false;
    bf16_t* O; int ldc;
    __device__ __forceinline__ void operator()(const f32x4 (&acc)[2][2][4][2], const Unit& u, int wr, int wc, int fr, int fq) const {
        const int row0 = u.pm * BM + wr * 64 + fr, col0 = u.pn * HALF + wc * 32 + 8 * fq;
#pragma unroll
        for (int ai = 0; ai < 2; ++ai)
#pragma unroll
            for (int m = 0; m < 4; ++m) { bf16_t* rowp = O + (size_t)(row0 + ai * HALF + m * 16) * ldc + col0;
                f32x4 v0, v1;
#pragma unroll
                for (int i = 0; i < 4; ++i) { v0[i] = silu_f(acc[ai][0][m][0][i]) * acc[ai][1][m][0][i]; v1[i] = silu_f(acc[ai][0][m][1][i]) * acc[ai][1][m][1][i]; }
                u32x4 w; w.x = cvt_pk_bf16(v0[0], v0[1]); w.y = cvt_pk_bf16(v0[2], v0[3]); w.z = cvt_pk_bf16(v1[0], v1[1]); w.w = cvt_pk_bf16(v1[2], v1[3]);
                *(u32x4*)rowp = w; }
    }
};
struct EpiSwiGLU8 {
    static constexpr bool PERM = true, AFTER_DRAIN = false;
    unsigned char* O; int ldc;
    __device__ __forceinline__ void operator()(const f32x4 (&acc)[2][2][4][2], const Unit& u, int wr, int wc, int fr, int fq) const {
        const int row0 = u.pm * BM + wr * 64 + fr, col0 = u.pn * HALF + wc * 32 + 8 * fq; constexpr float si = 1.f / FP8_SW1;
#pragma unroll
        for (int ai = 0; ai < 2; ++ai)
#pragma unroll
            for (int m = 0; m < 4; ++m) { unsigned char* rowp = O + (size_t)(row0 + ai * HALF + m * 16) * ldc + col0;
                f32x4 v0, v1;
#pragma unroll
                for (int i = 0; i < 4; ++i) { v0[i] = silu_f(acc[ai][0][m][0][i] * si) * (acc[ai][1][m][0][i] * (si * FP8_SH)); v1[i] = silu_f(acc[ai][0][m][1][i] * si) * (acc[ai][1][m][1][i] * (si * FP8_SH)); }
                typedef unsigned u32x2 __attribute__((ext_vector_type(2))); u32x2 w; w.x = pk4_fp8(v0[0], v0[1], v0[2], v0[3]); w.y = pk4_fp8(v1[0], v1[1], v1[2], v1[3]);
                *(u32x2*)rowp = w; }
    }
};
__device__ __forceinline__ float logf_gate(float x, float la, float l1) {
    const float ls = fminf(x, 0.f) - __logf(1.0f + __expf(-fabsf(x)));
    const float b = l1 + ls;
    if (la == -INFINITY) return b;
    const float mx = fmaxf(la, b), d = fabsf(la - b);
    return mx + __logf(1.0f + __expf(-d));
}
struct EpiHgrnIn {
    static constexpr bool PERM = true, AFTER_DRAIN = false;
    unsigned char* ws; int layer;
    static constexpr size_t O_PQ = 580ull << 20, O_PI = O_PQ + (128ull << 20), O_PG = O_PQ + (256ull << 20), O_LF = O_PQ + (384ull << 20), O_LA = 1ull << 20, O_L1 = O_LA + 8192;
    __device__ __forceinline__ void operator()(const f32x4 (&acc)[2][2][4][2], const Unit& u, int wr, int wc, int fr, int fq) const {
        const int quarter = u.pn >> 2;
        const int row0 = u.pm * BM + wr * 64 + fr, col0 = (u.pn & 3) * BM + wc * 32 + 8 * fq;
        if (quarter == 1) {
            const float* la = (const float*)(ws + O_LA) + layer * 1024; const float* l1 = (const float*)(ws + O_L1) + layer * 1024; float* LF = (float*)(ws + O_LF);
            f32x4 A0[2][2], A1[2][2];
#pragma unroll
            for (int bj = 0; bj < 2; ++bj)
#pragma unroll
                for (int n = 0; n < 2; ++n) { A0[bj][n] = *(const f32x4*)(la + col0 + bj * HALF + 4 * n); A1[bj][n] = *(const f32x4*)(l1 + col0 + bj * HALF + 4 * n); }
#pragma unroll
            for (int ai = 0; ai < 2; ++ai)
#pragma unroll
                for (int m = 0; m < 4; ++m) { float* rowp = LF + (size_t)(row0 + ai * HALF + m * 16) * 1024 + col0;
#pragma unroll
                    for (int bj = 0; bj < 2; ++bj)
#pragma unroll
                        for (int n = 0; n < 2; ++n) { f32x4 o;
#pragma unroll
                            for (int i = 0; i < 4; ++i) o[i] = logf_gate(acc[ai][bj][m][n][i], A0[bj][n][i], A1[bj][n][i]);
                            *(f32x4*)(rowp + bj * HALF + 4 * n) = o; } }
        } else {
            bf16_t* O = (bf16_t*)(ws + (quarter == 0 ? O_PQ : (quarter == 2 ? O_PI : O_PG)));
#pragma unroll
            for (int ai = 0; ai < 2; ++ai)
#pragma unroll
                for (int m = 0; m < 4; ++m) { bf16_t* rowp = O + (size_t)(row0 + ai * HALF + m * 16) * 1024 + col0;
#pragma unroll
                    for (int bj = 0; bj < 2; ++bj) { f32x4 v0 = acc[ai][bj][m][0], v1 = acc[ai][bj][m][1];
                        if (quarter != 2) {
#pragma unroll
                            for (int i = 0; i < 4; ++i) { v0[i] = silu_f(v0[i]); v1[i] = silu_f(v1[i]); } }
                        u32x4 w; w.x = cvt_pk_bf16(v0[0], v0[1]); w.y = cvt_pk_bf16(v0[2], v0[3]); w.z = cvt_pk_bf16(v1[0], v1[1]); w.w = cvt_pk_bf16(v1[2], v1[3]);
                        *(u32x4*)(rowp + bj * HALF) = w; } }
        }
    }
};

template <class Epi, class Sched, bool ALIGN_EPI = false, bool SP2 = false, bool FP8 = false>
__device__ __forceinline__ void gemm_phase(PG8_LAS unsigned char* lds, const Gemm g, const Sched& S, const Epi& E, const int wave_id) {
    int lane_; asm volatile("v_mbcnt_lo_u32_b32 %0, -1, 0\n\tv_mbcnt_hi_u32_b32 %0, -1, %0" : "=v"(lane_));
    const int wid = wave_id, lane = lane_, tid = wid * 64 + lane, wr = wid >> 2, wc = wid & 3, fr = lane & 15, fq = lane >> 4;
    const int K = g.K, nt = K / BK, lda = g.lda;
    unsigned voffA[2], voffB[2];
#pragma unroll
    for (int i = 0; i < 2; ++i) { int R, C; stage_rc(tid * 16 + i * 8192, R, C); const int Rb = Epi::PERM ? ((R & ~31) + perm32(R & 31)) : R;
        voffA[i] = (unsigned)(R * lda + C) * 2u; voffB[i] = (unsigned)(Rb * K + C) * 2u; }
    const size_t kstep = (size_t)(BK * 2);
    const size_t hstep = (size_t)HALF * K * 2;
    const size_t tstep = 2 * hstep;
    const size_t hstepA = (size_t)HALF * lda * 2, tstepA = 2 * hstepA;
    const unsigned ldsw = (unsigned)wid * 1024u;
    const int aoff = lds_byte(wr * 64 + fr, fq * 8), boff = lds_byte(wc * 32 + fr, fq * 8);
#define PG8_SA(b, h) (((b) * 2 + (h)) * HTB)
#define PG8_SB(b, h) ((4 + (b) * 2 + (h)) * HTB)
#define PG8_STAGE(bufoff, gbase, voff) do { _Pragma("unroll") for (int _i = 0; _i < 2; ++_i) \
        __builtin_amdgcn_global_load_lds((const unsigned*)((const char*)(gbase) + (voff)[_i]), (PG8_LAS unsigned*)(lds + (bufoff) + ldsw + _i * 8192), 16, 0, 0); } while (0)
    typedef int i32x4_ __attribute__((ext_vector_type(4))); typedef int i32x8_ __attribute__((ext_vector_type(8)));
#define PG8_CAT(x, y) __builtin_shufflevector((x), (y), 0, 1, 2, 3, 4, 5, 6, 7)
#define PG8_LDA(dst, b, h) do { _Pragma("unroll") for (int m = 0; m < 4; ++m) { \
        if constexpr (FP8) dst##8[m] = PG8_CAT(*(const PG8_LAS i32x4_*)(lds + PG8_SA(b, h) + aoff + m * 2048), *(const PG8_LAS i32x4_*)(lds + PG8_SA(b, h) + aoff + m * 2048 + 1024)); \
        else { _Pragma("unroll") for (int k = 0; k < 2; ++k) dst[m][k] = *(const PG8_LAS bf16x8*)(lds + PG8_SA(b, h) + aoff + m * 2048 + k * 1024); } } } while (0)
#define PG8_LDB(dst, b, h) do { _Pragma("unroll") for (int n = 0; n < 2; ++n) { \
        if constexpr (FP8) dst##8[n] = PG8_CAT(*(const PG8_LAS i32x4_*)(lds + PG8_SB(b, h) + boff + n * 2048), *(const PG8_LAS i32x4_*)(lds + PG8_SB(b, h) + boff + n * 2048 + 1024)); \
        else { _Pragma("unroll") for (int k = 0; k < 2; ++k) dst[n][k] = *(const PG8_LAS bf16x8*)(lds + PG8_SB(b, h) + boff + n * 2048 + k * 1024); } } } while (0)
#define PG8_MMA(ai, bj, At, Bt) do { __builtin_amdgcn_s_setprio(1); _Pragma("unroll") for (int m = 0; m < 4; ++m) _Pragma("unroll") for (int n = 0; n < 2; ++n) { \
        if constexpr (FP8) asm volatile("v_mfma_scale_f32_16x16x128_f8f6f4 %0, %1, %2, %0, %3, %3 op_sel_hi:[0,0,0]" : "+v"(acc[ai][bj][m][n]) : "v"(Bt##8[n]), "v"(At##8[m]), "v"(f8scale_)); \
        else { _Pragma("unroll") for (int k = 0; k < 2; ++k) acc[ai][bj][m][n] = __builtin_amdgcn_mfma_f32_16x16x32_bf16(Bt[n][k], At[m][k], acc[ai][bj][m][n], 0, 0, 0); } } \
        __builtin_amdgcn_s_setprio(0); } while (0)
#define PG8_WAIT_V(n) asm volatile("s_waitcnt vmcnt(" #n ")" ::: "memory")
#define PG8_WAIT_L(n) asm volatile("s_waitcnt lgkmcnt(" #n ")" ::: "memory")
#define PG8_BAR __builtin_amdgcn_s_barrier()
#define PG8_SCHED __builtin_amdgcn_sched_barrier(0)
    Unit cur, nxt; int ui = 0;
    if (!S.next(0, cur)) return;
    f32x4 acc[2][2][4][2];
#pragma unroll
    for (int a = 0; a < 2; ++a)
#pragma unroll
        for (int b = 0; b < 2; ++b)
#pragma unroll
            for (int m = 0; m < 4; ++m)
#pragma unroll
                for (int n = 0; n < 2; ++n) acc[a][b][m][n] = (f32x4){0.f, 0.f, 0.f, 0.f};
    const int f8scale_ = 0x7f7f7f7f;
    bf16x8 At[4][2], B0[2][2], B1[2][2]; i32x8_ At8[4], B08[2], B18[2];
    const char* cA = (const char*)g.A + (size_t)cur.pm * tstepA; const char* cB = (const char*)g.Bt + (size_t)cur.e * g.estride + (size_t)cur.pn * tstep;
    S.a_ready(cur);
    if constexpr (SP2) {
        PG8_STAGE(PG8_SB(0, 0), cB, voffB); PG8_STAGE(PG8_SB(0, 1), cB + hstep, voffB); PG8_STAGE(PG8_SA(0, 0), cA, voffA); PG8_STAGE(PG8_SA(0, 1), cA + hstepA, voffA);
        if (wr == 1) PG8_BAR;
        PG8_WAIT_V(2); PG8_BAR;
        PG8_STAGE(PG8_SB(1, 0), cB + kstep, voffB); PG8_STAGE(PG8_SA(1, 0), cA + kstep, voffA); PG8_STAGE(PG8_SB(1, 1), cB + hstep + kstep, voffB);
        PG8_WAIT_V(6); PG8_BAR;
    } else {
        PG8_STAGE(PG8_SB(0, 0), cB, voffB); PG8_STAGE(PG8_SA(0, 0), cA, voffA); PG8_STAGE(PG8_SB(0, 1), cB + hstep, voffB); PG8_STAGE(PG8_SA(0, 1), cA + hstepA, voffA);
        if (wr == 1) PG8_BAR;
        PG8_WAIT_V(4); PG8_BAR;
        PG8_STAGE(PG8_SB(1, 0), cB + kstep, voffB); PG8_STAGE(PG8_SA(1, 0), cA + kstep, voffA); PG8_STAGE(PG8_SB(1, 1), cB + hstep + kstep, voffB);
        PG8_WAIT_V(6); PG8_BAR;
    }
    for (;;) {
        const bool has_next = S.next(ui + 1, nxt);
        const char* nA = has_next ? (const char*)g.A + (size_t)nxt.pm * tstepA : cA; const char* nB = has_next ? (const char*)g.Bt + (size_t)nxt.e * g.estride + (size_t)nxt.pn * tstep : cB;
        for (int t = 0; t < nt; t += 2) {
            const bool last = (t == nt - 2);
            const char* a1 = cA + (size_t)(t + 1) * kstep;
            const char* a2 = last ? nA : cA + (size_t)(t + 2) * kstep; const char* b2 = last ? nB : cB + (size_t)(t + 2) * kstep;
            const char* a3 = a2 + kstep; const char* b3 = b2 + kstep;
            if (last && has_next) S.a_ready(nxt);
            if constexpr (SP2) {
            PG8_LDB(B0, 0, 0); PG8_LDB(B1, 0, 1); PG8_SCHED; PG8_LDA(At, 0, 0); PG8_STAGE(PG8_SA(1, 1), a1 + hstepA, voffA);
            PG8_WAIT_V(8); PG8_WAIT_L(0); PG8_BAR; PG8_MMA(0, 0, At, B0); PG8_MMA(0, 1, At, B1); PG8_BAR; PG8_SCHED;
            PG8_LDA(At, 0, 1); PG8_STAGE(PG8_SB(0, 0), b2, voffB); PG8_STAGE(PG8_SB(0, 1), b2 + hstep, voffB); PG8_STAGE(PG8_SA(0, 0), a2, voffA);
            PG8_WAIT_V(8); PG8_WAIT_L(0); PG8_BAR; PG8_MMA(1, 0, At, B0); PG8_MMA(1, 1, At, B1); PG8_BAR; PG8_SCHED;
            PG8_LDB(B0, 1, 0); PG8_LDB(B1, 1, 1); PG8_SCHED; PG8_LDA(At, 1, 0); PG8_STAGE(PG8_SA(0, 1), a2 + hstepA, voffA);
            PG8_WAIT_V(8); PG8_WAIT_L(0); PG8_BAR; PG8_MMA(0, 0, At, B0); PG8_MMA(0, 1, At, B1); PG8_BAR; PG8_SCHED;
            PG8_LDA(At, 1, 1); PG8_STAGE(PG8_SB(1, 0), b3, voffB); PG8_STAGE(PG8_SB(1, 1), b3 + hstep, voffB); PG8_STAGE(PG8_SA(1, 0), a3, voffA);
            PG8_WAIT_V(8); PG8_WAIT_L(0); PG8_BAR; PG8_MMA(1, 0, At, B0); PG8_MMA(1, 1, At, B1); PG8_BAR; PG8_SCHED;
            } else {
            PG8_LDB(B0, 0, 0); PG8_SCHED; PG8_LDA(At, 0, 0); PG8_STAGE(PG8_SA(1, 1), a1 + hstepA, voffA);
            PG8_WAIT_L(8); PG8_BAR; PG8_WAIT_L(0); PG8_MMA(0, 0, At, B0); PG8_BAR; PG8_SCHED;
            PG8_LDB(B1, 0, 1); PG8_STAGE(PG8_SB(0, 0), b2, voffB);
            PG8_BAR; PG8_WAIT_L(0); PG8_MMA(0, 1, At, B1); PG8_BAR;
            PG8_LDA(At, 0, 1); PG8_STAGE(PG8_SA(0, 0), a2, voffA);
            PG8_BAR; PG8_WAIT_L(0); PG8_MMA(1, 0, At, B0); PG8_BAR; PG8_SCHED;
            PG8_STAGE(PG8_SB(0, 1), b2 + hstep, voffB);
            PG8_WAIT_V(6); PG8_BAR; PG8_MMA(1, 1, At, B1); PG8_BAR;
            PG8_LDB(B0, 1, 0); PG8_SCHED; PG8_LDA(At, 1, 0); PG8_STAGE(PG8_SA(0, 1), a2 + hstepA, voffA);
            PG8_WAIT_L(8); PG8_BAR; PG8_WAIT_L(0); PG8_MMA(0, 0, At, B0); PG8_BAR; PG8_SCHED;
            PG8_LDB(B1, 1, 1); PG8_STAGE(PG8_SB(1, 0), b3, voffB);
            PG8_BAR; PG8_WAIT_L(0); PG8_MMA(0, 1, At, B1); PG8_BAR;
            PG8_LDA(At, 1, 1); PG8_STAGE(PG8_SA(1, 0), a3, voffA);
            PG8_BAR; PG8_WAIT_L(0); PG8_MMA(1, 0, At, B0); PG8_BAR; PG8_SCHED;
            PG8_STAGE(PG8_SB(1, 1), b3 + hstep, voffB);
            PG8_WAIT_V(6); PG8_BAR; PG8_MMA(1, 1, At, B1); PG8_BAR;
            }
        }
        if constexpr (FP8) asm volatile("s_nop 15\n\ts_nop 15" ::: "memory");
        if constexpr (ALIGN_EPI) { if (wr == 0) PG8_BAR; }
        if constexpr (!Epi::AFTER_DRAIN) { E(acc, cur, wr, wc, fr, fq); S.done(cur); }
        if (!has_next) break;
#pragma unroll
        for (int a = 0; a < 2; ++a)
#pragma unroll
            for (int b = 0; b < 2; ++b)
#pragma unroll
                for (int m = 0; m < 4; ++m)
#pragma unroll
                    for (int n = 0; n < 2; ++n) acc[a][b][m][n] = (f32x4){0.f, 0.f, 0.f, 0.f};
        cur = nxt; cA = nA; cB = nB; ++ui;
        if constexpr (ALIGN_EPI) { if (wr == 1) PG8_BAR; }
    }
    PG8_WAIT_V(0);
    if constexpr (!ALIGN_EPI) { if (wr == 0) PG8_BAR; }
    PG8_BAR;
    if constexpr (Epi::AFTER_DRAIN) { E.fused(acc, cur, wr, wc, fr, fq, lds, wid, lane); S.done(cur); }
#undef PG8_SA
#undef PG8_SB
#undef PG8_STAGE
#undef PG8_LDA
#undef PG8_LDB
#undef PG8_MMA
#undef PG8_CAT
#undef PG8_WAIT_V
#undef PG8_WAIT_L
#undef PG8_BAR
#undef PG8_SCHED
}
}

constexpr int NT = 65536, DM = 1024, NBATCH = 32, SEQ = 2048;
constexpr int DFF = 2816, DFE = 3584, NEXP = 8;
constexpr int MOE_ROWS = 133120;
constexpr float EPS = 1e-6f;
constexpr size_t MiB = 1u << 20;
constexpr size_t WS_CTL = 0, CTL_ZERO_BYTES = 1 * MiB;
constexpr size_t WS_LA = 1 * MiB;
constexpr size_t WS_L1 = WS_LA + 8192;
constexpr size_t WS_CB = WS_LA + 16384;
constexpr size_t WS_RCNT = WS_LA + 32768;
constexpr size_t WS_RTAB = WS_LA + 65536;
constexpr size_t WS_ROUTE = 2 * MiB;
constexpr size_t WS_SLOT = 3 * MiB;
constexpr size_t WS_SELM = 4 * MiB;
constexpr size_t WS_GATES = 8 * MiB;
constexpr size_t WS_KC = 20 * MiB;
constexpr size_t WS_VCT = 22 * MiB;
constexpr size_t WS_HC = 24 * MiB;
constexpr size_t WS_W = 48 * MiB;
constexpr size_t W_HIN = WS_W, W_HOUT = WS_W + 16 * MiB, W_KVQ = WS_W + 20 * MiB, W_Q3 = WS_W + 26 * MiB, W_CMP1 = WS_W + 29 * MiB, W_NOUT = WS_W + 31 * MiB,
                 W_FGU = WS_W + 35 * MiB, W_FDN = WS_W + 57 * MiB, W_MGU = WS_W + 68 * MiB, W_MDN = WS_W + 292 * MiB;
constexpr size_t WS_XN = 452 * MiB;
constexpr size_t WS_R = 580 * MiB;
constexpr size_t R_PQ = WS_R, R_PI = WS_R + 128 * MiB, R_PG = WS_R + 256 * MiB, R_LF = WS_R + 384 * MiB, R_O2 = WS_R + 640 * MiB;
constexpr size_t R_HF = WS_R + 256 * MiB;
constexpr size_t R_KS = WS_R, R_KW = WS_R + 32 * MiB, R_VST = WS_R + 64 * MiB, R_VWT = WS_R + 96 * MiB, R_KCR = WS_R + 128 * MiB, R_VCR = WS_R + 160 * MiB;
constexpr size_t R_QKV = WS_R + 256 * MiB;
constexpr size_t R_Q = WS_R + 608 * MiB, R_O = WS_R + 736 * MiB;
constexpr size_t R_XP = WS_R, R_HM = WS_R + 260 * MiB;
constexpr size_t WS_NEED = R_HM + (size_t)MOE_ROWS * DFE * 2;
static_assert(WS_NEED <= 1792 * MiB, "workspace map");
static_assert(W_MDN + 112 * MiB <= WS_XN, "weights map");
static_assert(pg8::EpiHgrnIn::O_PQ == R_PQ && pg8::EpiHgrnIn::O_PI == R_PI && pg8::EpiHgrnIn::O_PG == R_PG && pg8::EpiHgrnIn::O_LF == R_LF && pg8::EpiHgrnIn::O_LA == WS_LA && pg8::EpiHgrnIn::O_L1 == WS_L1, "EpiHgrnIn offsets");

constexpr int LDS_BYTES = 147456;
constexpr int MISC_OFF = 131072 + 320;
constexpr int NWAVES = 8;

#define GAS __attribute__((address_space(1)))
#define LAS __attribute__((address_space(3)))
typedef unsigned short bf16;
typedef unsigned v4u __attribute__((ext_vector_type(4)));
typedef unsigned v2u __attribute__((ext_vector_type(2)));
typedef float f32x4 __attribute__((ext_vector_type(4)));
#define LDS_WAIT() asm volatile("s_waitcnt lgkmcnt(0)" ::: "memory")
__device__ __forceinline__ unsigned f2bf(float f) { unsigned u = __builtin_bit_cast(unsigned, f); return (u + 0x7fffu + ((u >> 16) & 1u)) >> 16; }
__device__ __forceinline__ unsigned pk2(float lo, float hi) { return f2bf(lo) | (f2bf(hi) << 16); }
__device__ __forceinline__ float bf2f(unsigned b) { return __builtin_bit_cast(float, b << 16); }
__device__ __forceinline__ float bflo(unsigned w) { return __builtin_bit_cast(float, w << 16); }
__device__ __forceinline__ float bfhi(unsigned w) { return __builtin_bit_cast(float, w & 0xffff0000u); }
__device__ __forceinline__ float wave_sum(float v) {
#pragma unroll
    for (int o = 32; o >= 1; o >>= 1) v += __shfl_xor(v, o);
    return v;
}
__device__ __forceinline__ float wave_max(float v) {
#pragma unroll
    for (int o = 32; o >= 1; o >>= 1) v = fmaxf(v, __shfl_xor(v, o));
    return v;
}

#define XB_TMO      128
#define XB_XCNT(j)  (256  + 64 * (j))
#define XB_XSUB(j)  (1280 + 64 * (j))
#define XB_XGEN(j)  (2304 + 64 * (j))
#define XB_TOP      3328
#define XB_TOPGEN   3392
#define XCD_BAR_WORDS 3456
#define XB_SPIN_CAP (1u << 22)
__device__ __forceinline__ unsigned xb_ld(unsigned* p)              { return __hip_atomic_load(p, __ATOMIC_RELAXED, __HIP_MEMORY_SCOPE_AGENT); }
__device__ __forceinline__ unsigned xb_add(unsigned* p, unsigned v) { return __hip_atomic_fetch_add(p, v, __ATOMIC_RELAXED, __HIP_MEMORY_SCOPE_AGENT); }
__device__ __forceinline__ unsigned xb_xcc_id() { return (unsigned)__builtin_amdgcn_s_getreg((3 << 11) | 20) & 0xFu; }
#define XB_SPIN(cond, bar) do { unsigned _sp = 0; while (cond) { __builtin_amdgcn_s_sleep(1); \
    if ((++_sp & 255u) == 0u) { if (xb_ld(&(bar)[XB_TMO])) break; if (_sp > XB_SPIN_CAP) { atomicAdd(&(bar)[XB_TMO], 1u); break; } } } } while (0)
struct XcdBarrier { unsigned* bar; unsigned x; volatile LAS unsigned* st; };
__device__ __forceinline__ XcdBarrier xcd_barrier_post(unsigned* bar, volatile LAS unsigned* st) {
    XcdBarrier b; b.bar = bar; b.x = xb_xcc_id(); b.st = st;
    if (threadIdx.x == 0) (void)xb_add(&bar[XB_XCNT(b.x)], 1u);
    return b;
}
__device__ __forceinline__ void xcd_barrier_complete(unsigned* bar, unsigned x, unsigned& nloc, unsigned& nx) {
    const unsigned G = gridDim.x * gridDim.y * gridDim.z;
    unsigned sum, cnt, mine, sp = 0u;
    for (;;) {
        sum = 0u; cnt = 0u; mine = 0u;
#pragma unroll
        for (unsigned j = 0; j < 16; ++j) { const unsigned c = xb_ld(&bar[XB_XCNT(j)]); sum += c; cnt += (c > 0u) ? 1u : 0u; mine = (j == x) ? c : mine; }
        if (sum == G) break;
        __builtin_amdgcn_s_sleep(1);
        if ((++sp & 255u) == 0u) { if (xb_ld(&bar[XB_TMO])) break; if (sp > XB_SPIN_CAP) { atomicAdd(&bar[XB_TMO], 1u); break; } }
    }
    nloc = mine > 0u ? mine : 1u; nx = cnt > 0u ? cnt : 1u;
}
__device__ __forceinline__ void xcd_barrier(const XcdBarrier& b) {
    asm volatile("s_waitcnt vmcnt(0)" ::: "memory");
    __syncthreads();
    if (threadIdx.x == 0) {
        unsigned* bar = b.bar; unsigned bx_ = b.x; asm volatile("" : "+s"(bar), "+s"(bx_));
        __builtin_amdgcn_s_waitcnt(0);
        unsigned nloc = b.st[0], nx = b.st[1];
        if (nloc == 0u) { xcd_barrier_complete(bar, bx_, nloc, nx); b.st[0] = nloc; b.st[1] = nx; }
        const unsigned old = xb_add(&bar[XB_XSUB(bx_)], 1u);
        const unsigned gen = old / nloc;
        if (old + 1u == (gen + 1u) * nloc) {
            __builtin_amdgcn_fence(__ATOMIC_RELEASE, "agent");
            asm volatile("s_waitcnt vmcnt(0)" ::: "memory");
            const unsigned og = xb_add(&bar[XB_TOP], 1u);
            const unsigned tg = og / nx;
            if (og + 1u == (tg + 1u) * nx) xb_add(&bar[XB_TOPGEN], 1u);
            else XB_SPIN(xb_ld(&bar[XB_TOPGEN]) == tg, bar);
            __builtin_amdgcn_fence(__ATOMIC_ACQUIRE, "agent");
            xb_add(&bar[XB_XGEN(bx_)], 1u);
            asm volatile("s_waitcnt vmcnt(0)" ::: "memory");
        } else {
            XB_SPIN(xb_ld(&bar[XB_XGEN(bx_)]) == gen, bar);
            __builtin_amdgcn_fence(__ATOMIC_ACQUIRE, "agent");
            asm volatile("s_waitcnt vmcnt(0)" ::: "memory");
        }
    }
    __syncthreads();
}

struct Ctx {
    LAS unsigned char* lds;
    int tid, lane, wave, G, bid;
    float* out; unsigned char* ws;
    __device__ __forceinline__ const float* inp(int i) const {
        const __attribute__((address_space(4))) unsigned char* kp = (const __attribute__((address_space(4))) unsigned char*)__builtin_amdgcn_kernarg_segment_ptr();
        asm volatile("" : "+s"(kp));
        return ((const float* const __attribute__((address_space(4)))*)kp)[i];
    }
};
enum { I_X = 0, I_NMIX, I_NFFN, I_HWIN, I_HWOUT, I_HGN, I_HLB, I_KVN, I_KVW, I_CPK, I_CW1K, I_CW2K, I_CPV, I_CW1V, I_CW2V, I_KN, I_NWIN, I_NWOUT, I_NQN, I_FGU, I_FDN, I_MR, I_MGU, I_MDN };

constexpr int MAXJOB = 64;
struct JobTab { unsigned long long src[MAXJOB], gain[MAXJOB], dst[MAXJOB]; int K[MAXJOB], Nsrc[MAXJOB], npb[MAXJOB], F[MAXJOB], rowoff[MAXJOB], istart[MAXJOB + 1]; float f8s[MAXJOB]; int njobs; };
__device__ __forceinline__ void add_job(LAS JobTab* J, const float* src, const float* gain, bf16* dst, int K, int Nsrc, int Npad, int F, int rowoff, float f8s = 0.f) {
    const int j = J->njobs; J->src[j] = (unsigned long long)src; J->gain[j] = (unsigned long long)gain; J->dst[j] = (unsigned long long)dst;
    J->K[j] = K; J->Nsrc[j] = Nsrc; J->npb[j] = Npad / 32; J->F[j] = F; J->rowoff[j] = rowoff; J->f8s[j] = f8s; J->istart[j + 1] = J->istart[j] + (K / 64) * (Npad / 32); J->njobs = j + 1;
}
__device__ __forceinline__ void transpose_item(const float* W, int K, int Nsrc, const float* gain, bf16* WT, int dstrow0, int k0, int n0, LAS float* scr, int lane, float f8s) {
    const int c4 = lane & 7, kr = lane >> 3, n = n0 + 4 * c4; const bool okn = n < Nsrc;
    f32x4 v[8];
#pragma unroll
    for (int i = 0; i < 8; ++i) { const int kk = 8 * i + kr; v[i] = okn ? *(const f32x4*)(W + (size_t)(k0 + kk) * Nsrc + n) : (f32x4){0.f, 0.f, 0.f, 0.f}; }
#pragma unroll
    for (int i = 0; i < 8; ++i) { const int kk = 8 * i + kr; if (gain) v[i] = v[i] * gain[k0 + kk]; *(LAS f32x4*)(scr + kk * 36 + 4 * c4) = v[i]; }
    LDS_WAIT();
    const int c = lane & 7;
#pragma unroll
    for (int j = 0; j < 4; ++j) { const int nn = (lane >> 3) + 8 * j; const LAS float* s = scr + (8 * c) * 36 + nn;
        if (f8s != 0.f) { v2u o; o.x = pg8::pk4_fp8(s[0 * 36] * f8s, s[1 * 36] * f8s, s[2 * 36] * f8s, s[3 * 36] * f8s); o.y = pg8::pk4_fp8(s[4 * 36] * f8s, s[5 * 36] * f8s, s[6 * 36] * f8s, s[7 * 36] * f8s);
            *(v2u*)((unsigned char*)WT + (size_t)(dstrow0 + nn) * K + k0 + 8 * c) = o; }
        else { v4u o; o.x = pk2(s[0 * 36], s[1 * 36]); o.y = pk2(s[2 * 36], s[3 * 36]); o.z = pk2(s[4 * 36], s[5 * 36]); o.w = pk2(s[6 * 36], s[7 * 36]);
            *(v4u*)(WT + (size_t)(dstrow0 + nn) * K + k0 + 8 * c) = o; } }
    LDS_WAIT();
}
__device__ __forceinline__ void norm_row_store(const f32x4 (&v)[4], bf16* orow, int lane) {
    float s = 0.f;
#pragma unroll
    for (int j = 0; j < 4; ++j) s += (v[j].x * v[j].x + v[j].y * v[j].y) + (v[j].z * v[j].z + v[j].w * v[j].w);
    const float rstd = rsqrtf(wave_sum(s) * (1.f / DM) + EPS);
    v2u* o8 = (v2u*)orow + lane;
#pragma unroll
    for (int j = 0; j < 4; ++j) { v2u w; w.x = pk2(v[j].x * rstd, v[j].y * rstd); w.y = pk2(v[j].z * rstd, v[j].w * rstd); o8[64 * j] = w; }
}
__device__ __forceinline__ void p_prologue(Ctx& C) {
    LAS JobTab* J = (LAS JobTab*)(C.lds + 73728);
    unsigned char* ws = C.ws;
    if (C.tid == 0) {
        J->njobs = 0; J->istart[0] = 0;
        for (int l = 0; l < 2; ++l) add_job(J, C.inp(I_HWIN) + (size_t)l * 1024 * 4096, C.inp(I_NMIX) + l * 1024, (bf16*)(ws + W_HIN) + (size_t)l * 4096 * 1024, 1024, 4096, 4096, 0, 0);
        for (int l = 0; l < 2; ++l) add_job(J, C.inp(I_HWOUT) + (size_t)l * 1024 * 1024, nullptr, (bf16*)(ws + W_HOUT) + (size_t)l * 1024 * 1024, 1024, 1024, 1024, 0, 0);
        add_job(J, C.inp(I_KVW), C.inp(I_KVN), (bf16*)(ws + W_KVQ), 1024, 1536, 1536, 0, 0);
        add_job(J, C.inp(I_NWIN), C.inp(I_NMIX) + 2048, (bf16*)(ws + W_KVQ), 1024, 1072, 1280, 0, 1536);
        add_job(J, C.inp(I_NWIN) + (size_t)1024 * 1072, C.inp(I_NMIX) + 3072, (bf16*)(ws + W_Q3), 1024, 1072, 1280, 0, 0);
        add_job(J, C.inp(I_CW1K), nullptr, (bf16*)(ws + W_CMP1), 2048, 256, 256, 0, 0);
        add_job(J, C.inp(I_CW1V), nullptr, (bf16*)(ws + W_CMP1) + (size_t)256 * 2048, 2048, 256, 256, 0, 0);
        for (int l = 0; l < 2; ++l) add_job(J, C.inp(I_NWOUT) + (size_t)l * 1024 * 1024, nullptr, (bf16*)(ws + W_NOUT) + (size_t)l * 1024 * 1024, 1024, 1024, 1024, 0, 0);
        for (int l = 0; l < 2; ++l) add_job(J, C.inp(I_FGU) + (size_t)l * 1024 * 2 * DFF, C.inp(I_NFFN) + (2 * l) * 1024, (bf16*)(ws + W_FGU + (size_t)l * 2 * DFF * 2048), 1024, 2 * DFF, 2 * DFF, DFF, 0, l ? pg8::FP8_SW1 : 0.f);
        for (int l = 0; l < 2; ++l) add_job(J, C.inp(I_FDN) + (size_t)l * DFF * 1024, nullptr, (bf16*)(ws + W_FDN + (size_t)l * 1024 * DFF * 2), DFF, 1024, 1024, 0, 0, l ? pg8::FP8_SW2 : 0.f);
        for (int l = 0; l < 16; ++l) add_job(J, C.inp(I_MGU) + (size_t)l * 1024 * 2 * DFE, C.inp(I_NFFN) + (2 * (l >> 3) + 1) * 1024, (bf16*)(ws + W_MGU + (size_t)l * 2 * DFE * 1024), 1024, 2 * DFE, 2 * DFE, DFE, 0, pg8::FP8_SW1);
        for (int l = 0; l < 16; ++l) add_job(J, C.inp(I_MDN) + (size_t)l * DFE * 1024, nullptr, (bf16*)(ws + W_MDN + (size_t)l * 1024 * DFE), DFE, 1024, 1024, 0, 0, pg8::FP8_SW2);
    }
    __syncthreads();
    LAS float* scr = (LAS float*)(C.lds + C.wave * 9216);
    const int gw = C.bid * NWAVES + C.wave, NGW = C.G * NWAVES;
    const int nj = J->njobs, total = J->istart[nj];
    for (int it = gw; it < total; it += NGW) {
        int j = 0; while (j + 1 < nj && J->istart[j + 1] <= it) ++j;
        const int r = it - J->istart[j], npb = J->npb[j], kb = r / npb, nb = r % npb, n0 = 32 * nb, F = J->F[j];
        int drow = J->rowoff[j] + n0;
        if (F) drow = (n0 < F) ? 256 * (n0 / 128) + (n0 % 128) : 256 * ((n0 - F) / 128) + 128 + ((n0 - F) % 128);
        transpose_item((const float*)J->src[j], J->K[j], J->Nsrc[j], (const float*)J->gain[j], (bf16*)J->dst[j], drow, 64 * kb, n0, scr, C.lane, J->f8s[j]);
    }
    { const int gt = C.bid * 512 + C.tid;
      if (gt < 1024) { const float a0 = C.inp(I_HLB)[gt], a1 = C.inp(I_HLB)[1024 + gt]; const float mx = fmaxf(a0, a1), e0 = expf(a0 - mx), e1 = expf(a1 - mx), s = e0 + e1;
          const float s0 = e0 / s, s1 = e1 / s, lb1 = (s0 + s1) - s0;
          float* la = (float*)(ws + WS_LA); float* l1 = (float*)(ws + WS_L1);
          la[gt] = -INFINITY; l1[gt] = 0.f; la[1024 + gt] = logf(lb1); l1[1024 + gt] = log1pf(-lb1); } }
    if (C.bid == 0 && C.tid < 128) ((int*)(ws + WS_RTAB))[2048 + C.tid] = C.tid >> 6;
    if (C.G >= 8 && C.bid >= C.G - 8) { const int ob = (C.bid - (C.G - 8)) * 64 + C.lane, which = ob >> 8, j = ob & 255; const float* pos = C.inp(which ? I_CPV : I_CPK); const float* w1 = C.inp(which ? I_CW1V : I_CW1K);
        float a = 0.f;
#pragma unroll 8
        for (int i = C.wave * 256; i < C.wave * 256 + 256; ++i) a += pos[i] * w1[(size_t)i * 256 + j];
        __syncthreads();
        LAS float* red = (LAS float*)(C.lds + 80 * 1024); red[C.wave * 64 + C.lane] = a;
        __syncthreads();
        if (C.wave == 0) { float t = 0.f;
#pragma unroll
            for (int w = 0; w < 8; ++w) t += red[w * 64 + C.lane];
            ((float*)(ws + WS_CB))[ob] = t; } }
    for (int c = C.bid; c < 256; c += C.G)
        for (int i = 0; i < 32; i += 4) { f32x4 v[4][4]; const float* xb = C.inp(I_X);
#pragma unroll
            for (int r = 0; r < 4; ++r) { const f32x4* xr = (const f32x4*)(xb + (size_t)(c * 256 + C.wave * 32 + i + r) * DM) + C.lane;
#pragma unroll
                for (int j = 0; j < 4; ++j) v[r][j] = xr[64 * j]; }
#pragma unroll
            for (int r = 0; r < 4; ++r) norm_row_store(v[r], (bf16*)(ws + WS_XN) + (size_t)(c * 256 + C.wave * 32 + i + r) * DM, C.lane); }
}

template <bool MOE_ADD, bool ROUTER, bool WRITE_XN, bool XN_FP8 = false>
__device__ __forceinline__ void p_norm(Ctx& C, const float* rw, const float* rgain) {
    unsigned char* ws = C.ws;
    LAS int* cnt8 = (LAS int*)(C.lds + 1024);
    const bf16* Y = (const bf16*)(ws + R_XP);
    const int4* route = (const int4*)(ws + WS_ROUTE); const int2* slot = (const int2*)(ws + WS_SLOT);
    constexpr int NR = (MOE_ADD || ROUTER) ? 2 : 4;
    for (int c = C.bid; c < 256; c += C.G) {
        if (ROUTER) { __syncthreads(); if (C.tid < 8) cnt8[C.tid] = 0; __syncthreads(); }
#pragma unroll 1
        for (int i = 0; i < 32; i += NR) {
            f32x4 v[NR][4];
#pragma unroll
            for (int r = 0; r < NR; ++r) { const float* hr = C.out + (size_t)(c * 256 + C.wave * 32 + i + r) * DM;
#pragma unroll
                for (int j = 0; j < 4; ++j) v[r][j] = ((const f32x4*)hr + C.lane)[64 * j]; }
            if (MOE_ADD) {
#pragma unroll
                for (int r = 0; r < NR; ++r) { const int row = c * 256 + C.wave * 32 + i + r; float* hr = C.out + (size_t)row * DM;
                    const int4 rt = route[row]; const int2 sl = slot[row]; const float w0 = __builtin_bit_cast(float, rt.y), w1 = __builtin_bit_cast(float, rt.z);
                    const v2u* y0 = (const v2u*)(Y + (size_t)sl.x * DM) + C.lane; const v2u* y1 = (const v2u*)(Y + (size_t)sl.y * DM) + C.lane;
#pragma unroll
                    for (int j = 0; j < 4; ++j) { const v2u a = y0[64 * j], b = y1[64 * j];
                        v[r][j].x += w0 * bflo(a.x) + w1 * bflo(b.x); v[r][j].y += w0 * bfhi(a.x) + w1 * bfhi(b.x); v[r][j].z += w0 * bflo(a.y) + w1 * bflo(b.y); v[r][j].w += w0 * bfhi(a.y) + w1 * bfhi(b.y);
                        ((f32x4*)hr + C.lane)[64 * j] = v[r][j]; } }
            }
            if (WRITE_XN || ROUTER) {
#pragma unroll
                for (int r = 0; r < NR; ++r) { const int row = c * 256 + C.wave * 32 + i + r;
                    float s = 0.f;
#pragma unroll
                    for (int j = 0; j < 4; ++j) s += (v[r][j].x * v[r][j].x + v[r][j].y * v[r][j].y) + (v[r][j].z * v[r][j].z + v[r][j].w * v[r][j].w);
                    const float rstd = rsqrtf(wave_sum(s) * (1.f / DM) + EPS);
                    if (WRITE_XN && XN_FP8) { unsigned* o4 = (unsigned*)(ws + WS_XN + (size_t)row * DM) + C.lane;
#pragma unroll
                        for (int j = 0; j < 4; ++j) o4[64 * j] = pg8::pk4_fp8(v[r][j].x * rstd, v[r][j].y * rstd, v[r][j].z * rstd, v[r][j].w * rstd); }
                    if (WRITE_XN && !XN_FP8) { v2u* o8 = (v2u*)((bf16*)(ws + WS_XN) + (size_t)row * DM) + C.lane;
#pragma unroll
                        for (int j = 0; j < 4; ++j) { v2u w; w.x = pk2(v[r][j].x * rstd, v[r][j].y * rstd); w.y = pk2(v[r][j].z * rstd, v[r][j].w * rstd); o8[64 * j] = w; } }
                    if (ROUTER) {
                        float lg[8];
#pragma unroll
                        for (int e = 0; e < 8; ++e) lg[e] = 0.f;
#pragma unroll
                        for (int j = 0; j < 4; ++j) { const int k0 = 4 * C.lane + 256 * j; const f32x4 g4 = *(const f32x4*)(rgain + k0);
#pragma unroll
                            for (int q = 0; q < 4; ++q) { const float xv = v[r][j][q] * rstd * g4[q]; const f32x4 wa = *(const f32x4*)(rw + (size_t)(k0 + q) * 8), wb = *(const f32x4*)(rw + (size_t)(k0 + q) * 8 + 4);
                                lg[0] += xv * wa.x; lg[1] += xv * wa.y; lg[2] += xv * wa.z; lg[3] += xv * wa.w; lg[4] += xv * wb.x; lg[5] += xv * wb.y; lg[6] += xv * wb.z; lg[7] += xv * wb.w; } }
#pragma unroll
                        for (int e = 0; e < 8; ++e) lg[e] = wave_sum(lg[e]);
                        int e0 = 0; float v0 = lg[0];
#pragma unroll
                        for (int e = 1; e < 8; ++e) if (lg[e] > v0) { v0 = lg[e]; e0 = e; }
                        int e1 = -1; float v1 = -INFINITY;
#pragma unroll
                        for (int e = 0; e < 8; ++e) if (e != e0 && (e1 < 0 || lg[e] > v1)) { v1 = lg[e]; e1 = e; }
                        const float ex = expf(v1 - v0), w0 = 1.f / (1.f + ex), w1 = ex / (1.f + ex);
                        if (C.lane == 0) { ((int4*)(ws + WS_ROUTE))[row] = make_int4(e0 | (e1 << 8), __builtin_bit_cast(int, w0), __builtin_bit_cast(int, w1), 0);
                            atomicAdd((int*)&cnt8[e0], 1); atomicAdd((int*)&cnt8[e1], 1); }
                    }
                }
            }
        }
        if (ROUTER) { __syncthreads(); if (C.tid < 8) ((int*)(ws + WS_RCNT))[c * 8 + C.tid] = cnt8[C.tid]; }
    }
}

__device__ __forceinline__ void p_gather(Ctx& C) {
    unsigned char* ws = C.ws;
    LAS int* tot = (LAS int*)(C.lds + 0);
    LAS int* pre = tot + 8;
    LAS int* base = tot + 16;
    LAS int* ee = tot + 32;
    LAS int* sl = tot + 32 + 256;
    const int* rcnt = (const int*)(ws + WS_RCNT);
    const int4* route = (const int4*)(ws + WS_ROUTE);
    for (int c = C.bid; c < 256; c += C.G) {
        __syncthreads();
        { const int e = C.wave; int t = 0, p = 0;
          for (int i = C.lane; i < 256; i += 64) { const int v = rcnt[i * 8 + e]; t += v; if (i < c) p += v; }
#pragma unroll
          for (int o = 32; o >= 1; o >>= 1) { t += __shfl_xor(t, o); p += __shfl_xor(p, o); }
          if (C.lane == 0) { tot[e] = t; pre[e] = p; } }
        if (C.tid < 256) ee[C.tid] = route[c * 256 + C.tid].x;
        __syncthreads();
        if (C.tid == 0) { int off = 0; for (int e = 0; e < 8; ++e) { base[e] = off + pre[e]; const int nt = (tot[e] + 255) >> 8;
                if (c == 0) { int* te = (int*)(ws + WS_RTAB); for (int q = 0; q < nt; ++q) te[(off >> 8) + q] = e; }
                off += nt << 8; }
            if (c == 0) ((int*)(ws + WS_RTAB))[1024] = off >> 8; }
        __syncthreads();
        if (C.tid < 8) { const int e = C.tid; int r = base[e];
            for (int i = 0; i < 256; ++i) { const int pk = ee[i]; if ((pk & 255) == e) sl[2 * i] = r++; if ((pk >> 8) == e) sl[2 * i + 1] = r++; } }
        __syncthreads();
        if (C.tid < 256) ((int2*)(ws + WS_SLOT))[c * 256 + C.tid] = make_int2(sl[2 * C.tid], sl[2 * C.tid + 1]);
        for (int i = 0; i < 32; i += 4) { v4u a[4];
#pragma unroll
            for (int r = 0; r < 4; ++r) a[r] = *((const v4u*)(ws + WS_XN + (size_t)(c * 256 + C.wave * 32 + i + r) * DM) + C.lane);
#pragma unroll
            for (int r = 0; r < 4; ++r) { const int tl = C.wave * 32 + i + r;
                *((v4u*)(ws + R_XP + (size_t)sl[2 * tl] * DM) + C.lane) = a[r]; *((v4u*)(ws + R_XP + (size_t)sl[2 * tl + 1] * DM) + C.lane) = a[r]; } }
    }
}

__device__ __forceinline__ void p_post_kv(Ctx& C) {
    unsigned char* ws = C.ws;
    const bf16* raw = (const bf16*)(ws + R_QKV);
    const float* kn = C.inp(I_KN);
    LAS unsigned char* tl = C.lds + C.wave * 4608;
    const int l = C.lane, c8 = l & 7, r8 = l >> 3, gw = C.bid * NWAVES + C.wave, NGW = C.G * NWAVES;
    for (int it = gw; it < 128 * 64; it += NGW) {
        const int bg = it >> 6, blk = it & 63, b = bg >> 2, g = bg & 3;
        const bf16* rb = raw + (size_t)(b * SEQ + blk * 32) * 2816 + g * 64 + 8 * c8;
        const size_t dst0 = ((size_t)bg * SEQ + blk * 32) * 64 + 8 * c8;
#pragma unroll
        for (int j = 0; j < 6; ++j) {
            v4u x[4];
#pragma unroll
            for (int i = 0; i < 4; ++i) x[i] = *(const v4u*)(rb + (size_t)(r8 + 8 * i) * 2816 + j * 256);
            if (j == 0 || j == 1) {
                bf16* d = (bf16*)(ws + (j == 0 ? R_KCR : R_VCR)) + dst0;
#pragma unroll
                for (int i = 0; i < 4; ++i) *(v4u*)(d + (size_t)(r8 + 8 * i) * 64) = x[i];
            } else if (j == 2 || j == 4) {
                unsigned char* d = ws + (j == 2 ? R_KS : R_KW) + ((size_t)bg * SEQ + blk * 32) * 64 + (c8 >> 2) * 1024 + (c8 & 3) * 8; const float* gk = kn + (j == 2 ? 64 : 128) + 8 * c8;
                const f32x4 ga = *(const f32x4*)gk, gb = *(const f32x4*)(gk + 4);
#pragma unroll
                for (int i = 0; i < 4; ++i) { const float f[8] = {bflo(x[i].x), bfhi(x[i].x), bflo(x[i].y), bfhi(x[i].y), bflo(x[i].z), bfhi(x[i].z), bflo(x[i].w), bfhi(x[i].w)};
                    float ss = (f[0] * f[0] + f[1] * f[1]) + (f[2] * f[2] + f[3] * f[3]) + (f[4] * f[4] + f[5] * f[5]) + (f[6] * f[6] + f[7] * f[7]);
                    ss += __shfl_xor(ss, 1); ss += __shfl_xor(ss, 2); ss += __shfl_xor(ss, 4);
                    const float rs = rsqrtf(ss * (1.f / 64.f) + EPS);
                    v2u o; o.x = pg8::pk4_fp8(f[0] * rs * ga.x, f[1] * rs * ga.y, f[2] * rs * ga.z, f[3] * rs * ga.w); o.y = pg8::pk4_fp8(f[4] * rs * gb.x, f[5] * rs * gb.y, f[6] * rs * gb.z, f[7] * rs * gb.w);
                    *(v2u*)(d + (size_t)(r8 + 8 * i) * 32) = o; }
            } else {
#pragma unroll
                for (int i = 0; i < 4; ++i) *(LAS v4u*)(tl + (r8 + 8 * i) * 144 + 16 * c8) = x[i];
                LDS_WAIT();
                unsigned wv[8];
#pragma unroll
                for (int t4 = 0; t4 < 8; ++t4) { const float a0 = bf2f(*(const LAS bf16*)(tl + (4 * t4) * 144 + 2 * l)), a1 = bf2f(*(const LAS bf16*)(tl + (4 * t4 + 1) * 144 + 2 * l)),
                                                             a2 = bf2f(*(const LAS bf16*)(tl + (4 * t4 + 2) * 144 + 2 * l)), a3 = bf2f(*(const LAS bf16*)(tl + (4 * t4 + 3) * 144 + 2 * l)); wv[t4] = pg8::pk4_fp8(a0, a1, a2, a3); }
                unsigned char* d = ws + (j == 3 ? R_VST : R_VWT) + (((size_t)bg * 64 + blk) * 64 + l) * 32;
#pragma unroll
                for (int q = 0; q < 2; ++q) { const v4u o = {wv[4 * q], wv[4 * q + 1], wv[4 * q + 2], wv[4 * q + 3]}; *(v4u*)(d + 16 * q) = o; }
                LDS_WAIT();
            }
        }
    }
}

__device__ __forceinline__ void p_cmp2(Ctx& C) {
    unsigned char* ws = C.ws;
    const bf16* Hk = (const bf16*)(ws + WS_HC); const bf16* Hv = Hk + (size_t)16384 * 256;
    const float* w2k = C.inp(I_CW2K); const float* w2v = C.inp(I_CW2V); const float* kn = C.inp(I_KN);
    LAS float* hk = (LAS float*)(C.lds + C.wave * 2048); LAS float* hv = hk + 256;
    const int l = C.lane, gw = C.bid * NWAVES + C.wave, NGW = C.G * NWAVES;
    for (int r = gw; r < 16384; r += NGW) {
        const int bg = r >> 7, c = r & 127;
        { const v2u a = *((const v2u*)(Hk + (size_t)r * 256) + l), bq = *((const v2u*)(Hv + (size_t)r * 256) + l);
          hk[4 * l] = bflo(a.x); hk[4 * l + 1] = bfhi(a.x); hk[4 * l + 2] = bflo(a.y); hk[4 * l + 3] = bfhi(a.y);
          hv[4 * l] = bflo(bq.x); hv[4 * l + 1] = bfhi(bq.x); hv[4 * l + 2] = bflo(bq.y); hv[4 * l + 3] = bfhi(bq.y); }
        LDS_WAIT();
        float ak = 0.f, av = 0.f;
#pragma unroll 8
        for (int j = 0; j < 256; ++j) { ak += hk[j] * w2k[j * 64 + l]; av += hv[j] * w2v[j * 64 + l]; }
        if (c == 127) { ak = 0.f; av = 0.f; }
        const float rs = rsqrtf(wave_sum(ak * ak) * (1.f / 64.f) + EPS);
        ((bf16*)(ws + WS_KC))[((size_t)bg * 128 + 32 * (c >> 5)) * 64 + (l >> 5) * 1024 + (c & 31) * 32 + (l & 31)] = (bf16)f2bf(ak * rs * kn[l]);
        ((bf16*)(ws + WS_VCT))[(((size_t)bg * 4 + (c >> 5)) * 64 + l) * 32 + (c & 31)] = (bf16)f2bf(av);
        LDS_WAIT();
    }
}

typedef short bf16x8v __attribute__((ext_vector_type(8)));
#define MFMA16(a, b, c) __builtin_amdgcn_mfma_f32_16x16x32_bf16((a), (b), (c), 0, 0, 0)
constexpr float LOG2E = 1.4426950408889634f;
__device__ __forceinline__ float xmax_q4(float v) {
    float t;
    asm volatile("v_mov_b32 %1, %0\n\ts_nop 1\n\tv_permlane16_swap_b32 %0, %1\n\ts_nop 1\n\tv_max_f32 %0, %0, %1\n\tv_mov_b32 %1, %0\n\ts_nop 1\n\tv_permlane32_swap_b32 %0, %1\n\ts_nop 1\n\tv_max_f32 %0, %0, %1" : "+v"(v), "=&v"(t));
    return v;
}
__device__ __forceinline__ f32x4 att_mma(bf16x8v a, bf16x8v b, f32x4 c) { return __builtin_amdgcn_mfma_f32_16x16x32_bf16(a, b, c, 0, 0, 0); }
__device__ __forceinline__ f32x4 att_mma(long a, long b, f32x4 c) { return __builtin_amdgcn_mfma_f32_16x16x32_fp8_fp8(a, b, c, 0, 0, 0); }
__device__ __forceinline__ void att_pack(bf16x8v& pf, const float (&p)[8], bool keep) {
    unsigned w0 = pg8::cvt_pk_bf16(p[0], p[1]), w1 = pg8::cvt_pk_bf16(p[2], p[3]), w2 = pg8::cvt_pk_bf16(p[4], p[5]), w3 = pg8::cvt_pk_bf16(p[6], p[7]);
    if (!keep) { w0 = 0u; w1 = 0u; w2 = 0u; w3 = 0u; }
    const v4u w = {w0, w1, w2, w3}; pf = __builtin_bit_cast(bf16x8v, w); }
__device__ __forceinline__ void att_pack(long& pf, const float (&p)[8], bool keep) {
    unsigned w0 = pg8::pk4_fp8(p[0], p[1], p[2], p[3]), w1 = pg8::pk4_fp8(p[4], p[5], p[6], p[7]);
    if (!keep) { w0 = 0u; w1 = 0u; }
    const v2u w = {w0, w1}; pf = __builtin_bit_cast(long, w); }
template <int MODE, int PATH, class FR, bool NOPV = false>
__device__ __forceinline__ void attn_step(const void* __restrict__ Kb, unsigned koff, const void* __restrict__ Vb, unsigned voff, int k0, int trel, bool tk, int cmax,
                                          const FR (&qf)[2][2], const f32x4 (&bv)[2], float (&m)[2], float (&ls)[2], f32x4 (&o)[2][4], const float (&sl2)[2], int q4) {
    constexpr int SH = sizeof(FR) == 16 ? 0 : 1;
    const char* kblk = (const char*)Kb + (((size_t)k0 * 128) >> SH); const char* vblk = (const char*)Vb + (((size_t)k0 * 128) >> SH);
    FR ka[2], kb[2], vf[4];
#pragma unroll
    for (int ks = 0; ks < 2; ++ks) { ka[ks] = *(const FR*)(kblk + koff + ((2048 * ks) >> SH)); kb[ks] = *(const FR*)(kblk + koff + ((256 + 2048 * ks) >> SH)); }
    if (!NOPV) {
#pragma unroll
        for (int dt = 0; dt < 4; ++dt) vf[dt] = *(const FR*)(vblk + voff + ((1024 * dt) >> SH)); }
    constexpr int DMUL = (MODE == 0) ? 16 : 1;
    const float trelf = (float)trel;
    bool ok[8];
    if (PATH == 2) {
#pragma unroll
        for (int i = 0; i < 8; ++i) { const int kk = 8 * q4 + i; const int d = trel - DMUL * kk; ok[i] = (MODE == 0) ? (k0 + kk <= cmax) : (MODE == 1 ? (tk && d >= 0) : (d >= 0 && d < 512)); } }
#pragma unroll
    for (int h = 0; h < 2; ++h) {
        f32x4 sa = att_mma(ka[0], qf[h][0], bv[0] * ((float)DMUL * sl2[h])), sb = att_mma(kb[0], qf[h][0], bv[1] * ((float)DMUL * sl2[h])); sa = att_mma(ka[1], qf[h][1], sa); sb = att_mma(kb[1], qf[h][1], sb);
        float mref = m[h] + sl2[h] * trelf;
        float mx;
        if (PATH == 2) { mx = -1e30f;
#pragma unroll
            for (int i = 0; i < 8; ++i) { const float v = i < 4 ? sa[i] : sb[i - 4]; mx = ok[i] ? fmaxf(mx, v) : mx; } }
        else { mx = fmaxf(fmaxf(fmaxf(sa[0], sa[1]), fmaxf(sa[2], sa[3])), fmaxf(fmaxf(sb[0], sb[1]), fmaxf(sb[2], sb[3]))); if (PATH == 1) mx = tk ? mx : -1e30f; }
        mx = xmax_q4(mx);
        if (__any(mx > mref + 8.f)) { const float mn = fmaxf(mref, mx), alpha = __builtin_amdgcn_exp2f(mref - mn); m[h] = mn - sl2[h] * trelf; mref = mn; ls[h] *= alpha;
            if (!NOPV) {
#pragma unroll
                for (int dt = 0; dt < 4; ++dt) o[h][dt] = o[h][dt] * alpha; } }
        float p[8]; float psum = 0.f;
#pragma unroll
        for (int i = 0; i < 8; ++i) { const float e = __builtin_amdgcn_exp2f((i < 4 ? sa[i] : sb[i - 4]) - mref); p[i] = (PATH == 2) ? (ok[i] ? e : 0.f) : e; psum += p[i]; }
        if (PATH == 1) psum = tk ? psum : 0.f;
        ls[h] += psum;
        FR pf; att_pack(pf, p, PATH == 1 ? tk : true);
        if (!NOPV) {
#pragma unroll
            for (int dt = 0; dt < 4; ++dt) o[h][dt] = att_mma(vf[dt], pf, o[h][dt]); }
    }
}
constexpr int PSW = 132;
__device__ __forceinline__ void p_attn_fast(Ctx& C, unsigned* queue, const int ld, const int qo, const float* qn) {
    unsigned char* ws = C.ws;
    const bf16* Qraw = (const bf16*)(ws + R_QKV);
    const bf16* KC = (const bf16*)(ws + WS_KC); const bf16* VCT = (const bf16*)(ws + WS_VCT);
    const unsigned char* KS = ws + R_KS; const unsigned char* VST = ws + R_VST; const unsigned char* KW = ws + R_KW; const unsigned char* VWT = ws + R_VWT;
    bf16* O = (bf16*)(ws + R_O);
    LAS float* psl = (LAS float*)(C.lds + C.wave * (16 * PSW * 4));
    const int l = C.lane, r16 = l & 15, q4 = l >> 4;
    const unsigned koff = (unsigned)((8 * (r16 >> 2) + (r16 & 3)) * 64 + 16 * q4), voff = (unsigned)((r16 * 32 + 8 * q4) * 2);
    int qsel = (int)(xb_xcc_id() & 7u), qtry = 0;
    for (;;) {
        unsigned u = 0; if (l == 0) u = __hip_atomic_fetch_add(queue + 64 * qsel, 1u, __ATOMIC_RELAXED, __HIP_MEMORY_SCOPE_AGENT);
        u = (unsigned)__builtin_amdgcn_readfirstlane((int)u);
        if (u >= 2048u) { if (++qtry >= 8) break; qsel = (qsel + 1) & 7; continue; }
        u = ((u >> 7) * 8 + (unsigned)qsel) * 128 + (u & 127);
        const int bg = (int)(u >> 7), tile = 127 - (int)(u & 127), g = bg & 3, b = bg >> 2, t0 = tile * 16, t = t0 + r16, row = b * SEQ + t;
        const bf16* qrow = Qraw + (size_t)row * ld + qo; const bf16* gtp = qrow + 1024 + g * 12;
#define ATT_GATE(idx) (1.f / (1.f + __expf(-bf2f(gtp[(idx)]))))
        bf16* orow = O + (size_t)row * DM + g * 256 + 4 * q4;
        bf16x8v qf[2][2]; long qf8[2][2]; float sl2[2]; f32x4 bv[2]; float m[2]; float ls[2]; f32x4 o[2][4];
#define ATT_LOADQ(hp, DM_) do { _Pragma("unroll") for (int i_ = 0; i_ < 4; ++i_) { bv[0][i_] = (float)(8 * q4 + i_); bv[1][i_] = (float)(8 * q4 + 4 + i_); } \
            _Pragma("unroll") for (int h = 0; h < 2; ++h) { sl2[h] = exp2f(-0.5f * (float)(g * 4 + 2 * (hp) + h + 1)) * LOG2E; \
            float xq_[2][8]; float ssq_ = 0.f; \
            _Pragma("unroll") for (int ks = 0; ks < 2; ++ks) { const v4u r_ = *(const v4u*)(qrow + (g * 4 + 2 * (hp) + h) * 64 + 32 * ks + 8 * q4); \
                xq_[ks][0] = bflo(r_.x); xq_[ks][1] = bfhi(r_.x); xq_[ks][2] = bflo(r_.y); xq_[ks][3] = bfhi(r_.y); xq_[ks][4] = bflo(r_.z); xq_[ks][5] = bfhi(r_.z); xq_[ks][6] = bflo(r_.w); xq_[ks][7] = bfhi(r_.w); \
                _Pragma("unroll") for (int j_ = 0; j_ < 8; ++j_) ssq_ += xq_[ks][j_] * xq_[ks][j_]; } \
            ssq_ += __shfl_xor(ssq_, 16); ssq_ += __shfl_xor(ssq_, 32); \
            const float rq_ = rsqrtf(ssq_ * (1.f / 64.f) + EPS) * (0.125f * LOG2E); \
            _Pragma("unroll") for (int ks = 0; ks < 2; ++ks) { const f32x4 ga_ = *(const f32x4*)(qn + 32 * ks + 8 * q4), gb_ = *(const f32x4*)(qn + 32 * ks + 8 * q4 + 4); \
                const v4u w_ = {pg8::cvt_pk_bf16(xq_[ks][0] * rq_ * ga_.x, xq_[ks][1] * rq_ * ga_.y), pg8::cvt_pk_bf16(xq_[ks][2] * rq_ * ga_.z, xq_[ks][3] * rq_ * ga_.w), \
                                pg8::cvt_pk_bf16(xq_[ks][4] * rq_ * gb_.x, xq_[ks][5] * rq_ * gb_.y), pg8::cvt_pk_bf16(xq_[ks][6] * rq_ * gb_.z, xq_[ks][7] * rq_ * gb_.w)}; \
                qf[h][ks] = __builtin_bit_cast(bf16x8v, w_); \
                const v2u w8_ = {pg8::pk4_fp8(xq_[ks][0] * rq_ * ga_.x, xq_[ks][1] * rq_ * ga_.y, xq_[ks][2] * rq_ * ga_.z, xq_[ks][3] * rq_ * ga_.w), pg8::pk4_fp8(xq_[ks][4] * rq_ * gb_.x, xq_[ks][5] * rq_ * gb_.y, xq_[ks][6] * rq_ * gb_.z, xq_[ks][7] * rq_ * gb_.w)}; \
                qf8[h][ks] = __builtin_bit_cast(long, w8_); } } } while (0)
#define ATT_RESET() do { _Pragma("unroll") for (int h = 0; h < 2; ++h) { m[h] = -1e30f; ls[h] = 0.f; _Pragma("unroll") for (int dt = 0; dt < 4; ++dt) o[h][dt] = (f32x4){0.f, 0.f, 0.f, 0.f}; } } while (0)
        const int cmax = t >= 31 ? (((t - 31) >> 4) < 126 ? ((t - 31) >> 4) : 126) : -1;
        const int cmax0 = t0 >= 31 ? (((t0 - 31) >> 4) < 126 ? ((t0 - 31) >> 4) : 126) : -1;
        const bf16* KCb = KC + (size_t)bg * 128 * 64; const bf16* VCb = VCT + (size_t)bg * 128 * 64;
        const int ncs = ((t0 + 15 - 31) >> 4) < 0 ? 0 : ((((t0 + 15 - 31) >> 4) < 126 ? ((t0 + 15 - 31) >> 4) : 126) >> 5) + 1;
#pragma unroll 1
        for (int hp = 0; hp < 2; ++hp) {
            ATT_LOADQ(hp, 16); ATT_RESET();
            for (int st = ncs - 1; st >= 0; --st) {
                if (32 * st + 31 <= cmax0) attn_step<0, 0, bf16x8v, true>(KCb, koff, VCb, voff, 32 * st, t - 31 - 16 * 32 * st, true, cmax, qf, bv, m, ls, o, sl2, q4);
                else attn_step<0, 2, bf16x8v, true>(KCb, koff, VCb, voff, 32 * st, t - 31 - 16 * 32 * st, true, cmax, qf, bv, m, ls, o, sl2, q4); }
#pragma unroll
            for (int h = 0; h < 2; ++h) { float lt = ls[h]; lt += __shfl_xor(lt, 16); lt += __shfl_xor(lt, 32); ls[h] = lt; }
            float ps[4][8];
#pragma unroll
            for (int st = 0; st < 4; ++st)
#pragma unroll
                for (int i = 0; i < 8; ++i) ps[st][i] = 0.f;
#pragma unroll
            for (int st = 0; st < 4; ++st) {
                if (st < ncs) {
                    const int k0 = 32 * st; const char* kblk = (const char*)(KCb + (size_t)k0 * 64);
                    bf16x8v ka[2], kb[2];
#pragma unroll
                    for (int ks = 0; ks < 2; ++ks) { ka[ks] = *(const bf16x8v*)(kblk + koff + 2048 * ks); kb[ks] = *(const bf16x8v*)(kblk + koff + 256 + 2048 * ks); }
#pragma unroll
                    for (int h = 0; h < 2; ++h) {
                        f32x4 sa = MFMA16(ka[0], qf[h][0], bv[0] * (16.f * sl2[h])), sb = MFMA16(kb[0], qf[h][0], bv[1] * (16.f * sl2[h])); sa = MFMA16(ka[1], qf[h][1], sa); sb = MFMA16(kb[1], qf[h][1], sb);
                        const float lt = ls[h], inv = lt > 0.f ? 1.f / lt : 0.f, mref = m[h] + sl2[h] * (float)(t - 31 - 16 * k0);
#pragma unroll
                        for (int i = 0; i < 8; ++i) { const int c = k0 + 8 * q4 + i; ps[st][i] += (c <= cmax) ? __builtin_amdgcn_exp2f((i < 4 ? sa[i] : sb[i - 4]) - mref) * inv : 0.f; }
                    }
                }
            }
#pragma unroll
            for (int st = 0; st < 4; ++st) { LAS f32x4* p0 = (LAS f32x4*)(psl + r16 * PSW + 32 * st + 8 * q4);
                f32x4 a = {ps[st][0], ps[st][1], ps[st][2], ps[st][3]}, bq = {ps[st][4], ps[st][5], ps[st][6], ps[st][7]};
                if (hp) { a = a + p0[0]; bq = bq + p0[1]; }
                p0[0] = a; p0[1] = bq; }
            LDS_WAIT();
        }
        unsigned mlo, mhi;
        {
            float sc[16]; const LAS float* pr = psl + r16 * PSW + 32 * q4; const int cur = t >> 5;
            float prev = q4 > 0 ? pr[-1] : 0.f;
#pragma unroll
            for (int jj = 0; jj < 16; ++jj) { const float a = pr[2 * jj], bq = pr[2 * jj + 1]; const float imp = prev + a + bq; prev = bq;
                const int j = 16 * q4 + jj; const bool valid = 32 * j <= t; const bool forced = valid && (j == 0 || j == cur || j == cur - 1);
                sc[jj] = forced ? 1e9f : (valid ? imp : -1e9f); }
            unsigned my = 0u;
#pragma unroll 1
            for (int r = 0; r < 8; ++r) {
                float best = sc[0]; int bi = 0;
#pragma unroll
                for (int jj = 1; jj < 16; ++jj) if (sc[jj] > best) { best = sc[jj]; bi = jj; }
                bi += 16 * q4;
#pragma unroll
                for (int sh = 16; sh <= 32; sh <<= 1) { const float ov = __shfl_xor(best, sh); const int oi = __shfl_xor(bi, sh); if (ov > best || (ov == best && oi < bi)) { best = ov; bi = oi; } }
                if ((bi >> 4) == q4) { const int jj0 = bi & 15; if (best > -0.5e9f) my |= 1u << jj0;
#pragma unroll
                    for (int jj = 0; jj < 16; ++jj) if (jj == jj0) sc[jj] = -INFINITY; }
            }
            mlo = (q4 == 0 ? my : 0u) | (q4 == 1 ? my << 16 : 0u); mhi = (q4 == 2 ? my : 0u) | (q4 == 3 ? my << 16 : 0u);
            mlo |= __shfl_xor(mlo, 16); mlo |= __shfl_xor(mlo, 32); mhi |= __shfl_xor(mhi, 16); mhi |= __shfl_xor(mhi, 32);
        }
        LDS_WAIT();
        unsigned ulo = mlo, uhi = mhi;
#pragma unroll
        for (int sh = 1; sh <= 8; sh <<= 1) { ulo |= __shfl_xor(ulo, sh); uhi |= __shfl_xor(uhi, sh); }
        const unsigned long long un0 = ((unsigned long long)(unsigned)__builtin_amdgcn_readfirstlane((int)uhi) << 32) | (unsigned)__builtin_amdgcn_readfirstlane((int)ulo);
        const unsigned long long mine = ((unsigned long long)mhi << 32) | mlo;
#pragma unroll 1
        for (int hp = 0; hp < 2; ++hp) {
            const v2u g6raw = *(const v2u*)(gtp + 6 * hp); const unsigned g6x = gtp[6 * hp + 4], g6y = gtp[6 * hp + 5];
            v2u oacc[2][4];
#define ATT_GLOG(i) ((i) == 0 ? bflo(g6raw.x) : (i) == 1 ? bfhi(g6raw.x) : (i) == 2 ? bflo(g6raw.y) : (i) == 3 ? bfhi(g6raw.y) : (i) == 4 ? bf2f(g6x) : bf2f(g6y))
#define ATT_FOLD(br, first) do { _Pragma("unroll") for (int h = 0; h < 2; ++h) { float lt = ls[h]; lt += __shfl_xor(lt, 16); lt += __shfl_xor(lt, 32); const float sc_ = lt > 0.f ? (1.f / (1.f + __expf(-ATT_GLOG(h * 3 + (br))))) / lt : 0.f; \
            _Pragma("unroll") for (int dt = 0; dt < 4; ++dt) { f32x4 r_ = o[h][dt] * sc_; \
                if (!(first)) { r_[0] += bflo(oacc[h][dt].x); r_[1] += bfhi(oacc[h][dt].x); r_[2] += bflo(oacc[h][dt].y); r_[3] += bfhi(oacc[h][dt].y); } \
                oacc[h][dt].x = pg8::cvt_pk_bf16(r_[0], r_[1]); oacc[h][dt].y = pg8::cvt_pk_bf16(r_[2], r_[3]); } } } while (0)
            ATT_LOADQ(hp, 16); ATT_RESET();
            for (int st = ncs - 1; st >= 0; --st) {
                if (32 * st + 31 <= cmax0) attn_step<0, 0, bf16x8v>(KCb, koff, VCb, voff, 32 * st, t - 31 - 16 * 32 * st, true, cmax, qf, bv, m, ls, o, sl2, q4);
                else attn_step<0, 2, bf16x8v>(KCb, koff, VCb, voff, 32 * st, t - 31 - 16 * 32 * st, true, cmax, qf, bv, m, ls, o, sl2, q4); }
            ATT_FOLD(0, true);
            {
                const unsigned char* Kb = KS + (size_t)bg * SEQ * 64; const unsigned char* Vb = VST + (size_t)bg * SEQ * 64;
                ATT_RESET();
                unsigned long long un = un0;
                const int cur0 = t0 >> 5;
                while (un) { const int j = 63 - __builtin_clzll(un); un &= ~(1ull << j);
                    const bool tk = ((mine >> j) & 1ull) != 0ull;
                    if (j >= cur0) attn_step<1, 2, long>(Kb, koff >> 1, Vb, voff >> 1, 32 * j, t - 32 * j, tk, 0, qf8, bv, m, ls, o, sl2, q4);
                    else if (__all(tk)) attn_step<1, 0, long>(Kb, koff >> 1, Vb, voff >> 1, 32 * j, t - 32 * j, true, 0, qf8, bv, m, ls, o, sl2, q4);
                    else attn_step<1, 1, long>(Kb, koff >> 1, Vb, voff >> 1, 32 * j, t - 32 * j, tk, 0, qf8, bv, m, ls, o, sl2, q4); }
                ATT_FOLD(1, false);
            }
            {
                const unsigned char* Kb = KW + (size_t)bg * SEQ * 64; const unsigned char* Vb = VWT + (size_t)bg * SEQ * 64;
                const int sb = t0 >= 511 ? (t0 - 511) >> 5 : 0, se = t0 >> 5;
                ATT_RESET();
                for (int st = se; st >= sb; --st) {
                    if (32 * st + 31 <= t0 && 32 * st > t0 - 497) attn_step<2, 0, long>(Kb, koff >> 1, Vb, voff >> 1, 32 * st, t - 32 * st, true, 0, qf8, bv, m, ls, o, sl2, q4);
                    else attn_step<2, 2, long>(Kb, koff >> 1, Vb, voff >> 1, 32 * st, t - 32 * st, true, 0, qf8, bv, m, ls, o, sl2, q4); }
                ATT_FOLD(2, false);
            }
#pragma unroll
            for (int h = 0; h < 2; ++h)
#pragma unroll
                for (int dt = 0; dt < 4; ++dt) *(v2u*)(orow + (2 * hp + h) * 64 + 16 * dt) = oacc[h][dt];
        }
#undef ATT_FOLD
#undef ATT_GLOG
#undef ATT_LOADQ
#undef ATT_RESET
#undef ATT_GATE
    }
}

constexpr int SCQ = 272, SCT = 144;
constexpr int LQ_ = 0, LK_ = 17408, LKT_ = 34816, LVT_ = 53248, LP_ = 71680, LO_ = 80896, LE_ = 114688, LT_ = 115712;
__device__ __forceinline__ void p_scan_fast(Ctx& C, int layer) {
    unsigned char* ws = C.ws;
    const bf16* Pq = (const bf16*)(ws + R_PQ); const bf16* Pi = (const bf16*)(ws + R_PI); const bf16* Pg = (const bf16*)(ws + R_PG); const float* LF = (const float*)(ws + R_LF);
    bf16* O2 = (bf16*)(ws + R_O2);
    const float* gn = C.inp(I_HGN) + layer * 128;
    LAS unsigned char* L = C.lds;
    const int tid = C.tid, lane = C.lane, w = C.wave, r16 = lane & 15, q4 = lane >> 4, k = tid & 127, seg = tid >> 7;
    LAS float* tot = (LAS float*)(L + LT_); LAS float* eref = (LAS float*)(L + LE_); LAS float* elr = eref + 128;
    { const int tile = tid >> 8, e = tid & 255, row = e >> 4, col = e & 15;
      *(LAS bf16*)(L + LP_ + ((tile ? 32 : 0) + row) * SCT + ((tile ? 48 : 16) + col) * 2) = 0; }
    for (int bh = C.bid; bh < 256; bh += C.G) {
        const int b = bh >> 3, h = bh & 7;
        const size_t base = (size_t)(b * SEQ) * DM + h * 128;
        f32x4 S[8];
#pragma unroll
        for (int i = 0; i < 8; ++i) S[i] = (f32x4){0.f, 0.f, 0.f, 0.f};
        bf16 qv[16], vv[16]; float lf[16];
#define SC_LOAD(t0) do { _Pragma("unroll") for (int i = 0; i < 16; ++i) { const size_t off = base + (size_t)((t0) + 16 * seg + i) * DM + k; qv[i] = Pq[off]; vv[i] = Pi[off]; lf[i] = LF[off]; } } while (0)
        SC_LOAD(0);
#pragma unroll 1
        for (int c = 0; c < SEQ / 64; ++c) {
            const int t0 = c * 64;
            float cs[16]; { float run = 0.f;
#pragma unroll
                for (int i = 0; i < 16; ++i) { run += lf[i]; cs[i] = run; }
                tot[seg * 128 + k] = run; }
            __syncthreads();
            { const float a0 = tot[k], a1 = tot[128 + k], a2 = tot[256 + k], a3 = tot[384 + k];
              const float off = seg == 0 ? 0.f : (seg == 1 ? a0 : (seg == 2 ? a0 + a1 : a0 + a1 + a2)), ref = a0 + a1, last = ref + a2 + a3;
              unsigned kt[16];
#pragma unroll
              for (int i = 0; i < 16; ++i) { const float d = off + cs[i] - ref; const float qt = bf2f(qv[i]) * __expf(fminf(d, 80.f)), ktv = (1.f - __expf(lf[i])) * __expf(fminf(-d, 80.f));
                  const int s = 16 * seg + i; kt[i] = f2bf(ktv);
                  *(LAS bf16*)(L + LQ_ + s * SCQ + k * 2) = (bf16)f2bf(qt); *(LAS bf16*)(L + LK_ + s * SCQ + k * 2) = (bf16)kt[i]; }
              v4u w0, w1, x0, x1;
              w0.x = kt[0] | (kt[1] << 16); w0.y = kt[2] | (kt[3] << 16); w0.z = kt[4] | (kt[5] << 16); w0.w = kt[6] | (kt[7] << 16);
              w1.x = kt[8] | (kt[9] << 16); w1.y = kt[10] | (kt[11] << 16); w1.z = kt[12] | (kt[13] << 16); w1.w = kt[14] | (kt[15] << 16);
              x0.x = vv[0] | ((unsigned)vv[1] << 16); x0.y = vv[2] | ((unsigned)vv[3] << 16); x0.z = vv[4] | ((unsigned)vv[5] << 16); x0.w = vv[6] | ((unsigned)vv[7] << 16);
              x1.x = vv[8] | ((unsigned)vv[9] << 16); x1.y = vv[10] | ((unsigned)vv[11] << 16); x1.z = vv[12] | ((unsigned)vv[13] << 16); x1.w = vv[14] | ((unsigned)vv[15] << 16);
              *(LAS v4u*)(L + LKT_ + k * SCT + seg * 32) = w0; *(LAS v4u*)(L + LKT_ + k * SCT + seg * 32 + 16) = w1;
              *(LAS v4u*)(L + LVT_ + k * SCT + seg * 32) = x0; *(LAS v4u*)(L + LVT_ + k * SCT + seg * 32 + 16) = x1;
              if (seg == 0) { eref[k] = __expf(ref); elr[k] = __expf(last - ref); } }
            __syncthreads();
            if (c + 1 < SEQ / 64) SC_LOAD(t0 + 64);
#pragma unroll 1
            for (int ti = w; ti < 10; ti += 8) {
                const int rt = ti < 1 ? 0 : (ti < 3 ? 1 : (ti < 6 ? 2 : 3)), ct = ti - (rt * (rt + 1)) / 2;
                f32x4 acc = {0.f, 0.f, 0.f, 0.f};
#pragma unroll
                for (int p = 0; p < 4; ++p) { const bf16x8v a = *(const LAS bf16x8v*)(L + LQ_ + (16 * rt + r16) * SCQ + (32 * p + 8 * q4) * 2), bq = *(const LAS bf16x8v*)(L + LK_ + (16 * ct + r16) * SCQ + (32 * p + 8 * q4) * 2);
                    acc = MFMA16(a, bq, acc); }
#pragma unroll
                for (int i = 0; i < 4; ++i) { const int t = 16 * rt + 4 * q4 + i, s = 16 * ct + r16; *(LAS bf16*)(L + LP_ + t * SCT + s * 2) = (bf16)f2bf(s <= t ? acc[i] : 0.f); }
            }
            __syncthreads();
            bf16x8v sfrag[4]; f32x4 e8[4][2];
#pragma unroll
            for (int p = 0; p < 4; ++p) { e8[p][0] = *(const LAS f32x4*)(eref + 32 * p + 8 * q4); e8[p][1] = *(const LAS f32x4*)(eref + 32 * p + 8 * q4 + 4);
                S[2 * p] = S[2 * p] * e8[p][0]; S[2 * p + 1] = S[2 * p + 1] * e8[p][1];
                const v4u wv = {pg8::cvt_pk_bf16(S[2 * p][0], S[2 * p][1]), pg8::cvt_pk_bf16(S[2 * p][2], S[2 * p][3]), pg8::cvt_pk_bf16(S[2 * p + 1][0], S[2 * p + 1][1]), pg8::cvt_pk_bf16(S[2 * p + 1][2], S[2 * p + 1][3])};
                sfrag[p] = __builtin_bit_cast(bf16x8v, wv); }
            bf16x8v vfr[2];
#pragma unroll
            for (int ss = 0; ss < 2; ++ss) vfr[ss] = *(const LAS bf16x8v*)(L + LVT_ + (16 * w + r16) * SCT + (32 * ss + 8 * q4) * 2);
#pragma unroll
            for (int rt = 0; rt < 4; ++rt) { f32x4 o = {0.f, 0.f, 0.f, 0.f};
#pragma unroll
                for (int p = 0; p < 4; ++p) { const bf16x8v a = *(const LAS bf16x8v*)(L + LQ_ + (16 * rt + r16) * SCQ + (32 * p + 8 * q4) * 2); o = MFMA16(a, sfrag[p], o); }
#pragma unroll
                for (int ss = 0; ss < 2; ++ss) if (ss <= rt / 2) { const bf16x8v a = *(const LAS bf16x8v*)(L + LP_ + (16 * rt + r16) * SCT + (32 * ss + 8 * q4) * 2); o = MFMA16(a, vfr[ss], o); }
#pragma unroll
                for (int i = 0; i < 4; ++i) *(LAS float*)(L + LO_ + (16 * rt + 4 * q4 + i) * 528 + (16 * w + r16) * 4) = o[i]; }
#pragma unroll
            for (int p = 0; p < 4; ++p)
#pragma unroll
                for (int ab = 0; ab < 2; ++ab) { const int krow = 32 * p + 8 * (r16 >> 2) + (r16 & 3) + 4 * ab;
#pragma unroll
                    for (int ss = 0; ss < 2; ++ss) { const bf16x8v a = *(const LAS bf16x8v*)(L + LKT_ + krow * SCT + (32 * ss + 8 * q4) * 2); S[2 * p + ab] = MFMA16(a, vfr[ss], S[2 * p + ab]); } }
#pragma unroll
            for (int p = 0; p < 4; ++p) { const f32x4 l0 = *(const LAS f32x4*)(elr + 32 * p + 8 * q4), l1 = *(const LAS f32x4*)(elr + 32 * p + 8 * q4 + 4); S[2 * p] = S[2 * p] * l0; S[2 * p + 1] = S[2 * p + 1] * l1; }
            __syncthreads();
#pragma unroll
            for (int rep = 0; rep < 2; ++rep) { const int tok = (tid >> 4) + 32 * rep, part = tid & 15;
                const f32x4 oa = *(const LAS f32x4*)(L + LO_ + tok * 528 + part * 32), ob = *(const LAS f32x4*)(L + LO_ + tok * 528 + part * 32 + 16);
                float ss = (oa.x * oa.x + oa.y * oa.y) + (oa.z * oa.z + oa.w * oa.w) + (ob.x * ob.x + ob.y * ob.y) + (ob.z * ob.z + ob.w * ob.w);
                ss += __shfl_xor(ss, 1); ss += __shfl_xor(ss, 2); ss += __shfl_xor(ss, 4); ss += __shfl_xor(ss, 8);
                const float rstd = rsqrtf(ss * (1.f / 128.f) + EPS);
                const size_t off = base + (size_t)(t0 + tok) * DM + part * 8; const v4u g8 = *(const v4u*)(Pg + off);
                const f32x4 ga = *(const f32x4*)(gn + part * 8), gb = *(const f32x4*)(gn + part * 8 + 4);
                v4u wv; wv.x = pk2(oa.x * rstd * ga.x * bflo(g8.x), oa.y * rstd * ga.y * bfhi(g8.x)); wv.y = pk2(oa.z * rstd * ga.z * bflo(g8.y), oa.w * rstd * ga.w * bfhi(g8.y));
                wv.z = pk2(ob.x * rstd * gb.x * bflo(g8.z), ob.y * rstd * gb.y * bfhi(g8.z)); wv.w = pk2(ob.z * rstd * gb.z * bflo(g8.w), ob.w * rstd * gb.w * bfhi(g8.w));
                *(v4u*)(O2 + off) = wv; }
        }
#undef SC_LOAD
        __syncthreads();
    }
}

#define PH_BEGIN { const bool run_ = (pid >= lo && pid < hi); ++pid; if (run_) { { int ln_; asm volatile("v_mbcnt_lo_u32_b32 %0, -1, 0\n\tv_mbcnt_hi_u32_b32 %0, -1, %0" : "=v"(ln_)); C.lane = ln_; C.tid = C.wave * 64 + ln_; }
#define PH_END   if (pid < hi) xcd_barrier(bar); } }
#define XN ((const bf16*)(ws + WS_XN))
#define RTAB ((const int*)(ws + WS_RTAB))

template <int L>
__device__ __forceinline__ void run_layer(Ctx& C, const XcdBarrier& bar, int& pid, const int lo, const int hi, PG8_LAS unsigned char* ring) {
    unsigned char* const ws = C.ws;

        const int li = L >> 1;
        if (L < 2) {
            PH_BEGIN { pg8::Gemm g{XN, (const bf16*)(ws + W_HIN) + (size_t)L * 4096 * 1024, 1024, 1024, 0}; pg8::GenOrder S; S.init(256, 16, C.G, C.bid, nullptr);
                pg8::EpiHgrnIn E{ws, L};
                pg8::gemm_phase<pg8::EpiHgrnIn, pg8::GenOrder, true, true>(ring, g, S, E, C.wave); } PH_END
            PH_BEGIN p_scan_fast(C, L); PH_END
        } else {
            PH_BEGIN { const bool first = (L == 2); pg8::Gemm g{XN, (const bf16*)(ws + (first ? W_KVQ : W_Q3)), 1024, 1024, 0}; pg8::GenOrder S; S.init(256, first ? 11 : 5, C.G, C.bid, nullptr);
                pg8::EpiBf16 E{(bf16*)(ws + R_QKV), first ? 2816 : 1280, nullptr, 0, 0, 1.f};
                pg8::gemm_phase<pg8::EpiBf16, pg8::GenOrder, true, true>(ring, g, S, E, C.wave); } PH_END
            if (L == 2) {
                PH_BEGIN p_post_kv(C); PH_END
                PH_BEGIN { pg8::Gemm g{(const bf16*)(ws + R_KCR), (const bf16*)(ws + W_CMP1), 2048, 1024, (size_t)256 * 2048 * 2}; pg8::GenOrder S; S.init(128, 1, C.G, C.bid, RTAB + 2048);
                    pg8::EpiBf16 E{(bf16*)(ws + WS_HC), 256, (const float*)(ws + WS_CB), 1, 256, 1.f};
                    pg8::gemm_phase<pg8::EpiBf16, pg8::GenOrder, true, true>(ring, g, S, E, C.wave); } PH_END
                PH_BEGIN p_cmp2(C); PH_END
            }
            PH_BEGIN p_attn_fast(C, (unsigned*)(ws + WS_CTL) + 8192 + 2048 * (L - 2), L == 2 ? 2816 : 1280, L == 2 ? 1536 : 0, C.inp(I_NQN) + (L - 2) * 64); PH_END
        }
        PH_BEGIN { pg8::Gemm g{(const bf16*)(ws + (L < 2 ? R_O2 : R_O)), (const bf16*)(ws + (L < 2 ? W_HOUT : W_NOUT)) + (size_t)(L & 1) * 1024 * 1024, 1024, 1024, 0};
            pg8::GenOrder S; S.init(256, 4, C.G, C.bid, nullptr);
            pg8::EpiRes E{L == 0 ? C.inp(I_X) : C.out, C.out, 1024, 1.f};
            pg8::gemm_phase<pg8::EpiRes, pg8::GenOrder, true, true>(ring, g, S, E, C.wave); } PH_END
        PH_BEGIN { if (L & 1) p_norm<false, true, true, true>(C, C.inp(I_MR) + (size_t)li * 1024 * 8, C.inp(I_NFFN) + L * 1024); else if (L == 2) p_norm<false, false, true, true>(C, nullptr, nullptr); else p_norm<false, false, true, false>(C, nullptr, nullptr); } PH_END
        if (L & 1) { PH_BEGIN p_gather(C); PH_END }
        if (L == 0) {
            PH_BEGIN { pg8::Gemm g{XN, (const bf16*)(ws + W_FGU), 1024, 1024, 0};
                pg8::GenOrder S; S.init(256, 22, C.G, C.bid, nullptr);
                pg8::EpiSwiGLU E{(bf16*)(ws + R_HF), DFF};
                pg8::gemm_phase<pg8::EpiSwiGLU, pg8::GenOrder, true, true>(ring, g, S, E, C.wave); } PH_END
            PH_BEGIN { pg8::Gemm g{(const bf16*)(ws + R_HF), (const bf16*)(ws + W_FDN), DFF, DFF, 0}; pg8::GenOrder S; S.init(256, 4, C.G, C.bid, nullptr);
                pg8::EpiRes E{C.out, C.out, 1024, 1.f};
                pg8::gemm_phase<pg8::EpiRes, pg8::GenOrder, true, true>(ring, g, S, E, C.wave); } PH_END
            PH_BEGIN p_norm<false, false, true>(C, nullptr, nullptr); PH_END
        } else {
        PH_BEGIN { const bool moe = (L & 1) != 0;
            pg8::Gemm g{(const bf16*)(ws + (moe ? R_XP : WS_XN)), (const bf16*)(ws + (moe ? W_MGU + (size_t)li * 8 * 2 * DFE * 1024 : W_FGU + (size_t)li * 2 * DFF * 2048)), 512, 512, moe ? (size_t)2 * DFE * 1024 : 0};
            pg8::GenOrder S; S.init(moe ? RTAB[1024] : 256, moe ? 28 : 22, C.G, C.bid, moe ? RTAB : nullptr);
            pg8::EpiSwiGLU8 E{ws + (moe ? R_HM : R_HF), moe ? DFE : DFF};
            pg8::gemm_phase<pg8::EpiSwiGLU8, pg8::GenOrder, true, true, true>(ring, g, S, E, C.wave); } PH_END
        if (!(L & 1)) {
            PH_BEGIN { pg8::Gemm g{(const bf16*)(ws + R_HF), (const bf16*)(ws + W_FDN + (size_t)li * 1024 * DFF * 2), DFF / 2, DFF / 2, 0}; pg8::GenOrder S; S.init(256, 4, C.G, C.bid, nullptr);
                pg8::EpiRes E{C.out, C.out, 1024, 1.f / (pg8::FP8_SH * pg8::FP8_SW2)};
                pg8::gemm_phase<pg8::EpiRes, pg8::GenOrder, true, true, true>(ring, g, S, E, C.wave); } PH_END
            PH_BEGIN p_norm<false, false, true>(C, nullptr, nullptr); PH_END
        } else {
            PH_BEGIN { pg8::Gemm g{(const bf16*)(ws + R_HM), (const bf16*)(ws + W_MDN + (size_t)li * 8 * 1024 * DFE), DFE / 2, DFE / 2, (size_t)1024 * DFE}; pg8::GenOrder S; S.init(RTAB[1024], 4, C.G, C.bid, RTAB);
                pg8::EpiBf16 E{(bf16*)(ws + R_XP), 1024, nullptr, 0, 0, 1.f / (pg8::FP8_SH * pg8::FP8_SW2)};
                pg8::gemm_phase<pg8::EpiBf16, pg8::GenOrder, true, true, true>(ring, g, S, E, C.wave); } PH_END
            PH_BEGIN { if (L == 1) p_norm<true, false, true>(C, nullptr, nullptr); else p_norm<true, false, false>(C, nullptr, nullptr); } PH_END
        }
        }
    }

struct Args { const float* in[24]; float* out; unsigned char* ws; int ph_lo, ph_hi; };
constexpr int N_PHASES = 34;

__global__ void __launch_bounds__(NWAVES * 64, 2) yoco_fwd(Args args) {
    extern __shared__ __attribute__((aligned(16))) unsigned char lds_raw[];
    Ctx C;
    C.lds = (LAS unsigned char*)lds_raw;
    C.wave = __builtin_amdgcn_readfirstlane((int)(threadIdx.x >> 6)); C.tid = threadIdx.x; C.lane = C.tid & 63;
    C.G = gridDim.x; C.bid = blockIdx.x;
    C.out = args.out; C.ws = args.ws;
    unsigned char* const ws = args.ws;
    volatile LAS unsigned* MISC = (volatile LAS unsigned*)(C.lds + MISC_OFF);
    if (C.tid < 32) MISC[C.tid] = 0u;
    __syncthreads();
    XcdBarrier bar = xcd_barrier_post((unsigned*)(ws + WS_CTL) + 4096, MISC + 8);
    const int lo = args.ph_lo, hi = args.ph_hi;
    int pid = 0;
    PG8_LAS unsigned char* ring = (PG8_LAS unsigned char*)lds_raw;
    PH_BEGIN p_prologue(C); PH_END

    run_layer<0>(C, bar, pid, lo, hi, ring); run_layer<1>(C, bar, pid, lo, hi, ring); run_layer<2>(C, bar, pid, lo, hi, ring); run_layer<3>(C, bar, pid, lo, hi, ring);
#undef PH_BEGIN
#undef PH_END
#undef XN
#undef RTAB
}

extern "C" void kernel_launch(void* const* d_in, const int* in_sizes, int n_in, void* d_out, int out_size, void* d_ws, size_t ws_size, hipStream_t stream) {
    static int grid = 0;
    if (grid == 0) {
        if (n_in != 24 || in_sizes[0] != NT * DM || out_size != NT * DM || ws_size < WS_NEED) { fprintf(stderr, "kernel_launch: unexpected shapes / workspace (n_in %d, ws %zu, need %zu)\n", n_in, ws_size, (size_t)WS_NEED); grid = -1; return; }
        int dev = 0, cus = 0;
        if (hipGetDevice(&dev) != hipSuccess || hipDeviceGetAttribute(&cus, hipDeviceAttributeMultiprocessorCount, dev) != hipSuccess) { grid = -1; return; }
        if (hipFuncSetAttribute((const void*)yoco_fwd, hipFuncAttributeMaxDynamicSharedMemorySize, LDS_BYTES) != hipSuccess) { fprintf(stderr, "kernel_launch: hipFuncSetAttribute failed\n"); grid = -1; return; }
        int per_cu = 0;
        if (hipOccupancyMaxActiveBlocksPerMultiprocessor(&per_cu, (const void*)yoco_fwd, NWAVES * 64, LDS_BYTES) != hipSuccess || per_cu < 1) { fprintf(stderr, "kernel_launch: occupancy query says %d\n", per_cu); }
        (void)hipGetLastError();
        grid = cus;
    }
    if (grid < 0) return;
    (void)hipMemsetAsync((char*)d_ws + WS_CTL, 0, CTL_ZERO_BYTES, stream);
    Args a{};
    for (int i = 0; i < 24; ++i) a.in[i] = (const float*)d_in[i];
    a.out = (float*)d_out; a.ws = (unsigned char*)d_ws;
#if MK_SINGLE
    a.ph_lo = 0; a.ph_hi = PROBE_DUP ? 1000 : N_PHASES;
    hipLaunchKernelGGL(yoco_fwd, dim3(grid), dim3(NWAVES * 64), LDS_BYTES, stream, a);
#else
    for (int k = 0; k < N_PHASES; ++k) { a.ph_lo = k; a.ph_hi = k + 1; hipLaunchKernelGGL(yoco_fwd, dim3(grid), dim3(NWAVES * 64), LDS_BYTES, stream, a); }
#endif
}
```

```cpp
#include <hip/hip_runtime.h>
#include <cstdio>
#include <cstdint>

#ifndef PROBE_DUP
#define PROBE_DUP 0
#endif
#ifndef MK_SINGLE
#define MK_SINGLE 1
#endif

namespace pg8 {
#define PG8_LAS __attribute__((address_space(3)))
typedef unsigned short bf16_t;
typedef short bf16x8 __attribute__((ext_vector_type(8)));
typedef float f32x4 __attribute__((ext_vector_type(4)));
typedef unsigned u32x4 __attribute__((ext_vector_type(4)));
constexpr int BM = 256, BK = 64, HALF = 128, HTB = HALF * BK * 2  , STAGE_BYTES = 8 * HTB, NXCD = 8, WGM = 8;

__host__ __device__ __forceinline__ int lds_byte(int r, int c) { const int st = (r >> 4) * 2 + (c >> 5), rr = r & 15, cc = c & 31, ob = rr * 64 + cc * 2; return st * 1024 + (ob ^ (((ob >> 9) & 1) << 5)); }
__host__ __device__ __forceinline__ void stage_rc(int b, int& R, int& C) { const int st = b / 1024, sb = b % 1024, swz = sb ^ (((sb >> 9) & 1) << 5); R = (st >> 1) * 16 + swz / 64; C = (st & 1) * 32 + (swz % 64) / 2; }
__host__ __device__ __forceinline__ int perm32(int rho) { const int n = rho >> 4, i = rho & 15; return 8 * (i >> 2) + 4 * n + (i & 3); }

struct Unit { int pm, pn, e; };
struct Gemm { const bf16_t* A; const bf16_t* Bt; int K; int lda; size_t estride; };

struct GenOrder {
    int nM, nN, nwg, G, c; const int* tile_e;
    __device__ void init(int nM_, int nN_, int G_, int c_, const int* te) { nM = nM_; nN = nN_; nwg = nM * nN; G = G_; c = c_; tile_e = te; }
    __device__ bool next(int i, Unit& u) const {
        const long L = (long)i * G + c; if (L >= nwg) return false;
        int wgid = (int)L; { const int q = nwg / NXCD, r = nwg % NXCD, xcd = wgid % NXCD, off = wgid / NXCD; wgid = (xcd < r ? xcd * (q + 1) : r * (q + 1) + (xcd - r) * q) + off; }
        const int nig = WGM * nN, gid = wgid / nig, fm = gid * WGM, gsz = (nM - fm) < WGM ? (nM - fm) : WGM;
        u.pm = fm + ((wgid % nig) % gsz); u.pn = (wgid % nig) / gsz; u.e = tile_e ? tile_e[u.pm] : 0; return true;
    }
    __device__ __forceinline__ void a_ready(const Unit&) const {}
    __device__ __forceinline__ void done(const Unit&) const {}
};

__device__ __forceinline__ unsigned cvt_pk_bf16(float lo, float hi) { unsigned r; asm volatile("v_cvt_pk_bf16_f32 %0, %1, %2" : "=v"(r) : "v"(lo), "v"(hi)); return r; }
__device__ __forceinline__ float silu_f(float v) { return v * __builtin_amdgcn_rcpf(1.0f + __expf(-v)); }
__device__ __forceinline__ float clamp448(float v) { return fminf(fmaxf(v, -448.f), 448.f); }
__device__ __forceinline__ unsigned pk4_fp8(float a, float b, float c, float d) {
    int w = __builtin_amdgcn_cvt_pk_fp8_f32(clamp448(a), clamp448(b), 0, false); w = __builtin_amdgcn_cvt_pk_fp8_f32(clamp448(c), clamp448(d), w, true); return (unsigned)w; }
constexpr float FP8_SW1 = 32.f, FP8_SW2 = 64.f, FP8_SH = 8.f;

struct EpiBf16 {
    static constexpr bool PERM = true, AFTER_DRAIN = false;
    bf16_t* O; int ldc; const float* bias; int act; int bias_es; float oscale;
    __device__ __forceinline__ void operator()(const f32x4 (&acc)[2][2][4][2], const Unit& u, int wr, int wc, int fr, int fq) const {
        const int row0 = u.pm * BM + wr * 64 + fr, col0 = u.pn * BM + wc * 32 + 8 * fq;
        f32x4 bv[2][2];
#pragma unroll
        for (int bj = 0; bj < 2; ++bj)
#pragma unroll
            for (int n = 0; n < 2; ++n) bv[bj][n] = bias ? *(const f32x4*)(bias + u.e * bias_es + col0 + bj * HALF + 4 * n) : (f32x4){0.f, 0.f, 0.f, 0.f};
#pragma unroll
        for (int ai = 0; ai < 2; ++ai)
#pragma unroll
            for (int m = 0; m < 4; ++m) { bf16_t* rowp = O + (size_t)(row0 + ai * HALF + m * 16) * ldc + col0;
#pragma unroll
                for (int bj = 0; bj < 2; ++bj) { f32x4 v0 = acc[ai][bj][m][0] * oscale + bv[bj][0], v1 = acc[ai][bj][m][1] * oscale + bv[bj][1];
                    if (act == 1) {
#pragma unroll
                        for (int i = 0; i < 4; ++i) { v0[i] = silu_f(v0[i]); v1[i] = silu_f(v1[i]); } }
                    u32x4 w; w.x = cvt_pk_bf16(v0[0], v0[1]); w.y = cvt_pk_bf16(v0[2], v0[3]); w.z = cvt_pk_bf16(v1[0], v1[1]); w.w = cvt_pk_bf16(v1[2], v1[3]);
                    *(u32x4*)(rowp + bj * HALF) = w; } }
    }
};
struct EpiRes {
    static constexpr bool PERM = false, AFTER_DRAIN = false;
    const float* base; float* out; int ldc; float oscale;
    __device__ __forceinline__ void operator()(const f32x4 (&acc)[2][2][4][2], const Unit& u, int wr, int wc, int fr, int fq) const {
        const int row0 = u.pm * BM + wr * 64 + fr, col0 = u.pn * BM + wc * 32 + 4 * fq;
#pragma unroll
        for (int ai = 0; ai < 2; ++ai)
#pragma unroll
            for (int m = 0; m < 4; ++m) { const size_t off = (size_t)(row0 + ai * HALF + m * 16) * ldc + col0;
#pragma unroll
                for (int bj = 0; bj < 2; ++bj)
#pragma unroll
                    for (int n = 0; n < 2; ++n) { const f32x4 b = *(const f32x4*)(base + off + bj * HALF + n * 16); *(f32x4*)(out + off + bj * HALF + n * 16) = b + acc[ai][bj][m][n] * oscale; } }
    }
};
struct EpiSwiGLU {
    static constexpr bool PERM = true, AFTER_DRAIN = false;
    bf16_t* O; int ldc;
    __device__ __forceinline__ void operator()(const f32x4 (&acc)[2][2][4][2], const Unit& u, int wr, int wc, int fr, int fq) const {
        const int row0 = u.pm * BM + wr * 64 + fr, col0 = u.pn * HALF + wc * 32 + 8 * fq;
#pragma unroll
        for (int ai = 0; ai < 2; ++ai)
#pragma unroll
            for (int m = 0; m < 4; ++m) { bf16_t* rowp = O + (size_t)(row0 + ai * HALF + m * 16) * ldc + col0;
                f32x4 v0, v1;
#pragma unroll
                for (int i = 0; i < 4; ++i) { v0[i] = silu_f(acc[ai][0][m][0][i]) * acc[ai][1][m][0][i]; v1[i] = silu_f(acc[ai][0][m][1][i]) * acc[ai][1][m][1][i]; }
                u32x4 w; w.x = cvt_pk_bf16(v0[0], v0[1]); w.y = cvt_pk_bf16(v0[2], v0[3]); w.z = cvt_pk_bf16(v1[0], v1[1]); w.w = cvt_pk_bf16(v1[2], v1[3]);
                *(u32x4*)rowp = w; }
    }
};
struct EpiSwiGLU8 {
    static constexpr bool PERM = true, AFTER_DRAIN = false;
    unsigned char* O; int ldc;
    __device__ __forceinline__ void operator()(const f32x4 (&acc)[2][2][4][2], const Unit& u, int wr, int wc, int fr, int fq) const {
        const int row0 = u.pm * BM + wr * 64 + fr, col0 = u.pn * HALF + wc * 32 + 8 * fq; constexpr float si = 1.f / FP8_SW1;
#pragma unroll
        for (int ai = 0; ai < 2; ++ai)
#pragma unroll
            for (int m = 0; m < 4; ++m) { unsigned char* rowp = O + (size_t)(row0 + ai * HALF + m * 16) * ldc + col0;
                f32x4 v0, v1;
#pragma unroll
                for (int i = 0; i < 4; ++i) { v0[i] = silu_f(acc[ai][0][m][0][i] * si) * (acc[ai][1][m][0][i] * (si * FP8_SH)); v1[i] = silu_f(acc[ai][0][m][1][i] * si) * (acc[ai][1][m][1][i] * (si * FP8_SH)); }
                typedef unsigned u32x2 __attribute__((ext_vector_type(2))); u32x2 w; w.x = pk4_fp8(v0[0], v0[1], v0[2], v0[3]); w.y = pk4_fp8(v1[0], v1[1], v1[2], v1[3]);
                *(u32x2*)rowp = w; }
    }
};
__device__ __forceinline__ float logf_gate(float x, float la, float l1) {
    const float ls = fminf(x, 0.f) - __logf(1.0f + __expf(-fabsf(x)));
    const float b = l1 + ls;
    if (la == -INFINITY) return b;
    const float mx = fmaxf(la, b), d = fabsf(la - b);
    return mx + __logf(1.0f + __expf(-d));
}
struct EpiHgrnIn {
    static constexpr bool PERM = true, AFTER_DRAIN = false;
    unsigned char* ws; int layer;
    static constexpr size_t O_PQ = 580ull << 20, O_PI = O_PQ + (128ull << 20), O_PG = O_PQ + (256ull << 20), O_LF = O_PQ + (384ull << 20), O_LA = 1ull << 20, O_L1 = O_LA + 8192;
    __device__ __forceinline__ void operator()(const f32x4 (&acc)[2][2][4][2], const Unit& u, int wr, int wc, int fr, int fq) const {
        const int quarter = u.pn >> 2;
        const int row0 = u.pm * BM + wr * 64 + fr, col0 = (u.pn & 3) * BM + wc * 32 + 8 * fq;
        if (quarter == 1) {
            const float* la = (const float*)(ws + O_LA) + layer * 1024; const float* l1 = (const float*)(ws + O_L1) + layer * 1024; float* LF = (float*)(ws + O_LF);
            f32x4 A0[2][2], A1[2][2];
#pragma unroll
            for (int bj = 0; bj < 2; ++bj)
#pragma unroll
                for (int n = 0; n < 2; ++n) { A0[bj][n] = *(const f32x4*)(la + col0 + bj * HALF + 4 * n); A1[bj][n] = *(const f32x4*)(l1 + col0 + bj * HALF + 4 * n); }
#pragma unroll
            for (int ai = 0; ai < 2; ++ai)
#pragma unroll
                for (int m = 0; m < 4; ++m) { float* rowp = LF + (size_t)(row0 + ai * HALF + m * 16) * 1024 + col0;
#pragma unroll
                    for (int bj = 0; bj < 2; ++bj)
#pragma unroll
                        for (int n = 0; n < 2; ++n) { f32x4 o;
#pragma unroll
                            for (int i = 0; i < 4; ++i) o[i] = logf_gate(acc[ai][bj][m][n][i], A0[bj][n][i], A1[bj][n][i]);
                            *(f32x4*)(rowp + bj * HALF + 4 * n) = o; } }
        } else {
            bf16_t* O = (bf16_t*)(ws + (quarter == 0 ? O_PQ : (quarter == 2 ? O_PI : O_PG)));
#pragma unroll
            for (int ai = 0; ai < 2; ++ai)
#pragma unroll
                for (int m = 0; m < 4; ++m) { bf16_t* rowp = O + (size_t)(row0 + ai * HALF + m * 16) * 1024 + col0;
#pragma unroll
                    for (int bj = 0; bj < 2; ++bj) { f32x4 v0 = acc[ai][bj][m][0], v1 = acc[ai][bj][m][1];
                        if (quarter != 2) {
#pragma unroll
                            for (int i = 0; i < 4; ++i) { v0[i] = silu_f(v0[i]); v1[i] = silu_f(v1[i]); } }
                        u32x4 w; w.x = cvt_pk_bf16(v0[0], v0[1]); w.y = cvt_pk_bf16(v0[2], v0[3]); w.z = cvt_pk_bf16(v1[0], v1[1]); w.w = cvt_pk_bf16(v1[2], v1[3]);
                        *(u32x4*)(rowp + bj * HALF) = w; } }
        }
    }
};

template <class Epi, class Sched, bool ALIGN_EPI = false, bool SP2 = false, bool FP8 = false>
__device__ __forceinline__ void gemm_phase(PG8_LAS unsigned char* lds, const Gemm g, const Sched& S, const Epi& E, const int wave_id) {
    int lane_; asm volatile("v_mbcnt_lo_u32_b32 %0, -1, 0\n\tv_mbcnt_hi_u32_b32 %0, -1, %0" : "=v"(lane_));
    const int wid = wave_id, lane = lane_, tid = wid * 64 + lane, wr = wid >> 2, wc = wid & 3, fr = lane & 15, fq = lane >> 4;
    const int K = g.K, nt = K / BK, lda = g.lda;
    unsigned voffA[2], voffB[2];
#pragma unroll
    for (int i = 0; i < 2; ++i) { int R, C; stage_rc(tid * 16 + i * 8192, R, C); const int Rb = Epi::PERM ? ((R & ~31) + perm32(R & 31)) : R;
        voffA[i] = (unsigned)(R * lda + C) * 2u; voffB[i] = (unsigned)(Rb * K + C) * 2u; }
    const size_t kstep = (size_t)(BK * 2);
    const size_t hstep = (size_t)HALF * K * 2;
    const size_t tstep = 2 * hstep;
    const size_t hstepA = (size_t)HALF * lda * 2, tstepA = 2 * hstepA;
    const unsigned ldsw = (unsigned)wid * 1024u;
    const int aoff = lds_byte(wr * 64 + fr, fq * 8), boff = lds_byte(wc * 32 + fr, fq * 8);
#define PG8_SA(b, h) (((b) * 2 + (h)) * HTB)
#define PG8_SB(b, h) ((4 + (b) * 2 + (h)) * HTB)
#define PG8_STAGE(bufoff, gbase, voff) do { _Pragma("unroll") for (int _i = 0; _i < 2; ++_i) \
        __builtin_amdgcn_global_load_lds((const unsigned*)((const char*)(gbase) + (voff)[_i]), (PG8_LAS unsigned*)(lds + (bufoff) + ldsw + _i * 8192), 16, 0, 0); } while (0)
    typedef int i32x4_ __attribute__((ext_vector_type(4))); typedef int i32x8_ __attribute__((ext_vector_type(8)));
#define PG8_CAT(x, y) __builtin_shufflevector((x), (y), 0, 1, 2, 3, 4, 5, 6, 7)
#define PG8_LDA(dst, b, h) do { _Pragma("unroll") for (int m = 0; m < 4; ++m) { \
        if constexpr (FP8) dst##8[m] = PG8_CAT(*(const PG8_LAS i32x4_*)(lds + PG8_SA(b, h) + aoff + m * 2048), *(const PG8_LAS i32x4_*)(lds + PG8_SA(b, h) + aoff + m * 2048 + 1024)); \
        else { _Pragma("unroll") for (int k = 0; k < 2; ++k) dst[m][k] = *(const PG8_LAS bf16x8*)(lds + PG8_SA(b, h) + aoff + m * 2048 + k * 1024); } } } while (0)
#define PG8_LDB(dst, b, h) do { _Pragma("unroll") for (int n = 0; n < 2; ++n) { \
        if constexpr (FP8) dst##8[n] = PG8_CAT(*(const PG8_LAS i32x4_*)(lds + PG8_SB(b, h) + boff + n * 2048), *(const PG8_LAS i32x4_*)(lds + PG8_SB(b, h) + boff + n * 2048 + 1024)); \
        else { _Pragma("unroll") for (int k = 0; k < 2; ++k) dst[n][k] = *(const PG8_LAS bf16x8*)(lds + PG8_SB(b, h) + boff + n * 2048 + k * 1024); } } } while (0)
#define PG8_MMA(ai, bj, At, Bt) do { __builtin_amdgcn_s_setprio(1); _Pragma("unroll") for (int m = 0; m < 4; ++m) _Pragma("unroll") for (int n = 0; n < 2; ++n) { \
        if constexpr (FP8) asm volatile("v_mfma_scale_f32_16x16x128_f8f6f4 %0, %1, %2, %0, %3, %3 op_sel_hi:[0,0,0]" : "+v"(acc[ai][bj][m][n]) : "v"(Bt##8[n]), "v"(At##8[m]), "v"(f8scale_)); \
        else { _Pragma("unroll") for (int k = 0; k < 2; ++k) acc[ai][bj][m][n] = __builtin_amdgcn_mfma_f32_16x16x32_bf16(Bt[n][k], At[m][k], acc[ai][bj][m][n], 0, 0, 0); } } \
        __builtin_amdgcn_s_setprio(0); } while (0)
#define PG8_WAIT_V(n) asm volatile("s_waitcnt vmcnt(" #n ")" ::: "memory")
#define PG8_WAIT_L(n) asm volatile("s_waitcnt lgkmcnt(" #n ")" ::: "memory")
#define PG8_BAR __builtin_amdgcn_s_barrier()
#define PG8_SCHED __builtin_amdgcn_sched_barrier(0)
    Unit cur, nxt; int ui = 0;
    if (!S.next(0, cur)) return;
    f32x4 acc[2][2][4][2];
#pragma unroll
    for (int a = 0; a < 2; ++a)
#pragma unroll
        for (int b = 0; b < 2; ++b)
#pragma unroll
            for (int m = 0; m < 4; ++m)
#pragma unroll
                for (int n = 0; n < 2; ++n) acc[a][b][m][n] = (f32x4){0.f, 0.f, 0.f, 0.f};
    const int f8scale_ = 0x7f7f7f7f;
    bf16x8 At[4][2], B0[2][2], B1[2][2]; i32x8_ At8[4], B08[2], B18[2];
    const char* cA = (const char*)g.A + (size_t)cur.pm * tstepA; const char* cB = (const char*)g.Bt + (size_t)cur.e * g.estride + (size_t)cur.pn * tstep;
    S.a_ready(cur);
    if constexpr (SP2) {
        PG8_STAGE(PG8_SB(0, 0), cB, voffB); PG8_STAGE(PG8_SB(0, 1), cB + hstep, voffB); PG8_STAGE(PG8_SA(0, 0), cA, voffA); PG8_STAGE(PG8_SA(0, 1), cA + hstepA, voffA);
        if (wr == 1) PG8_BAR;
        PG8_WAIT_V(2); PG8_BAR;
        PG8_STAGE(PG8_SB(1, 0), cB + kstep, voffB); PG8_STAGE(PG8_SA(1, 0), cA + kstep, voffA); PG8_STAGE(PG8_SB(1, 1), cB + hstep + kstep, voffB);
        PG8_WAIT_V(6); PG8_BAR;
    } else {
        PG8_STAGE(PG8_SB(0, 0), cB, voffB); PG8_STAGE(PG8_SA(0, 0), cA, voffA); PG8_STAGE(PG8_SB(0, 1), cB + hstep, voffB); PG8_STAGE(PG8_SA(0, 1), cA + hstepA, voffA);
        if (wr == 1) PG8_BAR;
        PG8_WAIT_V(4); PG8_BAR;
        PG8_STAGE(PG8_SB(1, 0), cB + kstep, voffB); PG8_STAGE(PG8_SA(1, 0), cA + kstep, voffA); PG8_STAGE(PG8_SB(1, 1), cB + hstep + kstep, voffB);
        PG8_WAIT_V(6); PG8_BAR;
    }
    for (;;) {
        const bool has_next = S.next(ui + 1, nxt);
        const char* nA = has_next ? (const char*)g.A + (size_t)nxt.pm * tstepA : cA; const char* nB = has_next ? (const char*)g.Bt + (size_t)nxt.e * g.estride + (size_t)nxt.pn * tstep : cB;
        for (int t = 0; t < nt; t += 2) {
            const bool last = (t == nt - 2);
            const char* a1 = cA + (size_t)(t + 1) * kstep;
            const char* a2 = last ? nA : cA + (size_t)(t + 2) * kstep; const char* b2 = last ? nB : cB + (size_t)(t + 2) * kstep;
            const char* a3 = a2 + kstep; const char* b3 = b2 + kstep;
            if (last && has_next) S.a_ready(nxt);
            if constexpr (SP2) {
            PG8_LDB(B0, 0, 0); PG8_LDB(B1, 0, 1); PG8_SCHED; PG8_LDA(At, 0, 0); PG8_STAGE(PG8_SA(1, 1), a1 + hstepA, voffA);
            PG8_WAIT_V(8); PG8_WAIT_L(0); PG8_BAR; PG8_MMA(0, 0, At, B0); PG8_MMA(0, 1, At, B1); PG8_BAR; PG8_SCHED;
            PG8_LDA(At, 0, 1); PG8_STAGE(PG8_SB(0, 0), b2, voffB); PG8_STAGE(PG8_SB(0, 1), b2 + hstep, voffB); PG8_STAGE(PG8_SA(0, 0), a2, voffA);
            PG8_WAIT_V(8); PG8_WAIT_L(0); PG8_BAR; PG8_MMA(1, 0, At, B0); PG8_MMA(1, 1, At, B1); PG8_BAR; PG8_SCHED;
            PG8_LDB(B0, 1, 0); PG8_LDB(B1, 1, 1); PG8_SCHED; PG8_LDA(At, 1, 0); PG8_STAGE(PG8_SA(0, 1), a2 + hstepA, voffA);
            PG8_WAIT_V(8); PG8_WAIT_L(0); PG8_BAR; PG8_MMA(0, 0, At, B0); PG8_MMA(0, 1, At, B1); PG8_BAR; PG8_SCHED;
            PG8_LDA(At, 1, 1); PG8_STAGE(PG8_SB(1, 0), b3, voffB); PG8_STAGE(PG8_SB(1, 1), b3 + hstep, voffB); PG8_STAGE(PG8_SA(1, 0), a3, voffA);
            PG8_WAIT_V(8); PG8_WAIT_L(0); PG8_BAR; PG8_MMA(1, 0, At, B0); PG8_MMA(1, 1, At, B1); PG8_BAR; PG8_SCHED;
            } else {
            PG8_LDB(B0, 0, 0); PG8_SCHED; PG8_LDA(At, 0, 0); PG8_STAGE(PG8_SA(1, 1), a1 + hstepA, voffA);
            PG8_WAIT_L(8); PG8_BAR; PG8_WAIT_L(0); PG8_MMA(0, 0, At, B0); PG8_BAR; PG8_SCHED;
            PG8_LDB(B1, 0, 1); PG8_STAGE(PG8_SB(0, 0), b2, voffB);
            PG8_BAR; PG8_WAIT_L(0); PG8_MMA(0, 1, At, B1); PG8_BAR;
            PG8_LDA(At, 0, 1); PG8_STAGE(PG8_SA(0, 0), a2, voffA);
            PG8_BAR; PG8_WAIT_L(0); PG8_MMA(1, 0, At, B0); PG8_BAR; PG8_SCHED;
            PG8_STAGE(PG8_SB(0, 1), b2 + hstep, voffB);
            PG8_WAIT_V(6); PG8_BAR; PG8_MMA(1, 1, At, B1); PG8_BAR;
            PG8_LDB(B0, 1, 0); PG8_SCHED; PG8_LDA(At, 1, 0); PG8_STAGE(PG8_SA(0, 1), a2 + hstepA, voffA);
            PG8_WAIT_L(8); PG8_BAR; PG8_WAIT_L(0); PG8_MMA(0, 0, At, B0); PG8_BAR; PG8_SCHED;
            PG8_LDB(B1, 1, 1); PG8_STAGE(PG8_SB(1, 0), b3, voffB);
            PG8_BAR; PG8_WAIT_L(0); PG8_MMA(0, 1, At, B1); PG8_BAR;
            PG8_LDA(At, 1, 1); PG8_STAGE(PG8_SA(1, 0), a3, voffA);
            PG8_BAR; PG8_WAIT_L(0); PG8_MMA(1, 0, At, B0); PG8_BAR; PG8_SCHED;
            PG8_STAGE(PG8_SB(1, 1), b3 + hstep, voffB);
            PG8_WAIT_V(6); PG8_BAR; PG8_MMA(1, 1, At, B1); PG8_BAR;
            }
        }
        if constexpr (FP8) asm volatile("s_nop 15\n\ts_nop 15" ::: "memory");
        if constexpr (ALIGN_EPI) { if (wr == 0) PG8_BAR; }
        if constexpr (!Epi::AFTER_DRAIN) { E(acc, cur, wr, wc, fr, fq); S.done(cur); }
        if (!has_next) break;
#pragma unroll
        for (int a = 0; a < 2; ++a)
#pragma unroll
            for (int b = 0; b < 2; ++b)
#pragma unroll
                for (int m = 0; m < 4; ++m)
#pragma unroll
                    for (int n = 0; n < 2; ++n) acc[a][b][m][n] = (f32x4){0.f, 0.f, 0.f, 0.f};
        cur = nxt; cA = nA; cB = nB; ++ui;
        if constexpr (ALIGN_EPI) { if (wr == 1) PG8_BAR; }
    }
    PG8_WAIT_V(0);
    if constexpr (!ALIGN_EPI) { if (wr == 0) PG8_BAR; }
    PG8_BAR;
    if constexpr (Epi::AFTER_DRAIN) { E.fused(acc, cur, wr, wc, fr, fq, lds, wid, lane); S.done(cur); }
#undef PG8_SA
#undef PG8_SB
#undef PG8_STAGE
#undef PG8_LDA
#undef PG8_LDB
#undef PG8_MMA
#undef PG8_CAT
#undef PG8_WAIT_V
#undef PG8_WAIT_L
#undef PG8_BAR
#undef PG8_SCHED
}
}

constexpr int NT = 65536, DM = 1024, NBATCH = 32, SEQ = 2048;
constexpr int DFF = 2816, DFE = 3584, NEXP = 8;
constexpr int MOE_ROWS = 133120;
constexpr float EPS = 1e-6f;
constexpr size_t MiB = 1u << 20;
constexpr size_t WS_CTL = 0, CTL_ZERO_BYTES = 1 * MiB;
constexpr size_t WS_LA = 1 * MiB;
constexpr size_t WS_L1 = WS_LA + 8192;
constexpr size_t WS_CB = WS_LA + 16384;
constexpr size_t WS_RCNT = WS_LA + 32768;
constexpr size_t WS_RTAB = WS_LA + 65536;
constexpr size_t WS_ROUTE = 2 * MiB;
constexpr size_t WS_SLOT = 3 * MiB;
constexpr size_t WS_SELM = 4 * MiB;
constexpr size_t WS_GATES = 8 * MiB;
constexpr size_t WS_KC = 20 * MiB;
constexpr size_t WS_VCT = 22 * MiB;
constexpr size_t WS_HC = 24 * MiB;
constexpr size_t WS_W = 48 * MiB;
constexpr size_t W_HIN = WS_W, W_HOUT = WS_W + 16 * MiB, W_KVQ = WS_W + 20 * MiB, W_Q3 = WS_W + 26 * MiB, W_CMP1 = WS_W + 29 * MiB, W_NOUT = WS_W + 31 * MiB,
                 W_FGU = WS_W + 35 * MiB, W_FDN = WS_W + 57 * MiB, W_MGU = WS_W + 68 * MiB, W_MDN = WS_W + 292 * MiB;
constexpr size_t WS_XN = 452 * MiB;
constexpr size_t WS_R = 580 * MiB;
constexpr size_t R_PQ = WS_R, R_PI = WS_R + 128 * MiB, R_PG = WS_R + 256 * MiB, R_LF = WS_R + 384 * MiB, R_O2 = WS_R + 640 * MiB;
constexpr size_t R_HF = WS_R + 256 * MiB;
constexpr size_t R_KS = WS_R, R_KW = WS_R + 32 * MiB, R_VST = WS_R + 64 * MiB, R_VWT = WS_R + 96 * MiB, R_KCR = WS_R + 128 * MiB, R_VCR = WS_R + 160 * MiB;
constexpr size_t R_QKV = WS_R + 256 * MiB;
constexpr size_t R_Q = WS_R + 608 * MiB, R_O = WS_R + 736 * MiB;
constexpr size_t R_XP = WS_R, R_HM = WS_R + 260 * MiB;
constexpr size_t WS_NEED = R_HM + (size_t)MOE_ROWS * DFE * 2;
static_assert(WS_NEED <= 1792 * MiB, "workspace map");
static_assert(W_MDN + 112 * MiB <= WS_XN, "weights map");
static_assert(pg8::EpiHgrnIn::O_PQ == R_PQ && pg8::EpiHgrnIn::O_PI == R_PI && pg8::EpiHgrnIn::O_PG == R_PG && pg8::EpiHgrnIn::O_LF == R_LF && pg8::EpiHgrnIn::O_LA == WS_LA && pg8::EpiHgrnIn::O_L1 == WS_L1, "EpiHgrnIn offsets");

constexpr int LDS_BYTES = 147456;
constexpr int MISC_OFF = 131072 + 320;
constexpr int NWAVES = 8;

#define GAS __attribute__((address_space(1)))
#define LAS __attribute__((address_space(3)))
typedef unsigned short bf16;
typedef unsigned v4u __attribute__((ext_vector_type(4)));
typedef unsigned v2u __attribute__((ext_vector_type(2)));
typedef float f32x4 __attribute__((ext_vector_type(4)));
#define LDS_WAIT() asm volatile("s_waitcnt lgkmcnt(0)" ::: "memory")
__device__ __forceinline__ unsigned f2bf(float f) { unsigned u = __builtin_bit_cast(unsigned, f); return (u + 0x7fffu + ((u >> 16) & 1u)) >> 16; }
__device__ __forceinline__ unsigned pk2(float lo, float hi) { return f2bf(lo) | (f2bf(hi) << 16); }
__device__ __forceinline__ float bf2f(unsigned b) { return __builtin_bit_cast(float, b << 16); }
__device__ __forceinline__ float bflo(unsigned w) { return __builtin_bit_cast(float, w << 16); }
__device__ __forceinline__ float bfhi(unsigned w) { return __builtin_bit_cast(float, w & 0xffff0000u); }
__device__ __forceinline__ float wave_sum(float v) {
#pragma unroll
    for (int o = 32; o >= 1; o >>= 1) v += __shfl_xor(v, o);
    return v;
}
__device__ __forceinline__ float wave_max(float v) {
#pragma unroll
    for (int o = 32; o >= 1; o >>= 1) v = fmaxf(v, __shfl_xor(v, o));
    return v;
}

#define XB_TMO      128
#define XB_XCNT(j)  (256  + 64 * (j))
#define XB_XSUB(j)  (1280 + 64 * (j))
#define XB_XGEN(j)  (2304 + 64 * (j))
#define XB_TOP      3328
#define XB_TOPGEN   3392
#define XCD_BAR_WORDS 3456
#define XB_SPIN_CAP (1u << 22)
__device__ __forceinline__ unsigned xb_ld(unsigned* p)              { return __hip_atomic_load(p, __ATOMIC_RELAXED, __HIP_MEMORY_SCOPE_AGENT); }
__device__ __forceinline__ unsigned xb_add(unsigned* p, unsigned v) { return __hip_atomic_fetch_add(p, v, __ATOMIC_RELAXED, __HIP_MEMORY_SCOPE_AGENT); }
__device__ __forceinline__ unsigned xb_xcc_id() { return (unsigned)__builtin_amdgcn_s_getreg((3 << 11) | 20) & 0xFu; }
#define XB_SPIN(cond, bar) do { unsigned _sp = 0; while (cond) { __builtin_amdgcn_s_sleep(1); \
    if ((++_sp & 255u) == 0u) { if (xb_ld(&(bar)[XB_TMO])) break; if (_sp > XB_SPIN_CAP) { atomicAdd(&(bar)[XB_TMO], 1u); break; } } } } while (0)
struct XcdBarrier { unsigned* bar; unsigned x; volatile LAS unsigned* st; };
__device__ __forceinline__ XcdBarrier xcd_barrier_post(unsigned* bar, volatile LAS unsigned* st) {
    XcdBarrier b; b.bar = bar; b.x = xb_xcc_id(); b.st = st;
    if (threadIdx.x == 0) (void)xb_add(&bar[XB_XCNT(b.x)], 1u);
    return b;
}
__device__ __forceinline__ void xcd_barrier_complete(unsigned* bar, unsigned x, unsigned& nloc, unsigned& nx) {
    const unsigned G = gridDim.x * gridDim.y * gridDim.z;
    unsigned sum, cnt, mine, sp = 0u;
    for (;;) {
        sum = 0u; cnt = 0u; mine = 0u;
#pragma unroll
        for (unsigned j = 0; j < 16; ++j) { const unsigned c = xb_ld(&bar[XB_XCNT(j)]); sum += c; cnt += (c > 0u) ? 1u : 0u; mine = (j == x) ? c : mine; }
        if (sum == G) break;
        __builtin_amdgcn_s_sleep(1);
        if ((++sp & 255u) == 0u) { if (xb_ld(&bar[XB_TMO])) break; if (sp > XB_SPIN_CAP) { atomicAdd(&bar[XB_TMO], 1u); break; } }
    }
    nloc = mine > 0u ? mine : 1u; nx = cnt > 0u ? cnt : 1u;
}
__device__ __forceinline__ void xcd_barrier(const XcdBarrier& b) {
    asm volatile("s_waitcnt vmcnt(0)" ::: "memory");
    __syncthreads();
    if (threadIdx.x == 0) {
        unsigned* bar = b.bar; unsigned bx_ = b.x; asm volatile("" : "+s"(bar), "+s"(bx_));
        __builtin_amdgcn_s_waitcnt(0);
        unsigned nloc = b.st[0], nx = b.st[1];
        if (nloc == 0u) { xcd_barrier_complete(bar, bx_, nloc, nx); b.st[0] = nloc; b.st[1] = nx; }
        const unsigned old = xb_add(&bar[XB_XSUB(bx_)], 1u);
        const unsigned gen = old / nloc;
        if (old + 1u == (gen + 1u) * nloc) {
            __builtin_amdgcn_fence(__ATOMIC_RELEASE, "agent");
            asm volatile("s_waitcnt vmcnt(0)" ::: "memory");
            const unsigned og = xb_add(&bar[XB_TOP], 1u);
            const unsigned tg = og / nx;
            if (og + 1u == (tg + 1u) * nx) xb_add(&bar[XB_TOPGEN], 1u);
            else XB_SPIN(xb_ld(&bar[XB_TOPGEN]) == tg, bar);
            __builtin_amdgcn_fence(__ATOMIC_ACQUIRE, "agent");
            xb_add(&bar[XB_XGEN(bx_)], 1u);
            asm volatile("s_waitcnt vmcnt(0)" ::: "memory");
        } else {
            XB_SPIN(xb_ld(&bar[XB_XGEN(bx_)]) == gen, bar);
            __builtin_amdgcn_fence(__ATOMIC_ACQUIRE, "agent");
            asm volatile("s_waitcnt vmcnt(0)" ::: "memory");
        }
    }
    __syncthreads();
}

struct Ctx {
    LAS unsigned char* lds;
    int tid, lane, wave, G, bid;
    float* out; unsigned char* ws;
    __device__ __forceinline__ const float* inp(int i) const {
        const __attribute__((address_space(4))) unsigned char* kp = (const __attribute__((address_space(4))) unsigned char*)__builtin_amdgcn_kernarg_segment_ptr();
        asm volatile("" : "+s"(kp));
        return ((const float* const __attribute__((address_space(4)))*)kp)[i];
    }
};
enum { I_X = 0, I_NMIX, I_NFFN, I_HWIN, I_HWOUT, I_HGN, I_HLB, I_KVN, I_KVW, I_CPK, I_CW1K, I_CW2K, I_CPV, I_CW1V, I_CW2V, I_KN, I_NWIN, I_NWOUT, I_NQN, I_FGU, I_FDN, I_MR, I_MGU, I_MDN };

constexpr int MAXJOB = 64;
struct JobTab { unsigned long long src[MAXJOB], gain[MAXJOB], dst[MAXJOB]; int K[MAXJOB], Nsrc[MAXJOB], npb[MAXJOB], F[MAXJOB], rowoff[MAXJOB], istart[MAXJOB + 1]; float f8s[MAXJOB]; int njobs; };
__device__ __forceinline__ void add_job(LAS JobTab* J, const float* src, const float* gain, bf16* dst, int K, int Nsrc, int Npad, int F, int rowoff, float f8s = 0.f) {
    const int j = J->njobs; J->src[j] = (unsigned long long)src; J->gain[j] = (unsigned long long)gain; J->dst[j] = (unsigned long long)dst;
    J->K[j] = K; J->Nsrc[j] = Nsrc; J->npb[j] = Npad / 32; J->F[j] = F; J->rowoff[j] = rowoff; J->f8s[j] = f8s; J->istart[j + 1] = J->istart[j] + (K / 64) * (Npad / 32); J->njobs = j + 1;
}
__device__ __forceinline__ void transpose_item(const float* W, int K, int Nsrc, const float* gain, bf16* WT, int dstrow0, int k0, int n0, LAS float* scr, int lane, float f8s) {
    const int c4 = lane & 7, kr = lane >> 3, n = n0 + 4 * c4; const bool okn = n < Nsrc;
    f32x4 v[8];
#pragma unroll
    for (int i = 0; i < 8; ++i) { const int kk = 8 * i + kr; v[i] = okn ? *(const f32x4*)(W + (size_t)(k0 + kk) * Nsrc + n) : (f32x4){0.f, 0.f, 0.f, 0.f}; }
#pragma unroll
    for (int i = 0; i < 8; ++i) { const int kk = 8 * i + kr; if (gain) v[i] = v[i] * gain[k0 + kk]; *(LAS f32x4*)(scr + kk * 36 + 4 * c4) = v[i]; }
    LDS_WAIT();
    const int c = lane & 7;
#pragma unroll
    for (int j = 0; j < 4; ++j) { const int nn = (lane >> 3) + 8 * j; const LAS float* s = scr + (8 * c) * 36 + nn;
        if (f8s != 0.f) { v2u o; o.x = pg8::pk4_fp8(s[0 * 36] * f8s, s[1 * 36] * f8s, s[2 * 36] * f8s, s[3 * 36] * f8s); o.y = pg8::pk4_fp8(s[4 * 36] * f8s, s[5 * 36] * f8s, s[6 * 36] * f8s, s[7 * 36] * f8s);
            *(v2u*)((unsigned char*)WT + (size_t)(dstrow0 + nn) * K + k0 + 8 * c) = o; }
        else { v4u o; o.x = pk2(s[0 * 36], s[1 * 36]); o.y = pk2(s[2 * 36], s[3 * 36]); o.z = pk2(s[4 * 36], s[5 * 36]); o.w = pk2(s[6 * 36], s[7 * 36]);
            *(v4u*)(WT + (size_t)(dstrow0 + nn) * K + k0 + 8 * c) = o; } }
    LDS_WAIT();
}
__device__ __forceinline__ void norm_row_store(const f32x4 (&v)[4], bf16* orow, int lane) {
    float s = 0.f;
#pragma unroll
    for (int j = 0; j < 4; ++j) s += (v[j].x * v[j].x + v[j].y * v[j].y) + (v[j].z * v[j].z + v[j].w * v[j].w);
    const float rstd = rsqrtf(wave_sum(s) * (1.f / DM) + EPS);
    v2u* o8 = (v2u*)orow + lane;
#pragma unroll
    for (int j = 0; j < 4; ++j) { v2u w; w.x = pk2(v[j].x * rstd, v[j].y * rstd); w.y = pk2(v[j].z * rstd, v[j].w * rstd); o8[64 * j] = w; }
}
__device__ __forceinline__ void p_prologue(Ctx& C) {
    LAS JobTab* J = (LAS JobTab*)(C.lds + 73728);
    unsigned char* ws = C.ws;
    if (C.tid == 0) {
        J->njobs = 0; J->istart[0] = 0;
        for (int l = 0; l < 2; ++l) add_job(J, C.inp(I_HWIN) + (size_t)l * 1024 * 4096, C.inp(I_NMIX) + l * 1024, (bf16*)(ws + W_HIN) + (size_t)l * 4096 * 1024, 1024, 4096, 4096, 0, 0);
        for (int l = 0; l < 2; ++l) add_job(J, C.inp(I_HWOUT) + (size_t)l * 1024 * 1024, nullptr, (bf16*)(ws + W_HOUT) + (size_t)l * 1024 * 1024, 1024, 1024, 1024, 0, 0);
        add_job(J, C.inp(I_KVW), C.inp(I_KVN), (bf16*)(ws + W_KVQ), 1024, 1536, 1536, 0, 0);
        add_job(J, C.inp(I_NWIN), C.inp(I_NMIX) + 2048, (bf16*)(ws + W_KVQ), 1024, 1072, 1280, 0, 1536);
        add_job(J, C.inp(I_NWIN) + (size_t)1024 * 1072, C.inp(I_NMIX) + 3072, (bf16*)(ws + W_Q3), 1024, 1072, 1280, 0, 0);
        add_job(J, C.inp(I_CW1K), nullptr, (bf16*)(ws + W_CMP1), 2048, 256, 256, 0, 0);
        add_job(J, C.inp(I_CW1V), nullptr, (bf16*)(ws + W_CMP1) + (size_t)256 * 2048, 2048, 256, 256, 0, 0);
        for (int l = 0; l < 2; ++l) add_job(J, C.inp(I_NWOUT) + (size_t)l * 1024 * 1024, nullptr, (bf16*)(ws + W_NOUT) + (size_t)l * 1024 * 1024, 1024, 1024, 1024, 0, 0);
        for (int l = 0; l < 2; ++l) add_job(J, C.inp(I_FGU) + (size_t)l * 1024 * 2 * DFF, C.inp(I_NFFN) + (2 * l) * 1024, (bf16*)(ws + W_FGU + (size_t)l * 2 * DFF * 2048), 1024, 2 * DFF, 2 * DFF, DFF, 0, l ? pg8::FP8_SW1 : 0.f);
        for (int l = 0; l < 2; ++l) add_job(J, C.inp(I_FDN) + (size_t)l * DFF * 1024, nullptr, (bf16*)(ws + W_FDN + (size_t)l * 1024 * DFF * 2), DFF, 1024, 1024, 0, 0, l ? pg8::FP8_SW2 : 0.f);
        for (int l = 0; l < 16; ++l) add_job(J, C.inp(I_MGU) + (size_t)l * 1024 * 2 * DFE, C.inp(I_NFFN) + (2 * (l >> 3) + 1) * 1024, (bf16*)(ws + W_MGU + (size_t)l * 2 * DFE * 1024), 1024, 2 * DFE, 2 * DFE, DFE, 0, pg8::FP8_SW1);
        for (int l = 0; l < 16; ++l) add_job(J, C.inp(I_MDN) + (size_t)l * DFE * 1024, nullptr, (bf16*)(ws + W_MDN + (size_t)l * 1024 * DFE), DFE, 1024, 1024, 0, 0, pg8::FP8_SW2);
    }
    __syncthreads();
    LAS float* scr = (LAS float*)(C.lds + C.wave * 9216);
    const int gw = C.bid * NWAVES + C.wave, NGW = C.G * NWAVES;
    const int nj = J->njobs, total = J->istart[nj];
    for (int it = gw; it < total; it += NGW) {
        int j = 0; while (j + 1 < nj && J->istart[j + 1] <= it) ++j;
        const int r = it - J->istart[j], npb = J->npb[j], kb = r / npb, nb = r % npb, n0 = 32 * nb, F = J->F[j];
        int drow = J->rowoff[j] + n0;
        if (F) drow = (n0 < F) ? 256 * (n0 / 128) + (n0 % 128) : 256 * ((n0 - F) / 128) + 128 + ((n0 - F) % 128);
        transpose_item((const float*)J->src[j], J->K[j], J->Nsrc[j], (const float*)J->gain[j], (bf16*)J->dst[j], drow, 64 * kb, n0, scr, C.lane, J->f8s[j]);
    }
    { const int gt = C.bid * 512 + C.tid;
      if (gt < 1024) { const float a0 = C.inp(I_HLB)[gt], a1 = C.inp(I_HLB)[1024 + gt]; const float mx = fmaxf(a0, a1), e0 = expf(a0 - mx), e1 = expf(a1 - mx), s = e0 + e1;
          const float s0 = e0 / s, s1 = e1 / s, lb1 = (s0 + s1) - s0;
          float* la = (float*)(ws + WS_LA); float* l1 = (float*)(ws + WS_L1);
          la[gt] = -INFINITY; l1[gt] = 0.f; la[1024 + gt] = logf(lb1); l1[1024 + gt] = log1pf(-lb1); } }
    if (C.bid == 0 && C.tid < 128) ((int*)(ws + WS_RTAB))[2048 + C.tid] = C.tid >> 6;
    if (C.G >= 8 && C.bid >= C.G - 8) { const int ob = (C.bid - (C.G - 8)) * 64 + C.lane, which = ob >> 8, j = ob & 255; const float* pos = C.inp(which ? I_CPV : I_CPK); const float* w1 = C.inp(which ? I_CW1V : I_CW1K);
        float a = 0.f;
#pragma unroll 8
        for (int i = C.wave * 256; i < C.wave * 256 + 256; ++i) a += pos[i] * w1[(size_t)i * 256 + j];
        __syncthreads();
        LAS float* red = (LAS float*)(C.lds + 80 * 1024); red[C.wave * 64 + C.lane] = a;
        __syncthreads();
        if (C.wave == 0) { float t = 0.f;
#pragma unroll
            for (int w = 0; w < 8; ++w) t += red[w * 64 + C.lane];
            ((float*)(ws + WS_CB))[ob] = t; } }
    for (int c = C.bid; c < 256; c += C.G)
        for (int i = 0; i < 32; i += 4) { f32x4 v[4][4]; const float* xb = C.inp(I_X);
#pragma unroll
            for (int r = 0; r < 4; ++r) { const f32x4* xr = (const f32x4*)(xb + (size_t)(c * 256 + C.wave * 32 + i + r) * DM) + C.lane;
#pragma unroll
                for (int j = 0; j < 4; ++j) v[r][j] = xr[64 * j]; }
#pragma unroll
            for (int r = 0; r < 4; ++r) norm_row_store(v[r], (bf16*)(ws + WS_XN) + (size_t)(c * 256 + C.wave * 32 + i + r) * DM, C.lane); }
}

template <bool MOE_ADD, bool ROUTER, bool WRITE_XN, bool XN_FP8 = false>
__device__ __forceinline__ void p_norm(Ctx& C, const float* rw, const float* rgain) {
    unsigned char* ws = C.ws;
    LAS int* cnt8 = (LAS int*)(C.lds + 1024);
    const bf16* Y = (const bf16*)(ws + R_XP);
    const int4* route = (const int4*)(ws + WS_ROUTE); const int2* slot = (const int2*)(ws + WS_SLOT);
    constexpr int NR = (MOE_ADD || ROUTER) ? 2 : 4;
    for (int c = C.bid; c < 256; c += C.G) {
        if (ROUTER) { __syncthreads(); if (C.tid < 8) cnt8[C.tid] = 0; __syncthreads(); }
#pragma unroll 1
        for (int i = 0; i < 32; i += NR) {
            f32x4 v[NR][4];
#pragma unroll
            for (int r = 0; r < NR; ++r) { const float* hr = C.out + (size_t)(c * 256 + C.wave * 32 + i + r) * DM;
#pragma unroll
                for (int j = 0; j < 4; ++j) v[r][j] = ((const f32x4*)hr + C.lane)[64 * j]; }
            if (MOE_ADD) {
#pragma unroll
                for (int r = 0; r < NR; ++r) { const int row = c * 256 + C.wave * 32 + i + r; float* hr = C.out + (size_t)row * DM;
                    const int4 rt = route[row]; const int2 sl = slot[row]; const float w0 = __builtin_bit_cast(float, rt.y), w1 = __builtin_bit_cast(float, rt.z);
                    const v2u* y0 = (const v2u*)(Y + (size_t)sl.x * DM) + C.lane; const v2u* y1 = (const v2u*)(Y + (size_t)sl.y * DM) + C.lane;
#pragma unroll
                    for (int j = 0; j < 4; ++j) { const v2u a = y0[64 * j], b = y1[64 * j];
                        v[r][j].x += w0 * bflo(a.x) + w1 * bflo(b.x); v[r][j].y += w0 * bfhi(a.x) + w1 * bfhi(b.x); v[r][j].z += w0 * bflo(a.y) + w1 * bflo(b.y); v[r][j].w += w0 * bfhi(a.y) + w1 * bfhi(b.y);
                        ((f32x4*)hr + C.lane)[64 * j] = v[r][j]; } }
            }
            if (WRITE_XN || ROUTER) {
#pragma unroll
                for (int r = 0; r < NR; ++r) { const int row = c * 256 + C.wave * 32 + i + r;
                    float s = 0.f;
#pragma unroll
                    for (int j = 0; j < 4; ++j) s += (v[r][j].x * v[r][j].x + v[r][j].y * v[r][j].y) + (v[r][j].z * v[r][j].z + v[r][j].w * v[r][j].w);
                    const float rstd = rsqrtf(wave_sum(s) * (1.f / DM) + EPS);
                    if (WRITE_XN && XN_FP8) { unsigned* o4 = (unsigned*)(ws + WS_XN + (size_t)row * DM) + C.lane;
#pragma unroll
                        for (int j = 0; j < 4; ++j) o4[64 * j] = pg8::pk4_fp8(v[r][j].x * rstd, v[r][j].y * rstd, v[r][j].z * rstd, v[r][j].w * rstd); }
                    if (WRITE_XN && !XN_FP8) { v2u* o8 = (v2u*)((bf16*)(ws + WS_XN) + (size_t)row * DM) + C.lane;
#pragma unroll
                        for (int j = 0; j < 4; ++j) { v2u w; w.x = pk2(v[r][j].x * rstd, v[r][j].y * rstd); w.y = pk2(v[r][j].z * rstd, v[r][j].w * rstd); o8[64 * j] = w; } }
                    if (ROUTER) {
                        float lg[8];
#pragma unroll
                        for (int e = 0; e < 8; ++e) lg[e] = 0.f;
#pragma unroll
                        for (int j = 0; j < 4; ++j) { const int k0 = 4 * C.lane + 256 * j; const f32x4 g4 = *(const f32x4*)(rgain + k0);
#pragma unroll
                            for (int q = 0; q < 4; ++q) { const float xv = v[r][j][q] * rstd * g4[q]; const f32x4 wa = *(const f32x4*)(rw + (size_t)(k0 + q) * 8), wb = *(const f32x4*)(rw + (size_t)(k0 + q) * 8 + 4);
                                lg[0] += xv * wa.x; lg[1] += xv * wa.y; lg[2] += xv * wa.z; lg[3] += xv * wa.w; lg[4] += xv * wb.x; lg[5] += xv * wb.y; lg[6] += xv * wb.z; lg[7] += xv * wb.w; } }
#pragma unroll
                        for (int e = 0; e < 8; ++e) lg[e] = wave_sum(lg[e]);
                        int e0 = 0; float v0 = lg[0];
#pragma unroll
                        for (int e = 1; e < 8; ++e) if (lg[e] > v0) { v0 = lg[e]; e0 = e; }
                        int e1 = -1; float v1 = -INFINITY;
#pragma unroll
                        for (int e = 0; e < 8; ++e) if (e != e0 && (e1 < 0 || lg[e] > v1)) { v1 = lg[e]; e1 = e; }
                        const float ex = expf(v1 - v0), w0 = 1.f / (1.f + ex), w1 = ex / (1.f + ex);
                        if (C.lane == 0) { ((int4*)(ws + WS_ROUTE))[row] = make_int4(e0 | (e1 << 8), __builtin_bit_cast(int, w0), __builtin_bit_cast(int, w1), 0);
                            atomicAdd((int*)&cnt8[e0], 1); atomicAdd((int*)&cnt8[e1], 1); }
                    }
                }
            }
        }
        if (ROUTER) { __syncthreads(); if (C.tid < 8) ((int*)(ws + WS_RCNT))[c * 8 + C.tid] = cnt8[C.tid]; }
    }
}

__device__ __forceinline__ void p_gather(Ctx& C) {
    unsigned char* ws = C.ws;
    LAS int* tot = (LAS int*)(C.lds + 0);
    LAS int* pre = tot + 8;
    LAS int* base = tot + 16;
    LAS int* ee = tot + 32;
    LAS int* sl = tot + 32 + 256;
    const int* rcnt = (const int*)(ws + WS_RCNT);
    const int4* route = (const int4*)(ws + WS_ROUTE);
    for (int c = C.bid; c < 256; c += C.G) {
        __syncthreads();
        { const int e = C.wave; int t = 0, p = 0;
          for (int i = C.lane; i < 256; i += 64) { const int v = rcnt[i * 8 + e]; t += v; if (i < c) p += v; }
#pragma unroll
          for (int o = 32; o >= 1; o >>= 1) { t += __shfl_xor(t, o); p += __shfl_xor(p, o); }
          if (C.lane == 0) { tot[e] = t; pre[e] = p; } }
        if (C.tid < 256) ee[C.tid] = route[c * 256 + C.tid].x;
        __syncthreads();
        if (C.tid == 0) { int off = 0; for (int e = 0; e < 8; ++e) { base[e] = off + pre[e]; const int nt = (tot[e] + 255) >> 8;
                if (c == 0) { int* te = (int*)(ws + WS_RTAB); for (int q = 0; q < nt; ++q) te[(off >> 8) + q] = e; }
                off += nt << 8; }
            if (c == 0) ((int*)(ws + WS_RTAB))[1024] = off >> 8; }
        __syncthreads();
        if (C.tid < 8) { const int e = C.tid; int r = base[e];
            for (int i = 0; i < 256; ++i) { const int pk = ee[i]; if ((pk & 255) == e) sl[2 * i] = r++; if ((pk >> 8) == e) sl[2 * i + 1] = r++; } }
        __syncthreads();
        if (C.tid < 256) ((int2*)(ws + WS_SLOT))[c * 256 + C.tid] = make_int2(sl[2 * C.tid], sl[2 * C.tid + 1]);
        for (int i = 0; i < 32; i += 4) { v4u a[4];
#pragma unroll
            for (int r = 0; r < 4; ++r) a[r] = *((const v4u*)(ws + WS_XN + (size_t)(c * 256 + C.wave * 32 + i + r) * DM) + C.lane);
#pragma unroll
            for (int r = 0; r < 4; ++r) { const int tl = C.wave * 32 + i + r;
                *((v4u*)(ws + R_XP + (size_t)sl[2 * tl] * DM) + C.lane) = a[r]; *((v4u*)(ws + R_XP + (size_t)sl[2 * tl + 1] * DM) + C.lane) = a[r]; } }
    }
}

__device__ __forceinline__ void p_post_kv(Ctx& C) {
    unsigned char* ws = C.ws;
    const bf16* raw = (const bf16*)(ws + R_QKV);
    const float* kn = C.inp(I_KN);
    LAS unsigned char* tl = C.lds + C.wave * 4608;
    const int l = C.lane, c8 = l & 7, r8 = l >> 3, gw = C.bid * NWAVES + C.wave, NGW = C.G * NWAVES;
    for (int it = gw; it < 128 * 64; it += NGW) {
        const int bg = it >> 6, blk = it & 63, b = bg >> 2, g = bg & 3;
        const bf16* rb = raw + (size_t)(b * SEQ + blk * 32) * 2816 + g * 64 + 8 * c8;
        const size_t dst0 = ((size_t)bg * SEQ + blk * 32) * 64 + 8 * c8;
#pragma unroll
        for (int j = 0; j < 6; ++j) {
            v4u x[4];
#pragma unroll
            for (int i = 0; i < 4; ++i) x[i] = *(const v4u*)(rb + (size_t)(r8 + 8 * i) * 2816 + j * 256);
            if (j == 0 || j == 1) {
                bf16* d = (bf16*)(ws + (j == 0 ? R_KCR : R_VCR)) + dst0;
#pragma unroll
                for (int i = 0; i < 4; ++i) *(v4u*)(d + (size_t)(r8 + 8 * i) * 64) = x[i];
            } else if (j == 2 || j == 4) {
                unsigned char* d = ws + (j == 2 ? R_KS : R_KW) + ((size_t)bg * SEQ + blk * 32) * 64 + (c8 >> 2) * 1024 + (c8 & 3) * 8; const float* gk = kn + (j == 2 ? 64 : 128) + 8 * c8;
                const f32x4 ga = *(const f32x4*)gk, gb = *(const f32x4*)(gk + 4);
#pragma unroll
                for (int i = 0; i < 4; ++i) { const float f[8] = {bflo(x[i].x), bfhi(x[i].x), bflo(x[i].y), bfhi(x[i].y), bflo(x[i].z), bfhi(x[i].z), bflo(x[i].w), bfhi(x[i].w)};
                    float ss = (f[0] * f[0] + f[1] * f[1]) + (f[2] * f[2] + f[3] * f[3]) + (f[4] * f[4] + f[5] * f[5]) + (f[6] * f[6] + f[7] * f[7]);
                    ss += __shfl_xor(ss, 1); ss += __shfl_xor(ss, 2); ss += __shfl_xor(ss, 4);
                    const float rs = rsqrtf(ss * (1.f / 64.f) + EPS);
                    v2u o; o.x = pg8::pk4_fp8(f[0] * rs * ga.x, f[1] * rs * ga.y, f[2] * rs * ga.z, f[3] * rs * ga.w); o.y = pg8::pk4_fp8(f[4] * rs * gb.x, f[5] * rs * gb.y, f[6] * rs * gb.z, f[7] * rs * gb.w);
                    *(v2u*)(d + (size_t)(r8 + 8 * i) * 32) = o; }
            } else {
#pragma unroll
                for (int i = 0; i < 4; ++i) *(LAS v4u*)(tl + (r8 + 8 * i) * 144 + 16 * c8) = x[i];
                LDS_WAIT();
                unsigned wv[8];
#pragma unroll
                for (int t4 = 0; t4 < 8; ++t4) { const float a0 = bf2f(*(const LAS bf16*)(tl + (4 * t4) * 144 + 2 * l)), a1 = bf2f(*(const LAS bf16*)(tl + (4 * t4 + 1) * 144 + 2 * l)),
                                                             a2 = bf2f(*(const LAS bf16*)(tl + (4 * t4 + 2) * 144 + 2 * l)), a3 = bf2f(*(const LAS bf16*)(tl + (4 * t4 + 3) * 144 + 2 * l)); wv[t4] = pg8::pk4_fp8(a0, a1, a2, a3); }
                unsigned char* d = ws + (j == 3 ? R_VST : R_VWT) + (((size_t)bg * 64 + blk) * 64 + l) * 32;
#pragma unroll
                for (int q = 0; q < 2; ++q) { const v4u o = {wv[4 * q], wv[4 * q + 1], wv[4 * q + 2], wv[4 * q + 3]}; *(v4u*)(d + 16 * q) = o; }
                LDS_WAIT();
            }
        }
    }
}

__device__ __forceinline__ void p_cmp2(Ctx& C) {
    unsigned char* ws = C.ws;
    const bf16* Hk = (const bf16*)(ws + WS_HC); const bf16* Hv = Hk + (size_t)16384 * 256;
    const float* w2k = C.inp(I_CW2K); const float* w2v = C.inp(I_CW2V); const float* kn = C.inp(I_KN);
    LAS float* hk = (LAS float*)(C.lds + C.wave * 2048); LAS float* hv = hk + 256;
    const int l = C.lane, gw = C.bid * NWAVES + C.wave, NGW = C.G * NWAVES;
    for (int r = gw; r < 16384; r += NGW) {
        const int bg = r >> 7, c = r & 127;
        { const v2u a = *((const v2u*)(Hk + (size_t)r * 256) + l), bq = *((const v2u*)(Hv + (size_t)r * 256) + l);
          hk[4 * l] = bflo(a.x); hk[4 * l + 1] = bfhi(a.x); hk[4 * l + 2] = bflo(a.y); hk[4 * l + 3] = bfhi(a.y);
          hv[4 * l] = bflo(bq.x); hv[4 * l + 1] = bfhi(bq.x); hv[4 * l + 2] = bflo(bq.y); hv[4 * l + 3] = bfhi(bq.y); }
        LDS_WAIT();
        float ak = 0.f, av = 0.f;
#pragma unroll 8
        for (int j = 0; j < 256; ++j) { ak += hk[j] * w2k[j * 64 + l]; av += hv[j] * w2v[j * 64 + l]; }
        if (c == 127) { ak = 0.f; av = 0.f; }
        const float rs = rsqrtf(wave_sum(ak * ak) * (1.f / 64.f) + EPS);
        ((bf16*)(ws + WS_KC))[((size_t)bg * 128 + 32 * (c >> 5)) * 64 + (l >> 5) * 1024 + (c & 31) * 32 + (l & 31)] = (bf16)f2bf(ak * rs * kn[l]);
        ((bf16*)(ws + WS_VCT))[(((size_t)bg * 4 + (c >> 5)) * 64 + l) * 32 + (c & 31)] = (bf16)f2bf(av);
        LDS_WAIT();
    }
}

typedef short bf16x8v __attribute__((ext_vector_type(8)));
#define MFMA16(a, b, c) __builtin_amdgcn_mfma_f32_16x16x32_bf16((a), (b), (c), 0, 0, 0)
constexpr float LOG2E = 1.4426950408889634f;
__device__ __forceinline__ float xmax_q4(float v) {
    float t;
    asm volatile("v_mov_b32 %1, %0\n\ts_nop 1\n\tv_permlane16_swap_b32 %0, %1\n\ts_nop 1\n\tv_max_f32 %0, %0, %1\n\tv_mov_b32 %1, %0\n\ts_nop 1\n\tv_permlane32_swap_b32 %0, %1\n\ts_nop 1\n\tv_max_f32 %0, %0, %1" : "+v"(v), "=&v"(t));
    return v;
}
__device__ __forceinline__ f32x4 att_mma(bf16x8v a, bf16x8v b, f32x4 c) { return __builtin_amdgcn_mfma_f32_16x16x32_bf16(a, b, c, 0, 0, 0); }
__device__ __forceinline__ f32x4 att_mma(long a, long b, f32x4 c) { return __builtin_amdgcn_mfma_f32_16x16x32_fp8_fp8(a, b, c, 0, 0, 0); }
__device__ __forceinline__ void att_pack(bf16x8v& pf, const float (&p)[8], bool keep) {
    unsigned w0 = pg8::cvt_pk_bf16(p[0], p[1]), w1 = pg8::cvt_pk_bf16(p[2], p[3]), w2 = pg8::cvt_pk_bf16(p[4], p[5]), w3 = pg8::cvt_pk_bf16(p[6], p[7]);
    if (!keep) { w0 = 0u; w1 = 0u; w2 = 0u; w3 = 0u; }
    const v4u w = {w0, w1, w2, w3}; pf = __builtin_bit_cast(bf16x8v, w); }
__device__ __forceinline__ void att_pack(long& pf, const float (&p)[8], bool keep) {
    unsigned w0 = pg8::pk4_fp8(p[0], p[1], p[2], p[3]), w1 = pg8::pk4_fp8(p[4], p[5], p[6], p[7]);
    if (!keep) { w0 = 0u; w1 = 0u; }
    const v2u w = {w0, w1}; pf = __builtin_bit_cast(long, w); }
template <class FR> struct AttKV { FR ka[2], kb[2], vf[4]; };
template <class FR, bool NOPV>
__device__ __forceinline__ void attn_kv_load(AttKV<FR>& f, const void* __restrict__ Kb, unsigned koff, const void* __restrict__ Vb, unsigned voff, int k0) {
    constexpr int SH = sizeof(FR) == 16 ? 0 : 1;
    const char* kblk = (const char*)Kb + (((size_t)k0 * 128) >> SH); const char* vblk = (const char*)Vb + (((size_t)k0 * 128) >> SH);
#pragma unroll
    for (int ks = 0; ks < 2; ++ks) { f.ka[ks] = *(const FR*)(kblk + koff + ((2048 * ks) >> SH)); f.kb[ks] = *(const FR*)(kblk + koff + ((256 + 2048 * ks) >> SH)); }
    if (!NOPV) {
#pragma unroll
        for (int dt = 0; dt < 4; ++dt) f.vf[dt] = *(const FR*)(vblk + voff + ((1024 * dt) >> SH)); }
}
template <int MODE, int PATH, class FR, bool NOPV = false>
__device__ __forceinline__ void attn_step(const AttKV<FR>& f, int k0, int trel, bool tk, int cmax,
                                          const FR (&qf)[2][2], const f32x4 (&bv)[2], float (&m)[2], float (&ls)[2], f32x4 (&o)[2][4], const float (&sl2)[2], int q4) {
    constexpr int DMUL = (MODE == 0) ? 16 : 1;
    const float trelf = (float)trel;
    bool ok[8];
    if (PATH == 2) {
#pragma unroll
        for (int i = 0; i < 8; ++i) { const int kk = 8 * q4 + i; const int d = trel - DMUL * kk; ok[i] = (MODE == 0) ? (k0 + kk <= cmax) : (MODE == 1 ? (tk && d >= 0) : (d >= 0 && d < 512)); } }
#pragma unroll
    for (int h = 0; h < 2; ++h) {
        f32x4 sa = att_mma(f.ka[0], qf[h][0], bv[0] * ((float)DMUL * sl2[h])), sb = att_mma(f.kb[0], qf[h][0], bv[1] * ((float)DMUL * sl2[h])); sa = att_mma(f.ka[1], qf[h][1], sa); sb = att_mma(f.kb[1], qf[h][1], sb);
        float mref = m[h] + sl2[h] * trelf;
        float mx;
        if (PATH == 2) { mx = -1e30f;
#pragma unroll
            for (int i = 0; i < 8; ++i) { const float v = i < 4 ? sa[i] : sb[i - 4]; mx = ok[i] ? fmaxf(mx, v) : mx; } }
        else { mx = fmaxf(fmaxf(fmaxf(sa[0], sa[1]), fmaxf(sa[2], sa[3])), fmaxf(fmaxf(sb[0], sb[1]), fmaxf(sb[2], sb[3]))); if (PATH == 1) mx = tk ? mx : -1e30f; }
        mx = xmax_q4(mx);
        if (__any(mx > mref + 8.f)) { const float mn = fmaxf(mref, mx), alpha = __builtin_amdgcn_exp2f(mref - mn); m[h] = mn - sl2[h] * trelf; mref = mn; ls[h] *= alpha;
            if (!NOPV) {
#pragma unroll
                for (int dt = 0; dt < 4; ++dt) o[h][dt] = o[h][dt] * alpha; } }
        float p[8]; float psum = 0.f;
#pragma unroll
        for (int i = 0; i < 8; ++i) { const float e = __builtin_amdgcn_exp2f((i < 4 ? sa[i] : sb[i - 4]) - mref); p[i] = (PATH == 2) ? (ok[i] ? e : 0.f) : e; psum += p[i]; }
        if (PATH == 1) psum = tk ? psum : 0.f;
        ls[h] += psum;
        FR pf; att_pack(pf, p, PATH == 1 ? tk : true);
        if (!NOPV) {
#pragma unroll
            for (int dt = 0; dt < 4; ++dt) o[h][dt] = att_mma(f.vf[dt], pf, o[h][dt]); }
    }
}
constexpr int PSW = 132;
__device__ __forceinline__ void p_attn_fast(Ctx& C, unsigned* queue, const int ld, const int qo, const float* qn) {
    unsigned char* ws = C.ws;
    const bf16* Qraw = (const bf16*)(ws + R_QKV);
    const bf16* KC = (const bf16*)(ws + WS_KC); const bf16* VCT = (const bf16*)(ws + WS_VCT);
    const unsigned char* KS = ws + R_KS; const unsigned char* VST = ws + R_VST; const unsigned char* KW = ws + R_KW; const unsigned char* VWT = ws + R_VWT;
    bf16* O = (bf16*)(ws + R_O);
    LAS float* psl = (LAS float*)(C.lds + C.wave * (16 * PSW * 4));
    int qsel = (int)(xb_xcc_id() & 7u), qtry = 0;
    for (;;) {
        int l = C.lane; asm volatile("" : "+v"(l));
        const int r16 = l & 15, q4 = l >> 4;
        const unsigned koff = (unsigned)((8 * (r16 >> 2) + (r16 & 3)) * 64 + 16 * q4), voff = (unsigned)((r16 * 32 + 8 * q4) * 2);
        unsigned u = 0; if (l == 0) u = __hip_atomic_fetch_add(queue + 64 * qsel, 1u, __ATOMIC_RELAXED, __HIP_MEMORY_SCOPE_AGENT);
        u = (unsigned)__builtin_amdgcn_readfirstlane((int)u);
        if (u >= 2048u) { if (++qtry >= 8) break; qsel = (qsel + 1) & 7; continue; }
        u = ((u >> 7) * 8 + (unsigned)qsel) * 128 + (u & 127);
        const int bg = (int)(u >> 7), tile = 127 - (int)(u & 127), g = bg & 3, b = bg >> 2, t0 = tile * 16, t = t0 + r16, row = b * SEQ + t;
#define qrow (Qraw + (size_t)row * ld + qo)
#define gtp (qrow + 1024 + g * 12)
#define orow (O + (size_t)row * DM + g * 256 + 4 * q4)
        bf16x8v qf[2][2]; long qf8[2][2]; float sl2[2]; f32x4 bv[2]; float m[2]; float ls[2]; f32x4 o[2][4];
#define ATT_LOADQ(hp, DM_) do { _Pragma("unroll") for (int i_ = 0; i_ < 4; ++i_) { bv[0][i_] = (float)(8 * q4 + i_); bv[1][i_] = (float)(8 * q4 + 4 + i_); } \
            _Pragma("unroll") for (int h = 0; h < 2; ++h) { sl2[h] = exp2f(-0.5f * (float)(g * 4 + 2 * (hp) + h + 1)) * LOG2E; \
            float xq_[2][8]; float ssq_ = 0.f; \
            _Pragma("unroll") for (int ks = 0; ks < 2; ++ks) { const v4u r_ = *(const v4u*)(qrow + (g * 4 + 2 * (hp) + h) * 64 + 32 * ks + 8 * q4); \
                xq_[ks][0] = bflo(r_.x); xq_[ks][1] = bfhi(r_.x); xq_[ks][2] = bflo(r_.y); xq_[ks][3] = bfhi(r_.y); xq_[ks][4] = bflo(r_.z); xq_[ks][5] = bfhi(r_.z); xq_[ks][6] = bflo(r_.w); xq_[ks][7] = bfhi(r_.w); \
                _Pragma("unroll") for (int j_ = 0; j_ < 8; ++j_) ssq_ += xq_[ks][j_] * xq_[ks][j_]; } \
            ssq_ += __shfl_xor(ssq_, 16); ssq_ += __shfl_xor(ssq_, 32); \
            const float rq_ = rsqrtf(ssq_ * (1.f / 64.f) + EPS) * (0.125f * LOG2E); \
            _Pragma("unroll") for (int ks = 0; ks < 2; ++ks) { const f32x4 ga_ = *(const f32x4*)(qn + 32 * ks + 8 * q4), gb_ = *(const f32x4*)(qn + 32 * ks + 8 * q4 + 4); \
                const v4u w_ = {pg8::cvt_pk_bf16(xq_[ks][0] * rq_ * ga_.x, xq_[ks][1] * rq_ * ga_.y), pg8::cvt_pk_bf16(xq_[ks][2] * rq_ * ga_.z, xq_[ks][3] * rq_ * ga_.w), \
                                pg8::cvt_pk_bf16(xq_[ks][4] * rq_ * gb_.x, xq_[ks][5] * rq_ * gb_.y), pg8::cvt_pk_bf16(xq_[ks][6] * rq_ * gb_.z, xq_[ks][7] * rq_ * gb_.w)}; \
                qf[h][ks] = __builtin_bit_cast(bf16x8v, w_); \
                const v2u w8_ = {pg8::pk4_fp8(xq_[ks][0] * rq_ * ga_.x, xq_[ks][1] * rq_ * ga_.y, xq_[ks][2] * rq_ * ga_.z, xq_[ks][3] * rq_ * ga_.w), pg8::pk4_fp8(xq_[ks][4] * rq_ * gb_.x, xq_[ks][5] * rq_ * gb_.y, xq_[ks][6] * rq_ * gb_.z, xq_[ks][7] * rq_ * gb_.w)}; \
                qf8[h][ks] = __builtin_bit_cast(long, w8_); } } } while (0)
#define ATT_RESET() do { _Pragma("unroll") for (int h = 0; h < 2; ++h) { m[h] = -1e30f; ls[h] = 0.f; _Pragma("unroll") for (int dt = 0; dt < 4; ++dt) o[h][dt] = (f32x4){0.f, 0.f, 0.f, 0.f}; } } while (0)
        const int cmax = t >= 31 ? (((t - 31) >> 4) < 126 ? ((t - 31) >> 4) : 126) : -1;
        const int cmax0 = t0 >= 31 ? (((t0 - 31) >> 4) < 126 ? ((t0 - 31) >> 4) : 126) : -1;
        const bf16* KCb = KC + (size_t)bg * 128 * 64; const bf16* VCb = VCT + (size_t)bg * 128 * 64;
        const int ncs = ((t0 + 15 - 31) >> 4) < 0 ? 0 : ((((t0 + 15 - 31) >> 4) < 126 ? ((t0 + 15 - 31) >> 4) : 126) >> 5) + 1;
#pragma unroll 1
        for (int hp = 0; hp < 2; ++hp) {
            ATT_LOADQ(hp, 16); ATT_RESET();
            for (int st = ncs - 1; st >= 0; --st) {
                AttKV<bf16x8v> fc; attn_kv_load<bf16x8v, true>(fc, KCb, koff, VCb, voff, 32 * st);
                if (32 * st + 31 <= cmax0) attn_step<0, 0, bf16x8v, true>(fc, 32 * st, t - 31 - 16 * 32 * st, true, cmax, qf, bv, m, ls, o, sl2, q4);
                else attn_step<0, 2, bf16x8v, true>(fc, 32 * st, t - 31 - 16 * 32 * st, true, cmax, qf, bv, m, ls, o, sl2, q4); }
#pragma unroll
            for (int h = 0; h < 2; ++h) { float lt = ls[h]; lt += __shfl_xor(lt, 16); lt += __shfl_xor(lt, 32); ls[h] = lt; }
            float ps[4][8];
#pragma unroll
            for (int st = 0; st < 4; ++st)
#pragma unroll
                for (int i = 0; i < 8; ++i) ps[st][i] = 0.f;
#pragma unroll
            for (int st = 0; st < 4; ++st) {
                if (st < ncs) {
                    const int k0 = 32 * st; const char* kblk = (const char*)(KCb + (size_t)k0 * 64);
                    bf16x8v ka[2], kb[2];
#pragma unroll
                    for (int ks = 0; ks < 2; ++ks) { ka[ks] = *(const bf16x8v*)(kblk + koff + 2048 * ks); kb[ks] = *(const bf16x8v*)(kblk + koff + 256 + 2048 * ks); }
#pragma unroll
                    for (int h = 0; h < 2; ++h) {
                        f32x4 sa = MFMA16(ka[0], qf[h][0], bv[0] * (16.f * sl2[h])), sb = MFMA16(kb[0], qf[h][0], bv[1] * (16.f * sl2[h])); sa = MFMA16(ka[1], qf[h][1], sa); sb = MFMA16(kb[1], qf[h][1], sb);
                        const float lt = ls[h], inv = lt > 0.f ? 1.f / lt : 0.f, mref = m[h] + sl2[h] * (float)(t - 31 - 16 * k0);
#pragma unroll
                        for (int i = 0; i < 8; ++i) { const int c = k0 + 8 * q4 + i; ps[st][i] += (c <= cmax) ? __builtin_amdgcn_exp2f((i < 4 ? sa[i] : sb[i - 4]) - mref) * inv : 0.f; }
                    }
                }
            }
#pragma unroll
            for (int st = 0; st < 4; ++st) { LAS f32x4* p0 = (LAS f32x4*)(psl + r16 * PSW + 32 * st + 8 * q4);
                f32x4 a = {ps[st][0], ps[st][1], ps[st][2], ps[st][3]}, bq = {ps[st][4], ps[st][5], ps[st][6], ps[st][7]};
                if (hp) { a = a + p0[0]; bq = bq + p0[1]; }
                p0[0] = a; p0[1] = bq; }
            LDS_WAIT();
        }
        unsigned mlo, mhi;
        {
            float sc[16]; const LAS float* pr = psl + r16 * PSW + 32 * q4; const int cur = t >> 5;
            float prev = q4 > 0 ? pr[-1] : 0.f;
#pragma unroll
            for (int jj = 0; jj < 16; ++jj) { const float a = pr[2 * jj], bq = pr[2 * jj + 1]; const float imp = prev + a + bq; prev = bq;
                const int j = 16 * q4 + jj; const bool valid = 32 * j <= t; const bool forced = valid && (j == 0 || j == cur || j == cur - 1);
                sc[jj] = forced ? 1e9f : (valid ? imp : -1e9f); }
            unsigned my = 0u;
#pragma unroll 1
            for (int r = 0; r < 8; ++r) {
                float best = sc[0]; int bi = 0;
#pragma unroll
                for (int jj = 1; jj < 16; ++jj) if (sc[jj] > best) { best = sc[jj]; bi = jj; }
                bi += 16 * q4;
#pragma unroll
                for (int sh = 16; sh <= 32; sh <<= 1) { const float ov = __shfl_xor(best, sh); const int oi = __shfl_xor(bi, sh); if (ov > best || (ov == best && oi < bi)) { best = ov; bi = oi; } }
                if ((bi >> 4) == q4) { const int jj0 = bi & 15; if (best > -0.5e9f) my |= 1u << jj0;
#pragma unroll
                    for (int jj = 0; jj < 16; ++jj) if (jj == jj0) sc[jj] = -INFINITY; }
            }
            mlo = (q4 == 0 ? my : 0u) | (q4 == 1 ? my << 16 : 0u); mhi = (q4 == 2 ? my : 0u) | (q4 == 3 ? my << 16 : 0u);
            mlo |= __shfl_xor(mlo, 16); mlo |= __shfl_xor(mlo, 32); mhi |= __shfl_xor(mhi, 16); mhi |= __shfl_xor(mhi, 32);
        }
        LDS_WAIT();
        unsigned ulo = mlo, uhi = mhi;
#pragma unroll
        for (int sh = 1; sh <= 8; sh <<= 1) { ulo |= __shfl_xor(ulo, sh); uhi |= __shfl_xor(uhi, sh); }
        const unsigned long long un0 = ((unsigned long long)(unsigned)__builtin_amdgcn_readfirstlane((int)uhi) << 32) | (unsigned)__builtin_amdgcn_readfirstlane((int)ulo);
        const unsigned long long mine = ((unsigned long long)mhi << 32) | mlo;
#pragma unroll 1
        for (int hp = 0; hp < 2; ++hp) {
            const v2u g6raw = *(const v2u*)(gtp + 6 * hp); const unsigned g6x = gtp[6 * hp + 4], g6y = gtp[6 * hp + 5];
            v2u oacc[2][4];
#define ATT_GLOG(i) ((i) == 0 ? bflo(g6raw.x) : (i) == 1 ? bfhi(g6raw.x) : (i) == 2 ? bflo(g6raw.y) : (i) == 3 ? bfhi(g6raw.y) : (i) == 4 ? bf2f(g6x) : bf2f(g6y))
#define ATT_FOLD(br, first) do { _Pragma("unroll") for (int h = 0; h < 2; ++h) { float lt = ls[h]; lt += __shfl_xor(lt, 16); lt += __shfl_xor(lt, 32); const float sc_ = lt > 0.f ? (1.f / (1.f + __expf(-ATT_GLOG(h * 3 + (br))))) / lt : 0.f; \
            _Pragma("unroll") for (int dt = 0; dt < 4; ++dt) { f32x4 r_ = o[h][dt] * sc_; \
                if (!(first)) { r_[0] += bflo(oacc[h][dt].x); r_[1] += bfhi(oacc[h][dt].x); r_[2] += bflo(oacc[h][dt].y); r_[3] += bfhi(oacc[h][dt].y); } \
                oacc[h][dt].x = pg8::cvt_pk_bf16(r_[0], r_[1]); oacc[h][dt].y = pg8::cvt_pk_bf16(r_[2], r_[3]); } } } while (0)
            ATT_LOADQ(hp, 16); ATT_RESET();
            for (int st = ncs - 1; st >= 0; --st) {
                AttKV<bf16x8v> fc; attn_kv_load<bf16x8v, false>(fc, KCb, koff, VCb, voff, 32 * st);
                if (32 * st + 31 <= cmax0) attn_step<0, 0, bf16x8v>(fc, 32 * st, t - 31 - 16 * 32 * st, true, cmax, qf, bv, m, ls, o, sl2, q4);
                else attn_step<0, 2, bf16x8v>(fc, 32 * st, t - 31 - 16 * 32 * st, true, cmax, qf, bv, m, ls, o, sl2, q4); }
            ATT_FOLD(0, true);
            {
                const unsigned char* Kb = KS + (size_t)bg * SEQ * 64; const unsigned char* Vb = VST + (size_t)bg * SEQ * 64;
                ATT_RESET();
                unsigned long long un = un0;
                const int cur0 = t0 >> 5;
                AttKV<long> fn; int jn = 63 - __builtin_clzll(un); un &= ~(1ull << jn); attn_kv_load<long, false>(fn, Kb, koff >> 1, Vb, voff >> 1, 32 * jn);
#pragma unroll 1
                for (;;) { const int j = jn; const AttKV<long> fc = fn; const bool more = un != 0ull;
                    if (more) { jn = 63 - __builtin_clzll(un); un &= ~(1ull << jn); }
                    attn_kv_load<long, false>(fn, Kb, koff >> 1, Vb, voff >> 1, 32 * jn);
                    const bool tk = ((mine >> j) & 1ull) != 0ull;
                    if (j >= cur0) attn_step<1, 2, long>(fc, 32 * j, t - 32 * j, tk, 0, qf8, bv, m, ls, o, sl2, q4);
                    else if (__all(tk)) attn_step<1, 0, long>(fc, 32 * j, t - 32 * j, true, 0, qf8, bv, m, ls, o, sl2, q4);
                    else attn_step<1, 1, long>(fc, 32 * j, t - 32 * j, tk, 0, qf8, bv, m, ls, o, sl2, q4);
                    if (!more) break; }
                ATT_FOLD(1, false);
            }
            {
                const unsigned char* Kb = KW + (size_t)bg * SEQ * 64; const unsigned char* Vb = VWT + (size_t)bg * SEQ * 64;
                const int sb = t0 >= 511 ? (t0 - 511) >> 5 : 0, se = t0 >> 5;
                ATT_RESET();
                AttKV<long> fn; attn_kv_load<long, false>(fn, Kb, koff >> 1, Vb, voff >> 1, 32 * se);
#pragma unroll 1
                for (int st = se; st >= sb; --st) { const AttKV<long> fc = fn;
                    attn_kv_load<long, false>(fn, Kb, koff >> 1, Vb, voff >> 1, 32 * (st > sb ? st - 1 : st));
                    if (32 * st + 31 <= t0 && 32 * st > t0 - 497) attn_step<2, 0, long>(fc, 32 * st, t - 32 * st, true, 0, qf8, bv, m, ls, o, sl2, q4);
                    else attn_step<2, 2, long>(fc, 32 * st, t - 32 * st, true, 0, qf8, bv, m, ls, o, sl2, q4); }
                ATT_FOLD(2, false);
            }
#pragma unroll
            for (int h = 0; h < 2; ++h)
#pragma unroll
                for (int dt = 0; dt < 4; ++dt) *(v2u*)(orow + (2 * hp + h) * 64 + 16 * dt) = oacc[h][dt];
        }
#undef ATT_FOLD
#undef ATT_GLOG
#undef ATT_LOADQ
#undef ATT_RESET
#undef qrow
#undef gtp
#undef orow
    }
}

constexpr int SCQ = 272, SCT = 144;
constexpr int LQ_ = 0, LK_ = 17408, LKT_ = 34816, LVT_ = 53248, LP_ = 71680, LO_ = 80896, LE_ = 114688, LT_ = 115712;
__device__ __forceinline__ void p_scan_fast(Ctx& C, int layer) {
    unsigned char* ws = C.ws;
    const bf16* Pq = (const bf16*)(ws + R_PQ); const bf16* Pi = (const bf16*)(ws + R_PI); const bf16* Pg = (const bf16*)(ws + R_PG); const float* LF = (const float*)(ws + R_LF);
    bf16* O2 = (bf16*)(ws + R_O2);
    const float* gn = C.inp(I_HGN) + layer * 128;
    LAS unsigned char* L = C.lds;
    const int tid = C.tid, lane = C.lane, w = C.wave, r16 = lane & 15, q4 = lane >> 4, k = tid & 127, seg = tid >> 7;
    LAS float* tot = (LAS float*)(L + LT_); LAS float* eref = (LAS float*)(L + LE_); LAS float* elr = eref + 128;
    { const int tile = tid >> 8, e = tid & 255, row = e >> 4, col = e & 15;
      *(LAS bf16*)(L + LP_ + ((tile ? 32 : 0) + row) * SCT + ((tile ? 48 : 16) + col) * 2) = 0; }
    for (int bh = C.bid; bh < 256; bh += C.G) {
        const int b = bh >> 3, h = bh & 7;
        const size_t base = (size_t)(b * SEQ) * DM + h * 128;
        f32x4 S[8];
#pragma unroll
        for (int i = 0; i < 8; ++i) S[i] = (f32x4){0.f, 0.f, 0.f, 0.f};
        bf16 qv[16], vv[16]; float lf[16];
#define SC_LOAD(t0) do { _Pragma("unroll") for (int i = 0; i < 16; ++i) { const size_t off = base + (size_t)((t0) + 16 * seg + i) * DM + k; qv[i] = Pq[off]; vv[i] = Pi[off]; lf[i] = LF[off]; } } while (0)
        SC_LOAD(0);
#pragma unroll 1
        for (int c = 0; c < SEQ / 64; ++c) {
            const int t0 = c * 64;
            float cs[16]; { float run = 0.f;
#pragma unroll
                for (int i = 0; i < 16; ++i) { run += lf[i]; cs[i] = run; }
                tot[seg * 128 + k] = run; }
            __syncthreads();
            { const float a0 = tot[k], a1 = tot[128 + k], a2 = tot[256 + k], a3 = tot[384 + k];
              const float off = seg == 0 ? 0.f : (seg == 1 ? a0 : (seg == 2 ? a0 + a1 : a0 + a1 + a2)), ref = a0 + a1, last = ref + a2 + a3;
              unsigned kt[16];
#pragma unroll
              for (int i = 0; i < 16; ++i) { const float d = off + cs[i] - ref; const float qt = bf2f(qv[i]) * __expf(fminf(d, 80.f)), ktv = (1.f - __expf(lf[i])) * __expf(fminf(-d, 80.f));
                  const int s = 16 * seg + i; kt[i] = f2bf(ktv);
                  *(LAS bf16*)(L + LQ_ + s * SCQ + k * 2) = (bf16)f2bf(qt); *(LAS bf16*)(L + LK_ + s * SCQ + k * 2) = (bf16)kt[i]; }
              v4u w0, w1, x0, x1;
              w0.x = kt[0] | (kt[1] << 16); w0.y = kt[2] | (kt[3] << 16); w0.z = kt[4] | (kt[5] << 16); w0.w = kt[6] | (kt[7] << 16);
              w1.x = kt[8] | (kt[9] << 16); w1.y = kt[10] | (kt[11] << 16); w1.z = kt[12] | (kt[13] << 16); w1.w = kt[14] | (kt[15] << 16);
              x0.x = vv[0] | ((unsigned)vv[1] << 16); x0.y = vv[2] | ((unsigned)vv[3] << 16); x0.z = vv[4] | ((unsigned)vv[5] << 16); x0.w = vv[6] | ((unsigned)vv[7] << 16);
              x1.x = vv[8] | ((unsigned)vv[9] << 16); x1.y = vv[10] | ((unsigned)vv[11] << 16); x1.z = vv[12] | ((unsigned)vv[13] << 16); x1.w = vv[14] | ((unsigned)vv[15] << 16);
              *(LAS v4u*)(L + LKT_ + k * SCT + seg * 32) = w0; *(LAS v4u*)(L + LKT_ + k * SCT + seg * 32 + 16) = w1;
              *(LAS v4u*)(L + LVT_ + k * SCT + seg * 32) = x0; *(LAS v4u*)(L + LVT_ + k * SCT + seg * 32 + 16) = x1;
              if (seg == 0) { eref[k] = __expf(ref); elr[k] = __expf(last - ref); } }
            __syncthreads();
            if (c + 1 < SEQ / 64) SC_LOAD(t0 + 64);
#pragma unroll 1
            for (int ti = w; ti < 10; ti += 8) {
                const int rt = ti < 1 ? 0 : (ti < 3 ? 1 : (ti < 6 ? 2 : 3)), ct = ti - (rt * (rt + 1)) / 2;
                f32x4 acc = {0.f, 0.f, 0.f, 0.f};
#pragma unroll
                for (int p = 0; p < 4; ++p) { const bf16x8v a = *(const LAS bf16x8v*)(L + LQ_ + (16 * rt + r16) * SCQ + (32 * p + 8 * q4) * 2), bq = *(const LAS bf16x8v*)(L + LK_ + (16 * ct + r16) * SCQ + (32 * p + 8 * q4) * 2);
                    acc = MFMA16(a, bq, acc); }
#pragma unroll
                for (int i = 0; i < 4; ++i) { const int t = 16 * rt + 4 * q4 + i, s = 16 * ct + r16; *(LAS bf16*)(L + LP_ + t * SCT + s * 2) = (bf16)f2bf(s <= t ? acc[i] : 0.f); }
            }
            __syncthreads();
            bf16x8v sfrag[4]; f32x4 e8[4][2];
#pragma unroll
            for (int p = 0; p < 4; ++p) { e8[p][0] = *(const LAS f32x4*)(eref + 32 * p + 8 * q4); e8[p][1] = *(const LAS f32x4*)(eref + 32 * p + 8 * q4 + 4);
                S[2 * p] = S[2 * p] * e8[p][0]; S[2 * p + 1] = S[2 * p + 1] * e8[p][1];
                const v4u wv = {pg8::cvt_pk_bf16(S[2 * p][0], S[2 * p][1]), pg8::cvt_pk_bf16(S[2 * p][2], S[2 * p][3]), pg8::cvt_pk_bf16(S[2 * p + 1][0], S[2 * p + 1][1]), pg8::cvt_pk_bf16(S[2 * p + 1][2], S[2 * p + 1][3])};
                sfrag[p] = __builtin_bit_cast(bf16x8v, wv); }
            bf16x8v vfr[2];
#pragma unroll
            for (int ss = 0; ss < 2; ++ss) vfr[ss] = *(const LAS bf16x8v*)(L + LVT_ + (16 * w + r16) * SCT + (32 * ss + 8 * q4) * 2);
#pragma unroll
            for (int rt = 0; rt < 4; ++rt) { f32x4 o = {0.f, 0.f, 0.f, 0.f};
#pragma unroll
                for (int p = 0; p < 4; ++p) { const bf16x8v a = *(const LAS bf16x8v*)(L + LQ_ + (16 * rt + r16) * SCQ + (32 * p + 8 * q4) * 2); o = MFMA16(a, sfrag[p], o); }
#pragma unroll
                for (int ss = 0; ss < 2; ++ss) if (ss <= rt / 2) { const bf16x8v a = *(const LAS bf16x8v*)(L + LP_ + (16 * rt + r16) * SCT + (32 * ss + 8 * q4) * 2); o = MFMA16(a, vfr[ss], o); }
#pragma unroll
                for (int i = 0; i < 4; ++i) *(LAS float*)(L + LO_ + (16 * rt + 4 * q4 + i) * 528 + (16 * w + r16) * 4) = o[i]; }
#pragma unroll
            for (int p = 0; p < 4; ++p)
#pragma unroll
                for (int ab = 0; ab < 2; ++ab) { const int krow = 32 * p + 8 * (r16 >> 2) + (r16 & 3) + 4 * ab;
#pragma unroll
                    for (int ss = 0; ss < 2; ++ss) { const bf16x8v a = *(const LAS bf16x8v*)(L + LKT_ + krow * SCT + (32 * ss + 8 * q4) * 2); S[2 * p + ab] = MFMA16(a, vfr[ss], S[2 * p + ab]); } }
#pragma unroll
            for (int p = 0; p < 4; ++p) { const f32x4 l0 = *(const LAS f32x4*)(elr + 32 * p + 8 * q4), l1 = *(const LAS f32x4*)(elr + 32 * p + 8 * q4 + 4); S[2 * p] = S[2 * p] * l0; S[2 * p + 1] = S[2 * p + 1] * l1; }
            __syncthreads();
#pragma unroll
            for (int rep = 0; rep < 2; ++rep) { const int tok = (tid >> 4) + 32 * rep, part = tid & 15;
                const f32x4 oa = *(const LAS f32x4*)(L + LO_ + tok * 528 + part * 32), ob = *(const LAS f32x4*)(L + LO_ + tok * 528 + part * 32 + 16);
                float ss = (oa.x * oa.x + oa.y * oa.y) + (oa.z * oa.z + oa.w * oa.w) + (ob.x * ob.x + ob.y * ob.y) + (ob.z * ob.z + ob.w * ob.w);
                ss += __shfl_xor(ss, 1); ss += __shfl_xor(ss, 2); ss += __shfl_xor(ss, 4); ss += __shfl_xor(ss, 8);
                const float rstd = rsqrtf(ss * (1.f / 128.f) + EPS);
                const size_t off = base + (size_t)(t0 + tok) * DM + part * 8; const v4u g8 = *(const v4u*)(Pg + off);
                const f32x4 ga = *(const f32x4*)(gn + part * 8), gb = *(const f32x4*)(gn + part * 8 + 4);
                v4u wv; wv.x = pk2(oa.x * rstd * ga.x * bflo(g8.x), oa.y * rstd * ga.y * bfhi(g8.x)); wv.y = pk2(oa.z * rstd * ga.z * bflo(g8.y), oa.w * rstd * ga.w * bfhi(g8.y));
                wv.z = pk2(ob.x * rstd * gb.x * bflo(g8.z), ob.y * rstd * gb.y * bfhi(g8.z)); wv.w = pk2(ob.z * rstd * gb.z * bflo(g8.w), ob.w * rstd * gb.w * bfhi(g8.w));
                *(v4u*)(O2 + off) = wv; }
        }
#undef SC_LOAD
        __syncthreads();
    }
}

#define PH_BEGIN { const bool run_ = (pid >= lo && pid < hi); ++pid; if (run_) { { int ln_; asm volatile("v_mbcnt_lo_u32_b32 %0, -1, 0\n\tv_mbcnt_hi_u32_b32 %0, -1, %0" : "=v"(ln_)); C.lane = ln_; C.tid = C.wave * 64 + ln_; }
#define PH_END   if (pid < hi) xcd_barrier(bar); } }
#define XN ((const bf16*)(ws + WS_XN))
#define RTAB ((const int*)(ws + WS_RTAB))

template <int L>
__device__ __forceinline__ void run_layer(Ctx& C, const XcdBarrier& bar, int& pid, const int lo, const int hi, PG8_LAS unsigned char* ring) {
    unsigned char* const ws = C.ws;

        const int li = L >> 1;
        if (L < 2) {
            PH_BEGIN { pg8::Gemm g{XN, (const bf16*)(ws + W_HIN) + (size_t)L * 4096 * 1024, 1024, 1024, 0}; pg8::GenOrder S; S.init(256, 16, C.G, C.bid, nullptr);
                pg8::EpiHgrnIn E{ws, L};
                pg8::gemm_phase<pg8::EpiHgrnIn, pg8::GenOrder, true, true>(ring, g, S, E, C.wave); } PH_END
            PH_BEGIN p_scan_fast(C, L); PH_END
        } else {
            PH_BEGIN { const bool first = (L == 2); pg8::Gemm g{XN, (const bf16*)(ws + (first ? W_KVQ : W_Q3)), 1024, 1024, 0}; pg8::GenOrder S; S.init(256, first ? 11 : 5, C.G, C.bid, nullptr);
                pg8::EpiBf16 E{(bf16*)(ws + R_QKV), first ? 2816 : 1280, nullptr, 0, 0, 1.f};
                pg8::gemm_phase<pg8::EpiBf16, pg8::GenOrder, true, true>(ring, g, S, E, C.wave); } PH_END
            if (L == 2) {
                PH_BEGIN p_post_kv(C); PH_END
                PH_BEGIN { pg8::Gemm g{(const bf16*)(ws + R_KCR), (const bf16*)(ws + W_CMP1), 2048, 1024, (size_t)256 * 2048 * 2}; pg8::GenOrder S; S.init(128, 1, C.G, C.bid, RTAB + 2048);
                    pg8::EpiBf16 E{(bf16*)(ws + WS_HC), 256, (const float*)(ws + WS_CB), 1, 256, 1.f};
                    pg8::gemm_phase<pg8::EpiBf16, pg8::GenOrder, true, true>(ring, g, S, E, C.wave); } PH_END
                PH_BEGIN p_cmp2(C); PH_END
            }
            PH_BEGIN p_attn_fast(C, (unsigned*)(ws + WS_CTL) + 8192 + 2048 * (L - 2), L == 2 ? 2816 : 1280, L == 2 ? 1536 : 0, C.inp(I_NQN) + (L - 2) * 64); PH_END
        }
        PH_BEGIN { pg8::Gemm g{(const bf16*)(ws + (L < 2 ? R_O2 : R_O)), (const bf16*)(ws + (L < 2 ? W_HOUT : W_NOUT)) + (size_t)(L & 1) * 1024 * 1024, 1024, 1024, 0};
            pg8::GenOrder S; S.init(256, 4, C.G, C.bid, nullptr);
            pg8::EpiRes E{L == 0 ? C.inp(I_X) : C.out, C.out, 1024, 1.f};
            pg8::gemm_phase<pg8::EpiRes, pg8::GenOrder, true, true>(ring, g, S, E, C.wave); } PH_END
        PH_BEGIN { if (L & 1) p_norm<false, true, true, true>(C, C.inp(I_MR) + (size_t)li * 1024 * 8, C.inp(I_NFFN) + L * 1024); else if (L == 2) p_norm<false, false, true, true>(C, nullptr, nullptr); else p_norm<false, false, true, false>(C, nullptr, nullptr); } PH_END
        if (L & 1) { PH_BEGIN p_gather(C); PH_END }
        if (L == 0) {
            PH_BEGIN { pg8::Gemm g{XN, (const bf16*)(ws + W_FGU), 1024, 1024, 0};
                pg8::GenOrder S; S.init(256, 22, C.G, C.bid, nullptr);
                pg8::EpiSwiGLU E{(bf16*)(ws + R_HF), DFF};
                pg8::gemm_phase<pg8::EpiSwiGLU, pg8::GenOrder, true, true>(ring, g, S, E, C.wave); } PH_END
            PH_BEGIN { pg8::Gemm g{(const bf16*)(ws + R_HF), (const bf16*)(ws + W_FDN), DFF, DFF, 0}; pg8::GenOrder S; S.init(256, 4, C.G, C.bid, nullptr);
                pg8::EpiRes E{C.out, C.out, 1024, 1.f};
                pg8::gemm_phase<pg8::EpiRes, pg8::GenOrder, true, true>(ring, g, S, E, C.wave); } PH_END
            PH_BEGIN p_norm<false, false, true>(C, nullptr, nullptr); PH_END
        } else {
        PH_BEGIN { const bool moe = (L & 1) != 0;
            pg8::Gemm g{(const bf16*)(ws + (moe ? R_XP : WS_XN)), (const bf16*)(ws + (moe ? W_MGU + (size_t)li * 8 * 2 * DFE * 1024 : W_FGU + (size_t)li * 2 * DFF * 2048)), 512, 512, moe ? (size_t)2 * DFE * 1024 : 0};
            pg8::GenOrder S; S.init(moe ? RTAB[1024] : 256, moe ? 28 : 22, C.G, C.bid, moe ? RTAB : nullptr);
            pg8::EpiSwiGLU8 E{ws + (moe ? R_HM : R_HF), moe ? DFE : DFF};
            pg8::gemm_phase<pg8::EpiSwiGLU8, pg8::GenOrder, true, true, true>(ring, g, S, E, C.wave); } PH_END
        if (!(L & 1)) {
            PH_BEGIN { pg8::Gemm g{(const bf16*)(ws + R_HF), (const bf16*)(ws + W_FDN + (size_t)li * 1024 * DFF * 2), DFF / 2, DFF / 2, 0}; pg8::GenOrder S; S.init(256, 4, C.G, C.bid, nullptr);
                pg8::EpiRes E{C.out, C.out, 1024, 1.f / (pg8::FP8_SH * pg8::FP8_SW2)};
                pg8::gemm_phase<pg8::EpiRes, pg8::GenOrder, true, true, true>(ring, g, S, E, C.wave); } PH_END
            PH_BEGIN p_norm<false, false, true>(C, nullptr, nullptr); PH_END
        } else {
            PH_BEGIN { pg8::Gemm g{(const bf16*)(ws + R_HM), (const bf16*)(ws + W_MDN + (size_t)li * 8 * 1024 * DFE), DFE / 2, DFE / 2, (size_t)1024 * DFE}; pg8::GenOrder S; S.init(RTAB[1024], 4, C.G, C.bid, RTAB);
                pg8::EpiBf16 E{(bf16*)(ws + R_XP), 1024, nullptr, 0, 0, 1.f / (pg8::FP8_SH * pg8::FP8_SW2)};
                pg8::gemm_phase<pg8::EpiBf16, pg8::GenOrder, true, true, true>(ring, g, S, E, C.wave); } PH_END
            PH_BEGIN { if (L == 1) p_norm<true, false, true>(C, nullptr, nullptr); else p_norm<true, false, false>(C, nullptr, nullptr); } PH_END
        }
        }
    }

struct Args { const float* in[24]; float* out; unsigned char* ws; int ph_lo, ph_hi; };
constexpr int N_PHASES = 34;

__global__ void __launch_bounds__(NWAVES * 64, 2) yoco_fwd(Args args) {
    extern __shared__ __attribute__((aligned(16))) unsigned char lds_raw[];
    Ctx C;
    C.lds = (LAS unsigned char*)lds_raw;
    C.wave = __builtin_amdgcn_readfirstlane((int)(threadIdx.x >> 6)); C.tid = threadIdx.x; C.lane = C.tid & 63;
    C.G = gridDim.x; C.bid = blockIdx.x;
    C.out = args.out; C.ws = args.ws;
    unsigned char* const ws = args.ws;
    volatile LAS unsigned* MISC = (volatile LAS unsigned*)(C.lds + MISC_OFF);
    if (C.tid < 32) MISC[C.tid] = 0u;
    __syncthreads();
    XcdBarrier bar = xcd_barrier_post((unsigned*)(ws + WS_CTL) + 4096, MISC + 8);
    const int lo = args.ph_lo, hi = args.ph_hi;
    int pid = 0;
    PG8_LAS unsigned char* ring = (PG8_LAS unsigned char*)lds_raw;
    PH_BEGIN p_prologue(C); PH_END

    run_layer<0>(C, bar, pid, lo, hi, ring); run_layer<1>(C, bar, pid, lo, hi, ring); run_layer<2>(C, bar, pid, lo, hi, ring); run_layer<3>(C, bar, pid, lo, hi, ring);
#undef PH_BEGIN
#undef PH_END
#undef XN
#undef RTAB
}

extern "C" void kernel_launch(void* const* d_in, const int* in_sizes, int n_in, void* d_out, int out_size, void* d_ws, size_t ws_size, hipStream_t stream) {
    static int grid = 0;
    if (grid == 0) {
        if (n_in != 24 || in_sizes[0] != NT * DM || out_size != NT * DM || ws_size < WS_NEED) { fprintf(stderr, "kernel_launch: unexpected shapes / workspace (n_in %d, ws %zu, need %zu)\n", n_in, ws_size, (size_t)WS_NEED); grid = -1; return; }
        int dev = 0, cus = 0;
        if (hipGetDevice(&dev) != hipSuccess || hipDeviceGetAttribute(&cus, hipDeviceAttributeMultiprocessorCount, dev) != hipSuccess) { grid = -1; return; }
        if (hipFuncSetAttribute((const void*)yoco_fwd, hipFuncAttributeMaxDynamicSharedMemorySize, LDS_BYTES) != hipSuccess) { fprintf(stderr, "kernel_launch: hipFuncSetAttribute failed\n"); grid = -1; return; }
        int per_cu = 0;
        if (hipOccupancyMaxActiveBlocksPerMultiprocessor(&per_cu, (const void*)yoco_fwd, NWAVES * 64, LDS_BYTES) != hipSuccess || per_cu < 1) { fprintf(stderr, "kernel_launch: occupancy query says %d\n", per_cu); }
        (void)hipGetLastError();
        grid = cus;
    }
    if (grid < 0) return;
    (void)hipMemsetAsync((char*)d_ws + WS_CTL, 0, CTL_ZERO_BYTES, stream);
    Args a{};
    for (int i = 0; i < 24; ++i) a.in[i] = (const float*)d_in[i];
    a.out = (float*)d_out; a.ws = (unsigned char*)d_ws;
#if MK_SINGLE
    a.ph_lo = 0; a.ph_hi = PROBE_DUP ? 1000 : N_PHASES;
    hipLaunchKernelGGL(yoco_fwd, dim3(grid), dim3(NWAVES * 64), LDS_BYTES, stream, a);
#else
    for (int k = 0; k < N_PHASES; ++k) { a.ph_lo = k; a.ph_hi = k + 1; hipLaunchKernelGGL(yoco_fwd, dim3(grid), dim3(NWAVES * 64), LDS_BYTES, stream, a); }
#endif
}
```

```cpp
#include <hip/hip_runtime.h>
#include <cstdio>
#include <cstdint>

#ifndef MK_SINGLE
#define MK_SINGLE 1
#endif

namespace pg8 {
#define PG8_LAS __attribute__((address_space(3)))
typedef unsigned short bf16_t;
typedef short bf16x8 __attribute__((ext_vector_type(8)));
typedef float f32x4 __attribute__((ext_vector_type(4)));
typedef unsigned u32x4 __attribute__((ext_vector_type(4)));
constexpr int BM = 256, BK = 64, HALF = 128, HTB = HALF * BK * 2  , STAGE_BYTES = 8 * HTB, NXCD = 8, WGM = 8;

__host__ __device__ __forceinline__ int lds_byte(int r, int c) { const int st = (r >> 4) * 2 + (c >> 5), rr = r & 15, cc = c & 31, ob = rr * 64 + cc * 2; return st * 1024 + (ob ^ (((ob >> 9) & 1) << 5)); }
__host__ __device__ __forceinline__ void stage_rc(int b, int& R, int& C) { const int st = b / 1024, sb = b % 1024, swz = sb ^ (((sb >> 9) & 1) << 5); R = (st >> 1) * 16 + swz / 64; C = (st & 1) * 32 + (swz % 64) / 2; }
__host__ __device__ __forceinline__ int perm32(int rho) { const int n = rho >> 4, i = rho & 15; return 8 * (i >> 2) + 4 * n + (i & 3); }

struct Unit { int pm, pn, e; };
struct Gemm { const bf16_t* A; const bf16_t* Bt; int K; int lda; size_t estride; };

struct GenOrder {
    int nM, nN, nwg, G, c; const int* tile_e;
    __device__ void init(int nM_, int nN_, int G_, int c_, const int* te) { nM = nM_; nN = nN_; nwg = nM * nN; G = G_; c = c_; tile_e = te; }
    __device__ bool next(int i, Unit& u) const {
        const long L = (long)i * G + c; if (L >= nwg) return false;
        int wgid = (int)L; { const int q = nwg / NXCD, r = nwg % NXCD, xcd = wgid % NXCD, off = wgid / NXCD; wgid = (xcd < r ? xcd * (q + 1) : r * (q + 1) + (xcd - r) * q) + off; }
        const int nig = WGM * nN, gid = wgid / nig, fm = gid * WGM, gsz = (nM - fm) < WGM ? (nM - fm) : WGM;
        u.pm = fm + ((wgid % nig) % gsz); u.pn = (wgid % nig) / gsz; u.e = tile_e ? tile_e[u.pm] : 0; return true;
    }
    __device__ __forceinline__ void a_ready(const Unit&) const {}
    __device__ __forceinline__ void done(const Unit&) const {}
};

__device__ __forceinline__ unsigned cvt_pk_bf16(float lo, float hi) { unsigned r; asm volatile("v_cvt_pk_bf16_f32 %0, %1, %2" : "=v"(r) : "v"(lo), "v"(hi)); return r; }
__device__ __forceinline__ float silu_f(float v) { return v * __builtin_amdgcn_rcpf(1.0f + __expf(-v)); }
__device__ __forceinline__ float clamp448(float v) { return __builtin_amdgcn_fmed3f(v, -448.f, 448.f); }
__device__ __forceinline__ unsigned pk4_fp8(float a, float b, float c, float d) {
    int w = __builtin_amdgcn_cvt_pk_fp8_f32(clamp448(a), clamp448(b), 0, false); w = __builtin_amdgcn_cvt_pk_fp8_f32(clamp448(c), clamp448(d), w, true); return (unsigned)w; }
constexpr float FP8_SW1 = 32.f, FP8_SW2 = 64.f, FP8_SH = 8.f;

struct EpiBf16 {
    static constexpr bool PERM = true, AFTER_DRAIN = false;
    bf16_t* O; int ldc; const float* bias; int act; int bias_es; float oscale;
    __device__ __forceinline__ void operator()(const f32x4 (&acc)[2][2][4][2], const Unit& u, int wr, int wc, int fr, int fq) const {
        const int row0 = u.pm * BM + wr * 64 + fr, col0 = u.pn * BM + wc * 32 + 8 * fq;
        f32x4 bv[2][2];
#pragma unroll
        for (int bj = 0; bj < 2; ++bj)
#pragma unroll
            for (int n = 0; n < 2; ++n) bv[bj][n] = bias ? *(const f32x4*)(bias + u.e * bias_es + col0 + bj * HALF + 4 * n) : (f32x4){0.f, 0.f, 0.f, 0.f};
#pragma unroll
        for (int ai = 0; ai < 2; ++ai)
#pragma unroll
            for (int m = 0; m < 4; ++m) { bf16_t* rowp = O + (size_t)(row0 + ai * HALF + m * 16) * ldc + col0;
#pragma unroll
                for (int bj = 0; bj < 2; ++bj) { f32x4 v0 = acc[ai][bj][m][0] * oscale + bv[bj][0], v1 = acc[ai][bj][m][1] * oscale + bv[bj][1];
                    if (act == 1) {
#pragma unroll
                        for (int i = 0; i < 4; ++i) { v0[i] = silu_f(v0[i]); v1[i] = silu_f(v1[i]); } }
                    u32x4 w; w.x = cvt_pk_bf16(v0[0], v0[1]); w.y = cvt_pk_bf16(v0[2], v0[3]); w.z = cvt_pk_bf16(v1[0], v1[1]); w.w = cvt_pk_bf16(v1[2], v1[3]);
                    *(u32x4*)(rowp + bj * HALF) = w; } }
    }
};
struct EpiRes {
    static constexpr bool PERM = false, AFTER_DRAIN = false;
    const float* base; float* out; int ldc; float oscale;
    __device__ __forceinline__ void operator()(const f32x4 (&acc)[2][2][4][2], const Unit& u, int wr, int wc, int fr, int fq) const {
        const int row0 = u.pm * BM + wr * 64 + fr, col0 = u.pn * BM + wc * 32 + 4 * fq;
#pragma unroll
        for (int ai = 0; ai < 2; ++ai)
#pragma unroll
            for (int m = 0; m < 4; ++m) { const size_t off = (size_t)(row0 + ai * HALF + m * 16) * ldc + col0;
#pragma unroll
                for (int bj = 0; bj < 2; ++bj)
#pragma unroll
                    for (int n = 0; n < 2; ++n) { const f32x4 b = *(const f32x4*)(base + off + bj * HALF + n * 16); *(f32x4*)(out + off + bj * HALF + n * 16) = b + acc[ai][bj][m][n] * oscale; } }
    }
};
struct EpiSwiGLU {
    static constexpr bool PERM = true, AFTER_DRAIN = false;
    bf16_t* O; int ldc;
    __device__ __forceinline__ void operator()(const f32x4 (&acc)[2][2][4][2], const Unit& u, int wr, int wc, int fr, int fq) const {
        const int row0 = u.pm * BM + wr * 64 + fr, col0 = u.pn * HALF + wc * 32 + 8 * fq;
#pragma unroll
        for (int ai = 0; ai < 2; ++ai)
#pragma unroll
            for (int m = 0; m < 4; ++m) { bf16_t* rowp = O + (size_t)(row0 + ai * HALF + m * 16) * ldc + col0;
                f32x4 v0, v1;
#pragma unroll
                for (int i = 0; i < 4; ++i) { v0[i] = silu_f(acc[ai][0][m][0][i]) * acc[ai][1][m][0][i]; v1[i] = silu_f(acc[ai][0][m][1][i]) * acc[ai][1][m][1][i]; }
                u32x4 w; w.x = cvt_pk_bf16(v0[0], v0[1]); w.y = cvt_pk_bf16(v0[2], v0[3]); w.z = cvt_pk_bf16(v1[0], v1[1]); w.w = cvt_pk_bf16(v1[2], v1[3]);
                *(u32x4*)rowp = w; }
    }
};
struct EpiSwiGLU8 {
    static constexpr bool PERM = true, AFTER_DRAIN = false;
    unsigned char* O; int ldc;
    __device__ __forceinline__ void operator()(const f32x4 (&acc)[2][2][4][2], const Unit& u, int wr, int wc, int fr, int fq) const {
        const int row0 = u.pm * BM + wr * 64 + fr, col0 = u.pn * HALF + wc * 32 + 8 * fq; constexpr float si = 1.f / FP8_SW1;
#pragma unroll
        for (int ai = 0; ai < 2; ++ai)
#pragma unroll
            for (int m = 0; m < 4; ++m) { unsigned char* rowp = O + (size_t)(row0 + ai * HALF + m * 16) * ldc + col0;
                f32x4 v0, v1;
#pragma unroll
                for (int i = 0; i < 4; ++i) {
                    const float g0 = acc[ai][0][m][0][i], g1 = acc[ai][0][m][1][i];
                    v0[i] = (g0 * acc[ai][1][m][0][i]) * ((si * si * FP8_SH) * __builtin_amdgcn_rcpf(1.f + __builtin_amdgcn_exp2f(g0 * (-si * 1.4426950408889634f))));
                    v1[i] = (g1 * acc[ai][1][m][1][i]) * ((si * si * FP8_SH) * __builtin_amdgcn_rcpf(1.f + __builtin_amdgcn_exp2f(g1 * (-si * 1.4426950408889634f)))); }
                typedef unsigned u32x2 __attribute__((ext_vector_type(2))); u32x2 w; w.x = pk4_fp8(v0[0], v0[1], v0[2], v0[3]); w.y = pk4_fp8(v1[0], v1[1], v1[2], v1[3]);
                *(u32x2*)rowp = w; }
    }
};
__device__ __forceinline__ float logf_gate(float x, float la, float l1) {
    const float ls = fminf(x, 0.f) - __logf(1.0f + __expf(-fabsf(x)));
    const float b = l1 + ls;
    if (la == -INFINITY) return b;
    const float mx = fmaxf(la, b), d = fabsf(la - b);
    return mx + __logf(1.0f + __expf(-d));
}
struct EpiHgrnIn {
    static constexpr bool PERM = true, AFTER_DRAIN = false;
    unsigned char* ws; int layer;
    static constexpr size_t O_PQ = 580ull << 20, O_PI = O_PQ + (128ull << 20), O_PG = O_PQ + (256ull << 20), O_LF = O_PQ + (384ull << 20), O_LA = 1ull << 20, O_L1 = O_LA + 8192;
    __device__ __forceinline__ void operator()(const f32x4 (&acc)[2][2][4][2], const Unit& u, int wr, int wc, int fr, int fq) const {
        const int quarter = u.pn >> 2;
        const int row0 = u.pm * BM + wr * 64 + fr, col0 = (u.pn & 3) * BM + wc * 32 + 8 * fq;
        if (quarter == 1) {
            const float* la = (const float*)(ws + O_LA) + layer * 1024; const float* l1 = (const float*)(ws + O_L1) + layer * 1024; float* LF = (float*)(ws + O_LF);
            f32x4 A0[2][2], A1[2][2];
#pragma unroll
            for (int bj = 0; bj < 2; ++bj)
#pragma unroll
                for (int n = 0; n < 2; ++n) { A0[bj][n] = *(const f32x4*)(la + col0 + bj * HALF + 4 * n); A1[bj][n] = *(const f32x4*)(l1 + col0 + bj * HALF + 4 * n); }
#pragma unroll
            for (int ai = 0; ai < 2; ++ai)
#pragma unroll
                for (int m = 0; m < 4; ++m) { float* rowp = LF + (size_t)(row0 + ai * HALF + m * 16) * 1024 + col0;
#pragma unroll
                    for (int bj = 0; bj < 2; ++bj)
#pragma unroll
                        for (int n = 0; n < 2; ++n) { f32x4 o;
#pragma unroll
                            for (int i = 0; i < 4; ++i) o[i] = logf_gate(acc[ai][bj][m][n][i], A0[bj][n][i], A1[bj][n][i]);
                            *(f32x4*)(rowp + bj * HALF + 4 * n) = o; } }
        } else {
            bf16_t* O = (bf16_t*)(ws + (quarter == 0 ? O_PQ : (quarter == 2 ? O_PI : O_PG)));
#pragma unroll
            for (int ai = 0; ai < 2; ++ai)
#pragma unroll
                for (int m = 0; m < 4; ++m) { bf16_t* rowp = O + (size_t)(row0 + ai * HALF + m * 16) * 1024 + col0;
#pragma unroll
                    for (int bj = 0; bj < 2; ++bj) { f32x4 v0 = acc[ai][bj][m][0], v1 = acc[ai][bj][m][1];
                        if (quarter != 2) {
#pragma unroll
                            for (int i = 0; i < 4; ++i) { v0[i] = silu_f(v0[i]); v1[i] = silu_f(v1[i]); } }
                        u32x4 w; w.x = cvt_pk_bf16(v0[0], v0[1]); w.y = cvt_pk_bf16(v0[2], v0[3]); w.z = cvt_pk_bf16(v1[0], v1[1]); w.w = cvt_pk_bf16(v1[2], v1[3]);
                        *(u32x4*)(rowp + bj * HALF) = w; } }
        }
    }
};

template <class Epi, class Sched, bool ALIGN_EPI = false, bool SP2 = false, bool FP8 = false>
__device__ __forceinline__ void gemm_phase(PG8_LAS unsigned char* lds, const Gemm g, const Sched& S, const Epi& E, const int wave_id) {
    int lane_; asm volatile("v_mbcnt_lo_u32_b32 %0, -1, 0\n\tv_mbcnt_hi_u32_b32 %0, -1, %0" : "=v"(lane_));
    const int wid = wave_id, lane = lane_, tid = wid * 64 + lane, wr = wid >> 2, wc = wid & 3, fr = lane & 15, fq = lane >> 4;
    const int K = g.K, nt = K / BK, lda = g.lda;
    unsigned voffA[2], voffB[2];
#pragma unroll
    for (int i = 0; i < 2; ++i) { int R, C; stage_rc(tid * 16 + i * 8192, R, C); const int Rb = Epi::PERM ? ((R & ~31) + perm32(R & 31)) : R;
        voffA[i] = (unsigned)(R * lda + C) * 2u; voffB[i] = (unsigned)(Rb * K + C) * 2u; }
    const size_t kstep = (size_t)(BK * 2);
    const size_t hstep = (size_t)HALF * K * 2;
    const size_t tstep = 2 * hstep;
    const size_t hstepA = (size_t)HALF * lda * 2, tstepA = 2 * hstepA;
    const unsigned ldsw = (unsigned)wid * 1024u;
    const int aoff = lds_byte(wr * 64 + fr, fq * 8), boff = lds_byte(wc * 32 + fr, fq * 8);
#define PG8_SA(b, h) (((b) * 2 + (h)) * HTB)
#define PG8_SB(b, h) ((4 + (b) * 2 + (h)) * HTB)
#define PG8_STAGE(bufoff, gbase, voff) do { _Pragma("unroll") for (int _i = 0; _i < 2; ++_i) \
        __builtin_amdgcn_global_load_lds((const unsigned*)((const char*)(gbase) + (voff)[_i]), (PG8_LAS unsigned*)(lds + (bufoff) + ldsw + _i * 8192), 16, 0, 0); } while (0)
    typedef int i32x4_ __attribute__((ext_vector_type(4))); typedef int i32x8_ __attribute__((ext_vector_type(8)));
#define PG8_CAT(x, y) __builtin_shufflevector((x), (y), 0, 1, 2, 3, 4, 5, 6, 7)
#define PG8_LDA(dst, b, h) do { _Pragma("unroll") for (int m = 0; m < 4; ++m) { \
        if constexpr (FP8) dst##8[m] = PG8_CAT(*(const PG8_LAS i32x4_*)(lds + PG8_SA(b, h) + aoff + m * 2048), *(const PG8_LAS i32x4_*)(lds + PG8_SA(b, h) + aoff + m * 2048 + 1024)); \
        else { _Pragma("unroll") for (int k = 0; k < 2; ++k) dst[m][k] = *(const PG8_LAS bf16x8*)(lds + PG8_SA(b, h) + aoff + m * 2048 + k * 1024); } } } while (0)
#define PG8_LDB(dst, b, h) do { _Pragma("unroll") for (int n = 0; n < 2; ++n) { \
        if constexpr (FP8) dst##8[n] = PG8_CAT(*(const PG8_LAS i32x4_*)(lds + PG8_SB(b, h) + boff + n * 2048), *(const PG8_LAS i32x4_*)(lds + PG8_SB(b, h) + boff + n * 2048 + 1024)); \
        else { _Pragma("unroll") for (int k = 0; k < 2; ++k) dst[n][k] = *(const PG8_LAS bf16x8*)(lds + PG8_SB(b, h) + boff + n * 2048 + k * 1024); } } } while (0)
#define PG8_MMA(ai, bj, At, Bt) do { __builtin_amdgcn_s_setprio(1); _Pragma("unroll") for (int m = 0; m < 4; ++m) _Pragma("unroll") for (int n = 0; n < 2; ++n) { \
        if constexpr (FP8) asm volatile("v_mfma_scale_f32_16x16x128_f8f6f4 %0, %1, %2, %0, %3, %3 op_sel_hi:[0,0,0]" : "+v"(acc[ai][bj][m][n]) : "v"(Bt##8[n]), "v"(At##8[m]), "v"(f8scale_)); \
        else { _Pragma("unroll") for (int k = 0; k < 2; ++k) acc[ai][bj][m][n] = __builtin_amdgcn_mfma_f32_16x16x32_bf16(Bt[n][k], At[m][k], acc[ai][bj][m][n], 0, 0, 0); } } \
        __builtin_amdgcn_s_setprio(0); } while (0)
#define PG8_WAIT_V(n) asm volatile("s_waitcnt vmcnt(" #n ")" ::: "memory")
#define PG8_WAIT_L(n) asm volatile("s_waitcnt lgkmcnt(" #n ")" ::: "memory")
#define PG8_BAR __builtin_amdgcn_s_barrier()
#define PG8_SCHED __builtin_amdgcn_sched_barrier(0)
    Unit cur, nxt; int ui = 0;
    if (!S.next(0, cur)) return;
    f32x4 acc[2][2][4][2];
#pragma unroll
    for (int a = 0; a < 2; ++a)
#pragma unroll
        for (int b = 0; b < 2; ++b)
#pragma unroll
            for (int m = 0; m < 4; ++m)
#pragma unroll
                for (int n = 0; n < 2; ++n) acc[a][b][m][n] = (f32x4){0.f, 0.f, 0.f, 0.f};
    const int f8scale_ = 0x7f7f7f7f;
    bf16x8 At[4][2], B0[2][2], B1[2][2]; i32x8_ At8[4], B08[2], B18[2];
    const char* cA = (const char*)g.A + (size_t)cur.pm * tstepA; const char* cB = (const char*)g.Bt + (size_t)cur.e * g.estride + (size_t)cur.pn * tstep;
    S.a_ready(cur);
    if constexpr (SP2) {
        PG8_STAGE(PG8_SB(0, 0), cB, voffB); PG8_STAGE(PG8_SB(0, 1), cB + hstep, voffB); PG8_STAGE(PG8_SA(0, 0), cA, voffA); PG8_STAGE(PG8_SA(0, 1), cA + hstepA, voffA);
        if (wr == 1) PG8_BAR;
        PG8_WAIT_V(2); PG8_BAR;
        PG8_STAGE(PG8_SB(1, 0), cB + kstep, voffB); PG8_STAGE(PG8_SA(1, 0), cA + kstep, voffA); PG8_STAGE(PG8_SB(1, 1), cB + hstep + kstep, voffB);
        PG8_WAIT_V(6); PG8_BAR;
    } else {
        PG8_STAGE(PG8_SB(0, 0), cB, voffB); PG8_STAGE(PG8_SA(0, 0), cA, voffA); PG8_STAGE(PG8_SB(0, 1), cB + hstep, voffB); PG8_STAGE(PG8_SA(0, 1), cA + hstepA, voffA);
        if (wr == 1) PG8_BAR;
        PG8_WAIT_V(4); PG8_BAR;
        PG8_STAGE(PG8_SB(1, 0), cB + kstep, voffB); PG8_STAGE(PG8_SA(1, 0), cA + kstep, voffA); PG8_STAGE(PG8_SB(1, 1), cB + hstep + kstep, voffB);
        PG8_WAIT_V(6); PG8_BAR;
    }
    for (;;) {
        const bool has_next = S.next(ui + 1, nxt);
        const char* nA = has_next ? (const char*)g.A + (size_t)nxt.pm * tstepA : cA; const char* nB = has_next ? (const char*)g.Bt + (size_t)nxt.e * g.estride + (size_t)nxt.pn * tstep : cB;
        for (int t = 0; t < nt; t += 2) {
            const bool last = (t == nt - 2);
            const char* a1 = cA + (size_t)(t + 1) * kstep;
            const char* a2 = last ? nA : cA + (size_t)(t + 2) * kstep; const char* b2 = last ? nB : cB + (size_t)(t + 2) * kstep;
            const char* a3 = a2 + kstep; const char* b3 = b2 + kstep;
            if (last && has_next) S.a_ready(nxt);
            if constexpr (SP2) {
            PG8_LDB(B0, 0, 0); PG8_LDB(B1, 0, 1); PG8_SCHED; PG8_LDA(At, 0, 0); PG8_STAGE(PG8_SA(1, 1), a1 + hstepA, voffA);
            PG8_WAIT_V(8); PG8_WAIT_L(0); PG8_BAR; PG8_MMA(0, 0, At, B0); PG8_MMA(0, 1, At, B1); PG8_BAR; PG8_SCHED;
            PG8_LDA(At, 0, 1); PG8_STAGE(PG8_SB(0, 0), b2, voffB); PG8_STAGE(PG8_SB(0, 1), b2 + hstep, voffB); PG8_STAGE(PG8_SA(0, 0), a2, voffA);
            PG8_WAIT_V(8); PG8_WAIT_L(0); PG8_BAR; PG8_MMA(1, 0, At, B0); PG8_MMA(1, 1, At, B1); PG8_BAR; PG8_SCHED;
            PG8_LDB(B0, 1, 0); PG8_LDB(B1, 1, 1); PG8_SCHED; PG8_LDA(At, 1, 0); PG8_STAGE(PG8_SA(0, 1), a2 + hstepA, voffA);
            PG8_WAIT_V(8); PG8_WAIT_L(0); PG8_BAR; PG8_MMA(0, 0, At, B0); PG8_MMA(0, 1, At, B1); PG8_BAR; PG8_SCHED;
            PG8_LDA(At, 1, 1); PG8_STAGE(PG8_SB(1, 0), b3, voffB); PG8_STAGE(PG8_SB(1, 1), b3 + hstep, voffB); PG8_STAGE(PG8_SA(1, 0), a3, voffA);
            PG8_WAIT_V(8); PG8_WAIT_L(0); PG8_BAR; PG8_MMA(1, 0, At, B0); PG8_MMA(1, 1, At, B1); PG8_BAR; PG8_SCHED;
            } else {
            PG8_LDB(B0, 0, 0); PG8_SCHED; PG8_LDA(At, 0, 0); PG8_STAGE(PG8_SA(1, 1), a1 + hstepA, voffA);
            PG8_WAIT_L(8); PG8_BAR; PG8_WAIT_L(0); PG8_MMA(0, 0, At, B0); PG8_BAR; PG8_SCHED;
            PG8_LDB(B1, 0, 1); PG8_STAGE(PG8_SB(0, 0), b2, voffB);
            PG8_BAR; PG8_WAIT_L(0); PG8_MMA(0, 1, At, B1); PG8_BAR;
            PG8_LDA(At, 0, 1); PG8_STAGE(PG8_SA(0, 0), a2, voffA);
            PG8_BAR; PG8_WAIT_L(0); PG8_MMA(1, 0, At, B0); PG8_BAR; PG8_SCHED;
            PG8_STAGE(PG8_SB(0, 1), b2 + hstep, voffB);
            PG8_WAIT_V(6); PG8_BAR; PG8_MMA(1, 1, At, B1); PG8_BAR;
            PG8_LDB(B0, 1, 0); PG8_SCHED; PG8_LDA(At, 1, 0); PG8_STAGE(PG8_SA(0, 1), a2 + hstepA, voffA);
            PG8_WAIT_L(8); PG8_BAR; PG8_WAIT_L(0); PG8_MMA(0, 0, At, B0); PG8_BAR; PG8_SCHED;
            PG8_LDB(B1, 1, 1); PG8_STAGE(PG8_SB(1, 0), b3, voffB);
            PG8_BAR; PG8_WAIT_L(0); PG8_MMA(0, 1, At, B1); PG8_BAR;
            PG8_LDA(At, 1, 1); PG8_STAGE(PG8_SA(1, 0), a3, voffA);
            PG8_BAR; PG8_WAIT_L(0); PG8_MMA(1, 0, At, B0); PG8_BAR; PG8_SCHED;
            PG8_STAGE(PG8_SB(1, 1), b3 + hstep, voffB);
            PG8_WAIT_V(6); PG8_BAR; PG8_MMA(1, 1, At, B1); PG8_BAR;
            }
        }
        if constexpr (FP8) asm volatile("s_nop 15\n\ts_nop 15" ::: "memory");
        if constexpr (ALIGN_EPI) { if (wr == 0) PG8_BAR; }
        if constexpr (!Epi::AFTER_DRAIN) { E(acc, cur, wr, wc, fr, fq); S.done(cur); }
        if (!has_next) break;
#pragma unroll
        for (int a = 0; a < 2; ++a)
#pragma unroll
            for (int b = 0; b < 2; ++b)
#pragma unroll
                for (int m = 0; m < 4; ++m)
#pragma unroll
                    for (int n = 0; n < 2; ++n) acc[a][b][m][n] = (f32x4){0.f, 0.f, 0.f, 0.f};
        cur = nxt; cA = nA; cB = nB; ++ui;
        if constexpr (ALIGN_EPI) { if (wr == 1) PG8_BAR; }
    }
    PG8_WAIT_V(0);
    if constexpr (!ALIGN_EPI) { if (wr == 0) PG8_BAR; }
    PG8_BAR;
    if constexpr (Epi::AFTER_DRAIN) { E.fused(acc, cur, wr, wc, fr, fq, lds, wid, lane); S.done(cur); }
#undef PG8_SA
#undef PG8_SB
#undef PG8_STAGE
#undef PG8_LDA
#undef PG8_LDB
#undef PG8_MMA
#undef PG8_CAT
#undef PG8_WAIT_V
#undef PG8_WAIT_L
#undef PG8_BAR
#undef PG8_SCHED
}
}

constexpr int NT = 65536, DM = 1024, NBATCH = 32, SEQ = 2048;
constexpr int DFF = 2816, DFE = 3584, NEXP = 8;
constexpr int MOE_ROWS = 133120;
constexpr float EPS = 1e-6f;
constexpr size_t MiB = 1u << 20;
constexpr size_t WS_CTL = 0, CTL_ZERO_BYTES = 1 * MiB;
constexpr size_t WS_LA = 1 * MiB;
constexpr size_t WS_L1 = WS_LA + 8192;
constexpr size_t WS_CB = WS_LA + 16384;
constexpr size_t WS_RCNT = WS_LA + 32768;
constexpr size_t WS_RTAB = WS_LA + 65536;
constexpr size_t WS_ROUTE = 2 * MiB;
constexpr size_t WS_SLOT = 3 * MiB;
constexpr size_t WS_SELM = 4 * MiB;
constexpr size_t WS_GATES = 8 * MiB;
constexpr size_t WS_KC = 20 * MiB;
constexpr size_t WS_VCT = 22 * MiB;
constexpr size_t WS_HC = 24 * MiB;
constexpr size_t WS_W = 48 * MiB;
constexpr size_t W_HIN = WS_W, W_HOUT = WS_W + 16 * MiB, W_KVQ = WS_W + 20 * MiB, W_Q3 = WS_W + 26 * MiB, W_CMP1 = WS_W + 29 * MiB, W_NOUT = WS_W + 31 * MiB,
                 W_FGU = WS_W + 35 * MiB, W_FDN = WS_W + 57 * MiB, W_MGU = WS_W + 68 * MiB, W_MDN = WS_W + 292 * MiB;
constexpr size_t WS_XN = 452 * MiB;
constexpr size_t WS_R = 580 * MiB;
constexpr size_t R_PQ = WS_R, R_PI = WS_R + 128 * MiB, R_PG = WS_R + 256 * MiB, R_LF = WS_R + 384 * MiB, R_O2 = WS_R + 640 * MiB;
constexpr size_t R_HF = WS_R + 256 * MiB;
constexpr size_t R_KS = WS_R, R_KW = WS_R + 32 * MiB, R_VST = WS_R + 64 * MiB, R_VWT = WS_R + 96 * MiB, R_KCR = WS_R + 128 * MiB, R_VCR = WS_R + 160 * MiB;
constexpr size_t R_QKV = WS_R + 256 * MiB;
constexpr size_t R_Q = WS_R + 608 * MiB, R_O = WS_R + 736 * MiB;
constexpr size_t R_XP = WS_R, R_HM = WS_R + 260 * MiB;
constexpr size_t WS_NEED = R_HM + (size_t)MOE_ROWS * DFE * 2;
static_assert(WS_NEED <= 1792 * MiB, "workspace map");
static_assert(W_MDN + 112 * MiB <= WS_XN, "weights map");
static_assert(pg8::EpiHgrnIn::O_PQ == R_PQ && pg8::EpiHgrnIn::O_PI == R_PI && pg8::EpiHgrnIn::O_PG == R_PG && pg8::EpiHgrnIn::O_LF == R_LF && pg8::EpiHgrnIn::O_LA == WS_LA && pg8::EpiHgrnIn::O_L1 == WS_L1, "EpiHgrnIn offsets");

constexpr int LDS_BYTES = 147456;
constexpr int MISC_OFF = 131072 + 320;
constexpr int NWAVES = 8;

#define GAS __attribute__((address_space(1)))
#define LAS __attribute__((address_space(3)))
typedef unsigned short bf16;
typedef unsigned v4u __attribute__((ext_vector_type(4)));
typedef unsigned v2u __attribute__((ext_vector_type(2)));
typedef float f32x4 __attribute__((ext_vector_type(4)));
#define LDS_WAIT() asm volatile("s_waitcnt lgkmcnt(0)" ::: "memory")
__device__ __forceinline__ unsigned f2bf(float f) { unsigned u = __builtin_bit_cast(unsigned, f); return (u + 0x7fffu + ((u >> 16) & 1u)) >> 16; }
__device__ __forceinline__ unsigned pk2(float lo, float hi) { return f2bf(lo) | (f2bf(hi) << 16); }
__device__ __forceinline__ float bf2f(unsigned b) { return __builtin_bit_cast(float, b << 16); }
__device__ __forceinline__ float bflo(unsigned w) { return __builtin_bit_cast(float, w << 16); }
__device__ __forceinline__ float bfhi(unsigned w) { return __builtin_bit_cast(float, w & 0xffff0000u); }
__device__ __forceinline__ float wave_sum(float v) {
#pragma unroll
    for (int o = 32; o >= 1; o >>= 1) v += __shfl_xor(v, o);
    return v;
}
__device__ __forceinline__ float wave_max(float v) {
#pragma unroll
    for (int o = 32; o >= 1; o >>= 1) v = fmaxf(v, __shfl_xor(v, o));
    return v;
}

#define XB_TMO      128
#define XB_XCNT(j)  (256  + 64 * (j))
#define XB_XSUB(j)  (1280 + 64 * (j))
#define XB_XGEN(j)  (2304 + 64 * (j))
#define XB_TOP      3328
#define XB_TOPGEN   3392
#define XCD_BAR_WORDS 3456
#define XB_SPIN_CAP (1u << 22)
__device__ __forceinline__ unsigned xb_ld(unsigned* p)              { return __hip_atomic_load(p, __ATOMIC_RELAXED, __HIP_MEMORY_SCOPE_AGENT); }
__device__ __forceinline__ unsigned xb_add(unsigned* p, unsigned v) { return __hip_atomic_fetch_add(p, v, __ATOMIC_RELAXED, __HIP_MEMORY_SCOPE_AGENT); }
__device__ __forceinline__ unsigned xb_xcc_id() { return (unsigned)__builtin_amdgcn_s_getreg((3 << 11) | 20) & 0xFu; }
#define XB_SPIN(cond, bar) do { unsigned _sp = 0; while (cond) { __builtin_amdgcn_s_sleep(1); \
    if ((++_sp & 255u) == 0u) { if (xb_ld(&(bar)[XB_TMO])) break; if (_sp > XB_SPIN_CAP) { atomicAdd(&(bar)[XB_TMO], 1u); break; } } } } while (0)
struct XcdBarrier { unsigned* bar; unsigned x; volatile LAS unsigned* st; };
__device__ __forceinline__ XcdBarrier xcd_barrier_post(unsigned* bar, volatile LAS unsigned* st) {
    XcdBarrier b; b.bar = bar; b.x = xb_xcc_id(); b.st = st;
    if (threadIdx.x == 0) (void)xb_add(&bar[XB_XCNT(b.x)], 1u);
    return b;
}
__device__ __forceinline__ void xcd_barrier_complete(unsigned* bar, unsigned x, unsigned& nloc, unsigned& nx) {
    const unsigned G = gridDim.x * gridDim.y * gridDim.z;
    unsigned sum, cnt, mine, sp = 0u;
    for (;;) {
        sum = 0u; cnt = 0u; mine = 0u;
#pragma unroll
        for (unsigned j = 0; j < 16; ++j) { const unsigned c = xb_ld(&bar[XB_XCNT(j)]); sum += c; cnt += (c > 0u) ? 1u : 0u; mine = (j == x) ? c : mine; }
        if (sum == G) break;
        __builtin_amdgcn_s_sleep(1);
        if ((++sp & 255u) == 0u) { if (xb_ld(&bar[XB_TMO])) break; if (sp > XB_SPIN_CAP) { atomicAdd(&bar[XB_TMO], 1u); break; } }
    }
    nloc = mine > 0u ? mine : 1u; nx = cnt > 0u ? cnt : 1u;
}
__device__ __forceinline__ void xcd_barrier(const XcdBarrier& b) {
    asm volatile("s_waitcnt vmcnt(0)" ::: "memory");
    __syncthreads();
    if (threadIdx.x == 0) {
        unsigned* bar = b.bar; unsigned bx_ = b.x; asm volatile("" : "+s"(bar), "+s"(bx_));
        __builtin_amdgcn_s_waitcnt(0);
        unsigned nloc = b.st[0], nx = b.st[1];
        if (nloc == 0u) { xcd_barrier_complete(bar, bx_, nloc, nx); b.st[0] = nloc; b.st[1] = nx; }
        const unsigned old = xb_add(&bar[XB_XSUB(bx_)], 1u);
        const unsigned gen = old / nloc;
        if (old + 1u == (gen + 1u) * nloc) {
            __builtin_amdgcn_fence(__ATOMIC_RELEASE, "agent");
            asm volatile("s_waitcnt vmcnt(0)" ::: "memory");
            const unsigned og = xb_add(&bar[XB_TOP], 1u);
            const unsigned tg = og / nx;
            if (og + 1u == (tg + 1u) * nx) xb_add(&bar[XB_TOPGEN], 1u);
            else XB_SPIN(xb_ld(&bar[XB_TOPGEN]) == tg, bar);
            __builtin_amdgcn_fence(__ATOMIC_ACQUIRE, "agent");
            xb_add(&bar[XB_XGEN(bx_)], 1u);
            asm volatile("s_waitcnt vmcnt(0)" ::: "memory");
        } else {
            XB_SPIN(xb_ld(&bar[XB_XGEN(bx_)]) == gen, bar);
            __builtin_amdgcn_fence(__ATOMIC_ACQUIRE, "agent");
            asm volatile("s_waitcnt vmcnt(0)" ::: "memory");
        }
    }
    __syncthreads();
}

struct Ctx {
    LAS unsigned char* lds;
    int tid, lane, wave, G, bid;
    float* out; unsigned char* ws;
    __device__ __forceinline__ const float* inp(int i) const {
        const __attribute__((address_space(4))) unsigned char* kp = (const __attribute__((address_space(4))) unsigned char*)__builtin_amdgcn_kernarg_segment_ptr();
        asm volatile("" : "+s"(kp));
        return ((const float* const __attribute__((address_space(4)))*)kp)[i];
    }
};
enum { I_X = 0, I_NMIX, I_NFFN, I_HWIN, I_HWOUT, I_HGN, I_HLB, I_KVN, I_KVW, I_CPK, I_CW1K, I_CW2K, I_CPV, I_CW1V, I_CW2V, I_KN, I_NWIN, I_NWOUT, I_NQN, I_FGU, I_FDN, I_MR, I_MGU, I_MDN };

constexpr int MAXJOB = 64;
struct JobTab { unsigned long long src[MAXJOB], gain[MAXJOB], dst[MAXJOB]; int K[MAXJOB], Nsrc[MAXJOB], npb[MAXJOB], F[MAXJOB], rowoff[MAXJOB], istart[MAXJOB + 1]; float f8s[MAXJOB]; int njobs; };
__device__ __forceinline__ void add_job(LAS JobTab* J, const float* src, const float* gain, bf16* dst, int K, int Nsrc, int Npad, int F, int rowoff, float f8s = 0.f) {
    const int j = J->njobs; J->src[j] = (unsigned long long)src; J->gain[j] = (unsigned long long)gain; J->dst[j] = (unsigned long long)dst;
    J->K[j] = K; J->Nsrc[j] = Nsrc; J->npb[j] = Npad / 32; J->F[j] = F; J->rowoff[j] = rowoff; J->f8s[j] = f8s; J->istart[j + 1] = J->istart[j] + (K / 64) * (Npad / 32); J->njobs = j + 1;
}
struct TrItem { const float* W; const float* gain; bf16* WT; int K, Nsrc, drow, k0, n0; float f8s; };
__device__ __forceinline__ void tr_load(const TrItem& p, f32x4 (&v)[8], int lane) {
    const int c4 = lane & 7, kr = lane >> 3, n = p.n0 + 4 * c4; const bool okn = n < p.Nsrc;
#pragma unroll
    for (int i = 0; i < 8; ++i) { const int kk = 8 * i + kr; v[i] = okn ? *(const f32x4*)(p.W + (size_t)(p.k0 + kk) * p.Nsrc + n) : (f32x4){0.f, 0.f, 0.f, 0.f}; }
}
__device__ __forceinline__ void tr_finish(const TrItem& p, f32x4 (&v)[8], LAS float* scr, int lane) {
    const int c4 = lane & 7, kr = lane >> 3;
#pragma unroll
    for (int i = 0; i < 8; ++i) { const int kk = 8 * i + kr; if (p.gain) v[i] = v[i] * p.gain[p.k0 + kk]; *(LAS f32x4*)(scr + kk * 36 + 4 * c4) = v[i]; }
    LDS_WAIT();
    const int c = lane & 7; const float f8s = p.f8s;
#pragma unroll
    for (int j = 0; j < 4; ++j) { const int nn = (lane >> 3) + 8 * j; const LAS float* s = scr + (8 * c) * 36 + nn;
        if (f8s != 0.f) { v2u o; o.x = pg8::pk4_fp8(s[0 * 36] * f8s, s[1 * 36] * f8s, s[2 * 36] * f8s, s[3 * 36] * f8s); o.y = pg8::pk4_fp8(s[4 * 36] * f8s, s[5 * 36] * f8s, s[6 * 36] * f8s, s[7 * 36] * f8s);
            *(v2u*)((unsigned char*)p.WT + (size_t)(p.drow + nn) * p.K + p.k0 + 8 * c) = o; }
        else { v4u o; o.x = pk2(s[0 * 36], s[1 * 36]); o.y = pk2(s[2 * 36], s[3 * 36]); o.z = pk2(s[4 * 36], s[5 * 36]); o.w = pk2(s[6 * 36], s[7 * 36]);
            *(v4u*)(p.WT + (size_t)(p.drow + nn) * p.K + p.k0 + 8 * c) = o; } }
    LDS_WAIT();
}
__device__ __forceinline__ void norm_row_store(const f32x4 (&v)[4], bf16* orow, int lane) {
    float s = 0.f;
#pragma unroll
    for (int j = 0; j < 4; ++j) s += (v[j].x * v[j].x + v[j].y * v[j].y) + (v[j].z * v[j].z + v[j].w * v[j].w);
    const float rstd = rsqrtf(wave_sum(s) * (1.f / DM) + EPS);
    v2u* o8 = (v2u*)orow + lane;
#pragma unroll
    for (int j = 0; j < 4; ++j) { v2u w; w.x = pk2(v[j].x * rstd, v[j].y * rstd); w.y = pk2(v[j].z * rstd, v[j].w * rstd); o8[64 * j] = w; }
}
__device__ __forceinline__ void p_prologue(Ctx& C) {
    LAS JobTab* J = (LAS JobTab*)(C.lds + 73728);
    unsigned char* ws = C.ws;
    if (C.tid == 0) {
        J->njobs = 0; J->istart[0] = 0;
        for (int l = 0; l < 2; ++l) add_job(J, C.inp(I_HWIN) + (size_t)l * 1024 * 4096, C.inp(I_NMIX) + l * 1024, (bf16*)(ws + W_HIN) + (size_t)l * 4096 * 1024, 1024, 4096, 4096, 0, 0);
        for (int l = 0; l < 2; ++l) add_job(J, C.inp(I_HWOUT) + (size_t)l * 1024 * 1024, nullptr, (bf16*)(ws + W_HOUT) + (size_t)l * 1024 * 1024, 1024, 1024, 1024, 0, 0);
        add_job(J, C.inp(I_KVW), C.inp(I_KVN), (bf16*)(ws + W_KVQ), 1024, 1536, 1536, 0, 0);
        add_job(J, C.inp(I_NWIN), C.inp(I_NMIX) + 2048, (bf16*)(ws + W_KVQ), 1024, 1072, 1280, 0, 1536);
        add_job(J, C.inp(I_NWIN) + (size_t)1024 * 1072, C.inp(I_NMIX) + 3072, (bf16*)(ws + W_Q3), 1024, 1072, 1280, 0, 0);
        add_job(J, C.inp(I_CW1K), nullptr, (bf16*)(ws + W_CMP1), 2048, 256, 256, 0, 0);
        add_job(J, C.inp(I_CW1V), nullptr, (bf16*)(ws + W_CMP1) + (size_t)256 * 2048, 2048, 256, 256, 0, 0);
        for (int l = 0; l < 2; ++l) add_job(J, C.inp(I_NWOUT) + (size_t)l * 1024 * 1024, nullptr, (bf16*)(ws + W_NOUT) + (size_t)l * 1024 * 1024, 1024, 1024, 1024, 0, 0);
        for (int l = 0; l < 2; ++l) add_job(J, C.inp(I_FGU) + (size_t)l * 1024 * 2 * DFF, C.inp(I_NFFN) + (2 * l) * 1024, (bf16*)(ws + W_FGU + (size_t)l * 2 * DFF * 2048), 1024, 2 * DFF, 2 * DFF, DFF, 0, l ? pg8::FP8_SW1 : 0.f);
        for (int l = 0; l < 2; ++l) add_job(J, C.inp(I_FDN) + (size_t)l * DFF * 1024, nullptr, (bf16*)(ws + W_FDN + (size_t)l * 1024 * DFF * 2), DFF, 1024, 1024, 0, 0, l ? pg8::FP8_SW2 : 0.f);
        for (int l = 0; l < 16; ++l) add_job(J, C.inp(I_MGU) + (size_t)l * 1024 * 2 * DFE, C.inp(I_NFFN) + (2 * (l >> 3) + 1) * 1024, (bf16*)(ws + W_MGU + (size_t)l * 2 * DFE * 1024), 1024, 2 * DFE, 2 * DFE, DFE, 0, pg8::FP8_SW1);
        for (int l = 0; l < 16; ++l) add_job(J, C.inp(I_MDN) + (size_t)l * DFE * 1024, nullptr, (bf16*)(ws + W_MDN + (size_t)l * 1024 * DFE), DFE, 1024, 1024, 0, 0, pg8::FP8_SW2);
    }
    __syncthreads();
    LAS float* scr = (LAS float*)(C.lds + C.wave * 9216);
    const int gw = C.bid * NWAVES + C.wave, NGW = C.G * NWAVES;
    const int nj = J->njobs, total = J->istart[nj];
#define TR_SETUP(it_, P) do { int j = 0; while (j + 1 < nj && J->istart[j + 1] <= (it_)) ++j; \
        const int r = (it_) - J->istart[j], npb = J->npb[j], kb = r / npb, nb = r % npb, n0 = 32 * nb, F = J->F[j]; \
        int drow = J->rowoff[j] + n0; \
        if (F) drow = (n0 < F) ? 256 * (n0 / 128) + (n0 % 128) : 256 * ((n0 - F) / 128) + 128 + ((n0 - F) % 128); \
        P.W = (const float*)J->src[j]; P.gain = (const float*)J->gain[j]; P.WT = (bf16*)J->dst[j]; P.K = J->K[j]; P.Nsrc = J->Nsrc[j]; P.drow = drow; P.k0 = 64 * kb; P.n0 = n0; P.f8s = J->f8s[j]; } while (0)
    {
        TrItem pa, pb; f32x4 va[8], vb[8]; int it = gw;
        if (it < total) { TR_SETUP(it, pa); tr_load(pa, va, C.lane); }
        while (it < total) {
            int itn = it + NGW; bool hn = itn < total;
            if (hn) { TR_SETUP(itn, pb); tr_load(pb, vb, C.lane); }
            tr_finish(pa, va, scr, C.lane);
            if (!hn) break;
            it = itn; itn = it + NGW; hn = itn < total;
            if (hn) { TR_SETUP(itn, pa); tr_load(pa, va, C.lane); }
            tr_finish(pb, vb, scr, C.lane);
            if (!hn) break;
            it = itn; }
    }
#undef TR_SETUP
    { const int gt = C.bid * 512 + C.tid;
      if (gt < 1024) { const float a0 = C.inp(I_HLB)[gt], a1 = C.inp(I_HLB)[1024 + gt]; const float mx = fmaxf(a0, a1), e0 = expf(a0 - mx), e1 = expf(a1 - mx), s = e0 + e1;
          const float s0 = e0 / s, s1 = e1 / s, lb1 = (s0 + s1) - s0;
          float* la = (float*)(ws + WS_LA); float* l1 = (float*)(ws + WS_L1);
          la[gt] = -INFINITY; l1[gt] = 0.f; la[1024 + gt] = logf(lb1); l1[1024 + gt] = log1pf(-lb1); } }
    if (C.bid == 0 && C.tid < 128) ((int*)(ws + WS_RTAB))[2048 + C.tid] = C.tid >> 6;
    if (C.G >= 8 && C.bid >= C.G - 8) { const int ob = (C.bid - (C.G - 8)) * 64 + C.lane, which = ob >> 8, j = ob & 255; const float* pos = C.inp(which ? I_CPV : I_CPK); const float* w1 = C.inp(which ? I_CW1V : I_CW1K);
        float a = 0.f;
#pragma unroll 8
        for (int i = C.wave * 256; i < C.wave * 256 + 256; ++i) a += pos[i] * w1[(size_t)i * 256 + j];
        __syncthreads();
        LAS float* red = (LAS float*)(C.lds + 80 * 1024); red[C.wave * 64 + C.lane] = a;
        __syncthreads();
        if (C.wave == 0) { float t = 0.f;
#pragma unroll
            for (int w = 0; w < 8; ++w) t += red[w * 64 + C.lane];
            ((float*)(ws + WS_CB))[ob] = t; } }
    for (int c = C.bid; c < 256; c += C.G)
        for (int i = 0; i < 32; i += 4) { f32x4 v[4][4]; const float* xb = C.inp(I_X);
#pragma unroll
            for (int r = 0; r < 4; ++r) { const f32x4* xr = (const f32x4*)(xb + (size_t)(c * 256 + C.wave * 32 + i + r) * DM) + C.lane;
#pragma unroll
                for (int j = 0; j < 4; ++j) v[r][j] = xr[64 * j]; }
#pragma unroll
            for (int r = 0; r < 4; ++r) norm_row_store(v[r], (bf16*)(ws + WS_XN) + (size_t)(c * 256 + C.wave * 32 + i + r) * DM, C.lane); }
}

template <bool MOE_ADD, bool ROUTER, bool WRITE_XN, bool XN_FP8 = false>
__device__ __forceinline__ void p_norm(Ctx& C, const float* rw, const float* rgain) {
    unsigned char* ws = C.ws;
    LAS int* cnt8 = (LAS int*)(C.lds + 1024);
    const bf16* Y = (const bf16*)(ws + R_XP);
    const int4* route = (const int4*)(ws + WS_ROUTE); const int2* slot = (const int2*)(ws + WS_SLOT);
    constexpr int NR = (MOE_ADD || ROUTER) ? 2 : 4;
    for (int c = C.bid; c < 256; c += C.G) {
        if (ROUTER) { __syncthreads(); if (C.tid < 8) cnt8[C.tid] = 0; __syncthreads(); }
#pragma unroll 1
        for (int i = 0; i < 32; i += NR) {
            f32x4 v[NR][4];
#pragma unroll
            for (int r = 0; r < NR; ++r) { const float* hr = C.out + (size_t)(c * 256 + C.wave * 32 + i + r) * DM;
#pragma unroll
                for (int j = 0; j < 4; ++j) v[r][j] = ((const f32x4*)hr + C.lane)[64 * j]; }
            if (MOE_ADD) {
#pragma unroll
                for (int r = 0; r < NR; ++r) { const int row = c * 256 + C.wave * 32 + i + r; float* hr = C.out + (size_t)row * DM;
                    const int4 rt = route[row]; const int2 sl = slot[row]; const float w0 = __builtin_bit_cast(float, rt.y), w1 = __builtin_bit_cast(float, rt.z);
                    const v2u* y0 = (const v2u*)(Y + (size_t)sl.x * DM) + C.lane; const v2u* y1 = (const v2u*)(Y + (size_t)sl.y * DM) + C.lane;
#pragma unroll
                    for (int j = 0; j < 4; ++j) { const v2u a = y0[64 * j], b = y1[64 * j];
                        v[r][j].x += w0 * bflo(a.x) + w1 * bflo(b.x); v[r][j].y += w0 * bfhi(a.x) + w1 * bfhi(b.x); v[r][j].z += w0 * bflo(a.y) + w1 * bflo(b.y); v[r][j].w += w0 * bfhi(a.y) + w1 * bfhi(b.y);
                        ((f32x4*)hr + C.lane)[64 * j] = v[r][j]; } }
            }
            if (WRITE_XN || ROUTER) {
#pragma unroll
                for (int r = 0; r < NR; ++r) { const int row = c * 256 + C.wave * 32 + i + r;
                    float s = 0.f;
#pragma unroll
                    for (int j = 0; j < 4; ++j) s += (v[r][j].x * v[r][j].x + v[r][j].y * v[r][j].y) + (v[r][j].z * v[r][j].z + v[r][j].w * v[r][j].w);
                    const float rstd = rsqrtf(wave_sum(s) * (1.f / DM) + EPS);
                    if (WRITE_XN && XN_FP8) { unsigned* o4 = (unsigned*)(ws + WS_XN + (size_t)row * DM) + C.lane;
#pragma unroll
                        for (int j = 0; j < 4; ++j) o4[64 * j] = pg8::pk4_fp8(v[r][j].x * rstd, v[r][j].y * rstd, v[r][j].z * rstd, v[r][j].w * rstd); }
                    if (WRITE_XN && !XN_FP8) { v2u* o8 = (v2u*)((bf16*)(ws + WS_XN) + (size_t)row * DM) + C.lane;
#pragma unroll
                        for (int j = 0; j < 4; ++j) { v2u w; w.x = pk2(v[r][j].x * rstd, v[r][j].y * rstd); w.y = pk2(v[r][j].z * rstd, v[r][j].w * rstd); o8[64 * j] = w; } }
                    if (ROUTER) {
                        float lg[8];
#pragma unroll
                        for (int e = 0; e < 8; ++e) lg[e] = 0.f;
#pragma unroll
                        for (int j = 0; j < 4; ++j) { const int k0 = 4 * C.lane + 256 * j; const f32x4 g4 = *(const f32x4*)(rgain + k0);
#pragma unroll
                            for (int q = 0; q < 4; ++q) { const float xv = v[r][j][q] * rstd * g4[q]; const f32x4 wa = *(const f32x4*)(rw + (size_t)(k0 + q) * 8), wb = *(const f32x4*)(rw + (size_t)(k0 + q) * 8 + 4);
                                lg[0] += xv * wa.x; lg[1] += xv * wa.y; lg[2] += xv * wa.z; lg[3] += xv * wa.w; lg[4] += xv * wb.x; lg[5] += xv * wb.y; lg[6] += xv * wb.z; lg[7] += xv * wb.w; } }
#pragma unroll
                        for (int e = 0; e < 8; ++e) lg[e] = wave_sum(lg[e]);
                        int e0 = 0; float v0 = lg[0];
#pragma unroll
                        for (int e = 1; e < 8; ++e) if (lg[e] > v0) { v0 = lg[e]; e0 = e; }
                        int e1 = -1; float v1 = -INFINITY;
#pragma unroll
                        for (int e = 0; e < 8; ++e) if (e != e0 && (e1 < 0 || lg[e] > v1)) { v1 = lg[e]; e1 = e; }
                        const float ex = expf(v1 - v0), w0 = 1.f / (1.f + ex), w1 = ex / (1.f + ex);
                        if (C.lane == 0) { ((int4*)(ws + WS_ROUTE))[row] = make_int4(e0 | (e1 << 8), __builtin_bit_cast(int, w0), __builtin_bit_cast(int, w1), 0);
                            atomicAdd((int*)&cnt8[e0], 1); atomicAdd((int*)&cnt8[e1], 1); }
                    }
                }
            }
        }
        if (ROUTER) { __syncthreads(); if (C.tid < 8) ((int*)(ws + WS_RCNT))[c * 8 + C.tid] = cnt8[C.tid]; }
    }
}

__device__ __forceinline__ void p_gather(Ctx& C) {
    unsigned char* ws = C.ws;
    LAS int* tot = (LAS int*)(C.lds + 0);
    LAS int* pre = tot + 8;
    LAS int* base = tot + 16;
    LAS int* ee = tot + 32;
    LAS int* sl = tot + 32 + 256;
    const int* rcnt = (const int*)(ws + WS_RCNT);
    const int4* route = (const int4*)(ws + WS_ROUTE);
    for (int c = C.bid; c < 256; c += C.G) {
        __syncthreads();
        { const int e = C.wave; int t = 0, p = 0;
          for (int i = C.lane; i < 256; i += 64) { const int v = rcnt[i * 8 + e]; t += v; if (i < c) p += v; }
#pragma unroll
          for (int o = 32; o >= 1; o >>= 1) { t += __shfl_xor(t, o); p += __shfl_xor(p, o); }
          if (C.lane == 0) { tot[e] = t; pre[e] = p; } }
        if (C.tid < 256) ee[C.tid] = route[c * 256 + C.tid].x;
        __syncthreads();
        if (C.tid == 0) { int off = 0; for (int e = 0; e < 8; ++e) { base[e] = off + pre[e]; const int nt = (tot[e] + 255) >> 8;
                if (c == 0) { int* te = (int*)(ws + WS_RTAB); for (int q = 0; q < nt; ++q) te[(off >> 8) + q] = e; }
                off += nt << 8; }
            if (c == 0) ((int*)(ws + WS_RTAB))[1024] = off >> 8; }
        __syncthreads();
        if (C.tid < 8) { const int e = C.tid; int r = base[e];
            for (int i = 0; i < 256; ++i) { const int pk = ee[i]; if ((pk & 255) == e) sl[2 * i] = r++; if ((pk >> 8) == e) sl[2 * i + 1] = r++; } }
        __syncthreads();
        if (C.tid < 256) ((int2*)(ws + WS_SLOT))[c * 256 + C.tid] = make_int2(sl[2 * C.tid], sl[2 * C.tid + 1]);
        for (int i = 0; i < 32; i += 4) { v4u a[4];
#pragma unroll
            for (int r = 0; r < 4; ++r) a[r] = *((const v4u*)(ws + WS_XN + (size_t)(c * 256 + C.wave * 32 + i + r) * DM) + C.lane);
#pragma unroll
            for (int r = 0; r < 4; ++r) { const int tl = C.wave * 32 + i + r;
                *((v4u*)(ws + R_XP + (size_t)sl[2 * tl] * DM) + C.lane) = a[r]; *((v4u*)(ws + R_XP + (size_t)sl[2 * tl + 1] * DM) + C.lane) = a[r]; } }
    }
}

__device__ __forceinline__ void p_post_kv(Ctx& C) {
    unsigned char* ws = C.ws;
    const bf16* raw = (const bf16*)(ws + R_QKV);
    const float* kn = C.inp(I_KN);
    LAS unsigned char* tl = C.lds + C.wave * 4608;
    const int l = C.lane, c8 = l & 7, r8 = l >> 3, gw = C.bid * NWAVES + C.wave, NGW = C.G * NWAVES;
    for (int it = gw; it < 128 * 64; it += NGW) {
        const int bg = it >> 6, blk = it & 63, b = bg >> 2, g = bg & 3;
        const bf16* rb = raw + (size_t)(b * SEQ + blk * 32) * 2816 + g * 64 + 8 * c8;
        const size_t dst0 = ((size_t)bg * SEQ + blk * 32) * 64 + 8 * c8;
#pragma unroll
        for (int j = 0; j < 6; ++j) {
            v4u x[4];
#pragma unroll
            for (int i = 0; i < 4; ++i) x[i] = *(const v4u*)(rb + (size_t)(r8 + 8 * i) * 2816 + j * 256);
            if (j == 0 || j == 1) {
                bf16* d = (bf16*)(ws + (j == 0 ? R_KCR : R_VCR)) + dst0;
#pragma unroll
                for (int i = 0; i < 4; ++i) *(v4u*)(d + (size_t)(r8 + 8 * i) * 64) = x[i];
            } else if (j == 2 || j == 4) {
                unsigned char* d = ws + (j == 2 ? R_KS : R_KW) + ((size_t)bg * SEQ + blk * 32) * 64 + (c8 >> 2) * 1024 + (c8 & 3) * 8; const float* gk = kn + (j == 2 ? 64 : 128) + 8 * c8;
                const f32x4 ga = *(const f32x4*)gk, gb = *(const f32x4*)(gk + 4);
#pragma unroll
                for (int i = 0; i < 4; ++i) { const float f[8] = {bflo(x[i].x), bfhi(x[i].x), bflo(x[i].y), bfhi(x[i].y), bflo(x[i].z), bfhi(x[i].z), bflo(x[i].w), bfhi(x[i].w)};
                    float ss = (f[0] * f[0] + f[1] * f[1]) + (f[2] * f[2] + f[3] * f[3]) + (f[4] * f[4] + f[5] * f[5]) + (f[6] * f[6] + f[7] * f[7]);
                    ss += __shfl_xor(ss, 1); ss += __shfl_xor(ss, 2); ss += __shfl_xor(ss, 4);
                    const float rs = rsqrtf(ss * (1.f / 64.f) + EPS);
                    v2u o; o.x = pg8::pk4_fp8(f[0] * rs * ga.x, f[1] * rs * ga.y, f[2] * rs * ga.z, f[3] * rs * ga.w); o.y = pg8::pk4_fp8(f[4] * rs * gb.x, f[5] * rs * gb.y, f[6] * rs * gb.z, f[7] * rs * gb.w);
                    *(v2u*)(d + (size_t)(r8 + 8 * i) * 32) = o; }
            } else {
#pragma unroll
                for (int i = 0; i < 4; ++i) *(LAS v4u*)(tl + (r8 + 8 * i) * 144 + 16 * c8) = x[i];
                LDS_WAIT();
                unsigned wv[8];
#pragma unroll
                for (int t4 = 0; t4 < 8; ++t4) { const float a0 = bf2f(*(const LAS bf16*)(tl + (4 * t4) * 144 + 2 * l)), a1 = bf2f(*(const LAS bf16*)(tl + (4 * t4 + 1) * 144 + 2 * l)),
                                                             a2 = bf2f(*(const LAS bf16*)(tl + (4 * t4 + 2) * 144 + 2 * l)), a3 = bf2f(*(const LAS bf16*)(tl + (4 * t4 + 3) * 144 + 2 * l)); wv[t4] = pg8::pk4_fp8(a0, a1, a2, a3); }
                unsigned char* d = ws + (j == 3 ? R_VST : R_VWT) + (((size_t)bg * 64 + blk) * 64 + l) * 32;
#pragma unroll
                for (int q = 0; q < 2; ++q) { const v4u o = {wv[4 * q], wv[4 * q + 1], wv[4 * q + 2], wv[4 * q + 3]}; *(v4u*)(d + 16 * q) = o; }
                LDS_WAIT();
            }
        }
    }
}

__device__ __forceinline__ void p_cmp2(Ctx& C) {
    unsigned char* ws = C.ws;
    const bf16* Hk = (const bf16*)(ws + WS_HC); const bf16* Hv = Hk + (size_t)16384 * 256;
    const float* w2k = C.inp(I_CW2K); const float* w2v = C.inp(I_CW2V); const float* kn = C.inp(I_KN);
    LAS float* hk = (LAS float*)(C.lds + C.wave * 2048); LAS float* hv = hk + 256;
    const int l = C.lane, gw = C.bid * NWAVES + C.wave, NGW = C.G * NWAVES;
    for (int r = gw; r < 16384; r += NGW) {
        const int bg = r >> 7, c = r & 127;
        { const v2u a = *((const v2u*)(Hk + (size_t)r * 256) + l), bq = *((const v2u*)(Hv + (size_t)r * 256) + l);
          hk[4 * l] = bflo(a.x); hk[4 * l + 1] = bfhi(a.x); hk[4 * l + 2] = bflo(a.y); hk[4 * l + 3] = bfhi(a.y);
          hv[4 * l] = bflo(bq.x); hv[4 * l + 1] = bfhi(bq.x); hv[4 * l + 2] = bflo(bq.y); hv[4 * l + 3] = bfhi(bq.y); }
        LDS_WAIT();
        float ak = 0.f, av = 0.f;
#pragma unroll 8
        for (int j = 0; j < 256; ++j) { ak += hk[j] * w2k[j * 64 + l]; av += hv[j] * w2v[j * 64 + l]; }
        if (c == 127) { ak = 0.f; av = 0.f; }
        const float rs = rsqrtf(wave_sum(ak * ak) * (1.f / 64.f) + EPS);
        ((bf16*)(ws + WS_KC))[((size_t)bg * 128 + 32 * (c >> 5)) * 64 + (l >> 5) * 1024 + (c & 31) * 32 + (l & 31)] = (bf16)f2bf(ak * rs * kn[l]);
        ((bf16*)(ws + WS_VCT))[(((size_t)bg * 4 + (c >> 5)) * 64 + l) * 32 + (c & 31)] = (bf16)f2bf(av);
        LDS_WAIT();
    }
}

typedef short bf16x8v __attribute__((ext_vector_type(8)));
#define MFMA16(a, b, c) __builtin_amdgcn_mfma_f32_16x16x32_bf16((a), (b), (c), 0, 0, 0)
constexpr float LOG2E = 1.4426950408889634f;
__device__ __forceinline__ float xmax_q4(float v) {
    float t;
    asm volatile("v_mov_b32 %1, %0\n\ts_nop 1\n\tv_permlane16_swap_b32 %0, %1\n\ts_nop 1\n\tv_max_f32 %0, %0, %1\n\tv_mov_b32 %1, %0\n\ts_nop 1\n\tv_permlane32_swap_b32 %0, %1\n\ts_nop 1\n\tv_max_f32 %0, %0, %1" : "+v"(v), "=&v"(t));
    return v;
}
__device__ __forceinline__ f32x4 att_mma(bf16x8v a, bf16x8v b, f32x4 c) { return __builtin_amdgcn_mfma_f32_16x16x32_bf16(a, b, c, 0, 0, 0); }
__device__ __forceinline__ f32x4 att_mma(long a, long b, f32x4 c) { return __builtin_amdgcn_mfma_f32_16x16x32_fp8_fp8(a, b, c, 0, 0, 0); }
__device__ __forceinline__ void att_pack(bf16x8v& pf, const float (&p)[8], bool keep) {
    unsigned w0 = pg8::cvt_pk_bf16(p[0], p[1]), w1 = pg8::cvt_pk_bf16(p[2], p[3]), w2 = pg8::cvt_pk_bf16(p[4], p[5]), w3 = pg8::cvt_pk_bf16(p[6], p[7]);
    if (!keep) { w0 = 0u; w1 = 0u; w2 = 0u; w3 = 0u; }
    const v4u w = {w0, w1, w2, w3}; pf = __builtin_bit_cast(bf16x8v, w); }
__device__ __forceinline__ void att_pack(long& pf, const float (&p)[8], bool keep) {
    unsigned w0 = pg8::pk4_fp8(p[0], p[1], p[2], p[3]), w1 = pg8::pk4_fp8(p[4], p[5], p[6], p[7]);
    if (!keep) { w0 = 0u; w1 = 0u; }
    const v2u w = {w0, w1}; pf = __builtin_bit_cast(long, w); }
template <class FR> struct AttKV { FR ka[2], kb[2], vf[4]; };
template <class FR, bool NOPV>
__device__ __forceinline__ void attn_kv_load(AttKV<FR>& f, const void* __restrict__ Kb, unsigned koff, const void* __restrict__ Vb, unsigned voff, int k0) {
    constexpr int SH = sizeof(FR) == 16 ? 0 : 1;
    const char* kblk = (const char*)Kb + (((size_t)k0 * 128) >> SH); const char* vblk = (const char*)Vb + (((size_t)k0 * 128) >> SH);
#pragma unroll
    for (int ks = 0; ks < 2; ++ks) { f.ka[ks] = *(const FR*)(kblk + koff + ((2048 * ks) >> SH)); f.kb[ks] = *(const FR*)(kblk + koff + ((256 + 2048 * ks) >> SH)); }
    if (!NOPV) {
#pragma unroll
        for (int dt = 0; dt < 4; ++dt) f.vf[dt] = *(const FR*)(vblk + voff + ((1024 * dt) >> SH)); }
}
template <int MODE, int PATH, class FR, bool NOPV = false>
__device__ __forceinline__ void attn_step(const AttKV<FR>& f, int k0, int trel, bool tk, int cmax,
                                          const FR (&qf)[2][2], const f32x4 (&bv)[2], float (&m)[2], float (&ls)[2], f32x4 (&o)[2][4], const float (&sl2)[2], int q4) {
    constexpr int DMUL = (MODE == 0) ? 16 : 1;
    const float trelf = (float)trel;
    bool ok[8];
    if (PATH == 2) {
#pragma unroll
        for (int i = 0; i < 8; ++i) { const int kk = 8 * q4 + i; const int d = trel - DMUL * kk; ok[i] = (MODE == 0) ? (k0 + kk <= cmax) : (MODE == 1 ? (tk && d >= 0) : (d >= 0 && d < 512)); } }
#pragma unroll
    for (int h = 0; h < 2; ++h) {
        f32x4 sa = att_mma(f.ka[0], qf[h][0], bv[0] * ((float)DMUL * sl2[h])), sb = att_mma(f.kb[0], qf[h][0], bv[1] * ((float)DMUL * sl2[h])); sa = att_mma(f.ka[1], qf[h][1], sa); sb = att_mma(f.kb[1], qf[h][1], sb);
        float mref = m[h] + sl2[h] * trelf;
        float mx;
        if (PATH == 2) { mx = -1e30f;
#pragma unroll
            for (int i = 0; i < 8; ++i) { const float v = i < 4 ? sa[i] : sb[i - 4]; mx = ok[i] ? fmaxf(mx, v) : mx; } }
        else { mx = fmaxf(fmaxf(fmaxf(sa[0], sa[1]), fmaxf(sa[2], sa[3])), fmaxf(fmaxf(sb[0], sb[1]), fmaxf(sb[2], sb[3]))); if (PATH == 1) mx = tk ? mx : -1e30f; }
        mx = xmax_q4(mx);
        if (__any(mx > mref + 8.f)) { const float mn = fmaxf(mref, mx), alpha = __builtin_amdgcn_exp2f(mref - mn); m[h] = mn - sl2[h] * trelf; mref = mn; ls[h] *= alpha;
            if (!NOPV) {
#pragma unroll
                for (int dt = 0; dt < 4; ++dt) o[h][dt] = o[h][dt] * alpha; } }
        float p[8]; float psum = 0.f;
#pragma unroll
        for (int i = 0; i < 8; ++i) { const float e = __builtin_amdgcn_exp2f((i < 4 ? sa[i] : sb[i - 4]) - mref); p[i] = (PATH == 2) ? (ok[i] ? e : 0.f) : e; psum += p[i]; }
        if (PATH == 1) psum = tk ? psum : 0.f;
        ls[h] += psum;
        FR pf; att_pack(pf, p, PATH == 1 ? tk : true);
        if (!NOPV) {
#pragma unroll
            for (int dt = 0; dt < 4; ++dt) o[h][dt] = att_mma(f.vf[dt], pf, o[h][dt]); }
    }
}
constexpr int PSW = 132;
__device__ __forceinline__ void p_attn_fast(Ctx& C, unsigned* queue, const int ld, const int qo, const float* qn) {
    unsigned char* ws = C.ws;
    const bf16* Qraw = (const bf16*)(ws + R_QKV);
    const bf16* KC = (const bf16*)(ws + WS_KC); const bf16* VCT = (const bf16*)(ws + WS_VCT);
    const unsigned char* KS = ws + R_KS; const unsigned char* VST = ws + R_VST; const unsigned char* KW = ws + R_KW; const unsigned char* VWT = ws + R_VWT;
    bf16* O = (bf16*)(ws + R_O);
    LAS float* psl = (LAS float*)(C.lds + C.wave * (16 * PSW * 4));
    int qsel = (int)(xb_xcc_id() & 7u), qtry = 0;
    for (;;) {
        int l = C.lane; asm volatile("" : "+v"(l));
        const int r16 = l & 15, q4 = l >> 4;
        const unsigned koff = (unsigned)((8 * (r16 >> 2) + (r16 & 3)) * 64 + 16 * q4), voff = (unsigned)((r16 * 32 + 8 * q4) * 2);
        unsigned u = 0; if (l == 0) u = __hip_atomic_fetch_add(queue + 64 * qsel, 1u, __ATOMIC_RELAXED, __HIP_MEMORY_SCOPE_AGENT);
        u = (unsigned)__builtin_amdgcn_readfirstlane((int)u);
        if (u >= 2048u) { if (++qtry >= 8) break; qsel = (qsel + 1) & 7; continue; }
        u = ((u >> 7) * 8 + (unsigned)qsel) * 128 + (u & 127);
        const int bg = (int)(u >> 7), tile = 127 - (int)(u & 127), g = bg & 3, b = bg >> 2, t0 = tile * 16, t = t0 + r16, row = b * SEQ + t;
#define qrow (Qraw + (size_t)row * ld + qo)
#define gtp (qrow + 1024 + g * 12)
#define orow (O + (size_t)row * DM + g * 256 + 4 * q4)
        bf16x8v qf[2][2]; long qf8[2][2]; float sl2[2]; f32x4 bv[2]; float m[2]; float ls[2]; f32x4 o[2][4];
#define ATT_LOADQ(hp, DM_) do { _Pragma("unroll") for (int i_ = 0; i_ < 4; ++i_) { bv[0][i_] = (float)(8 * q4 + i_); bv[1][i_] = (float)(8 * q4 + 4 + i_); } \
            _Pragma("unroll") for (int h = 0; h < 2; ++h) { sl2[h] = exp2f(-0.5f * (float)(g * 4 + 2 * (hp) + h + 1)) * LOG2E; \
            float xq_[2][8]; float ssq_ = 0.f; \
            _Pragma("unroll") for (int ks = 0; ks < 2; ++ks) { const v4u r_ = *(const v4u*)(qrow + (g * 4 + 2 * (hp) + h) * 64 + 32 * ks + 8 * q4); \
                xq_[ks][0] = bflo(r_.x); xq_[ks][1] = bfhi(r_.x); xq_[ks][2] = bflo(r_.y); xq_[ks][3] = bfhi(r_.y); xq_[ks][4] = bflo(r_.z); xq_[ks][5] = bfhi(r_.z); xq_[ks][6] = bflo(r_.w); xq_[ks][7] = bfhi(r_.w); \
                _Pragma("unroll") for (int j_ = 0; j_ < 8; ++j_) ssq_ += xq_[ks][j_] * xq_[ks][j_]; } \
            ssq_ += __shfl_xor(ssq_, 16); ssq_ += __shfl_xor(ssq_, 32); \
            const float rq_ = rsqrtf(ssq_ * (1.f / 64.f) + EPS) * (0.125f * LOG2E); \
            _Pragma("unroll") for (int ks = 0; ks < 2; ++ks) { const f32x4 ga_ = *(const f32x4*)(qn + 32 * ks + 8 * q4), gb_ = *(const f32x4*)(qn + 32 * ks + 8 * q4 + 4); \
                const v4u w_ = {pg8::cvt_pk_bf16(xq_[ks][0] * rq_ * ga_.x, xq_[ks][1] * rq_ * ga_.y), pg8::cvt_pk_bf16(xq_[ks][2] * rq_ * ga_.z, xq_[ks][3] * rq_ * ga_.w), \
                                pg8::cvt_pk_bf16(xq_[ks][4] * rq_ * gb_.x, xq_[ks][5] * rq_ * gb_.y), pg8::cvt_pk_bf16(xq_[ks][6] * rq_ * gb_.z, xq_[ks][7] * rq_ * gb_.w)}; \
                qf[h][ks] = __builtin_bit_cast(bf16x8v, w_); \
                const v2u w8_ = {pg8::pk4_fp8(xq_[ks][0] * rq_ * ga_.x, xq_[ks][1] * rq_ * ga_.y, xq_[ks][2] * rq_ * ga_.z, xq_[ks][3] * rq_ * ga_.w), pg8::pk4_fp8(xq_[ks][4] * rq_ * gb_.x, xq_[ks][5] * rq_ * gb_.y, xq_[ks][6] * rq_ * gb_.z, xq_[ks][7] * rq_ * gb_.w)}; \
                qf8[h][ks] = __builtin_bit_cast(long, w8_); } } } while (0)
#define ATT_RESET() do { _Pragma("unroll") for (int h = 0; h < 2; ++h) { m[h] = -1e30f; ls[h] = 0.f; _Pragma("unroll") for (int dt = 0; dt < 4; ++dt) o[h][dt] = (f32x4){0.f, 0.f, 0.f, 0.f}; } } while (0)
        const int cmax = t >= 31 ? (((t - 31) >> 4) < 126 ? ((t - 31) >> 4) : 126) : -1;
        const int cmax0 = t0 >= 31 ? (((t0 - 31) >> 4) < 126 ? ((t0 - 31) >> 4) : 126) : -1;
        const bf16* KCb = KC + (size_t)bg * 128 * 64; const bf16* VCb = VCT + (size_t)bg * 128 * 64;
        const int ncs = ((t0 + 15 - 31) >> 4) < 0 ? 0 : ((((t0 + 15 - 31) >> 4) < 126 ? ((t0 + 15 - 31) >> 4) : 126) >> 5) + 1;
#pragma unroll 1
        for (int hp = 0; hp < 2; ++hp) {
            ATT_LOADQ(hp, 16); ATT_RESET();
            for (int st = ncs - 1; st >= 0; --st) {
                AttKV<bf16x8v> fc; attn_kv_load<bf16x8v, true>(fc, KCb, koff, VCb, voff, 32 * st);
                if (32 * st + 31 <= cmax0) attn_step<0, 0, bf16x8v, true>(fc, 32 * st, t - 31 - 16 * 32 * st, true, cmax, qf, bv, m, ls, o, sl2, q4);
                else attn_step<0, 2, bf16x8v, true>(fc, 32 * st, t - 31 - 16 * 32 * st, true, cmax, qf, bv, m, ls, o, sl2, q4); }
#pragma unroll
            for (int h = 0; h < 2; ++h) { float lt = ls[h]; lt += __shfl_xor(lt, 16); lt += __shfl_xor(lt, 32); ls[h] = lt; }
            float ps[4][8];
#pragma unroll
            for (int st = 0; st < 4; ++st)
#pragma unroll
                for (int i = 0; i < 8; ++i) ps[st][i] = 0.f;
#pragma unroll
            for (int st = 0; st < 4; ++st) {
                if (st < ncs) {
                    const int k0 = 32 * st; const char* kblk = (const char*)(KCb + (size_t)k0 * 64);
                    bf16x8v ka[2], kb[2];
#pragma unroll
                    for (int ks = 0; ks < 2; ++ks) { ka[ks] = *(const bf16x8v*)(kblk + koff + 2048 * ks); kb[ks] = *(const bf16x8v*)(kblk + koff + 256 + 2048 * ks); }
#pragma unroll
                    for (int h = 0; h < 2; ++h) {
                        f32x4 sa = MFMA16(ka[0], qf[h][0], bv[0] * (16.f * sl2[h])), sb = MFMA16(kb[0], qf[h][0], bv[1] * (16.f * sl2[h])); sa = MFMA16(ka[1], qf[h][1], sa); sb = MFMA16(kb[1], qf[h][1], sb);
                        const float lt = ls[h], inv = lt > 0.f ? 1.f / lt : 0.f, mref = m[h] + sl2[h] * (float)(t - 31 - 16 * k0);
#pragma unroll
                        for (int i = 0; i < 8; ++i) { const int c = k0 + 8 * q4 + i; ps[st][i] += (c <= cmax) ? __builtin_amdgcn_exp2f((i < 4 ? sa[i] : sb[i - 4]) - mref) * inv : 0.f; }
                    }
                }
            }
#pragma unroll
            for (int st = 0; st < 4; ++st) { LAS f32x4* p0 = (LAS f32x4*)(psl + r16 * PSW + 32 * st + 8 * q4);
                f32x4 a = {ps[st][0], ps[st][1], ps[st][2], ps[st][3]}, bq = {ps[st][4], ps[st][5], ps[st][6], ps[st][7]};
                if (hp) { a = a + p0[0]; bq = bq + p0[1]; }
                p0[0] = a; p0[1] = bq; }
            LDS_WAIT();
        }
        unsigned mlo, mhi;
        {
            float sc[16]; const LAS float* pr = psl + r16 * PSW + 32 * q4; const int cur = t >> 5;
            float prev = q4 > 0 ? pr[-1] : 0.f;
#pragma unroll
            for (int jj = 0; jj < 16; ++jj) { const float a = pr[2 * jj], bq = pr[2 * jj + 1]; const float imp = prev + a + bq; prev = bq;
                const int j = 16 * q4 + jj; const bool valid = 32 * j <= t; const bool forced = valid && (j == 0 || j == cur || j == cur - 1);
                sc[jj] = forced ? 1e9f : (valid ? imp : -1e9f); }
            unsigned my = 0u;
#pragma unroll 1
            for (int r = 0; r < 8; ++r) {
                float best = sc[0]; int bi = 0;
#pragma unroll
                for (int jj = 1; jj < 16; ++jj) if (sc[jj] > best) { best = sc[jj]; bi = jj; }
                bi += 16 * q4;
#pragma unroll
                for (int sh = 16; sh <= 32; sh <<= 1) { const float ov = __shfl_xor(best, sh); const int oi = __shfl_xor(bi, sh); if (ov > best || (ov == best && oi < bi)) { best = ov; bi = oi; } }
                if ((bi >> 4) == q4) { const int jj0 = bi & 15; if (best > -0.5e9f) my |= 1u << jj0;
#pragma unroll
                    for (int jj = 0; jj < 16; ++jj) if (jj == jj0) sc[jj] = -INFINITY; }
            }
            mlo = (q4 == 0 ? my : 0u) | (q4 == 1 ? my << 16 : 0u); mhi = (q4 == 2 ? my : 0u) | (q4 == 3 ? my << 16 : 0u);
            mlo |= __shfl_xor(mlo, 16); mlo |= __shfl_xor(mlo, 32); mhi |= __shfl_xor(mhi, 16); mhi |= __shfl_xor(mhi, 32);
        }
        LDS_WAIT();
        unsigned ulo = mlo, uhi = mhi;
#pragma unroll
        for (int sh = 1; sh <= 8; sh <<= 1) { ulo |= __shfl_xor(ulo, sh); uhi |= __shfl_xor(uhi, sh); }
        const unsigned long long un0 = ((unsigned long long)(unsigned)__builtin_amdgcn_readfirstlane((int)uhi) << 32) | (unsigned)__builtin_amdgcn_readfirstlane((int)ulo);
        const unsigned long long mine = ((unsigned long long)mhi << 32) | mlo;
#pragma unroll 1
        for (int hp = 0; hp < 2; ++hp) {
            const v2u g6raw = *(const v2u*)(gtp + 6 * hp); const unsigned g6x = gtp[6 * hp + 4], g6y = gtp[6 * hp + 5];
            v2u oacc[2][4];
#define ATT_GLOG(i) ((i) == 0 ? bflo(g6raw.x) : (i) == 1 ? bfhi(g6raw.x) : (i) == 2 ? bflo(g6raw.y) : (i) == 3 ? bfhi(g6raw.y) : (i) == 4 ? bf2f(g6x) : bf2f(g6y))
#define ATT_FOLD(br, first) do { _Pragma("unroll") for (int h = 0; h < 2; ++h) { float lt = ls[h]; lt += __shfl_xor(lt, 16); lt += __shfl_xor(lt, 32); const float sc_ = lt > 0.f ? (1.f / (1.f + __expf(-ATT_GLOG(h * 3 + (br))))) / lt : 0.f; \
            _Pragma("unroll") for (int dt = 0; dt < 4; ++dt) { f32x4 r_ = o[h][dt] * sc_; \
                if (!(first)) { r_[0] += bflo(oacc[h][dt].x); r_[1] += bfhi(oacc[h][dt].x); r_[2] += bflo(oacc[h][dt].y); r_[3] += bfhi(oacc[h][dt].y); } \
                oacc[h][dt].x = pg8::cvt_pk_bf16(r_[0], r_[1]); oacc[h][dt].y = pg8::cvt_pk_bf16(r_[2], r_[3]); } } } while (0)
            ATT_LOADQ(hp, 16); ATT_RESET();
            for (int st = ncs - 1; st >= 0; --st) {
                AttKV<bf16x8v> fc; attn_kv_load<bf16x8v, false>(fc, KCb, koff, VCb, voff, 32 * st);
                if (32 * st + 31 <= cmax0) attn_step<0, 0, bf16x8v>(fc, 32 * st, t - 31 - 16 * 32 * st, true, cmax, qf, bv, m, ls, o, sl2, q4);
                else attn_step<0, 2, bf16x8v>(fc, 32 * st, t - 31 - 16 * 32 * st, true, cmax, qf, bv, m, ls, o, sl2, q4); }
            ATT_FOLD(0, true);
            {
                const unsigned char* Kb = KS + (size_t)bg * SEQ * 64; const unsigned char* Vb = VST + (size_t)bg * SEQ * 64;
                ATT_RESET();
                unsigned long long un = un0;
                const int cur0 = t0 >> 5;
                AttKV<long> fn; int jn = 63 - __builtin_clzll(un); un &= ~(1ull << jn); attn_kv_load<long, false>(fn, Kb, koff >> 1, Vb, voff >> 1, 32 * jn);
#pragma unroll 1
                for (;;) { const int j = jn; const AttKV<long> fc = fn; const bool more = un != 0ull;
                    if (more) { jn = 63 - __builtin_clzll(un); un &= ~(1ull << jn); }
                    attn_kv_load<long, false>(fn, Kb, koff >> 1, Vb, voff >> 1, 32 * jn);
                    const bool tk = ((mine >> j) & 1ull) != 0ull;
                    if (j >= cur0) attn_step<1, 2, long>(fc, 32 * j, t - 32 * j, tk, 0, qf8, bv, m, ls, o, sl2, q4);
                    else if (__all(tk)) attn_step<1, 0, long>(fc, 32 * j, t - 32 * j, true, 0, qf8, bv, m, ls, o, sl2, q4);
                    else attn_step<1, 1, long>(fc, 32 * j, t - 32 * j, tk, 0, qf8, bv, m, ls, o, sl2, q4);
                    if (!more) break; }
                ATT_FOLD(1, false);
            }
            {
                const unsigned char* Kb = KW + (size_t)bg * SEQ * 64; const unsigned char* Vb = VWT + (size_t)bg * SEQ * 64;
                const int sb = t0 >= 511 ? (t0 - 511) >> 5 : 0, se = t0 >> 5;
                ATT_RESET();
                AttKV<long> fn; attn_kv_load<long, false>(fn, Kb, koff >> 1, Vb, voff >> 1, 32 * se);
#pragma unroll 1
                for (int st = se; st >= sb; --st) { const AttKV<long> fc = fn;
                    attn_kv_load<long, false>(fn, Kb, koff >> 1, Vb, voff >> 1, 32 * (st > sb ? st - 1 : st));
                    if (32 * st + 31 <= t0 && 32 * st > t0 - 497) attn_step<2, 0, long>(fc, 32 * st, t - 32 * st, true, 0, qf8, bv, m, ls, o, sl2, q4);
                    else attn_step<2, 2, long>(fc, 32 * st, t - 32 * st, true, 0, qf8, bv, m, ls, o, sl2, q4); }
                ATT_FOLD(2, false);
            }
#pragma unroll
            for (int h = 0; h < 2; ++h)
#pragma unroll
                for (int dt = 0; dt < 4; ++dt) *(v2u*)(orow + (2 * hp + h) * 64 + 16 * dt) = oacc[h][dt];
        }
#undef ATT_FOLD
#undef ATT_GLOG
#undef ATT_LOADQ
#undef ATT_RESET
#undef qrow
#undef gtp
#undef orow
    }
}

constexpr int SCQ = 272, SCT = 144;
constexpr int LQ_ = 0, LK_ = 17408, LKT_ = 34816, LVT_ = 53248, LP_ = 71680, LO_ = 80896, LE_ = 114688, LT_ = 115712;
__device__ __forceinline__ void p_scan_fast(Ctx& C, int layer) {
    unsigned char* ws = C.ws;
    const bf16* Pq = (const bf16*)(ws + R_PQ); const bf16* Pi = (const bf16*)(ws + R_PI); const bf16* Pg = (const bf16*)(ws + R_PG); const float* LF = (const float*)(ws + R_LF);
    bf16* O2 = (bf16*)(ws + R_O2);
    const float* gn = C.inp(I_HGN) + layer * 128;
    LAS unsigned char* L = C.lds;
    const int tid = C.tid, lane = C.lane, w = C.wave, r16 = lane & 15, q4 = lane >> 4, k = tid & 127, seg = tid >> 7;
    LAS float* tot = (LAS float*)(L + LT_); LAS float* eref = (LAS float*)(L + LE_); LAS float* elr = eref + 128;
    { const int tile = tid >> 8, e = tid & 255, row = e >> 4, col = e & 15;
      *(LAS bf16*)(L + LP_ + ((tile ? 32 : 0) + row) * SCT + ((tile ? 48 : 16) + col) * 2) = 0; }
    for (int bh = C.bid; bh < 256; bh += C.G) {
        const int b = bh >> 3, h = bh & 7;
        const size_t base = (size_t)(b * SEQ) * DM + h * 128;
        f32x4 S[8];
#pragma unroll
        for (int i = 0; i < 8; ++i) S[i] = (f32x4){0.f, 0.f, 0.f, 0.f};
        bf16 qv[16], vv[16]; float lf[16];
#define SC_LOAD(t0) do { _Pragma("unroll") for (int i = 0; i < 16; ++i) { const size_t off = base + (size_t)((t0) + 16 * seg + i) * DM + k; qv[i] = Pq[off]; vv[i] = Pi[off]; lf[i] = LF[off]; } } while (0)
        SC_LOAD(0);
#pragma unroll 1
        for (int c = 0; c < SEQ / 64; ++c) {
            const int t0 = c * 64;
            float cs[16]; { float run = 0.f;
#pragma unroll
                for (int i = 0; i < 16; ++i) { run += lf[i]; cs[i] = run; }
                tot[seg * 128 + k] = run; }
            __syncthreads();
            { const float a0 = tot[k], a1 = tot[128 + k], a2 = tot[256 + k], a3 = tot[384 + k];
              const float off = seg == 0 ? 0.f : (seg == 1 ? a0 : (seg == 2 ? a0 + a1 : a0 + a1 + a2)), ref = a0 + a1, last = ref + a2 + a3;
              unsigned kt[16];
#pragma unroll
              for (int i = 0; i < 16; ++i) { const float d = off + cs[i] - ref; const float qt = bf2f(qv[i]) * __expf(fminf(d, 80.f)), ktv = (1.f - __expf(lf[i])) * __expf(fminf(-d, 80.f));
                  const int s = 16 * seg + i; kt[i] = f2bf(ktv);
                  *(LAS bf16*)(L + LQ_ + s * SCQ + k * 2) = (bf16)f2bf(qt); *(LAS bf16*)(L + LK_ + s * SCQ + k * 2) = (bf16)kt[i]; }
              v4u w0, w1, x0, x1;
              w0.x = kt[0] | (kt[1] << 16); w0.y = kt[2] | (kt[3] << 16); w0.z = kt[4] | (kt[5] << 16); w0.w = kt[6] | (kt[7] << 16);
              w1.x = kt[8] | (kt[9] << 16); w1.y = kt[10] | (kt[11] << 16); w1.z = kt[12] | (kt[13] << 16); w1.w = kt[14] | (kt[15] << 16);
              x0.x = vv[0] | ((unsigned)vv[1] << 16); x0.y = vv[2] | ((unsigned)vv[3] << 16); x0.z = vv[4] | ((unsigned)vv[5] << 16); x0.w = vv[6] | ((unsigned)vv[7] << 16);
              x1.x = vv[8] | ((unsigned)vv[9] << 16); x1.y = vv[10] | ((unsigned)vv[11] << 16); x1.z = vv[12] | ((unsigned)vv[13] << 16); x1.w = vv[14] | ((unsigned)vv[15] << 16);
              *(LAS v4u*)(L + LKT_ + k * SCT + seg * 32) = w0; *(LAS v4u*)(L + LKT_ + k * SCT + seg * 32 + 16) = w1;
              *(LAS v4u*)(L + LVT_ + k * SCT + seg * 32) = x0; *(LAS v4u*)(L + LVT_ + k * SCT + seg * 32 + 16) = x1;
              if (seg == 0) { eref[k] = __expf(ref); elr[k] = __expf(last - ref); } }
            __syncthreads();
            if (c + 1 < SEQ / 64) SC_LOAD(t0 + 64);
#pragma unroll 1
            for (int ti = w; ti < 10; ti += 8) {
                const int rt = ti < 1 ? 0 : (ti < 3 ? 1 : (ti < 6 ? 2 : 3)), ct = ti - (rt * (rt + 1)) / 2;
                f32x4 acc = {0.f, 0.f, 0.f, 0.f};
#pragma unroll
                for (int p = 0; p < 4; ++p) { const bf16x8v a = *(const LAS bf16x8v*)(L + LQ_ + (16 * rt + r16) * SCQ + (32 * p + 8 * q4) * 2), bq = *(const LAS bf16x8v*)(L + LK_ + (16 * ct + r16) * SCQ + (32 * p + 8 * q4) * 2);
                    acc = MFMA16(a, bq, acc); }
#pragma unroll
                for (int i = 0; i < 4; ++i) { const int t = 16 * rt + 4 * q4 + i, s = 16 * ct + r16; *(LAS bf16*)(L + LP_ + t * SCT + s * 2) = (bf16)f2bf(s <= t ? acc[i] : 0.f); }
            }
            __syncthreads();
            bf16x8v sfrag[4]; f32x4 e8[4][2];
#pragma unroll
            for (int p = 0; p < 4; ++p) { e8[p][0] = *(const LAS f32x4*)(eref + 32 * p + 8 * q4); e8[p][1] = *(const LAS f32x4*)(eref + 32 * p + 8 * q4 + 4);
                S[2 * p] = S[2 * p] * e8[p][0]; S[2 * p + 1] = S[2 * p + 1] * e8[p][1];
                const v4u wv = {pg8::cvt_pk_bf16(S[2 * p][0], S[2 * p][1]), pg8::cvt_pk_bf16(S[2 * p][2], S[2 * p][3]), pg8::cvt_pk_bf16(S[2 * p + 1][0], S[2 * p + 1][1]), pg8::cvt_pk_bf16(S[2 * p + 1][2], S[2 * p + 1][3])};
                sfrag[p] = __builtin_bit_cast(bf16x8v, wv); }
            bf16x8v vfr[2];
#pragma unroll
            for (int ss = 0; ss < 2; ++ss) vfr[ss] = *(const LAS bf16x8v*)(L + LVT_ + (16 * w + r16) * SCT + (32 * ss + 8 * q4) * 2);
#pragma unroll
            for (int rt = 0; rt < 4; ++rt) { f32x4 o = {0.f, 0.f, 0.f, 0.f};
#pragma unroll
                for (int p = 0; p < 4; ++p) { const bf16x8v a = *(const LAS bf16x8v*)(L + LQ_ + (16 * rt + r16) * SCQ + (32 * p + 8 * q4) * 2); o = MFMA16(a, sfrag[p], o); }
#pragma unroll
                for (int ss = 0; ss < 2; ++ss) if (ss <= rt / 2) { const bf16x8v a = *(const LAS bf16x8v*)(L + LP_ + (16 * rt + r16) * SCT + (32 * ss + 8 * q4) * 2); o = MFMA16(a, vfr[ss], o); }
#pragma unroll
                for (int i = 0; i < 4; ++i) *(LAS float*)(L + LO_ + (16 * rt + 4 * q4 + i) * 528 + (16 * w + r16) * 4) = o[i]; }
#pragma unroll
            for (int p = 0; p < 4; ++p)
#pragma unroll
                for (int ab = 0; ab < 2; ++ab) { const int krow = 32 * p + 8 * (r16 >> 2) + (r16 & 3) + 4 * ab;
#pragma unroll
                    for (int ss = 0; ss < 2; ++ss) { const bf16x8v a = *(const LAS bf16x8v*)(L + LKT_ + krow * SCT + (32 * ss + 8 * q4) * 2); S[2 * p + ab] = MFMA16(a, vfr[ss], S[2 * p + ab]); } }
#pragma unroll
            for (int p = 0; p < 4; ++p) { const f32x4 l0 = *(const LAS f32x4*)(elr + 32 * p + 8 * q4), l1 = *(const LAS f32x4*)(elr + 32 * p + 8 * q4 + 4); S[2 * p] = S[2 * p] * l0; S[2 * p + 1] = S[2 * p + 1] * l1; }
            __syncthreads();
#pragma unroll
            for (int rep = 0; rep < 2; ++rep) { const int tok = (tid >> 4) + 32 * rep, part = tid & 15;
                const f32x4 oa = *(const LAS f32x4*)(L + LO_ + tok * 528 + part * 32), ob = *(const LAS f32x4*)(L + LO_ + tok * 528 + part * 32 + 16);
                float ss = (oa.x * oa.x + oa.y * oa.y) + (oa.z * oa.z + oa.w * oa.w) + (ob.x * ob.x + ob.y * ob.y) + (ob.z * ob.z + ob.w * ob.w);
                ss += __shfl_xor(ss, 1); ss += __shfl_xor(ss, 2); ss += __shfl_xor(ss, 4); ss += __shfl_xor(ss, 8);
                const float rstd = rsqrtf(ss * (1.f / 128.f) + EPS);
                const size_t off = base + (size_t)(t0 + tok) * DM + part * 8; const v4u g8 = *(const v4u*)(Pg + off);
                const f32x4 ga = *(const f32x4*)(gn + part * 8), gb = *(const f32x4*)(gn + part * 8 + 4);
                v4u wv; wv.x = pk2(oa.x * rstd * ga.x * bflo(g8.x), oa.y * rstd * ga.y * bfhi(g8.x)); wv.y = pk2(oa.z * rstd * ga.z * bflo(g8.y), oa.w * rstd * ga.w * bfhi(g8.y));
                wv.z = pk2(ob.x * rstd * gb.x * bflo(g8.z), ob.y * rstd * gb.y * bfhi(g8.z)); wv.w = pk2(ob.z * rstd * gb.z * bflo(g8.w), ob.w * rstd * gb.w * bfhi(g8.w));
                *(v4u*)(O2 + off) = wv; }
        }
#undef SC_LOAD
        __syncthreads();
    }
}

#define PH_BEGIN { const bool run_ = (pid >= lo && pid < hi); ++pid; if (run_) { { int ln_; asm volatile("v_mbcnt_lo_u32_b32 %0, -1, 0\n\tv_mbcnt_hi_u32_b32 %0, -1, %0" : "=v"(ln_)); C.lane = ln_; C.tid = C.wave * 64 + ln_; }
#define PH_END   if (pid < hi) xcd_barrier(bar); } }
#define XN ((const bf16*)(ws + WS_XN))
#define RTAB ((const int*)(ws + WS_RTAB))

template <int L>
__device__ __forceinline__ void run_layer(Ctx& C, const XcdBarrier& bar, int& pid, const int lo, const int hi, PG8_LAS unsigned char* ring) {
    unsigned char* const ws = C.ws;

        const int li = L >> 1;
        if (L < 2) {
            PH_BEGIN { pg8::Gemm g{XN, (const bf16*)(ws + W_HIN) + (size_t)L * 4096 * 1024, 1024, 1024, 0}; pg8::GenOrder S; S.init(256, 16, C.G, C.bid, nullptr);
                pg8::EpiHgrnIn E{ws, L};
                pg8::gemm_phase<pg8::EpiHgrnIn, pg8::GenOrder, true, true>(ring, g, S, E, C.wave); } PH_END
            PH_BEGIN p_scan_fast(C, L); PH_END
        } else {
            PH_BEGIN { const bool first = (L == 2); pg8::Gemm g{XN, (const bf16*)(ws + (first ? W_KVQ : W_Q3)), 1024, 1024, 0}; pg8::GenOrder S; S.init(256, first ? 11 : 5, C.G, C.bid, nullptr);
                pg8::EpiBf16 E{(bf16*)(ws + R_QKV), first ? 2816 : 1280, nullptr, 0, 0, 1.f};
                pg8::gemm_phase<pg8::EpiBf16, pg8::GenOrder, true, true>(ring, g, S, E, C.wave); } PH_END
            if (L == 2) {
                PH_BEGIN p_post_kv(C); PH_END
                PH_BEGIN { pg8::Gemm g{(const bf16*)(ws + R_KCR), (const bf16*)(ws + W_CMP1), 2048, 1024, (size_t)256 * 2048 * 2}; pg8::GenOrder S; S.init(128, 1, C.G, C.bid, RTAB + 2048);
                    pg8::EpiBf16 E{(bf16*)(ws + WS_HC), 256, (const float*)(ws + WS_CB), 1, 256, 1.f};
                    pg8::gemm_phase<pg8::EpiBf16, pg8::GenOrder, true, true>(ring, g, S, E, C.wave); } PH_END
                PH_BEGIN p_cmp2(C); PH_END
            }
            PH_BEGIN p_attn_fast(C, (unsigned*)(ws + WS_CTL) + 8192 + 2048 * (L - 2), L == 2 ? 2816 : 1280, L == 2 ? 1536 : 0, C.inp(I_NQN) + (L - 2) * 64); PH_END
        }
        PH_BEGIN { pg8::Gemm g{(const bf16*)(ws + (L < 2 ? R_O2 : R_O)), (const bf16*)(ws + (L < 2 ? W_HOUT : W_NOUT)) + (size_t)(L & 1) * 1024 * 1024, 1024, 1024, 0};
            pg8::GenOrder S; S.init(256, 4, C.G, C.bid, nullptr);
            pg8::EpiRes E{L == 0 ? C.inp(I_X) : C.out, C.out, 1024, 1.f};
            pg8::gemm_phase<pg8::EpiRes, pg8::GenOrder, true, true>(ring, g, S, E, C.wave); } PH_END
        PH_BEGIN { if (L & 1) p_norm<false, true, true, true>(C, C.inp(I_MR) + (size_t)li * 1024 * 8, C.inp(I_NFFN) + L * 1024); else if (L == 2) p_norm<false, false, true, true>(C, nullptr, nullptr); else p_norm<false, false, true, false>(C, nullptr, nullptr); } PH_END
        if (L & 1) { PH_BEGIN p_gather(C); PH_END }
        if (L == 0) {
            PH_BEGIN { pg8::Gemm g{XN, (const bf16*)(ws + W_FGU), 1024, 1024, 0};
                pg8::GenOrder S; S.init(256, 22, C.G, C.bid, nullptr);
                pg8::EpiSwiGLU E{(bf16*)(ws + R_HF), DFF};
                pg8::gemm_phase<pg8::EpiSwiGLU, pg8::GenOrder, true, true>(ring, g, S, E, C.wave); } PH_END
            PH_BEGIN { pg8::Gemm g{(const bf16*)(ws + R_HF), (const bf16*)(ws + W_FDN), DFF, DFF, 0}; pg8::GenOrder S; S.init(256, 4, C.G, C.bid, nullptr);
                pg8::EpiRes E{C.out, C.out, 1024, 1.f};
                pg8::gemm_phase<pg8::EpiRes, pg8::GenOrder, true, true>(ring, g, S, E, C.wave); } PH_END
            PH_BEGIN p_norm<false, false, true>(C, nullptr, nullptr); PH_END
        } else {
        PH_BEGIN { const bool moe = (L & 1) != 0;
            pg8::Gemm g{(const bf16*)(ws + (moe ? R_XP : WS_XN)), (const bf16*)(ws + (moe ? W_MGU + (size_t)li * 8 * 2 * DFE * 1024 : W_FGU + (size_t)li * 2 * DFF * 2048)), 512, 512, moe ? (size_t)2 * DFE * 1024 : 0};
            pg8::GenOrder S; S.init(moe ? RTAB[1024] : 256, moe ? 28 : 22, C.G, C.bid, moe ? RTAB : nullptr);
            pg8::EpiSwiGLU8 E{ws + (moe ? R_HM : R_HF), moe ? DFE : DFF};
            pg8::gemm_phase<pg8::EpiSwiGLU8, pg8::GenOrder, true, true, true>(ring, g, S, E, C.wave); } PH_END
        if (!(L & 1)) {
            PH_BEGIN { pg8::Gemm g{(const bf16*)(ws + R_HF), (const bf16*)(ws + W_FDN + (size_t)li * 1024 * DFF * 2), DFF / 2, DFF / 2, 0}; pg8::GenOrder S; S.init(256, 4, C.G, C.bid, nullptr);
                pg8::EpiRes E{C.out, C.out, 1024, 1.f / (pg8::FP8_SH * pg8::FP8_SW2)};
                pg8::gemm_phase<pg8::EpiRes, pg8::GenOrder, true, true, true>(ring, g, S, E, C.wave); } PH_END
            PH_BEGIN p_norm<false, false, true>(C, nullptr, nullptr); PH_END
        } else {
            PH_BEGIN { pg8::Gemm g{(const bf16*)(ws + R_HM), (const bf16*)(ws + W_MDN + (size_t)li * 8 * 1024 * DFE), DFE / 2, DFE / 2, (size_t)1024 * DFE}; pg8::GenOrder S; S.init(RTAB[1024], 4, C.G, C.bid, RTAB);
                pg8::EpiBf16 E{(bf16*)(ws + R_XP), 1024, nullptr, 0, 0, 1.f / (pg8::FP8_SH * pg8::FP8_SW2)};
                pg8::gemm_phase<pg8::EpiBf16, pg8::GenOrder, true, true, true>(ring, g, S, E, C.wave); } PH_END
            PH_BEGIN { if (L == 1) p_norm<true, false, true>(C, nullptr, nullptr); else p_norm<true, false, false>(C, nullptr, nullptr); } PH_END
        }
        }
    }

struct Args { const float* in[24]; float* out; unsigned char* ws; int ph_lo, ph_hi; };
constexpr int N_PHASES = 34;

__global__ void __launch_bounds__(NWAVES * 64, 2) yoco_fwd(Args args) {
    extern __shared__ __attribute__((aligned(16))) unsigned char lds_raw[];
    Ctx C;
    C.lds = (LAS unsigned char*)lds_raw;
    C.wave = __builtin_amdgcn_readfirstlane((int)(threadIdx.x >> 6)); C.tid = threadIdx.x; C.lane = C.tid & 63;
    C.G = gridDim.x; C.bid = blockIdx.x;
    C.out = args.out; C.ws = args.ws;
    unsigned char* const ws = args.ws;
    volatile LAS unsigned* MISC = (volatile LAS unsigned*)(C.lds + MISC_OFF);
    if (C.tid < 32) MISC[C.tid] = 0u;
    __syncthreads();
    XcdBarrier bar = xcd_barrier_post((unsigned*)(ws + WS_CTL) + 4096, MISC + 8);
    const int lo = args.ph_lo, hi = args.ph_hi;
    int pid = 0;
    PG8_LAS unsigned char* ring = (PG8_LAS unsigned char*)lds_raw;
    PH_BEGIN p_prologue(C); PH_END

    run_layer<0>(C, bar, pid, lo, hi, ring); run_layer<1>(C, bar, pid, lo, hi, ring); run_layer<2>(C, bar, pid, lo, hi, ring); run_layer<3>(C, bar, pid, lo, hi, ring);
#undef PH_BEGIN
#undef PH_END
#undef XN
#undef RTAB
}

extern "C" void kernel_launch(void* const* d_in, const int* in_sizes, int n_in, void* d_out, int out_size, void* d_ws, size_t ws_size, hipStream_t stream) {
    static int grid = 0;
    if (grid == 0) {
        if (n_in != 24 || in_sizes[0] != NT * DM || out_size != NT * DM || ws_size < WS_NEED) { fprintf(stderr, "kernel_launch: unexpected shapes / workspace (n_in %d, ws %zu, need %zu)\n", n_in, ws_size, (size_t)WS_NEED); grid = -1; return; }
        int dev = 0, cus = 0;
        if (hipGetDevice(&dev) != hipSuccess || hipDeviceGetAttribute(&cus, hipDeviceAttributeMultiprocessorCount, dev) != hipSuccess) { grid = -1; return; }
        if (hipFuncSetAttribute((const void*)yoco_fwd, hipFuncAttributeMaxDynamicSharedMemorySize, LDS_BYTES) != hipSuccess) { fprintf(stderr, "kernel_launch: hipFuncSetAttribute failed\n"); grid = -1; return; }
        int per_cu = 0;
        if (hipOccupancyMaxActiveBlocksPerMultiprocessor(&per_cu, (const void*)yoco_fwd, NWAVES * 64, LDS_BYTES) != hipSuccess || per_cu < 1) { fprintf(stderr, "kernel_launch: occupancy query says %d\n", per_cu); }
        (void)hipGetLastError();
        grid = cus;
    }
    if (grid < 0) return;
    (void)hipMemsetAsync((char*)d_ws + WS_CTL, 0, CTL_ZERO_BYTES, stream);
    Args a{};
    for (int i = 0; i < 24; ++i) a.in[i] = (const float*)d_in[i];
    a.out = (float*)d_out; a.ws = (unsigned char*)d_ws;
#if MK_SINGLE
    a.ph_lo = 0; a.ph_hi = N_PHASES;
    hipLaunchKernelGGL(yoco_fwd, dim3(grid), dim3(NWAVES * 64), LDS_BYTES, stream, a);
#else
    for (int k = 0; k < N_PHASES; ++k) { a.ph_lo = k; a.ph_hi = k + 1; hipLaunchKernelGGL(yoco_fwd, dim3(grid), dim3(NWAVES * 64), LDS_BYTES, stream, a); }
#endif
}
```

```cpp
#include <hip/hip_runtime.h>
#include <cstdio>
#include <cstdint>

#ifndef MK_SINGLE
#define MK_SINGLE 1
#endif

namespace pg8 {
#define PG8_LAS __attribute__((address_space(3)))
typedef unsigned short bf16_t;
typedef short bf16x8 __attribute__((ext_vector_type(8)));
typedef float f32x4 __attribute__((ext_vector_type(4)));
typedef unsigned u32x4 __attribute__((ext_vector_type(4)));
constexpr int BM = 256, BK = 64, HALF = 128, HTB = HALF * BK * 2  , STAGE_BYTES = 8 * HTB, NXCD = 8, WGM = 8;

__host__ __device__ __forceinline__ int lds_byte(int r, int c) { const int st = (r >> 4) * 2 + (c >> 5), rr = r & 15, cc = c & 31, ob = rr * 64 + cc * 2; return st * 1024 + (ob ^ (((ob >> 9) & 1) << 5)); }
__host__ __device__ __forceinline__ void stage_rc(int b, int& R, int& C) { const int st = b / 1024, sb = b % 1024, swz = sb ^ (((sb >> 9) & 1) << 5); R = (st >> 1) * 16 + swz / 64; C = (st & 1) * 32 + (swz % 64) / 2; }
__host__ __device__ __forceinline__ int perm32(int rho) { const int n = rho >> 4, i = rho & 15; return 8 * (i >> 2) + 4 * n + (i & 3); }

struct Unit { int pm, pn, e; };
struct Gemm { const bf16_t* A; const bf16_t* Bt; int K; int lda; size_t estride; };

struct GenOrder {
    int nM, nN, nwg, G, c; const int* tile_e;
    __device__ void init(int nM_, int nN_, int G_, int c_, const int* te) { nM = nM_; nN = nN_; nwg = nM * nN; G = G_; c = c_; tile_e = te; }
    __device__ bool next(int i, Unit& u) const {
        const long L = (long)i * G + c; if (L >= nwg) return false;
        int wgid = (int)L; { const int q = nwg / NXCD, r = nwg % NXCD, xcd = wgid % NXCD, off = wgid / NXCD; wgid = (xcd < r ? xcd * (q + 1) : r * (q + 1) + (xcd - r) * q) + off; }
        const int nig = WGM * nN, gid = wgid / nig, fm = gid * WGM, gsz = (nM - fm) < WGM ? (nM - fm) : WGM;
        u.pm = fm + ((wgid % nig) % gsz); u.pn = (wgid % nig) / gsz; u.e = tile_e ? tile_e[u.pm] : 0; return true;
    }
    __device__ __forceinline__ void a_ready(const Unit&) const {}
    __device__ __forceinline__ void done(const Unit&) const {}
};

__device__ __forceinline__ unsigned cvt_pk_bf16(float lo, float hi) { unsigned r; asm volatile("v_cvt_pk_bf16_f32 %0, %1, %2" : "=v"(r) : "v"(lo), "v"(hi)); return r; }
__device__ __forceinline__ float silu_f(float v) { return v * __builtin_amdgcn_rcpf(1.0f + __expf(-v)); }
__device__ __forceinline__ float clamp448(float v) { return __builtin_amdgcn_fmed3f(v, -448.f, 448.f); }
__device__ __forceinline__ unsigned pk4_fp8(float a, float b, float c, float d) {
    int w = __builtin_amdgcn_cvt_pk_fp8_f32(clamp448(a), clamp448(b), 0, false); w = __builtin_amdgcn_cvt_pk_fp8_f32(clamp448(c), clamp448(d), w, true); return (unsigned)w; }
constexpr float FP8_SW1 = 32.f, FP8_SW2 = 64.f, FP8_SH = 8.f;

struct EpiBf16 {
    static constexpr bool PERM = true, AFTER_DRAIN = false;
    bf16_t* O; int ldc; const float* bias; int act; int bias_es; float oscale;
    __device__ __forceinline__ void operator()(const f32x4 (&acc)[2][2][4][2], const Unit& u, int wr, int wc, int fr, int fq) const {
        const int row0 = u.pm * BM + wr * 64 + fr, col0 = u.pn * BM + wc * 32 + 8 * fq;
        f32x4 bv[2][2];
#pragma unroll
        for (int bj = 0; bj < 2; ++bj)
#pragma unroll
            for (int n = 0; n < 2; ++n) bv[bj][n] = bias ? *(const f32x4*)(bias + u.e * bias_es + col0 + bj * HALF + 4 * n) : (f32x4){0.f, 0.f, 0.f, 0.f};
#pragma unroll
        for (int ai = 0; ai < 2; ++ai)
#pragma unroll
            for (int m = 0; m < 4; ++m) { bf16_t* rowp = O + (size_t)(row0 + ai * HALF + m * 16) * ldc + col0;
#pragma unroll
                for (int bj = 0; bj < 2; ++bj) { f32x4 v0 = acc[ai][bj][m][0] * oscale + bv[bj][0], v1 = acc[ai][bj][m][1] * oscale + bv[bj][1];
                    if (act == 1) {
#pragma unroll
                        for (int i = 0; i < 4; ++i) { v0[i] = silu_f(v0[i]); v1[i] = silu_f(v1[i]); } }
                    u32x4 w; w.x = cvt_pk_bf16(v0[0], v0[1]); w.y = cvt_pk_bf16(v0[2], v0[3]); w.z = cvt_pk_bf16(v1[0], v1[1]); w.w = cvt_pk_bf16(v1[2], v1[3]);
                    *(u32x4*)(rowp + bj * HALF) = w; } }
    }
};
struct EpiRes {
    static constexpr bool PERM = false, AFTER_DRAIN = false;
    const float* base; float* out; int ldc; float oscale;
    __device__ __forceinline__ void operator()(const f32x4 (&acc)[2][2][4][2], const Unit& u, int wr, int wc, int fr, int fq) const {
        const int row0 = u.pm * BM + wr * 64 + fr, col0 = u.pn * BM + wc * 32 + 4 * fq;
#pragma unroll
        for (int ai = 0; ai < 2; ++ai)
#pragma unroll
            for (int m = 0; m < 4; ++m) { const size_t off = (size_t)(row0 + ai * HALF + m * 16) * ldc + col0;
#pragma unroll
                for (int bj = 0; bj < 2; ++bj)
#pragma unroll
                    for (int n = 0; n < 2; ++n) { const f32x4 b = *(const f32x4*)(base + off + bj * HALF + n * 16); *(f32x4*)(out + off + bj * HALF + n * 16) = b + acc[ai][bj][m][n] * oscale; } }
    }
};
struct EpiSwiGLU {
    static constexpr bool PERM = true, AFTER_DRAIN = false;
    bf16_t* O; int ldc;
    __device__ __forceinline__ void operator()(const f32x4 (&acc)[2][2][4][2], const Unit& u, int wr, int wc, int fr, int fq) const {
        const int row0 = u.pm * BM + wr * 64 + fr, col0 = u.pn * HALF + wc * 32 + 8 * fq;
#pragma unroll
        for (int ai = 0; ai < 2; ++ai)
#pragma unroll
            for (int m = 0; m < 4; ++m) { bf16_t* rowp = O + (size_t)(row0 + ai * HALF + m * 16) * ldc + col0;
                f32x4 v0, v1;
#pragma unroll
                for (int i = 0; i < 4; ++i) { v0[i] = silu_f(acc[ai][0][m][0][i]) * acc[ai][1][m][0][i]; v1[i] = silu_f(acc[ai][0][m][1][i]) * acc[ai][1][m][1][i]; }
                u32x4 w; w.x = cvt_pk_bf16(v0[0], v0[1]); w.y = cvt_pk_bf16(v0[2], v0[3]); w.z = cvt_pk_bf16(v1[0], v1[1]); w.w = cvt_pk_bf16(v1[2], v1[3]);
                *(u32x4*)rowp = w; }
    }
};
struct EpiSwiGLU8 {
    static constexpr bool PERM = true, AFTER_DRAIN = false;
    unsigned char* O; int ldc;
    __device__ __forceinline__ void operator()(const f32x4 (&acc)[2][2][4][2], const Unit& u, int wr, int wc, int fr, int fq) const {
        const int row0 = u.pm * BM + wr * 64 + fr, col0 = u.pn * HALF + wc * 32 + 8 * fq; constexpr float si = 1.f / FP8_SW1;
#pragma unroll
        for (int ai = 0; ai < 2; ++ai)
#pragma unroll
            for (int m = 0; m < 4; ++m) { unsigned char* rowp = O + (size_t)(row0 + ai * HALF + m * 16) * ldc + col0;
                f32x4 v0, v1;
#pragma unroll
                for (int i = 0; i < 4; ++i) {
                    const float g0 = acc[ai][0][m][0][i], g1 = acc[ai][0][m][1][i];
                    v0[i] = (g0 * acc[ai][1][m][0][i]) * ((si * si * FP8_SH) * __builtin_amdgcn_rcpf(1.f + __builtin_amdgcn_exp2f(g0 * (-si * 1.4426950408889634f))));
                    v1[i] = (g1 * acc[ai][1][m][1][i]) * ((si * si * FP8_SH) * __builtin_amdgcn_rcpf(1.f + __builtin_amdgcn_exp2f(g1 * (-si * 1.4426950408889634f)))); }
                typedef unsigned u32x2 __attribute__((ext_vector_type(2))); u32x2 w; w.x = pk4_fp8(v0[0], v0[1], v0[2], v0[3]); w.y = pk4_fp8(v1[0], v1[1], v1[2], v1[3]);
                *(u32x2*)rowp = w; }
    }
};
__device__ __forceinline__ float logf_gate(float x, float la, float l1) {
    const float ls = fminf(x, 0.f) - __logf(1.0f + __expf(-fabsf(x)));
    const float b = l1 + ls;
    if (la == -INFINITY) return b;
    const float mx = fmaxf(la, b), d = fabsf(la - b);
    return mx + __logf(1.0f + __expf(-d));
}
struct EpiHgrnIn {
    static constexpr bool PERM = true, AFTER_DRAIN = false;
    unsigned char* ws; int layer;
    static constexpr size_t O_PQ = 580ull << 20, O_PI = O_PQ + (128ull << 20), O_PG = O_PQ + (256ull << 20), O_LF = O_PQ + (384ull << 20), O_LA = 1ull << 20, O_L1 = O_LA + 8192;
    __device__ __forceinline__ void operator()(const f32x4 (&acc)[2][2][4][2], const Unit& u, int wr, int wc, int fr, int fq) const {
        const int quarter = u.pn >> 2;
        const int row0 = u.pm * BM + wr * 64 + fr, col0 = (u.pn & 3) * BM + wc * 32 + 8 * fq;
        if (quarter == 1) {
            const float* la = (const float*)(ws + O_LA) + layer * 1024; const float* l1 = (const float*)(ws + O_L1) + layer * 1024; float* LF = (float*)(ws + O_LF);
            f32x4 A0[2][2], A1[2][2];
#pragma unroll
            for (int bj = 0; bj < 2; ++bj)
#pragma unroll
                for (int n = 0; n < 2; ++n) { A0[bj][n] = *(const f32x4*)(la + col0 + bj * HALF + 4 * n); A1[bj][n] = *(const f32x4*)(l1 + col0 + bj * HALF + 4 * n); }
#pragma unroll
            for (int ai = 0; ai < 2; ++ai)
#pragma unroll
                for (int m = 0; m < 4; ++m) { float* rowp = LF + (size_t)(row0 + ai * HALF + m * 16) * 1024 + col0;
#pragma unroll
                    for (int bj = 0; bj < 2; ++bj)
#pragma unroll
                        for (int n = 0; n < 2; ++n) { f32x4 o;
#pragma unroll
                            for (int i = 0; i < 4; ++i) o[i] = logf_gate(acc[ai][bj][m][n][i], A0[bj][n][i], A1[bj][n][i]);
                            *(f32x4*)(rowp + bj * HALF + 4 * n) = o; } }
        } else {
            bf16_t* O = (bf16_t*)(ws + (quarter == 0 ? O_PQ : (quarter == 2 ? O_PI : O_PG)));
#pragma unroll
            for (int ai = 0; ai < 2; ++ai)
#pragma unroll
                for (int m = 0; m < 4; ++m) { bf16_t* rowp = O + (size_t)(row0 + ai * HALF + m * 16) * 1024 + col0;
#pragma unroll
                    for (int bj = 0; bj < 2; ++bj) { f32x4 v0 = acc[ai][bj][m][0], v1 = acc[ai][bj][m][1];
                        if (quarter != 2) {
#pragma unroll
                            for (int i = 0; i < 4; ++i) { v0[i] = silu_f(v0[i]); v1[i] = silu_f(v1[i]); } }
                        u32x4 w; w.x = cvt_pk_bf16(v0[0], v0[1]); w.y = cvt_pk_bf16(v0[2], v0[3]); w.z = cvt_pk_bf16(v1[0], v1[1]); w.w = cvt_pk_bf16(v1[2], v1[3]);
                        *(u32x4*)(rowp + bj * HALF) = w; } }
        }
    }
};

template <class Epi, class Sched, bool ALIGN_EPI = false, bool SP2 = false, bool FP8 = false>
__device__ __forceinline__ void gemm_phase(PG8_LAS unsigned char* lds, const Gemm g, const Sched& S, const Epi& E, const int wave_id) {
    int lane_; asm volatile("v_mbcnt_lo_u32_b32 %0, -1, 0\n\tv_mbcnt_hi_u32_b32 %0, -1, %0" : "=v"(lane_));
    const int wid = wave_id, lane = lane_, tid = wid * 64 + lane, wr = wid >> 2, wc = wid & 3, fr = lane & 15, fq = lane >> 4;
    const int K = g.K, nt = K / BK, lda = g.lda;
    unsigned voffA[2], voffB[2];
#pragma unroll
    for (int i = 0; i < 2; ++i) { int R, C; stage_rc(tid * 16 + i * 8192, R, C); const int Rb = Epi::PERM ? ((R & ~31) + perm32(R & 31)) : R;
        voffA[i] = (unsigned)(R * lda + C) * 2u; voffB[i] = (unsigned)(Rb * K + C) * 2u; }
    const size_t kstep = (size_t)(BK * 2);
    const size_t hstep = (size_t)HALF * K * 2;
    const size_t tstep = 2 * hstep;
    const size_t hstepA = (size_t)HALF * lda * 2, tstepA = 2 * hstepA;
    const unsigned ldsw = (unsigned)wid * 1024u;
    const int aoff = lds_byte(wr * 64 + fr, fq * 8), boff = lds_byte(wc * 32 + fr, fq * 8);
#define PG8_SA(b, h) (((b) * 2 + (h)) * HTB)
#define PG8_SB(b, h) ((4 + (b) * 2 + (h)) * HTB)
#define PG8_STAGE(bufoff, gbase, voff) do { _Pragma("unroll") for (int _i = 0; _i < 2; ++_i) \
        __builtin_amdgcn_global_load_lds((const unsigned*)((const char*)(gbase) + (voff)[_i]), (PG8_LAS unsigned*)(lds + (bufoff) + ldsw + _i * 8192), 16, 0, 0); } while (0)
    typedef int i32x4_ __attribute__((ext_vector_type(4))); typedef int i32x8_ __attribute__((ext_vector_type(8)));
#define PG8_CAT(x, y) __builtin_shufflevector((x), (y), 0, 1, 2, 3, 4, 5, 6, 7)
#define PG8_LDA(dst, b, h) do { _Pragma("unroll") for (int m = 0; m < 4; ++m) { \
        if constexpr (FP8) dst##8[m] = PG8_CAT(*(const PG8_LAS i32x4_*)(lds + PG8_SA(b, h) + aoff + m * 2048), *(const PG8_LAS i32x4_*)(lds + PG8_SA(b, h) + aoff + m * 2048 + 1024)); \
        else { _Pragma("unroll") for (int k = 0; k < 2; ++k) dst[m][k] = *(const PG8_LAS bf16x8*)(lds + PG8_SA(b, h) + aoff + m * 2048 + k * 1024); } } } while (0)
#define PG8_LDB(dst, b, h) do { _Pragma("unroll") for (int n = 0; n < 2; ++n) { \
        if constexpr (FP8) dst##8[n] = PG8_CAT(*(const PG8_LAS i32x4_*)(lds + PG8_SB(b, h) + boff + n * 2048), *(const PG8_LAS i32x4_*)(lds + PG8_SB(b, h) + boff + n * 2048 + 1024)); \
        else { _Pragma("unroll") for (int k = 0; k < 2; ++k) dst[n][k] = *(const PG8_LAS bf16x8*)(lds + PG8_SB(b, h) + boff + n * 2048 + k * 1024); } } } while (0)
#define PG8_MMA(ai, bj, At, Bt) do { __builtin_amdgcn_s_setprio(1); _Pragma("unroll") for (int m = 0; m < 4; ++m) _Pragma("unroll") for (int n = 0; n < 2; ++n) { \
        if constexpr (FP8) asm volatile("v_mfma_scale_f32_16x16x128_f8f6f4 %0, %1, %2, %0, %3, %3 op_sel_hi:[0,0,0]" : "+v"(acc[ai][bj][m][n]) : "v"(Bt##8[n]), "v"(At##8[m]), "v"(f8scale_)); \
        else { _Pragma("unroll") for (int k = 0; k < 2; ++k) acc[ai][bj][m][n] = __builtin_amdgcn_mfma_f32_16x16x32_bf16(Bt[n][k], At[m][k], acc[ai][bj][m][n], 0, 0, 0); } } \
        __builtin_amdgcn_s_setprio(0); } while (0)
#define PG8_WAIT_V(n) asm volatile("s_waitcnt vmcnt(" #n ")" ::: "memory")
#define PG8_WAIT_L(n) asm volatile("s_waitcnt lgkmcnt(" #n ")" ::: "memory")
#define PG8_BAR __builtin_amdgcn_s_barrier()
#define PG8_SCHED __builtin_amdgcn_sched_barrier(0)
    Unit cur, nxt; int ui = 0;
    if (!S.next(0, cur)) return;
    f32x4 acc[2][2][4][2];
#pragma unroll
    for (int a = 0; a < 2; ++a)
#pragma unroll
        for (int b = 0; b < 2; ++b)
#pragma unroll
            for (int m = 0; m < 4; ++m)
#pragma unroll
                for (int n = 0; n < 2; ++n) acc[a][b][m][n] = (f32x4){0.f, 0.f, 0.f, 0.f};
    const int f8scale_ = 0x7f7f7f7f;
    bf16x8 At[4][2], B0[2][2], B1[2][2]; i32x8_ At8[4], B08[2], B18[2];
    const char* cA = (const char*)g.A + (size_t)cur.pm * tstepA; const char* cB = (const char*)g.Bt + (size_t)cur.e * g.estride + (size_t)cur.pn * tstep;
    S.a_ready(cur);
    if constexpr (SP2) {
        PG8_STAGE(PG8_SB(0, 0), cB, voffB); PG8_STAGE(PG8_SB(0, 1), cB + hstep, voffB); PG8_STAGE(PG8_SA(0, 0), cA, voffA); PG8_STAGE(PG8_SA(0, 1), cA + hstepA, voffA);
        if (wr == 1) PG8_BAR;
        PG8_WAIT_V(2); PG8_BAR;
        PG8_STAGE(PG8_SB(1, 0), cB + kstep, voffB); PG8_STAGE(PG8_SA(1, 0), cA + kstep, voffA); PG8_STAGE(PG8_SB(1, 1), cB + hstep + kstep, voffB);
        PG8_WAIT_V(6); PG8_BAR;
    } else {
        PG8_STAGE(PG8_SB(0, 0), cB, voffB); PG8_STAGE(PG8_SA(0, 0), cA, voffA); PG8_STAGE(PG8_SB(0, 1), cB + hstep, voffB); PG8_STAGE(PG8_SA(0, 1), cA + hstepA, voffA);
        if (wr == 1) PG8_BAR;
        PG8_WAIT_V(4); PG8_BAR;
        PG8_STAGE(PG8_SB(1, 0), cB + kstep, voffB); PG8_STAGE(PG8_SA(1, 0), cA + kstep, voffA); PG8_STAGE(PG8_SB(1, 1), cB + hstep + kstep, voffB);
        PG8_WAIT_V(6); PG8_BAR;
    }
    for (;;) {
        const bool has_next = S.next(ui + 1, nxt);
        const char* nA = has_next ? (const char*)g.A + (size_t)nxt.pm * tstepA : cA; const char* nB = has_next ? (const char*)g.Bt + (size_t)nxt.e * g.estride + (size_t)nxt.pn * tstep : cB;
        for (int t = 0; t < nt; t += 2) {
            const bool last = (t == nt - 2);
            const char* a1 = cA + (size_t)(t + 1) * kstep;
            const char* a2 = last ? nA : cA + (size_t)(t + 2) * kstep; const char* b2 = last ? nB : cB + (size_t)(t + 2) * kstep;
            const char* a3 = a2 + kstep; const char* b3 = b2 + kstep;
            if (last && has_next) S.a_ready(nxt);
            if constexpr (SP2) {
            PG8_LDB(B0, 0, 0); PG8_LDB(B1, 0, 1); PG8_SCHED; PG8_LDA(At, 0, 0); PG8_STAGE(PG8_SA(1, 1), a1 + hstepA, voffA);
            PG8_WAIT_V(8); PG8_WAIT_L(0); PG8_BAR; PG8_MMA(0, 0, At, B0); PG8_MMA(0, 1, At, B1); PG8_BAR; PG8_SCHED;
            PG8_LDA(At, 0, 1); PG8_STAGE(PG8_SB(0, 0), b2, voffB); PG8_STAGE(PG8_SB(0, 1), b2 + hstep, voffB); PG8_STAGE(PG8_SA(0, 0), a2, voffA);
            PG8_WAIT_V(8); PG8_WAIT_L(0); PG8_BAR; PG8_MMA(1, 0, At, B0); PG8_MMA(1, 1, At, B1); PG8_BAR; PG8_SCHED;
            PG8_LDB(B0, 1, 0); PG8_LDB(B1, 1, 1); PG8_SCHED; PG8_LDA(At, 1, 0); PG8_STAGE(PG8_SA(0, 1), a2 + hstepA, voffA);
            PG8_WAIT_V(8); PG8_WAIT_L(0); PG8_BAR; PG8_MMA(0, 0, At, B0); PG8_MMA(0, 1, At, B1); PG8_BAR; PG8_SCHED;
            PG8_LDA(At, 1, 1); PG8_STAGE(PG8_SB(1, 0), b3, voffB); PG8_STAGE(PG8_SB(1, 1), b3 + hstep, voffB); PG8_STAGE(PG8_SA(1, 0), a3, voffA);
            PG8_WAIT_V(8); PG8_WAIT_L(0); PG8_BAR; PG8_MMA(1, 0, At, B0); PG8_MMA(1, 1, At, B1); PG8_BAR; PG8_SCHED;
            } else {
            PG8_LDB(B0, 0, 0); PG8_SCHED; PG8_LDA(At, 0, 0); PG8_STAGE(PG8_SA(1, 1), a1 + hstepA, voffA);
            PG8_WAIT_L(8); PG8_BAR; PG8_WAIT_L(0); PG8_MMA(0, 0, At, B0); PG8_BAR; PG8_SCHED;
            PG8_LDB(B1, 0, 1); PG8_STAGE(PG8_SB(0, 0), b2, voffB);
            PG8_BAR; PG8_WAIT_L(0); PG8_MMA(0, 1, At, B1); PG8_BAR;
            PG8_LDA(At, 0, 1); PG8_STAGE(PG8_SA(0, 0), a2, voffA);
            PG8_BAR; PG8_WAIT_L(0); PG8_MMA(1, 0, At, B0); PG8_BAR; PG8_SCHED;
            PG8_STAGE(PG8_SB(0, 1), b2 + hstep, voffB);
            PG8_WAIT_V(6); PG8_BAR; PG8_MMA(1, 1, At, B1); PG8_BAR;
            PG8_LDB(B0, 1, 0); PG8_SCHED; PG8_LDA(At, 1, 0); PG8_STAGE(PG8_SA(0, 1), a2 + hstepA, voffA);
            PG8_WAIT_L(8); PG8_BAR; PG8_WAIT_L(0); PG8_MMA(0, 0, At, B0); PG8_BAR; PG8_SCHED;
            PG8_LDB(B1, 1, 1); PG8_STAGE(PG8_SB(1, 0), b3, voffB);
            PG8_BAR; PG8_WAIT_L(0); PG8_MMA(0, 1, At, B1); PG8_BAR;
            PG8_LDA(At, 1, 1); PG8_STAGE(PG8_SA(1, 0), a3, voffA);
            PG8_BAR; PG8_WAIT_L(0); PG8_MMA(1, 0, At, B0); PG8_BAR; PG8_SCHED;
            PG8_STAGE(PG8_SB(1, 1), b3 + hstep, voffB);
            PG8_WAIT_V(6); PG8_BAR; PG8_MMA(1, 1, At, B1); PG8_BAR;
            }
        }
        if constexpr (FP8) asm volatile("s_nop 15\n\ts_nop 15" ::: "memory");
        if constexpr (ALIGN_EPI) { if (wr == 0) PG8_BAR; }
        if constexpr (!Epi::AFTER_DRAIN) { E(acc, cur, wr, wc, fr, fq); S.done(cur); }
        if (!has_next) break;
#pragma unroll
        for (int a = 0; a < 2; ++a)
#pragma unroll
            for (int b = 0; b < 2; ++b)
#pragma unroll
                for (int m = 0; m < 4; ++m)
#pragma unroll
                    for (int n = 0; n < 2; ++n) acc[a][b][m][n] = (f32x4){0.f, 0.f, 0.f, 0.f};
        cur = nxt; cA = nA; cB = nB; ++ui;
        if constexpr (ALIGN_EPI) { if (wr == 1) PG8_BAR; }
    }
    PG8_WAIT_V(0);
    if constexpr (!ALIGN_EPI) { if (wr == 0) PG8_BAR; }
    PG8_BAR;
    if constexpr (Epi::AFTER_DRAIN) { E.fused(acc, cur, wr, wc, fr, fq, lds, wid, lane); S.done(cur); }
#undef PG8_SA
#undef PG8_SB
#undef PG8_STAGE
#undef PG8_LDA
#undef PG8_LDB
#undef PG8_MMA
#undef PG8_CAT
#undef PG8_WAIT_V
#undef PG8_WAIT_L
#undef PG8_BAR
#undef PG8_SCHED
}
}

constexpr int NT = 65536, DM = 1024, NBATCH = 32, SEQ = 2048;
constexpr int DFF = 2816, DFE = 3584, NEXP = 8;
constexpr int MOE_ROWS = 133120;
constexpr float EPS = 1e-6f;
constexpr size_t MiB = 1u << 20;
constexpr size_t WS_CTL = 0, CTL_ZERO_BYTES = 1 * MiB;
constexpr size_t WS_LA = 1 * MiB;
constexpr size_t WS_L1 = WS_LA + 8192;
constexpr size_t WS_CB = WS_LA + 16384;
constexpr size_t WS_RCNT = WS_LA + 32768;
constexpr size_t WS_RTAB = WS_LA + 65536;
constexpr size_t WS_ROUTE = 2 * MiB;
constexpr size_t WS_SLOT = 3 * MiB;
constexpr size_t WS_SELM = 4 * MiB;
constexpr size_t WS_GATES = 8 * MiB;
constexpr size_t WS_KC = 20 * MiB;
constexpr size_t WS_VCT = 22 * MiB;
constexpr size_t WS_HC = 24 * MiB;
constexpr size_t WS_W = 48 * MiB;
constexpr size_t W_HIN = WS_W, W_HOUT = WS_W + 16 * MiB, W_KVQ = WS_W + 20 * MiB, W_Q3 = WS_W + 26 * MiB, W_CMP1 = WS_W + 29 * MiB, W_NOUT = WS_W + 31 * MiB,
                 W_FGU = WS_W + 35 * MiB, W_FDN = WS_W + 57 * MiB, W_MGU = WS_W + 68 * MiB, W_MDN = WS_W + 292 * MiB;
constexpr size_t WS_XN = 452 * MiB;
constexpr size_t WS_R = 580 * MiB;
constexpr size_t R_PQ = WS_R, R_PI = WS_R + 128 * MiB, R_PG = WS_R + 256 * MiB, R_LF = WS_R + 384 * MiB, R_O2 = WS_R + 640 * MiB;
constexpr size_t R_HF = WS_R + 256 * MiB;
constexpr size_t R_KS = WS_R, R_KW = WS_R + 32 * MiB, R_VST = WS_R + 64 * MiB, R_VWT = WS_R + 96 * MiB, R_KCR = WS_R + 128 * MiB, R_VCR = WS_R + 160 * MiB;
constexpr size_t R_QKV = WS_R + 256 * MiB;
constexpr size_t R_Q = WS_R + 608 * MiB, R_O = WS_R + 736 * MiB;
constexpr size_t R_XP = WS_R, R_HM = WS_R + 260 * MiB;
constexpr size_t WS_NEED = R_HM + (size_t)MOE_ROWS * DFE * 2;
static_assert(WS_NEED <= 1792 * MiB, "workspace map");
static_assert(W_MDN + 112 * MiB <= WS_XN, "weights map");
static_assert(pg8::EpiHgrnIn::O_PQ == R_PQ && pg8::EpiHgrnIn::O_PI == R_PI && pg8::EpiHgrnIn::O_PG == R_PG && pg8::EpiHgrnIn::O_LF == R_LF && pg8::EpiHgrnIn::O_LA == WS_LA && pg8::EpiHgrnIn::O_L1 == WS_L1, "EpiHgrnIn offsets");

constexpr int LDS_BYTES = 147456;
constexpr int MISC_OFF = 131072 + 320;
constexpr int NWAVES = 8;

#define GAS __attribute__((address_space(1)))
#define LAS __attribute__((address_space(3)))
typedef unsigned short bf16;
typedef unsigned v4u __attribute__((ext_vector_type(4)));
typedef unsigned v2u __attribute__((ext_vector_type(2)));
typedef float f32x4 __attribute__((ext_vector_type(4)));
#define LDS_WAIT() asm volatile("s_waitcnt lgkmcnt(0)" ::: "memory")
__device__ __forceinline__ unsigned f2bf(float f) { unsigned u = __builtin_bit_cast(unsigned, f); return (u + 0x7fffu + ((u >> 16) & 1u)) >> 16; }
__device__ __forceinline__ unsigned pk2(float lo, float hi) { return f2bf(lo) | (f2bf(hi) << 16); }
__device__ __forceinline__ float bf2f(unsigned b) { return __builtin_bit_cast(float, b << 16); }
__device__ __forceinline__ float bflo(unsigned w) { return __builtin_bit_cast(float, w << 16); }
__device__ __forceinline__ float bfhi(unsigned w) { return __builtin_bit_cast(float, w & 0xffff0000u); }
__device__ __forceinline__ float wave_sum(float v) {
#pragma unroll
    for (int o = 32; o >= 1; o >>= 1) v += __shfl_xor(v, o);
    return v;
}
__device__ __forceinline__ float wave_max(float v) {
#pragma unroll
    for (int o = 32; o >= 1; o >>= 1) v = fmaxf(v, __shfl_xor(v, o));
    return v;
}

#define XB_TMO      128
#define XB_XCNT(j)  (256  + 64 * (j))
#define XB_XSUB(j)  (1280 + 64 * (j))
#define XB_XGEN(j)  (2304 + 64 * (j))
#define XB_TOP      3328
#define XB_TOPGEN   3392
#define XCD_BAR_WORDS 3456
#define XB_SPIN_CAP (1u << 22)
__device__ __forceinline__ unsigned xb_ld(unsigned* p)              { return __hip_atomic_load(p, __ATOMIC_RELAXED, __HIP_MEMORY_SCOPE_AGENT); }
__device__ __forceinline__ unsigned xb_add(unsigned* p, unsigned v) { return __hip_atomic_fetch_add(p, v, __ATOMIC_RELAXED, __HIP_MEMORY_SCOPE_AGENT); }
__device__ __forceinline__ unsigned xb_xcc_id() { return (unsigned)__builtin_amdgcn_s_getreg((3 << 11) | 20) & 0xFu; }
#define XB_SPIN(cond, bar) do { unsigned _sp = 0; while (cond) { __builtin_amdgcn_s_sleep(1); \
    if ((++_sp & 255u) == 0u) { if (xb_ld(&(bar)[XB_TMO])) break; if (_sp > XB_SPIN_CAP) { atomicAdd(&(bar)[XB_TMO], 1u); break; } } } } while (0)
struct XcdBarrier { unsigned* bar; unsigned x; volatile LAS unsigned* st; };
__device__ __forceinline__ XcdBarrier xcd_barrier_post(unsigned* bar, volatile LAS unsigned* st) {
    XcdBarrier b; b.bar = bar; b.x = xb_xcc_id(); b.st = st;
    if (threadIdx.x == 0) (void)xb_add(&bar[XB_XCNT(b.x)], 1u);
    return b;
}
__device__ __forceinline__ void xcd_barrier_complete(unsigned* bar, unsigned x, unsigned& nloc, unsigned& nx) {
    const unsigned G = gridDim.x * gridDim.y * gridDim.z;
    unsigned sum, cnt, mine, sp = 0u;
    for (;;) {
        sum = 0u; cnt = 0u; mine = 0u;
#pragma unroll
        for (unsigned j = 0; j < 16; ++j) { const unsigned c = xb_ld(&bar[XB_XCNT(j)]); sum += c; cnt += (c > 0u) ? 1u : 0u; mine = (j == x) ? c : mine; }
        if (sum == G) break;
        __builtin_amdgcn_s_sleep(1);
        if ((++sp & 255u) == 0u) { if (xb_ld(&bar[XB_TMO])) break; if (sp > XB_SPIN_CAP) { atomicAdd(&bar[XB_TMO], 1u); break; } }
    }
    nloc = mine > 0u ? mine : 1u; nx = cnt > 0u ? cnt : 1u;
}
__device__ __forceinline__ void xcd_barrier(const XcdBarrier& b) {
    asm volatile("s_waitcnt vmcnt(0)" ::: "memory");
    __syncthreads();
    if (threadIdx.x == 0) {
        unsigned* bar = b.bar; unsigned bx_ = b.x; asm volatile("" : "+s"(bar), "+s"(bx_));
        __builtin_amdgcn_s_waitcnt(0);
        unsigned nloc = b.st[0], nx = b.st[1];
        if (nloc == 0u) { xcd_barrier_complete(bar, bx_, nloc, nx); b.st[0] = nloc; b.st[1] = nx; }
        const unsigned old = xb_add(&bar[XB_XSUB(bx_)], 1u);
        const unsigned gen = old / nloc;
        if (old + 1u == (gen + 1u) * nloc) {
            __builtin_amdgcn_fence(__ATOMIC_RELEASE, "agent");
            asm volatile("s_waitcnt vmcnt(0)" ::: "memory");
            const unsigned og = xb_add(&bar[XB_TOP], 1u);
            const unsigned tg = og / nx;
            if (og + 1u == (tg + 1u) * nx) xb_add(&bar[XB_TOPGEN], 1u);
            else XB_SPIN(xb_ld(&bar[XB_TOPGEN]) == tg, bar);
            __builtin_amdgcn_fence(__ATOMIC_ACQUIRE, "agent");
            xb_add(&bar[XB_XGEN(bx_)], 1u);
            asm volatile("s_waitcnt vmcnt(0)" ::: "memory");
        } else {
            XB_SPIN(xb_ld(&bar[XB_XGEN(bx_)]) == gen, bar);
            __builtin_amdgcn_fence(__ATOMIC_ACQUIRE, "agent");
            asm volatile("s_waitcnt vmcnt(0)" ::: "memory");
        }
    }
    __syncthreads();
}

struct Ctx {
    LAS unsigned char* lds;
    int tid, lane, wave, G, bid;
    float* out; unsigned char* ws;
    __device__ __forceinline__ const float* inp(int i) const {
        const __attribute__((address_space(4))) unsigned char* kp = (const __attribute__((address_space(4))) unsigned char*)__builtin_amdgcn_kernarg_segment_ptr();
        asm volatile("" : "+s"(kp));
        return ((const float* const __attribute__((address_space(4)))*)kp)[i];
    }
};
enum { I_X = 0, I_NMIX, I_NFFN, I_HWIN, I_HWOUT, I_HGN, I_HLB, I_KVN, I_KVW, I_CPK, I_CW1K, I_CW2K, I_CPV, I_CW1V, I_CW2V, I_KN, I_NWIN, I_NWOUT, I_NQN, I_FGU, I_FDN, I_MR, I_MGU, I_MDN };

constexpr int MAXJOB = 64;
struct JobTab { unsigned long long src[MAXJOB], gain[MAXJOB], dst[MAXJOB]; int K[MAXJOB], Nsrc[MAXJOB], npb[MAXJOB], F[MAXJOB], rowoff[MAXJOB], istart[MAXJOB + 1]; float f8s[MAXJOB]; int njobs; };
__device__ __forceinline__ void add_job(LAS JobTab* J, const float* src, const float* gain, bf16* dst, int K, int Nsrc, int Npad, int F, int rowoff, float f8s = 0.f) {
    const int j = J->njobs; J->src[j] = (unsigned long long)src; J->gain[j] = (unsigned long long)gain; J->dst[j] = (unsigned long long)dst;
    J->K[j] = K; J->Nsrc[j] = Nsrc; J->npb[j] = Npad / 32; J->F[j] = F; J->rowoff[j] = rowoff; J->f8s[j] = f8s; J->istart[j + 1] = J->istart[j] + (K / 64) * (Npad / 32); J->njobs = j + 1;
}
struct TrItem { const float* W; const float* gain; bf16* WT; int K, Nsrc, drow, k0, n0; float f8s; };
__device__ __forceinline__ void tr_load(const TrItem& p, f32x4 (&v)[8], int lane) {
    const int c4 = lane & 7, kr = lane >> 3, n = p.n0 + 4 * c4; const bool okn = n < p.Nsrc;
#pragma unroll
    for (int i = 0; i < 8; ++i) { const int kk = 8 * i + kr; v[i] = okn ? *(const f32x4*)(p.W + (size_t)(p.k0 + kk) * p.Nsrc + n) : (f32x4){0.f, 0.f, 0.f, 0.f}; }
}
__device__ __forceinline__ void tr_finish(const TrItem& p, f32x4 (&v)[8], LAS float* scr, int lane) {
    const int c4 = lane & 7, kr = lane >> 3;
#pragma unroll
    for (int i = 0; i < 8; ++i) { const int kk = 8 * i + kr; if (p.gain) v[i] = v[i] * p.gain[p.k0 + kk]; *(LAS f32x4*)(scr + kk * 36 + 4 * c4) = v[i]; }
    LDS_WAIT();
    const int c = lane & 7; const float f8s = p.f8s;
#pragma unroll
    for (int j = 0; j < 4; ++j) { const int nn = (lane >> 3) + 8 * j; const LAS float* s = scr + (8 * c) * 36 + nn;
        if (f8s != 0.f) { v2u o; o.x = pg8::pk4_fp8(s[0 * 36] * f8s, s[1 * 36] * f8s, s[2 * 36] * f8s, s[3 * 36] * f8s); o.y = pg8::pk4_fp8(s[4 * 36] * f8s, s[5 * 36] * f8s, s[6 * 36] * f8s, s[7 * 36] * f8s);
            *(v2u*)((unsigned char*)p.WT + (size_t)(p.drow + nn) * p.K + p.k0 + 8 * c) = o; }
        else { v4u o; o.x = pk2(s[0 * 36], s[1 * 36]); o.y = pk2(s[2 * 36], s[3 * 36]); o.z = pk2(s[4 * 36], s[5 * 36]); o.w = pk2(s[6 * 36], s[7 * 36]);
            *(v4u*)(p.WT + (size_t)(p.drow + nn) * p.K + p.k0 + 8 * c) = o; } }
    LDS_WAIT();
}
__device__ __forceinline__ void norm_row_store(const f32x4 (&v)[4], bf16* orow, int lane) {
    float s = 0.f;
#pragma unroll
    for (int j = 0; j < 4; ++j) s += (v[j].x * v[j].x + v[j].y * v[j].y) + (v[j].z * v[j].z + v[j].w * v[j].w);
    const float rstd = rsqrtf(wave_sum(s) * (1.f / DM) + EPS);
    v2u* o8 = (v2u*)orow + lane;
#pragma unroll
    for (int j = 0; j < 4; ++j) { v2u w; w.x = pk2(v[j].x * rstd, v[j].y * rstd); w.y = pk2(v[j].z * rstd, v[j].w * rstd); o8[64 * j] = w; }
}
__device__ __forceinline__ void p_prologue(Ctx& C) {
    LAS JobTab* J = (LAS JobTab*)(C.lds + 73728);
    unsigned char* ws = C.ws;
    if (C.tid == 0) {
        J->njobs = 0; J->istart[0] = 0;
        for (int l = 0; l < 2; ++l) add_job(J, C.inp(I_HWIN) + (size_t)l * 1024 * 4096, C.inp(I_NMIX) + l * 1024, (bf16*)(ws + W_HIN) + (size_t)l * 4096 * 1024, 1024, 4096, 4096, 0, 0);
        for (int l = 0; l < 2; ++l) add_job(J, C.inp(I_HWOUT) + (size_t)l * 1024 * 1024, nullptr, (bf16*)(ws + W_HOUT) + (size_t)l * 1024 * 1024, 1024, 1024, 1024, 0, 0);
        add_job(J, C.inp(I_KVW), C.inp(I_KVN), (bf16*)(ws + W_KVQ), 1024, 1536, 1536, 0, 0);
        add_job(J, C.inp(I_NWIN), C.inp(I_NMIX) + 2048, (bf16*)(ws + W_KVQ), 1024, 1072, 1280, 0, 1536);
        add_job(J, C.inp(I_NWIN) + (size_t)1024 * 1072, C.inp(I_NMIX) + 3072, (bf16*)(ws + W_Q3), 1024, 1072, 1280, 0, 0);
        add_job(J, C.inp(I_CW1K), nullptr, (bf16*)(ws + W_CMP1), 2048, 256, 256, 0, 0);
        add_job(J, C.inp(I_CW1V), nullptr, (bf16*)(ws + W_CMP1) + (size_t)256 * 2048, 2048, 256, 256, 0, 0);
        for (int l = 0; l < 2; ++l) add_job(J, C.inp(I_NWOUT) + (size_t)l * 1024 * 1024, nullptr, (bf16*)(ws + W_NOUT) + (size_t)l * 1024 * 1024, 1024, 1024, 1024, 0, 0);
        for (int l = 0; l < 2; ++l) add_job(J, C.inp(I_FGU) + (size_t)l * 1024 * 2 * DFF, C.inp(I_NFFN) + (2 * l) * 1024, (bf16*)(ws + W_FGU + (size_t)l * 2 * DFF * 2048), 1024, 2 * DFF, 2 * DFF, DFF, 0, l ? pg8::FP8_SW1 : 0.f);
        for (int l = 0; l < 2; ++l) add_job(J, C.inp(I_FDN) + (size_t)l * DFF * 1024, nullptr, (bf16*)(ws + W_FDN + (size_t)l * 1024 * DFF * 2), DFF, 1024, 1024, 0, 0, l ? pg8::FP8_SW2 : 0.f);
        for (int l = 0; l < 16; ++l) add_job(J, C.inp(I_MGU) + (size_t)l * 1024 * 2 * DFE, C.inp(I_NFFN) + (2 * (l >> 3) + 1) * 1024, (bf16*)(ws + W_MGU + (size_t)l * 2 * DFE * 1024), 1024, 2 * DFE, 2 * DFE, DFE, 0, pg8::FP8_SW1);
        for (int l = 0; l < 16; ++l) add_job(J, C.inp(I_MDN) + (size_t)l * DFE * 1024, nullptr, (bf16*)(ws + W_MDN + (size_t)l * 1024 * DFE), DFE, 1024, 1024, 0, 0, pg8::FP8_SW2);
    }
    __syncthreads();
    LAS float* scr = (LAS float*)(C.lds + C.wave * 9216);
    const int gw = C.bid * NWAVES + C.wave, NGW = C.G * NWAVES;
    const int nj = J->njobs, total = J->istart[nj];
#define TR_SETUP(it_, P) do { int j = 0; while (j + 1 < nj && J->istart[j + 1] <= (it_)) ++j; \
        const int r = (it_) - J->istart[j], npb = J->npb[j], kb = r / npb, nb = r % npb, n0 = 32 * nb, F = J->F[j]; \
        int drow = J->rowoff[j] + n0; \
        if (F) drow = (n0 < F) ? 256 * (n0 / 128) + (n0 % 128) : 256 * ((n0 - F) / 128) + 128 + ((n0 - F) % 128); \
        P.W = (const float*)J->src[j]; P.gain = (const float*)J->gain[j]; P.WT = (bf16*)J->dst[j]; P.K = J->K[j]; P.Nsrc = J->Nsrc[j]; P.drow = drow; P.k0 = 64 * kb; P.n0 = n0; P.f8s = J->f8s[j]; } while (0)
    {
        TrItem pa, pb; f32x4 va[8], vb[8]; int it = gw;
        if (it < total) { TR_SETUP(it, pa); tr_load(pa, va, C.lane); }
        while (it < total) {
            int itn = it + NGW; bool hn = itn < total;
            if (hn) { TR_SETUP(itn, pb); tr_load(pb, vb, C.lane); }
            tr_finish(pa, va, scr, C.lane);
            if (!hn) break;
            it = itn; itn = it + NGW; hn = itn < total;
            if (hn) { TR_SETUP(itn, pa); tr_load(pa, va, C.lane); }
            tr_finish(pb, vb, scr, C.lane);
            if (!hn) break;
            it = itn; }
    }
#undef TR_SETUP
    { const int gt = C.bid * 512 + C.tid;
      if (gt < 1024) { const float a0 = C.inp(I_HLB)[gt], a1 = C.inp(I_HLB)[1024 + gt]; const float mx = fmaxf(a0, a1), e0 = expf(a0 - mx), e1 = expf(a1 - mx), s = e0 + e1;
          const float s0 = e0 / s, s1 = e1 / s, lb1 = (s0 + s1) - s0;
          float* la = (float*)(ws + WS_LA); float* l1 = (float*)(ws + WS_L1);
          la[gt] = -INFINITY; l1[gt] = 0.f; la[1024 + gt] = logf(lb1); l1[1024 + gt] = log1pf(-lb1); } }
    if (C.bid == 0 && C.tid < 128) ((int*)(ws + WS_RTAB))[2048 + C.tid] = C.tid >> 6;
    if (C.G >= 8 && C.bid >= C.G - 8) { const int ob = (C.bid - (C.G - 8)) * 64 + C.lane, which = ob >> 8, j = ob & 255; const float* pos = C.inp(which ? I_CPV : I_CPK); const float* w1 = C.inp(which ? I_CW1V : I_CW1K);
        float a = 0.f;
#pragma unroll 8
        for (int i = C.wave * 256; i < C.wave * 256 + 256; ++i) a += pos[i] * w1[(size_t)i * 256 + j];
        __syncthreads();
        LAS float* red = (LAS float*)(C.lds + 80 * 1024); red[C.wave * 64 + C.lane] = a;
        __syncthreads();
        if (C.wave == 0) { float t = 0.f;
#pragma unroll
            for (int w = 0; w < 8; ++w) t += red[w * 64 + C.lane];
            ((float*)(ws + WS_CB))[ob] = t; } }
    for (int c = C.bid; c < 256; c += C.G)
        for (int i = 0; i < 32; i += 4) { f32x4 v[4][4]; const float* xb = C.inp(I_X);
#pragma unroll
            for (int r = 0; r < 4; ++r) { const f32x4* xr = (const f32x4*)(xb + (size_t)(c * 256 + C.wave * 32 + i + r) * DM) + C.lane;
#pragma unroll
                for (int j = 0; j < 4; ++j) v[r][j] = xr[64 * j]; }
#pragma unroll
            for (int r = 0; r < 4; ++r) norm_row_store(v[r], (bf16*)(ws + WS_XN) + (size_t)(c * 256 + C.wave * 32 + i + r) * DM, C.lane); }
}

template <bool MOE_ADD, bool ROUTER, bool WRITE_XN, bool XN_FP8 = false>
__device__ __forceinline__ void p_norm(Ctx& C, const float* rw, const float* rgain) {
    unsigned char* ws = C.ws;
    LAS int* cnt8 = (LAS int*)(C.lds + 1024);
    const bf16* Y = (const bf16*)(ws + R_XP);
    const int4* route = (const int4*)(ws + WS_ROUTE); const int2* slot = (const int2*)(ws + WS_SLOT);
    constexpr int NR = (MOE_ADD || ROUTER) ? 2 : 4;
    for (int c = C.bid; c < 256; c += C.G) {
        if (ROUTER) { __syncthreads(); if (C.tid < 8) cnt8[C.tid] = 0; __syncthreads(); }
#pragma unroll 1
        for (int i = 0; i < 32; i += NR) {
            f32x4 v[NR][4];
#pragma unroll
            for (int r = 0; r < NR; ++r) { const float* hr = C.out + (size_t)(c * 256 + C.wave * 32 + i + r) * DM;
#pragma unroll
                for (int j = 0; j < 4; ++j) v[r][j] = ((const f32x4*)hr + C.lane)[64 * j]; }
            if (MOE_ADD) {
#pragma unroll
                for (int r = 0; r < NR; ++r) { const int row = c * 256 + C.wave * 32 + i + r; float* hr = C.out + (size_t)row * DM;
                    const int4 rt = route[row]; const int2 sl = slot[row]; const float w0 = __builtin_bit_cast(float, rt.y), w1 = __builtin_bit_cast(float, rt.z);
                    const v2u* y0 = (const v2u*)(Y + (size_t)sl.x * DM) + C.lane; const v2u* y1 = (const v2u*)(Y + (size_t)sl.y * DM) + C.lane;
#pragma unroll
                    for (int j = 0; j < 4; ++j) { const v2u a = y0[64 * j], b = y1[64 * j];
                        v[r][j].x += w0 * bflo(a.x) + w1 * bflo(b.x); v[r][j].y += w0 * bfhi(a.x) + w1 * bfhi(b.x); v[r][j].z += w0 * bflo(a.y) + w1 * bflo(b.y); v[r][j].w += w0 * bfhi(a.y) + w1 * bfhi(b.y);
                        ((f32x4*)hr + C.lane)[64 * j] = v[r][j]; } }
            }
            if (WRITE_XN || ROUTER) {
#pragma unroll
                for (int r = 0; r < NR; ++r) { const int row = c * 256 + C.wave * 32 + i + r;
                    float s = 0.f;
#pragma unroll
                    for (int j = 0; j < 4; ++j) s += (v[r][j].x * v[r][j].x + v[r][j].y * v[r][j].y) + (v[r][j].z * v[r][j].z + v[r][j].w * v[r][j].w);
                    const float rstd = rsqrtf(wave_sum(s) * (1.f / DM) + EPS);
                    if (WRITE_XN && XN_FP8) { unsigned* o4 = (unsigned*)(ws + WS_XN + (size_t)row * DM) + C.lane;
#pragma unroll
                        for (int j = 0; j < 4; ++j) o4[64 * j] = pg8::pk4_fp8(v[r][j].x * rstd, v[r][j].y * rstd, v[r][j].z * rstd, v[r][j].w * rstd); }
                    if (WRITE_XN && !XN_FP8) { v2u* o8 = (v2u*)((bf16*)(ws + WS_XN) + (size_t)row * DM) + C.lane;
#pragma unroll
                        for (int j = 0; j < 4; ++j) { v2u w; w.x = pk2(v[r][j].x * rstd, v[r][j].y * rstd); w.y = pk2(v[r][j].z * rstd, v[r][j].w * rstd); o8[64 * j] = w; } }
                    if (ROUTER) {
                        float lg[8];
#pragma unroll
                        for (int e = 0; e < 8; ++e) lg[e] = 0.f;
#pragma unroll
                        for (int j = 0; j < 4; ++j) { const int k0 = 4 * C.lane + 256 * j; const f32x4 g4 = *(const f32x4*)(rgain + k0);
#pragma unroll
                            for (int q = 0; q < 4; ++q) { const float xv = v[r][j][q] * rstd * g4[q]; const f32x4 wa = *(const f32x4*)(rw + (size_t)(k0 + q) * 8), wb = *(const f32x4*)(rw + (size_t)(k0 + q) * 8 + 4);
                                lg[0] += xv * wa.x; lg[1] += xv * wa.y; lg[2] += xv * wa.z; lg[3] += xv * wa.w; lg[4] += xv * wb.x; lg[5] += xv * wb.y; lg[6] += xv * wb.z; lg[7] += xv * wb.w; } }
#pragma unroll
                        for (int e = 0; e < 8; ++e) lg[e] = wave_sum(lg[e]);
                        int e0 = 0; float v0 = lg[0];
#pragma unroll
                        for (int e = 1; e < 8; ++e) if (lg[e] > v0) { v0 = lg[e]; e0 = e; }
                        int e1 = -1; float v1 = -INFINITY;
#pragma unroll
                        for (int e = 0; e < 8; ++e) if (e != e0 && (e1 < 0 || lg[e] > v1)) { v1 = lg[e]; e1 = e; }
                        const float ex = expf(v1 - v0), w0 = 1.f / (1.f + ex), w1 = ex / (1.f + ex);
                        if (C.lane == 0) { ((int4*)(ws + WS_ROUTE))[row] = make_int4(e0 | (e1 << 8), __builtin_bit_cast(int, w0), __builtin_bit_cast(int, w1), 0);
                            atomicAdd((int*)&cnt8[e0], 1); atomicAdd((int*)&cnt8[e1], 1); }
                    }
                }
            }
        }
        if (ROUTER) { __syncthreads(); if (C.tid < 8) ((int*)(ws + WS_RCNT))[c * 8 + C.tid] = cnt8[C.tid]; }
    }
}

__device__ __forceinline__ void p_gather(Ctx& C) {
    unsigned char* ws = C.ws;
    LAS int* tot = (LAS int*)(C.lds + 0);
    LAS int* pre = tot + 8;
    LAS int* base = tot + 16;
    LAS int* ee = tot + 32;
    LAS int* sl = tot + 32 + 256;
    const int* rcnt = (const int*)(ws + WS_RCNT);
    const int4* route = (const int4*)(ws + WS_ROUTE);
    for (int c = C.bid; c < 256; c += C.G) {
        __syncthreads();
        { const int e = C.wave; int t = 0, p = 0;
          for (int i = C.lane; i < 256; i += 64) { const int v = rcnt[i * 8 + e]; t += v; if (i < c) p += v; }
#pragma unroll
          for (int o = 32; o >= 1; o >>= 1) { t += __shfl_xor(t, o); p += __shfl_xor(p, o); }
          if (C.lane == 0) { tot[e] = t; pre[e] = p; } }
        if (C.tid < 256) ee[C.tid] = route[c * 256 + C.tid].x;
        __syncthreads();
        if (C.tid == 0) { int off = 0; for (int e = 0; e < 8; ++e) { base[e] = off + pre[e]; const int nt = (tot[e] + 255) >> 8;
                if (c == 0) { int* te = (int*)(ws + WS_RTAB); for (int q = 0; q < nt; ++q) te[(off >> 8) + q] = e; }
                off += nt << 8; }
            if (c == 0) ((int*)(ws + WS_RTAB))[1024] = off >> 8; }
        __syncthreads();
        if (C.tid < 8) { const int e = C.tid; int r = base[e];
            for (int i = 0; i < 256; ++i) { const int pk = ee[i]; if ((pk & 255) == e) sl[2 * i] = r++; if ((pk >> 8) == e) sl[2 * i + 1] = r++; } }
        __syncthreads();
        if (C.tid < 256) ((int2*)(ws + WS_SLOT))[c * 256 + C.tid] = make_int2(sl[2 * C.tid], sl[2 * C.tid + 1]);
        for (int i = 0; i < 32; i += 4) { v4u a[4];
#pragma unroll
            for (int r = 0; r < 4; ++r) a[r] = *((const v4u*)(ws + WS_XN + (size_t)(c * 256 + C.wave * 32 + i + r) * DM) + C.lane);
#pragma unroll
            for (int r = 0; r < 4; ++r) { const int tl = C.wave * 32 + i + r;
                *((v4u*)(ws + R_XP + (size_t)sl[2 * tl] * DM) + C.lane) = a[r]; *((v4u*)(ws + R_XP + (size_t)sl[2 * tl + 1] * DM) + C.lane) = a[r]; } }
    }
}

__device__ __forceinline__ void p_post_kv(Ctx& C) {
    unsigned char* ws = C.ws;
    const bf16* raw = (const bf16*)(ws + R_QKV);
    const float* kn = C.inp(I_KN);
    LAS unsigned char* tl = C.lds + C.wave * 4608;
    const int l = C.lane, c8 = l & 7, r8 = l >> 3, gw = C.bid * NWAVES + C.wave, NGW = C.G * NWAVES;
    for (int it = gw; it < 128 * 64; it += NGW) {
        const int bg = it >> 6, blk = it & 63, b = bg >> 2, g = bg & 3;
        const bf16* rb = raw + (size_t)(b * SEQ + blk * 32) * 2816 + g * 64 + 8 * c8;
        const size_t dst0 = ((size_t)bg * SEQ + blk * 32) * 64 + 8 * c8;
#pragma unroll
        for (int j = 0; j < 6; ++j) {
            v4u x[4];
#pragma unroll
            for (int i = 0; i < 4; ++i) x[i] = *(const v4u*)(rb + (size_t)(r8 + 8 * i) * 2816 + j * 256);
            if (j == 0 || j == 1) {
                bf16* d = (bf16*)(ws + (j == 0 ? R_KCR : R_VCR)) + dst0;
#pragma unroll
                for (int i = 0; i < 4; ++i) *(v4u*)(d + (size_t)(r8 + 8 * i) * 64) = x[i];
            } else if (j == 2 || j == 4) {
                unsigned char* d = ws + (j == 2 ? R_KS : R_KW) + ((size_t)bg * SEQ + blk * 32) * 64 + (c8 >> 2) * 1024 + (c8 & 3) * 8; const float* gk = kn + (j == 2 ? 64 : 128) + 8 * c8;
                const f32x4 ga = *(const f32x4*)gk, gb = *(const f32x4*)(gk + 4);
#pragma unroll
                for (int i = 0; i < 4; ++i) { const float f[8] = {bflo(x[i].x), bfhi(x[i].x), bflo(x[i].y), bfhi(x[i].y), bflo(x[i].z), bfhi(x[i].z), bflo(x[i].w), bfhi(x[i].w)};
                    float ss = (f[0] * f[0] + f[1] * f[1]) + (f[2] * f[2] + f[3] * f[3]) + (f[4] * f[4] + f[5] * f[5]) + (f[6] * f[6] + f[7] * f[7]);
                    ss += __shfl_xor(ss, 1); ss += __shfl_xor(ss, 2); ss += __shfl_xor(ss, 4);
                    const float rs = rsqrtf(ss * (1.f / 64.f) + EPS);
                    v2u o; o.x = pg8::pk4_fp8(f[0] * rs * ga.x, f[1] * rs * ga.y, f[2] * rs * ga.z, f[3] * rs * ga.w); o.y = pg8::pk4_fp8(f[4] * rs * gb.x, f[5] * rs * gb.y, f[6] * rs * gb.z, f[7] * rs * gb.w);
                    *(v2u*)(d + (size_t)(r8 + 8 * i) * 32) = o; }
            } else {
#pragma unroll
                for (int i = 0; i < 4; ++i) *(LAS v4u*)(tl + (r8 + 8 * i) * 144 + 16 * c8) = x[i];
                LDS_WAIT();
                unsigned wv[8];
#pragma unroll
                for (int t4 = 0; t4 < 8; ++t4) { const float a0 = bf2f(*(const LAS bf16*)(tl + (4 * t4) * 144 + 2 * l)), a1 = bf2f(*(const LAS bf16*)(tl + (4 * t4 + 1) * 144 + 2 * l)),
                                                             a2 = bf2f(*(const LAS bf16*)(tl + (4 * t4 + 2) * 144 + 2 * l)), a3 = bf2f(*(const LAS bf16*)(tl + (4 * t4 + 3) * 144 + 2 * l)); wv[t4] = pg8::pk4_fp8(a0, a1, a2, a3); }
                unsigned char* d = ws + (j == 3 ? R_VST : R_VWT) + (((size_t)bg * 64 + blk) * 64 + l) * 32;
#pragma unroll
                for (int q = 0; q < 2; ++q) { const v4u o = {wv[4 * q], wv[4 * q + 1], wv[4 * q + 2], wv[4 * q + 3]}; *(v4u*)(d + 16 * q) = o; }
                LDS_WAIT();
            }
        }
    }
}

__device__ __forceinline__ void p_cmp2(Ctx& C) {
    unsigned char* ws = C.ws;
    const bf16* Hk = (const bf16*)(ws + WS_HC); const bf16* Hv = Hk + (size_t)16384 * 256;
    const float* w2k = C.inp(I_CW2K); const float* w2v = C.inp(I_CW2V); const float* kn = C.inp(I_KN);
    LAS float* hk = (LAS float*)(C.lds + C.wave * 2048); LAS float* hv = hk + 256;
    const int l = C.lane, gw = C.bid * NWAVES + C.wave, NGW = C.G * NWAVES;
    for (int r = gw; r < 16384; r += NGW) {
        const int bg = r >> 7, c = r & 127;
        { const v2u a = *((const v2u*)(Hk + (size_t)r * 256) + l), bq = *((const v2u*)(Hv + (size_t)r * 256) + l);
          hk[4 * l] = bflo(a.x); hk[4 * l + 1] = bfhi(a.x); hk[4 * l + 2] = bflo(a.y); hk[4 * l + 3] = bfhi(a.y);
          hv[4 * l] = bflo(bq.x); hv[4 * l + 1] = bfhi(bq.x); hv[4 * l + 2] = bflo(bq.y); hv[4 * l + 3] = bfhi(bq.y); }
        LDS_WAIT();
        float ak = 0.f, av = 0.f;
#pragma unroll 8
        for (int j = 0; j < 256; ++j) { ak += hk[j] * w2k[j * 64 + l]; av += hv[j] * w2v[j * 64 + l]; }
        if (c == 127) { ak = 0.f; av = 0.f; }
        const float rs = rsqrtf(wave_sum(ak * ak) * (1.f / 64.f) + EPS);
        ((bf16*)(ws + WS_KC))[((size_t)bg * 128 + 32 * (c >> 5)) * 64 + (l >> 5) * 1024 + (c & 31) * 32 + (l & 31)] = (bf16)f2bf(ak * rs * kn[l]);
        ((bf16*)(ws + WS_VCT))[(((size_t)bg * 4 + (c >> 5)) * 64 + l) * 32 + (c & 31)] = (bf16)f2bf(av);
        LDS_WAIT();
    }
}

typedef short bf16x8v __attribute__((ext_vector_type(8)));
#define MFMA16(a, b, c) __builtin_amdgcn_mfma_f32_16x16x32_bf16((a), (b), (c), 0, 0, 0)
constexpr float LOG2E = 1.4426950408889634f;
__device__ __forceinline__ float xmax_q4(float v) {
    float t;
    asm volatile("v_mov_b32 %1, %0\n\ts_nop 1\n\tv_permlane16_swap_b32 %0, %1\n\ts_nop 1\n\tv_max_f32 %0, %0, %1\n\tv_mov_b32 %1, %0\n\ts_nop 1\n\tv_permlane32_swap_b32 %0, %1\n\ts_nop 1\n\tv_max_f32 %0, %0, %1" : "+v"(v), "=&v"(t));
    return v;
}
__device__ __forceinline__ f32x4 att_mma(bf16x8v a, bf16x8v b, f32x4 c) { return __builtin_amdgcn_mfma_f32_16x16x32_bf16(a, b, c, 0, 0, 0); }
__device__ __forceinline__ f32x4 att_mma(long a, long b, f32x4 c) { return __builtin_amdgcn_mfma_f32_16x16x32_fp8_fp8(a, b, c, 0, 0, 0); }
__device__ __forceinline__ void att_pack(bf16x8v& pf, const float (&p)[8], bool keep) {
    unsigned w0 = pg8::cvt_pk_bf16(p[0], p[1]), w1 = pg8::cvt_pk_bf16(p[2], p[3]), w2 = pg8::cvt_pk_bf16(p[4], p[5]), w3 = pg8::cvt_pk_bf16(p[6], p[7]);
    if (!keep) { w0 = 0u; w1 = 0u; w2 = 0u; w3 = 0u; }
    const v4u w = {w0, w1, w2, w3}; pf = __builtin_bit_cast(bf16x8v, w); }
__device__ __forceinline__ void att_pack(long& pf, const float (&p)[8], bool keep) {
    unsigned w0 = pg8::pk4_fp8(p[0], p[1], p[2], p[3]), w1 = pg8::pk4_fp8(p[4], p[5], p[6], p[7]);
    if (!keep) { w0 = 0u; w1 = 0u; }
    const v2u w = {w0, w1}; pf = __builtin_bit_cast(long, w); }
template <class FR> struct AttKV { FR ka[2], kb[2], vf[4]; };
template <class FR, bool NOPV>
__device__ __forceinline__ void attn_kv_load(AttKV<FR>& f, const void* __restrict__ Kb, unsigned koff, const void* __restrict__ Vb, unsigned voff, int k0) {
    constexpr int SH = sizeof(FR) == 16 ? 0 : 1;
    const char* kblk = (const char*)Kb + (((size_t)k0 * 128) >> SH); const char* vblk = (const char*)Vb + (((size_t)k0 * 128) >> SH);
#pragma unroll
    for (int ks = 0; ks < 2; ++ks) { f.ka[ks] = *(const FR*)(kblk + koff + ((2048 * ks) >> SH)); f.kb[ks] = *(const FR*)(kblk + koff + ((256 + 2048 * ks) >> SH)); }
    if (!NOPV) {
#pragma unroll
        for (int dt = 0; dt < 4; ++dt) f.vf[dt] = *(const FR*)(vblk + voff + ((1024 * dt) >> SH)); }
}
template <int MODE, int PATH, class FR, bool NOPV = false>
__device__ __forceinline__ void attn_step(const AttKV<FR>& f, int k0, int trel, bool tk, int cmax,
                                          const FR (&qf)[2][2], const f32x4 (&bv)[2], float (&m)[2], float (&ls)[2], f32x4 (&o)[2][4], const float (&sl2)[2], int q4) {
    constexpr int DMUL = (MODE == 0) ? 16 : 1;
    const float trelf = (float)trel;
    bool ok[8];
    if (PATH == 2) {
#pragma unroll
        for (int i = 0; i < 8; ++i) { const int kk = 8 * q4 + i; const int d = trel - DMUL * kk; ok[i] = (MODE == 0) ? (k0 + kk <= cmax) : (MODE == 1 ? (tk && d >= 0) : (d >= 0 && d < 512)); } }
#pragma unroll
    for (int h = 0; h < 2; ++h) {
        f32x4 sa = att_mma(f.ka[0], qf[h][0], bv[0] * ((float)DMUL * sl2[h])), sb = att_mma(f.kb[0], qf[h][0], bv[1] * ((float)DMUL * sl2[h])); sa = att_mma(f.ka[1], qf[h][1], sa); sb = att_mma(f.kb[1], qf[h][1], sb);
        float mref = m[h] + sl2[h] * trelf;
        float mx;
        if (PATH == 2) { mx = -1e30f;
#pragma unroll
            for (int i = 0; i < 8; ++i) { const float v = i < 4 ? sa[i] : sb[i - 4]; mx = ok[i] ? fmaxf(mx, v) : mx; } }
        else { mx = fmaxf(fmaxf(fmaxf(sa[0], sa[1]), fmaxf(sa[2], sa[3])), fmaxf(fmaxf(sb[0], sb[1]), fmaxf(sb[2], sb[3]))); if (PATH == 1) mx = tk ? mx : -1e30f; }
        mx = xmax_q4(mx);
        if (__any(mx > mref + 8.f)) { const float mn = fmaxf(mref, mx), alpha = __builtin_amdgcn_exp2f(mref - mn); m[h] = mn - sl2[h] * trelf; mref = mn; ls[h] *= alpha;
            if (!NOPV) {
#pragma unroll
                for (int dt = 0; dt < 4; ++dt) o[h][dt] = o[h][dt] * alpha; } }
        float p[8]; float psum = 0.f;
#pragma unroll
        for (int i = 0; i < 8; ++i) { const float e = __builtin_amdgcn_exp2f((i < 4 ? sa[i] : sb[i - 4]) - mref); p[i] = (PATH == 2) ? (ok[i] ? e : 0.f) : e; psum += p[i]; }
        if (PATH == 1) psum = tk ? psum : 0.f;
        ls[h] += psum;
        FR pf; att_pack(pf, p, PATH == 1 ? tk : true);
        if (!NOPV) {
#pragma unroll
            for (int dt = 0; dt < 4; ++dt) o[h][dt] = att_mma(f.vf[dt], pf, o[h][dt]); }
    }
}
constexpr int PSW = 132;
__device__ __forceinline__ void p_attn_fast(Ctx& C, unsigned* queue, const int ld, const int qo, const float* qn) {
    unsigned char* ws = C.ws;
    const bf16* Qraw = (const bf16*)(ws + R_QKV);
    const bf16* KC = (const bf16*)(ws + WS_KC); const bf16* VCT = (const bf16*)(ws + WS_VCT);
    const unsigned char* KS = ws + R_KS; const unsigned char* VST = ws + R_VST; const unsigned char* KW = ws + R_KW; const unsigned char* VWT = ws + R_VWT;
    bf16* O = (bf16*)(ws + R_O);
    LAS float* psl = (LAS float*)(C.lds + C.wave * (16 * PSW * 4));
    int qsel = (int)(xb_xcc_id() & 7u), qtry = 0;
    for (;;) {
        int l = C.lane; asm volatile("" : "+v"(l));
        const int r16 = l & 15, q4 = l >> 4;
        const unsigned koff = (unsigned)((8 * (r16 >> 2) + (r16 & 3)) * 64 + 16 * q4), voff = (unsigned)((r16 * 32 + 8 * q4) * 2);
        unsigned u = 0; if (l == 0) u = __hip_atomic_fetch_add(queue + 64 * qsel, 1u, __ATOMIC_RELAXED, __HIP_MEMORY_SCOPE_AGENT);
        u = (unsigned)__builtin_amdgcn_readfirstlane((int)u);
        if (u >= 2048u) { if (++qtry >= 8) break; qsel = (qsel + 1) & 7; continue; }
        u = ((u >> 7) * 8 + (unsigned)qsel) * 128 + (u & 127);
        const int bg = (int)(u >> 7), tile = 127 - (int)(u & 127), g = bg & 3, b = bg >> 2, t0 = tile * 16, t = t0 + r16, row = b * SEQ + t;
#define qrow (Qraw + (size_t)row * ld + qo)
#define gtp (qrow + 1024 + g * 12)
#define orow (O + (size_t)row * DM + g * 256 + 4 * q4)
        bf16x8v qf[2][2]; long qf8[2][2]; float sl2[2]; f32x4 bv[2]; float m[2]; float ls[2]; f32x4 o[2][4];
#define ATT_LOADQ(hp, DM_) do { _Pragma("unroll") for (int i_ = 0; i_ < 4; ++i_) { bv[0][i_] = (float)(8 * q4 + i_); bv[1][i_] = (float)(8 * q4 + 4 + i_); } \
            _Pragma("unroll") for (int h = 0; h < 2; ++h) { sl2[h] = exp2f(-0.5f * (float)(g * 4 + 2 * (hp) + h + 1)) * LOG2E; \
            float xq_[2][8]; float ssq_ = 0.f; \
            _Pragma("unroll") for (int ks = 0; ks < 2; ++ks) { const v4u r_ = *(const v4u*)(qrow + (g * 4 + 2 * (hp) + h) * 64 + 32 * ks + 8 * q4); \
                xq_[ks][0] = bflo(r_.x); xq_[ks][1] = bfhi(r_.x); xq_[ks][2] = bflo(r_.y); xq_[ks][3] = bfhi(r_.y); xq_[ks][4] = bflo(r_.z); xq_[ks][5] = bfhi(r_.z); xq_[ks][6] = bflo(r_.w); xq_[ks][7] = bfhi(r_.w); \
                _Pragma("unroll") for (int j_ = 0; j_ < 8; ++j_) ssq_ += xq_[ks][j_] * xq_[ks][j_]; } \
            ssq_ += __shfl_xor(ssq_, 16); ssq_ += __shfl_xor(ssq_, 32); \
            const float rq_ = rsqrtf(ssq_ * (1.f / 64.f) + EPS) * (0.125f * LOG2E); \
            _Pragma("unroll") for (int ks = 0; ks < 2; ++ks) { const f32x4 ga_ = *(const f32x4*)(qn + 32 * ks + 8 * q4), gb_ = *(const f32x4*)(qn + 32 * ks + 8 * q4 + 4); \
                const v4u w_ = {pg8::cvt_pk_bf16(xq_[ks][0] * rq_ * ga_.x, xq_[ks][1] * rq_ * ga_.y), pg8::cvt_pk_bf16(xq_[ks][2] * rq_ * ga_.z, xq_[ks][3] * rq_ * ga_.w), \
                                pg8::cvt_pk_bf16(xq_[ks][4] * rq_ * gb_.x, xq_[ks][5] * rq_ * gb_.y), pg8::cvt_pk_bf16(xq_[ks][6] * rq_ * gb_.z, xq_[ks][7] * rq_ * gb_.w)}; \
                qf[h][ks] = __builtin_bit_cast(bf16x8v, w_); \
                const v2u w8_ = {pg8::pk4_fp8(xq_[ks][0] * rq_ * ga_.x, xq_[ks][1] * rq_ * ga_.y, xq_[ks][2] * rq_ * ga_.z, xq_[ks][3] * rq_ * ga_.w), pg8::pk4_fp8(xq_[ks][4] * rq_ * gb_.x, xq_[ks][5] * rq_ * gb_.y, xq_[ks][6] * rq_ * gb_.z, xq_[ks][7] * rq_ * gb_.w)}; \
                qf8[h][ks] = __builtin_bit_cast(long, w8_); } } } while (0)
#define ATT_RESET() do { _Pragma("unroll") for (int h = 0; h < 2; ++h) { m[h] = -1e30f; ls[h] = 0.f; _Pragma("unroll") for (int dt = 0; dt < 4; ++dt) o[h][dt] = (f32x4){0.f, 0.f, 0.f, 0.f}; } } while (0)
        const int cmax = t >= 31 ? (((t - 31) >> 4) < 126 ? ((t - 31) >> 4) : 126) : -1;
        const int cmax0 = t0 >= 31 ? (((t0 - 31) >> 4) < 126 ? ((t0 - 31) >> 4) : 126) : -1;
        const bf16* KCb = KC + (size_t)bg * 128 * 64; const bf16* VCb = VCT + (size_t)bg * 128 * 64;
        const int ncs = ((t0 + 15 - 31) >> 4) < 0 ? 0 : ((((t0 + 15 - 31) >> 4) < 126 ? ((t0 + 15 - 31) >> 4) : 126) >> 5) + 1;
#pragma unroll 1
        for (int hp = 0; hp < 2; ++hp) {
            ATT_LOADQ(hp, 16); ATT_RESET();
            for (int st = ncs - 1; st >= 0; --st) {
                AttKV<bf16x8v> fc; attn_kv_load<bf16x8v, true>(fc, KCb, koff, VCb, voff, 32 * st);
                if (32 * st + 31 <= cmax0) attn_step<0, 0, bf16x8v, true>(fc, 32 * st, t - 31 - 16 * 32 * st, true, cmax, qf, bv, m, ls, o, sl2, q4);
                else attn_step<0, 2, bf16x8v, true>(fc, 32 * st, t - 31 - 16 * 32 * st, true, cmax, qf, bv, m, ls, o, sl2, q4); }
#pragma unroll
            for (int h = 0; h < 2; ++h) { float lt = ls[h]; lt += __shfl_xor(lt, 16); lt += __shfl_xor(lt, 32); ls[h] = lt; }
            float ps[4][8];
#pragma unroll
            for (int st = 0; st < 4; ++st)
#pragma unroll
                for (int i = 0; i < 8; ++i) ps[st][i] = 0.f;
#pragma unroll
            for (int st = 0; st < 4; ++st) {
                if (st < ncs) {
                    const int k0 = 32 * st; const char* kblk = (const char*)(KCb + (size_t)k0 * 64);
                    bf16x8v ka[2], kb[2];
#pragma unroll
                    for (int ks = 0; ks < 2; ++ks) { ka[ks] = *(const bf16x8v*)(kblk + koff + 2048 * ks); kb[ks] = *(const bf16x8v*)(kblk + koff + 256 + 2048 * ks); }
#pragma unroll
                    for (int h = 0; h < 2; ++h) {
                        f32x4 sa = MFMA16(ka[0], qf[h][0], bv[0] * (16.f * sl2[h])), sb = MFMA16(kb[0], qf[h][0], bv[1] * (16.f * sl2[h])); sa = MFMA16(ka[1], qf[h][1], sa); sb = MFMA16(kb[1], qf[h][1], sb);
                        const float lt = ls[h], inv = lt > 0.f ? 1.f / lt : 0.f, mref = m[h] + sl2[h] * (float)(t - 31 - 16 * k0);
#pragma unroll
                        for (int i = 0; i < 8; ++i) { const int c = k0 + 8 * q4 + i; ps[st][i] += (c <= cmax) ? __builtin_amdgcn_exp2f((i < 4 ? sa[i] : sb[i - 4]) - mref) * inv : 0.f; }
                    }
                }
            }
#pragma unroll
            for (int st = 0; st < 4; ++st) { LAS f32x4* p0 = (LAS f32x4*)(psl + r16 * PSW + 32 * st + 8 * q4);
                f32x4 a = {ps[st][0], ps[st][1], ps[st][2], ps[st][3]}, bq = {ps[st][4], ps[st][5], ps[st][6], ps[st][7]};
                if (hp) { a = a + p0[0]; bq = bq + p0[1]; }
                p0[0] = a; p0[1] = bq; }
            LDS_WAIT();
        }
        unsigned mlo, mhi;
        {
            float sc[16]; const LAS float* pr = psl + r16 * PSW + 32 * q4; const int cur = t >> 5;
            float prev = q4 > 0 ? pr[-1] : 0.f;
#pragma unroll
            for (int jj = 0; jj < 16; ++jj) { const float a = pr[2 * jj], bq = pr[2 * jj + 1]; const float imp = prev + a + bq; prev = bq;
                const int j = 16 * q4 + jj; const bool valid = 32 * j <= t; const bool forced = valid && (j == 0 || j == cur || j == cur - 1);
                sc[jj] = forced ? 1e9f : (valid ? imp : -1e9f); }
            unsigned my = 0u;
#pragma unroll 1
            for (int r = 0; r < 8; ++r) {
                float best = sc[0]; int bi = 0;
#pragma unroll
                for (int jj = 1; jj < 16; ++jj) if (sc[jj] > best) { best = sc[jj]; bi = jj; }
                bi += 16 * q4;
#pragma unroll
                for (int sh = 16; sh <= 32; sh <<= 1) { const float ov = __shfl_xor(best, sh); const int oi = __shfl_xor(bi, sh); if (ov > best || (ov == best && oi < bi)) { best = ov; bi = oi; } }
                if ((bi >> 4) == q4) { const int jj0 = bi & 15; if (best > -0.5e9f) my |= 1u << jj0;
#pragma unroll
                    for (int jj = 0; jj < 16; ++jj) if (jj == jj0) sc[jj] = -INFINITY; }
            }
            mlo = (q4 == 0 ? my : 0u) | (q4 == 1 ? my << 16 : 0u); mhi = (q4 == 2 ? my : 0u) | (q4 == 3 ? my << 16 : 0u);
            mlo |= __shfl_xor(mlo, 16); mlo |= __shfl_xor(mlo, 32); mhi |= __shfl_xor(mhi, 16); mhi |= __shfl_xor(mhi, 32);
        }
        LDS_WAIT();
        unsigned ulo = mlo, uhi = mhi;
#pragma unroll
        for (int sh = 1; sh <= 8; sh <<= 1) { ulo |= __shfl_xor(ulo, sh); uhi |= __shfl_xor(uhi, sh); }
        const unsigned long long un0 = ((unsigned long long)(unsigned)__builtin_amdgcn_readfirstlane((int)uhi) << 32) | (unsigned)__builtin_amdgcn_readfirstlane((int)ulo);
        const unsigned long long mine = ((unsigned long long)mhi << 32) | mlo;
#pragma unroll 1
        for (int hp = 0; hp < 2; ++hp) {
            const v2u g6raw = *(const v2u*)(gtp + 6 * hp); const unsigned g6x = gtp[6 * hp + 4], g6y = gtp[6 * hp + 5];
            v2u oacc[2][4];
#define ATT_GLOG(i) ((i) == 0 ? bflo(g6raw.x) : (i) == 1 ? bfhi(g6raw.x) : (i) == 2 ? bflo(g6raw.y) : (i) == 3 ? bfhi(g6raw.y) : (i) == 4 ? bf2f(g6x) : bf2f(g6y))
#define ATT_FOLD(br, first) do { _Pragma("unroll") for (int h = 0; h < 2; ++h) { float lt = ls[h]; lt += __shfl_xor(lt, 16); lt += __shfl_xor(lt, 32); const float sc_ = lt > 0.f ? (1.f / (1.f + __expf(-ATT_GLOG(h * 3 + (br))))) / lt : 0.f; \
            _Pragma("unroll") for (int dt = 0; dt < 4; ++dt) { f32x4 r_ = o[h][dt] * sc_; \
                if (!(first)) { r_[0] += bflo(oacc[h][dt].x); r_[1] += bfhi(oacc[h][dt].x); r_[2] += bflo(oacc[h][dt].y); r_[3] += bfhi(oacc[h][dt].y); } \
                oacc[h][dt].x = pg8::cvt_pk_bf16(r_[0], r_[1]); oacc[h][dt].y = pg8::cvt_pk_bf16(r_[2], r_[3]); } } } while (0)
            ATT_LOADQ(hp, 16); ATT_RESET();
            for (int st = ncs - 1; st >= 0; --st) {
                AttKV<bf16x8v> fc; attn_kv_load<bf16x8v, false>(fc, KCb, koff, VCb, voff, 32 * st);
                if (32 * st + 31 <= cmax0) attn_step<0, 0, bf16x8v>(fc, 32 * st, t - 31 - 16 * 32 * st, true, cmax, qf, bv, m, ls, o, sl2, q4);
                else attn_step<0, 2, bf16x8v>(fc, 32 * st, t - 31 - 16 * 32 * st, true, cmax, qf, bv, m, ls, o, sl2, q4); }
            ATT_FOLD(0, true);
            {
                const unsigned char* Kb = KS + (size_t)bg * SEQ * 64; const unsigned char* Vb = VST + (size_t)bg * SEQ * 64;
                ATT_RESET();
                unsigned long long un = un0;
                const int cur0 = t0 >> 5;
                AttKV<long> fn; int jn = 63 - __builtin_clzll(un); un &= ~(1ull << jn); attn_kv_load<long, false>(fn, Kb, koff >> 1, Vb, voff >> 1, 32 * jn);
#pragma unroll 1
                for (;;) { const int j = jn; const AttKV<long> fc = fn; const bool more = un != 0ull;
                    if (more) { jn = 63 - __builtin_clzll(un); un &= ~(1ull << jn); }
                    attn_kv_load<long, false>(fn, Kb, koff >> 1, Vb, voff >> 1, 32 * jn);
                    const bool tk = ((mine >> j) & 1ull) != 0ull;
                    if (j >= cur0) attn_step<1, 2, long>(fc, 32 * j, t - 32 * j, tk, 0, qf8, bv, m, ls, o, sl2, q4);
                    else if (__all(tk)) attn_step<1, 0, long>(fc, 32 * j, t - 32 * j, true, 0, qf8, bv, m, ls, o, sl2, q4);
                    else attn_step<1, 1, long>(fc, 32 * j, t - 32 * j, tk, 0, qf8, bv, m, ls, o, sl2, q4);
                    if (!more) break; }
                ATT_FOLD(1, false);
            }
            {
                const unsigned char* Kb = KW + (size_t)bg * SEQ * 64; const unsigned char* Vb = VWT + (size_t)bg * SEQ * 64;
                const int sb = t0 >= 511 ? (t0 - 511) >> 5 : 0, se = t0 >> 5;
                ATT_RESET();
                AttKV<long> fn; attn_kv_load<long, false>(fn, Kb, koff >> 1, Vb, voff >> 1, 32 * se);
#pragma unroll 1
                for (int st = se; st >= sb; --st) { const AttKV<long> fc = fn;
                    attn_kv_load<long, false>(fn, Kb, koff >> 1, Vb, voff >> 1, 32 * (st > sb ? st - 1 : st));
                    if (32 * st + 31 <= t0 && 32 * st > t0 - 497) attn_step<2, 0, long>(fc, 32 * st, t - 32 * st, true, 0, qf8, bv, m, ls, o, sl2, q4);
                    else attn_step<2, 2, long>(fc, 32 * st, t - 32 * st, true, 0, qf8, bv, m, ls, o, sl2, q4); }
                ATT_FOLD(2, false);
            }
#pragma unroll
            for (int h = 0; h < 2; ++h)
#pragma unroll
                for (int dt = 0; dt < 4; ++dt) *(v2u*)(orow + (2 * hp + h) * 64 + 16 * dt) = oacc[h][dt];
        }
#undef ATT_FOLD
#undef ATT_GLOG
#undef ATT_LOADQ
#undef ATT_RESET
#undef qrow
#undef gtp
#undef orow
    }
}

constexpr int SCQ = 272, SCT = 144;
constexpr int LQ_ = 0, LK_ = 17408, LKT_ = 34816, LVT_ = 53248, LP_ = 71680, LO_ = 80896, LE_ = 114688, LT_ = 115712;
#define SC_BAR() do { asm volatile("s_waitcnt lgkmcnt(0)" ::: "memory"); __builtin_amdgcn_s_barrier(); asm volatile("" ::: "memory"); } while (0)
__device__ __forceinline__ void p_scan_fast(Ctx& C, int layer) {
    unsigned char* ws = C.ws;
    const bf16* Pq = (const bf16*)(ws + R_PQ); const bf16* Pi = (const bf16*)(ws + R_PI); const bf16* Pg = (const bf16*)(ws + R_PG); const float* LF = (const float*)(ws + R_LF);
    bf16* O2 = (bf16*)(ws + R_O2);
    const float* gn = C.inp(I_HGN) + layer * 128;
    LAS unsigned char* L = C.lds;
    const int tid = C.tid, lane = C.lane, w = C.wave, r16 = lane & 15, q4 = lane >> 4, k = tid & 127, seg = tid >> 7;
    LAS float* tot = (LAS float*)(L + LT_); LAS float* eref = (LAS float*)(L + LE_); LAS float* elr = eref + 128;
    { const int tile = tid >> 8, e = tid & 255, row = e >> 4, col = e & 15;
      *(LAS bf16*)(L + LP_ + ((tile ? 32 : 0) + row) * SCT + ((tile ? 48 : 16) + col) * 2) = 0; }
    for (int bh = C.bid; bh < 256; bh += C.G) {
        const int b = bh >> 3, h = bh & 7;
        const size_t base = (size_t)(b * SEQ) * DM + h * 128;
        f32x4 S[8];
#pragma unroll
        for (int i = 0; i < 8; ++i) S[i] = (f32x4){0.f, 0.f, 0.f, 0.f};
        bf16 qv[16], vv[16]; float lf[16];
#define SC_LOAD(t0) do { _Pragma("unroll") for (int i = 0; i < 16; ++i) { const size_t off = base + (size_t)((t0) + 16 * seg + i) * DM + k; qv[i] = Pq[off]; vv[i] = Pi[off]; lf[i] = LF[off]; } } while (0)
        SC_LOAD(0);
#pragma unroll 1
        for (int c = 0; c < SEQ / 64; ++c) {
            const int t0 = c * 64;
            float cs[16]; { float run = 0.f;
#pragma unroll
                for (int i = 0; i < 16; ++i) { run += lf[i]; cs[i] = run; }
                tot[seg * 128 + k] = run; }
            SC_BAR();
            { const float a0 = tot[k], a1 = tot[128 + k], a2 = tot[256 + k], a3 = tot[384 + k];
              const float off = seg == 0 ? 0.f : (seg == 1 ? a0 : (seg == 2 ? a0 + a1 : a0 + a1 + a2)), ref = a0 + a1, last = ref + a2 + a3;
              unsigned kt[16];
#pragma unroll
              for (int i = 0; i < 16; ++i) { const float d = off + cs[i] - ref; const float qt = bf2f(qv[i]) * __expf(fminf(d, 80.f)), ktv = (1.f - __expf(lf[i])) * __expf(fminf(-d, 80.f));
                  const int s = 16 * seg + i; kt[i] = f2bf(ktv);
                  *(LAS bf16*)(L + LQ_ + s * SCQ + k * 2) = (bf16)f2bf(qt); *(LAS bf16*)(L + LK_ + s * SCQ + k * 2) = (bf16)kt[i]; }
              v4u w0, w1, x0, x1;
              w0.x = kt[0] | (kt[1] << 16); w0.y = kt[2] | (kt[3] << 16); w0.z = kt[4] | (kt[5] << 16); w0.w = kt[6] | (kt[7] << 16);
              w1.x = kt[8] | (kt[9] << 16); w1.y = kt[10] | (kt[11] << 16); w1.z = kt[12] | (kt[13] << 16); w1.w = kt[14] | (kt[15] << 16);
              x0.x = vv[0] | ((unsigned)vv[1] << 16); x0.y = vv[2] | ((unsigned)vv[3] << 16); x0.z = vv[4] | ((unsigned)vv[5] << 16); x0.w = vv[6] | ((unsigned)vv[7] << 16);
              x1.x = vv[8] | ((unsigned)vv[9] << 16); x1.y = vv[10] | ((unsigned)vv[11] << 16); x1.z = vv[12] | ((unsigned)vv[13] << 16); x1.w = vv[14] | ((unsigned)vv[15] << 16);
              *(LAS v4u*)(L + LKT_ + k * SCT + seg * 32) = w0; *(LAS v4u*)(L + LKT_ + k * SCT + seg * 32 + 16) = w1;
              *(LAS v4u*)(L + LVT_ + k * SCT + seg * 32) = x0; *(LAS v4u*)(L + LVT_ + k * SCT + seg * 32 + 16) = x1;
              if (seg == 0) { eref[k] = __expf(ref); elr[k] = __expf(last - ref); } }
            SC_BAR();
            if (c + 1 < SEQ / 64) SC_LOAD(t0 + 64);
            v4u g8p[2];
#pragma unroll
            for (int rep = 0; rep < 2; ++rep) g8p[rep] = *(const v4u*)(Pg + base + (size_t)(t0 + (tid >> 4) + 32 * rep) * DM + (tid & 15) * 8);
#pragma unroll 1
            for (int ti = w; ti < 10; ti += 8) {
                const int rt = ti < 1 ? 0 : (ti < 3 ? 1 : (ti < 6 ? 2 : 3)), ct = ti - (rt * (rt + 1)) / 2;
                f32x4 acc = {0.f, 0.f, 0.f, 0.f};
#pragma unroll
                for (int p = 0; p < 4; ++p) { const bf16x8v a = *(const LAS bf16x8v*)(L + LQ_ + (16 * rt + r16) * SCQ + (32 * p + 8 * q4) * 2), bq = *(const LAS bf16x8v*)(L + LK_ + (16 * ct + r16) * SCQ + (32 * p + 8 * q4) * 2);
                    acc = MFMA16(a, bq, acc); }
#pragma unroll
                for (int i = 0; i < 4; ++i) { const int t = 16 * rt + 4 * q4 + i, s = 16 * ct + r16; *(LAS bf16*)(L + LP_ + t * SCT + s * 2) = (bf16)f2bf(s <= t ? acc[i] : 0.f); }
            }
            SC_BAR();
            bf16x8v sfrag[4]; f32x4 e8[4][2];
#pragma unroll
            for (int p = 0; p < 4; ++p) { e8[p][0] = *(const LAS f32x4*)(eref + 32 * p + 8 * q4); e8[p][1] = *(const LAS f32x4*)(eref + 32 * p + 8 * q4 + 4);
                S[2 * p] = S[2 * p] * e8[p][0]; S[2 * p + 1] = S[2 * p + 1] * e8[p][1];
                const v4u wv = {pg8::cvt_pk_bf16(S[2 * p][0], S[2 * p][1]), pg8::cvt_pk_bf16(S[2 * p][2], S[2 * p][3]), pg8::cvt_pk_bf16(S[2 * p + 1][0], S[2 * p + 1][1]), pg8::cvt_pk_bf16(S[2 * p + 1][2], S[2 * p + 1][3])};
                sfrag[p] = __builtin_bit_cast(bf16x8v, wv); }
            bf16x8v vfr[2];
#pragma unroll
            for (int ss = 0; ss < 2; ++ss) vfr[ss] = *(const LAS bf16x8v*)(L + LVT_ + (16 * w + r16) * SCT + (32 * ss + 8 * q4) * 2);
#pragma unroll
            for (int rt = 0; rt < 4; ++rt) { f32x4 o = {0.f, 0.f, 0.f, 0.f};
#pragma unroll
                for (int p = 0; p < 4; ++p) { const bf16x8v a = *(const LAS bf16x8v*)(L + LQ_ + (16 * rt + r16) * SCQ + (32 * p + 8 * q4) * 2); o = MFMA16(a, sfrag[p], o); }
#pragma unroll
                for (int ss = 0; ss < 2; ++ss) if (ss <= rt / 2) { const bf16x8v a = *(const LAS bf16x8v*)(L + LP_ + (16 * rt + r16) * SCT + (32 * ss + 8 * q4) * 2); o = MFMA16(a, vfr[ss], o); }
#pragma unroll
                for (int i = 0; i < 4; ++i) *(LAS float*)(L + LO_ + (16 * rt + 4 * q4 + i) * 528 + (16 * w + r16) * 4) = o[i]; }
#pragma unroll
            for (int p = 0; p < 4; ++p)
#pragma unroll
                for (int ab = 0; ab < 2; ++ab) { const int krow = 32 * p + 8 * (r16 >> 2) + (r16 & 3) + 4 * ab;
#pragma unroll
                    for (int ss = 0; ss < 2; ++ss) { const bf16x8v a = *(const LAS bf16x8v*)(L + LKT_ + krow * SCT + (32 * ss + 8 * q4) * 2); S[2 * p + ab] = MFMA16(a, vfr[ss], S[2 * p + ab]); } }
#pragma unroll
            for (int p = 0; p < 4; ++p) { const f32x4 l0 = *(const LAS f32x4*)(elr + 32 * p + 8 * q4), l1 = *(const LAS f32x4*)(elr + 32 * p + 8 * q4 + 4); S[2 * p] = S[2 * p] * l0; S[2 * p + 1] = S[2 * p + 1] * l1; }
            SC_BAR();
#pragma unroll
            for (int rep = 0; rep < 2; ++rep) { const int tok = (tid >> 4) + 32 * rep, part = tid & 15;
                const f32x4 oa = *(const LAS f32x4*)(L + LO_ + tok * 528 + part * 32), ob = *(const LAS f32x4*)(L + LO_ + tok * 528 + part * 32 + 16);
                float ss = (oa.x * oa.x + oa.y * oa.y) + (oa.z * oa.z + oa.w * oa.w) + (ob.x * ob.x + ob.y * ob.y) + (ob.z * ob.z + ob.w * ob.w);
                ss += __shfl_xor(ss, 1); ss += __shfl_xor(ss, 2); ss += __shfl_xor(ss, 4); ss += __shfl_xor(ss, 8);
                const float rstd = rsqrtf(ss * (1.f / 128.f) + EPS);
                const size_t off = base + (size_t)(t0 + tok) * DM + part * 8; const v4u g8 = g8p[rep];
                const f32x4 ga = *(const f32x4*)(gn + part * 8), gb = *(const f32x4*)(gn + part * 8 + 4);
                v4u wv; wv.x = pk2(oa.x * rstd * ga.x * bflo(g8.x), oa.y * rstd * ga.y * bfhi(g8.x)); wv.y = pk2(oa.z * rstd * ga.z * bflo(g8.y), oa.w * rstd * ga.w * bfhi(g8.y));
                wv.z = pk2(ob.x * rstd * gb.x * bflo(g8.z), ob.y * rstd * gb.y * bfhi(g8.z)); wv.w = pk2(ob.z * rstd * gb.z * bflo(g8.w), ob.w * rstd * gb.w * bfhi(g8.w));
                *(v4u*)(O2 + off) = wv; }
        }
#undef SC_LOAD
        __syncthreads();
    }
}

#undef SC_BAR
#define PH_BEGIN { const bool run_ = (pid >= lo && pid < hi); ++pid; if (run_) { { int ln_; asm volatile("v_mbcnt_lo_u32_b32 %0, -1, 0\n\tv_mbcnt_hi_u32_b32 %0, -1, %0" : "=v"(ln_)); C.lane = ln_; C.tid = C.wave * 64 + ln_; }
#define PH_END   if (pid < hi) xcd_barrier(bar); } }
#define XN ((const bf16*)(ws + WS_XN))
#define RTAB ((const int*)(ws + WS_RTAB))

template <int L>
__device__ __forceinline__ void run_layer(Ctx& C, const XcdBarrier& bar, int& pid, const int lo, const int hi, PG8_LAS unsigned char* ring) {
    unsigned char* const ws = C.ws;

        const int li = L >> 1;
        if (L < 2) {
            PH_BEGIN { pg8::Gemm g{XN, (const bf16*)(ws + W_HIN) + (size_t)L * 4096 * 1024, 1024, 1024, 0}; pg8::GenOrder S; S.init(256, 16, C.G, C.bid, nullptr);
                pg8::EpiHgrnIn E{ws, L};
                pg8::gemm_phase<pg8::EpiHgrnIn, pg8::GenOrder, true, true>(ring, g, S, E, C.wave); } PH_END
            PH_BEGIN p_scan_fast(C, L); PH_END
        } else {
            PH_BEGIN { const bool first = (L == 2); pg8::Gemm g{XN, (const bf16*)(ws + (first ? W_KVQ : W_Q3)), 1024, 1024, 0}; pg8::GenOrder S; S.init(256, first ? 11 : 5, C.G, C.bid, nullptr);
                pg8::EpiBf16 E{(bf16*)(ws + R_QKV), first ? 2816 : 1280, nullptr, 0, 0, 1.f};
                pg8::gemm_phase<pg8::EpiBf16, pg8::GenOrder, true, true>(ring, g, S, E, C.wave); } PH_END
            if (L == 2) {
                PH_BEGIN p_post_kv(C); PH_END
                PH_BEGIN { pg8::Gemm g{(const bf16*)(ws + R_KCR), (const bf16*)(ws + W_CMP1), 2048, 1024, (size_t)256 * 2048 * 2}; pg8::GenOrder S; S.init(128, 1, C.G, C.bid, RTAB + 2048);
                    pg8::EpiBf16 E{(bf16*)(ws + WS_HC), 256, (const float*)(ws + WS_CB), 1, 256, 1.f};
                    pg8::gemm_phase<pg8::EpiBf16, pg8::GenOrder, true, true>(ring, g, S, E, C.wave); } PH_END
                PH_BEGIN p_cmp2(C); PH_END
            }
            PH_BEGIN p_attn_fast(C, (unsigned*)(ws + WS_CTL) + 8192 + 2048 * (L - 2), L == 2 ? 2816 : 1280, L == 2 ? 1536 : 0, C.inp(I_NQN) + (L - 2) * 64); PH_END
        }
        PH_BEGIN { pg8::Gemm g{(const bf16*)(ws + (L < 2 ? R_O2 : R_O)), (const bf16*)(ws + (L < 2 ? W_HOUT : W_NOUT)) + (size_t)(L & 1) * 1024 * 1024, 1024, 1024, 0};
            pg8::GenOrder S; S.init(256, 4, C.G, C.bid, nullptr);
            pg8::EpiRes E{L == 0 ? C.inp(I_X) : C.out, C.out, 1024, 1.f};
            pg8::gemm_phase<pg8::EpiRes, pg8::GenOrder, true, true>(ring, g, S, E, C.wave); } PH_END
        PH_BEGIN { if (L & 1) p_norm<false, true, true, true>(C, C.inp(I_MR) + (size_t)li * 1024 * 8, C.inp(I_NFFN) + L * 1024); else if (L == 2) p_norm<false, false, true, true>(C, nullptr, nullptr); else p_norm<false, false, true, false>(C, nullptr, nullptr); } PH_END
        if (L & 1) { PH_BEGIN p_gather(C); PH_END }
        if (L == 0) {
            PH_BEGIN { pg8::Gemm g{XN, (const bf16*)(ws + W_FGU), 1024, 1024, 0};
                pg8::GenOrder S; S.init(256, 22, C.G, C.bid, nullptr);
                pg8::EpiSwiGLU E{(bf16*)(ws + R_HF), DFF};
                pg8::gemm_phase<pg8::EpiSwiGLU, pg8::GenOrder, true, true>(ring, g, S, E, C.wave); } PH_END
            PH_BEGIN { pg8::Gemm g{(const bf16*)(ws + R_HF), (const bf16*)(ws + W_FDN), DFF, DFF, 0}; pg8::GenOrder S; S.init(256, 4, C.G, C.bid, nullptr);
                pg8::EpiRes E{C.out, C.out, 1024, 1.f};
                pg8::gemm_phase<pg8::EpiRes, pg8::GenOrder, true, true>(ring, g, S, E, C.wave); } PH_END
            PH_BEGIN p_norm<false, false, true>(C, nullptr, nullptr); PH_END
        } else {
        PH_BEGIN { const bool moe = (L & 1) != 0;
            pg8::Gemm g{(const bf16*)(ws + (moe ? R_XP : WS_XN)), (const bf16*)(ws + (moe ? W_MGU + (size_t)li * 8 * 2 * DFE * 1024 : W_FGU + (size_t)li * 2 * DFF * 2048)), 512, 512, moe ? (size_t)2 * DFE * 1024 : 0};
            pg8::GenOrder S; S.init(moe ? RTAB[1024] : 256, moe ? 28 : 22, C.G, C.bid, moe ? RTAB : nullptr);
            pg8::EpiSwiGLU8 E{ws + (moe ? R_HM : R_HF), moe ? DFE : DFF};
            pg8::gemm_phase<pg8::EpiSwiGLU8, pg8::GenOrder, true, true, true>(ring, g, S, E, C.wave); } PH_END
        if (!(L & 1)) {
            PH_BEGIN { pg8::Gemm g{(const bf16*)(ws + R_HF), (const bf16*)(ws + W_FDN + (size_t)li * 1024 * DFF * 2), DFF / 2, DFF / 2, 0}; pg8::GenOrder S; S.init(256, 4, C.G, C.bid, nullptr);
                pg8::EpiRes E{C.out, C.out, 1024, 1.f / (pg8::FP8_SH * pg8::FP8_SW2)};
                pg8::gemm_phase<pg8::EpiRes, pg8::GenOrder, true, true, true>(ring, g, S, E, C.wave); } PH_END
            PH_BEGIN p_norm<false, false, true>(C, nullptr, nullptr); PH_END
        } else {
            PH_BEGIN { pg8::Gemm g{(const bf16*)(ws + R_HM), (const bf16*)(ws + W_MDN + (size_t)li * 8 * 1024 * DFE), DFE / 2, DFE / 2, (size_t)1024 * DFE}; pg8::GenOrder S; S.init(RTAB[1024], 4, C.G, C.bid, RTAB);
                pg8::EpiBf16 E{(bf16*)(ws + R_XP), 1024, nullptr, 0, 0, 1.f / (pg8::FP8_SH * pg8::FP8_SW2)};
                pg8::gemm_phase<pg8::EpiBf16, pg8::GenOrder, true, true, true>(ring, g, S, E, C.wave); } PH_END
            PH_BEGIN { if (L == 1) p_norm<true, false, true>(C, nullptr, nullptr); else p_norm<true, false, false>(C, nullptr, nullptr); } PH_END
        }
        }
    }

struct Args { const float* in[24]; float* out; unsigned char* ws; int ph_lo, ph_hi; };
constexpr int N_PHASES = 34;

__global__ void __launch_bounds__(NWAVES * 64, 2) yoco_fwd(Args args) {
    extern __shared__ __attribute__((aligned(16))) unsigned char lds_raw[];
    Ctx C;
    C.lds = (LAS unsigned char*)lds_raw;
    C.wave = __builtin_amdgcn_readfirstlane((int)(threadIdx.x >> 6)); C.tid = threadIdx.x; C.lane = C.tid & 63;
    C.G = gridDim.x; C.bid = blockIdx.x;
    C.out = args.out; C.ws = args.ws;
    unsigned char* const ws = args.ws;
    volatile LAS unsigned* MISC = (volatile LAS unsigned*)(C.lds + MISC_OFF);
    if (C.tid < 32) MISC[C.tid] = 0u;
    __syncthreads();
    XcdBarrier bar = xcd_barrier_post((unsigned*)(ws + WS_CTL) + 4096, MISC + 8);
    const int lo = args.ph_lo, hi = args.ph_hi;
    int pid = 0;
    PG8_LAS unsigned char* ring = (PG8_LAS unsigned char*)lds_raw;
    PH_BEGIN p_prologue(C); PH_END

    run_layer<0>(C, bar, pid, lo, hi, ring); run_layer<1>(C, bar, pid, lo, hi, ring); run_layer<2>(C, bar, pid, lo, hi, ring); run_layer<3>(C, bar, pid, lo, hi, ring);
#undef PH_BEGIN
#undef PH_END
#undef XN
#undef RTAB
}

extern "C" void kernel_launch(void* const* d_in, const int* in_sizes, int n_in, void* d_out, int out_size, void* d_ws, size_t ws_size, hipStream_t stream) {
    static int grid = 0;
    if (grid == 0) {
        if (n_in != 24 || in_sizes[0] != NT * DM || out_size != NT * DM || ws_size < WS_NEED) { fprintf(stderr, "kernel_launch: unexpected shapes / workspace (n_in %d, ws %zu, need %zu)\n", n_in, ws_size, (size_t)WS_NEED); grid = -1; return; }
        int dev = 0, cus = 0;
        if (hipGetDevice(&dev) != hipSuccess || hipDeviceGetAttribute(&cus, hipDeviceAttributeMultiprocessorCount, dev) != hipSuccess) { grid = -1; return; }
        if (hipFuncSetAttribute((const void*)yoco_fwd, hipFuncAttributeMaxDynamicSharedMemorySize, LDS_BYTES) != hipSuccess) { fprintf(stderr, "kernel_launch: hipFuncSetAttribute failed\n"); grid = -1; return; }
        int per_cu = 0;
        if (hipOccupancyMaxActiveBlocksPerMultiprocessor(&per_cu, (const void*)yoco_fwd, NWAVES * 64, LDS_BYTES) != hipSuccess || per_cu < 1) { fprintf(stderr, "kernel_launch: occupancy query says %d\n", per_cu); }
        (void)hipGetLastError();
        grid = cus;
    }
    if (grid < 0) return;
    (void)hipMemsetAsync((char*)d_ws + WS_CTL, 0, CTL_ZERO_BYTES, stream);
    Args a{};
    for (int i = 0; i < 24; ++i) a.in[i] = (const float*)d_in[i];
    a.out = (float*)d_out; a.ws = (unsigned char*)d_ws;
#if MK_SINGLE
    a.ph_lo = 0; a.ph_hi = N_PHASES;
    hipLaunchKernelGGL(yoco_fwd, dim3(grid), dim3(NWAVES * 64), LDS_BYTES, stream, a);
#else
    for (int k = 0; k < N_PHASES; ++k) { a.ph_lo = k; a.ph_hi = k + 1; hipLaunchKernelGGL(yoco_fwd, dim3(grid), dim3(NWAVES * 64), LDS_BYTES, stream, a); }
#endif
}
```

```cpp
#include <hip/hip_runtime.h>
#include <cstdio>
#include <cstdint>

#ifndef MK_SINGLE
#define MK_SINGLE 1
#endif

namespace pg8 {
#define PG8_LAS __attribute__((address_space(3)))
typedef unsigned short bf16_t;
typedef short bf16x8 __attribute__((ext_vector_type(8)));
typedef float f32x4 __attribute__((ext_vector_type(4)));
typedef unsigned u32x4 __attribute__((ext_vector_type(4)));
constexpr int BM = 256, BK = 64, HALF = 128, HTB = HALF * BK * 2  , STAGE_BYTES = 8 * HTB, NXCD = 8, WGM = 8;

__host__ __device__ __forceinline__ int lds_byte(int r, int c) { const int st = (r >> 4) * 2 + (c >> 5), rr = r & 15, cc = c & 31, ob = rr * 64 + cc * 2; return st * 1024 + (ob ^ (((ob >> 9) & 1) << 5)); }
__host__ __device__ __forceinline__ void stage_rc(int b, int& R, int& C) { const int st = b / 1024, sb = b % 1024, swz = sb ^ (((sb >> 9) & 1) << 5); R = (st >> 1) * 16 + swz / 64; C = (st & 1) * 32 + (swz % 64) / 2; }
__host__ __device__ __forceinline__ int perm32(int rho) { const int n = rho >> 4, i = rho & 15; return 8 * (i >> 2) + 4 * n + (i & 3); }

struct Unit { int pm, pn, e; };
struct Gemm { const bf16_t* A; const bf16_t* Bt; int K; int lda; size_t estride; };

struct GenOrder {
    int nM, nN, nwg, G, c; const int* tile_e;
    __device__ void init(int nM_, int nN_, int G_, int c_, const int* te) { nM = nM_; nN = nN_; nwg = nM * nN; G = G_; c = c_; tile_e = te; }
    __device__ bool next(int i, Unit& u) const {
        const long L = (long)i * G + c; if (L >= nwg) return false;
        int wgid = (int)L; { const int q = nwg / NXCD, r = nwg % NXCD, xcd = wgid % NXCD, off = wgid / NXCD; wgid = (xcd < r ? xcd * (q + 1) : r * (q + 1) + (xcd - r) * q) + off; }
        const int nig = WGM * nN, gid = wgid / nig, fm = gid * WGM, gsz = (nM - fm) < WGM ? (nM - fm) : WGM;
        u.pm = fm + ((wgid % nig) % gsz); u.pn = (wgid % nig) / gsz; u.e = tile_e ? tile_e[u.pm] : 0; return true;
    }
    __device__ __forceinline__ void a_ready(const Unit&) const {}
    __device__ __forceinline__ void done(const Unit&) const {}
};

__device__ __forceinline__ unsigned cvt_pk_bf16(float lo, float hi) { unsigned r; asm volatile("v_cvt_pk_bf16_f32 %0, %1, %2" : "=v"(r) : "v"(lo), "v"(hi)); return r; }
__device__ __forceinline__ float silu_f(float v) { return v * __builtin_amdgcn_rcpf(1.0f + __expf(-v)); }
__device__ __forceinline__ float clamp448(float v) { return __builtin_amdgcn_fmed3f(v, -448.f, 448.f); }
__device__ __forceinline__ unsigned pk4_fp8(float a, float b, float c, float d) {
    int w = __builtin_amdgcn_cvt_pk_fp8_f32(clamp448(a), clamp448(b), 0, false); w = __builtin_amdgcn_cvt_pk_fp8_f32(clamp448(c), clamp448(d), w, true); return (unsigned)w; }
constexpr float FP8_SW1 = 32.f, FP8_SW2 = 64.f, FP8_SH = 8.f;

struct EpiBf16 {
    static constexpr bool PERM = true, AFTER_DRAIN = false;
    bf16_t* O; int ldc; const float* bias; int act; int bias_es; float oscale;
    __device__ __forceinline__ void operator()(const f32x4 (&acc)[2][2][4][2], const Unit& u, int wr, int wc, int fr, int fq) const {
        const int row0 = u.pm * BM + wr * 64 + fr, col0 = u.pn * BM + wc * 32 + 8 * fq;
        f32x4 bv[2][2];
#pragma unroll
        for (int bj = 0; bj < 2; ++bj)
#pragma unroll
            for (int n = 0; n < 2; ++n) bv[bj][n] = bias ? *(const f32x4*)(bias + u.e * bias_es + col0 + bj * HALF + 4 * n) : (f32x4){0.f, 0.f, 0.f, 0.f};
#pragma unroll
        for (int ai = 0; ai < 2; ++ai)
#pragma unroll
            for (int m = 0; m < 4; ++m) { bf16_t* rowp = O + (size_t)(row0 + ai * HALF + m * 16) * ldc + col0;
#pragma unroll
                for (int bj = 0; bj < 2; ++bj) { f32x4 v0 = acc[ai][bj][m][0] * oscale + bv[bj][0], v1 = acc[ai][bj][m][1] * oscale + bv[bj][1];
                    if (act == 1) {
#pragma unroll
                        for (int i = 0; i < 4; ++i) { v0[i] = silu_f(v0[i]); v1[i] = silu_f(v1[i]); } }
                    u32x4 w; w.x = cvt_pk_bf16(v0[0], v0[1]); w.y = cvt_pk_bf16(v0[2], v0[3]); w.z = cvt_pk_bf16(v1[0], v1[1]); w.w = cvt_pk_bf16(v1[2], v1[3]);
                    *(u32x4*)(rowp + bj * HALF) = w; } }
    }
};
struct EpiRes {
    static constexpr bool PERM = false, AFTER_DRAIN = false;
    const float* base; float* out; int ldc; float oscale;
    __device__ __forceinline__ void operator()(const f32x4 (&acc)[2][2][4][2], const Unit& u, int wr, int wc, int fr, int fq) const {
        const int row0 = u.pm * BM + wr * 64 + fr, col0 = u.pn * BM + wc * 32 + 4 * fq;
#pragma unroll
        for (int ai = 0; ai < 2; ++ai)
#pragma unroll
            for (int m = 0; m < 4; ++m) { const size_t off = (size_t)(row0 + ai * HALF + m * 16) * ldc + col0;
#pragma unroll
                for (int bj = 0; bj < 2; ++bj)
#pragma unroll
                    for (int n = 0; n < 2; ++n) { const f32x4 b = *(const f32x4*)(base + off + bj * HALF + n * 16); *(f32x4*)(out + off + bj * HALF + n * 16) = b + acc[ai][bj][m][n] * oscale; } }
    }
};
struct EpiSwiGLU {
    static constexpr bool PERM = true, AFTER_DRAIN = false;
    bf16_t* O; int ldc;
    __device__ __forceinline__ void operator()(const f32x4 (&acc)[2][2][4][2], const Unit& u, int wr, int wc, int fr, int fq) const {
        const int row0 = u.pm * BM + wr * 64 + fr, col0 = u.pn * HALF + wc * 32 + 8 * fq;
#pragma unroll
        for (int ai = 0; ai < 2; ++ai)
#pragma unroll
            for (int m = 0; m < 4; ++m) { bf16_t* rowp = O + (size_t)(row0 + ai * HALF + m * 16) * ldc + col0;
                f32x4 v0, v1;
#pragma unroll
                for (int i = 0; i < 4; ++i) { v0[i] = silu_f(acc[ai][0][m][0][i]) * acc[ai][1][m][0][i]; v1[i] = silu_f(acc[ai][0][m][1][i]) * acc[ai][1][m][1][i]; }
                u32x4 w; w.x = cvt_pk_bf16(v0[0], v0[1]); w.y = cvt_pk_bf16(v0[2], v0[3]); w.z = cvt_pk_bf16(v1[0], v1[1]); w.w = cvt_pk_bf16(v1[2], v1[3]);
                *(u32x4*)rowp = w; }
    }
};
struct EpiSwiGLU8 {
    static constexpr bool PERM = true, AFTER_DRAIN = false;
    unsigned char* O; int ldc;
    __device__ __forceinline__ void operator()(const f32x4 (&acc)[2][2][4][2], const Unit& u, int wr, int wc, int fr, int fq) const {
        const int row0 = u.pm * BM + wr * 64 + fr, col0 = u.pn * HALF + wc * 32 + 8 * fq; constexpr float si = 1.f / FP8_SW1;
#pragma unroll
        for (int ai = 0; ai < 2; ++ai)
#pragma unroll
            for (int m = 0; m < 4; ++m) { unsigned char* rowp = O + (size_t)(row0 + ai * HALF + m * 16) * ldc + col0;
                f32x4 v0, v1;
#pragma unroll
                for (int i = 0; i < 4; ++i) {
                    const float g0 = acc[ai][0][m][0][i], g1 = acc[ai][0][m][1][i];
                    v0[i] = (g0 * acc[ai][1][m][0][i]) * ((si * si * FP8_SH) * __builtin_amdgcn_rcpf(1.f + __builtin_amdgcn_exp2f(g0 * (-si * 1.4426950408889634f))));
                    v1[i] = (g1 * acc[ai][1][m][1][i]) * ((si * si * FP8_SH) * __builtin_amdgcn_rcpf(1.f + __builtin_amdgcn_exp2f(g1 * (-si * 1.4426950408889634f)))); }
                typedef unsigned u32x2 __attribute__((ext_vector_type(2))); u32x2 w; w.x = pk4_fp8(v0[0], v0[1], v0[2], v0[3]); w.y = pk4_fp8(v1[0], v1[1], v1[2], v1[3]);
                *(u32x2*)rowp = w; }
    }
};
__device__ __forceinline__ float logf_gate(float x, float la, float l1) {
    const float ls = fminf(x, 0.f) - __logf(1.0f + __expf(-fabsf(x)));
    const float b = l1 + ls;
    if (la == -INFINITY) return b;
    const float mx = fmaxf(la, b), d = fabsf(la - b);
    return mx + __logf(1.0f + __expf(-d));
}
struct EpiHgrnIn {
    static constexpr bool PERM = true, AFTER_DRAIN = false;
    unsigned char* ws; int layer;
    static constexpr size_t O_PQ = 580ull << 20, O_PI = O_PQ + (128ull << 20), O_PG = O_PQ + (256ull << 20), O_LF = O_PQ + (384ull << 20), O_LA = 1ull << 20, O_L1 = O_LA + 8192;
    __device__ __forceinline__ void operator()(const f32x4 (&acc)[2][2][4][2], const Unit& u, int wr, int wc, int fr, int fq) const {
        const int quarter = u.pn >> 2;
        const int row0 = u.pm * BM + wr * 64 + fr, col0 = (u.pn & 3) * BM + wc * 32 + 8 * fq;
        if (quarter == 1) {
            const float* la = (const float*)(ws + O_LA) + layer * 1024; const float* l1 = (const float*)(ws + O_L1) + layer * 1024; float* LF = (float*)(ws + O_LF);
            f32x4 A0[2][2], A1[2][2];
#pragma unroll
            for (int bj = 0; bj < 2; ++bj)
#pragma unroll
                for (int n = 0; n < 2; ++n) { A0[bj][n] = *(const f32x4*)(la + col0 + bj * HALF + 4 * n); A1[bj][n] = *(const f32x4*)(l1 + col0 + bj * HALF + 4 * n); }
#pragma unroll
            for (int ai = 0; ai < 2; ++ai)
#pragma unroll
                for (int m = 0; m < 4; ++m) { float* rowp = LF + (size_t)(row0 + ai * HALF + m * 16) * 1024 + col0;
#pragma unroll
                    for (int bj = 0; bj < 2; ++bj)
#pragma unroll
                        for (int n = 0; n < 2; ++n) { f32x4 o;
#pragma unroll
                            for (int i = 0; i < 4; ++i) o[i] = logf_gate(acc[ai][bj][m][n][i], A0[bj][n][i], A1[bj][n][i]);
                            *(f32x4*)(rowp + bj * HALF + 4 * n) = o; } }
        } else {
            bf16_t* O = (bf16_t*)(ws + (quarter == 0 ? O_PQ : (quarter == 2 ? O_PI : O_PG)));
#pragma unroll
            for (int ai = 0; ai < 2; ++ai)
#pragma unroll
                for (int m = 0; m < 4; ++m) { bf16_t* rowp = O + (size_t)(row0 + ai * HALF + m * 16) * 1024 + col0;
#pragma unroll
                    for (int bj = 0; bj < 2; ++bj) { f32x4 v0 = acc[ai][bj][m][0], v1 = acc[ai][bj][m][1];
                        if (quarter != 2) {
#pragma unroll
                            for (int i = 0; i < 4; ++i) { v0[i] = silu_f(v0[i]); v1[i] = silu_f(v1[i]); } }
                        u32x4 w; w.x = cvt_pk_bf16(v0[0], v0[1]); w.y = cvt_pk_bf16(v0[2], v0[3]); w.z = cvt_pk_bf16(v1[0], v1[1]); w.w = cvt_pk_bf16(v1[2], v1[3]);
                        *(u32x4*)(rowp + bj * HALF) = w; } }
        }
    }
};

template <class Epi, class Sched, bool ALIGN_EPI = false, bool SP2 = false, bool FP8 = false>
__device__ __forceinline__ void gemm_phase(PG8_LAS unsigned char* lds, const Gemm g, const Sched& S, const Epi& E, const int wave_id) {
    int lane_; asm volatile("v_mbcnt_lo_u32_b32 %0, -1, 0\n\tv_mbcnt_hi_u32_b32 %0, -1, %0" : "=v"(lane_));
    const int wid = wave_id, lane = lane_, tid = wid * 64 + lane, wr = wid >> 2, wc = wid & 3, fr = lane & 15, fq = lane >> 4;
    const int K = g.K, nt = K / BK, lda = g.lda;
    unsigned voffA[2], voffB[2];
#pragma unroll
    for (int i = 0; i < 2; ++i) { int R, C; stage_rc(tid * 16 + i * 8192, R, C); const int Rb = Epi::PERM ? ((R & ~31) + perm32(R & 31)) : R;
        voffA[i] = (unsigned)(R * lda + C) * 2u; voffB[i] = (unsigned)(Rb * K + C) * 2u; }
    const size_t kstep = (size_t)(BK * 2);
    const size_t hstep = (size_t)HALF * K * 2;
    const size_t tstep = 2 * hstep;
    const size_t hstepA = (size_t)HALF * lda * 2, tstepA = 2 * hstepA;
    const unsigned ldsw = (unsigned)wid * 1024u;
    const int aoff = lds_byte(wr * 64 + fr, fq * 8), boff = lds_byte(wc * 32 + fr, fq * 8);
#define PG8_SA(b, h) (((b) * 2 + (h)) * HTB)
#define PG8_SB(b, h) ((4 + (b) * 2 + (h)) * HTB)
#define PG8_STAGE(bufoff, gbase, voff) do { _Pragma("unroll") for (int _i = 0; _i < 2; ++_i) \
        __builtin_amdgcn_global_load_lds((const unsigned*)((const char*)(gbase) + (voff)[_i]), (PG8_LAS unsigned*)(lds + (bufoff) + ldsw + _i * 8192), 16, 0, 0); } while (0)
    typedef int i32x4_ __attribute__((ext_vector_type(4))); typedef int i32x8_ __attribute__((ext_vector_type(8)));
#define PG8_CAT(x, y) __builtin_shufflevector((x), (y), 0, 1, 2, 3, 4, 5, 6, 7)
#define PG8_LDA(dst, b, h) do { _Pragma("unroll") for (int m = 0; m < 4; ++m) { \
        if constexpr (FP8) dst##8[m] = PG8_CAT(*(const PG8_LAS i32x4_*)(lds + PG8_SA(b, h) + aoff + m * 2048), *(const PG8_LAS i32x4_*)(lds + PG8_SA(b, h) + aoff + m * 2048 + 1024)); \
        else { _Pragma("unroll") for (int k = 0; k < 2; ++k) dst[m][k] = *(const PG8_LAS bf16x8*)(lds + PG8_SA(b, h) + aoff + m * 2048 + k * 1024); } } } while (0)
#define PG8_LDB(dst, b, h) do { _Pragma("unroll") for (int n = 0; n < 2; ++n) { \
        if constexpr (FP8) dst##8[n] = PG8_CAT(*(const PG8_LAS i32x4_*)(lds + PG8_SB(b, h) + boff + n * 2048), *(const PG8_LAS i32x4_*)(lds + PG8_SB(b, h) + boff + n * 2048 + 1024)); \
        else { _Pragma("unroll") for (int k = 0; k < 2; ++k) dst[n][k] = *(const PG8_LAS bf16x8*)(lds + PG8_SB(b, h) + boff + n * 2048 + k * 1024); } } } while (0)
#define PG8_MMA(ai, bj, At, Bt) do { __builtin_amdgcn_s_setprio(1); _Pragma("unroll") for (int m = 0; m < 4; ++m) _Pragma("unroll") for (int n = 0; n < 2; ++n) { \
        if constexpr (FP8) asm volatile("v_mfma_scale_f32_16x16x128_f8f6f4 %0, %1, %2, %0, %3, %3 op_sel_hi:[0,0,0]" : "+v"(acc[ai][bj][m][n]) : "v"(Bt##8[n]), "v"(At##8[m]), "v"(f8scale_)); \
        else { _Pragma("unroll") for (int k = 0; k < 2; ++k) acc[ai][bj][m][n] = __builtin_amdgcn_mfma_f32_16x16x32_bf16(Bt[n][k], At[m][k], acc[ai][bj][m][n], 0, 0, 0); } } \
        __builtin_amdgcn_s_setprio(0); } while (0)
#define PG8_WAIT_V(n) asm volatile("s_waitcnt vmcnt(" #n ")" ::: "memory")
#define PG8_WAIT_L(n) asm volatile("s_waitcnt lgkmcnt(" #n ")" ::: "memory")
#define PG8_BAR __builtin_amdgcn_s_barrier()
#define PG8_SCHED __builtin_amdgcn_sched_barrier(0)
    Unit cur, nxt; int ui = 0;
    if (!S.next(0, cur)) return;
    f32x4 acc[2][2][4][2];
#pragma unroll
    for (int a = 0; a < 2; ++a)
#pragma unroll
        for (int b = 0; b < 2; ++b)
#pragma unroll
            for (int m = 0; m < 4; ++m)
#pragma unroll
                for (int n = 0; n < 2; ++n) acc[a][b][m][n] = (f32x4){0.f, 0.f, 0.f, 0.f};
    const int f8scale_ = 0x7f7f7f7f;
    bf16x8 At[4][2], B0[2][2], B1[2][2]; i32x8_ At8[4], B08[2], B18[2];
    const char* cA = (const char*)g.A + (size_t)cur.pm * tstepA; const char* cB = (const char*)g.Bt + (size_t)cur.e * g.estride + (size_t)cur.pn * tstep;
    S.a_ready(cur);
    if constexpr (SP2) {
        PG8_STAGE(PG8_SB(0, 0), cB, voffB); PG8_STAGE(PG8_SB(0, 1), cB + hstep, voffB); PG8_STAGE(PG8_SA(0, 0), cA, voffA); PG8_STAGE(PG8_SA(0, 1), cA + hstepA, voffA);
        if (wr == 1) PG8_BAR;
        PG8_WAIT_V(2); PG8_BAR;
        PG8_STAGE(PG8_SB(1, 0), cB + kstep, voffB); PG8_STAGE(PG8_SA(1, 0), cA + kstep, voffA); PG8_STAGE(PG8_SB(1, 1), cB + hstep + kstep, voffB);
        PG8_WAIT_V(6); PG8_BAR;
    } else {
        PG8_STAGE(PG8_SB(0, 0), cB, voffB); PG8_STAGE(PG8_SA(0, 0), cA, voffA); PG8_STAGE(PG8_SB(0, 1), cB + hstep, voffB); PG8_STAGE(PG8_SA(0, 1), cA + hstepA, voffA);
        if (wr == 1) PG8_BAR;
        PG8_WAIT_V(4); PG8_BAR;
        PG8_STAGE(PG8_SB(1, 0), cB + kstep, voffB); PG8_STAGE(PG8_SA(1, 0), cA + kstep, voffA); PG8_STAGE(PG8_SB(1, 1), cB + hstep + kstep, voffB);
        PG8_WAIT_V(6); PG8_BAR;
    }
    for (;;) {
        const bool has_next = S.next(ui + 1, nxt);
        const char* nA = has_next ? (const char*)g.A + (size_t)nxt.pm * tstepA : cA; const char* nB = has_next ? (const char*)g.Bt + (size_t)nxt.e * g.estride + (size_t)nxt.pn * tstep : cB;
        for (int t = 0; t < nt; t += 2) {
            const bool last = (t == nt - 2);
            const char* a1 = cA + (size_t)(t + 1) * kstep;
            const char* a2 = last ? nA : cA + (size_t)(t + 2) * kstep; const char* b2 = last ? nB : cB + (size_t)(t + 2) * kstep;
            const char* a3 = a2 + kstep; const char* b3 = b2 + kstep;
            if (last && has_next) S.a_ready(nxt);
            if constexpr (SP2) {
            PG8_LDB(B0, 0, 0); PG8_LDB(B1, 0, 1); PG8_SCHED; PG8_LDA(At, 0, 0); PG8_STAGE(PG8_SA(1, 1), a1 + hstepA, voffA);
            PG8_WAIT_V(8); PG8_WAIT_L(0); PG8_BAR; PG8_MMA(0, 0, At, B0); PG8_MMA(0, 1, At, B1); PG8_BAR; PG8_SCHED;
            PG8_LDA(At, 0, 1); PG8_STAGE(PG8_SB(0, 0), b2, voffB); PG8_STAGE(PG8_SB(0, 1), b2 + hstep, voffB); PG8_STAGE(PG8_SA(0, 0), a2, voffA);
            PG8_WAIT_V(8); PG8_WAIT_L(0); PG8_BAR; PG8_MMA(1, 0, At, B0); PG8_MMA(1, 1, At, B1); PG8_BAR; PG8_SCHED;
            PG8_LDB(B0, 1, 0); PG8_LDB(B1, 1, 1); PG8_SCHED; PG8_LDA(At, 1, 0); PG8_STAGE(PG8_SA(0, 1), a2 + hstepA, voffA);
            PG8_WAIT_V(8); PG8_WAIT_L(0); PG8_BAR; PG8_MMA(0, 0, At, B0); PG8_MMA(0, 1, At, B1); PG8_BAR; PG8_SCHED;
            PG8_LDA(At, 1, 1); PG8_STAGE(PG8_SB(1, 0), b3, voffB); PG8_STAGE(PG8_SB(1, 1), b3 + hstep, voffB); PG8_STAGE(PG8_SA(1, 0), a3, voffA);
            PG8_WAIT_V(8); PG8_WAIT_L(0); PG8_BAR; PG8_MMA(1, 0, At, B0); PG8_MMA(1, 1, At, B1); PG8_BAR; PG8_SCHED;
            } else {
            PG8_LDB(B0, 0, 0); PG8_SCHED; PG8_LDA(At, 0, 0); PG8_STAGE(PG8_SA(1, 1), a1 + hstepA, voffA);
            PG8_WAIT_L(8); PG8_BAR; PG8_WAIT_L(0); PG8_MMA(0, 0, At, B0); PG8_BAR; PG8_SCHED;
            PG8_LDB(B1, 0, 1); PG8_STAGE(PG8_SB(0, 0), b2, voffB);
            PG8_BAR; PG8_WAIT_L(0); PG8_MMA(0, 1, At, B1); PG8_BAR;
            PG8_LDA(At, 0, 1); PG8_STAGE(PG8_SA(0, 0), a2, voffA);
            PG8_BAR; PG8_WAIT_L(0); PG8_MMA(1, 0, At, B0); PG8_BAR; PG8_SCHED;
            PG8_STAGE(PG8_SB(0, 1), b2 + hstep, voffB);
            PG8_WAIT_V(6); PG8_BAR; PG8_MMA(1, 1, At, B1); PG8_BAR;
            PG8_LDB(B0, 1, 0); PG8_SCHED; PG8_LDA(At, 1, 0); PG8_STAGE(PG8_SA(0, 1), a2 + hstepA, voffA);
            PG8_WAIT_L(8); PG8_BAR; PG8_WAIT_L(0); PG8_MMA(0, 0, At, B0); PG8_BAR; PG8_SCHED;
            PG8_LDB(B1, 1, 1); PG8_STAGE(PG8_SB(1, 0), b3, voffB);
            PG8_BAR; PG8_WAIT_L(0); PG8_MMA(0, 1, At, B1); PG8_BAR;
            PG8_LDA(At, 1, 1); PG8_STAGE(PG8_SA(1, 0), a3, voffA);
            PG8_BAR; PG8_WAIT_L(0); PG8_MMA(1, 0, At, B0); PG8_BAR; PG8_SCHED;
            PG8_STAGE(PG8_SB(1, 1), b3 + hstep, voffB);
            PG8_WAIT_V(6); PG8_BAR; PG8_MMA(1, 1, At, B1); PG8_BAR;
            }
        }
        if constexpr (FP8) asm volatile("s_nop 15\n\ts_nop 15" ::: "memory");
        if constexpr (ALIGN_EPI) { if (wr == 0) PG8_BAR; }
        if constexpr (!Epi::AFTER_DRAIN) { E(acc, cur, wr, wc, fr, fq); S.done(cur); }
        if (!has_next) break;
#pragma unroll
        for (int a = 0; a < 2; ++a)
#pragma unroll
            for (int b = 0; b < 2; ++b)
#pragma unroll
                for (int m = 0; m < 4; ++m)
#pragma unroll
                    for (int n = 0; n < 2; ++n) acc[a][b][m][n] = (f32x4){0.f, 0.f, 0.f, 0.f};
        cur = nxt; cA = nA; cB = nB; ++ui;
        if constexpr (ALIGN_EPI) { if (wr == 1) PG8_BAR; }
    }
    PG8_WAIT_V(0);
    if constexpr (!ALIGN_EPI) { if (wr == 0) PG8_BAR; }
    PG8_BAR;
    if constexpr (Epi::AFTER_DRAIN) { E.fused(acc, cur, wr, wc, fr, fq, lds, wid, lane); S.done(cur); }
#undef PG8_SA
#undef PG8_SB
#undef PG8_STAGE
#undef PG8_LDA
#undef PG8_LDB
#undef PG8_MMA
#undef PG8_CAT
#undef PG8_WAIT_V
#undef PG8_WAIT_L
#undef PG8_BAR
#undef PG8_SCHED
}
}

constexpr int NT = 65536, DM = 1024, NBATCH = 32, SEQ = 2048;
constexpr int DFF = 2816, DFE = 3584, NEXP = 8;
constexpr int MOE_ROWS = 133120;
constexpr float EPS = 1e-6f;
constexpr size_t MiB = 1u << 20;
constexpr size_t WS_CTL = 0, CTL_ZERO_BYTES = 1 * MiB;
constexpr size_t WS_LA = 1 * MiB;
constexpr size_t WS_L1 = WS_LA + 8192;
constexpr size_t WS_CB = WS_LA + 16384;
constexpr size_t WS_RCNT = WS_LA + 32768;
constexpr size_t WS_RTAB = WS_LA + 65536;
constexpr size_t WS_ROUTE = 2 * MiB;
constexpr size_t WS_SLOT = 3 * MiB;
constexpr size_t WS_SELM = 4 * MiB;
constexpr size_t WS_GATES = 8 * MiB;
constexpr size_t WS_KC = 20 * MiB;
constexpr size_t WS_VCT = 22 * MiB;
constexpr size_t WS_HC = 24 * MiB;
constexpr size_t WS_W = 48 * MiB;
constexpr size_t W_HIN = WS_W, W_HOUT = WS_W + 16 * MiB, W_KVQ = WS_W + 20 * MiB, W_Q3 = WS_W + 26 * MiB, W_CMP1 = WS_W + 29 * MiB, W_NOUT = WS_W + 31 * MiB,
                 W_FGU = WS_W + 35 * MiB, W_FDN = WS_W + 57 * MiB, W_MGU = WS_W + 68 * MiB, W_MDN = WS_W + 292 * MiB;
constexpr size_t WS_XN = 452 * MiB;
constexpr size_t WS_R = 580 * MiB;
constexpr size_t R_PQ = WS_R, R_PI = WS_R + 128 * MiB, R_PG = WS_R + 256 * MiB, R_LF = WS_R + 384 * MiB, R_O2 = WS_R + 640 * MiB;
constexpr size_t R_HF = WS_R + 256 * MiB;
constexpr size_t R_KS = WS_R, R_KW = WS_R + 32 * MiB, R_VST = WS_R + 64 * MiB, R_VWT = WS_R + 96 * MiB, R_KCR = WS_R + 128 * MiB, R_VCR = WS_R + 160 * MiB;
constexpr size_t R_QKV = WS_R + 256 * MiB;
constexpr size_t R_Q = WS_R + 608 * MiB, R_O = WS_R + 736 * MiB;
constexpr size_t R_XP = WS_R, R_HM = WS_R + 260 * MiB;
constexpr size_t WS_NEED = R_HM + (size_t)MOE_ROWS * DFE * 2;
static_assert(WS_NEED <= 1792 * MiB, "workspace map");
static_assert(W_MDN + 112 * MiB <= WS_XN, "weights map");
static_assert(pg8::EpiHgrnIn::O_PQ == R_PQ && pg8::EpiHgrnIn::O_PI == R_PI && pg8::EpiHgrnIn::O_PG == R_PG && pg8::EpiHgrnIn::O_LF == R_LF && pg8::EpiHgrnIn::O_LA == WS_LA && pg8::EpiHgrnIn::O_L1 == WS_L1, "EpiHgrnIn offsets");

constexpr int LDS_BYTES = 147456;
constexpr int MISC_OFF = 131072 + 320;
constexpr int NWAVES = 8;

#define GAS __attribute__((address_space(1)))
#define LAS __attribute__((address_space(3)))
typedef unsigned short bf16;
typedef unsigned v4u __attribute__((ext_vector_type(4)));
typedef unsigned v2u __attribute__((ext_vector_type(2)));
typedef float f32x4 __attribute__((ext_vector_type(4)));
#define LDS_WAIT() asm volatile("s_waitcnt lgkmcnt(0)" ::: "memory")
__device__ __forceinline__ unsigned f2bf(float f) { unsigned u = __builtin_bit_cast(unsigned, f); return (u + 0x7fffu + ((u >> 16) & 1u)) >> 16; }
__device__ __forceinline__ unsigned pk2(float lo, float hi) { return f2bf(lo) | (f2bf(hi) << 16); }
__device__ __forceinline__ float bf2f(unsigned b) { return __builtin_bit_cast(float, b << 16); }
__device__ __forceinline__ float bflo(unsigned w) { return __builtin_bit_cast(float, w << 16); }
__device__ __forceinline__ float bfhi(unsigned w) { return __builtin_bit_cast(float, w & 0xffff0000u); }
__device__ __forceinline__ float wave_sum(float v) {
#pragma unroll
    for (int o = 32; o >= 1; o >>= 1) v += __shfl_xor(v, o);
    return v;
}
__device__ __forceinline__ float wave_max(float v) {
#pragma unroll
    for (int o = 32; o >= 1; o >>= 1) v = fmaxf(v, __shfl_xor(v, o));
    return v;
}

#define XB_TMO      128
#define XB_XCNT(j)  (256  + 64 * (j))
#define XB_XSUB(j)  (1280 + 64 * (j))
#define XB_XGEN(j)  (2304 + 64 * (j))
#define XB_TOP      3328
#define XB_TOPGEN   3392
#define XCD_BAR_WORDS 3456
#define XB_SPIN_CAP (1u << 22)
__device__ __forceinline__ unsigned xb_ld(unsigned* p)              { return __hip_atomic_load(p, __ATOMIC_RELAXED, __HIP_MEMORY_SCOPE_AGENT); }
__device__ __forceinline__ unsigned xb_add(unsigned* p, unsigned v) { return __hip_atomic_fetch_add(p, v, __ATOMIC_RELAXED, __HIP_MEMORY_SCOPE_AGENT); }
__device__ __forceinline__ unsigned xb_xcc_id() { return (unsigned)__builtin_amdgcn_s_getreg((3 << 11) | 20) & 0xFu; }
#define XB_SPIN(cond, bar) do { unsigned _sp = 0; while (cond) { __builtin_amdgcn_s_sleep(1); \
    if ((++_sp & 255u) == 0u) { if (xb_ld(&(bar)[XB_TMO])) break; if (_sp > XB_SPIN_CAP) { atomicAdd(&(bar)[XB_TMO], 1u); break; } } } } while (0)
struct XcdBarrier { unsigned* bar; unsigned x; volatile LAS unsigned* st; };
__device__ __forceinline__ XcdBarrier xcd_barrier_post(unsigned* bar, volatile LAS unsigned* st) {
    XcdBarrier b; b.bar = bar; b.x = xb_xcc_id(); b.st = st;
    if (threadIdx.x == 0) (void)xb_add(&bar[XB_XCNT(b.x)], 1u);
    return b;
}
__device__ __forceinline__ void xcd_barrier_complete(unsigned* bar, unsigned x, unsigned& nloc, unsigned& nx) {
    const unsigned G = gridDim.x * gridDim.y * gridDim.z;
    unsigned sum, cnt, mine, sp = 0u;
    for (;;) {
        sum = 0u; cnt = 0u; mine = 0u;
#pragma unroll
        for (unsigned j = 0; j < 16; ++j) { const unsigned c = xb_ld(&bar[XB_XCNT(j)]); sum += c; cnt += (c > 0u) ? 1u : 0u; mine = (j == x) ? c : mine; }
        if (sum == G) break;
        __builtin_amdgcn_s_sleep(1);
        if ((++sp & 255u) == 0u) { if (xb_ld(&bar[XB_TMO])) break; if (sp > XB_SPIN_CAP) { atomicAdd(&bar[XB_TMO], 1u); break; } }
    }
    nloc = mine > 0u ? mine : 1u; nx = cnt > 0u ? cnt : 1u;
}
__device__ __forceinline__ void xcd_barrier(const XcdBarrier& b) {
    asm volatile("s_waitcnt vmcnt(0)" ::: "memory");
    __syncthreads();
    if (threadIdx.x == 0) {
        unsigned* bar = b.bar; unsigned bx_ = b.x; asm volatile("" : "+s"(bar), "+s"(bx_));
        __builtin_amdgcn_s_waitcnt(0);
        unsigned nloc = b.st[0], nx = b.st[1];
        if (nloc == 0u) { xcd_barrier_complete(bar, bx_, nloc, nx); b.st[0] = nloc; b.st[1] = nx; }
        const unsigned old = xb_add(&bar[XB_XSUB(bx_)], 1u);
        const unsigned gen = old / nloc;
        if (old + 1u == (gen + 1u) * nloc) {
            __builtin_amdgcn_fence(__ATOMIC_RELEASE, "agent");
            asm volatile("s_waitcnt vmcnt(0)" ::: "memory");
            const unsigned og = xb_add(&bar[XB_TOP], 1u);
            const unsigned tg = og / nx;
            if (og + 1u == (tg + 1u) * nx) xb_add(&bar[XB_TOPGEN], 1u);
            else XB_SPIN(xb_ld(&bar[XB_TOPGEN]) == tg, bar);
            __builtin_amdgcn_fence(__ATOMIC_ACQUIRE, "agent");
            xb_add(&bar[XB_XGEN(bx_)], 1u);
            asm volatile("s_waitcnt vmcnt(0)" ::: "memory");
        } else {
            XB_SPIN(xb_ld(&bar[XB_XGEN(bx_)]) == gen, bar);
            __builtin_amdgcn_fence(__ATOMIC_ACQUIRE, "agent");
            asm volatile("s_waitcnt vmcnt(0)" ::: "memory");
        }
    }
    __syncthreads();
}

struct Ctx {
    LAS unsigned char* lds;
    int tid, lane, wave, G, bid;
    float* out; unsigned char* ws;
    __device__ __forceinline__ const float* inp(int i) const {
        const __attribute__((address_space(4))) unsigned char* kp = (const __attribute__((address_space(4))) unsigned char*)__builtin_amdgcn_kernarg_segment_ptr();
        asm volatile("" : "+s"(kp));
        return ((const float* const __attribute__((address_space(4)))*)kp)[i];
    }
};
enum { I_X = 0, I_NMIX, I_NFFN, I_HWIN, I_HWOUT, I_HGN, I_HLB, I_KVN, I_KVW, I_CPK, I_CW1K, I_CW2K, I_CPV, I_CW1V, I_CW2V, I_KN, I_NWIN, I_NWOUT, I_NQN, I_FGU, I_FDN, I_MR, I_MGU, I_MDN };

constexpr int MAXJOB = 64;
struct JobTab { unsigned long long src[MAXJOB], gain[MAXJOB], dst[MAXJOB]; int K[MAXJOB], Nsrc[MAXJOB], npb[MAXJOB], F[MAXJOB], rowoff[MAXJOB], istart[MAXJOB + 1]; float f8s[MAXJOB]; int njobs; };
__device__ __forceinline__ void add_job(LAS JobTab* J, const float* src, const float* gain, bf16* dst, int K, int Nsrc, int Npad, int F, int rowoff, float f8s = 0.f) {
    const int j = J->njobs; J->src[j] = (unsigned long long)src; J->gain[j] = (unsigned long long)gain; J->dst[j] = (unsigned long long)dst;
    J->K[j] = K; J->Nsrc[j] = Nsrc; J->npb[j] = Npad / 32; J->F[j] = F; J->rowoff[j] = rowoff; J->f8s[j] = f8s; J->istart[j + 1] = J->istart[j] + (K / 64) * (Npad / 32); J->njobs = j + 1;
}
struct TrItem { const float* W; const float* gain; bf16* WT; int K, Nsrc, drow, k0, n0; float f8s; };
__device__ __forceinline__ void tr_load(const TrItem& p, f32x4 (&v)[8], int lane) {
    const int c4 = lane & 7, kr = lane >> 3, n = p.n0 + 4 * c4; const bool okn = n < p.Nsrc;
#pragma unroll
    for (int i = 0; i < 8; ++i) { const int kk = 8 * i + kr; v[i] = okn ? *(const f32x4*)(p.W + (size_t)(p.k0 + kk) * p.Nsrc + n) : (f32x4){0.f, 0.f, 0.f, 0.f}; }
}
__device__ __forceinline__ void tr_finish(const TrItem& p, f32x4 (&v)[8], LAS float* scr, int lane) {
    const int c4 = lane & 7, kr = lane >> 3;
#pragma unroll
    for (int i = 0; i < 8; ++i) { const int kk = 8 * i + kr; if (p.gain) v[i] = v[i] * p.gain[p.k0 + kk]; *(LAS f32x4*)(scr + kk * 36 + 4 * c4) = v[i]; }
    LDS_WAIT();
    const int c = lane & 7; const float f8s = p.f8s;
#pragma unroll
    for (int j = 0; j < 4; ++j) { const int nn = (lane >> 3) + 8 * j; const LAS float* s = scr + (8 * c) * 36 + nn;
        if (f8s != 0.f) { v2u o; o.x = pg8::pk4_fp8(s[0 * 36] * f8s, s[1 * 36] * f8s, s[2 * 36] * f8s, s[3 * 36] * f8s); o.y = pg8::pk4_fp8(s[4 * 36] * f8s, s[5 * 36] * f8s, s[6 * 36] * f8s, s[7 * 36] * f8s);
            *(v2u*)((unsigned char*)p.WT + (size_t)(p.drow + nn) * p.K + p.k0 + 8 * c) = o; }
        else { v4u o; o.x = pk2(s[0 * 36], s[1 * 36]); o.y = pk2(s[2 * 36], s[3 * 36]); o.z = pk2(s[4 * 36], s[5 * 36]); o.w = pk2(s[6 * 36], s[7 * 36]);
            *(v4u*)(p.WT + (size_t)(p.drow + nn) * p.K + p.k0 + 8 * c) = o; } }
    LDS_WAIT();
}
__device__ __forceinline__ void norm_row_store(const f32x4 (&v)[4], bf16* orow, int lane) {
    float s = 0.f;
#pragma unroll
    for (int j = 0; j < 4; ++j) s += (v[j].x * v[j].x + v[j].y * v[j].y) + (v[j].z * v[j].z + v[j].w * v[j].w);
    const float rstd = rsqrtf(wave_sum(s) * (1.f / DM) + EPS);
    v2u* o8 = (v2u*)orow + lane;
#pragma unroll
    for (int j = 0; j < 4; ++j) { v2u w; w.x = pk2(v[j].x * rstd, v[j].y * rstd); w.y = pk2(v[j].z * rstd, v[j].w * rstd); o8[64 * j] = w; }
}
__device__ __forceinline__ void p_prologue(Ctx& C) {
    LAS JobTab* J = (LAS JobTab*)(C.lds + 73728);
    unsigned char* ws = C.ws;
    if (C.tid == 0) {
        J->njobs = 0; J->istart[0] = 0;
        for (int l = 0; l < 2; ++l) add_job(J, C.inp(I_HWIN) + (size_t)l * 1024 * 4096, C.inp(I_NMIX) + l * 1024, (bf16*)(ws + W_HIN) + (size_t)l * 4096 * 1024, 1024, 4096, 4096, 0, 0);
        for (int l = 0; l < 2; ++l) add_job(J, C.inp(I_HWOUT) + (size_t)l * 1024 * 1024, nullptr, (bf16*)(ws + W_HOUT) + (size_t)l * 1024 * 1024, 1024, 1024, 1024, 0, 0);
        add_job(J, C.inp(I_KVW), C.inp(I_KVN), (bf16*)(ws + W_KVQ), 1024, 1536, 1536, 0, 0);
        add_job(J, C.inp(I_NWIN), C.inp(I_NMIX) + 2048, (bf16*)(ws + W_KVQ), 1024, 1072, 1280, 0, 1536);
        add_job(J, C.inp(I_NWIN) + (size_t)1024 * 1072, C.inp(I_NMIX) + 3072, (bf16*)(ws + W_Q3), 1024, 1072, 1280, 0, 0);
        add_job(J, C.inp(I_CW1K), nullptr, (bf16*)(ws + W_CMP1), 2048, 256, 256, 0, 0);
        add_job(J, C.inp(I_CW1V), nullptr, (bf16*)(ws + W_CMP1) + (size_t)256 * 2048, 2048, 256, 256, 0, 0);
        for (int l = 0; l < 2; ++l) add_job(J, C.inp(I_NWOUT) + (size_t)l * 1024 * 1024, nullptr, (bf16*)(ws + W_NOUT) + (size_t)l * 1024 * 1024, 1024, 1024, 1024, 0, 0);
        for (int l = 0; l < 2; ++l) add_job(J, C.inp(I_FGU) + (size_t)l * 1024 * 2 * DFF, C.inp(I_NFFN) + (2 * l) * 1024, (bf16*)(ws + W_FGU + (size_t)l * 2 * DFF * 2048), 1024, 2 * DFF, 2 * DFF, DFF, 0, l ? pg8::FP8_SW1 : 0.f);
        for (int l = 0; l < 2; ++l) add_job(J, C.inp(I_FDN) + (size_t)l * DFF * 1024, nullptr, (bf16*)(ws + W_FDN + (size_t)l * 1024 * DFF * 2), DFF, 1024, 1024, 0, 0, l ? pg8::FP8_SW2 : 0.f);
        for (int l = 0; l < 16; ++l) add_job(J, C.inp(I_MGU) + (size_t)l * 1024 * 2 * DFE, C.inp(I_NFFN) + (2 * (l >> 3) + 1) * 1024, (bf16*)(ws + W_MGU + (size_t)l * 2 * DFE * 1024), 1024, 2 * DFE, 2 * DFE, DFE, 0, pg8::FP8_SW1);
        for (int l = 0; l < 16; ++l) add_job(J, C.inp(I_MDN) + (size_t)l * DFE * 1024, nullptr, (bf16*)(ws + W_MDN + (size_t)l * 1024 * DFE), DFE, 1024, 1024, 0, 0, pg8::FP8_SW2);
    }
    __syncthreads();
    LAS float* scr = (LAS float*)(C.lds + C.wave * 9216);
    const int gw = C.bid * NWAVES + C.wave, NGW = C.G * NWAVES;
    const int nj = J->njobs, total = J->istart[nj];
#define TR_SETUP(it_, P) do { int j = 0; while (j + 1 < nj && J->istart[j + 1] <= (it_)) ++j; \
        const int r = (it_) - J->istart[j], npb = J->npb[j], kb = r / npb, nb = r % npb, n0 = 32 * nb, F = J->F[j]; \
        int drow = J->rowoff[j] + n0; \
        if (F) drow = (n0 < F) ? 256 * (n0 / 128) + (n0 % 128) : 256 * ((n0 - F) / 128) + 128 + ((n0 - F) % 128); \
        P.W = (const float*)J->src[j]; P.gain = (const float*)J->gain[j]; P.WT = (bf16*)J->dst[j]; P.K = J->K[j]; P.Nsrc = J->Nsrc[j]; P.drow = drow; P.k0 = 64 * kb; P.n0 = n0; P.f8s = J->f8s[j]; } while (0)
    {
        TrItem pa, pb; f32x4 va[8], vb[8]; int it = gw;
        if (it < total) { TR_SETUP(it, pa); tr_load(pa, va, C.lane); }
        while (it < total) {
            int itn = it + NGW; bool hn = itn < total;
            if (hn) { TR_SETUP(itn, pb); tr_load(pb, vb, C.lane); }
            tr_finish(pa, va, scr, C.lane);
            if (!hn) break;
            it = itn; itn = it + NGW; hn = itn < total;
            if (hn) { TR_SETUP(itn, pa); tr_load(pa, va, C.lane); }
            tr_finish(pb, vb, scr, C.lane);
            if (!hn) break;
            it = itn; }
    }
#undef TR_SETUP
    { const int gt = C.bid * 512 + C.tid;
      if (gt < 1024) { const float a0 = C.inp(I_HLB)[gt], a1 = C.inp(I_HLB)[1024 + gt]; const float mx = fmaxf(a0, a1), e0 = expf(a0 - mx), e1 = expf(a1 - mx), s = e0 + e1;
          const float s0 = e0 / s, s1 = e1 / s, lb1 = (s0 + s1) - s0;
          float* la = (float*)(ws + WS_LA); float* l1 = (float*)(ws + WS_L1);
          la[gt] = -INFINITY; l1[gt] = 0.f; la[1024 + gt] = logf(lb1); l1[1024 + gt] = log1pf(-lb1); } }
    if (C.bid == 0 && C.tid < 128) ((int*)(ws + WS_RTAB))[2048 + C.tid] = C.tid >> 6;
    if (C.G >= 8 && C.bid >= C.G - 8) { const int ob = (C.bid - (C.G - 8)) * 64 + C.lane, which = ob >> 8, j = ob & 255; const float* pos = C.inp(which ? I_CPV : I_CPK); const float* w1 = C.inp(which ? I_CW1V : I_CW1K);
        float a = 0.f;
#pragma unroll 8
        for (int i = C.wave * 256; i < C.wave * 256 + 256; ++i) a += pos[i] * w1[(size_t)i * 256 + j];
        __syncthreads();
        LAS float* red = (LAS float*)(C.lds + 80 * 1024); red[C.wave * 64 + C.lane] = a;
        __syncthreads();
        if (C.wave == 0) { float t = 0.f;
#pragma unroll
            for (int w = 0; w < 8; ++w) t += red[w * 64 + C.lane];
            ((float*)(ws + WS_CB))[ob] = t; } }
    for (int c = C.bid; c < 256; c += C.G)
        for (int i = 0; i < 32; i += 4) { f32x4 v[4][4]; const float* xb = C.inp(I_X);
#pragma unroll
            for (int r = 0; r < 4; ++r) { const f32x4* xr = (const f32x4*)(xb + (size_t)(c * 256 + C.wave * 32 + i + r) * DM) + C.lane;
#pragma unroll
                for (int j = 0; j < 4; ++j) v[r][j] = xr[64 * j]; }
#pragma unroll
            for (int r = 0; r < 4; ++r) norm_row_store(v[r], (bf16*)(ws + WS_XN) + (size_t)(c * 256 + C.wave * 32 + i + r) * DM, C.lane); }
}

template <bool MOE_ADD, bool ROUTER, bool WRITE_XN, bool XN_FP8 = false>
__device__ __forceinline__ void p_norm(Ctx& C, const float* rw, const float* rgain) {
    unsigned char* ws = C.ws;
    LAS int* cnt8 = (LAS int*)(C.lds + 1024);
    const bf16* Y = (const bf16*)(ws + R_XP);
    const int4* route = (const int4*)(ws + WS_ROUTE); const int2* slot = (const int2*)(ws + WS_SLOT);
    constexpr int NR = (MOE_ADD || ROUTER) ? 2 : 4;
    for (int c = C.bid; c < 256; c += C.G) {
        if (ROUTER) { __syncthreads(); if (C.tid < 8) cnt8[C.tid] = 0; __syncthreads(); }
#pragma unroll 1
        for (int i = 0; i < 32; i += NR) {
            f32x4 v[NR][4];
#pragma unroll
            for (int r = 0; r < NR; ++r) { const float* hr = C.out + (size_t)(c * 256 + C.wave * 32 + i + r) * DM;
#pragma unroll
                for (int j = 0; j < 4; ++j) v[r][j] = __builtin_nontemporal_load((const f32x4*)hr + C.lane + 64 * j); }
            if (MOE_ADD) {
#pragma unroll
                for (int r = 0; r < NR; ++r) { const int row = c * 256 + C.wave * 32 + i + r; float* hr = C.out + (size_t)row * DM;
                    const int4 rt = route[row]; const int2 sl = slot[row]; const float w0 = __builtin_bit_cast(float, rt.y), w1 = __builtin_bit_cast(float, rt.z);
                    const v2u* y0 = (const v2u*)(Y + (size_t)sl.x * DM) + C.lane; const v2u* y1 = (const v2u*)(Y + (size_t)sl.y * DM) + C.lane;
#pragma unroll
                    for (int j = 0; j < 4; ++j) { const v2u a = y0[64 * j], b = y1[64 * j];
                        v[r][j].x += w0 * bflo(a.x) + w1 * bflo(b.x); v[r][j].y += w0 * bfhi(a.x) + w1 * bfhi(b.x); v[r][j].z += w0 * bflo(a.y) + w1 * bflo(b.y); v[r][j].w += w0 * bfhi(a.y) + w1 * bfhi(b.y);
                        ((f32x4*)hr + C.lane)[64 * j] = v[r][j]; } }
            }
            if (WRITE_XN || ROUTER) {
#pragma unroll
                for (int r = 0; r < NR; ++r) { const int row = c * 256 + C.wave * 32 + i + r;
                    float s = 0.f;
#pragma unroll
                    for (int j = 0; j < 4; ++j) s += (v[r][j].x * v[r][j].x + v[r][j].y * v[r][j].y) + (v[r][j].z * v[r][j].z + v[r][j].w * v[r][j].w);
                    const float rstd = rsqrtf(wave_sum(s) * (1.f / DM) + EPS);
                    if (WRITE_XN && XN_FP8) { unsigned* o4 = (unsigned*)(ws + WS_XN + (size_t)row * DM) + C.lane;
#pragma unroll
                        for (int j = 0; j < 4; ++j) o4[64 * j] = pg8::pk4_fp8(v[r][j].x * rstd, v[r][j].y * rstd, v[r][j].z * rstd, v[r][j].w * rstd); }
                    if (WRITE_XN && !XN_FP8) { v2u* o8 = (v2u*)((bf16*)(ws + WS_XN) + (size_t)row * DM) + C.lane;
#pragma unroll
                        for (int j = 0; j < 4; ++j) { v2u w; w.x = pk2(v[r][j].x * rstd, v[r][j].y * rstd); w.y = pk2(v[r][j].z * rstd, v[r][j].w * rstd); o8[64 * j] = w; } }
                    if (ROUTER) {
                        float lg[8];
#pragma unroll
                        for (int e = 0; e < 8; ++e) lg[e] = 0.f;
#pragma unroll
                        for (int j = 0; j < 4; ++j) { const int k0 = 4 * C.lane + 256 * j; const f32x4 g4 = *(const f32x4*)(rgain + k0);
#pragma unroll
                            for (int q = 0; q < 4; ++q) { const float xv = v[r][j][q] * rstd * g4[q]; const f32x4 wa = *(const f32x4*)(rw + (size_t)(k0 + q) * 8), wb = *(const f32x4*)(rw + (size_t)(k0 + q) * 8 + 4);
                                lg[0] += xv * wa.x; lg[1] += xv * wa.y; lg[2] += xv * wa.z; lg[3] += xv * wa.w; lg[4] += xv * wb.x; lg[5] += xv * wb.y; lg[6] += xv * wb.z; lg[7] += xv * wb.w; } }
#pragma unroll
                        for (int e = 0; e < 8; ++e) lg[e] = wave_sum(lg[e]);
                        int e0 = 0; float v0 = lg[0];
#pragma unroll
                        for (int e = 1; e < 8; ++e) if (lg[e] > v0) { v0 = lg[e]; e0 = e; }
                        int e1 = -1; float v1 = -INFINITY;
#pragma unroll
                        for (int e = 0; e < 8; ++e) if (e != e0 && (e1 < 0 || lg[e] > v1)) { v1 = lg[e]; e1 = e; }
                        const float ex = expf(v1 - v0), w0 = 1.f / (1.f + ex), w1 = ex / (1.f + ex);
                        if (C.lane == 0) { ((int4*)(ws + WS_ROUTE))[row] = make_int4(e0 | (e1 << 8), __builtin_bit_cast(int, w0), __builtin_bit_cast(int, w1), 0);
                            atomicAdd((int*)&cnt8[e0], 1); atomicAdd((int*)&cnt8[e1], 1); }
                    }
                }
            }
        }
        if (ROUTER) { __syncthreads(); if (C.tid < 8) ((int*)(ws + WS_RCNT))[c * 8 + C.tid] = cnt8[C.tid]; }
    }
}

__device__ __forceinline__ void p_gather(Ctx& C) {
    unsigned char* ws = C.ws;
    LAS int* tot = (LAS int*)(C.lds + 0);
    LAS int* pre = tot + 8;
    LAS int* base = tot + 16;
    LAS int* ee = tot + 32;
    LAS int* sl = tot + 32 + 256;
    const int* rcnt = (const int*)(ws + WS_RCNT);
    const int4* route = (const int4*)(ws + WS_ROUTE);
    for (int c = C.bid; c < 256; c += C.G) {
        __syncthreads();
        { const int e = C.wave; int t = 0, p = 0;
          for (int i = C.lane; i < 256; i += 64) { const int v = rcnt[i * 8 + e]; t += v; if (i < c) p += v; }
#pragma unroll
          for (int o = 32; o >= 1; o >>= 1) { t += __shfl_xor(t, o); p += __shfl_xor(p, o); }
          if (C.lane == 0) { tot[e] = t; pre[e] = p; } }
        if (C.tid < 256) ee[C.tid] = route[c * 256 + C.tid].x;
        __syncthreads();
        if (C.tid == 0) { int off = 0; for (int e = 0; e < 8; ++e) { base[e] = off + pre[e]; const int nt = (tot[e] + 255) >> 8;
                if (c == 0) { int* te = (int*)(ws + WS_RTAB); for (int q = 0; q < nt; ++q) te[(off >> 8) + q] = e; }
                off += nt << 8; }
            if (c == 0) ((int*)(ws + WS_RTAB))[1024] = off >> 8; }
        __syncthreads();
        if (C.tid < 8) { const int e = C.tid; int r = base[e];
            for (int i = 0; i < 256; ++i) { const int pk = ee[i]; if ((pk & 255) == e) sl[2 * i] = r++; if ((pk >> 8) == e) sl[2 * i + 1] = r++; } }
        __syncthreads();
        if (C.tid < 256) ((int2*)(ws + WS_SLOT))[c * 256 + C.tid] = make_int2(sl[2 * C.tid], sl[2 * C.tid + 1]);
        for (int i = 0; i < 32; i += 4) { v4u a[4];
#pragma unroll
            for (int r = 0; r < 4; ++r) a[r] = *((const v4u*)(ws + WS_XN + (size_t)(c * 256 + C.wave * 32 + i + r) * DM) + C.lane);
#pragma unroll
            for (int r = 0; r < 4; ++r) { const int tl = C.wave * 32 + i + r;
                *((v4u*)(ws + R_XP + (size_t)sl[2 * tl] * DM) + C.lane) = a[r]; *((v4u*)(ws + R_XP + (size_t)sl[2 * tl + 1] * DM) + C.lane) = a[r]; } }
    }
}

__device__ __forceinline__ void p_post_kv(Ctx& C) {
    unsigned char* ws = C.ws;
    const bf16* raw = (const bf16*)(ws + R_QKV);
    const float* kn = C.inp(I_KN);
    LAS unsigned char* tl = C.lds + C.wave * 4608;
    const int l = C.lane, c8 = l & 7, r8 = l >> 3, gw = C.bid * NWAVES + C.wave, NGW = C.G * NWAVES;
    for (int it = gw; it < 128 * 64; it += NGW) {
        const int bg = it >> 6, blk = it & 63, b = bg >> 2, g = bg & 3;
        const bf16* rb = raw + (size_t)(b * SEQ + blk * 32) * 2816 + g * 64 + 8 * c8;
        const size_t dst0 = ((size_t)bg * SEQ + blk * 32) * 64 + 8 * c8;
#pragma unroll
        for (int j = 0; j < 6; ++j) {
            v4u x[4];
#pragma unroll
            for (int i = 0; i < 4; ++i) x[i] = *(const v4u*)(rb + (size_t)(r8 + 8 * i) * 2816 + j * 256);
            if (j == 0 || j == 1) {
                bf16* d = (bf16*)(ws + (j == 0 ? R_KCR : R_VCR)) + dst0;
#pragma unroll
                for (int i = 0; i < 4; ++i) *(v4u*)(d + (size_t)(r8 + 8 * i) * 64) = x[i];
            } else if (j == 2 || j == 4) {
                unsigned char* d = ws + (j == 2 ? R_KS : R_KW) + ((size_t)bg * SEQ + blk * 32) * 64 + (c8 >> 2) * 1024 + (c8 & 3) * 8; const float* gk = kn + (j == 2 ? 64 : 128) + 8 * c8;
                const f32x4 ga = *(const f32x4*)gk, gb = *(const f32x4*)(gk + 4);
#pragma unroll
                for (int i = 0; i < 4; ++i) { const float f[8] = {bflo(x[i].x), bfhi(x[i].x), bflo(x[i].y), bfhi(x[i].y), bflo(x[i].z), bfhi(x[i].z), bflo(x[i].w), bfhi(x[i].w)};
                    float ss = (f[0] * f[0] + f[1] * f[1]) + (f[2] * f[2] + f[3] * f[3]) + (f[4] * f[4] + f[5] * f[5]) + (f[6] * f[6] + f[7] * f[7]);
                    ss += __shfl_xor(ss, 1); ss += __shfl_xor(ss, 2); ss += __shfl_xor(ss, 4);
                    const float rs = rsqrtf(ss * (1.f / 64.f) + EPS);
                    v2u o; o.x = pg8::pk4_fp8(f[0] * rs * ga.x, f[1] * rs * ga.y, f[2] * rs * ga.z, f[3] * rs * ga.w); o.y = pg8::pk4_fp8(f[4] * rs * gb.x, f[5] * rs * gb.y, f[6] * rs * gb.z, f[7] * rs * gb.w);
                    *(v2u*)(d + (size_t)(r8 + 8 * i) * 32) = o; }
            } else {
#pragma unroll
                for (int i = 0; i < 4; ++i) *(LAS v4u*)(tl + (r8 + 8 * i) * 144 + 16 * c8) = x[i];
                LDS_WAIT();
                unsigned wv[8];
#pragma unroll
                for (int t4 = 0; t4 < 8; ++t4) { const float a0 = bf2f(*(const LAS bf16*)(tl + (4 * t4) * 144 + 2 * l)), a1 = bf2f(*(const LAS bf16*)(tl + (4 * t4 + 1) * 144 + 2 * l)),
                                                             a2 = bf2f(*(const LAS bf16*)(tl + (4 * t4 + 2) * 144 + 2 * l)), a3 = bf2f(*(const LAS bf16*)(tl + (4 * t4 + 3) * 144 + 2 * l)); wv[t4] = pg8::pk4_fp8(a0, a1, a2, a3); }
                unsigned char* d = ws + (j == 3 ? R_VST : R_VWT) + (((size_t)bg * 64 + blk) * 64 + l) * 32;
#pragma unroll
                for (int q = 0; q < 2; ++q) { const v4u o = {wv[4 * q], wv[4 * q + 1], wv[4 * q + 2], wv[4 * q + 3]}; *(v4u*)(d + 16 * q) = o; }
                LDS_WAIT();
            }
        }
    }
}

__device__ __forceinline__ void p_cmp2(Ctx& C) {
    unsigned char* ws = C.ws;
    const bf16* Hk = (const bf16*)(ws + WS_HC); const bf16* Hv = Hk + (size_t)16384 * 256;
    const float* w2k = C.inp(I_CW2K); const float* w2v = C.inp(I_CW2V); const float* kn = C.inp(I_KN);
    LAS float* hk = (LAS float*)(C.lds + C.wave * 2048); LAS float* hv = hk + 256;
    const int l = C.lane, gw = C.bid * NWAVES + C.wave, NGW = C.G * NWAVES;
    for (int r = gw; r < 16384; r += NGW) {
        const int bg = r >> 7, c = r & 127;
        { const v2u a = *((const v2u*)(Hk + (size_t)r * 256) + l), bq = *((const v2u*)(Hv + (size_t)r * 256) + l);
          hk[4 * l] = bflo(a.x); hk[4 * l + 1] = bfhi(a.x); hk[4 * l + 2] = bflo(a.y); hk[4 * l + 3] = bfhi(a.y);
          hv[4 * l] = bflo(bq.x); hv[4 * l + 1] = bfhi(bq.x); hv[4 * l + 2] = bflo(bq.y); hv[4 * l + 3] = bfhi(bq.y); }
        LDS_WAIT();
        float ak = 0.f, av = 0.f;
#pragma unroll 8
        for (int j = 0; j < 256; ++j) { ak += hk[j] * w2k[j * 64 + l]; av += hv[j] * w2v[j * 64 + l]; }
        if (c == 127) { ak = 0.f; av = 0.f; }
        const float rs = rsqrtf(wave_sum(ak * ak) * (1.f / 64.f) + EPS);
        ((bf16*)(ws + WS_KC))[((size_t)bg * 128 + 32 * (c >> 5)) * 64 + (l >> 5) * 1024 + (c & 31) * 32 + (l & 31)] = (bf16)f2bf(ak * rs * kn[l]);
        ((bf16*)(ws + WS_VCT))[(((size_t)bg * 4 + (c >> 5)) * 64 + l) * 32 + (c & 31)] = (bf16)f2bf(av);
        LDS_WAIT();
    }
}

typedef short bf16x8v __attribute__((ext_vector_type(8)));
#define MFMA16(a, b, c) __builtin_amdgcn_mfma_f32_16x16x32_bf16((a), (b), (c), 0, 0, 0)
constexpr float LOG2E = 1.4426950408889634f;
__device__ __forceinline__ float xmax_q4(float v) {
    float t;
    asm volatile("v_mov_b32 %1, %0\n\ts_nop 1\n\tv_permlane16_swap_b32 %0, %1\n\ts_nop 1\n\tv_max_f32 %0, %0, %1\n\tv_mov_b32 %1, %0\n\ts_nop 1\n\tv_permlane32_swap_b32 %0, %1\n\ts_nop 1\n\tv_max_f32 %0, %0, %1" : "+v"(v), "=&v"(t));
    return v;
}
__device__ __forceinline__ f32x4 att_mma(bf16x8v a, bf16x8v b, f32x4 c) { return __builtin_amdgcn_mfma_f32_16x16x32_bf16(a, b, c, 0, 0, 0); }
__device__ __forceinline__ f32x4 att_mma(long a, long b, f32x4 c) { return __builtin_amdgcn_mfma_f32_16x16x32_fp8_fp8(a, b, c, 0, 0, 0); }
__device__ __forceinline__ void att_pack(bf16x8v& pf, const float (&p)[8], bool keep) {
    unsigned w0 = pg8::cvt_pk_bf16(p[0], p[1]), w1 = pg8::cvt_pk_bf16(p[2], p[3]), w2 = pg8::cvt_pk_bf16(p[4], p[5]), w3 = pg8::cvt_pk_bf16(p[6], p[7]);
    if (!keep) { w0 = 0u; w1 = 0u; w2 = 0u; w3 = 0u; }
    const v4u w = {w0, w1, w2, w3}; pf = __builtin_bit_cast(bf16x8v, w); }
__device__ __forceinline__ void att_pack(long& pf, const float (&p)[8], bool keep) {
    unsigned w0 = pg8::pk4_fp8(p[0], p[1], p[2], p[3]), w1 = pg8::pk4_fp8(p[4], p[5], p[6], p[7]);
    if (!keep) { w0 = 0u; w1 = 0u; }
    const v2u w = {w0, w1}; pf = __builtin_bit_cast(long, w); }
template <class FR> struct AttKV { FR ka[2], kb[2], vf[4]; };
template <class FR, bool NOPV>
__device__ __forceinline__ void attn_kv_load(AttKV<FR>& f, const void* __restrict__ Kb, unsigned koff, const void* __restrict__ Vb, unsigned voff, int k0) {
    constexpr int SH = sizeof(FR) == 16 ? 0 : 1;
    const char* kblk = (const char*)Kb + (((size_t)k0 * 128) >> SH); const char* vblk = (const char*)Vb + (((size_t)k0 * 128) >> SH);
#pragma unroll
    for (int ks = 0; ks < 2; ++ks) { f.ka[ks] = *(const FR*)(kblk + koff + ((2048 * ks) >> SH)); f.kb[ks] = *(const FR*)(kblk + koff + ((256 + 2048 * ks) >> SH)); }
    if (!NOPV) {
#pragma unroll
        for (int dt = 0; dt < 4; ++dt) f.vf[dt] = *(const FR*)(vblk + voff + ((1024 * dt) >> SH)); }
}
template <int MODE, int PATH, class FR, bool NOPV = false>
__device__ __forceinline__ void attn_step(const AttKV<FR>& f, int k0, int trel, bool tk, int cmax,
                                          const FR (&qf)[2][2], const f32x4 (&bv)[2], float (&m)[2], float (&ls)[2], f32x4 (&o)[2][4], const float (&sl2)[2], int q4) {
    constexpr int DMUL = (MODE == 0) ? 16 : 1;
    const float trelf = (float)trel;
    bool ok[8];
    if (PATH == 2) {
#pragma unroll
        for (int i = 0; i < 8; ++i) { const int kk = 8 * q4 + i; const int d = trel - DMUL * kk; ok[i] = (MODE == 0) ? (k0 + kk <= cmax) : (MODE == 1 ? (tk && d >= 0) : (d >= 0 && d < 512)); } }
#pragma unroll
    for (int h = 0; h < 2; ++h) {
        f32x4 sa = att_mma(f.ka[0], qf[h][0], bv[0] * ((float)DMUL * sl2[h])), sb = att_mma(f.kb[0], qf[h][0], bv[1] * ((float)DMUL * sl2[h])); sa = att_mma(f.ka[1], qf[h][1], sa); sb = att_mma(f.kb[1], qf[h][1], sb);
        float mref = m[h] + sl2[h] * trelf;
        float mx;
        if (PATH == 2) { mx = -1e30f;
#pragma unroll
            for (int i = 0; i < 8; ++i) { const float v = i < 4 ? sa[i] : sb[i - 4]; mx = ok[i] ? fmaxf(mx, v) : mx; } }
        else { mx = fmaxf(fmaxf(fmaxf(sa[0], sa[1]), fmaxf(sa[2], sa[3])), fmaxf(fmaxf(sb[0], sb[1]), fmaxf(sb[2], sb[3]))); if (PATH == 1) mx = tk ? mx : -1e30f; }
        mx = xmax_q4(mx);
        if (__any(mx > mref + 8.f)) { const float mn = fmaxf(mref, mx), alpha = __builtin_amdgcn_exp2f(mref - mn); m[h] = mn - sl2[h] * trelf; mref = mn; ls[h] *= alpha;
            if (!NOPV) {
#pragma unroll
                for (int dt = 0; dt < 4; ++dt) o[h][dt] = o[h][dt] * alpha; } }
        float p[8]; float psum = 0.f;
#pragma unroll
        for (int i = 0; i < 8; ++i) { const float e = __builtin_amdgcn_exp2f((i < 4 ? sa[i] : sb[i - 4]) - mref); p[i] = (PATH == 2) ? (ok[i] ? e : 0.f) : e; psum += p[i]; }
        if (PATH == 1) psum = tk ? psum : 0.f;
        ls[h] += psum;
        FR pf; att_pack(pf, p, PATH == 1 ? tk : true);
        if (!NOPV) {
#pragma unroll
            for (int dt = 0; dt < 4; ++dt) o[h][dt] = att_mma(f.vf[dt], pf, o[h][dt]); }
    }
}
constexpr int PSW = 132;
__device__ __forceinline__ void p_attn_fast(Ctx& C, unsigned* queue, const int ld, const int qo, const float* qn) {
    unsigned char* ws = C.ws;
    const bf16* Qraw = (const bf16*)(ws + R_QKV);
    const bf16* KC = (const bf16*)(ws + WS_KC); const bf16* VCT = (const bf16*)(ws + WS_VCT);
    const unsigned char* KS = ws + R_KS; const unsigned char* VST = ws + R_VST; const unsigned char* KW = ws + R_KW; const unsigned char* VWT = ws + R_VWT;
    bf16* O = (bf16*)(ws + R_O);
    LAS float* psl = (LAS float*)(C.lds + C.wave * (16 * PSW * 4));
    int qsel = (int)(xb_xcc_id() & 7u), qtry = 0;
    for (;;) {
        int l = C.lane; asm volatile("" : "+v"(l));
        const int r16 = l & 15, q4 = l >> 4;
        const unsigned koff = (unsigned)((8 * (r16 >> 2) + (r16 & 3)) * 64 + 16 * q4), voff = (unsigned)((r16 * 32 + 8 * q4) * 2);
        unsigned u = 0; if (l == 0) u = __hip_atomic_fetch_add(queue + 64 * qsel, 1u, __ATOMIC_RELAXED, __HIP_MEMORY_SCOPE_AGENT);
        u = (unsigned)__builtin_amdgcn_readfirstlane((int)u);
        if (u >= 2048u) { if (++qtry >= 8) break; qsel = (qsel + 1) & 7; continue; }
        u = ((u >> 7) * 8 + (unsigned)qsel) * 128 + (u & 127);
        const int bg = (int)(u >> 7), tile = 127 - (int)(u & 127), g = bg & 3, b = bg >> 2, t0 = tile * 16, t = t0 + r16, row = b * SEQ + t;
#define qrow (Qraw + (size_t)row * ld + qo)
#define gtp (qrow + 1024 + g * 12)
#define orow (O + (size_t)row * DM + g * 256 + 4 * q4)
        bf16x8v qf[2][2]; long qf8[2][2]; float sl2[2]; f32x4 bv[2]; float m[2]; float ls[2]; f32x4 o[2][4];
#define ATT_LOADQ(hp, DM_) do { _Pragma("unroll") for (int i_ = 0; i_ < 4; ++i_) { bv[0][i_] = (float)(8 * q4 + i_); bv[1][i_] = (float)(8 * q4 + 4 + i_); } \
            _Pragma("unroll") for (int h = 0; h < 2; ++h) { sl2[h] = exp2f(-0.5f * (float)(g * 4 + 2 * (hp) + h + 1)) * LOG2E; \
            float xq_[2][8]; float ssq_ = 0.f; \
            _Pragma("unroll") for (int ks = 0; ks < 2; ++ks) { const v4u r_ = *(const v4u*)(qrow + (g * 4 + 2 * (hp) + h) * 64 + 32 * ks + 8 * q4); \
                xq_[ks][0] = bflo(r_.x); xq_[ks][1] = bfhi(r_.x); xq_[ks][2] = bflo(r_.y); xq_[ks][3] = bfhi(r_.y); xq_[ks][4] = bflo(r_.z); xq_[ks][5] = bfhi(r_.z); xq_[ks][6] = bflo(r_.w); xq_[ks][7] = bfhi(r_.w); \
                _Pragma("unroll") for (int j_ = 0; j_ < 8; ++j_) ssq_ += xq_[ks][j_] * xq_[ks][j_]; } \
            ssq_ += __shfl_xor(ssq_, 16); ssq_ += __shfl_xor(ssq_, 32); \
            const float rq_ = rsqrtf(ssq_ * (1.f / 64.f) + EPS) * (0.125f * LOG2E); \
            _Pragma("unroll") for (int ks = 0; ks < 2; ++ks) { const f32x4 ga_ = *(const f32x4*)(qn + 32 * ks + 8 * q4), gb_ = *(const f32x4*)(qn + 32 * ks + 8 * q4 + 4); \
                const v4u w_ = {pg8::cvt_pk_bf16(xq_[ks][0] * rq_ * ga_.x, xq_[ks][1] * rq_ * ga_.y), pg8::cvt_pk_bf16(xq_[ks][2] * rq_ * ga_.z, xq_[ks][3] * rq_ * ga_.w), \
                                pg8::cvt_pk_bf16(xq_[ks][4] * rq_ * gb_.x, xq_[ks][5] * rq_ * gb_.y), pg8::cvt_pk_bf16(xq_[ks][6] * rq_ * gb_.z, xq_[ks][7] * rq_ * gb_.w)}; \
                qf[h][ks] = __builtin_bit_cast(bf16x8v, w_); \
                const v2u w8_ = {pg8::pk4_fp8(xq_[ks][0] * rq_ * ga_.x, xq_[ks][1] * rq_ * ga_.y, xq_[ks][2] * rq_ * ga_.z, xq_[ks][3] * rq_ * ga_.w), pg8::pk4_fp8(xq_[ks][4] * rq_ * gb_.x, xq_[ks][5] * rq_ * gb_.y, xq_[ks][6] * rq_ * gb_.z, xq_[ks][7] * rq_ * gb_.w)}; \
                qf8[h][ks] = __builtin_bit_cast(long, w8_); } } } while (0)
#define ATT_RESET() do { _Pragma("unroll") for (int h = 0; h < 2; ++h) { m[h] = -1e30f; ls[h] = 0.f; _Pragma("unroll") for (int dt = 0; dt < 4; ++dt) o[h][dt] = (f32x4){0.f, 0.f, 0.f, 0.f}; } } while (0)
        const int cmax = t >= 31 ? (((t - 31) >> 4) < 126 ? ((t - 31) >> 4) : 126) : -1;
        const int cmax0 = t0 >= 31 ? (((t0 - 31) >> 4) < 126 ? ((t0 - 31) >> 4) : 126) : -1;
        const bf16* KCb = KC + (size_t)bg * 128 * 64; const bf16* VCb = VCT + (size_t)bg * 128 * 64;
        const int ncs = ((t0 + 15 - 31) >> 4) < 0 ? 0 : ((((t0 + 15 - 31) >> 4) < 126 ? ((t0 + 15 - 31) >> 4) : 126) >> 5) + 1;
#pragma unroll 1
        for (int hp = 0; hp < 2; ++hp) {
            ATT_LOADQ(hp, 16); ATT_RESET();
            for (int st = ncs - 1; st >= 0; --st) {
                AttKV<bf16x8v> fc; attn_kv_load<bf16x8v, true>(fc, KCb, koff, VCb, voff, 32 * st);
                if (32 * st + 31 <= cmax0) attn_step<0, 0, bf16x8v, true>(fc, 32 * st, t - 31 - 16 * 32 * st, true, cmax, qf, bv, m, ls, o, sl2, q4);
                else attn_step<0, 2, bf16x8v, true>(fc, 32 * st, t - 31 - 16 * 32 * st, true, cmax, qf, bv, m, ls, o, sl2, q4); }
#pragma unroll
            for (int h = 0; h < 2; ++h) { float lt = ls[h]; lt += __shfl_xor(lt, 16); lt += __shfl_xor(lt, 32); ls[h] = lt; }
            float ps[4][8];
#pragma unroll
            for (int st = 0; st < 4; ++st)
#pragma unroll
                for (int i = 0; i < 8; ++i) ps[st][i] = 0.f;
#pragma unroll
            for (int st = 0; st < 4; ++st) {
                if (st < ncs) {
                    const int k0 = 32 * st; const char* kblk = (const char*)(KCb + (size_t)k0 * 64);
                    bf16x8v ka[2], kb[2];
#pragma unroll
                    for (int ks = 0; ks < 2; ++ks) { ka[ks] = *(const bf16x8v*)(kblk + koff + 2048 * ks); kb[ks] = *(const bf16x8v*)(kblk + koff + 256 + 2048 * ks); }
#pragma unroll
                    for (int h = 0; h < 2; ++h) {
                        f32x4 sa = MFMA16(ka[0], qf[h][0], bv[0] * (16.f * sl2[h])), sb = MFMA16(kb[0], qf[h][0], bv[1] * (16.f * sl2[h])); sa = MFMA16(ka[1], qf[h][1], sa); sb = MFMA16(kb[1], qf[h][1], sb);
                        const float lt = ls[h], inv = lt > 0.f ? 1.f / lt : 0.f, mref = m[h] + sl2[h] * (float)(t - 31 - 16 * k0);
#pragma unroll
                        for (int i = 0; i < 8; ++i) { const int c = k0 + 8 * q4 + i; ps[st][i] += (c <= cmax) ? __builtin_amdgcn_exp2f((i < 4 ? sa[i] : sb[i - 4]) - mref) * inv : 0.f; }
                    }
                }
            }
#pragma unroll
            for (int st = 0; st < 4; ++st) { LAS f32x4* p0 = (LAS f32x4*)(psl + r16 * PSW + 32 * st + 8 * q4);
                f32x4 a = {ps[st][0], ps[st][1], ps[st][2], ps[st][3]}, bq = {ps[st][4], ps[st][5], ps[st][6], ps[st][7]};
                if (hp) { a = a + p0[0]; bq = bq + p0[1]; }
                p0[0] = a; p0[1] = bq; }
            LDS_WAIT();
        }
        unsigned mlo, mhi;
        {
            float sc[16]; const LAS float* pr = psl + r16 * PSW + 32 * q4; const int cur = t >> 5;
            float prev = q4 > 0 ? pr[-1] : 0.f;
#pragma unroll
            for (int jj = 0; jj < 16; ++jj) { const float a = pr[2 * jj], bq = pr[2 * jj + 1]; const float imp = prev + a + bq; prev = bq;
                const int j = 16 * q4 + jj; const bool valid = 32 * j <= t; const bool forced = valid && (j == 0 || j == cur || j == cur - 1);
                sc[jj] = forced ? 1e9f : (valid ? imp : -1e9f); }
            unsigned my = 0u;
#pragma unroll 1
            for (int r = 0; r < 8; ++r) {
                float best = sc[0]; int bi = 0;
#pragma unroll
                for (int jj = 1; jj < 16; ++jj) if (sc[jj] > best) { best = sc[jj]; bi = jj; }
                bi += 16 * q4;
#pragma unroll
                for (int sh = 16; sh <= 32; sh <<= 1) { const float ov = __shfl_xor(best, sh); const int oi = __shfl_xor(bi, sh); if (ov > best || (ov == best && oi < bi)) { best = ov; bi = oi; } }
                if ((bi >> 4) == q4) { const int jj0 = bi & 15; if (best > -0.5e9f) my |= 1u << jj0;
#pragma unroll
                    for (int jj = 0; jj < 16; ++jj) if (jj == jj0) sc[jj] = -INFINITY; }
            }
            mlo = (q4 == 0 ? my : 0u) | (q4 == 1 ? my << 16 : 0u); mhi = (q4 == 2 ? my : 0u) | (q4 == 3 ? my << 16 : 0u);
            mlo |= __shfl_xor(mlo, 16); mlo |= __shfl_xor(mlo, 32); mhi |= __shfl_xor(mhi, 16); mhi |= __shfl_xor(mhi, 32);
        }
        LDS_WAIT();
        unsigned ulo = mlo, uhi = mhi;
#pragma unroll
        for (int sh = 1; sh <= 8; sh <<= 1) { ulo |= __shfl_xor(ulo, sh); uhi |= __shfl_xor(uhi, sh); }
        const unsigned long long un0 = ((unsigned long long)(unsigned)__builtin_amdgcn_readfirstlane((int)uhi) << 32) | (unsigned)__builtin_amdgcn_readfirstlane((int)ulo);
        const unsigned long long mine = ((unsigned long long)mhi << 32) | mlo;
#pragma unroll 1
        for (int hp = 0; hp < 2; ++hp) {
            const v2u g6raw = *(const v2u*)(gtp + 6 * hp); const unsigned g6x = gtp[6 * hp + 4], g6y = gtp[6 * hp + 5];
            v2u oacc[2][4];
#define ATT_GLOG(i) ((i) == 0 ? bflo(g6raw.x) : (i) == 1 ? bfhi(g6raw.x) : (i) == 2 ? bflo(g6raw.y) : (i) == 3 ? bfhi(g6raw.y) : (i) == 4 ? bf2f(g6x) : bf2f(g6y))
#define ATT_FOLD(br, first) do { _Pragma("unroll") for (int h = 0; h < 2; ++h) { float lt = ls[h]; lt += __shfl_xor(lt, 16); lt += __shfl_xor(lt, 32); const float sc_ = lt > 0.f ? (1.f / (1.f + __expf(-ATT_GLOG(h * 3 + (br))))) / lt : 0.f; \
            _Pragma("unroll") for (int dt = 0; dt < 4; ++dt) { f32x4 r_ = o[h][dt] * sc_; \
                if (!(first)) { r_[0] += bflo(oacc[h][dt].x); r_[1] += bfhi(oacc[h][dt].x); r_[2] += bflo(oacc[h][dt].y); r_[3] += bfhi(oacc[h][dt].y); } \
                oacc[h][dt].x = pg8::cvt_pk_bf16(r_[0], r_[1]); oacc[h][dt].y = pg8::cvt_pk_bf16(r_[2], r_[3]); } } } while (0)
            ATT_LOADQ(hp, 16); ATT_RESET();
            for (int st = ncs - 1; st >= 0; --st) {
                AttKV<bf16x8v> fc; attn_kv_load<bf16x8v, false>(fc, KCb, koff, VCb, voff, 32 * st);
                if (32 * st + 31 <= cmax0) attn_step<0, 0, bf16x8v>(fc, 32 * st, t - 31 - 16 * 32 * st, true, cmax, qf, bv, m, ls, o, sl2, q4);
                else attn_step<0, 2, bf16x8v>(fc, 32 * st, t - 31 - 16 * 32 * st, true, cmax, qf, bv, m, ls, o, sl2, q4); }
            ATT_FOLD(0, true);
            {
                const unsigned char* Kb = KS + (size_t)bg * SEQ * 64; const unsigned char* Vb = VST + (size_t)bg * SEQ * 64;
                ATT_RESET();
                unsigned long long un = un0;
                const int cur0 = t0 >> 5;
                AttKV<long> fn; int jn = 63 - __builtin_clzll(un); un &= ~(1ull << jn); attn_kv_load<long, false>(fn, Kb, koff >> 1, Vb, voff >> 1, 32 * jn);
#pragma unroll 1
                for (;;) { const int j = jn; const AttKV<long> fc = fn; const bool more = un != 0ull;
                    if (more) { jn = 63 - __builtin_clzll(un); un &= ~(1ull << jn); }
                    attn_kv_load<long, false>(fn, Kb, koff >> 1, Vb, voff >> 1, 32 * jn);
                    const bool tk = ((mine >> j) & 1ull) != 0ull;
                    if (j >= cur0) attn_step<1, 2, long>(fc, 32 * j, t - 32 * j, tk, 0, qf8, bv, m, ls, o, sl2, q4);
                    else if (__all(tk)) attn_step<1, 0, long>(fc, 32 * j, t - 32 * j, true, 0, qf8, bv, m, ls, o, sl2, q4);
                    else attn_step<1, 1, long>(fc, 32 * j, t - 32 * j, tk, 0, qf8, bv, m, ls, o, sl2, q4);
                    if (!more) break; }
                ATT_FOLD(1, false);
            }
            {
                const unsigned char* Kb = KW + (size_t)bg * SEQ * 64; const unsigned char* Vb = VWT + (size_t)bg * SEQ * 64;
                const int sb = t0 >= 511 ? (t0 - 511) >> 5 : 0, se = t0 >> 5;
                ATT_RESET();
                AttKV<long> fn; attn_kv_load<long, false>(fn, Kb, koff >> 1, Vb, voff >> 1, 32 * se);
#pragma unroll 1
                for (int st = se; st >= sb; --st) { const AttKV<long> fc = fn;
                    attn_kv_load<long, false>(fn, Kb, koff >> 1, Vb, voff >> 1, 32 * (st > sb ? st - 1 : st));
                    if (32 * st + 31 <= t0 && 32 * st > t0 - 497) attn_step<2, 0, long>(fc, 32 * st, t - 32 * st, true, 0, qf8, bv, m, ls, o, sl2, q4);
                    else attn_step<2, 2, long>(fc, 32 * st, t - 32 * st, true, 0, qf8, bv, m, ls, o, sl2, q4); }
                ATT_FOLD(2, false);
            }
#pragma unroll
            for (int h = 0; h < 2; ++h)
#pragma unroll
                for (int dt = 0; dt < 4; ++dt) *(v2u*)(orow + (2 * hp + h) * 64 + 16 * dt) = oacc[h][dt];
        }
#undef ATT_FOLD
#undef ATT_GLOG
#undef ATT_LOADQ
#undef ATT_RESET
#undef qrow
#undef gtp
#undef orow
    }
}

constexpr int SCQ = 272, SCT = 144;
constexpr int LQ_ = 0, LK_ = 17408, LKT_ = 34816, LVT_ = 53248, LP_ = 71680, LO_ = 80896, LE_ = 114688, LT_ = 115712;
#define SC_BAR() do { asm volatile("s_waitcnt lgkmcnt(0)" ::: "memory"); __builtin_amdgcn_s_barrier(); asm volatile("" ::: "memory"); } while (0)
__device__ __forceinline__ void p_scan_fast(Ctx& C, int layer) {
    unsigned char* ws = C.ws;
    const bf16* Pq = (const bf16*)(ws + R_PQ); const bf16* Pi = (const bf16*)(ws + R_PI); const bf16* Pg = (const bf16*)(ws + R_PG); const float* LF = (const float*)(ws + R_LF);
    bf16* O2 = (bf16*)(ws + R_O2);
    const float* gn = C.inp(I_HGN) + layer * 128;
    LAS unsigned char* L = C.lds;
    const int tid = C.tid, lane = C.lane, w = C.wave, r16 = lane & 15, q4 = lane >> 4, k = tid & 127, seg = tid >> 7;
    LAS float* tot = (LAS float*)(L + LT_); LAS float* eref = (LAS float*)(L + LE_); LAS float* elr = eref + 128;
    { const int tile = tid >> 8, e = tid & 255, row = e >> 4, col = e & 15;
      *(LAS bf16*)(L + LP_ + ((tile ? 32 : 0) + row) * SCT + ((tile ? 48 : 16) + col) * 2) = 0; }
    for (int bh = C.bid; bh < 256; bh += C.G) {
        const int b = bh >> 3, h = bh & 7;
        const size_t base = (size_t)(b * SEQ) * DM + h * 128;
        f32x4 S[8];
#pragma unroll
        for (int i = 0; i < 8; ++i) S[i] = (f32x4){0.f, 0.f, 0.f, 0.f};
        bf16 qv[16], vv[16]; float lf[16];
#define SC_LOAD(t0) do { _Pragma("unroll") for (int i = 0; i < 16; ++i) { const size_t off = base + (size_t)((t0) + 16 * seg + i) * DM + k; qv[i] = Pq[off]; vv[i] = Pi[off]; lf[i] = LF[off]; } } while (0)
        SC_LOAD(0);
#pragma unroll 1
        for (int c = 0; c < SEQ / 64; ++c) {
            const int t0 = c * 64;
            float cs[16]; { float run = 0.f;
#pragma unroll
                for (int i = 0; i < 16; ++i) { run += lf[i]; cs[i] = run; }
                tot[seg * 128 + k] = run; }
            SC_BAR();
            { const float a0 = tot[k], a1 = tot[128 + k], a2 = tot[256 + k], a3 = tot[384 + k];
              const float off = seg == 0 ? 0.f : (seg == 1 ? a0 : (seg == 2 ? a0 + a1 : a0 + a1 + a2)), ref = a0 + a1, last = ref + a2 + a3;
              unsigned kt[16];
#pragma unroll
              for (int i = 0; i < 16; ++i) { const float d = off + cs[i] - ref; const float qt = bf2f(qv[i]) * __expf(fminf(d, 80.f)), ktv = (1.f - __expf(lf[i])) * __expf(fminf(-d, 80.f));
                  const int s = 16 * seg + i; kt[i] = f2bf(ktv);
                  *(LAS bf16*)(L + LQ_ + s * SCQ + k * 2) = (bf16)f2bf(qt); *(LAS bf16*)(L + LK_ + s * SCQ + k * 2) = (bf16)kt[i]; }
              v4u w0, w1, x0, x1;
              w0.x = kt[0] | (kt[1] << 16); w0.y = kt[2] | (kt[3] << 16); w0.z = kt[4] | (kt[5] << 16); w0.w = kt[6] | (kt[7] << 16);
              w1.x = kt[8] | (kt[9] << 16); w1.y = kt[10] | (kt[11] << 16); w1.z = kt[12] | (kt[13] << 16); w1.w = kt[14] | (kt[15] << 16);
              x0.x = vv[0] | ((unsigned)vv[1] << 16); x0.y = vv[2] | ((unsigned)vv[3] << 16); x0.z = vv[4] | ((unsigned)vv[5] << 16); x0.w = vv[6] | ((unsigned)vv[7] << 16);
              x1.x = vv[8] | ((unsigned)vv[9] << 16); x1.y = vv[10] | ((unsigned)vv[11] << 16); x1.z = vv[12] | ((unsigned)vv[13] << 16); x1.w = vv[14] | ((unsigned)vv[15] << 16);
              *(LAS v4u*)(L + LKT_ + k * SCT + seg * 32) = w0; *(LAS v4u*)(L + LKT_ + k * SCT + seg * 32 + 16) = w1;
              *(LAS v4u*)(L + LVT_ + k * SCT + seg * 32) = x0; *(LAS v4u*)(L + LVT_ + k * SCT + seg * 32 + 16) = x1;
              if (seg == 0) { eref[k] = __expf(ref); elr[k] = __expf(last - ref); } }
            SC_BAR();
            if (c + 1 < SEQ / 64) SC_LOAD(t0 + 64);
            v4u g8p[2];
#pragma unroll
            for (int rep = 0; rep < 2; ++rep) g8p[rep] = *(const v4u*)(Pg + base + (size_t)(t0 + (tid >> 4) + 32 * rep) * DM + (tid & 15) * 8);
#pragma unroll 1
            for (int ti = w; ti < 10; ti += 8) {
                const int rt = ti < 1 ? 0 : (ti < 3 ? 1 : (ti < 6 ? 2 : 3)), ct = ti - (rt * (rt + 1)) / 2;
                f32x4 acc = {0.f, 0.f, 0.f, 0.f};
#pragma unroll
                for (int p = 0; p < 4; ++p) { const bf16x8v a = *(const LAS bf16x8v*)(L + LQ_ + (16 * rt + r16) * SCQ + (32 * p + 8 * q4) * 2), bq = *(const LAS bf16x8v*)(L + LK_ + (16 * ct + r16) * SCQ + (32 * p + 8 * q4) * 2);
                    acc = MFMA16(a, bq, acc); }
#pragma unroll
                for (int i = 0; i < 4; ++i) { const int t = 16 * rt + 4 * q4 + i, s = 16 * ct + r16; *(LAS bf16*)(L + LP_ + t * SCT + s * 2) = (bf16)f2bf(s <= t ? acc[i] : 0.f); }
            }
            SC_BAR();
            bf16x8v sfrag[4]; f32x4 e8[4][2];
#pragma unroll
            for (int p = 0; p < 4; ++p) { e8[p][0] = *(const LAS f32x4*)(eref + 32 * p + 8 * q4); e8[p][1] = *(const LAS f32x4*)(eref + 32 * p + 8 * q4 + 4);
                S[2 * p] = S[2 * p] * e8[p][0]; S[2 * p + 1] = S[2 * p + 1] * e8[p][1];
                const v4u wv = {pg8::cvt_pk_bf16(S[2 * p][0], S[2 * p][1]), pg8::cvt_pk_bf16(S[2 * p][2], S[2 * p][3]), pg8::cvt_pk_bf16(S[2 * p + 1][0], S[2 * p + 1][1]), pg8::cvt_pk_bf16(S[2 * p + 1][2], S[2 * p + 1][3])};
                sfrag[p] = __builtin_bit_cast(bf16x8v, wv); }
            bf16x8v vfr[2];
#pragma unroll
            for (int ss = 0; ss < 2; ++ss) vfr[ss] = *(const LAS bf16x8v*)(L + LVT_ + (16 * w + r16) * SCT + (32 * ss + 8 * q4) * 2);
#pragma unroll
            for (int rt = 0; rt < 4; ++rt) { f32x4 o = {0.f, 0.f, 0.f, 0.f};
#pragma unroll
                for (int p = 0; p < 4; ++p) { const bf16x8v a = *(const LAS bf16x8v*)(L + LQ_ + (16 * rt + r16) * SCQ + (32 * p + 8 * q4) * 2); o = MFMA16(a, sfrag[p], o); }
#pragma unroll
                for (int ss = 0; ss < 2; ++ss) if (ss <= rt / 2) { const bf16x8v a = *(const LAS bf16x8v*)(L + LP_ + (16 * rt + r16) * SCT + (32 * ss + 8 * q4) * 2); o = MFMA16(a, vfr[ss], o); }
#pragma unroll
                for (int i = 0; i < 4; ++i) *(LAS float*)(L + LO_ + (16 * rt + 4 * q4 + i) * 528 + (16 * w + r16) * 4) = o[i]; }
#pragma unroll
            for (int p = 0; p < 4; ++p)
#pragma unroll
                for (int ab = 0; ab < 2; ++ab) { const int krow = 32 * p + 8 * (r16 >> 2) + (r16 & 3) + 4 * ab;
#pragma unroll
                    for (int ss = 0; ss < 2; ++ss) { const bf16x8v a = *(const LAS bf16x8v*)(L + LKT_ + krow * SCT + (32 * ss + 8 * q4) * 2); S[2 * p + ab] = MFMA16(a, vfr[ss], S[2 * p + ab]); } }
#pragma unroll
            for (int p = 0; p < 4; ++p) { const f32x4 l0 = *(const LAS f32x4*)(elr + 32 * p + 8 * q4), l1 = *(const LAS f32x4*)(elr + 32 * p + 8 * q4 + 4); S[2 * p] = S[2 * p] * l0; S[2 * p + 1] = S[2 * p + 1] * l1; }
            SC_BAR();
#pragma unroll
            for (int rep = 0; rep < 2; ++rep) { const int tok = (tid >> 4) + 32 * rep, part = tid & 15;
                const f32x4 oa = *(const LAS f32x4*)(L + LO_ + tok * 528 + part * 32), ob = *(const LAS f32x4*)(L + LO_ + tok * 528 + part * 32 + 16);
                float ss = (oa.x * oa.x + oa.y * oa.y) + (oa.z * oa.z + oa.w * oa.w) + (ob.x * ob.x + ob.y * ob.y) + (ob.z * ob.z + ob.w * ob.w);
                ss += __shfl_xor(ss, 1); ss += __shfl_xor(ss, 2); ss += __shfl_xor(ss, 4); ss += __shfl_xor(ss, 8);
                const float rstd = rsqrtf(ss * (1.f / 128.f) + EPS);
                const size_t off = base + (size_t)(t0 + tok) * DM + part * 8; const v4u g8 = g8p[rep];
                const f32x4 ga = *(const f32x4*)(gn + part * 8), gb = *(const f32x4*)(gn + part * 8 + 4);
                v4u wv; wv.x = pk2(oa.x * rstd * ga.x * bflo(g8.x), oa.y * rstd * ga.y * bfhi(g8.x)); wv.y = pk2(oa.z * rstd * ga.z * bflo(g8.y), oa.w * rstd * ga.w * bfhi(g8.y));
                wv.z = pk2(ob.x * rstd * gb.x * bflo(g8.z), ob.y * rstd * gb.y * bfhi(g8.z)); wv.w = pk2(ob.z * rstd * gb.z * bflo(g8.w), ob.w * rstd * gb.w * bfhi(g8.w));
                *(v4u*)(O2 + off) = wv; }
        }
#undef SC_LOAD
        __syncthreads();
    }
}

#undef SC_BAR
#define PH_BEGIN { const bool run_ = (pid >= lo && pid < hi); ++pid; if (run_) { { int ln_; asm volatile("v_mbcnt_lo_u32_b32 %0, -1, 0\n\tv_mbcnt_hi_u32_b32 %0, -1, %0" : "=v"(ln_)); C.lane = ln_; C.tid = C.wave * 64 + ln_; }
#define PH_END   if (pid < hi) xcd_barrier(bar); } }
#define XN ((const bf16*)(ws + WS_XN))
#define RTAB ((const int*)(ws + WS_RTAB))

template <int L>
__device__ __forceinline__ void run_layer(Ctx& C, const XcdBarrier& bar, int& pid, const int lo, const int hi, PG8_LAS unsigned char* ring) {
    unsigned char* const ws = C.ws;

        const int li = L >> 1;
        if (L < 2) {
            PH_BEGIN { pg8::Gemm g{XN, (const bf16*)(ws + W_HIN) + (size_t)L * 4096 * 1024, 1024, 1024, 0}; pg8::GenOrder S; S.init(256, 16, C.G, C.bid, nullptr);
                pg8::EpiHgrnIn E{ws, L};
                pg8::gemm_phase<pg8::EpiHgrnIn, pg8::GenOrder, true, true>(ring, g, S, E, C.wave); } PH_END
            PH_BEGIN p_scan_fast(C, L); PH_END
        } else {
            PH_BEGIN { const bool first = (L == 2); pg8::Gemm g{XN, (const bf16*)(ws + (first ? W_KVQ : W_Q3)), 1024, 1024, 0}; pg8::GenOrder S; S.init(256, first ? 11 : 5, C.G, C.bid, nullptr);
                pg8::EpiBf16 E{(bf16*)(ws + R_QKV), first ? 2816 : 1280, nullptr, 0, 0, 1.f};
                pg8::gemm_phase<pg8::EpiBf16, pg8::GenOrder, true, true>(ring, g, S, E, C.wave); } PH_END
            if (L == 2) {
                PH_BEGIN p_post_kv(C); PH_END
                PH_BEGIN { pg8::Gemm g{(const bf16*)(ws + R_KCR), (const bf16*)(ws + W_CMP1), 2048, 1024, (size_t)256 * 2048 * 2}; pg8::GenOrder S; S.init(128, 1, C.G, C.bid, RTAB + 2048);
                    pg8::EpiBf16 E{(bf16*)(ws + WS_HC), 256, (const float*)(ws + WS_CB), 1, 256, 1.f};
                    pg8::gemm_phase<pg8::EpiBf16, pg8::GenOrder, true, true>(ring, g, S, E, C.wave); } PH_END
                PH_BEGIN p_cmp2(C); PH_END
            }
            PH_BEGIN p_attn_fast(C, (unsigned*)(ws + WS_CTL) + 8192 + 2048 * (L - 2), L == 2 ? 2816 : 1280, L == 2 ? 1536 : 0, C.inp(I_NQN) + (L - 2) * 64); PH_END
        }
        PH_BEGIN { pg8::Gemm g{(const bf16*)(ws + (L < 2 ? R_O2 : R_O)), (const bf16*)(ws + (L < 2 ? W_HOUT : W_NOUT)) + (size_t)(L & 1) * 1024 * 1024, 1024, 1024, 0};
            pg8::GenOrder S; S.init(256, 4, C.G, C.bid, nullptr);
            pg8::EpiRes E{L == 0 ? C.inp(I_X) : C.out, C.out, 1024, 1.f};
            pg8::gemm_phase<pg8::EpiRes, pg8::GenOrder, true, true>(ring, g, S, E, C.wave); } PH_END
        PH_BEGIN { if (L & 1) p_norm<false, true, true, true>(C, C.inp(I_MR) + (size_t)li * 1024 * 8, C.inp(I_NFFN) + L * 1024); else if (L == 2) p_norm<false, false, true, true>(C, nullptr, nullptr); else p_norm<false, false, true, false>(C, nullptr, nullptr); } PH_END
        if (L & 1) { PH_BEGIN p_gather(C); PH_END }
        if (L == 0) {
            PH_BEGIN { pg8::Gemm g{XN, (const bf16*)(ws + W_FGU), 1024, 1024, 0};
                pg8::GenOrder S; S.init(256, 22, C.G, C.bid, nullptr);
                pg8::EpiSwiGLU E{(bf16*)(ws + R_HF), DFF};
                pg8::gemm_phase<pg8::EpiSwiGLU, pg8::GenOrder, true, true>(ring, g, S, E, C.wave); } PH_END
            PH_BEGIN { pg8::Gemm g{(const bf16*)(ws + R_HF), (const bf16*)(ws + W_FDN), DFF, DFF, 0}; pg8::GenOrder S; S.init(256, 4, C.G, C.bid, nullptr);
                pg8::EpiRes E{C.out, C.out, 1024, 1.f};
                pg8::gemm_phase<pg8::EpiRes, pg8::GenOrder, true, true>(ring, g, S, E, C.wave); } PH_END
            PH_BEGIN p_norm<false, false, true>(C, nullptr, nullptr); PH_END
        } else {
        PH_BEGIN { const bool moe = (L & 1) != 0;
            pg8::Gemm g{(const bf16*)(ws + (moe ? R_XP : WS_XN)), (const bf16*)(ws + (moe ? W_MGU + (size_t)li * 8 * 2 * DFE * 1024 : W_FGU + (size_t)li * 2 * DFF * 2048)), 512, 512, moe ? (size_t)2 * DFE * 1024 : 0};
            pg8::GenOrder S; S.init(moe ? RTAB[1024] : 256, moe ? 28 : 22, C.G, C.bid, moe ? RTAB : nullptr);
            pg8::EpiSwiGLU8 E{ws + (moe ? R_HM : R_HF), moe ? DFE : DFF};
            pg8::gemm_phase<pg8::EpiSwiGLU8, pg8::GenOrder, true, true, true>(ring, g, S, E, C.wave); } PH_END
        if (!(L & 1)) {
            PH_BEGIN { pg8::Gemm g{(const bf16*)(ws + R_HF), (const bf16*)(ws + W_FDN + (size_t)li * 1024 * DFF * 2), DFF / 2, DFF / 2, 0}; pg8::GenOrder S; S.init(256, 4, C.G, C.bid, nullptr);
                pg8::EpiRes E{C.out, C.out, 1024, 1.f / (pg8::FP8_SH * pg8::FP8_SW2)};
                pg8::gemm_phase<pg8::EpiRes, pg8::GenOrder, true, true, true>(ring, g, S, E, C.wave); } PH_END
            PH_BEGIN p_norm<false, false, true>(C, nullptr, nullptr); PH_END
        } else {
            PH_BEGIN { pg8::Gemm g{(const bf16*)(ws + R_HM), (const bf16*)(ws + W_MDN + (size_t)li * 8 * 1024 * DFE), DFE / 2, DFE / 2, (size_t)1024 * DFE}; pg8::GenOrder S; S.init(RTAB[1024], 4, C.G, C.bid, RTAB);
                pg8::EpiBf16 E{(bf16*)(ws + R_XP), 1024, nullptr, 0, 0, 1.f / (pg8::FP8_SH * pg8::FP8_SW2)};
                pg8::gemm_phase<pg8::EpiBf16, pg8::GenOrder, true, true, true>(ring, g, S, E, C.wave); } PH_END
            PH_BEGIN { if (L == 1) p_norm<true, false, true>(C, nullptr, nullptr); else p_norm<true, false, false>(C, nullptr, nullptr); } PH_END
        }
        }
    }

struct Args { const float* in[24]; float* out; unsigned char* ws; int ph_lo, ph_hi; };
constexpr int N_PHASES = 34;

__global__ void __launch_bounds__(NWAVES * 64, 2) yoco_fwd(Args args) {
    extern __shared__ __attribute__((aligned(16))) unsigned char lds_raw[];
    Ctx C;
    C.lds = (LAS unsigned char*)lds_raw;
    C.wave = __builtin_amdgcn_readfirstlane((int)(threadIdx.x >> 6)); C.tid = threadIdx.x; C.lane = C.tid & 63;
    C.G = gridDim.x; C.bid = blockIdx.x;
    C.out = args.out; C.ws = args.ws;
    unsigned char* const ws = args.ws;
    volatile LAS unsigned* MISC = (volatile LAS unsigned*)(C.lds + MISC_OFF);
    if (C.tid < 32) MISC[C.tid] = 0u;
    __syncthreads();
    XcdBarrier bar = xcd_barrier_post((unsigned*)(ws + WS_CTL) + 4096, MISC + 8);
    const int lo = args.ph_lo, hi = args.ph_hi;
    int pid = 0;
    PG8_LAS unsigned char* ring = (PG8_LAS unsigned char*)lds_raw;
    PH_BEGIN p_prologue(C); PH_END

    run_layer<0>(C, bar, pid, lo, hi, ring); run_layer<1>(C, bar, pid, lo, hi, ring); run_layer<2>(C, bar, pid, lo, hi, ring); run_layer<3>(C, bar, pid, lo, hi, ring);
#undef PH_BEGIN
#undef PH_END
#undef XN
#undef RTAB
}

extern "C" void kernel_launch(void* const* d_in, const int* in_sizes, int n_in, void* d_out, int out_size, void* d_ws, size_t ws_size, hipStream_t stream) {
    static int grid = 0;
    if (grid == 0) {
        if (n_in != 24 || in_sizes[0] != NT * DM || out_size != NT * DM || ws_size < WS_NEED) { fprintf(stderr, "kernel_launch: unexpected shapes / workspace (n_in %d, ws %zu, need %zu)\n", n_in, ws_size, (size_t)WS_NEED); grid = -1; return; }
        int dev = 0, cus = 0;
        if (hipGetDevice(&dev) != hipSuccess || hipDeviceGetAttribute(&cus, hipDeviceAttributeMultiprocessorCount, dev) != hipSuccess) { grid = -1; return; }
        if (hipFuncSetAttribute((const void*)yoco_fwd, hipFuncAttributeMaxDynamicSharedMemorySize, LDS_BYTES) != hipSuccess) { fprintf(stderr, "kernel_launch: hipFuncSetAttribute failed\n"); grid = -1; return; }
        int per_cu = 0;
        if (hipOccupancyMaxActiveBlocksPerMultiprocessor(&per_cu, (const void*)yoco_fwd, NWAVES * 64, LDS_BYTES) != hipSuccess || per_cu < 1) { fprintf(stderr, "kernel_launch: occupancy query says %d\n", per_cu); }
        (void)hipGetLastError();
        grid = cus;
    }
    if (grid < 0) return;
    (void)hipMemsetAsync((char*)d_ws + WS_CTL, 0, CTL_ZERO_BYTES, stream);
    Args a{};
    for (int i = 0; i < 24; ++i) a.in[i] = (const float*)d_in[i];
    a.out = (float*)d_out; a.ws = (unsigned char*)d_ws;
#if MK_SINGLE
    a.ph_lo = 0; a.ph_hi = N_PHASES;
    hipLaunchKernelGGL(yoco_fwd, dim3(grid), dim3(NWAVES * 64), LDS_BYTES, stream, a);
#else
    for (int k = 0; k < N_PHASES; ++k) { a.ph_lo = k; a.ph_hi = k + 1; hipLaunchKernelGGL(yoco_fwd, dim3(grid), dim3(NWAVES * 64), LDS_BYTES, stream, a); }
#endif
}
```

```cpp
#include <hip/hip_runtime.h>
#include <cstdio>
#include <cstdint>

#ifndef MK_SINGLE
#define MK_SINGLE 1
#endif

namespace pg8 {
#define PG8_LAS __attribute__((address_space(3)))
typedef unsigned short bf16_t;
typedef short bf16x8 __attribute__((ext_vector_type(8)));
typedef float f32x4 __attribute__((ext_vector_type(4)));
typedef unsigned u32x4 __attribute__((ext_vector_type(4)));
constexpr int BM = 256, BK = 64, HALF = 128, HTB = HALF * BK * 2  , STAGE_BYTES = 8 * HTB, NXCD = 8, WGM = 8;

__host__ __device__ __forceinline__ int lds_byte(int r, int c) { const int st = (r >> 4) * 2 + (c >> 5), rr = r & 15, cc = c & 31, ob = rr * 64 + cc * 2; return st * 1024 + (ob ^ (((ob >> 9) & 1) << 5)); }
__host__ __device__ __forceinline__ void stage_rc(int b, int& R, int& C) { const int st = b / 1024, sb = b % 1024, swz = sb ^ (((sb >> 9) & 1) << 5); R = (st >> 1) * 16 + swz / 64; C = (st & 1) * 32 + (swz % 64) / 2; }
__host__ __device__ __forceinline__ int perm32(int rho) { const int n = rho >> 4, i = rho & 15; return 8 * (i >> 2) + 4 * n + (i & 3); }

struct Unit { int pm, pn, e; };
struct Gemm { const bf16_t* A; const bf16_t* Bt; int K; int lda; size_t estride; };

struct GenOrder {
    int nM, nN, nwg, G, c; const int* tile_e;
    __device__ void init(int nM_, int nN_, int G_, int c_, const int* te) { nM = nM_; nN = nN_; nwg = nM * nN; G = G_; c = c_; tile_e = te; }
    __device__ bool next(int i, Unit& u) const {
        const long L = (long)i * G + c; if (L >= nwg) return false;
        int wgid = (int)L; { const int q = nwg / NXCD, r = nwg % NXCD, xcd = wgid % NXCD, off = wgid / NXCD; wgid = (xcd < r ? xcd * (q + 1) : r * (q + 1) + (xcd - r) * q) + off; }
        const int nig = WGM * nN, gid = wgid / nig, fm = gid * WGM, gsz = (nM - fm) < WGM ? (nM - fm) : WGM;
        u.pm = fm + ((wgid % nig) % gsz); u.pn = (wgid % nig) / gsz; u.e = tile_e ? tile_e[u.pm] : 0; return true;
    }
    __device__ __forceinline__ void a_ready(const Unit&) const {}
    __device__ __forceinline__ void done(const Unit&) const {}
};

__device__ __forceinline__ unsigned cvt_pk_bf16(float lo, float hi) { unsigned r; asm volatile("v_cvt_pk_bf16_f32 %0, %1, %2" : "=v"(r) : "v"(lo), "v"(hi)); return r; }
__device__ __forceinline__ float silu_f(float v) { return v * __builtin_amdgcn_rcpf(1.0f + __expf(-v)); }
__device__ __forceinline__ float clamp448(float v) { return __builtin_amdgcn_fmed3f(v, -448.f, 448.f); }
__device__ __forceinline__ unsigned pk4_fp8(float a, float b, float c, float d) {
    int w = __builtin_amdgcn_cvt_pk_fp8_f32(clamp448(a), clamp448(b), 0, false); w = __builtin_amdgcn_cvt_pk_fp8_f32(clamp448(c), clamp448(d), w, true); return (unsigned)w; }
constexpr float FP8_SW1 = 32.f, FP8_SW2 = 64.f, FP8_SH = 8.f;

struct EpiBf16 {
    static constexpr bool PERM = true, AFTER_DRAIN = false;
    bf16_t* O; int ldc; const float* bias; int act; int bias_es; float oscale;
    __device__ __forceinline__ void operator()(const f32x4 (&acc)[2][2][4][2], const Unit& u, int wr, int wc, int fr, int fq) const {
        const int row0 = u.pm * BM + wr * 64 + fr, col0 = u.pn * BM + wc * 32 + 8 * fq;
        f32x4 bv[2][2];
#pragma unroll
        for (int bj = 0; bj < 2; ++bj)
#pragma unroll
            for (int n = 0; n < 2; ++n) bv[bj][n] = bias ? *(const f32x4*)(bias + u.e * bias_es + col0 + bj * HALF + 4 * n) : (f32x4){0.f, 0.f, 0.f, 0.f};
#pragma unroll
        for (int ai = 0; ai < 2; ++ai)
#pragma unroll
            for (int m = 0; m < 4; ++m) { bf16_t* rowp = O + (size_t)(row0 + ai * HALF + m * 16) * ldc + col0;
#pragma unroll
                for (int bj = 0; bj < 2; ++bj) { f32x4 v0 = acc[ai][bj][m][0] * oscale + bv[bj][0], v1 = acc[ai][bj][m][1] * oscale + bv[bj][1];
                    if (act == 1) {
#pragma unroll
                        for (int i = 0; i < 4; ++i) { v0[i] = silu_f(v0[i]); v1[i] = silu_f(v1[i]); } }
                    u32x4 w; w.x = cvt_pk_bf16(v0[0], v0[1]); w.y = cvt_pk_bf16(v0[2], v0[3]); w.z = cvt_pk_bf16(v1[0], v1[1]); w.w = cvt_pk_bf16(v1[2], v1[3]);
                    *(u32x4*)(rowp + bj * HALF) = w; } }
    }
};
struct EpiRes {
    static constexpr bool PERM = false, AFTER_DRAIN = false;
    const float* base; float* out; int ldc; float oscale;
    __device__ __forceinline__ void operator()(const f32x4 (&acc)[2][2][4][2], const Unit& u, int wr, int wc, int fr, int fq) const {
        const int row0 = u.pm * BM + wr * 64 + fr, col0 = u.pn * BM + wc * 32 + 4 * fq;
#pragma unroll
        for (int ai = 0; ai < 2; ++ai)
#pragma unroll
            for (int m = 0; m < 4; ++m) { const size_t off = (size_t)(row0 + ai * HALF + m * 16) * ldc + col0;
#pragma unroll
                for (int bj = 0; bj < 2; ++bj)
#pragma unroll
                    for (int n = 0; n < 2; ++n) { const f32x4 b = *(const f32x4*)(base + off + bj * HALF + n * 16); *(f32x4*)(out + off + bj * HALF + n * 16) = b + acc[ai][bj][m][n] * oscale; } }
    }
};
struct EpiSwiGLU {
    static constexpr bool PERM = true, AFTER_DRAIN = false;
    bf16_t* O; int ldc;
    __device__ __forceinline__ void operator()(const f32x4 (&acc)[2][2][4][2], const Unit& u, int wr, int wc, int fr, int fq) const {
        const int row0 = u.pm * BM + wr * 64 + fr, col0 = u.pn * HALF + wc * 32 + 8 * fq;
#pragma unroll
        for (int ai = 0; ai < 2; ++ai)
#pragma unroll
            for (int m = 0; m < 4; ++m) { bf16_t* rowp = O + (size_t)(row0 + ai * HALF + m * 16) * ldc + col0;
                f32x4 v0, v1;
#pragma unroll
                for (int i = 0; i < 4; ++i) { v0[i] = silu_f(acc[ai][0][m][0][i]) * acc[ai][1][m][0][i]; v1[i] = silu_f(acc[ai][0][m][1][i]) * acc[ai][1][m][1][i]; }
                u32x4 w; w.x = cvt_pk_bf16(v0[0], v0[1]); w.y = cvt_pk_bf16(v0[2], v0[3]); w.z = cvt_pk_bf16(v1[0], v1[1]); w.w = cvt_pk_bf16(v1[2], v1[3]);
                *(u32x4*)rowp = w; }
    }
};
struct EpiSwiGLU8 {
    static constexpr bool PERM = true, AFTER_DRAIN = false;
    unsigned char* O; int ldc;
    __device__ __forceinline__ void operator()(const f32x4 (&acc)[2][2][4][2], const Unit& u, int wr, int wc, int fr, int fq) const {
        const int row0 = u.pm * BM + wr * 64 + fr, col0 = u.pn * HALF + wc * 32 + 8 * fq; constexpr float si = 1.f / FP8_SW1;
#pragma unroll
        for (int ai = 0; ai < 2; ++ai)
#pragma unroll
            for (int m = 0; m < 4; ++m) { unsigned char* rowp = O + (size_t)(row0 + ai * HALF + m * 16) * ldc + col0;
                f32x4 v0, v1;
#pragma unroll
                for (int i = 0; i < 4; ++i) {
                    const float g0 = acc[ai][0][m][0][i], g1 = acc[ai][0][m][1][i];
                    v0[i] = (g0 * acc[ai][1][m][0][i]) * ((si * si * FP8_SH) * __builtin_amdgcn_rcpf(1.f + __builtin_amdgcn_exp2f(g0 * (-si * 1.4426950408889634f))));
                    v1[i] = (g1 * acc[ai][1][m][1][i]) * ((si * si * FP8_SH) * __builtin_amdgcn_rcpf(1.f + __builtin_amdgcn_exp2f(g1 * (-si * 1.4426950408889634f)))); }
                typedef unsigned u32x2 __attribute__((ext_vector_type(2))); u32x2 w; w.x = pk4_fp8(v0[0], v0[1], v0[2], v0[3]); w.y = pk4_fp8(v1[0], v1[1], v1[2], v1[3]);
                *(u32x2*)rowp = w; }
    }
};
__device__ __forceinline__ float logf_gate(float x, float la, float l1) {
    const float ls = fminf(x, 0.f) - __logf(1.0f + __expf(-fabsf(x)));
    const float b = l1 + ls;
    if (la == -INFINITY) return b;
    const float mx = fmaxf(la, b), d = fabsf(la - b);
    return mx + __logf(1.0f + __expf(-d));
}
struct EpiHgrnIn {
    static constexpr bool PERM = true, AFTER_DRAIN = false;
    unsigned char* ws; int layer;
    static constexpr size_t O_PQ = 580ull << 20, O_PI = O_PQ + (128ull << 20), O_PG = O_PQ + (256ull << 20), O_LF = O_PQ + (384ull << 20), O_LA = 1ull << 20, O_L1 = O_LA + 8192;
    __device__ __forceinline__ void operator()(const f32x4 (&acc)[2][2][4][2], const Unit& u, int wr, int wc, int fr, int fq) const {
        const int quarter = u.pn >> 2;
        const int row0 = u.pm * BM + wr * 64 + fr, col0 = (u.pn & 3) * BM + wc * 32 + 8 * fq;
        if (quarter == 1) {
            const float* la = (const float*)(ws + O_LA) + layer * 1024; const float* l1 = (const float*)(ws + O_L1) + layer * 1024; float* LF = (float*)(ws + O_LF);
            f32x4 A0[2][2], A1[2][2];
#pragma unroll
            for (int bj = 0; bj < 2; ++bj)
#pragma unroll
                for (int n = 0; n < 2; ++n) { A0[bj][n] = *(const f32x4*)(la + col0 + bj * HALF + 4 * n); A1[bj][n] = *(const f32x4*)(l1 + col0 + bj * HALF + 4 * n); }
#pragma unroll
            for (int ai = 0; ai < 2; ++ai)
#pragma unroll
                for (int m = 0; m < 4; ++m) { float* rowp = LF + (size_t)(row0 + ai * HALF + m * 16) * 1024 + col0;
#pragma unroll
                    for (int bj = 0; bj < 2; ++bj)
#pragma unroll
                        for (int n = 0; n < 2; ++n) { f32x4 o;
#pragma unroll
                            for (int i = 0; i < 4; ++i) o[i] = logf_gate(acc[ai][bj][m][n][i], A0[bj][n][i], A1[bj][n][i]);
                            *(f32x4*)(rowp + bj * HALF + 4 * n) = o; } }
        } else {
            bf16_t* O = (bf16_t*)(ws + (quarter == 0 ? O_PQ : (quarter == 2 ? O_PI : O_PG)));
#pragma unroll
            for (int ai = 0; ai < 2; ++ai)
#pragma unroll
                for (int m = 0; m < 4; ++m) { bf16_t* rowp = O + (size_t)(row0 + ai * HALF + m * 16) * 1024 + col0;
#pragma unroll
                    for (int bj = 0; bj < 2; ++bj) { f32x4 v0 = acc[ai][bj][m][0], v1 = acc[ai][bj][m][1];
                        if (quarter != 2) {
#pragma unroll
                            for (int i = 0; i < 4; ++i) { v0[i] = silu_f(v0[i]); v1[i] = silu_f(v1[i]); } }
                        u32x4 w; w.x = cvt_pk_bf16(v0[0], v0[1]); w.y = cvt_pk_bf16(v0[2], v0[3]); w.z = cvt_pk_bf16(v1[0], v1[1]); w.w = cvt_pk_bf16(v1[2], v1[3]);
                        *(u32x4*)(rowp + bj * HALF) = w; } }
        }
    }
};

template <class Epi, class Sched, bool ALIGN_EPI = false, bool SP2 = false, bool FP8 = false>
__device__ __forceinline__ void gemm_phase(PG8_LAS unsigned char* lds, const Gemm g, const Sched& S, const Epi& E, const int wave_id) {
    int lane_; asm volatile("v_mbcnt_lo_u32_b32 %0, -1, 0\n\tv_mbcnt_hi_u32_b32 %0, -1, %0" : "=v"(lane_));
    const int wid = wave_id, lane = lane_, tid = wid * 64 + lane, wr = wid >> 2, wc = wid & 3, fr = lane & 15, fq = lane >> 4;
    const int K = g.K, nt = K / BK, lda = g.lda;
    unsigned voffA[2], voffB[2];
#pragma unroll
    for (int i = 0; i < 2; ++i) { int R, C; stage_rc(tid * 16 + i * 8192, R, C); const int Rb = Epi::PERM ? ((R & ~31) + perm32(R & 31)) : R;
        voffA[i] = (unsigned)(R * lda + C) * 2u; voffB[i] = (unsigned)(Rb * K + C) * 2u; }
    const size_t kstep = (size_t)(BK * 2);
    const size_t hstep = (size_t)HALF * K * 2;
    const size_t tstep = 2 * hstep;
    const size_t hstepA = (size_t)HALF * lda * 2, tstepA = 2 * hstepA;
    const unsigned ldsw = (unsigned)wid * 1024u;
    const int aoff = lds_byte(wr * 64 + fr, fq * 8), boff = lds_byte(wc * 32 + fr, fq * 8);
#define PG8_SA(b, h) (((b) * 2 + (h)) * HTB)
#define PG8_SB(b, h) ((4 + (b) * 2 + (h)) * HTB)
#define PG8_STAGE(bufoff, gbase, voff) do { _Pragma("unroll") for (int _i = 0; _i < 2; ++_i) \
        __builtin_amdgcn_global_load_lds((const unsigned*)((const char*)(gbase) + (voff)[_i]), (PG8_LAS unsigned*)(lds + (bufoff) + ldsw + _i * 8192), 16, 0, 0); } while (0)
    typedef int i32x4_ __attribute__((ext_vector_type(4))); typedef int i32x8_ __attribute__((ext_vector_type(8)));
#define PG8_CAT(x, y) __builtin_shufflevector((x), (y), 0, 1, 2, 3, 4, 5, 6, 7)
#define PG8_LDA(dst, b, h) do { _Pragma("unroll") for (int m = 0; m < 4; ++m) { \
        if constexpr (FP8) dst##8[m] = PG8_CAT(*(const PG8_LAS i32x4_*)(lds + PG8_SA(b, h) + aoff + m * 2048), *(const PG8_LAS i32x4_*)(lds + PG8_SA(b, h) + aoff + m * 2048 + 1024)); \
        else { _Pragma("unroll") for (int k = 0; k < 2; ++k) dst[m][k] = *(const PG8_LAS bf16x8*)(lds + PG8_SA(b, h) + aoff + m * 2048 + k * 1024); } } } while (0)
#define PG8_LDB(dst, b, h) do { _Pragma("unroll") for (int n = 0; n < 2; ++n) { \
        if constexpr (FP8) dst##8[n] = PG8_CAT(*(const PG8_LAS i32x4_*)(lds + PG8_SB(b, h) + boff + n * 2048), *(const PG8_LAS i32x4_*)(lds + PG8_SB(b, h) + boff + n * 2048 + 1024)); \
        else { _Pragma("unroll") for (int k = 0; k < 2; ++k) dst[n][k] = *(const PG8_LAS bf16x8*)(lds + PG8_SB(b, h) + boff + n * 2048 + k * 1024); } } } while (0)
#define PG8_MMA(ai, bj, At, Bt) do { __builtin_amdgcn_s_setprio(1); _Pragma("unroll") for (int m = 0; m < 4; ++m) _Pragma("unroll") for (int n = 0; n < 2; ++n) { \
        if constexpr (FP8) asm volatile("v_mfma_scale_f32_16x16x128_f8f6f4 %0, %1, %2, %0, %3, %3 op_sel_hi:[0,0,0]" : "+v"(acc[ai][bj][m][n]) : "v"(Bt##8[n]), "v"(At##8[m]), "v"(f8scale_)); \
        else { _Pragma("unroll") for (int k = 0; k < 2; ++k) acc[ai][bj][m][n] = __builtin_amdgcn_mfma_f32_16x16x32_bf16(Bt[n][k], At[m][k], acc[ai][bj][m][n], 0, 0, 0); } } \
        __builtin_amdgcn_s_setprio(0); } while (0)
#define PG8_WAIT_V(n) asm volatile("s_waitcnt vmcnt(" #n ")" ::: "memory")
#define PG8_WAIT_L(n) asm volatile("s_waitcnt lgkmcnt(" #n ")" ::: "memory")
#define PG8_BAR __builtin_amdgcn_s_barrier()
#define PG8_SCHED __builtin_amdgcn_sched_barrier(0)
    Unit cur, nxt; int ui = 0;
    if (!S.next(0, cur)) return;
    f32x4 acc[2][2][4][2];
#pragma unroll
    for (int a = 0; a < 2; ++a)
#pragma unroll
        for (int b = 0; b < 2; ++b)
#pragma unroll
            for (int m = 0; m < 4; ++m)
#pragma unroll
                for (int n = 0; n < 2; ++n) acc[a][b][m][n] = (f32x4){0.f, 0.f, 0.f, 0.f};
    const int f8scale_ = 0x7f7f7f7f;
    bf16x8 At[4][2], B0[2][2], B1[2][2]; i32x8_ At8[4], B08[2], B18[2];
    const char* cA = (const char*)g.A + (size_t)cur.pm * tstepA; const char* cB = (const char*)g.Bt + (size_t)cur.e * g.estride + (size_t)cur.pn * tstep;
    S.a_ready(cur);
    if constexpr (SP2) {
        PG8_STAGE(PG8_SB(0, 0), cB, voffB); PG8_STAGE(PG8_SB(0, 1), cB + hstep, voffB); PG8_STAGE(PG8_SA(0, 0), cA, voffA); PG8_STAGE(PG8_SA(0, 1), cA + hstepA, voffA);
        if (wr == 1) PG8_BAR;
        PG8_WAIT_V(2); PG8_BAR;
        PG8_STAGE(PG8_SB(1, 0), cB + kstep, voffB); PG8_STAGE(PG8_SA(1, 0), cA + kstep, voffA); PG8_STAGE(PG8_SB(1, 1), cB + hstep + kstep, voffB);
        PG8_WAIT_V(6); PG8_BAR;
    } else {
        PG8_STAGE(PG8_SB(0, 0), cB, voffB); PG8_STAGE(PG8_SA(0, 0), cA, voffA); PG8_STAGE(PG8_SB(0, 1), cB + hstep, voffB); PG8_STAGE(PG8_SA(0, 1), cA + hstepA, voffA);
        if (wr == 1) PG8_BAR;
        PG8_WAIT_V(4); PG8_BAR;
        PG8_STAGE(PG8_SB(1, 0), cB + kstep, voffB); PG8_STAGE(PG8_SA(1, 0), cA + kstep, voffA); PG8_STAGE(PG8_SB(1, 1), cB + hstep + kstep, voffB);
        PG8_WAIT_V(6); PG8_BAR;
    }
    for (;;) {
        const bool has_next = S.next(ui + 1, nxt);
        const char* nA = has_next ? (const char*)g.A + (size_t)nxt.pm * tstepA : cA; const char* nB = has_next ? (const char*)g.Bt + (size_t)nxt.e * g.estride + (size_t)nxt.pn * tstep : cB;
        for (int t = 0; t < nt; t += 2) {
            const bool last = (t == nt - 2);
            const char* a1 = cA + (size_t)(t + 1) * kstep;
            const char* a2 = last ? nA : cA + (size_t)(t + 2) * kstep; const char* b2 = last ? nB : cB + (size_t)(t + 2) * kstep;
            const char* a3 = a2 + kstep; const char* b3 = b2 + kstep;
            if (last && has_next) S.a_ready(nxt);
            if constexpr (SP2) {
            PG8_LDB(B0, 0, 0); PG8_LDB(B1, 0, 1); PG8_SCHED; PG8_LDA(At, 0, 0); PG8_STAGE(PG8_SA(1, 1), a1 + hstepA, voffA);
            PG8_WAIT_V(8); PG8_WAIT_L(0); PG8_BAR; PG8_MMA(0, 0, At, B0); PG8_MMA(0, 1, At, B1); PG8_BAR; PG8_SCHED;
            PG8_LDA(At, 0, 1); PG8_STAGE(PG8_SB(0, 0), b2, voffB); PG8_STAGE(PG8_SB(0, 1), b2 + hstep, voffB); PG8_STAGE(PG8_SA(0, 0), a2, voffA);
            PG8_WAIT_V(8); PG8_WAIT_L(0); PG8_BAR; PG8_MMA(1, 0, At, B0); PG8_MMA(1, 1, At, B1); PG8_BAR; PG8_SCHED;
            PG8_LDB(B0, 1, 0); PG8_LDB(B1, 1, 1); PG8_SCHED; PG8_LDA(At, 1, 0); PG8_STAGE(PG8_SA(0, 1), a2 + hstepA, voffA);
            PG8_WAIT_V(8); PG8_WAIT_L(0); PG8_BAR; PG8_MMA(0, 0, At, B0); PG8_MMA(0, 1, At, B1); PG8_BAR; PG8_SCHED;
            PG8_LDA(At, 1, 1); PG8_STAGE(PG8_SB(1, 0), b3, voffB); PG8_STAGE(PG8_SB(1, 1), b3 + hstep, voffB); PG8_STAGE(PG8_SA(1, 0), a3, voffA);
            PG8_WAIT_V(8); PG8_WAIT_L(0); PG8_BAR; PG8_MMA(1, 0, At, B0); PG8_MMA(1, 1, At, B1); PG8_BAR; PG8_SCHED;
            } else {
            PG8_LDB(B0, 0, 0); PG8_SCHED; PG8_LDA(At, 0, 0); PG8_STAGE(PG8_SA(1, 1), a1 + hstepA, voffA);
            PG8_WAIT_L(8); PG8_BAR; PG8_WAIT_L(0); PG8_MMA(0, 0, At, B0); PG8_BAR; PG8_SCHED;
            PG8_LDB(B1, 0, 1); PG8_STAGE(PG8_SB(0, 0), b2, voffB);
            PG8_BAR; PG8_WAIT_L(0); PG8_MMA(0, 1, At, B1); PG8_BAR;
            PG8_LDA(At, 0, 1); PG8_STAGE(PG8_SA(0, 0), a2, voffA);
            PG8_BAR; PG8_WAIT_L(0); PG8_MMA(1, 0, At, B0); PG8_BAR; PG8_SCHED;
            PG8_STAGE(PG8_SB(0, 1), b2 + hstep, voffB);
            PG8_WAIT_V(6); PG8_BAR; PG8_MMA(1, 1, At, B1); PG8_BAR;
            PG8_LDB(B0, 1, 0); PG8_SCHED; PG8_LDA(At, 1, 0); PG8_STAGE(PG8_SA(0, 1), a2 + hstepA, voffA);
            PG8_WAIT_L(8); PG8_BAR; PG8_WAIT_L(0); PG8_MMA(0, 0, At, B0); PG8_BAR; PG8_SCHED;
            PG8_LDB(B1, 1, 1); PG8_STAGE(PG8_SB(1, 0), b3, voffB);
            PG8_BAR; PG8_WAIT_L(0); PG8_MMA(0, 1, At, B1); PG8_BAR;
            PG8_LDA(At, 1, 1); PG8_STAGE(PG8_SA(1, 0), a3, voffA);
            PG8_BAR; PG8_WAIT_L(0); PG8_MMA(1, 0, At, B0); PG8_BAR; PG8_SCHED;
            PG8_STAGE(PG8_SB(1, 1), b3 + hstep, voffB);
            PG8_WAIT_V(6); PG8_BAR; PG8_MMA(1, 1, At, B1); PG8_BAR;
            }
        }
        if constexpr (FP8) asm volatile("s_nop 15\n\ts_nop 15" ::: "memory");
        if constexpr (ALIGN_EPI) { if (wr == 0) PG8_BAR; }
        if constexpr (!Epi::AFTER_DRAIN) { E(acc, cur, wr, wc, fr, fq); S.done(cur); }
        if (!has_next) break;
#pragma unroll
        for (int a = 0; a < 2; ++a)
#pragma unroll
            for (int b = 0; b < 2; ++b)
#pragma unroll
                for (int m = 0; m < 4; ++m)
#pragma unroll
                    for (int n = 0; n < 2; ++n) acc[a][b][m][n] = (f32x4){0.f, 0.f, 0.f, 0.f};
        cur = nxt; cA = nA; cB = nB; ++ui;
        if constexpr (ALIGN_EPI) { if (wr == 1) PG8_BAR; }
    }
    PG8_WAIT_V(0);
    if constexpr (!ALIGN_EPI) { if (wr == 0) PG8_BAR; }
    PG8_BAR;
    if constexpr (Epi::AFTER_DRAIN) { E.fused(acc, cur, wr, wc, fr, fq, lds, wid, lane); S.done(cur); }
#undef PG8_SA
#undef PG8_SB
#undef PG8_STAGE
#undef PG8_LDA
#undef PG8_LDB
#undef PG8_MMA
#undef PG8_CAT
#undef PG8_WAIT_V
#undef PG8_WAIT_L
#undef PG8_BAR
#undef PG8_SCHED
}
}

constexpr int NT = 65536, DM = 1024, NBATCH = 32, SEQ = 2048;
constexpr int DFF = 2816, DFE = 3584, NEXP = 8;
constexpr int MOE_ROWS = 133120;
constexpr float EPS = 1e-6f;
constexpr size_t MiB = 1u << 20;
constexpr size_t WS_CTL = 0, CTL_ZERO_BYTES = 1 * MiB;
constexpr size_t WS_LA = 1 * MiB;
constexpr size_t WS_L1 = WS_LA + 8192;
constexpr size_t WS_CB = WS_LA + 16384;
constexpr size_t WS_RCNT = WS_LA + 32768;
constexpr size_t WS_RTAB = WS_LA + 65536;
constexpr size_t WS_ROUTE = 2 * MiB;
constexpr size_t WS_SLOT = 3 * MiB;
constexpr size_t WS_SELM = 4 * MiB;
constexpr size_t WS_GATES = 8 * MiB;
constexpr size_t WS_KC = 20 * MiB;
constexpr size_t WS_VCT = 22 * MiB;
constexpr size_t WS_HC = 24 * MiB;
constexpr size_t WS_W = 48 * MiB;
constexpr size_t W_HIN = WS_W, W_HOUT = WS_W + 16 * MiB, W_KVQ = WS_W + 20 * MiB, W_Q3 = WS_W + 26 * MiB, W_CMP1 = WS_W + 29 * MiB, W_NOUT = WS_W + 31 * MiB,
                 W_FGU = WS_W + 35 * MiB, W_FDN = WS_W + 57 * MiB, W_MGU = WS_W + 68 * MiB, W_MDN = WS_W + 292 * MiB;
constexpr size_t WS_XN = 452 * MiB;
constexpr size_t WS_R = 580 * MiB;
constexpr size_t R_PQ = WS_R, R_PI = WS_R + 128 * MiB, R_PG = WS_R + 256 * MiB, R_LF = WS_R + 384 * MiB, R_O2 = WS_R + 640 * MiB;
constexpr size_t R_HF = WS_R + 256 * MiB;
constexpr size_t R_KS = WS_R, R_KW = WS_R + 32 * MiB, R_VST = WS_R + 64 * MiB, R_VWT = WS_R + 96 * MiB, R_KCR = WS_R + 128 * MiB, R_VCR = WS_R + 160 * MiB;
constexpr size_t R_QKV = WS_R + 256 * MiB;
constexpr size_t R_Q = WS_R + 608 * MiB, R_O = WS_R + 736 * MiB;
constexpr size_t R_XP = WS_R, R_HM = WS_R + 260 * MiB;
constexpr size_t WS_NEED = R_HM + (size_t)MOE_ROWS * DFE * 2;
static_assert(WS_NEED <= 1792 * MiB, "workspace map");
static_assert(W_MDN + 112 * MiB <= WS_XN, "weights map");
static_assert(pg8::EpiHgrnIn::O_PQ == R_PQ && pg8::EpiHgrnIn::O_PI == R_PI && pg8::EpiHgrnIn::O_PG == R_PG && pg8::EpiHgrnIn::O_LF == R_LF && pg8::EpiHgrnIn::O_LA == WS_LA && pg8::EpiHgrnIn::O_L1 == WS_L1, "EpiHgrnIn offsets");

constexpr int LDS_BYTES = 147456;
constexpr int MISC_OFF = 131072 + 320;
constexpr int NWAVES = 8;

#define GAS __attribute__((address_space(1)))
#define LAS __attribute__((address_space(3)))
typedef unsigned short bf16;
typedef unsigned v4u __attribute__((ext_vector_type(4)));
typedef unsigned v2u __attribute__((ext_vector_type(2)));
typedef float f32x4 __attribute__((ext_vector_type(4)));
#define LDS_WAIT() asm volatile("s_waitcnt lgkmcnt(0)" ::: "memory")
__device__ __forceinline__ unsigned f2bf(float f) { unsigned u = __builtin_bit_cast(unsigned, f); return (u + 0x7fffu + ((u >> 16) & 1u)) >> 16; }
__device__ __forceinline__ unsigned pk2(float lo, float hi) { return f2bf(lo) | (f2bf(hi) << 16); }
__device__ __forceinline__ float bf2f(unsigned b) { return __builtin_bit_cast(float, b << 16); }
__device__ __forceinline__ float bflo(unsigned w) { return __builtin_bit_cast(float, w << 16); }
__device__ __forceinline__ float bfhi(unsigned w) { return __builtin_bit_cast(float, w & 0xffff0000u); }
__device__ __forceinline__ float wave_sum(float v) {
#pragma unroll
    for (int o = 32; o >= 1; o >>= 1) v += __shfl_xor(v, o);
    return v;
}
__device__ __forceinline__ float wave_max(float v) {
#pragma unroll
    for (int o = 32; o >= 1; o >>= 1) v = fmaxf(v, __shfl_xor(v, o));
    return v;
}

#define XB_TMO      128
#define XB_XCNT(j)  (256  + 64 * (j))
#define XB_XSUB(j)  (1280 + 64 * (j))
#define XB_XGEN(j)  (2304 + 64 * (j))
#define XB_TOP      3328
#define XB_TOPGEN   3392
#define XCD_BAR_WORDS 3456
#define XB_SPIN_CAP (1u << 22)
__device__ __forceinline__ unsigned xb_ld(unsigned* p)              { return __hip_atomic_load(p, __ATOMIC_RELAXED, __HIP_MEMORY_SCOPE_AGENT); }
__device__ __forceinline__ unsigned xb_add(unsigned* p, unsigned v) { return __hip_atomic_fetch_add(p, v, __ATOMIC_RELAXED, __HIP_MEMORY_SCOPE_AGENT); }
__device__ __forceinline__ unsigned xb_xcc_id() { return (unsigned)__builtin_amdgcn_s_getreg((3 << 11) | 20) & 0xFu; }
#define XB_SPIN(cond, bar) do { unsigned _sp = 0; while (cond) { __builtin_amdgcn_s_sleep(1); \
    if ((++_sp & 255u) == 0u) { if (xb_ld(&(bar)[XB_TMO])) break; if (_sp > XB_SPIN_CAP) { atomicAdd(&(bar)[XB_TMO], 1u); break; } } } } while (0)
struct XcdBarrier { unsigned* bar; unsigned x; volatile LAS unsigned* st; };
__device__ __forceinline__ XcdBarrier xcd_barrier_post(unsigned* bar, volatile LAS unsigned* st) {
    XcdBarrier b; b.bar = bar; b.x = xb_xcc_id(); b.st = st;
    if (threadIdx.x == 0) (void)xb_add(&bar[XB_XCNT(b.x)], 1u);
    return b;
}
__device__ __forceinline__ void xcd_barrier_complete(unsigned* bar, unsigned x, unsigned& nloc, unsigned& nx) {
    const unsigned G = gridDim.x * gridDim.y * gridDim.z;
    unsigned sum, cnt, mine, sp = 0u;
    for (;;) {
        sum = 0u; cnt = 0u; mine = 0u;
#pragma unroll
        for (unsigned j = 0; j < 16; ++j) { const unsigned c = xb_ld(&bar[XB_XCNT(j)]); sum += c; cnt += (c > 0u) ? 1u : 0u; mine = (j == x) ? c : mine; }
        if (sum == G) break;
        __builtin_amdgcn_s_sleep(1);
        if ((++sp & 255u) == 0u) { if (xb_ld(&bar[XB_TMO])) break; if (sp > XB_SPIN_CAP) { atomicAdd(&bar[XB_TMO], 1u); break; } }
    }
    nloc = mine > 0u ? mine : 1u; nx = cnt > 0u ? cnt : 1u;
}
__device__ __forceinline__ void xcd_barrier(const XcdBarrier& b) {
    asm volatile("s_waitcnt vmcnt(0)" ::: "memory");
    __syncthreads();
    if (threadIdx.x == 0) {
        unsigned* bar = b.bar; unsigned bx_ = b.x; asm volatile("" : "+s"(bar), "+s"(bx_));
        __builtin_amdgcn_s_waitcnt(0);
        unsigned nloc = b.st[0], nx = b.st[1];
        if (nloc == 0u) { xcd_barrier_complete(bar, bx_, nloc, nx); b.st[0] = nloc; b.st[1] = nx; }
        const unsigned old = xb_add(&bar[XB_XSUB(bx_)], 1u);
        const unsigned gen = old / nloc;
        if (old + 1u == (gen + 1u) * nloc) {
            __builtin_amdgcn_fence(__ATOMIC_RELEASE, "agent");
            asm volatile("s_waitcnt vmcnt(0)" ::: "memory");
            const unsigned og = xb_add(&bar[XB_TOP], 1u);
            const unsigned tg = og / nx;
            if (og + 1u == (tg + 1u) * nx) xb_add(&bar[XB_TOPGEN], 1u);
            else XB_SPIN(xb_ld(&bar[XB_TOPGEN]) == tg, bar);
            __builtin_amdgcn_fence(__ATOMIC_ACQUIRE, "agent");
            xb_add(&bar[XB_XGEN(bx_)], 1u);
            asm volatile("s_waitcnt vmcnt(0)" ::: "memory");
        } else {
            XB_SPIN(xb_ld(&bar[XB_XGEN(bx_)]) == gen, bar);
            __builtin_amdgcn_fence(__ATOMIC_ACQUIRE, "agent");
            asm volatile("s_waitcnt vmcnt(0)" ::: "memory");
        }
    }
    __syncthreads();
}

struct Ctx {
    LAS unsigned char* lds;
    int tid, lane, wave, G, bid;
    float* out; unsigned char* ws;
    __device__ __forceinline__ const float* inp(int i) const {
        const __attribute__((address_space(4))) unsigned char* kp = (const __attribute__((address_space(4))) unsigned char*)__builtin_amdgcn_kernarg_segment_ptr();
        asm volatile("" : "+s"(kp));
        return ((const float* const __attribute__((address_space(4)))*)kp)[i];
    }
};
enum { I_X = 0, I_NMIX, I_NFFN, I_HWIN, I_HWOUT, I_HGN, I_HLB, I_KVN, I_KVW, I_CPK, I_CW1K, I_CW2K, I_CPV, I_CW1V, I_CW2V, I_KN, I_NWIN, I_NWOUT, I_NQN, I_FGU, I_FDN, I_MR, I_MGU, I_MDN };

constexpr int MAXJOB = 64;
struct JobTab { unsigned long long src[MAXJOB], gain[MAXJOB], dst[MAXJOB]; int K[MAXJOB], Nsrc[MAXJOB], npb[MAXJOB], F[MAXJOB], rowoff[MAXJOB], istart[MAXJOB + 1]; float f8s[MAXJOB]; int njobs; };
__device__ __forceinline__ void add_job(LAS JobTab* J, const float* src, const float* gain, bf16* dst, int K, int Nsrc, int Npad, int F, int rowoff, float f8s = 0.f) {
    const int j = J->njobs; J->src[j] = (unsigned long long)src; J->gain[j] = (unsigned long long)gain; J->dst[j] = (unsigned long long)dst;
    J->K[j] = K; J->Nsrc[j] = Nsrc; J->npb[j] = Npad / 32; J->F[j] = F; J->rowoff[j] = rowoff; J->f8s[j] = f8s; J->istart[j + 1] = J->istart[j] + (K / 64) * (Npad / 32); J->njobs = j + 1;
}
struct TrItem { const float* W; const float* gain; bf16* WT; int K, Nsrc, drow, k0, n0; float f8s; };
__device__ __forceinline__ void tr_load(const TrItem& p, f32x4 (&v)[8], int lane) {
    const int c4 = lane & 7, kr = lane >> 3, n = p.n0 + 4 * c4; const bool okn = n < p.Nsrc;
#pragma unroll
    for (int i = 0; i < 8; ++i) { const int kk = 8 * i + kr; v[i] = okn ? *(const f32x4*)(p.W + (size_t)(p.k0 + kk) * p.Nsrc + n) : (f32x4){0.f, 0.f, 0.f, 0.f}; }
}
__device__ __forceinline__ void tr_finish(const TrItem& p, f32x4 (&v)[8], LAS float* scr, int lane) {
    const int c4 = lane & 7, kr = lane >> 3;
#pragma unroll
    for (int i = 0; i < 8; ++i) { const int kk = 8 * i + kr; if (p.gain) v[i] = v[i] * p.gain[p.k0 + kk]; *(LAS f32x4*)(scr + kk * 36 + 4 * c4) = v[i]; }
    LDS_WAIT();
    const int c = lane & 7; const float f8s = p.f8s;
#pragma unroll
    for (int j = 0; j < 4; ++j) { const int nn = (lane >> 3) + 8 * j; const LAS float* s = scr + (8 * c) * 36 + nn;
        if (f8s != 0.f) { v2u o; o.x = pg8::pk4_fp8(s[0 * 36] * f8s, s[1 * 36] * f8s, s[2 * 36] * f8s, s[3 * 36] * f8s); o.y = pg8::pk4_fp8(s[4 * 36] * f8s, s[5 * 36] * f8s, s[6 * 36] * f8s, s[7 * 36] * f8s);
            *(v2u*)((unsigned char*)p.WT + (size_t)(p.drow + nn) * p.K + p.k0 + 8 * c) = o; }
        else { v4u o; o.x = pk2(s[0 * 36], s[1 * 36]); o.y = pk2(s[2 * 36], s[3 * 36]); o.z = pk2(s[4 * 36], s[5 * 36]); o.w = pk2(s[6 * 36], s[7 * 36]);
            *(v4u*)(p.WT + (size_t)(p.drow + nn) * p.K + p.k0 + 8 * c) = o; } }
    LDS_WAIT();
}
__device__ __forceinline__ void norm_row_store(const f32x4 (&v)[4], bf16* orow, int lane) {
    float s = 0.f;
#pragma unroll
    for (int j = 0; j < 4; ++j) s += (v[j].x * v[j].x + v[j].y * v[j].y) + (v[j].z * v[j].z + v[j].w * v[j].w);
    const float rstd = rsqrtf(wave_sum(s) * (1.f / DM) + EPS);
    v2u* o8 = (v2u*)orow + lane;
#pragma unroll
    for (int j = 0; j < 4; ++j) { v2u w; w.x = pk2(v[j].x * rstd, v[j].y * rstd); w.y = pk2(v[j].z * rstd, v[j].w * rstd); o8[64 * j] = w; }
}
__device__ __forceinline__ void p_prologue(Ctx& C) {
    LAS JobTab* J = (LAS JobTab*)(C.lds + 73728);
    unsigned char* ws = C.ws;
    if (C.tid == 0) {
        J->njobs = 0; J->istart[0] = 0;
        for (int l = 0; l < 2; ++l) add_job(J, C.inp(I_HWIN) + (size_t)l * 1024 * 4096, C.inp(I_NMIX) + l * 1024, (bf16*)(ws + W_HIN) + (size_t)l * 4096 * 1024, 1024, 4096, 4096, 0, 0);
        for (int l = 0; l < 2; ++l) add_job(J, C.inp(I_HWOUT) + (size_t)l * 1024 * 1024, nullptr, (bf16*)(ws + W_HOUT) + (size_t)l * 1024 * 1024, 1024, 1024, 1024, 0, 0);
        add_job(J, C.inp(I_KVW), C.inp(I_KVN), (bf16*)(ws + W_KVQ), 1024, 1536, 1536, 0, 0, pg8::FP8_SW1);
        add_job(J, C.inp(I_NWIN), C.inp(I_NMIX) + 2048, (bf16*)(ws + W_KVQ), 1024, 1072, 1280, 0, 1536, pg8::FP8_SW1);
        add_job(J, C.inp(I_NWIN) + (size_t)1024 * 1072, C.inp(I_NMIX) + 3072, (bf16*)(ws + W_Q3), 1024, 1072, 1280, 0, 0, pg8::FP8_SW1);
        add_job(J, C.inp(I_CW1K), nullptr, (bf16*)(ws + W_CMP1), 2048, 256, 256, 0, 0);
        add_job(J, C.inp(I_CW1V), nullptr, (bf16*)(ws + W_CMP1) + (size_t)256 * 2048, 2048, 256, 256, 0, 0);
        for (int l = 0; l < 2; ++l) add_job(J, C.inp(I_NWOUT) + (size_t)l * 1024 * 1024, nullptr, (bf16*)(ws + W_NOUT) + (size_t)l * 1024 * 1024, 1024, 1024, 1024, 0, 0, pg8::FP8_SW1);
        for (int l = 0; l < 2; ++l) add_job(J, C.inp(I_FGU) + (size_t)l * 1024 * 2 * DFF, C.inp(I_NFFN) + (2 * l) * 1024, (bf16*)(ws + W_FGU + (size_t)l * 2 * DFF * 2048), 1024, 2 * DFF, 2 * DFF, DFF, 0, l ? pg8::FP8_SW1 : 0.f);
        for (int l = 0; l < 2; ++l) add_job(J, C.inp(I_FDN) + (size_t)l * DFF * 1024, nullptr, (bf16*)(ws + W_FDN + (size_t)l * 1024 * DFF * 2), DFF, 1024, 1024, 0, 0, l ? pg8::FP8_SW2 : 0.f);
        for (int l = 0; l < 16; ++l) add_job(J, C.inp(I_MGU) + (size_t)l * 1024 * 2 * DFE, C.inp(I_NFFN) + (2 * (l >> 3) + 1) * 1024, (bf16*)(ws + W_MGU + (size_t)l * 2 * DFE * 1024), 1024, 2 * DFE, 2 * DFE, DFE, 0, pg8::FP8_SW1);
        for (int l = 0; l < 16; ++l) add_job(J, C.inp(I_MDN) + (size_t)l * DFE * 1024, nullptr, (bf16*)(ws + W_MDN + (size_t)l * 1024 * DFE), DFE, 1024, 1024, 0, 0, pg8::FP8_SW2);
    }
    __syncthreads();
    LAS float* scr = (LAS float*)(C.lds + C.wave * 9216);
    const int gw = C.bid * NWAVES + C.wave, NGW = C.G * NWAVES;
    const int nj = J->njobs, total = J->istart[nj];
#define TR_SETUP(it_, P) do { int j = 0; while (j + 1 < nj && J->istart[j + 1] <= (it_)) ++j; \
        const int r = (it_) - J->istart[j], npb = J->npb[j], kb = r / npb, nb = r % npb, n0 = 32 * nb, F = J->F[j]; \
        int drow = J->rowoff[j] + n0; \
        if (F) drow = (n0 < F) ? 256 * (n0 / 128) + (n0 % 128) : 256 * ((n0 - F) / 128) + 128 + ((n0 - F) % 128); \
        P.W = (const float*)J->src[j]; P.gain = (const float*)J->gain[j]; P.WT = (bf16*)J->dst[j]; P.K = J->K[j]; P.Nsrc = J->Nsrc[j]; P.drow = drow; P.k0 = 64 * kb; P.n0 = n0; P.f8s = J->f8s[j]; } while (0)
    {
        TrItem pa, pb; f32x4 va[8], vb[8]; int it = gw;
        if (it < total) { TR_SETUP(it, pa); tr_load(pa, va, C.lane); }
        while (it < total) {
            int itn = it + NGW; bool hn = itn < total;
            if (hn) { TR_SETUP(itn, pb); tr_load(pb, vb, C.lane); }
            tr_finish(pa, va, scr, C.lane);
            if (!hn) break;
            it = itn; itn = it + NGW; hn = itn < total;
            if (hn) { TR_SETUP(itn, pa); tr_load(pa, va, C.lane); }
            tr_finish(pb, vb, scr, C.lane);
            if (!hn) break;
            it = itn; }
    }
#undef TR_SETUP
    { const int gt = C.bid * 512 + C.tid;
      if (gt < 1024) { const float a0 = C.inp(I_HLB)[gt], a1 = C.inp(I_HLB)[1024 + gt]; const float mx = fmaxf(a0, a1), e0 = expf(a0 - mx), e1 = expf(a1 - mx), s = e0 + e1;
          const float s0 = e0 / s, s1 = e1 / s, lb1 = (s0 + s1) - s0;
          float* la = (float*)(ws + WS_LA); float* l1 = (float*)(ws + WS_L1);
          la[gt] = -INFINITY; l1[gt] = 0.f; la[1024 + gt] = logf(lb1); l1[1024 + gt] = log1pf(-lb1); } }
    if (C.bid == 0 && C.tid < 128) ((int*)(ws + WS_RTAB))[2048 + C.tid] = C.tid >> 6;
    if (C.G >= 8 && C.bid >= C.G - 8) { const int ob = (C.bid - (C.G - 8)) * 64 + C.lane, which = ob >> 8, j = ob & 255; const float* pos = C.inp(which ? I_CPV : I_CPK); const float* w1 = C.inp(which ? I_CW1V : I_CW1K);
        float a = 0.f;
#pragma unroll 8
        for (int i = C.wave * 256; i < C.wave * 256 + 256; ++i) a += pos[i] * w1[(size_t)i * 256 + j];
        __syncthreads();
        LAS float* red = (LAS float*)(C.lds + 80 * 1024); red[C.wave * 64 + C.lane] = a;
        __syncthreads();
        if (C.wave == 0) { float t = 0.f;
#pragma unroll
            for (int w = 0; w < 8; ++w) t += red[w * 64 + C.lane];
            ((float*)(ws + WS_CB))[ob] = t; } }
    for (int c = C.bid; c < 256; c += C.G)
        for (int i = 0; i < 32; i += 4) { f32x4 v[4][4]; const float* xb = C.inp(I_X);
#pragma unroll
            for (int r = 0; r < 4; ++r) { const f32x4* xr = (const f32x4*)(xb + (size_t)(c * 256 + C.wave * 32 + i + r) * DM) + C.lane;
#pragma unroll
                for (int j = 0; j < 4; ++j) v[r][j] = xr[64 * j]; }
#pragma unroll
            for (int r = 0; r < 4; ++r) norm_row_store(v[r], (bf16*)(ws + WS_XN) + (size_t)(c * 256 + C.wave * 32 + i + r) * DM, C.lane); }
}

template <bool MOE_ADD, bool ROUTER, bool WRITE_XN, bool XN_FP8 = false>
__device__ __forceinline__ void p_norm(Ctx& C, const float* rw, const float* rgain) {
    unsigned char* ws = C.ws;
    LAS int* cnt8 = (LAS int*)(C.lds + 1024);
    const bf16* Y = (const bf16*)(ws + R_XP);
    const int4* route = (const int4*)(ws + WS_ROUTE); const int2* slot = (const int2*)(ws + WS_SLOT);
    constexpr int NR = (MOE_ADD || ROUTER) ? 2 : 4;
    for (int c = C.bid; c < 256; c += C.G) {
        if (ROUTER) { __syncthreads(); if (C.tid < 8) cnt8[C.tid] = 0; __syncthreads(); }
#pragma unroll 1
        for (int i = 0; i < 32; i += NR) {
            f32x4 v[NR][4];
#pragma unroll
            for (int r = 0; r < NR; ++r) { const float* hr = C.out + (size_t)(c * 256 + C.wave * 32 + i + r) * DM;
#pragma unroll
                for (int j = 0; j < 4; ++j) v[r][j] = __builtin_nontemporal_load((const f32x4*)hr + C.lane + 64 * j); }
            if (MOE_ADD) {
#pragma unroll
                for (int r = 0; r < NR; ++r) { const int row = c * 256 + C.wave * 32 + i + r; float* hr = C.out + (size_t)row * DM;
                    const int4 rt = route[row]; const int2 sl = slot[row]; const float w0 = __builtin_bit_cast(float, rt.y), w1 = __builtin_bit_cast(float, rt.z);
                    const v2u* y0 = (const v2u*)(Y + (size_t)sl.x * DM) + C.lane; const v2u* y1 = (const v2u*)(Y + (size_t)sl.y * DM) + C.lane;
#pragma unroll
                    for (int j = 0; j < 4; ++j) { const v2u a = y0[64 * j], b = y1[64 * j];
                        v[r][j].x += w0 * bflo(a.x) + w1 * bflo(b.x); v[r][j].y += w0 * bfhi(a.x) + w1 * bfhi(b.x); v[r][j].z += w0 * bflo(a.y) + w1 * bflo(b.y); v[r][j].w += w0 * bfhi(a.y) + w1 * bfhi(b.y);
                        ((f32x4*)hr + C.lane)[64 * j] = v[r][j]; } }
            }
            if (WRITE_XN || ROUTER) {
#pragma unroll
                for (int r = 0; r < NR; ++r) { const int row = c * 256 + C.wave * 32 + i + r;
                    float s = 0.f;
#pragma unroll
                    for (int j = 0; j < 4; ++j) s += (v[r][j].x * v[r][j].x + v[r][j].y * v[r][j].y) + (v[r][j].z * v[r][j].z + v[r][j].w * v[r][j].w);
                    const float rstd = rsqrtf(wave_sum(s) * (1.f / DM) + EPS);
                    if (WRITE_XN && XN_FP8) { unsigned* o4 = (unsigned*)(ws + WS_XN + (size_t)row * DM) + C.lane;
#pragma unroll
                        for (int j = 0; j < 4; ++j) o4[64 * j] = pg8::pk4_fp8(v[r][j].x * rstd, v[r][j].y * rstd, v[r][j].z * rstd, v[r][j].w * rstd); }
                    if (WRITE_XN && !XN_FP8) { v2u* o8 = (v2u*)((bf16*)(ws + WS_XN) + (size_t)row * DM) + C.lane;
#pragma unroll
                        for (int j = 0; j < 4; ++j) { v2u w; w.x = pk2(v[r][j].x * rstd, v[r][j].y * rstd); w.y = pk2(v[r][j].z * rstd, v[r][j].w * rstd); o8[64 * j] = w; } }
                    if (ROUTER) {
                        float lg[8];
#pragma unroll
                        for (int e = 0; e < 8; ++e) lg[e] = 0.f;
#pragma unroll
                        for (int j = 0; j < 4; ++j) { const int k0 = 4 * C.lane + 256 * j; const f32x4 g4 = *(const f32x4*)(rgain + k0);
#pragma unroll
                            for (int q = 0; q < 4; ++q) { const float xv = v[r][j][q] * rstd * g4[q]; const f32x4 wa = *(const f32x4*)(rw + (size_t)(k0 + q) * 8), wb = *(const f32x4*)(rw + (size_t)(k0 + q) * 8 + 4);
                                lg[0] += xv * wa.x; lg[1] += xv * wa.y; lg[2] += xv * wa.z; lg[3] += xv * wa.w; lg[4] += xv * wb.x; lg[5] += xv * wb.y; lg[6] += xv * wb.z; lg[7] += xv * wb.w; } }
#pragma unroll
                        for (int e = 0; e < 8; ++e) lg[e] = wave_sum(lg[e]);
                        int e0 = 0; float v0 = lg[0];
#pragma unroll
                        for (int e = 1; e < 8; ++e) if (lg[e] > v0) { v0 = lg[e]; e0 = e; }
                        int e1 = -1; float v1 = -INFINITY;
#pragma unroll
                        for (int e = 0; e < 8; ++e) if (e != e0 && (e1 < 0 || lg[e] > v1)) { v1 = lg[e]; e1 = e; }
                        const float ex = expf(v1 - v0), w0 = 1.f / (1.f + ex), w1 = ex / (1.f + ex);
                        if (C.lane == 0) { ((int4*)(ws + WS_ROUTE))[row] = make_int4(e0 | (e1 << 8), __builtin_bit_cast(int, w0), __builtin_bit_cast(int, w1), 0);
                            atomicAdd((int*)&cnt8[e0], 1); atomicAdd((int*)&cnt8[e1], 1); }
                    }
                }
            }
        }
        if (ROUTER) { __syncthreads(); if (C.tid < 8) ((int*)(ws + WS_RCNT))[c * 8 + C.tid] = cnt8[C.tid]; }
    }
}

__device__ __forceinline__ void p_gather(Ctx& C) {
    unsigned char* ws = C.ws;
    LAS int* tot = (LAS int*)(C.lds + 0);
    LAS int* pre = tot + 8;
    LAS int* base = tot + 16;
    LAS int* ee = tot + 32;
    LAS int* sl = tot + 32 + 256;
    const int* rcnt = (const int*)(ws + WS_RCNT);
    const int4* route = (const int4*)(ws + WS_ROUTE);
    for (int c = C.bid; c < 256; c += C.G) {
        __syncthreads();
        { const int e = C.wave; int t = 0, p = 0;
          for (int i = C.lane; i < 256; i += 64) { const int v = rcnt[i * 8 + e]; t += v; if (i < c) p += v; }
#pragma unroll
          for (int o = 32; o >= 1; o >>= 1) { t += __shfl_xor(t, o); p += __shfl_xor(p, o); }
          if (C.lane == 0) { tot[e] = t; pre[e] = p; } }
        if (C.tid < 256) ee[C.tid] = route[c * 256 + C.tid].x;
        __syncthreads();
        if (C.tid == 0) { int off = 0; for (int e = 0; e < 8; ++e) { base[e] = off + pre[e]; const int nt = (tot[e] + 255) >> 8;
                if (c == 0) { int* te = (int*)(ws + WS_RTAB); for (int q = 0; q < nt; ++q) te[(off >> 8) + q] = e; }
                off += nt << 8; }
            if (c == 0) ((int*)(ws + WS_RTAB))[1024] = off >> 8; }
        __syncthreads();
        if (C.tid < 8) { const int e = C.tid; int r = base[e];
            for (int i = 0; i < 256; ++i) { const int pk = ee[i]; if ((pk & 255) == e) sl[2 * i] = r++; if ((pk >> 8) == e) sl[2 * i + 1] = r++; } }
        __syncthreads();
        if (C.tid < 256) ((int2*)(ws + WS_SLOT))[c * 256 + C.tid] = make_int2(sl[2 * C.tid], sl[2 * C.tid + 1]);
        for (int i = 0; i < 32; i += 4) { v4u a[4];
#pragma unroll
            for (int r = 0; r < 4; ++r) a[r] = *((const v4u*)(ws + WS_XN + (size_t)(c * 256 + C.wave * 32 + i + r) * DM) + C.lane);
#pragma unroll
            for (int r = 0; r < 4; ++r) { const int tl = C.wave * 32 + i + r;
                *((v4u*)(ws + R_XP + (size_t)sl[2 * tl] * DM) + C.lane) = a[r]; *((v4u*)(ws + R_XP + (size_t)sl[2 * tl + 1] * DM) + C.lane) = a[r]; } }
    }
}

__device__ __forceinline__ void p_post_kv(Ctx& C) {
    unsigned char* ws = C.ws;
    const bf16* raw = (const bf16*)(ws + R_QKV);
    const float* kn = C.inp(I_KN);
    LAS unsigned char* tl = C.lds + C.wave * 4608;
    const int l = C.lane, c8 = l & 7, r8 = l >> 3, gw = C.bid * NWAVES + C.wave, NGW = C.G * NWAVES;
    for (int it = gw; it < 128 * 64; it += NGW) {
        const int bg = it >> 6, blk = it & 63, b = bg >> 2, g = bg & 3;
        const bf16* rb = raw + (size_t)(b * SEQ + blk * 32) * 2816 + g * 64 + 8 * c8;
        const size_t dst0 = ((size_t)bg * SEQ + blk * 32) * 64 + 8 * c8;
#pragma unroll
        for (int j = 0; j < 6; ++j) {
            v4u x[4];
#pragma unroll
            for (int i = 0; i < 4; ++i) x[i] = *(const v4u*)(rb + (size_t)(r8 + 8 * i) * 2816 + j * 256);
            if (j == 0 || j == 1) {
                bf16* d = (bf16*)(ws + (j == 0 ? R_KCR : R_VCR)) + dst0;
#pragma unroll
                for (int i = 0; i < 4; ++i) *(v4u*)(d + (size_t)(r8 + 8 * i) * 64) = x[i];
            } else if (j == 2 || j == 4) {
                unsigned char* d = ws + (j == 2 ? R_KS : R_KW) + ((size_t)bg * SEQ + blk * 32) * 64 + (c8 >> 2) * 1024 + (c8 & 3) * 8; const float* gk = kn + (j == 2 ? 64 : 128) + 8 * c8;
                const f32x4 ga = *(const f32x4*)gk, gb = *(const f32x4*)(gk + 4);
#pragma unroll
                for (int i = 0; i < 4; ++i) { const float f[8] = {bflo(x[i].x), bfhi(x[i].x), bflo(x[i].y), bfhi(x[i].y), bflo(x[i].z), bfhi(x[i].z), bflo(x[i].w), bfhi(x[i].w)};
                    float ss = (f[0] * f[0] + f[1] * f[1]) + (f[2] * f[2] + f[3] * f[3]) + (f[4] * f[4] + f[5] * f[5]) + (f[6] * f[6] + f[7] * f[7]);
                    ss += __shfl_xor(ss, 1); ss += __shfl_xor(ss, 2); ss += __shfl_xor(ss, 4);
                    const float rs = rsqrtf(ss * (1.f / 64.f) + EPS);
                    v2u o; o.x = pg8::pk4_fp8(f[0] * rs * ga.x, f[1] * rs * ga.y, f[2] * rs * ga.z, f[3] * rs * ga.w); o.y = pg8::pk4_fp8(f[4] * rs * gb.x, f[5] * rs * gb.y, f[6] * rs * gb.z, f[7] * rs * gb.w);
                    *(v2u*)(d + (size_t)(r8 + 8 * i) * 32) = o; }
            } else {
#pragma unroll
                for (int i = 0; i < 4; ++i) *(LAS v4u*)(tl + (r8 + 8 * i) * 144 + 16 * c8) = x[i];
                LDS_WAIT();
                unsigned wv[8];
#pragma unroll
                for (int t4 = 0; t4 < 8; ++t4) { const float a0 = bf2f(*(const LAS bf16*)(tl + (4 * t4) * 144 + 2 * l)), a1 = bf2f(*(const LAS bf16*)(tl + (4 * t4 + 1) * 144 + 2 * l)),
                                                             a2 = bf2f(*(const LAS bf16*)(tl + (4 * t4 + 2) * 144 + 2 * l)), a3 = bf2f(*(const LAS bf16*)(tl + (4 * t4 + 3) * 144 + 2 * l)); wv[t4] = pg8::pk4_fp8(a0, a1, a2, a3); }
                unsigned char* d = ws + (j == 3 ? R_VST : R_VWT) + (((size_t)bg * 64 + blk) * 64 + l) * 32;
#pragma unroll
                for (int q = 0; q < 2; ++q) { const v4u o = {wv[4 * q], wv[4 * q + 1], wv[4 * q + 2], wv[4 * q + 3]}; *(v4u*)(d + 16 * q) = o; }
                LDS_WAIT();
            }
        }
    }
}

__device__ __forceinline__ void p_cmp2(Ctx& C) {
    unsigned char* ws = C.ws;
    const bf16* Hk = (const bf16*)(ws + WS_HC); const bf16* Hv = Hk + (size_t)16384 * 256;
    const float* w2k = C.inp(I_CW2K); const float* w2v = C.inp(I_CW2V); const float* kn = C.inp(I_KN);
    LAS float* hk = (LAS float*)(C.lds + C.wave * 2048); LAS float* hv = hk + 256;
    const int l = C.lane, gw = C.bid * NWAVES + C.wave, NGW = C.G * NWAVES;
    for (int r = gw; r < 16384; r += NGW) {
        const int bg = r >> 7, c = r & 127;
        { const v2u a = *((const v2u*)(Hk + (size_t)r * 256) + l), bq = *((const v2u*)(Hv + (size_t)r * 256) + l);
          hk[4 * l] = bflo(a.x); hk[4 * l + 1] = bfhi(a.x); hk[4 * l + 2] = bflo(a.y); hk[4 * l + 3] = bfhi(a.y);
          hv[4 * l] = bflo(bq.x); hv[4 * l + 1] = bfhi(bq.x); hv[4 * l + 2] = bflo(bq.y); hv[4 * l + 3] = bfhi(bq.y); }
        LDS_WAIT();
        float ak = 0.f, av = 0.f;
#pragma unroll 8
        for (int j = 0; j < 256; ++j) { ak += hk[j] * w2k[j * 64 + l]; av += hv[j] * w2v[j * 64 + l]; }
        if (c == 127) { ak = 0.f; av = 0.f; }
        const float rs = rsqrtf(wave_sum(ak * ak) * (1.f / 64.f) + EPS);
        ((bf16*)(ws + WS_KC))[((size_t)bg * 128 + 32 * (c >> 5)) * 64 + (l >> 5) * 1024 + (c & 31) * 32 + (l & 31)] = (bf16)f2bf(ak * rs * kn[l]);
        ((bf16*)(ws + WS_VCT))[(((size_t)bg * 4 + (c >> 5)) * 64 + l) * 32 + (c & 31)] = (bf16)f2bf(av);
        LDS_WAIT();
    }
}

typedef short bf16x8v __attribute__((ext_vector_type(8)));
#define MFMA16(a, b, c) __builtin_amdgcn_mfma_f32_16x16x32_bf16((a), (b), (c), 0, 0, 0)
constexpr float LOG2E = 1.4426950408889634f;
__device__ __forceinline__ float xmax_q4(float v) {
    float t;
    asm volatile("v_mov_b32 %1, %0\n\ts_nop 1\n\tv_permlane16_swap_b32 %0, %1\n\ts_nop 1\n\tv_max_f32 %0, %0, %1\n\tv_mov_b32 %1, %0\n\ts_nop 1\n\tv_permlane32_swap_b32 %0, %1\n\ts_nop 1\n\tv_max_f32 %0, %0, %1" : "+v"(v), "=&v"(t));
    return v;
}
__device__ __forceinline__ f32x4 att_mma(bf16x8v a, bf16x8v b, f32x4 c) { return __builtin_amdgcn_mfma_f32_16x16x32_bf16(a, b, c, 0, 0, 0); }
__device__ __forceinline__ f32x4 att_mma(long a, long b, f32x4 c) { return __builtin_amdgcn_mfma_f32_16x16x32_fp8_fp8(a, b, c, 0, 0, 0); }
__device__ __forceinline__ void att_pack(bf16x8v& pf, const float (&p)[8], bool keep) {
    unsigned w0 = pg8::cvt_pk_bf16(p[0], p[1]), w1 = pg8::cvt_pk_bf16(p[2], p[3]), w2 = pg8::cvt_pk_bf16(p[4], p[5]), w3 = pg8::cvt_pk_bf16(p[6], p[7]);
    if (!keep) { w0 = 0u; w1 = 0u; w2 = 0u; w3 = 0u; }
    const v4u w = {w0, w1, w2, w3}; pf = __builtin_bit_cast(bf16x8v, w); }
__device__ __forceinline__ void att_pack(long& pf, const float (&p)[8], bool keep) {
    unsigned w0 = pg8::pk4_fp8(p[0], p[1], p[2], p[3]), w1 = pg8::pk4_fp8(p[4], p[5], p[6], p[7]);
    if (!keep) { w0 = 0u; w1 = 0u; }
    const v2u w = {w0, w1}; pf = __builtin_bit_cast(long, w); }
template <class FR> struct AttKV { FR ka[2], kb[2], vf[4]; };
template <class FR, bool NOPV>
__device__ __forceinline__ void attn_kv_load(AttKV<FR>& f, const void* __restrict__ Kb, unsigned koff, const void* __restrict__ Vb, unsigned voff, int k0) {
    constexpr int SH = sizeof(FR) == 16 ? 0 : 1;
    const char* kblk = (const char*)Kb + (((size_t)k0 * 128) >> SH); const char* vblk = (const char*)Vb + (((size_t)k0 * 128) >> SH);
#pragma unroll
    for (int ks = 0; ks < 2; ++ks) { f.ka[ks] = *(const FR*)(kblk + koff + ((2048 * ks) >> SH)); f.kb[ks] = *(const FR*)(kblk + koff + ((256 + 2048 * ks) >> SH)); }
    if (!NOPV) {
#pragma unroll
        for (int dt = 0; dt < 4; ++dt) f.vf[dt] = *(const FR*)(vblk + voff + ((1024 * dt) >> SH)); }
}
template <int MODE, int PATH, class FR, bool NOPV = false>
__device__ __forceinline__ void attn_step(const AttKV<FR>& f, int k0, int trel, bool tk, int cmax,
                                          const FR (&qf)[2][2], const f32x4 (&bv)[2], float (&m)[2], float (&ls)[2], f32x4 (&o)[2][4], const float (&sl2)[2], int q4) {
    constexpr int DMUL = (MODE == 0) ? 16 : 1;
    const float trelf = (float)trel;
    bool ok[8];
    if (PATH == 2) {
#pragma unroll
        for (int i = 0; i < 8; ++i) { const int kk = 8 * q4 + i; const int d = trel - DMUL * kk; ok[i] = (MODE == 0) ? (k0 + kk <= cmax) : (MODE == 1 ? (tk && d >= 0) : (d >= 0 && d < 512)); } }
#pragma unroll
    for (int h = 0; h < 2; ++h) {
        f32x4 sa = att_mma(f.ka[0], qf[h][0], bv[0] * ((float)DMUL * sl2[h])), sb = att_mma(f.kb[0], qf[h][0], bv[1] * ((float)DMUL * sl2[h])); sa = att_mma(f.ka[1], qf[h][1], sa); sb = att_mma(f.kb[1], qf[h][1], sb);
        float mref = m[h] + sl2[h] * trelf;
        float mx;
        if (PATH == 2) { mx = -1e30f;
#pragma unroll
            for (int i = 0; i < 8; ++i) { const float v = i < 4 ? sa[i] : sb[i - 4]; mx = ok[i] ? fmaxf(mx, v) : mx; } }
        else { mx = fmaxf(fmaxf(fmaxf(sa[0], sa[1]), fmaxf(sa[2], sa[3])), fmaxf(fmaxf(sb[0], sb[1]), fmaxf(sb[2], sb[3]))); if (PATH == 1) mx = tk ? mx : -1e30f; }
        mx = xmax_q4(mx);
        if (__any(mx > mref + 8.f)) { const float mn = fmaxf(mref, mx), alpha = __builtin_amdgcn_exp2f(mref - mn); m[h] = mn - sl2[h] * trelf; mref = mn; ls[h] *= alpha;
            if (!NOPV) {
#pragma unroll
                for (int dt = 0; dt < 4; ++dt) o[h][dt] = o[h][dt] * alpha; } }
        float p[8]; float psum = 0.f;
#pragma unroll
        for (int i = 0; i < 8; ++i) { const float e = __builtin_amdgcn_exp2f((i < 4 ? sa[i] : sb[i - 4]) - mref); p[i] = (PATH == 2) ? (ok[i] ? e : 0.f) : e; psum += p[i]; }
        if (PATH == 1) psum = tk ? psum : 0.f;
        ls[h] += psum;
        FR pf; att_pack(pf, p, PATH == 1 ? tk : true);
        if (!NOPV) {
#pragma unroll
            for (int dt = 0; dt < 4; ++dt) o[h][dt] = att_mma(f.vf[dt], pf, o[h][dt]); }
    }
}
constexpr int PSW = 132;
__device__ __forceinline__ void p_attn_fast(Ctx& C, unsigned* queue, const int ld, const int qo, const float* qn) {
    unsigned char* ws = C.ws;
    const bf16* Qraw = (const bf16*)(ws + R_QKV);
    const bf16* KC = (const bf16*)(ws + WS_KC); const bf16* VCT = (const bf16*)(ws + WS_VCT);
    const unsigned char* KS = ws + R_KS; const unsigned char* VST = ws + R_VST; const unsigned char* KW = ws + R_KW; const unsigned char* VWT = ws + R_VWT;
    bf16* O = (bf16*)(ws + R_O);
    LAS float* psl = (LAS float*)(C.lds + C.wave * (16 * PSW * 4));
    int qsel = (int)(xb_xcc_id() & 7u), qtry = 0;
    for (;;) {
        int l = C.lane; asm volatile("" : "+v"(l));
        const int r16 = l & 15, q4 = l >> 4;
        const unsigned koff = (unsigned)((8 * (r16 >> 2) + (r16 & 3)) * 64 + 16 * q4), voff = (unsigned)((r16 * 32 + 8 * q4) * 2);
        unsigned u = 0; if (l == 0) u = __hip_atomic_fetch_add(queue + 64 * qsel, 1u, __ATOMIC_RELAXED, __HIP_MEMORY_SCOPE_AGENT);
        u = (unsigned)__builtin_amdgcn_readfirstlane((int)u);
        if (u >= 2048u) { if (++qtry >= 8) break; qsel = (qsel + 1) & 7; continue; }
        u = ((u >> 7) * 8 + (unsigned)qsel) * 128 + (u & 127);
        const int bg = (int)(u >> 7), tile = 127 - (int)(u & 127), g = bg & 3, b = bg >> 2, t0 = tile * 16, t = t0 + r16, row = b * SEQ + t;
#define qrow (Qraw + (size_t)row * ld + qo)
#define gtp (qrow + 1024 + g * 12)
#define orow ((unsigned char*)O + (size_t)row * DM + g * 256 + 4 * q4)
        bf16x8v qf[2][2]; long qf8[2][2]; float sl2[2]; f32x4 bv[2]; float m[2]; float ls[2]; f32x4 o[2][4];
#define ATT_LOADQ(hp, DM_) do { _Pragma("unroll") for (int i_ = 0; i_ < 4; ++i_) { bv[0][i_] = (float)(8 * q4 + i_); bv[1][i_] = (float)(8 * q4 + 4 + i_); } \
            _Pragma("unroll") for (int h = 0; h < 2; ++h) { sl2[h] = exp2f(-0.5f * (float)(g * 4 + 2 * (hp) + h + 1)) * LOG2E; \
            float xq_[2][8]; float ssq_ = 0.f; \
            _Pragma("unroll") for (int ks = 0; ks < 2; ++ks) { const v4u r_ = *(const v4u*)(qrow + (g * 4 + 2 * (hp) + h) * 64 + 32 * ks + 8 * q4); \
                xq_[ks][0] = bflo(r_.x); xq_[ks][1] = bfhi(r_.x); xq_[ks][2] = bflo(r_.y); xq_[ks][3] = bfhi(r_.y); xq_[ks][4] = bflo(r_.z); xq_[ks][5] = bfhi(r_.z); xq_[ks][6] = bflo(r_.w); xq_[ks][7] = bfhi(r_.w); \
                _Pragma("unroll") for (int j_ = 0; j_ < 8; ++j_) ssq_ += xq_[ks][j_] * xq_[ks][j_]; } \
            ssq_ += __shfl_xor(ssq_, 16); ssq_ += __shfl_xor(ssq_, 32); \
            const float rq_ = rsqrtf(ssq_ * (1.f / 64.f) + EPS) * (0.125f * LOG2E); \
            _Pragma("unroll") for (int ks = 0; ks < 2; ++ks) { const f32x4 ga_ = *(const f32x4*)(qn + 32 * ks + 8 * q4), gb_ = *(const f32x4*)(qn + 32 * ks + 8 * q4 + 4); \
                const v4u w_ = {pg8::cvt_pk_bf16(xq_[ks][0] * rq_ * ga_.x, xq_[ks][1] * rq_ * ga_.y), pg8::cvt_pk_bf16(xq_[ks][2] * rq_ * ga_.z, xq_[ks][3] * rq_ * ga_.w), \
                                pg8::cvt_pk_bf16(xq_[ks][4] * rq_ * gb_.x, xq_[ks][5] * rq_ * gb_.y), pg8::cvt_pk_bf16(xq_[ks][6] * rq_ * gb_.z, xq_[ks][7] * rq_ * gb_.w)}; \
                qf[h][ks] = __builtin_bit_cast(bf16x8v, w_); \
                const v2u w8_ = {pg8::pk4_fp8(xq_[ks][0] * rq_ * ga_.x, xq_[ks][1] * rq_ * ga_.y, xq_[ks][2] * rq_ * ga_.z, xq_[ks][3] * rq_ * ga_.w), pg8::pk4_fp8(xq_[ks][4] * rq_ * gb_.x, xq_[ks][5] * rq_ * gb_.y, xq_[ks][6] * rq_ * gb_.z, xq_[ks][7] * rq_ * gb_.w)}; \
                qf8[h][ks] = __builtin_bit_cast(long, w8_); } } } while (0)
#define ATT_RESET() do { _Pragma("unroll") for (int h = 0; h < 2; ++h) { m[h] = -1e30f; ls[h] = 0.f; _Pragma("unroll") for (int dt = 0; dt < 4; ++dt) o[h][dt] = (f32x4){0.f, 0.f, 0.f, 0.f}; } } while (0)
        const int cmax = t >= 31 ? (((t - 31) >> 4) < 126 ? ((t - 31) >> 4) : 126) : -1;
        const int cmax0 = t0 >= 31 ? (((t0 - 31) >> 4) < 126 ? ((t0 - 31) >> 4) : 126) : -1;
        const bf16* KCb = KC + (size_t)bg * 128 * 64; const bf16* VCb = VCT + (size_t)bg * 128 * 64;
        const int ncs = ((t0 + 15 - 31) >> 4) < 0 ? 0 : ((((t0 + 15 - 31) >> 4) < 126 ? ((t0 + 15 - 31) >> 4) : 126) >> 5) + 1;
#pragma unroll 1
        for (int hp = 0; hp < 2; ++hp) {
            ATT_LOADQ(hp, 16); ATT_RESET();
            for (int st = ncs - 1; st >= 0; --st) {
                AttKV<bf16x8v> fc; attn_kv_load<bf16x8v, true>(fc, KCb, koff, VCb, voff, 32 * st);
                if (32 * st + 31 <= cmax0) attn_step<0, 0, bf16x8v, true>(fc, 32 * st, t - 31 - 16 * 32 * st, true, cmax, qf, bv, m, ls, o, sl2, q4);
                else attn_step<0, 2, bf16x8v, true>(fc, 32 * st, t - 31 - 16 * 32 * st, true, cmax, qf, bv, m, ls, o, sl2, q4); }
#pragma unroll
            for (int h = 0; h < 2; ++h) { float lt = ls[h]; lt += __shfl_xor(lt, 16); lt += __shfl_xor(lt, 32); ls[h] = lt; }
            float ps[4][8];
#pragma unroll
            for (int st = 0; st < 4; ++st)
#pragma unroll
                for (int i = 0; i < 8; ++i) ps[st][i] = 0.f;
#pragma unroll
            for (int st = 0; st < 4; ++st) {
                if (st < ncs) {
                    const int k0 = 32 * st; const char* kblk = (const char*)(KCb + (size_t)k0 * 64);
                    bf16x8v ka[2], kb[2];
#pragma unroll
                    for (int ks = 0; ks < 2; ++ks) { ka[ks] = *(const bf16x8v*)(kblk + koff + 2048 * ks); kb[ks] = *(const bf16x8v*)(kblk + koff + 256 + 2048 * ks); }
#pragma unroll
                    for (int h = 0; h < 2; ++h) {
                        f32x4 sa = MFMA16(ka[0], qf[h][0], bv[0] * (16.f * sl2[h])), sb = MFMA16(kb[0], qf[h][0], bv[1] * (16.f * sl2[h])); sa = MFMA16(ka[1], qf[h][1], sa); sb = MFMA16(kb[1], qf[h][1], sb);
                        const float lt = ls[h], inv = lt > 0.f ? 1.f / lt : 0.f, mref = m[h] + sl2[h] * (float)(t - 31 - 16 * k0);
#pragma unroll
                        for (int i = 0; i < 8; ++i) { const int c = k0 + 8 * q4 + i; ps[st][i] += (c <= cmax) ? __builtin_amdgcn_exp2f((i < 4 ? sa[i] : sb[i - 4]) - mref) * inv : 0.f; }
                    }
                }
            }
#pragma unroll
            for (int st = 0; st < 4; ++st) { LAS f32x4* p0 = (LAS f32x4*)(psl + r16 * PSW + 32 * st + 8 * q4);
                f32x4 a = {ps[st][0], ps[st][1], ps[st][2], ps[st][3]}, bq = {ps[st][4], ps[st][5], ps[st][6], ps[st][7]};
                if (hp) { a = a + p0[0]; bq = bq + p0[1]; }
                p0[0] = a; p0[1] = bq; }
            LDS_WAIT();
        }
        unsigned mlo, mhi;
        {
            float sc[16]; const LAS float* pr = psl + r16 * PSW + 32 * q4; const int cur = t >> 5;
            float prev = q4 > 0 ? pr[-1] : 0.f;
#pragma unroll
            for (int jj = 0; jj < 16; ++jj) { const float a = pr[2 * jj], bq = pr[2 * jj + 1]; const float imp = prev + a + bq; prev = bq;
                const int j = 16 * q4 + jj; const bool valid = 32 * j <= t; const bool forced = valid && (j == 0 || j == cur || j == cur - 1);
                sc[jj] = forced ? 1e9f : (valid ? imp : -1e9f); }
            unsigned my = 0u;
#pragma unroll 1
            for (int r = 0; r < 8; ++r) {
                float best = sc[0]; int bi = 0;
#pragma unroll
                for (int jj = 1; jj < 16; ++jj) if (sc[jj] > best) { best = sc[jj]; bi = jj; }
                bi += 16 * q4;
#pragma unroll
                for (int sh = 16; sh <= 32; sh <<= 1) { const float ov = __shfl_xor(best, sh); const int oi = __shfl_xor(bi, sh); if (ov > best || (ov == best && oi < bi)) { best = ov; bi = oi; } }
                if ((bi >> 4) == q4) { const int jj0 = bi & 15; if (best > -0.5e9f) my |= 1u << jj0;
#pragma unroll
                    for (int jj = 0; jj < 16; ++jj) if (jj == jj0) sc[jj] = -INFINITY; }
            }
            mlo = (q4 == 0 ? my : 0u) | (q4 == 1 ? my << 16 : 0u); mhi = (q4 == 2 ? my : 0u) | (q4 == 3 ? my << 16 : 0u);
            mlo |= __shfl_xor(mlo, 16); mlo |= __shfl_xor(mlo, 32); mhi |= __shfl_xor(mhi, 16); mhi |= __shfl_xor(mhi, 32);
        }
        LDS_WAIT();
        unsigned ulo = mlo, uhi = mhi;
#pragma unroll
        for (int sh = 1; sh <= 8; sh <<= 1) { ulo |= __shfl_xor(ulo, sh); uhi |= __shfl_xor(uhi, sh); }
        const unsigned long long un0 = ((unsigned long long)(unsigned)__builtin_amdgcn_readfirstlane((int)uhi) << 32) | (unsigned)__builtin_amdgcn_readfirstlane((int)ulo);
        const unsigned long long mine = ((unsigned long long)mhi << 32) | mlo;
#pragma unroll 1
        for (int hp = 0; hp < 2; ++hp) {
            const v2u g6raw = *(const v2u*)(gtp + 6 * hp); const unsigned g6x = gtp[6 * hp + 4], g6y = gtp[6 * hp + 5];
            v2u oacc[2][4];
#define ATT_GLOG(i) ((i) == 0 ? bflo(g6raw.x) : (i) == 1 ? bfhi(g6raw.x) : (i) == 2 ? bflo(g6raw.y) : (i) == 3 ? bfhi(g6raw.y) : (i) == 4 ? bf2f(g6x) : bf2f(g6y))
#define ATT_FOLD(br, first) do { _Pragma("unroll") for (int h = 0; h < 2; ++h) { float lt = ls[h]; lt += __shfl_xor(lt, 16); lt += __shfl_xor(lt, 32); const float sc_ = lt > 0.f ? (1.f / (1.f + __expf(-ATT_GLOG(h * 3 + (br))))) / lt : 0.f; \
            _Pragma("unroll") for (int dt = 0; dt < 4; ++dt) { f32x4 r_ = o[h][dt] * sc_; \
                if (!(first)) { r_[0] += bflo(oacc[h][dt].x); r_[1] += bfhi(oacc[h][dt].x); r_[2] += bflo(oacc[h][dt].y); r_[3] += bfhi(oacc[h][dt].y); } \
                oacc[h][dt].x = pg8::cvt_pk_bf16(r_[0], r_[1]); oacc[h][dt].y = pg8::cvt_pk_bf16(r_[2], r_[3]); } } } while (0)
            ATT_LOADQ(hp, 16); ATT_RESET();
            for (int st = ncs - 1; st >= 0; --st) {
                AttKV<bf16x8v> fc; attn_kv_load<bf16x8v, false>(fc, KCb, koff, VCb, voff, 32 * st);
                if (32 * st + 31 <= cmax0) attn_step<0, 0, bf16x8v>(fc, 32 * st, t - 31 - 16 * 32 * st, true, cmax, qf, bv, m, ls, o, sl2, q4);
                else attn_step<0, 2, bf16x8v>(fc, 32 * st, t - 31 - 16 * 32 * st, true, cmax, qf, bv, m, ls, o, sl2, q4); }
            ATT_FOLD(0, true);
            {
                const unsigned char* Kb = KS + (size_t)bg * SEQ * 64; const unsigned char* Vb = VST + (size_t)bg * SEQ * 64;
                ATT_RESET();
                unsigned long long un = un0;
                const int cur0 = t0 >> 5;
                AttKV<long> fn; int jn = 63 - __builtin_clzll(un); un &= ~(1ull << jn); attn_kv_load<long, false>(fn, Kb, koff >> 1, Vb, voff >> 1, 32 * jn);
#pragma unroll 1
                for (;;) { const int j = jn; const AttKV<long> fc = fn; const bool more = un != 0ull;
                    if (more) { jn = 63 - __builtin_clzll(un); un &= ~(1ull << jn); }
                    attn_kv_load<long, false>(fn, Kb, koff >> 1, Vb, voff >> 1, 32 * jn);
                    const bool tk = ((mine >> j) & 1ull) != 0ull;
                    if (j >= cur0) attn_step<1, 2, long>(fc, 32 * j, t - 32 * j, tk, 0, qf8, bv, m, ls, o, sl2, q4);
                    else if (__all(tk)) attn_step<1, 0, long>(fc, 32 * j, t - 32 * j, true, 0, qf8, bv, m, ls, o, sl2, q4);
                    else attn_step<1, 1, long>(fc, 32 * j, t - 32 * j, tk, 0, qf8, bv, m, ls, o, sl2, q4);
                    if (!more) break; }
                ATT_FOLD(1, false);
            }
            {
                const unsigned char* Kb = KW + (size_t)bg * SEQ * 64; const unsigned char* Vb = VWT + (size_t)bg * SEQ * 64;
                const int sb = t0 >= 511 ? (t0 - 511) >> 5 : 0, se = t0 >> 5;
                ATT_RESET();
                AttKV<long> fn; attn_kv_load<long, false>(fn, Kb, koff >> 1, Vb, voff >> 1, 32 * se);
#pragma unroll 1
                for (int st = se; st >= sb; --st) { const AttKV<long> fc = fn;
                    attn_kv_load<long, false>(fn, Kb, koff >> 1, Vb, voff >> 1, 32 * (st > sb ? st - 1 : st));
                    if (32 * st + 31 <= t0 && 32 * st > t0 - 497) attn_step<2, 0, long>(fc, 32 * st, t - 32 * st, true, 0, qf8, bv, m, ls, o, sl2, q4);
                    else attn_step<2, 2, long>(fc, 32 * st, t - 32 * st, true, 0, qf8, bv, m, ls, o, sl2, q4); }
                ATT_FOLD(2, false);
            }
#pragma unroll
            for (int h = 0; h < 2; ++h)
#pragma unroll
                for (int dt = 0; dt < 4; ++dt) *(unsigned*)(orow + (2 * hp + h) * 64 + 16 * dt) = pg8::pk4_fp8(16.f * bflo(oacc[h][dt].x), 16.f * bfhi(oacc[h][dt].x), 16.f * bflo(oacc[h][dt].y), 16.f * bfhi(oacc[h][dt].y));
        }
#undef ATT_FOLD
#undef ATT_GLOG
#undef ATT_LOADQ
#undef ATT_RESET
#undef qrow
#undef gtp
#undef orow
    }
}

constexpr int SCQ = 272, SCT = 144;
constexpr int LQ_ = 0, LK_ = 17408, LKT_ = 34816, LVT_ = 53248, LP_ = 71680, LO_ = 80896, LE_ = 114688, LT_ = 115712;
#define SC_BAR() do { asm volatile("s_waitcnt lgkmcnt(0)" ::: "memory"); __builtin_amdgcn_s_barrier(); asm volatile("" ::: "memory"); } while (0)
__device__ __forceinline__ void p_scan_fast(Ctx& C, int layer) {
    unsigned char* ws = C.ws;
    const bf16* Pq = (const bf16*)(ws + R_PQ); const bf16* Pi = (const bf16*)(ws + R_PI); const bf16* Pg = (const bf16*)(ws + R_PG); const float* LF = (const float*)(ws + R_LF);
    bf16* O2 = (bf16*)(ws + R_O2);
    const float* gn = C.inp(I_HGN) + layer * 128;
    LAS unsigned char* L = C.lds;
    const int tid = C.tid, lane = C.lane, w = C.wave, r16 = lane & 15, q4 = lane >> 4, k = tid & 127, seg = tid >> 7;
    LAS float* tot = (LAS float*)(L + LT_); LAS float* eref = (LAS float*)(L + LE_); LAS float* elr = eref + 128;
    { const int tile = tid >> 8, e = tid & 255, row = e >> 4, col = e & 15;
      *(LAS bf16*)(L + LP_ + ((tile ? 32 : 0) + row) * SCT + ((tile ? 48 : 16) + col) * 2) = 0; }
    for (int bh = C.bid; bh < 256; bh += C.G) {
        const int b = bh >> 3, h = bh & 7;
        const size_t base = (size_t)(b * SEQ) * DM + h * 128;
        f32x4 S[8];
#pragma unroll
        for (int i = 0; i < 8; ++i) S[i] = (f32x4){0.f, 0.f, 0.f, 0.f};
        bf16 qv[16], vv[16]; float lf[16];
#define SC_LOAD(t0) do { _Pragma("unroll") for (int i = 0; i < 16; ++i) { const size_t off = base + (size_t)((t0) + 16 * seg + i) * DM + k; qv[i] = Pq[off]; vv[i] = Pi[off]; lf[i] = LF[off]; } } while (0)
        SC_LOAD(0);
#pragma unroll 1
        for (int c = 0; c < SEQ / 64; ++c) {
            const int t0 = c * 64;
            float cs[16]; { float run = 0.f;
#pragma unroll
                for (int i = 0; i < 16; ++i) { run += lf[i]; cs[i] = run; }
                tot[seg * 128 + k] = run; }
            SC_BAR();
            { const float a0 = tot[k], a1 = tot[128 + k], a2 = tot[256 + k], a3 = tot[384 + k];
              const float off = seg == 0 ? 0.f : (seg == 1 ? a0 : (seg == 2 ? a0 + a1 : a0 + a1 + a2)), ref = a0 + a1, last = ref + a2 + a3;
              unsigned kt[16];
#pragma unroll
              for (int i = 0; i < 16; ++i) { const float d = off + cs[i] - ref; const float qt = bf2f(qv[i]) * __expf(fminf(d, 80.f)), ktv = (1.f - __expf(lf[i])) * __expf(fminf(-d, 80.f));
                  const int s = 16 * seg + i; kt[i] = f2bf(ktv);
                  *(LAS bf16*)(L + LQ_ + s * SCQ + k * 2) = (bf16)f2bf(qt); *(LAS bf16*)(L + LK_ + s * SCQ + k * 2) = (bf16)kt[i]; }
              v4u w0, w1, x0, x1;
              w0.x = kt[0] | (kt[1] << 16); w0.y = kt[2] | (kt[3] << 16); w0.z = kt[4] | (kt[5] << 16); w0.w = kt[6] | (kt[7] << 16);
              w1.x = kt[8] | (kt[9] << 16); w1.y = kt[10] | (kt[11] << 16); w1.z = kt[12] | (kt[13] << 16); w1.w = kt[14] | (kt[15] << 16);
              x0.x = vv[0] | ((unsigned)vv[1] << 16); x0.y = vv[2] | ((unsigned)vv[3] << 16); x0.z = vv[4] | ((unsigned)vv[5] << 16); x0.w = vv[6] | ((unsigned)vv[7] << 16);
              x1.x = vv[8] | ((unsigned)vv[9] << 16); x1.y = vv[10] | ((unsigned)vv[11] << 16); x1.z = vv[12] | ((unsigned)vv[13] << 16); x1.w = vv[14] | ((unsigned)vv[15] << 16);
              *(LAS v4u*)(L + LKT_ + k * SCT + seg * 32) = w0; *(LAS v4u*)(L + LKT_ + k * SCT + seg * 32 + 16) = w1;
              *(LAS v4u*)(L + LVT_ + k * SCT + seg * 32) = x0; *(LAS v4u*)(L + LVT_ + k * SCT + seg * 32 + 16) = x1;
              if (seg == 0) { eref[k] = __expf(ref); elr[k] = __expf(last - ref); } }
            SC_BAR();
            if (c + 1 < SEQ / 64) SC_LOAD(t0 + 64);
            v4u g8p[2];
#pragma unroll
            for (int rep = 0; rep < 2; ++rep) g8p[rep] = *(const v4u*)(Pg + base + (size_t)(t0 + (tid >> 4) + 32 * rep) * DM + (tid & 15) * 8);
#pragma unroll 1
            for (int ti = w; ti < 10; ti += 8) {
                const int rt = ti < 1 ? 0 : (ti < 3 ? 1 : (ti < 6 ? 2 : 3)), ct = ti - (rt * (rt + 1)) / 2;
                f32x4 acc = {0.f, 0.f, 0.f, 0.f};
#pragma unroll
                for (int p = 0; p < 4; ++p) { const bf16x8v a = *(const LAS bf16x8v*)(L + LQ_ + (16 * rt + r16) * SCQ + (32 * p + 8 * q4) * 2), bq = *(const LAS bf16x8v*)(L + LK_ + (16 * ct + r16) * SCQ + (32 * p + 8 * q4) * 2);
                    acc = MFMA16(a, bq, acc); }
#pragma unroll
                for (int i = 0; i < 4; ++i) { const int t = 16 * rt + 4 * q4 + i, s = 16 * ct + r16; *(LAS bf16*)(L + LP_ + t * SCT + s * 2) = (bf16)f2bf(s <= t ? acc[i] : 0.f); }
            }
            SC_BAR();
            bf16x8v sfrag[4]; f32x4 e8[4][2];
#pragma unroll
            for (int p = 0; p < 4; ++p) { e8[p][0] = *(const LAS f32x4*)(eref + 32 * p + 8 * q4); e8[p][1] = *(const LAS f32x4*)(eref + 32 * p + 8 * q4 + 4);
                S[2 * p] = S[2 * p] * e8[p][0]; S[2 * p + 1] = S[2 * p + 1] * e8[p][1];
                const v4u wv = {pg8::cvt_pk_bf16(S[2 * p][0], S[2 * p][1]), pg8::cvt_pk_bf16(S[2 * p][2], S[2 * p][3]), pg8::cvt_pk_bf16(S[2 * p + 1][0], S[2 * p + 1][1]), pg8::cvt_pk_bf16(S[2 * p + 1][2], S[2 * p + 1][3])};
                sfrag[p] = __builtin_bit_cast(bf16x8v, wv); }
            bf16x8v vfr[2];
#pragma unroll
            for (int ss = 0; ss < 2; ++ss) vfr[ss] = *(const LAS bf16x8v*)(L + LVT_ + (16 * w + r16) * SCT + (32 * ss + 8 * q4) * 2);
#pragma unroll
            for (int rt = 0; rt < 4; ++rt) { f32x4 o = {0.f, 0.f, 0.f, 0.f};
#pragma unroll
                for (int p = 0; p < 4; ++p) { const bf16x8v a = *(const LAS bf16x8v*)(L + LQ_ + (16 * rt + r16) * SCQ + (32 * p + 8 * q4) * 2); o = MFMA16(a, sfrag[p], o); }
#pragma unroll
                for (int ss = 0; ss < 2; ++ss) if (ss <= rt / 2) { const bf16x8v a = *(const LAS bf16x8v*)(L + LP_ + (16 * rt + r16) * SCT + (32 * ss + 8 * q4) * 2); o = MFMA16(a, vfr[ss], o); }
#pragma unroll
                for (int i = 0; i < 4; ++i) *(LAS float*)(L + LO_ + (16 * rt + 4 * q4 + i) * 528 + (16 * w + r16) * 4) = o[i]; }
#pragma unroll
            for (int p = 0; p < 4; ++p)
#pragma unroll
                for (int ab = 0; ab < 2; ++ab) { const int krow = 32 * p + 8 * (r16 >> 2) + (r16 & 3) + 4 * ab;
#pragma unroll
                    for (int ss = 0; ss < 2; ++ss) { const bf16x8v a = *(const LAS bf16x8v*)(L + LKT_ + krow * SCT + (32 * ss + 8 * q4) * 2); S[2 * p + ab] = MFMA16(a, vfr[ss], S[2 * p + ab]); } }
#pragma unroll
            for (int p = 0; p < 4; ++p) { const f32x4 l0 = *(const LAS f32x4*)(elr + 32 * p + 8 * q4), l1 = *(const LAS f32x4*)(elr + 32 * p + 8 * q4 + 4); S[2 * p] = S[2 * p] * l0; S[2 * p + 1] = S[2 * p + 1] * l1; }
            SC_BAR();
#pragma unroll
            for (int rep = 0; rep < 2; ++rep) { const int tok = (tid >> 4) + 32 * rep, part = tid & 15;
                const f32x4 oa = *(const LAS f32x4*)(L + LO_ + tok * 528 + part * 32), ob = *(const LAS f32x4*)(L + LO_ + tok * 528 + part * 32 + 16);
                float ss = (oa.x * oa.x + oa.y * oa.y) + (oa.z * oa.z + oa.w * oa.w) + (ob.x * ob.x + ob.y * ob.y) + (ob.z * ob.z + ob.w * ob.w);
                ss += __shfl_xor(ss, 1); ss += __shfl_xor(ss, 2); ss += __shfl_xor(ss, 4); ss += __shfl_xor(ss, 8);
                const float rstd = rsqrtf(ss * (1.f / 128.f) + EPS);
                const size_t off = base + (size_t)(t0 + tok) * DM + part * 8; const v4u g8 = g8p[rep];
                const f32x4 ga = *(const f32x4*)(gn + part * 8), gb = *(const f32x4*)(gn + part * 8 + 4);
                v4u wv; wv.x = pk2(oa.x * rstd * ga.x * bflo(g8.x), oa.y * rstd * ga.y * bfhi(g8.x)); wv.y = pk2(oa.z * rstd * ga.z * bflo(g8.y), oa.w * rstd * ga.w * bfhi(g8.y));
                wv.z = pk2(ob.x * rstd * gb.x * bflo(g8.z), ob.y * rstd * gb.y * bfhi(g8.z)); wv.w = pk2(ob.z * rstd * gb.z * bflo(g8.w), ob.w * rstd * gb.w * bfhi(g8.w));
                *(v4u*)(O2 + off) = wv; }
        }
#undef SC_LOAD
        __syncthreads();
    }
}

#undef SC_BAR
#define PH_BEGIN { const bool run_ = (pid >= lo && pid < hi); ++pid; if (run_) { { int ln_; asm volatile("v_mbcnt_lo_u32_b32 %0, -1, 0\n\tv_mbcnt_hi_u32_b32 %0, -1, %0" : "=v"(ln_)); C.lane = ln_; C.tid = C.wave * 64 + ln_; }
#define PH_END   if (pid < hi) xcd_barrier(bar); } }
#define XN ((const bf16*)(ws + WS_XN))
#define RTAB ((const int*)(ws + WS_RTAB))

template <int L>
__device__ __forceinline__ void run_layer(Ctx& C, const XcdBarrier& bar, int& pid, const int lo, const int hi, PG8_LAS unsigned char* ring) {
    unsigned char* const ws = C.ws;

        const int li = L >> 1;
        if (L < 2) {
            PH_BEGIN { pg8::Gemm g{XN, (const bf16*)(ws + W_HIN) + (size_t)L * 4096 * 1024, 1024, 1024, 0}; pg8::GenOrder S; S.init(256, 16, C.G, C.bid, nullptr);
                pg8::EpiHgrnIn E{ws, L};
                pg8::gemm_phase<pg8::EpiHgrnIn, pg8::GenOrder, true, true>(ring, g, S, E, C.wave); } PH_END
            PH_BEGIN p_scan_fast(C, L); PH_END
        } else {
            PH_BEGIN { const bool first = (L == 2); pg8::Gemm g{XN, (const bf16*)(ws + (first ? W_KVQ : W_Q3)), 512, 512, 0}; pg8::GenOrder S; S.init(256, first ? 11 : 5, C.G, C.bid, nullptr);
                pg8::EpiBf16 E{(bf16*)(ws + R_QKV), first ? 2816 : 1280, nullptr, 0, 0, 1.f / pg8::FP8_SW1};
                pg8::gemm_phase<pg8::EpiBf16, pg8::GenOrder, true, true, true>(ring, g, S, E, C.wave); } PH_END
            if (L == 2) {
                PH_BEGIN p_post_kv(C); PH_END
                PH_BEGIN { pg8::Gemm g{(const bf16*)(ws + R_KCR), (const bf16*)(ws + W_CMP1), 2048, 1024, (size_t)256 * 2048 * 2}; pg8::GenOrder S; S.init(128, 1, C.G, C.bid, RTAB + 2048);
                    pg8::EpiBf16 E{(bf16*)(ws + WS_HC), 256, (const float*)(ws + WS_CB), 1, 256, 1.f};
                    pg8::gemm_phase<pg8::EpiBf16, pg8::GenOrder, true, true>(ring, g, S, E, C.wave); } PH_END
                PH_BEGIN p_cmp2(C); PH_END
            }
            PH_BEGIN p_attn_fast(C, (unsigned*)(ws + WS_CTL) + 8192 + 2048 * (L - 2), L == 2 ? 2816 : 1280, L == 2 ? 1536 : 0, C.inp(I_NQN) + (L - 2) * 64); PH_END
        }
        PH_BEGIN { pg8::GenOrder S; S.init(256, 4, C.G, C.bid, nullptr);
            if (L < 2) { pg8::Gemm g{(const bf16*)(ws + R_O2), (const bf16*)(ws + W_HOUT) + (size_t)(L & 1) * 1024 * 1024, 1024, 1024, 0};
                pg8::EpiRes E{L == 0 ? C.inp(I_X) : C.out, C.out, 1024, 1.f};
                pg8::gemm_phase<pg8::EpiRes, pg8::GenOrder, true, true>(ring, g, S, E, C.wave); }
            else { pg8::Gemm g{(const bf16*)(ws + R_O), (const bf16*)(ws + W_NOUT + (size_t)(L & 1) * 1024 * 1024 * 2), 512, 512, 0};
                pg8::EpiRes E{C.out, C.out, 1024, 1.f / (16.f * pg8::FP8_SW1)};
                pg8::gemm_phase<pg8::EpiRes, pg8::GenOrder, true, true, true>(ring, g, S, E, C.wave); } } PH_END
        PH_BEGIN { if (L & 1) p_norm<false, true, true, true>(C, C.inp(I_MR) + (size_t)li * 1024 * 8, C.inp(I_NFFN) + L * 1024); else if (L == 2) p_norm<false, false, true, true>(C, nullptr, nullptr); else p_norm<false, false, true, false>(C, nullptr, nullptr); } PH_END
        if (L & 1) { PH_BEGIN p_gather(C); PH_END }
        if (L == 0) {
            PH_BEGIN { pg8::Gemm g{XN, (const bf16*)(ws + W_FGU), 1024, 1024, 0};
                pg8::GenOrder S; S.init(256, 22, C.G, C.bid, nullptr);
                pg8::EpiSwiGLU E{(bf16*)(ws + R_HF), DFF};
                pg8::gemm_phase<pg8::EpiSwiGLU, pg8::GenOrder, true, true>(ring, g, S, E, C.wave); } PH_END
            PH_BEGIN { pg8::Gemm g{(const bf16*)(ws + R_HF), (const bf16*)(ws + W_FDN), DFF, DFF, 0}; pg8::GenOrder S; S.init(256, 4, C.G, C.bid, nullptr);
                pg8::EpiRes E{C.out, C.out, 1024, 1.f};
                pg8::gemm_phase<pg8::EpiRes, pg8::GenOrder, true, true>(ring, g, S, E, C.wave); } PH_END
            PH_BEGIN p_norm<false, false, true>(C, nullptr, nullptr); PH_END
        } else {
        PH_BEGIN { const bool moe = (L & 1) != 0;
            pg8::Gemm g{(const bf16*)(ws + (moe ? R_XP : WS_XN)), (const bf16*)(ws + (moe ? W_MGU + (size_t)li * 8 * 2 * DFE * 1024 : W_FGU + (size_t)li * 2 * DFF * 2048)), 512, 512, moe ? (size_t)2 * DFE * 1024 : 0};
            pg8::GenOrder S; S.init(moe ? RTAB[1024] : 256, moe ? 28 : 22, C.G, C.bid, moe ? RTAB : nullptr);
            pg8::EpiSwiGLU8 E{ws + (moe ? R_HM : R_HF), moe ? DFE : DFF};
            pg8::gemm_phase<pg8::EpiSwiGLU8, pg8::GenOrder, true, true, true>(ring, g, S, E, C.wave); } PH_END
        if (!(L & 1)) {
            PH_BEGIN { pg8::Gemm g{(const bf16*)(ws + R_HF), (const bf16*)(ws + W_FDN + (size_t)li * 1024 * DFF * 2), DFF / 2, DFF / 2, 0}; pg8::GenOrder S; S.init(256, 4, C.G, C.bid, nullptr);
                pg8::EpiRes E{C.out, C.out, 1024, 1.f / (pg8::FP8_SH * pg8::FP8_SW2)};
                pg8::gemm_phase<pg8::EpiRes, pg8::GenOrder, true, true, true>(ring, g, S, E, C.wave); } PH_END
            PH_BEGIN p_norm<false, false, true, true>(C, nullptr, nullptr); PH_END
        } else {
            PH_BEGIN { pg8::Gemm g{(const bf16*)(ws + R_HM), (const bf16*)(ws + W_MDN + (size_t)li * 8 * 1024 * DFE), DFE / 2, DFE / 2, (size_t)1024 * DFE}; pg8::GenOrder S; S.init(RTAB[1024], 4, C.G, C.bid, RTAB);
                pg8::EpiBf16 E{(bf16*)(ws + R_XP), 1024, nullptr, 0, 0, 1.f / (pg8::FP8_SH * pg8::FP8_SW2)};
                pg8::gemm_phase<pg8::EpiBf16, pg8::GenOrder, true, true, true>(ring, g, S, E, C.wave); } PH_END
            PH_BEGIN { if (L == 1) p_norm<true, false, true, true>(C, nullptr, nullptr); else p_norm<true, false, false>(C, nullptr, nullptr); } PH_END
        }
        }
    }

struct Args { const float* in[24]; float* out; unsigned char* ws; int ph_lo, ph_hi; };
constexpr int N_PHASES = 34;

__global__ void __launch_bounds__(NWAVES * 64, 2) yoco_fwd(Args args) {
    extern __shared__ __attribute__((aligned(16))) unsigned char lds_raw[];
    Ctx C;
    C.lds = (LAS unsigned char*)lds_raw;
    C.wave = __builtin_amdgcn_readfirstlane((int)(threadIdx.x >> 6)); C.tid = threadIdx.x; C.lane = C.tid & 63;
    C.G = gridDim.x; C.bid = blockIdx.x;
    C.out = args.out; C.ws = args.ws;
    unsigned char* const ws = args.ws;
    volatile LAS unsigned* MISC = (volatile LAS unsigned*)(C.lds + MISC_OFF);
    if (C.tid < 32) MISC[C.tid] = 0u;
    __syncthreads();
    XcdBarrier bar = xcd_barrier_post((unsigned*)(ws + WS_CTL) + 4096, MISC + 8);
    const int lo = args.ph_lo, hi = args.ph_hi;
    int pid = 0;
    PG8_LAS unsigned char* ring = (PG8_LAS unsigned char*)lds_raw;
    PH_BEGIN p_prologue(C); PH_END

    run_layer<0>(C, bar, pid, lo, hi, ring); run_layer<1>(C, bar, pid, lo, hi, ring); run_layer<2>(C, bar, pid, lo, hi, ring); run_layer<3>(C, bar, pid, lo, hi, ring);
#undef PH_BEGIN
#undef PH_END
#undef XN
#undef RTAB
}

extern "C" void kernel_launch(void* const* d_in, const int* in_sizes, int n_in, void* d_out, int out_size, void* d_ws, size_t ws_size, hipStream_t stream) {
    static int grid = 0;
    if (grid == 0) {
        if (n_in != 24 || in_sizes[0] != NT * DM || out_size != NT * DM || ws_size < WS_NEED) { fprintf(stderr, "kernel_launch: unexpected shapes / workspace (n_in %d, ws %zu, need %zu)\n", n_in, ws_size, (size_t)WS_NEED); grid = -1; return; }
        int dev = 0, cus = 0;
        if (hipGetDevice(&dev) != hipSuccess || hipDeviceGetAttribute(&cus, hipDeviceAttributeMultiprocessorCount, dev) != hipSuccess) { grid = -1; return; }
        if (hipFuncSetAttribute((const void*)yoco_fwd, hipFuncAttributeMaxDynamicSharedMemorySize, LDS_BYTES) != hipSuccess) { fprintf(stderr, "kernel_launch: hipFuncSetAttribute failed\n"); grid = -1; return; }
        int per_cu = 0;
        if (hipOccupancyMaxActiveBlocksPerMultiprocessor(&per_cu, (const void*)yoco_fwd, NWAVES * 64, LDS_BYTES) != hipSuccess || per_cu < 1) { fprintf(stderr, "kernel_launch: occupancy query says %d\n", per_cu); }
        (void)hipGetLastError();
        grid = cus;
    }
    if (grid < 0) return;
    (void)hipMemsetAsync((char*)d_ws + WS_CTL, 0, CTL_ZERO_BYTES, stream);
    Args a{};
    for (int i = 0; i < 24; ++i) a.in[i] = (const float*)d_in[i];
    a.out = (float*)d_out; a.ws = (unsigned char*)d_ws;
#if MK_SINGLE
    a.ph_lo = 0; a.ph_hi = N_PHASES;
    hipLaunchKernelGGL(yoco_fwd, dim3(grid), dim3(NWAVES * 64), LDS_BYTES, stream, a);
#else
    for (int k = 0; k < N_PHASES; ++k) { a.ph_lo = k; a.ph_hi = k + 1; hipLaunchKernelGGL(yoco_fwd, dim3(grid), dim3(NWAVES * 64), LDS_BYTES, stream, a); }
#endif
}
```

```cpp
#include <hip/hip_runtime.h>
#include <cstdio>
#include <cstdint>

#ifndef MK_SINGLE
#define MK_SINGLE 1
#endif

namespace pg8 {
#define PG8_LAS __attribute__((address_space(3)))
typedef unsigned short bf16_t;
typedef short bf16x8 __attribute__((ext_vector_type(8)));
typedef float f32x4 __attribute__((ext_vector_type(4)));
typedef unsigned u32x4 __attribute__((ext_vector_type(4)));
constexpr int BM = 256, BK = 64, HALF = 128, HTB = HALF * BK * 2  , STAGE_BYTES = 8 * HTB, NXCD = 8, WGM = 8;

__host__ __device__ __forceinline__ int lds_byte(int r, int c) { const int st = (r >> 4) * 2 + (c >> 5), rr = r & 15, cc = c & 31, ob = rr * 64 + cc * 2; return st * 1024 + (ob ^ (((ob >> 9) & 1) << 5)); }
__host__ __device__ __forceinline__ void stage_rc(int b, int& R, int& C) { const int st = b / 1024, sb = b % 1024, swz = sb ^ (((sb >> 9) & 1) << 5); R = (st >> 1) * 16 + swz / 64; C = (st & 1) * 32 + (swz % 64) / 2; }
__host__ __device__ __forceinline__ int perm32(int rho) { const int n = rho >> 4, i = rho & 15; return 8 * (i >> 2) + 4 * n + (i & 3); }

struct Unit { int pm, pn, e; };
struct Gemm { const bf16_t* A; const bf16_t* Bt; int K; int lda; size_t estride; };

struct GenOrder {
    int nM, nN, nwg, G, c; const int* tile_e;
    __device__ void init(int nM_, int nN_, int G_, int c_, const int* te) { nM = nM_; nN = nN_; nwg = nM * nN; G = G_; c = c_; tile_e = te; }
    __device__ bool next(int i, Unit& u) const {
        const long L = (long)i * G + c; if (L >= nwg) return false;
        int wgid = (int)L; { const int q = nwg / NXCD, r = nwg % NXCD, xcd = wgid % NXCD, off = wgid / NXCD; wgid = (xcd < r ? xcd * (q + 1) : r * (q + 1) + (xcd - r) * q) + off; }
        const int nig = WGM * nN, gid = wgid / nig, fm = gid * WGM, gsz = (nM - fm) < WGM ? (nM - fm) : WGM;
        u.pm = fm + ((wgid % nig) % gsz); u.pn = (wgid % nig) / gsz; u.e = tile_e ? tile_e[u.pm] : 0; return true;
    }
    __device__ __forceinline__ void a_ready(const Unit&) const {}
    __device__ __forceinline__ void done(const Unit&) const {}
};

__device__ __forceinline__ unsigned cvt_pk_bf16(float lo, float hi) { unsigned r; asm volatile("v_cvt_pk_bf16_f32 %0, %1, %2" : "=v"(r) : "v"(lo), "v"(hi)); return r; }
__device__ __forceinline__ float silu_f(float v) { return v * __builtin_amdgcn_rcpf(1.0f + __expf(-v)); }
__device__ __forceinline__ float clamp448(float v) { return __builtin_amdgcn_fmed3f(v, -448.f, 448.f); }
__device__ __forceinline__ unsigned pk4_fp8(float a, float b, float c, float d) {
    int w = __builtin_amdgcn_cvt_pk_fp8_f32(clamp448(a), clamp448(b), 0, false); w = __builtin_amdgcn_cvt_pk_fp8_f32(clamp448(c), clamp448(d), w, true); return (unsigned)w; }
constexpr float FP8_SW1 = 32.f, FP8_SW2 = 64.f, FP8_SH = 8.f;

struct EpiBf16 {
    static constexpr bool PERM = true, AFTER_DRAIN = false;
    bf16_t* O; int ldc; const float* bias; int act; int bias_es; float oscale;
    __device__ __forceinline__ void operator()(const f32x4 (&acc)[2][2][4][2], const Unit& u, int wr, int wc, int fr, int fq) const {
        const int row0 = u.pm * BM + wr * 64 + fr, col0 = u.pn * BM + wc * 32 + 8 * fq;
        f32x4 bv[2][2];
#pragma unroll
        for (int bj = 0; bj < 2; ++bj)
#pragma unroll
            for (int n = 0; n < 2; ++n) bv[bj][n] = bias ? *(const f32x4*)(bias + u.e * bias_es + col0 + bj * HALF + 4 * n) : (f32x4){0.f, 0.f, 0.f, 0.f};
#pragma unroll
        for (int ai = 0; ai < 2; ++ai)
#pragma unroll
            for (int m = 0; m < 4; ++m) { bf16_t* rowp = O + (size_t)(row0 + ai * HALF + m * 16) * ldc + col0;
#pragma unroll
                for (int bj = 0; bj < 2; ++bj) { f32x4 v0 = acc[ai][bj][m][0] * oscale + bv[bj][0], v1 = acc[ai][bj][m][1] * oscale + bv[bj][1];
                    if (act == 1) {
#pragma unroll
                        for (int i = 0; i < 4; ++i) { v0[i] = silu_f(v0[i]); v1[i] = silu_f(v1[i]); } }
                    u32x4 w; w.x = cvt_pk_bf16(v0[0], v0[1]); w.y = cvt_pk_bf16(v0[2], v0[3]); w.z = cvt_pk_bf16(v1[0], v1[1]); w.w = cvt_pk_bf16(v1[2], v1[3]);
                    *(u32x4*)(rowp + bj * HALF) = w; } }
    }
};
struct EpiRes {
    static constexpr bool PERM = false, AFTER_DRAIN = false;
    const float* base; float* out; int ldc; float oscale;
    __device__ __forceinline__ void operator()(const f32x4 (&acc)[2][2][4][2], const Unit& u, int wr, int wc, int fr, int fq) const {
        const int row0 = u.pm * BM + wr * 64 + fr, col0 = u.pn * BM + wc * 32 + 4 * fq;
#pragma unroll
        for (int ai = 0; ai < 2; ++ai)
#pragma unroll
            for (int m = 0; m < 4; ++m) { const size_t off = (size_t)(row0 + ai * HALF + m * 16) * ldc + col0;
#pragma unroll
                for (int bj = 0; bj < 2; ++bj)
#pragma unroll
                    for (int n = 0; n < 2; ++n) { const f32x4 b = *(const f32x4*)(base + off + bj * HALF + n * 16); *(f32x4*)(out + off + bj * HALF + n * 16) = b + acc[ai][bj][m][n] * oscale; } }
    }
};
template <bool BASE_F32>
struct EpiResB {
    static constexpr bool PERM = true, AFTER_DRAIN = false;
    const float* basef; bf16_t* xr; float oscale;
    __device__ __forceinline__ void operator()(const f32x4 (&acc)[2][2][4][2], const Unit& u, int wr, int wc, int fr, int fq) const {
        const int row0 = u.pm * BM + wr * 64 + fr, col0 = u.pn * BM + wc * 32 + 8 * fq;
#pragma unroll
        for (int ai = 0; ai < 2; ++ai)
#pragma unroll
            for (int m = 0; m < 4; ++m) { const size_t off = (size_t)(row0 + ai * HALF + m * 16) * 1024 + col0;
#pragma unroll
                for (int bj = 0; bj < 2; ++bj) { f32x4 b0, b1;
                    if constexpr (BASE_F32) { b0 = *(const f32x4*)(basef + off + bj * HALF); b1 = *(const f32x4*)(basef + off + bj * HALF + 4); }
                    else { const u32x4 w = *(const u32x4*)(xr + off + bj * HALF);
                        b0 = (f32x4){__builtin_bit_cast(float, w.x << 16), __builtin_bit_cast(float, w.x & 0xffff0000u), __builtin_bit_cast(float, w.y << 16), __builtin_bit_cast(float, w.y & 0xffff0000u)};
                        b1 = (f32x4){__builtin_bit_cast(float, w.z << 16), __builtin_bit_cast(float, w.z & 0xffff0000u), __builtin_bit_cast(float, w.w << 16), __builtin_bit_cast(float, w.w & 0xffff0000u)}; }
                    const f32x4 v0 = b0 + acc[ai][bj][m][0] * oscale, v1 = b1 + acc[ai][bj][m][1] * oscale;
                    u32x4 o; o.x = cvt_pk_bf16(v0[0], v0[1]); o.y = cvt_pk_bf16(v0[2], v0[3]); o.z = cvt_pk_bf16(v1[0], v1[1]); o.w = cvt_pk_bf16(v1[2], v1[3]);
                    *(u32x4*)(xr + off + bj * HALF) = o; } }
    }
};
struct EpiSwiGLU {
    static constexpr bool PERM = true, AFTER_DRAIN = false;
    bf16_t* O; int ldc;
    __device__ __forceinline__ void operator()(const f32x4 (&acc)[2][2][4][2], const Unit& u, int wr, int wc, int fr, int fq) const {
        const int row0 = u.pm * BM + wr * 64 + fr, col0 = u.pn * HALF + wc * 32 + 8 * fq;
#pragma unroll
        for (int ai = 0; ai < 2; ++ai)
#pragma unroll
            for (int m = 0; m < 4; ++m) { bf16_t* rowp = O + (size_t)(row0 + ai * HALF + m * 16) * ldc + col0;
                f32x4 v0, v1;
#pragma unroll
                for (int i = 0; i < 4; ++i) { v0[i] = silu_f(acc[ai][0][m][0][i]) * acc[ai][1][m][0][i]; v1[i] = silu_f(acc[ai][0][m][1][i]) * acc[ai][1][m][1][i]; }
                u32x4 w; w.x = cvt_pk_bf16(v0[0], v0[1]); w.y = cvt_pk_bf16(v0[2], v0[3]); w.z = cvt_pk_bf16(v1[0], v1[1]); w.w = cvt_pk_bf16(v1[2], v1[3]);
                *(u32x4*)rowp = w; }
    }
};
struct EpiSwiGLU8 {
    static constexpr bool PERM = true, AFTER_DRAIN = false;
    static constexpr int WSCALE0 = 0x7a7a7a7a, WSCALE1 = 0x7d7d7d7d;
    unsigned char* O; int ldc;
    __device__ __forceinline__ void operator()(const f32x4 (&acc)[2][2][4][2], const Unit& u, int wr, int wc, int fr, int fq) const {
        const int row0 = u.pm * BM + wr * 64 + fr, col0 = u.pn * HALF + wc * 32 + 8 * fq;
        typedef float f32x2 __attribute__((ext_vector_type(2)));
#pragma unroll
        for (int ai = 0; ai < 2; ++ai)
#pragma unroll
            for (int m = 0; m < 4; ++m) { unsigned char* rowp = O + (size_t)(row0 + ai * HALF + m * 16) * ldc + col0;
                f32x2 o[2][2];
#pragma unroll
                for (int n = 0; n < 2; ++n)
#pragma unroll
                    for (int hh = 0; hh < 2; ++hh) {
                        const f32x2 g = {acc[ai][0][m][n][2 * hh], acc[ai][0][m][n][2 * hh + 1]}, up = {acc[ai][1][m][n][2 * hh], acc[ai][1][m][n][2 * hh + 1]};
                        const f32x2 t = g * (f32x2){-1.4426950408889634f, -1.4426950408889634f};
                        const f32x2 a = (f32x2){__builtin_amdgcn_exp2f(t.x), __builtin_amdgcn_exp2f(t.y)} + (f32x2){1.f, 1.f};
                        o[n][hh] = (g * up) * (f32x2){__builtin_amdgcn_rcpf(a.x), __builtin_amdgcn_rcpf(a.y)}; }
                typedef unsigned u32x2 __attribute__((ext_vector_type(2))); u32x2 w; w.x = pk4_fp8(o[0][0].x, o[0][0].y, o[0][1].x, o[0][1].y); w.y = pk4_fp8(o[1][0].x, o[1][0].y, o[1][1].x, o[1][1].y);
                *(u32x2*)rowp = w; }
    }
};
__device__ __forceinline__ float logf_gate(float x, float lb, float omlb) {
    const float sg = __builtin_amdgcn_rcpf(1.0f + __builtin_amdgcn_exp2f(x * -1.4426950408889634f));
    return __builtin_amdgcn_logf(lb + omlb * sg) * 0.6931471805599453f;
}
struct EpiHgrnIn {
    static constexpr bool PERM = true, AFTER_DRAIN = false;
    unsigned char* ws; int layer;
    static constexpr size_t O_PQ = 580ull << 20, O_PI = O_PQ + (128ull << 20), O_PG = O_PQ + (256ull << 20), O_LF = O_PQ + (384ull << 20), O_LA = 1ull << 20, O_L1 = O_LA + 8192;
    __device__ __forceinline__ void operator()(const f32x4 (&acc)[2][2][4][2], const Unit& u, int wr, int wc, int fr, int fq) const {
        const int quarter = u.pn >> 2;
        const int row0 = u.pm * BM + wr * 64 + fr, col0 = (u.pn & 3) * BM + wc * 32 + 8 * fq;
        if (quarter == 1) {
            const float* la = (const float*)(ws + O_LA) + layer * 1024; const float* l1 = (const float*)(ws + O_L1) + layer * 1024; _Float16* LF = (_Float16*)(ws + O_LF);
            f32x4 A0[2][2], A1[2][2];
#pragma unroll
            for (int bj = 0; bj < 2; ++bj)
#pragma unroll
                for (int n = 0; n < 2; ++n) { A0[bj][n] = *(const f32x4*)(la + col0 + bj * HALF + 4 * n); A1[bj][n] = *(const f32x4*)(l1 + col0 + bj * HALF + 4 * n); }
#pragma unroll
            for (int ai = 0; ai < 2; ++ai)
#pragma unroll
                for (int m = 0; m < 4; ++m) { _Float16* rowp = LF + (size_t)(row0 + ai * HALF + m * 16) * 1024 + col0;
#pragma unroll
                    for (int bj = 0; bj < 2; ++bj) { typedef _Float16 h8 __attribute__((ext_vector_type(8))); h8 o;
#pragma unroll
                        for (int n = 0; n < 2; ++n)
#pragma unroll
                            for (int i = 0; i < 4; ++i) o[4 * n + i] = (_Float16)logf_gate(acc[ai][bj][m][n][i], A0[bj][n][i], A1[bj][n][i]);
                        *(h8*)(rowp + bj * HALF) = o; } }
        } else {
            bf16_t* O = (bf16_t*)(ws + (quarter == 0 ? O_PQ : (quarter == 2 ? O_PI : O_PG)));
#pragma unroll
            for (int ai = 0; ai < 2; ++ai)
#pragma unroll
                for (int m = 0; m < 4; ++m) { bf16_t* rowp = O + (size_t)(row0 + ai * HALF + m * 16) * 1024 + col0;
#pragma unroll
                    for (int bj = 0; bj < 2; ++bj) { f32x4 v0 = acc[ai][bj][m][0], v1 = acc[ai][bj][m][1];
                        if (quarter != 2) {
#pragma unroll
                            for (int i = 0; i < 4; ++i) { v0[i] = silu_f(v0[i]); v1[i] = silu_f(v1[i]); } }
                        u32x4 w; w.x = cvt_pk_bf16(v0[0], v0[1]); w.y = cvt_pk_bf16(v0[2], v0[3]); w.z = cvt_pk_bf16(v1[0], v1[1]); w.w = cvt_pk_bf16(v1[2], v1[3]);
                        *(u32x4*)(rowp + bj * HALF) = w; } }
        }
    }
};

template <class E> constexpr int epi_wscale(int bj) { if constexpr (__is_same(E, EpiSwiGLU8)) return bj ? E::WSCALE1 : E::WSCALE0; else return 0x7f7f7f7f; }
template <class Epi, class Sched, bool ALIGN_EPI = false, bool SP2 = false, bool FP8 = false>
__device__ __forceinline__ void gemm_phase(PG8_LAS unsigned char* lds, const Gemm g, const Sched& S, const Epi& E, const int wave_id) {
    int lane_; asm volatile("v_mbcnt_lo_u32_b32 %0, -1, 0\n\tv_mbcnt_hi_u32_b32 %0, -1, %0" : "=v"(lane_));
    const int wid = wave_id, lane = lane_, tid = wid * 64 + lane, wr = wid >> 2, wc = wid & 3, fr = lane & 15, fq = lane >> 4;
    const int K = g.K, nt = K / BK, lda = g.lda;
    unsigned voffA[2], voffB[2];
#pragma unroll
    for (int i = 0; i < 2; ++i) { int R, C; stage_rc(tid * 16 + i * 8192, R, C); const int Rb = Epi::PERM ? ((R & ~31) + perm32(R & 31)) : R;
        voffA[i] = (unsigned)(R * lda + C) * 2u; voffB[i] = (unsigned)(Rb * K + C) * 2u; }
    const size_t kstep = (size_t)(BK * 2);
    const size_t hstep = (size_t)HALF * K * 2;
    const size_t tstep = 2 * hstep;
    const size_t hstepA = (size_t)HALF * lda * 2, tstepA = 2 * hstepA;
    const unsigned ldsw = (unsigned)wid * 1024u;
    const int aoff = lds_byte(wr * 64 + fr, fq * 8), boff = lds_byte(wc * 32 + fr, fq * 8);
#define PG8_SA(b, h) (((b) * 2 + (h)) * HTB)
#define PG8_SB(b, h) ((4 + (b) * 2 + (h)) * HTB)
#define PG8_STAGE(bufoff, gbase, voff) do { _Pragma("unroll") for (int _i = 0; _i < 2; ++_i) \
        __builtin_amdgcn_global_load_lds((const unsigned*)((const char*)(gbase) + (voff)[_i]), (PG8_LAS unsigned*)(lds + (bufoff) + ldsw + _i * 8192), 16, 0, 0); } while (0)
    typedef int i32x4_ __attribute__((ext_vector_type(4))); typedef int i32x8_ __attribute__((ext_vector_type(8)));
#define PG8_CAT(x, y) __builtin_shufflevector((x), (y), 0, 1, 2, 3, 4, 5, 6, 7)
#define PG8_LDA(dst, b, h) do { _Pragma("unroll") for (int m = 0; m < 4; ++m) { \
        if constexpr (FP8) dst##8[m] = PG8_CAT(*(const PG8_LAS i32x4_*)(lds + PG8_SA(b, h) + aoff + m * 2048), *(const PG8_LAS i32x4_*)(lds + PG8_SA(b, h) + aoff + m * 2048 + 1024)); \
        else { _Pragma("unroll") for (int k = 0; k < 2; ++k) dst[m][k] = *(const PG8_LAS bf16x8*)(lds + PG8_SA(b, h) + aoff + m * 2048 + k * 1024); } } } while (0)
#define PG8_LDB(dst, b, h) do { _Pragma("unroll") for (int n = 0; n < 2; ++n) { \
        if constexpr (FP8) dst##8[n] = PG8_CAT(*(const PG8_LAS i32x4_*)(lds + PG8_SB(b, h) + boff + n * 2048), *(const PG8_LAS i32x4_*)(lds + PG8_SB(b, h) + boff + n * 2048 + 1024)); \
        else { _Pragma("unroll") for (int k = 0; k < 2; ++k) dst[n][k] = *(const PG8_LAS bf16x8*)(lds + PG8_SB(b, h) + boff + n * 2048 + k * 1024); } } } while (0)
#define PG8_MMA(ai, bj, At, Bt) do { __builtin_amdgcn_s_setprio(1); _Pragma("unroll") for (int m = 0; m < 4; ++m) _Pragma("unroll") for (int n = 0; n < 2; ++n) { \
        if constexpr (FP8) asm volatile("v_mfma_scale_f32_16x16x128_f8f6f4 %0, %1, %2, %0, %3, %4 op_sel_hi:[0,0,0]" : "+v"(acc[ai][bj][m][n]) : "v"(Bt##8[n]), "v"(At##8[m]), "v"((bj) ? wscale1_ : wscale0_), "v"(f8scale_)); \
        else { _Pragma("unroll") for (int k = 0; k < 2; ++k) acc[ai][bj][m][n] = __builtin_amdgcn_mfma_f32_16x16x32_bf16(Bt[n][k], At[m][k], acc[ai][bj][m][n], 0, 0, 0); } } \
        __builtin_amdgcn_s_setprio(0); } while (0)
#define PG8_WAIT_V(n) asm volatile("s_waitcnt vmcnt(" #n ")" ::: "memory")
#define PG8_WAIT_L(n) asm volatile("s_waitcnt lgkmcnt(" #n ")" ::: "memory")
#define PG8_BAR __builtin_amdgcn_s_barrier()
#define PG8_SCHED __builtin_amdgcn_sched_barrier(0)
    Unit cur, nxt; int ui = 0;
    if (!S.next(0, cur)) return;
    f32x4 acc[2][2][4][2];
#pragma unroll
    for (int a = 0; a < 2; ++a)
#pragma unroll
        for (int b = 0; b < 2; ++b)
#pragma unroll
            for (int m = 0; m < 4; ++m)
#pragma unroll
                for (int n = 0; n < 2; ++n) acc[a][b][m][n] = (f32x4){0.f, 0.f, 0.f, 0.f};
    const int f8scale_ = 0x7f7f7f7f, wscale0_ = epi_wscale<Epi>(0), wscale1_ = epi_wscale<Epi>(1);
    bf16x8 At[4][2], B0[2][2], B1[2][2]; i32x8_ At8[4], B08[2], B18[2];
    const char* cA = (const char*)g.A + (size_t)cur.pm * tstepA; const char* cB = (const char*)g.Bt + (size_t)cur.e * g.estride + (size_t)cur.pn * tstep;
    S.a_ready(cur);
    if constexpr (SP2) {
        PG8_STAGE(PG8_SB(0, 0), cB, voffB); PG8_STAGE(PG8_SB(0, 1), cB + hstep, voffB); PG8_STAGE(PG8_SA(0, 0), cA, voffA); PG8_STAGE(PG8_SA(0, 1), cA + hstepA, voffA);
        if (wr == 1) PG8_BAR;
        PG8_WAIT_V(2); PG8_BAR;
        PG8_STAGE(PG8_SB(1, 0), cB + kstep, voffB); PG8_STAGE(PG8_SA(1, 0), cA + kstep, voffA); PG8_STAGE(PG8_SB(1, 1), cB + hstep + kstep, voffB);
        PG8_WAIT_V(6); PG8_BAR;
    } else {
        PG8_STAGE(PG8_SB(0, 0), cB, voffB); PG8_STAGE(PG8_SA(0, 0), cA, voffA); PG8_STAGE(PG8_SB(0, 1), cB + hstep, voffB); PG8_STAGE(PG8_SA(0, 1), cA + hstepA, voffA);
        if (wr == 1) PG8_BAR;
        PG8_WAIT_V(4); PG8_BAR;
        PG8_STAGE(PG8_SB(1, 0), cB + kstep, voffB); PG8_STAGE(PG8_SA(1, 0), cA + kstep, voffA); PG8_STAGE(PG8_SB(1, 1), cB + hstep + kstep, voffB);
        PG8_WAIT_V(6); PG8_BAR;
    }
    for (;;) {
        const bool has_next = S.next(ui + 1, nxt);
        const char* nA = has_next ? (const char*)g.A + (size_t)nxt.pm * tstepA : cA; const char* nB = has_next ? (const char*)g.Bt + (size_t)nxt.e * g.estride + (size_t)nxt.pn * tstep : cB;
        for (int t = 0; t < nt; t += 2) {
            const bool last = (t == nt - 2);
            const char* a1 = cA + (size_t)(t + 1) * kstep;
            const char* a2 = last ? nA : cA + (size_t)(t + 2) * kstep; const char* b2 = last ? nB : cB + (size_t)(t + 2) * kstep;
            const char* a3 = a2 + kstep; const char* b3 = b2 + kstep;
            if (last && has_next) S.a_ready(nxt);
            if constexpr (SP2) {
            PG8_STAGE(PG8_SA(1, 1), a1 + hstepA, voffA); PG8_SCHED; PG8_LDB(B0, 0, 0); PG8_LDB(B1, 0, 1); PG8_SCHED; PG8_LDA(At, 0, 0);
            PG8_WAIT_V(8); PG8_WAIT_L(0); PG8_BAR; PG8_MMA(0, 0, At, B0); PG8_MMA(0, 1, At, B1); PG8_BAR; PG8_SCHED;
            PG8_STAGE(PG8_SB(0, 0), b2, voffB); PG8_STAGE(PG8_SB(0, 1), b2 + hstep, voffB); PG8_STAGE(PG8_SA(0, 0), a2, voffA); PG8_SCHED; PG8_LDA(At, 0, 1);
            PG8_WAIT_V(8); PG8_WAIT_L(0); PG8_BAR; PG8_MMA(1, 0, At, B0); PG8_MMA(1, 1, At, B1); PG8_BAR; PG8_SCHED;
            PG8_STAGE(PG8_SA(0, 1), a2 + hstepA, voffA); PG8_SCHED; PG8_LDB(B0, 1, 0); PG8_LDB(B1, 1, 1); PG8_SCHED; PG8_LDA(At, 1, 0);
            PG8_WAIT_V(8); PG8_WAIT_L(0); PG8_BAR; PG8_MMA(0, 0, At, B0); PG8_MMA(0, 1, At, B1); PG8_BAR; PG8_SCHED;
            PG8_STAGE(PG8_SB(1, 0), b3, voffB); PG8_STAGE(PG8_SB(1, 1), b3 + hstep, voffB); PG8_STAGE(PG8_SA(1, 0), a3, voffA); PG8_SCHED; PG8_LDA(At, 1, 1);
            PG8_WAIT_V(8); PG8_WAIT_L(0); PG8_BAR; PG8_MMA(1, 0, At, B0); PG8_MMA(1, 1, At, B1); PG8_BAR; PG8_SCHED;
            } else {
            PG8_LDB(B0, 0, 0); PG8_SCHED; PG8_LDA(At, 0, 0); PG8_STAGE(PG8_SA(1, 1), a1 + hstepA, voffA);
            PG8_WAIT_L(8); PG8_BAR; PG8_WAIT_L(0); PG8_MMA(0, 0, At, B0); PG8_BAR; PG8_SCHED;
            PG8_LDB(B1, 0, 1); PG8_STAGE(PG8_SB(0, 0), b2, voffB);
            PG8_BAR; PG8_WAIT_L(0); PG8_MMA(0, 1, At, B1); PG8_BAR;
            PG8_LDA(At, 0, 1); PG8_STAGE(PG8_SA(0, 0), a2, voffA);
            PG8_BAR; PG8_WAIT_L(0); PG8_MMA(1, 0, At, B0); PG8_BAR; PG8_SCHED;
            PG8_STAGE(PG8_SB(0, 1), b2 + hstep, voffB);
            PG8_WAIT_V(6); PG8_BAR; PG8_MMA(1, 1, At, B1); PG8_BAR;
            PG8_LDB(B0, 1, 0); PG8_SCHED; PG8_LDA(At, 1, 0); PG8_STAGE(PG8_SA(0, 1), a2 + hstepA, voffA);
            PG8_WAIT_L(8); PG8_BAR; PG8_WAIT_L(0); PG8_MMA(0, 0, At, B0); PG8_BAR; PG8_SCHED;
            PG8_LDB(B1, 1, 1); PG8_STAGE(PG8_SB(1, 0), b3, voffB);
            PG8_BAR; PG8_WAIT_L(0); PG8_MMA(0, 1, At, B1); PG8_BAR;
            PG8_LDA(At, 1, 1); PG8_STAGE(PG8_SA(1, 0), a3, voffA);
            PG8_BAR; PG8_WAIT_L(0); PG8_MMA(1, 0, At, B0); PG8_BAR; PG8_SCHED;
            PG8_STAGE(PG8_SB(1, 1), b3 + hstep, voffB);
            PG8_WAIT_V(6); PG8_BAR; PG8_MMA(1, 1, At, B1); PG8_BAR;
            }
        }
        if constexpr (FP8) asm volatile("s_nop 15\n\ts_nop 15" ::: "memory");
        if constexpr (ALIGN_EPI) { if (wr == 0) PG8_BAR; }
        if constexpr (!Epi::AFTER_DRAIN) { E(acc, cur, wr, wc, fr, fq); S.done(cur); }
        if (!has_next) break;
#pragma unroll
        for (int a = 0; a < 2; ++a)
#pragma unroll
            for (int b = 0; b < 2; ++b)
#pragma unroll
                for (int m = 0; m < 4; ++m)
#pragma unroll
                    for (int n = 0; n < 2; ++n) acc[a][b][m][n] = (f32x4){0.f, 0.f, 0.f, 0.f};
        cur = nxt; cA = nA; cB = nB; ++ui;
        if constexpr (ALIGN_EPI) { if (wr == 1) PG8_BAR; }
    }
    PG8_WAIT_V(0);
    if constexpr (!ALIGN_EPI) { if (wr == 0) PG8_BAR; }
    PG8_BAR;
    if constexpr (Epi::AFTER_DRAIN) { E.fused(acc, cur, wr, wc, fr, fq, lds, wid, lane); S.done(cur); }
#undef PG8_SA
#undef PG8_SB
#undef PG8_STAGE
#undef PG8_LDA
#undef PG8_LDB
#undef PG8_MMA
#undef PG8_CAT
#undef PG8_WAIT_V
#undef PG8_WAIT_L
#undef PG8_BAR
#undef PG8_SCHED
}
}

constexpr int NT = 65536, DM = 1024, NBATCH = 32, SEQ = 2048;
constexpr int DFF = 2816, DFE = 3584, NEXP = 8;
constexpr int MOE_ROWS = 133120;
constexpr float EPS = 1e-6f;
constexpr size_t MiB = 1u << 20;
constexpr size_t WS_CTL = 0, CTL_ZERO_BYTES = 1 * MiB;
constexpr size_t WS_LA = 1 * MiB;
constexpr size_t WS_L1 = WS_LA + 8192;
constexpr size_t WS_CB = WS_LA + 16384;
constexpr size_t WS_RCNT = WS_LA + 32768;
constexpr size_t WS_RTAB = WS_LA + 65536;
constexpr size_t WS_ROUTE = 2 * MiB;
constexpr size_t WS_SLOT = 3 * MiB;
constexpr size_t WS_SELM = 4 * MiB;
constexpr size_t WS_GATES = 8 * MiB;
constexpr size_t WS_KC = 20 * MiB;
constexpr size_t WS_VCT = 22 * MiB;
constexpr size_t WS_HC = 24 * MiB;
constexpr size_t WS_W = 48 * MiB;
constexpr size_t W_HIN = WS_W, W_HOUT = WS_W + 16 * MiB, W_KVQ = WS_W + 20 * MiB, W_Q3 = WS_W + 26 * MiB, W_CMP1 = WS_W + 29 * MiB, W_NOUT = WS_W + 31 * MiB,
                 W_FGU = WS_W + 35 * MiB, W_FDN = WS_W + 57 * MiB, W_MGU = WS_W + 68 * MiB, W_MDN = WS_W + 292 * MiB;
constexpr size_t WS_XN = 452 * MiB;
constexpr size_t WS_R = 580 * MiB;
constexpr size_t R_PQ = WS_R, R_PI = WS_R + 128 * MiB, R_PG = WS_R + 256 * MiB, R_LF = WS_R + 384 * MiB, R_O2 = WS_R + 640 * MiB;
constexpr size_t R_HF = WS_R + 256 * MiB;
constexpr size_t R_KS = WS_R, R_KW = WS_R + 32 * MiB, R_VST = WS_R + 64 * MiB, R_VWT = WS_R + 96 * MiB, R_KCR = WS_R + 128 * MiB, R_VCR = WS_R + 160 * MiB;
constexpr size_t R_QKV = WS_R + 256 * MiB;
constexpr size_t R_Q = WS_R + 608 * MiB, R_O = WS_R + 736 * MiB;
constexpr size_t R_XP = WS_R, R_HM = WS_R + 260 * MiB;
constexpr size_t WS_XR = 1408 * MiB;
constexpr size_t WS_NEED = R_HM + (size_t)MOE_ROWS * DFE * 2;
static_assert(R_O + 64 * MiB <= WS_XR && R_O2 + 128 * MiB <= WS_XR && R_HM + (size_t)MOE_ROWS * DFE <= WS_XR && R_HF + (size_t)NT * DFF * 2 <= WS_XR && WS_XR + 128 * MiB <= WS_NEED, "residual rows");
static_assert(WS_NEED <= 1792 * MiB, "workspace map");
static_assert(W_MDN + 112 * MiB <= WS_XN, "weights map");
static_assert(pg8::EpiHgrnIn::O_PQ == R_PQ && pg8::EpiHgrnIn::O_PI == R_PI && pg8::EpiHgrnIn::O_PG == R_PG && pg8::EpiHgrnIn::O_LF == R_LF && pg8::EpiHgrnIn::O_LA == WS_LA && pg8::EpiHgrnIn::O_L1 == WS_L1, "EpiHgrnIn offsets");

constexpr int LDS_BYTES = 147456;
constexpr int MISC_OFF = 131072 + 320;
constexpr int NWAVES = 8;

#define GAS __attribute__((address_space(1)))
#define LAS __attribute__((address_space(3)))
typedef unsigned short bf16;
typedef unsigned v4u __attribute__((ext_vector_type(4)));
typedef unsigned v2u __attribute__((ext_vector_type(2)));
typedef float f32x4 __attribute__((ext_vector_type(4)));
#define LDS_WAIT() asm volatile("s_waitcnt lgkmcnt(0)" ::: "memory")
__device__ __forceinline__ unsigned f2bf(float f) { unsigned r; asm("v_cvt_pk_bf16_f32 %0, %1, 0" : "=v"(r) : "v"(f)); return r; }
__device__ __forceinline__ unsigned pk2(float lo, float hi) { unsigned r; asm("v_cvt_pk_bf16_f32 %0, %1, %2" : "=v"(r) : "v"(lo), "v"(hi)); return r; }
__device__ __forceinline__ float bf2f(unsigned b) { return __builtin_bit_cast(float, b << 16); }
__device__ __forceinline__ float bflo(unsigned w) { return __builtin_bit_cast(float, w << 16); }
__device__ __forceinline__ float bfhi(unsigned w) { return __builtin_bit_cast(float, w & 0xffff0000u); }
__device__ __forceinline__ float wave_sum(float v) {
#pragma unroll
    for (int o = 32; o >= 1; o >>= 1) v += __shfl_xor(v, o);
    return v;
}
__device__ __forceinline__ float wave_max(float v) {
#pragma unroll
    for (int o = 32; o >= 1; o >>= 1) v = fmaxf(v, __shfl_xor(v, o));
    return v;
}

#define XB_TMO      128
#define XB_XCNT(j)  (256  + 64 * (j))
#define XB_XSUB(j)  (1280 + 64 * (j))
#define XB_XGEN(j)  (2304 + 64 * (j))
#define XB_TOP      3328
#define XB_TOPGEN   3392
#define XCD_BAR_WORDS 3456
#define XB_SPIN_CAP (1u << 22)
__device__ __forceinline__ unsigned xb_ld(unsigned* p)              { return __hip_atomic_load(p, __ATOMIC_RELAXED, __HIP_MEMORY_SCOPE_AGENT); }
__device__ __forceinline__ unsigned xb_add(unsigned* p, unsigned v) { return __hip_atomic_fetch_add(p, v, __ATOMIC_RELAXED, __HIP_MEMORY_SCOPE_AGENT); }
__device__ __forceinline__ unsigned xb_xcc_id() { return (unsigned)__builtin_amdgcn_s_getreg((3 << 11) | 20) & 0xFu; }
#define XB_SPIN(cond, bar) do { unsigned _sp = 0; while (cond) { __builtin_amdgcn_s_sleep(1); \
    if ((++_sp & 255u) == 0u) { if (xb_ld(&(bar)[XB_TMO])) break; if (_sp > XB_SPIN_CAP) { atomicAdd(&(bar)[XB_TMO], 1u); break; } } } } while (0)
struct XcdBarrier { unsigned* bar; unsigned x; volatile LAS unsigned* st; };
__device__ __forceinline__ XcdBarrier xcd_barrier_post(unsigned* bar, volatile LAS unsigned* st) {
    XcdBarrier b; b.bar = bar; b.x = xb_xcc_id(); b.st = st;
    if (threadIdx.x == 0) (void)xb_add(&bar[XB_XCNT(b.x)], 1u);
    return b;
}
__device__ __forceinline__ void xcd_barrier_complete(unsigned* bar, unsigned x, unsigned& nloc, unsigned& nx) {
    const unsigned G = gridDim.x * gridDim.y * gridDim.z;
    unsigned sum, cnt, mine, sp = 0u;
    for (;;) {
        sum = 0u; cnt = 0u; mine = 0u;
#pragma unroll
        for (unsigned j = 0; j < 16; ++j) { const unsigned c = xb_ld(&bar[XB_XCNT(j)]); sum += c; cnt += (c > 0u) ? 1u : 0u; mine = (j == x) ? c : mine; }
        if (sum == G) break;
        __builtin_amdgcn_s_sleep(1);
        if ((++sp & 255u) == 0u) { if (xb_ld(&bar[XB_TMO])) break; if (sp > XB_SPIN_CAP) { atomicAdd(&bar[XB_TMO], 1u); break; } }
    }
    nloc = mine > 0u ? mine : 1u; nx = cnt > 0u ? cnt : 1u;
}
__device__ __forceinline__ void xcd_barrier(const XcdBarrier& b) {
    asm volatile("s_waitcnt vmcnt(0)" ::: "memory");
    __syncthreads();
    if (threadIdx.x == 0) {
        unsigned* bar = b.bar; unsigned bx_ = b.x; asm volatile("" : "+s"(bar), "+s"(bx_));
        __builtin_amdgcn_s_waitcnt(0);
        unsigned nloc = b.st[0], nx = b.st[1];
        if (nloc == 0u) { xcd_barrier_complete(bar, bx_, nloc, nx); b.st[0] = nloc; b.st[1] = nx; }
        const unsigned old = xb_add(&bar[XB_XSUB(bx_)], 1u);
        const unsigned gen = old / nloc;
        if (old + 1u == (gen + 1u) * nloc) {
            __builtin_amdgcn_fence(__ATOMIC_RELEASE, "agent");
            asm volatile("s_waitcnt vmcnt(0)" ::: "memory");
            const unsigned og = xb_add(&bar[XB_TOP], 1u);
            const unsigned tg = og / nx;
            if (og + 1u == (tg + 1u) * nx) xb_add(&bar[XB_TOPGEN], 1u);
            else XB_SPIN(xb_ld(&bar[XB_TOPGEN]) == tg, bar);
            __builtin_amdgcn_fence(__ATOMIC_ACQUIRE, "agent");
            xb_add(&bar[XB_XGEN(bx_)], 1u);
            asm volatile("s_waitcnt vmcnt(0)" ::: "memory");
        } else {
            XB_SPIN(xb_ld(&bar[XB_XGEN(bx_)]) == gen, bar);
            __builtin_amdgcn_fence(__ATOMIC_ACQUIRE, "agent");
            asm volatile("s_waitcnt vmcnt(0)" ::: "memory");
        }
    }
    __syncthreads();
}

struct Ctx {
    LAS unsigned char* lds;
    int tid, lane, wave, G, bid;
    float* out; unsigned char* ws;
    __device__ __forceinline__ const float* inp(int i) const {
        const __attribute__((address_space(4))) unsigned char* kp = (const __attribute__((address_space(4))) unsigned char*)__builtin_amdgcn_kernarg_segment_ptr();
        asm volatile("" : "+s"(kp));
        return ((const float* const __attribute__((address_space(4)))*)kp)[i];
    }
};
enum { I_X = 0, I_NMIX, I_NFFN, I_HWIN, I_HWOUT, I_HGN, I_HLB, I_KVN, I_KVW, I_CPK, I_CW1K, I_CW2K, I_CPV, I_CW1V, I_CW2V, I_KN, I_NWIN, I_NWOUT, I_NQN, I_FGU, I_FDN, I_MR, I_MGU, I_MDN };

constexpr int MAXJOB = 64;
struct JobTab { unsigned long long src[MAXJOB], gain[MAXJOB], dst[MAXJOB]; int K[MAXJOB], Nsrc[MAXJOB], npb[MAXJOB], F[MAXJOB], rowoff[MAXJOB], istart[MAXJOB + 1]; float f8s[MAXJOB]; int njobs; };
__device__ __forceinline__ void add_job(LAS JobTab* J, const float* src, const float* gain, bf16* dst, int K, int Nsrc, int Npad, int F, int rowoff, float f8s = 0.f) {
    const int j = J->njobs; J->src[j] = (unsigned long long)src; J->gain[j] = (unsigned long long)gain; J->dst[j] = (unsigned long long)dst;
    J->K[j] = K; J->Nsrc[j] = Nsrc; J->npb[j] = Npad / 32; J->F[j] = F; J->rowoff[j] = rowoff; J->f8s[j] = f8s; J->istart[j + 1] = J->istart[j] + (K / 64) * (Npad / 32); J->njobs = j + 1;
}
struct TrItem { const float* W; const float* gain; bf16* WT; int K, Nsrc, drow, k0, n0; float f8s; };
__device__ __forceinline__ void tr_load(const TrItem& p, f32x4 (&v)[8], int lane) {
    const int c4 = lane & 7, kr = lane >> 3, n = p.n0 + 4 * c4; const bool okn = n < p.Nsrc;
#pragma unroll
    for (int i = 0; i < 8; ++i) { const int kk = 8 * i + kr; v[i] = okn ? *(const f32x4*)(p.W + (size_t)(p.k0 + kk) * p.Nsrc + n) : (f32x4){0.f, 0.f, 0.f, 0.f}; }
}
__device__ __forceinline__ void tr_finish(const TrItem& p, f32x4 (&v)[8], LAS float* scr, int lane) {
    const int c4 = lane & 7, kr = lane >> 3;
#pragma unroll
    for (int i = 0; i < 8; ++i) { const int kk = 8 * i + kr; if (p.gain) v[i] = v[i] * p.gain[p.k0 + kk]; *(LAS f32x4*)(scr + kk * 36 + 4 * c4) = v[i]; }
    LDS_WAIT();
    const int c = lane & 7; const float f8s = p.f8s;
#pragma unroll
    for (int j = 0; j < 4; ++j) { const int nn = (lane >> 3) + 8 * j; const LAS float* s = scr + (8 * c) * 36 + nn;
        if (f8s != 0.f) { v2u o; o.x = pg8::pk4_fp8(s[0 * 36] * f8s, s[1 * 36] * f8s, s[2 * 36] * f8s, s[3 * 36] * f8s); o.y = pg8::pk4_fp8(s[4 * 36] * f8s, s[5 * 36] * f8s, s[6 * 36] * f8s, s[7 * 36] * f8s);
            *(v2u*)((unsigned char*)p.WT + (size_t)(p.drow + nn) * p.K + p.k0 + 8 * c) = o; }
        else { v4u o; o.x = pk2(s[0 * 36], s[1 * 36]); o.y = pk2(s[2 * 36], s[3 * 36]); o.z = pk2(s[4 * 36], s[5 * 36]); o.w = pk2(s[6 * 36], s[7 * 36]);
            *(v4u*)(p.WT + (size_t)(p.drow + nn) * p.K + p.k0 + 8 * c) = o; } }
    LDS_WAIT();
}
__device__ __forceinline__ void norm_row_store(const f32x4 (&v)[4], bf16* orow, int lane) {
    float s = 0.f;
#pragma unroll
    for (int j = 0; j < 4; ++j) s += (v[j].x * v[j].x + v[j].y * v[j].y) + (v[j].z * v[j].z + v[j].w * v[j].w);
    const float rstd = rsqrtf(wave_sum(s) * (1.f / DM) + EPS);
    v2u* o8 = (v2u*)orow + lane;
#pragma unroll
    for (int j = 0; j < 4; ++j) { v2u w; w.x = pk2(v[j].x * rstd, v[j].y * rstd); w.y = pk2(v[j].z * rstd, v[j].w * rstd); o8[64 * j] = w; }
}
__device__ __forceinline__ void p_prologue(Ctx& C) {
    LAS JobTab* J = (LAS JobTab*)(C.lds + 73728);
    unsigned char* ws = C.ws;
    if (C.tid == 0) {
        J->njobs = 0; J->istart[0] = 0;
        for (int l = 0; l < 2; ++l) add_job(J, C.inp(I_HWIN) + (size_t)l * 1024 * 4096, C.inp(I_NMIX) + l * 1024, (bf16*)(ws + W_HIN) + (size_t)l * 4096 * 1024, 1024, 4096, 4096, 0, 0);
        for (int l = 0; l < 2; ++l) add_job(J, C.inp(I_HWOUT) + (size_t)l * 1024 * 1024, nullptr, (bf16*)(ws + W_HOUT) + (size_t)l * 1024 * 1024, 1024, 1024, 1024, 0, 0);
        add_job(J, C.inp(I_KVW), C.inp(I_KVN), (bf16*)(ws + W_KVQ), 1024, 1536, 1536, 0, 0, pg8::FP8_SW1);
        add_job(J, C.inp(I_NWIN), C.inp(I_NMIX) + 2048, (bf16*)(ws + W_KVQ), 1024, 1072, 1280, 0, 1536, pg8::FP8_SW1);
        add_job(J, C.inp(I_NWIN) + (size_t)1024 * 1072, C.inp(I_NMIX) + 3072, (bf16*)(ws + W_Q3), 1024, 1072, 1280, 0, 0, pg8::FP8_SW1);
        add_job(J, C.inp(I_CW1K), nullptr, (bf16*)(ws + W_CMP1), 2048, 256, 256, 0, 0);
        add_job(J, C.inp(I_CW1V), nullptr, (bf16*)(ws + W_CMP1) + (size_t)256 * 2048, 2048, 256, 256, 0, 0);
        for (int l = 0; l < 2; ++l) add_job(J, C.inp(I_NWOUT) + (size_t)l * 1024 * 1024, nullptr, (bf16*)(ws + W_NOUT) + (size_t)l * 1024 * 1024, 1024, 1024, 1024, 0, 0, pg8::FP8_SW1);
        for (int l = 0; l < 2; ++l) add_job(J, C.inp(I_FGU) + (size_t)l * 1024 * 2 * DFF, C.inp(I_NFFN) + (2 * l) * 1024, (bf16*)(ws + W_FGU + (size_t)l * 2 * DFF * 2048), 1024, 2 * DFF, 2 * DFF, DFF, 0, l ? pg8::FP8_SW1 : 0.f);
        for (int l = 0; l < 2; ++l) add_job(J, C.inp(I_FDN) + (size_t)l * DFF * 1024, nullptr, (bf16*)(ws + W_FDN + (size_t)l * 1024 * DFF * 2), DFF, 1024, 1024, 0, 0, l ? pg8::FP8_SW2 : 0.f);
        for (int l = 0; l < 16; ++l) add_job(J, C.inp(I_MGU) + (size_t)l * 1024 * 2 * DFE, C.inp(I_NFFN) + (2 * (l >> 3) + 1) * 1024, (bf16*)(ws + W_MGU + (size_t)l * 2 * DFE * 1024), 1024, 2 * DFE, 2 * DFE, DFE, 0, pg8::FP8_SW1);
        for (int l = 0; l < 16; ++l) add_job(J, C.inp(I_MDN) + (size_t)l * DFE * 1024, nullptr, (bf16*)(ws + W_MDN + (size_t)l * 1024 * DFE), DFE, 1024, 1024, 0, 0, pg8::FP8_SW2);
    }
    __syncthreads();
    LAS float* scr = (LAS float*)(C.lds + C.wave * 9216);
    const int gw = C.bid * NWAVES + C.wave, NGW = C.G * NWAVES;
    const int nj = J->njobs, total = J->istart[nj];
#define TR_SETUP(it_, P) do { int j = 0; while (j + 1 < nj && J->istart[j + 1] <= (it_)) ++j; \
        const int r = (it_) - J->istart[j], npb = J->npb[j], kb = r / npb, nb = r % npb, n0 = 32 * nb, F = J->F[j]; \
        int drow = J->rowoff[j] + n0; \
        if (F) drow = (n0 < F) ? 256 * (n0 / 128) + (n0 % 128) : 256 * ((n0 - F) / 128) + 128 + ((n0 - F) % 128); \
        P.W = (const float*)J->src[j]; P.gain = (const float*)J->gain[j]; P.WT = (bf16*)J->dst[j]; P.K = J->K[j]; P.Nsrc = J->Nsrc[j]; P.drow = drow; P.k0 = 64 * kb; P.n0 = n0; P.f8s = J->f8s[j]; } while (0)
    {
        TrItem pa, pb; f32x4 va[8], vb[8]; int it = gw;
        if (it < total) { TR_SETUP(it, pa); tr_load(pa, va, C.lane); }
        while (it < total) {
            int itn = it + NGW; bool hn = itn < total;
            if (hn) { TR_SETUP(itn, pb); tr_load(pb, vb, C.lane); }
            tr_finish(pa, va, scr, C.lane);
            if (!hn) break;
            it = itn; itn = it + NGW; hn = itn < total;
            if (hn) { TR_SETUP(itn, pa); tr_load(pa, va, C.lane); }
            tr_finish(pb, vb, scr, C.lane);
            if (!hn) break;
            it = itn; }
    }
#undef TR_SETUP
    { const int gt = C.bid * 512 + C.tid;
      if (gt < 1024) { const float a0 = C.inp(I_HLB)[gt], a1 = C.inp(I_HLB)[1024 + gt]; const float mx = fmaxf(a0, a1), e0 = expf(a0 - mx), e1 = expf(a1 - mx), s = e0 + e1;
          const float s0 = e0 / s, s1 = e1 / s, lb1 = (s0 + s1) - s0;
          float* la = (float*)(ws + WS_LA); float* l1 = (float*)(ws + WS_L1);
          la[gt] = 0.f; l1[gt] = 1.f; la[1024 + gt] = lb1; l1[1024 + gt] = 1.f - lb1; } }
    if (C.bid == 0 && C.tid < 128) ((int*)(ws + WS_RTAB))[2048 + C.tid] = C.tid >> 6;
    if (C.G >= 8 && C.bid >= C.G - 8) { const int ob = (C.bid - (C.G - 8)) * 64 + C.lane, which = ob >> 8, j = ob & 255; const float* pos = C.inp(which ? I_CPV : I_CPK); const float* w1 = C.inp(which ? I_CW1V : I_CW1K);
        float a = 0.f;
#pragma unroll 8
        for (int i = C.wave * 256; i < C.wave * 256 + 256; ++i) a += pos[i] * w1[(size_t)i * 256 + j];
        __syncthreads();
        LAS float* red = (LAS float*)(C.lds + 80 * 1024); red[C.wave * 64 + C.lane] = a;
        __syncthreads();
        if (C.wave == 0) { float t = 0.f;
#pragma unroll
            for (int w = 0; w < 8; ++w) t += red[w * 64 + C.lane];
            ((float*)(ws + WS_CB))[ob] = t; } }
    for (int c = C.bid; c < 256; c += C.G)
        for (int i = 0; i < 32; i += 4) { f32x4 v[4][4]; const float* xb = C.inp(I_X);
#pragma unroll
            for (int r = 0; r < 4; ++r) { const f32x4* xr = (const f32x4*)(xb + (size_t)(c * 256 + C.wave * 32 + i + r) * DM) + C.lane;
#pragma unroll
                for (int j = 0; j < 4; ++j) v[r][j] = xr[64 * j]; }
#pragma unroll
            for (int r = 0; r < 4; ++r) norm_row_store(v[r], (bf16*)(ws + WS_XN) + (size_t)(c * 256 + C.wave * 32 + i + r) * DM, C.lane); }
}

#define DPP_ADD(v, ctrl) ((v) + __builtin_bit_cast(float, __builtin_amdgcn_update_dpp(0, __builtin_bit_cast(int, (v)), (ctrl), 0xf, 0xf, true)))
__device__ __forceinline__ float wave_sum_fast(float v) {
    v = DPP_ADD(v, 0xB1);  v = DPP_ADD(v, 0x4E);
    v = DPP_ADD(v, 0x141); v = DPP_ADD(v, 0x140);
    float t;
    asm volatile("v_mov_b32 %1, %0\n\ts_nop 1\n\tv_permlane16_swap_b32 %0, %1\n\ts_nop 1\n\tv_add_f32 %0, %0, %1\n\tv_mov_b32 %1, %0\n\ts_nop 1\n\tv_permlane32_swap_b32 %0, %1\n\ts_nop 1\n\tv_add_f32 %0, %0, %1" : "+v"(v), "=&v"(t));
    return v;
}
__device__ __forceinline__ unsigned pk4_fp8_nc(float a, float b, float c, float d) {
    int w = __builtin_amdgcn_cvt_pk_fp8_f32(a, b, 0, false); w = __builtin_amdgcn_cvt_pk_fp8_f32(c, d, w, true); return (unsigned)w; }

template <bool MOE_ADD, bool ROUTER, bool WRITE_XN, bool XN_FP8>
__device__ __forceinline__ void norm_one_row(Ctx& C, const v4u (&raw)[2], const v4u (&ya)[2], const v4u (&yb)[2], const float p, const float q, const int row, const LAS f32x4* wl, LAS int* cnt8) {
    unsigned char* ws = C.ws;
    constexpr bool FINAL = MOE_ADD && !WRITE_XN;
    f32x4 v[4];
#pragma unroll
    for (int j2 = 0; j2 < 2; ++j2) { const v4u w = raw[j2];
        v[2 * j2] = (f32x4){bflo(w.x), bfhi(w.x), bflo(w.y), bfhi(w.y)}; v[2 * j2 + 1] = (f32x4){bflo(w.z), bfhi(w.z), bflo(w.w), bfhi(w.w)}; }
    if (MOE_ADD) {
#pragma unroll
        for (int j2 = 0; j2 < 2; ++j2) { const v4u a = ya[j2], b = yb[j2];
            v[2 * j2] += (f32x4){p * bflo(a.x) + q * bflo(b.x), p * bfhi(a.x) + q * bfhi(b.x), p * bflo(a.y) + q * bflo(b.y), p * bfhi(a.y) + q * bfhi(b.y)};
            v[2 * j2 + 1] += (f32x4){p * bflo(a.z) + q * bflo(b.z), p * bfhi(a.z) + q * bfhi(b.z), p * bflo(a.w) + q * bflo(b.w), p * bfhi(a.w) + q * bfhi(b.w)};
            if (FINAL) { f32x4* o = (f32x4*)(C.out + (size_t)row * DM + 8 * C.lane + 512 * j2); o[0] = v[2 * j2]; o[1] = v[2 * j2 + 1]; }
            else { v4u o; o.x = pg8::cvt_pk_bf16(v[2 * j2].x, v[2 * j2].y); o.y = pg8::cvt_pk_bf16(v[2 * j2].z, v[2 * j2].w); o.z = pg8::cvt_pk_bf16(v[2 * j2 + 1].x, v[2 * j2 + 1].y); o.w = pg8::cvt_pk_bf16(v[2 * j2 + 1].z, v[2 * j2 + 1].w);
                ((v4u*)(ws + WS_XR + (size_t)row * (DM * 2)) + C.lane)[64 * j2] = o; } }
    }
    if (WRITE_XN || ROUTER) {
        float s = 0.f;
#pragma unroll
        for (int j = 0; j < 4; ++j) s += (v[j].x * v[j].x + v[j].y * v[j].y) + (v[j].z * v[j].z + v[j].w * v[j].w);
        const float rstd = rsqrtf(wave_sum_fast(s) * (1.f / DM) + EPS);
        if (WRITE_XN && XN_FP8) { v2u* o8 = (v2u*)(ws + WS_XN + (size_t)row * DM) + C.lane;
#pragma unroll
            for (int j2 = 0; j2 < 2; ++j2) { v2u w; w.x = pk4_fp8_nc(v[2 * j2].x * rstd, v[2 * j2].y * rstd, v[2 * j2].z * rstd, v[2 * j2].w * rstd);
                w.y = pk4_fp8_nc(v[2 * j2 + 1].x * rstd, v[2 * j2 + 1].y * rstd, v[2 * j2 + 1].z * rstd, v[2 * j2 + 1].w * rstd); o8[64 * j2] = w; } }
        if (WRITE_XN && !XN_FP8) { v4u* o16 = (v4u*)((bf16*)(ws + WS_XN) + (size_t)row * DM) + C.lane;
#pragma unroll
            for (int j2 = 0; j2 < 2; ++j2) { v4u w; w.x = pg8::cvt_pk_bf16(v[2 * j2].x * rstd, v[2 * j2].y * rstd); w.y = pg8::cvt_pk_bf16(v[2 * j2].z * rstd, v[2 * j2].w * rstd);
                w.z = pg8::cvt_pk_bf16(v[2 * j2 + 1].x * rstd, v[2 * j2 + 1].y * rstd); w.w = pg8::cvt_pk_bf16(v[2 * j2 + 1].z * rstd, v[2 * j2 + 1].w * rstd); o16[64 * j2] = w; } }
        if (ROUTER) {
            float a8[8];
#pragma unroll
            for (int e = 0; e < 8; ++e) a8[e] = 0.f;
#pragma unroll
            for (int j = 0; j < 4; ++j)
#pragma unroll
                for (int qq = 0; qq < 4; ++qq) { const int cc = 4 * j + qq; const float xv = v[j][qq] * rstd; const f32x4 wa = wl[(cc * 2) * 64 + C.lane], wb = wl[(cc * 2 + 1) * 64 + C.lane];
                    a8[0] += xv * wa.x; a8[1] += xv * wa.y; a8[2] += xv * wa.z; a8[3] += xv * wa.w; a8[4] += xv * wb.x; a8[5] += xv * wb.y; a8[6] += xv * wb.z; a8[7] += xv * wb.w; }
#pragma unroll
            for (int e = 0; e < 4; ++e) asm volatile("s_nop 1\n\tv_permlane32_swap_b32 %0, %1\n\ts_nop 1\n\tv_add_f32 %0, %0, %1" : "+v"(a8[e]), "+v"(a8[e + 4]));
#pragma unroll
            for (int e = 0; e < 2; ++e) asm volatile("s_nop 1\n\tv_permlane16_swap_b32 %0, %1\n\ts_nop 1\n\tv_add_f32 %0, %0, %1" : "+v"(a8[e]), "+v"(a8[e + 2]));
#pragma unroll
            for (int e = 0; e < 2; ++e) { float t = a8[e]; t = DPP_ADD(t, 0xB1); t = DPP_ADD(t, 0x4E); t = DPP_ADD(t, 0x141); t = DPP_ADD(t, 0x140); a8[e] = t; }
            float lg[8];
#pragma unroll
            for (int e = 0; e < 8; ++e) lg[e] = __builtin_bit_cast(float, __builtin_amdgcn_readlane(__builtin_bit_cast(int, a8[e & 1]), 16 * (((e >> 1) & 1) + 2 * (e >> 2))));
            int e0 = 0; float v0 = lg[0];
#pragma unroll
            for (int e = 1; e < 8; ++e) if (lg[e] > v0) { v0 = lg[e]; e0 = e; }
            int e1 = -1; float v1 = -INFINITY;
#pragma unroll
            for (int e = 0; e < 8; ++e) if (e != e0 && (e1 < 0 || lg[e] > v1)) { v1 = lg[e]; e1 = e; }
            const float ex = expf(v1 - v0), w0_ = 1.f / (1.f + ex), w1_ = ex / (1.f + ex);
            if (C.lane == 0) { ((int4*)(ws + WS_ROUTE))[row] = make_int4(e0 | (e1 << 8), __builtin_bit_cast(int, w0_), __builtin_bit_cast(int, w1_), 0);
                atomicAdd((int*)&cnt8[e0], 1); atomicAdd((int*)&cnt8[e1], 1); }
        }
    }
}

template <bool MOE_ADD, bool ROUTER, bool WRITE_XN, bool XN_FP8 = false>
__device__ __forceinline__ void p_norm(Ctx& C, const float* rw, const float* rgain) {
    unsigned char* ws = C.ws;
    LAS int* cnt8 = (LAS int*)(C.lds + 1024);
    const bf16* Y = (const bf16*)(ws + R_XP);
    constexpr int NB = MOE_ADD ? 2 : 4;
    const LAS f32x4* wl = (const LAS f32x4*)(C.lds + 2048);
    if (ROUTER) { LAS f32x4* wst = (LAS f32x4*)(C.lds + 2048);
        for (int idx = C.tid; idx < 2048; idx += 512) { const int cc = idx >> 7, h = (idx >> 6) & 1, l = idx & 63, k = 8 * l + 512 * (cc >> 3) + (cc & 7);
            wst[idx] = *(const f32x4*)(rw + (size_t)k * 8 + 4 * h) * rgain[k]; }
        __syncthreads(); }
    for (int c = C.bid; c < 256; c += C.G) {
        if (ROUTER) { __syncthreads(); if (C.tid < 8) cnt8[C.tid] = 0; __syncthreads(); }
        const int row0 = c * 256 + C.wave * 32;
        int sx = 0, sy = 0, pw = 0, qw = 0;
        if (MOE_ADD) { const int rr = row0 + (C.lane & 31); const int4 rt = ((const int4*)(ws + WS_ROUTE))[rr]; const int2 sl = ((const int2*)(ws + WS_SLOT))[rr]; sx = sl.x; sy = sl.y; pw = rt.y; qw = rt.z; }
        v4u raw[2][NB][2], ya[2][MOE_ADD ? NB : 1][2], yb[2][MOE_ADD ? NB : 1][2];
#define NLOAD(b, i0) do { _Pragma("unroll") for (int r = 0; r < NB; ++r) { const v4u* hr = (const v4u*)(ws + WS_XR + (size_t)(row0 + (i0) + r) * (DM * 2)) + C.lane; \
            _Pragma("unroll") for (int j2 = 0; j2 < 2; ++j2) raw[b][r][j2] = __builtin_nontemporal_load(hr + 64 * j2); \
            if (MOE_ADD) { const v4u* y0 = (const v4u*)(Y + (size_t)__builtin_amdgcn_readlane(sx, (i0) + r) * DM) + C.lane; const v4u* y1 = (const v4u*)(Y + (size_t)__builtin_amdgcn_readlane(sy, (i0) + r) * DM) + C.lane; \
                _Pragma("unroll") for (int j2 = 0; j2 < 2; ++j2) { ya[b][r][j2] = y0[64 * j2]; yb[b][r][j2] = y1[64 * j2]; } } } } while (0)
#define NPROC(b, i0) do { _Pragma("unroll") for (int r = 0; r < NB; ++r) { \
            const float p_ = MOE_ADD ? __builtin_bit_cast(float, __builtin_amdgcn_readlane(pw, (i0) + r)) : 0.f, q_ = MOE_ADD ? __builtin_bit_cast(float, __builtin_amdgcn_readlane(qw, (i0) + r)) : 0.f; \
            norm_one_row<MOE_ADD, ROUTER, WRITE_XN, XN_FP8>(C, raw[b][r], ya[b][MOE_ADD ? r : 0], yb[b][MOE_ADD ? r : 0], p_, q_, row0 + (i0) + r, wl, cnt8); } } while (0)
        NLOAD(0, 0);
#pragma unroll 1
        for (int i = 0; i < 32; i += 2 * NB) {
            NLOAD(1, i + NB);
            NPROC(0, i);
            if (i + 2 * NB < 32) NLOAD(0, i + 2 * NB);
            NPROC(1, i + NB);
        }
#undef NLOAD
#undef NPROC
        if (ROUTER) { __syncthreads(); if (C.tid < 8) ((int*)(ws + WS_RCNT))[c * 8 + C.tid] = cnt8[C.tid]; }
    }
}

__device__ __forceinline__ void p_gather(Ctx& C) {
    unsigned char* ws = C.ws;
    LAS int* tot = (LAS int*)(C.lds + 0);
    LAS int* pre = tot + 8;
    LAS int* base = tot + 16;
    LAS int* ee = tot + 32;
    LAS int* sl = tot + 32 + 256;
    const int* rcnt = (const int*)(ws + WS_RCNT);
    const int4* route = (const int4*)(ws + WS_ROUTE);
    for (int c = C.bid; c < 256; c += C.G) {
        __syncthreads();
        { const int e = C.wave; int t = 0, p = 0;
          for (int i = C.lane; i < 256; i += 64) { const int v = rcnt[i * 8 + e]; t += v; if (i < c) p += v; }
#pragma unroll
          for (int o = 32; o >= 1; o >>= 1) { t += __shfl_xor(t, o); p += __shfl_xor(p, o); }
          if (C.lane == 0) { tot[e] = t; pre[e] = p; } }
        if (C.tid < 256) ee[C.tid] = route[c * 256 + C.tid].x;
        __syncthreads();
        if (C.tid == 0) { int off = 0; for (int e = 0; e < 8; ++e) { base[e] = off + pre[e]; const int nt = (tot[e] + 255) >> 8;
                if (c == 0) { int* te = (int*)(ws + WS_RTAB); for (int q = 0; q < nt; ++q) te[(off >> 8) + q] = e; }
                off += nt << 8; }
            if (c == 0) ((int*)(ws + WS_RTAB))[1024] = off >> 8; }
        __syncthreads();
        { const int e = C.wave; int run = base[e];
#pragma unroll
          for (int blk = 0; blk < 4; ++blk) { const int i = blk * 64 + C.lane; const int pk = ee[i]; const bool m0 = (pk & 255) == e, m1 = (pk >> 8) == e;
              const unsigned long long bal = __ballot(m0 || m1); const int rank = __popcll(bal & ((1ull << C.lane) - 1ull));
              if (m0) sl[2 * i] = run + rank; if (m1) sl[2 * i + 1] = run + rank;
              run += __popcll(bal); } }
        __syncthreads();
        if (C.tid < 256) ((int2*)(ws + WS_SLOT))[c * 256 + C.tid] = make_int2(sl[2 * C.tid], sl[2 * C.tid + 1]);
        for (int i = 0; i < 32; i += 4) { v4u a[4];
#pragma unroll
            for (int r = 0; r < 4; ++r) a[r] = *((const v4u*)(ws + WS_XN + (size_t)(c * 256 + C.wave * 32 + i + r) * DM) + C.lane);
#pragma unroll
            for (int r = 0; r < 4; ++r) { const int tl = C.wave * 32 + i + r;
                *((v4u*)(ws + R_XP + (size_t)sl[2 * tl] * DM) + C.lane) = a[r]; *((v4u*)(ws + R_XP + (size_t)sl[2 * tl + 1] * DM) + C.lane) = a[r]; } }
    }
}

template <int JLO, int JHI>
__device__ __forceinline__ void p_post_kv(Ctx& C, const int gw, const int NGW) {
    unsigned char* ws = C.ws;
    const bf16* raw = (const bf16*)(ws + R_QKV);
    const float* kn = C.inp(I_KN);
    LAS unsigned char* tl = C.lds + C.wave * 4608;
    const int l = C.lane, c8 = l & 7, r8 = l >> 3;
    for (int it = gw; it < 128 * 64; it += NGW) {
        const int bg = it >> 6, blk = it & 63, b = bg >> 2, g = bg & 3;
        const bf16* rb = raw + (size_t)(b * SEQ + blk * 32) * 2816 + g * 64 + 8 * c8;
        const size_t dst0 = ((size_t)bg * SEQ + blk * 32) * 64 + 8 * c8;
        v4u xall[6][4];
#pragma unroll
        for (int j = JLO; j < JHI; ++j)
#pragma unroll
            for (int i = 0; i < 4; ++i) xall[j][i] = *(const v4u*)(rb + (size_t)(r8 + 8 * i) * 2816 + j * 256);
#pragma unroll
        for (int j = JLO; j < JHI; ++j) {
            const v4u (&x)[4] = xall[j];
            if (j == 0 || j == 1) {
                bf16* d = (bf16*)(ws + (j == 0 ? R_KCR : R_VCR)) + dst0;
#pragma unroll
                for (int i = 0; i < 4; ++i) *(v4u*)(d + (size_t)(r8 + 8 * i) * 64) = x[i];
            } else if (j == 2 || j == 4) {
                unsigned char* d = ws + (j == 2 ? R_KS : R_KW) + ((size_t)bg * SEQ + blk * 32) * 64 + (c8 >> 2) * 1024 + (c8 & 3) * 8; const float* gk = kn + (j == 2 ? 64 : 128) + 8 * c8;
                const f32x4 ga = *(const f32x4*)gk, gb = *(const f32x4*)(gk + 4);
#pragma unroll
                for (int i = 0; i < 4; ++i) { const float f[8] = {bflo(x[i].x), bfhi(x[i].x), bflo(x[i].y), bfhi(x[i].y), bflo(x[i].z), bfhi(x[i].z), bflo(x[i].w), bfhi(x[i].w)};
                    float ss = (f[0] * f[0] + f[1] * f[1]) + (f[2] * f[2] + f[3] * f[3]) + (f[4] * f[4] + f[5] * f[5]) + (f[6] * f[6] + f[7] * f[7]);
                    ss += __shfl_xor(ss, 1); ss += __shfl_xor(ss, 2); ss += __shfl_xor(ss, 4);
                    const float rs = rsqrtf(ss * (1.f / 64.f) + EPS);
                    v2u o; o.x = pg8::pk4_fp8(f[0] * rs * ga.x, f[1] * rs * ga.y, f[2] * rs * ga.z, f[3] * rs * ga.w); o.y = pg8::pk4_fp8(f[4] * rs * gb.x, f[5] * rs * gb.y, f[6] * rs * gb.z, f[7] * rs * gb.w);
                    *(v2u*)(d + (size_t)(r8 + 8 * i) * 32) = o; }
            } else {
#pragma unroll
                for (int i = 0; i < 4; ++i) *(LAS v4u*)(tl + (r8 + 8 * i) * 144 + 16 * c8) = x[i];
                LDS_WAIT();
                unsigned wv[8];
#pragma unroll
                for (int t4 = 0; t4 < 8; ++t4) { const float a0 = bf2f(*(const LAS bf16*)(tl + (4 * t4) * 144 + 2 * l)), a1 = bf2f(*(const LAS bf16*)(tl + (4 * t4 + 1) * 144 + 2 * l)),
                                                             a2 = bf2f(*(const LAS bf16*)(tl + (4 * t4 + 2) * 144 + 2 * l)), a3 = bf2f(*(const LAS bf16*)(tl + (4 * t4 + 3) * 144 + 2 * l)); wv[t4] = pg8::pk4_fp8(a0, a1, a2, a3); }
                unsigned char* d = ws + (j == 3 ? R_VST : R_VWT) + (((size_t)bg * 64 + blk) * 64 + l) * 32;
#pragma unroll
                for (int q = 0; q < 2; ++q) { const v4u o = {wv[4 * q], wv[4 * q + 1], wv[4 * q + 2], wv[4 * q + 3]}; *(v4u*)(d + 16 * q) = o; }
                LDS_WAIT();
            }
        }
    }
}

__device__ __forceinline__ void p_cmp2(Ctx& C) {
    unsigned char* ws = C.ws;
    const bf16* Hk = (const bf16*)(ws + WS_HC); const bf16* Hv = Hk + (size_t)16384 * 256;
    const float* w2k = C.inp(I_CW2K); const float* w2v = C.inp(I_CW2V); const float* kn = C.inp(I_KN);
    constexpr int RW = 4;
    LAS float* hk = (LAS float*)(C.lds + C.wave * (RW * 2048)); LAS float* hv = hk + RW * 256;
    const int l = C.lane, gw = C.bid * NWAVES + C.wave, NGW = C.G * NWAVES;
    for (int r0 = gw * RW; r0 < 16384; r0 += NGW * RW) {
#pragma unroll
        for (int q = 0; q < RW; ++q) { const v2u a = *((const v2u*)(Hk + (size_t)(r0 + q) * 256) + l), bq = *((const v2u*)(Hv + (size_t)(r0 + q) * 256) + l);
            *(LAS f32x4*)(hk + q * 256 + 4 * l) = (f32x4){bflo(a.x), bfhi(a.x), bflo(a.y), bfhi(a.y)}; *(LAS f32x4*)(hv + q * 256 + 4 * l) = (f32x4){bflo(bq.x), bfhi(bq.x), bflo(bq.y), bfhi(bq.y)}; }
        LDS_WAIT();
        float ak[RW], av[RW];
#pragma unroll
        for (int q = 0; q < RW; ++q) { ak[q] = 0.f; av[q] = 0.f; }
#pragma unroll 2
        for (int j = 0; j < 256; j += 4) { float wk[4], wv[4];
#pragma unroll
            for (int i = 0; i < 4; ++i) { wk[i] = w2k[(j + i) * 64 + l]; wv[i] = w2v[(j + i) * 64 + l]; }
#pragma unroll
            for (int q = 0; q < RW; ++q) { const f32x4 xk = *(const LAS f32x4*)(hk + q * 256 + j), xv = *(const LAS f32x4*)(hv + q * 256 + j);
                ak[q] += xk.x * wk[0]; ak[q] += xk.y * wk[1]; ak[q] += xk.z * wk[2]; ak[q] += xk.w * wk[3]; av[q] += xv.x * wv[0]; av[q] += xv.y * wv[1]; av[q] += xv.z * wv[2]; av[q] += xv.w * wv[3]; } }
        const float knl = kn[l];
#pragma unroll
        for (int q = 0; q < RW; ++q) { const int r = r0 + q, bg = r >> 7, c = r & 127;
            float a = ak[q], v = av[q];
            if (c == 127) { a = 0.f; v = 0.f; }
            const float rs = rsqrtf(wave_sum(a * a) * (1.f / 64.f) + EPS);
            ((bf16*)(ws + WS_KC))[((size_t)bg * 128 + 32 * (c >> 5)) * 64 + (l >> 5) * 1024 + (c & 31) * 32 + (l & 31)] = (bf16)f2bf(a * rs * knl);
            ((bf16*)(ws + WS_VCT))[(((size_t)bg * 4 + (c >> 5)) * 64 + l) * 32 + (c & 31)] = (bf16)f2bf(v); }
        LDS_WAIT();
    }
}

typedef short bf16x8v __attribute__((ext_vector_type(8)));
#define MFMA16(a, b, c) __builtin_amdgcn_mfma_f32_16x16x32_bf16((a), (b), (c), 0, 0, 0)
constexpr float LOG2E = 1.4426950408889634f;
__device__ __forceinline__ float xmax_q4(float v) {
    float t;
    asm volatile("v_mov_b32 %1, %0\n\ts_nop 1\n\tv_permlane16_swap_b32 %0, %1\n\ts_nop 1\n\tv_max_f32 %0, %0, %1\n\tv_mov_b32 %1, %0\n\ts_nop 1\n\tv_permlane32_swap_b32 %0, %1\n\ts_nop 1\n\tv_max_f32 %0, %0, %1" : "+v"(v), "=&v"(t));
    return v;
}
#define XQ4_ASM(op) "v_mov_b32 %1, %0\n\ts_nop 1\n\tv_permlane16_swap_b32 %0, %1\n\ts_nop 1\n\t" op " %0, %0, %1\n\tv_mov_b32 %1, %0\n\ts_nop 1\n\tv_permlane32_swap_b32 %0, %1\n\ts_nop 1\n\t" op " %0, %0, %1"
__device__ __forceinline__ float xsum_q4(float v) { float t; asm volatile(XQ4_ASM("v_add_f32") : "+v"(v), "=&v"(t)); return v; }
__device__ __forceinline__ unsigned xor_q4(unsigned v) { unsigned t; asm volatile(XQ4_ASM("v_or_b32") : "+v"(v), "=&v"(t)); return v; }
__device__ __forceinline__ unsigned xpart16(unsigned v, int q4) { unsigned a = v, b; asm volatile("v_mov_b32 %1, %0\n\ts_nop 1\n\tv_permlane16_swap_b32 %0, %1\n\ts_nop 1" : "+v"(a), "=&v"(b)); return (q4 & 1) ? a : b; }
__device__ __forceinline__ unsigned xpart32(unsigned v, int q4) { unsigned a = v, b; asm volatile("v_mov_b32 %1, %0\n\ts_nop 1\n\tv_permlane32_swap_b32 %0, %1\n\ts_nop 1" : "+v"(a), "=&v"(b)); return (q4 & 2) ? a : b; }
__device__ __forceinline__ unsigned xor_r16(unsigned v) {
    v |= (unsigned)__builtin_amdgcn_ds_swizzle((int)v, (1 << 10) | 0x1f); v |= (unsigned)__builtin_amdgcn_ds_swizzle((int)v, (2 << 10) | 0x1f);
    v |= (unsigned)__builtin_amdgcn_ds_swizzle((int)v, (4 << 10) | 0x1f); v |= (unsigned)__builtin_amdgcn_ds_swizzle((int)v, (8 << 10) | 0x1f); return v; }
__device__ __forceinline__ f32x4 att_mma(bf16x8v a, bf16x8v b, f32x4 c) { return __builtin_amdgcn_mfma_f32_16x16x32_bf16(a, b, c, 0, 0, 0); }
__device__ __forceinline__ f32x4 att_mma(long a, long b, f32x4 c) { return __builtin_amdgcn_mfma_f32_16x16x32_fp8_fp8(a, b, c, 0, 0, 0); }
__device__ __forceinline__ float fmax2(float a, float b) { return __builtin_amdgcn_fmed3f(a, b, INFINITY); }
__device__ __forceinline__ void att_pack(bf16x8v& pf, const float (&p)[8], bool keep) {
    unsigned w0 = pg8::cvt_pk_bf16(p[0], p[1]), w1 = pg8::cvt_pk_bf16(p[2], p[3]), w2 = pg8::cvt_pk_bf16(p[4], p[5]), w3 = pg8::cvt_pk_bf16(p[6], p[7]);
    if (!keep) { w0 = 0u; w1 = 0u; w2 = 0u; w3 = 0u; }
    const v4u w = {w0, w1, w2, w3}; pf = __builtin_bit_cast(bf16x8v, w); }
__device__ __forceinline__ unsigned pk4_fp8_raw(float a, float b, float c, float d) { int w = __builtin_amdgcn_cvt_pk_fp8_f32(a, b, 0, false); w = __builtin_amdgcn_cvt_pk_fp8_f32(c, d, w, true); return (unsigned)w; }
__device__ __forceinline__ void att_pack(long& pf, const float (&p)[8], bool keep) {
    unsigned w0 = pk4_fp8_raw(p[0], p[1], p[2], p[3]), w1 = pk4_fp8_raw(p[4], p[5], p[6], p[7]);
    if (!keep) { w0 = 0u; w1 = 0u; }
    const v2u w = {w0, w1}; pf = __builtin_bit_cast(long, w); }
template <class FR> struct AttKV { FR ka[2], kb[2], vf[4]; };
template <class FR, bool NOPV>
__device__ __forceinline__ void attn_kv_load(AttKV<FR>& f, const void* __restrict__ Kb, unsigned koff, const void* __restrict__ Vb, unsigned voff, int k0) {
    constexpr int SH = sizeof(FR) == 16 ? 0 : 1;
    const char* kblk = (const char*)Kb + (((size_t)k0 * 128) >> SH); const char* vblk = (const char*)Vb + (((size_t)k0 * 128) >> SH);
#pragma unroll
    for (int ks = 0; ks < 2; ++ks) { f.ka[ks] = *(const FR*)(kblk + koff + ((2048 * ks) >> SH)); f.kb[ks] = *(const FR*)(kblk + koff + ((256 + 2048 * ks) >> SH)); }
    if (!NOPV) {
#pragma unroll
        for (int dt = 0; dt < 4; ++dt) f.vf[dt] = *(const FR*)(vblk + voff + ((1024 * dt) >> SH)); }
}
template <int MODE, int PATH, class FR, bool NOPV = false, bool FAST = false>
__device__ __forceinline__ void attn_step(const AttKV<FR>& f, int k0, int trel, bool tk, int cmax,
                                          const FR (&qf)[2][2], float (&m)[2], float (&ls)[2], f32x4 (&o)[2][4], const float (&sl2)[2], int q4, bool& bad) {
    constexpr int DMUL = (MODE == 0) ? 16 : 1;
    const float trelf = (float)trel;
    const float kb_ = (float)(8 * q4); const f32x4 bv[2] = {(f32x4){kb_, kb_ + 1.f, kb_ + 2.f, kb_ + 3.f}, (f32x4){kb_ + 4.f, kb_ + 5.f, kb_ + 6.f, kb_ + 7.f}};
    bool ok[8];
    if (PATH == 2) {
#pragma unroll
        for (int i = 0; i < 8; ++i) { const int kk = 8 * q4 + i; const int d = trel - DMUL * kk; ok[i] = (MODE == 0) ? (k0 + kk <= cmax) : (MODE == 1 ? (tk && d >= 0) : (d >= 0 && d < 512)); } }
    if constexpr (sizeof(FR) == 16) {
#pragma unroll
    for (int h = 0; h < 2; ++h) {
        f32x4 sa = att_mma(f.ka[0], qf[h][0], bv[0] * ((float)DMUL * sl2[h])), sb = att_mma(f.kb[0], qf[h][0], bv[1] * ((float)DMUL * sl2[h])); sa = att_mma(f.ka[1], qf[h][1], sa); sb = att_mma(f.kb[1], qf[h][1], sb);
        float mref = m[h] + sl2[h] * trelf;
        float mx;
        if (PATH == 2) { mx = -1e30f;
#pragma unroll
            for (int i = 0; i < 8; ++i) { const float v = i < 4 ? sa[i] : sb[i - 4]; mx = ok[i] ? fmaxf(mx, v) : mx; } }
        else { mx = fmaxf(fmaxf(fmaxf(sa[0], sa[1]), fmaxf(sa[2], sa[3])), fmaxf(fmaxf(sb[0], sb[1]), fmaxf(sb[2], sb[3]))); if (PATH == 1) mx = tk ? mx : -1e30f; }
        mx = xmax_q4(mx);
        if (__any(mx > mref + 8.f)) { const float mn = fmaxf(mref, mx), alpha = __builtin_amdgcn_exp2f(mref - mn); m[h] = mn - sl2[h] * trelf; mref = mn; ls[h] *= alpha;
            if (!NOPV) {
#pragma unroll
                for (int dt = 0; dt < 4; ++dt) o[h][dt] = o[h][dt] * alpha; } }
        float p[8]; float psum = 0.f;
#pragma unroll
        for (int i = 0; i < 8; ++i) { const float e = __builtin_amdgcn_exp2f((i < 4 ? sa[i] : sb[i - 4]) - mref); p[i] = (PATH == 2) ? (ok[i] ? e : 0.f) : e; psum += p[i]; }
        if (PATH == 1) psum = tk ? psum : 0.f;
        ls[h] += psum;
        FR pf; att_pack(pf, p, PATH == 1 ? tk : true);
        if (!NOPV) {
#pragma unroll
            for (int dt = 0; dt < 4; ++dt) o[h][dt] = att_mma(f.vf[dt], pf, o[h][dt]); }
    }
    } else {
    f32x4 sa[2], sb[2]; float mref[2], mx[2];
#pragma unroll
    for (int h = 0; h < 2; ++h) { sa[h] = att_mma(f.ka[0], qf[h][0], bv[0] * ((float)DMUL * sl2[h])); sb[h] = att_mma(f.kb[0], qf[h][0], bv[1] * ((float)DMUL * sl2[h])); }
#pragma unroll
    for (int h = 0; h < 2; ++h) { sa[h] = att_mma(f.ka[1], qf[h][1], sa[h]); sb[h] = att_mma(f.kb[1], qf[h][1], sb[h]); }
#pragma unroll
    for (int h = 0; h < 2; ++h) { mref[h] = m[h] + sl2[h] * trelf;
        if (PATH == 4) mref[h] = tk ? mref[h] : INFINITY;
        const f32x4 mr4 = {mref[h], mref[h], mref[h], mref[h]}; sa[h] = sa[h] - mr4; sb[h] = sb[h] - mr4;
        if (PATH == 2) { mx[h] = -1e30f;
#pragma unroll
            for (int i = 0; i < 8; ++i) { const float v = i < 4 ? sa[h][i] : sb[h][i - 4]; mx[h] = ok[i] ? fmaxf(mx[h], v) : mx[h]; } }
        else { mx[h] = fmaxf(fmaxf(fmaxf(sa[h][0], sa[h][1]), fmaxf(sa[h][2], sa[h][3])), fmaxf(fmaxf(sb[h][0], sb[h][1]), fmaxf(sb[h][2], sb[h][3]))); if (PATH == 1) mx[h] = tk ? mx[h] : -1e30f; } }
    if (__any(mx[0] > 8.f || mx[1] > 8.f)) {
        if (FAST) bad = true; else
#pragma unroll
        for (int h = 0; h < 2; ++h) { const float d = fmaxf(xmax_q4(mx[h]), 0.f), alpha = __builtin_amdgcn_exp2f(-d); m[h] += d; ls[h] *= alpha;
            const f32x4 d4 = {d, d, d, d}; sa[h] = sa[h] - d4; sb[h] = sb[h] - d4;
            if (!NOPV) {
#pragma unroll
                for (int dt = 0; dt < 4; ++dt) o[h][dt] = o[h][dt] * alpha; } } }
    FR pf[2];
#pragma unroll
    for (int h = 0; h < 2; ++h) { float p[8]; float psum = 0.f;
#pragma unroll
        for (int i = 0; i < 8; ++i) { const float e = __builtin_amdgcn_exp2f(i < 4 ? sa[h][i] : sb[h][i - 4]); p[i] = (PATH == 2) ? (ok[i] ? e : 0.f) : e; psum += p[i]; }
        if (PATH == 1) psum = tk ? psum : 0.f;
        ls[h] += psum;
        att_pack(pf[h], p, PATH == 1 ? tk : true); }
    if (!NOPV) {
#pragma unroll
        for (int dt = 0; dt < 4; ++dt)
#pragma unroll
            for (int h = 0; h < 2; ++h) o[h][dt] = att_mma(f.vf[dt], pf[h], o[h][dt]); }
    }
}
template <int MODE, int PATH, class FR, bool NOPV = false>
__device__ __forceinline__ void attn_step(const AttKV<FR>& f, int k0, int trel, bool tk, int cmax, const FR (&qf)[2][2], float (&m)[2], float (&ls)[2], f32x4 (&o)[2][4], const float (&sl2)[2], int q4) {
    bool dummy = false; attn_step<MODE, PATH, FR, NOPV, false>(f, k0, trel, tk, cmax, qf, m, ls, o, sl2, q4, dummy); }
constexpr int PSW = 132;
__device__ __forceinline__ void p_attn_fast(Ctx& C, unsigned* queue, const int ld, const int qo, const float* qn) {
    unsigned char* ws = C.ws;
    const bf16* Qraw = (const bf16*)(ws + R_QKV);
    const bf16* KC = (const bf16*)(ws + WS_KC); const bf16* VCT = (const bf16*)(ws + WS_VCT);
    const unsigned char* KS = ws + R_KS; const unsigned char* VST = ws + R_VST; const unsigned char* KW = ws + R_KW; const unsigned char* VWT = ws + R_VWT;
    bf16* O = (bf16*)(ws + R_O);
    LAS float* psl = (LAS float*)(C.lds + C.wave * (16 * PSW * 4));
    int qsel = (int)(xb_xcc_id() & 7u), qtry = 0;
    for (;;) {
        int l = C.lane; asm volatile("" : "+v"(l));
        const int r16 = l & 15, q4 = l >> 4;
        const unsigned koff = (unsigned)((8 * (r16 >> 2) + (r16 & 3)) * 64 + 16 * q4), voff = (unsigned)((r16 * 32 + 8 * q4) * 2);
        unsigned u = 0; if (l == 0) u = __hip_atomic_fetch_add(queue + 64 * qsel, 1u, __ATOMIC_RELAXED, __HIP_MEMORY_SCOPE_AGENT);
        u = (unsigned)__builtin_amdgcn_readfirstlane((int)u);
        if (u >= 2048u) { if (++qtry >= 8) break; qsel = (qsel + 1) & 7; continue; }
        u = ((u >> 7) * 8 + (unsigned)qsel) * 128 + (u & 127);
        const int bg = (int)(u >> 7), tile = 127 - (int)(u & 127), g = bg & 3, b = bg >> 2, t0 = tile * 16, t = t0 + r16, row = b * SEQ + t;
#define qrow (Qraw + (size_t)row * ld + qo)
#define gtp (qrow + 1024 + g * 12)
#define orow ((unsigned char*)O + (size_t)row * DM + g * 256 + 4 * q4)
        bf16x8v qf[2][2]; long qf8[2][2]; float sl2[2]; f32x4 bv[2]; float m[2]; float ls[2]; f32x4 o[2][4];
#define ATT_LOADQ(hp, DM_) do { _Pragma("unroll") for (int i_ = 0; i_ < 4; ++i_) { bv[0][i_] = (float)(8 * q4 + i_); bv[1][i_] = (float)(8 * q4 + 4 + i_); } \
            _Pragma("unroll") for (int h = 0; h < 2; ++h) { sl2[h] = exp2f(-0.5f * (float)(g * 4 + 2 * (hp) + h + 1)) * LOG2E; \
            float xq_[2][8]; float ssq_ = 0.f; \
            _Pragma("unroll") for (int ks = 0; ks < 2; ++ks) { const v4u r_ = *(const v4u*)(qrow + (g * 4 + 2 * (hp) + h) * 64 + 32 * ks + 8 * q4); \
                xq_[ks][0] = bflo(r_.x); xq_[ks][1] = bfhi(r_.x); xq_[ks][2] = bflo(r_.y); xq_[ks][3] = bfhi(r_.y); xq_[ks][4] = bflo(r_.z); xq_[ks][5] = bfhi(r_.z); xq_[ks][6] = bflo(r_.w); xq_[ks][7] = bfhi(r_.w); \
                _Pragma("unroll") for (int j_ = 0; j_ < 8; ++j_) ssq_ += xq_[ks][j_] * xq_[ks][j_]; } \
            ssq_ = xsum_q4(ssq_); \
            const float rq_ = rsqrtf(ssq_ * (1.f / 64.f) + EPS) * (0.125f * LOG2E); \
            _Pragma("unroll") for (int ks = 0; ks < 2; ++ks) { const f32x4 ga_ = *(const f32x4*)(qn + 32 * ks + 8 * q4), gb_ = *(const f32x4*)(qn + 32 * ks + 8 * q4 + 4); \
                const v4u w_ = {pg8::cvt_pk_bf16(xq_[ks][0] * rq_ * ga_.x, xq_[ks][1] * rq_ * ga_.y), pg8::cvt_pk_bf16(xq_[ks][2] * rq_ * ga_.z, xq_[ks][3] * rq_ * ga_.w), \
                                pg8::cvt_pk_bf16(xq_[ks][4] * rq_ * gb_.x, xq_[ks][5] * rq_ * gb_.y), pg8::cvt_pk_bf16(xq_[ks][6] * rq_ * gb_.z, xq_[ks][7] * rq_ * gb_.w)}; \
                qf[h][ks] = __builtin_bit_cast(bf16x8v, w_); \
                const v2u w8_ = {pg8::pk4_fp8(xq_[ks][0] * rq_ * ga_.x, xq_[ks][1] * rq_ * ga_.y, xq_[ks][2] * rq_ * ga_.z, xq_[ks][3] * rq_ * ga_.w), pg8::pk4_fp8(xq_[ks][4] * rq_ * gb_.x, xq_[ks][5] * rq_ * gb_.y, xq_[ks][6] * rq_ * gb_.z, xq_[ks][7] * rq_ * gb_.w)}; \
                qf8[h][ks] = __builtin_bit_cast(long, w8_); } } } while (0)
#define ATT_RESET() do { _Pragma("unroll") for (int h = 0; h < 2; ++h) { m[h] = -1e4f; ls[h] = 0.f; _Pragma("unroll") for (int dt = 0; dt < 4; ++dt) o[h][dt] = (f32x4){0.f, 0.f, 0.f, 0.f}; } } while (0)
        const int cmax = t >= 31 ? (((t - 31) >> 4) < 126 ? ((t - 31) >> 4) : 126) : -1;
        const int cmax0 = t0 >= 31 ? (((t0 - 31) >> 4) < 126 ? ((t0 - 31) >> 4) : 126) : -1;
        const bf16* KCb = KC + (size_t)bg * 128 * 64; const bf16* VCb = VCT + (size_t)bg * 128 * 64;
        const int ncs = ((t0 + 15 - 31) >> 4) < 0 ? 0 : ((((t0 + 15 - 31) >> 4) < 126 ? ((t0 + 15 - 31) >> 4) : 126) >> 5) + 1;
        bf16x8v kfa[4][2], kfb[4][2];
#pragma unroll
        for (int st = 0; st < 4; ++st) { const char* kblk = (const char*)(KCb + (size_t)(32 * st) * 64);
#pragma unroll
            for (int ks = 0; ks < 2; ++ks) { kfa[st][ks] = *(const bf16x8v*)(kblk + koff + 2048 * ks); kfb[st][ks] = *(const bf16x8v*)(kblk + koff + 256 + 2048 * ks); } }
#pragma unroll 1
        for (int hp = 0; hp < 2; ++hp) {
            ATT_LOADQ(hp, 16); ATT_RESET();
#pragma unroll
            for (int st = 3; st >= 0; --st) {
                if (st < ncs) { AttKV<bf16x8v> fc; fc.ka[0] = kfa[st][0]; fc.ka[1] = kfa[st][1]; fc.kb[0] = kfb[st][0]; fc.kb[1] = kfb[st][1];
                    if (32 * st + 31 <= cmax0) attn_step<0, 0, bf16x8v, true>(fc, 32 * st, t - 31 - 16 * 32 * st, true, cmax, qf, m, ls, o, sl2, q4);
                    else attn_step<0, 2, bf16x8v, true>(fc, 32 * st, t - 31 - 16 * 32 * st, true, cmax, qf, m, ls, o, sl2, q4); } }
#pragma unroll
            for (int h = 0; h < 2; ++h) ls[h] = xsum_q4(ls[h]);
            float ps[4][8];
#pragma unroll
            for (int st = 0; st < 4; ++st)
#pragma unroll
                for (int i = 0; i < 8; ++i) ps[st][i] = 0.f;
#pragma unroll
            for (int st = 0; st < 4; ++st) {
                if (st < ncs) {
                    const int k0 = 32 * st;
                    const bf16x8v (&ka)[2] = kfa[st]; const bf16x8v (&kb)[2] = kfb[st];
#pragma unroll
                    for (int h = 0; h < 2; ++h) {
                        f32x4 sa = MFMA16(ka[0], qf[h][0], bv[0] * (16.f * sl2[h])), sb = MFMA16(kb[0], qf[h][0], bv[1] * (16.f * sl2[h])); sa = MFMA16(ka[1], qf[h][1], sa); sb = MFMA16(kb[1], qf[h][1], sb);
                        const float lt = ls[h], inv = lt > 0.f ? 1.f / lt : 0.f, mref = m[h] + sl2[h] * (float)(t - 31 - 16 * k0);
#pragma unroll
                        for (int i = 0; i < 8; ++i) { const int c = k0 + 8 * q4 + i; ps[st][i] += (c <= cmax) ? __builtin_amdgcn_exp2f((i < 4 ? sa[i] : sb[i - 4]) - mref) * inv : 0.f; }
                    }
                }
            }
#pragma unroll
            for (int st = 0; st < 4; ++st) { LAS f32x4* p0 = (LAS f32x4*)(psl + r16 * PSW + 32 * st + 8 * q4);
                f32x4 a = {ps[st][0], ps[st][1], ps[st][2], ps[st][3]}, bq = {ps[st][4], ps[st][5], ps[st][6], ps[st][7]};
                if (hp) { a = a + p0[0]; bq = bq + p0[1]; }
                p0[0] = a; p0[1] = bq; }
            LDS_WAIT();
        }
        unsigned mlo, mhi;
        {
            float sc[16]; const LAS float* pr = psl + r16 * PSW + 32 * q4; const int cur = t >> 5;
            float prev = q4 > 0 ? pr[-1] : 0.f;
#pragma unroll
            for (int jj = 0; jj < 16; ++jj) { const float a = pr[2 * jj], bq = pr[2 * jj + 1]; const float imp = prev + a + bq; prev = bq;
                const int j = 16 * q4 + jj; const bool valid = 32 * j <= t; const bool forced = valid && (j == 0 || j == cur || j == cur - 1);
                sc[jj] = forced ? 1e9f : (valid ? imp : -1e9f); }
            unsigned my = 0u;
#pragma unroll 1
            for (int r = 0; r < 8; ++r) {
                float best = sc[0]; int bi = 0;
#pragma unroll
                for (int jj = 1; jj < 16; ++jj) if (sc[jj] > best) { best = sc[jj]; bi = jj; }
                bi += 16 * q4;
                { const float ov = __builtin_bit_cast(float, xpart16(__builtin_bit_cast(unsigned, best), q4)); const int oi = (int)xpart16((unsigned)bi, q4); if (ov > best || (ov == best && oi < bi)) { best = ov; bi = oi; } }
                { const float ov = __builtin_bit_cast(float, xpart32(__builtin_bit_cast(unsigned, best), q4)); const int oi = (int)xpart32((unsigned)bi, q4); if (ov > best || (ov == best && oi < bi)) { best = ov; bi = oi; } }
                if ((bi >> 4) == q4) { const int jj0 = bi & 15; if (best > -0.5e9f) my |= 1u << jj0;
#pragma unroll
                    for (int jj = 0; jj < 16; ++jj) if (jj == jj0) sc[jj] = -INFINITY; }
            }
            mlo = (q4 == 0 ? my : 0u) | (q4 == 1 ? my << 16 : 0u); mhi = (q4 == 2 ? my : 0u) | (q4 == 3 ? my << 16 : 0u);
            mlo = xor_q4(mlo); mhi = xor_q4(mhi);
        }
        LDS_WAIT();
        unsigned ulo = mlo, uhi = mhi;
        ulo = xor_r16(ulo); uhi = xor_r16(uhi);
        const unsigned long long un0 = ((unsigned long long)(unsigned)__builtin_amdgcn_readfirstlane((int)uhi) << 32) | (unsigned)__builtin_amdgcn_readfirstlane((int)ulo);
        const unsigned long long mine = ((unsigned long long)mhi << 32) | mlo;
#pragma unroll 1
        for (int hp = 0; hp < 2; ++hp) {
            const v2u g6raw = *(const v2u*)(gtp + 6 * hp); const unsigned g6x = gtp[6 * hp + 4], g6y = gtp[6 * hp + 5];
            v2u oacc[2][4];
#define ATT_GLOG(i) ((i) == 0 ? bflo(g6raw.x) : (i) == 1 ? bfhi(g6raw.x) : (i) == 2 ? bflo(g6raw.y) : (i) == 3 ? bfhi(g6raw.y) : (i) == 4 ? bf2f(g6x) : bf2f(g6y))
#define ATT_FOLD(br, first) do { _Pragma("unroll") for (int h = 0; h < 2; ++h) { const float lt = xsum_q4(ls[h]); const float sc_ = lt > 0.f ? (1.f / (1.f + __expf(-ATT_GLOG(h * 3 + (br))))) / lt : 0.f; \
            _Pragma("unroll") for (int dt = 0; dt < 4; ++dt) { f32x4 r_ = o[h][dt] * sc_; \
                if (!(first)) { r_[0] += bflo(oacc[h][dt].x); r_[1] += bfhi(oacc[h][dt].x); r_[2] += bflo(oacc[h][dt].y); r_[3] += bfhi(oacc[h][dt].y); } \
                oacc[h][dt].x = pg8::cvt_pk_bf16(r_[0], r_[1]); oacc[h][dt].y = pg8::cvt_pk_bf16(r_[2], r_[3]); } } } while (0)
            ATT_LOADQ(hp, 16); ATT_RESET();
            for (int st = ncs - 1; st >= 0; --st) {
                AttKV<bf16x8v> fc; attn_kv_load<bf16x8v, false>(fc, KCb, koff, VCb, voff, 32 * st);
                if (32 * st + 31 <= cmax0) attn_step<0, 0, bf16x8v>(fc, 32 * st, t - 31 - 16 * 32 * st, true, cmax, qf, m, ls, o, sl2, q4);
                else attn_step<0, 2, bf16x8v>(fc, 32 * st, t - 31 - 16 * 32 * st, true, cmax, qf, m, ls, o, sl2, q4); }
            ATT_FOLD(0, true);
            {
                const unsigned char* Kb = KS + (size_t)bg * SEQ * 64; const unsigned char* Vb = VST + (size_t)bg * SEQ * 64;
                ATT_RESET();
                unsigned kof_ = koff >> 1, vof_ = voff >> 1; asm volatile("" : "+v"(kof_), "+v"(vof_));
                unsigned long long un = un0;
                const int cur0 = t0 >> 5;
                AttKV<long> fa, fb; int ja = 63 - __builtin_clzll(un), jb; un &= ~(1ull << ja); attn_kv_load<long, false>(fa, Kb, kof_, Vb, vof_, 32 * ja);
                bool bad = false;
                bool more = un != 0ull; jb = ja;
                if (more) { jb = 63 - __builtin_clzll(un); un &= ~(1ull << jb); }
                attn_kv_load<long, false>(fb, Kb, kof_, Vb, vof_, 32 * jb);
                { const bool tk = ((mine >> ja) & 1ull) != 0ull; attn_step<1, 2, long>(fa, 32 * ja, t - 32 * ja, tk, 0, qf8, m, ls, o, sl2, q4); }
#define ATT_SSTEP(fc_, j_) do { const bool tk = ((mine >> (j_)) & 1ull) != 0ull; attn_step<1, 4, long, false, true>(fc_, 32 * (j_), t - 32 * (j_), tk, 0, qf8, m, ls, o, sl2, q4, bad); } while (0)
                if (more) {
#pragma unroll 1
                    for (;;) { more = un != 0ull; ja = jb;
                        if (more) { ja = 63 - __builtin_clzll(un); un &= ~(1ull << ja); }
                        attn_kv_load<long, false>(fa, Kb, kof_, Vb, vof_, 32 * ja);
                        ATT_SSTEP(fb, jb); __builtin_amdgcn_sched_barrier(0);
                        if (!more) break;
                        more = un != 0ull; jb = ja;
                        if (more) { jb = 63 - __builtin_clzll(un); un &= ~(1ull << jb); }
                        attn_kv_load<long, false>(fb, Kb, kof_, Vb, vof_, 32 * jb);
                        ATT_SSTEP(fa, ja); __builtin_amdgcn_sched_barrier(0);
                        if (!more) break; } }
                if (bad) {
                    ATT_RESET(); un = un0; bool dmy = false;
#pragma unroll 1
                    while (un != 0ull) { const int j = 63 - __builtin_clzll(un); un &= ~(1ull << j);
                        attn_kv_load<long, false>(fa, Kb, kof_, Vb, vof_, 32 * j);
                        { const bool tk = ((mine >> j) & 1ull) != 0ull; attn_step<1, 2, long, false, false>(fa, 32 * j, t - 32 * j, tk, 0, qf8, m, ls, o, sl2, q4, dmy); } } }
#undef ATT_SSTEP
                ATT_FOLD(1, false);
            }
            {
                const unsigned char* Kb = KW + (size_t)bg * SEQ * 64; const unsigned char* Vb = VWT + (size_t)bg * SEQ * 64;
                const int sb = t0 >= 511 ? (t0 - 511) >> 5 : 0, se = t0 >> 5;
                ATT_RESET();
                unsigned kof_ = koff >> 1, vof_ = voff >> 1; asm volatile("" : "+v"(kof_), "+v"(vof_));
                AttKV<long> fa, fb; attn_kv_load<long, false>(fa, Kb, kof_, Vb, vof_, 32 * se);
                bool bad = false;
                int st = se;
                attn_kv_load<long, false>(fb, Kb, kof_, Vb, vof_, 32 * (st > sb ? st - 1 : st));
                attn_step<2, 2, long>(fa, 32 * st, t - 32 * st, true, 0, qf8, m, ls, o, sl2, q4);
                --st;
#define ATT_WIN_UNM(st_) ((st_) >= sb && 32 * (st_) + 31 <= t0 && 32 * (st_) > t0 - 497)
#pragma unroll 1
                for (;;) { if (!ATT_WIN_UNM(st)) break;
                    attn_kv_load<long, false>(fa, Kb, kof_, Vb, vof_, 32 * (st > sb ? st - 1 : st));
                    attn_step<2, 0, long, false, true>(fb, 32 * st, t - 32 * st, true, 0, qf8, m, ls, o, sl2, q4, bad); --st; __builtin_amdgcn_sched_barrier(0);
                    if (!ATT_WIN_UNM(st)) break;
                    attn_kv_load<long, false>(fb, Kb, kof_, Vb, vof_, 32 * (st > sb ? st - 1 : st));
                    attn_step<2, 0, long, false, true>(fa, 32 * st, t - 32 * st, true, 0, qf8, m, ls, o, sl2, q4, bad); --st; __builtin_amdgcn_sched_barrier(0); }
#undef ATT_WIN_UNM
#pragma unroll 1
                for (; st >= sb; --st) { attn_kv_load<long, false>(fa, Kb, kof_, Vb, vof_, 32 * st);
                    attn_step<2, 2, long, false, true>(fa, 32 * st, t - 32 * st, true, 0, qf8, m, ls, o, sl2, q4, bad); }
                if (bad) { ATT_RESET(); bool dmy = false;
#pragma unroll 1
                    for (int st = se; st >= sb; --st) { attn_kv_load<long, false>(fa, Kb, kof_, Vb, vof_, 32 * st);
                        attn_step<2, 2, long, false, false>(fa, 32 * st, t - 32 * st, true, 0, qf8, m, ls, o, sl2, q4, dmy); } }
                ATT_FOLD(2, false);
            }
#pragma unroll
            for (int h = 0; h < 2; ++h)
#pragma unroll
                for (int dt = 0; dt < 4; ++dt) *(unsigned*)(orow + (2 * hp + h) * 64 + 16 * dt) = pg8::pk4_fp8(16.f * bflo(oacc[h][dt].x), 16.f * bfhi(oacc[h][dt].x), 16.f * bflo(oacc[h][dt].y), 16.f * bfhi(oacc[h][dt].y));
        }
#undef ATT_FOLD
#undef ATT_GLOG
#undef ATT_LOADQ
#undef ATT_RESET
#undef qrow
#undef gtp
#undef orow
    }
}

constexpr int SCQ = 272, SCT = 144;
constexpr int LQ_ = 0, LK_ = 17408, LKT_ = 34816, LVT_ = 53248, LP_ = 71680, LO_ = 80896, LE_ = 114688, LT_ = 115712;
#define SC_BAR() do { asm volatile("s_waitcnt lgkmcnt(0)" ::: "memory"); __builtin_amdgcn_s_barrier(); asm volatile("" ::: "memory"); } while (0)
__device__ __forceinline__ void p_scan_fast(Ctx& C, int layer) {
    unsigned char* ws = C.ws;
    const bf16* Pq = (const bf16*)(ws + R_PQ); const bf16* Pi = (const bf16*)(ws + R_PI); const bf16* Pg = (const bf16*)(ws + R_PG); const _Float16* LF = (const _Float16*)(ws + R_LF);
    bf16* O2 = (bf16*)(ws + R_O2);
    const float* gn = C.inp(I_HGN) + layer * 128;
    LAS unsigned char* L = C.lds;
    const int tid = C.tid, lane = C.lane, w = C.wave, r16 = lane & 15, q4 = lane >> 4, k = tid & 127, seg = tid >> 7;
    LAS float* tot = (LAS float*)(L + LT_); LAS float* eref = (LAS float*)(L + LE_); LAS float* elr = eref + 128;
    { const int tile = tid >> 8, e = tid & 255, row = e >> 4, col = e & 15;
      *(LAS bf16*)(L + LP_ + ((tile ? 32 : 0) + row) * SCT + ((tile ? 48 : 16) + col) * 2) = 0; }
    for (int bh = C.bid; bh < 256; bh += C.G) {
        const int b = bh >> 3, h = bh & 7;
        const size_t base = (size_t)(b * SEQ) * DM + h * 128;
        f32x4 S[8];
#pragma unroll
        for (int i = 0; i < 8; ++i) S[i] = (f32x4){0.f, 0.f, 0.f, 0.f};
        bf16 qv[16], vv[16]; float lf[16];
#define SC_LOAD(t0) do { _Pragma("unroll") for (int i = 0; i < 16; ++i) { const size_t off = base + (size_t)((t0) + 16 * seg + i) * DM + k; qv[i] = Pq[off]; vv[i] = Pi[off]; lf[i] = (float)LF[off]; } } while (0)
        SC_LOAD(0);
#pragma unroll 1
        for (int c = 0; c < SEQ / 64; ++c) {
            const int t0 = c * 64;
            float cs[16]; { float run = 0.f;
#pragma unroll
                for (int i = 0; i < 16; ++i) { run += lf[i]; cs[i] = run; }
                tot[seg * 128 + k] = run; }
            SC_BAR();
            { const float a0 = tot[k], a1 = tot[128 + k], a2 = tot[256 + k], a3 = tot[384 + k];
              const float off = seg == 0 ? 0.f : (seg == 1 ? a0 : (seg == 2 ? a0 + a1 : a0 + a1 + a2)), ref = a0 + a1, last = ref + a2 + a3;
              unsigned kt[16];
#pragma unroll
              for (int i = 0; i < 16; ++i) { const float d = off + cs[i] - ref; const float qt = bf2f(qv[i]) * __expf(fminf(d, 80.f)), ktv = (1.f - __expf(lf[i])) * __expf(fminf(-d, 80.f));
                  const int s = 16 * seg + i; kt[i] = f2bf(ktv);
                  *(LAS bf16*)(L + LQ_ + s * SCQ + k * 2) = (bf16)f2bf(qt); *(LAS bf16*)(L + LK_ + s * SCQ + k * 2) = (bf16)kt[i]; }
              v4u w0, w1, x0, x1;
              w0.x = kt[0] | (kt[1] << 16); w0.y = kt[2] | (kt[3] << 16); w0.z = kt[4] | (kt[5] << 16); w0.w = kt[6] | (kt[7] << 16);
              w1.x = kt[8] | (kt[9] << 16); w1.y = kt[10] | (kt[11] << 16); w1.z = kt[12] | (kt[13] << 16); w1.w = kt[14] | (kt[15] << 16);
              x0.x = vv[0] | ((unsigned)vv[1] << 16); x0.y = vv[2] | ((unsigned)vv[3] << 16); x0.z = vv[4] | ((unsigned)vv[5] << 16); x0.w = vv[6] | ((unsigned)vv[7] << 16);
              x1.x = vv[8] | ((unsigned)vv[9] << 16); x1.y = vv[10] | ((unsigned)vv[11] << 16); x1.z = vv[12] | ((unsigned)vv[13] << 16); x1.w = vv[14] | ((unsigned)vv[15] << 16);
              *(LAS v4u*)(L + LKT_ + k * SCT + seg * 32) = w0; *(LAS v4u*)(L + LKT_ + k * SCT + seg * 32 + 16) = w1;
              *(LAS v4u*)(L + LVT_ + k * SCT + seg * 32) = x0; *(LAS v4u*)(L + LVT_ + k * SCT + seg * 32 + 16) = x1;
              if (seg == 0) { eref[k] = __expf(ref); elr[k] = __expf(last - ref); } }
            SC_BAR();
            if (c + 1 < SEQ / 64) SC_LOAD(t0 + 64);
            v4u g8p[2];
#pragma unroll
            for (int rep = 0; rep < 2; ++rep) g8p[rep] = *(const v4u*)(Pg + base + (size_t)(t0 + (tid >> 4) + 32 * rep) * DM + (tid & 15) * 8);
#pragma unroll 1
            for (int ti = w; ti < 10; ti += 8) {
                const int rt = ti < 1 ? 0 : (ti < 3 ? 1 : (ti < 6 ? 2 : 3)), ct = ti - (rt * (rt + 1)) / 2;
                f32x4 acc = {0.f, 0.f, 0.f, 0.f};
#pragma unroll
                for (int p = 0; p < 4; ++p) { const bf16x8v a = *(const LAS bf16x8v*)(L + LQ_ + (16 * rt + r16) * SCQ + (32 * p + 8 * q4) * 2), bq = *(const LAS bf16x8v*)(L + LK_ + (16 * ct + r16) * SCQ + (32 * p + 8 * q4) * 2);
                    acc = MFMA16(a, bq, acc); }
#pragma unroll
                for (int i = 0; i < 4; ++i) { const int t = 16 * rt + 4 * q4 + i, s = 16 * ct + r16; *(LAS bf16*)(L + LP_ + t * SCT + s * 2) = (bf16)f2bf(s <= t ? acc[i] : 0.f); }
            }
            SC_BAR();
            bf16x8v sfrag[4]; f32x4 e8[4][2];
#pragma unroll
            for (int p = 0; p < 4; ++p) { e8[p][0] = *(const LAS f32x4*)(eref + 32 * p + 8 * q4); e8[p][1] = *(const LAS f32x4*)(eref + 32 * p + 8 * q4 + 4);
                S[2 * p] = S[2 * p] * e8[p][0]; S[2 * p + 1] = S[2 * p + 1] * e8[p][1];
                const v4u wv = {pg8::cvt_pk_bf16(S[2 * p][0], S[2 * p][1]), pg8::cvt_pk_bf16(S[2 * p][2], S[2 * p][3]), pg8::cvt_pk_bf16(S[2 * p + 1][0], S[2 * p + 1][1]), pg8::cvt_pk_bf16(S[2 * p + 1][2], S[2 * p + 1][3])};
                sfrag[p] = __builtin_bit_cast(bf16x8v, wv); }
            bf16x8v vfr[2];
#pragma unroll
            for (int ss = 0; ss < 2; ++ss) vfr[ss] = *(const LAS bf16x8v*)(L + LVT_ + (16 * w + r16) * SCT + (32 * ss + 8 * q4) * 2);
#pragma unroll
            for (int rt = 0; rt < 4; ++rt) { f32x4 o = {0.f, 0.f, 0.f, 0.f};
#pragma unroll
                for (int p = 0; p < 4; ++p) { const bf16x8v a = *(const LAS bf16x8v*)(L + LQ_ + (16 * rt + r16) * SCQ + (32 * p + 8 * q4) * 2); o = MFMA16(a, sfrag[p], o); }
#pragma unroll
                for (int ss = 0; ss < 2; ++ss) if (ss <= rt / 2) { const bf16x8v a = *(const LAS bf16x8v*)(L + LP_ + (16 * rt + r16) * SCT + (32 * ss + 8 * q4) * 2); o = MFMA16(a, vfr[ss], o); }
#pragma unroll
                for (int i = 0; i < 4; ++i) *(LAS float*)(L + LO_ + (16 * rt + 4 * q4 + i) * 528 + (16 * w + r16) * 4) = o[i]; }
#pragma unroll
            for (int p = 0; p < 4; ++p)
#pragma unroll
                for (int ab = 0; ab < 2; ++ab) { const int krow = 32 * p + 8 * (r16 >> 2) + (r16 & 3) + 4 * ab;
#pragma unroll
                    for (int ss = 0; ss < 2; ++ss) { const bf16x8v a = *(const LAS bf16x8v*)(L + LKT_ + krow * SCT + (32 * ss + 8 * q4) * 2); S[2 * p + ab] = MFMA16(a, vfr[ss], S[2 * p + ab]); } }
#pragma unroll
            for (int p = 0; p < 4; ++p) { const f32x4 l0 = *(const LAS f32x4*)(elr + 32 * p + 8 * q4), l1 = *(const LAS f32x4*)(elr + 32 * p + 8 * q4 + 4); S[2 * p] = S[2 * p] * l0; S[2 * p + 1] = S[2 * p + 1] * l1; }
            SC_BAR();
#pragma unroll
            for (int rep = 0; rep < 2; ++rep) { const int tok = (tid >> 4) + 32 * rep, part = tid & 15;
                const f32x4 oa = *(const LAS f32x4*)(L + LO_ + tok * 528 + part * 32), ob = *(const LAS f32x4*)(L + LO_ + tok * 528 + part * 32 + 16);
                float ss = (oa.x * oa.x + oa.y * oa.y) + (oa.z * oa.z + oa.w * oa.w) + (ob.x * ob.x + ob.y * ob.y) + (ob.z * ob.z + ob.w * ob.w);
                ss = DPP_ADD(ss, 0xB1); ss = DPP_ADD(ss, 0x4E); ss = DPP_ADD(ss, 0x141); ss = DPP_ADD(ss, 0x140);
                const float rstd = rsqrtf(ss * (1.f / 128.f) + EPS);
                const size_t off = base + (size_t)(t0 + tok) * DM + part * 8; const v4u g8 = g8p[rep];
                const f32x4 ga = *(const f32x4*)(gn + part * 8), gb = *(const f32x4*)(gn + part * 8 + 4);
                v4u wv; wv.x = pk2(oa.x * rstd * ga.x * bflo(g8.x), oa.y * rstd * ga.y * bfhi(g8.x)); wv.y = pk2(oa.z * rstd * ga.z * bflo(g8.y), oa.w * rstd * ga.w * bfhi(g8.y));
                wv.z = pk2(ob.x * rstd * gb.x * bflo(g8.z), ob.y * rstd * gb.y * bfhi(g8.z)); wv.w = pk2(ob.z * rstd * gb.z * bflo(g8.w), ob.w * rstd * gb.w * bfhi(g8.w));
                *(v4u*)(O2 + off) = wv; }
        }
#undef SC_LOAD
        __syncthreads();
    }
}

#undef SC_BAR
#define PH_BEGIN { const bool run_ = (pid >= lo && pid < hi); ++pid; if (run_) { { int ln_; asm volatile("v_mbcnt_lo_u32_b32 %0, -1, 0\n\tv_mbcnt_hi_u32_b32 %0, -1, %0" : "=v"(ln_)); C.lane = ln_; C.tid = C.wave * 64 + ln_; }
#define PH_END   if (pid < hi) xcd_barrier(bar); } }
#define XN ((const bf16*)(ws + WS_XN))
#define RTAB ((const int*)(ws + WS_RTAB))

template <int L>
__device__ __forceinline__ void run_layer(Ctx& C, const XcdBarrier& bar, int& pid, const int lo, const int hi, PG8_LAS unsigned char* ring) {
    unsigned char* const ws = C.ws;

        const int li = L >> 1;
        if (L < 2) {
            PH_BEGIN { pg8::Gemm g{XN, (const bf16*)(ws + W_HIN) + (size_t)L * 4096 * 1024, 1024, 1024, 0}; pg8::GenOrder S; S.init(256, 16, C.G, C.bid, nullptr);
                pg8::EpiHgrnIn E{ws, L};
                pg8::gemm_phase<pg8::EpiHgrnIn, pg8::GenOrder, true, true>(ring, g, S, E, C.wave); } PH_END
            PH_BEGIN p_scan_fast(C, L); PH_END
        } else {
            PH_BEGIN { const bool first = (L == 2); pg8::Gemm g{XN, (const bf16*)(ws + (first ? W_KVQ : W_Q3)), 512, 512, 0}; pg8::GenOrder S; S.init(256, first ? 11 : 5, C.G, C.bid, nullptr);
                pg8::EpiBf16 E{(bf16*)(ws + R_QKV), first ? 2816 : 1280, nullptr, 0, 0, 1.f / pg8::FP8_SW1};
                pg8::gemm_phase<pg8::EpiBf16, pg8::GenOrder, true, true, true>(ring, g, S, E, C.wave); } PH_END
            if (L == 2) {
                PH_BEGIN p_post_kv<0, 2>(C, C.bid * NWAVES + C.wave, C.G * NWAVES); PH_END
                PH_BEGIN { const int hg = C.G >> 1;
                    if (C.G >= 256 && C.bid >= hg) p_post_kv<2, 6>(C, (C.bid - hg) * NWAVES + C.wave, (C.G - hg) * NWAVES);
                    else { if (C.G < 256) { p_post_kv<2, 6>(C, C.bid * NWAVES + C.wave, C.G * NWAVES); __syncthreads(); }
                        pg8::Gemm g{(const bf16*)(ws + R_KCR), (const bf16*)(ws + W_CMP1), 2048, 1024, (size_t)256 * 2048 * 2}; pg8::GenOrder S; S.init(128, 1, C.G >= 256 ? hg : C.G, C.bid, RTAB + 2048);
                        pg8::EpiBf16 E{(bf16*)(ws + WS_HC), 256, (const float*)(ws + WS_CB), 1, 256, 1.f};
                        pg8::gemm_phase<pg8::EpiBf16, pg8::GenOrder, true, true>(ring, g, S, E, C.wave); } } PH_END
                PH_BEGIN p_cmp2(C); PH_END
            }
            PH_BEGIN p_attn_fast(C, (unsigned*)(ws + WS_CTL) + 8192 + 2048 * (L - 2), L == 2 ? 2816 : 1280, L == 2 ? 1536 : 0, C.inp(I_NQN) + (L - 2) * 64); PH_END
        }
        PH_BEGIN { pg8::GenOrder S; S.init(256, 4, C.G, C.bid, nullptr);
            if (L < 2) { pg8::Gemm g{(const bf16*)(ws + R_O2), (const bf16*)(ws + W_HOUT) + (size_t)(L & 1) * 1024 * 1024, 1024, 1024, 0};
                if (L == 0) { pg8::EpiResB<true> E{C.inp(I_X), (bf16*)(ws + WS_XR), 1.f}; pg8::gemm_phase<pg8::EpiResB<true>, pg8::GenOrder, true, true>(ring, g, S, E, C.wave); }
                else { pg8::EpiResB<false> E{nullptr, (bf16*)(ws + WS_XR), 1.f}; pg8::gemm_phase<pg8::EpiResB<false>, pg8::GenOrder, true, true>(ring, g, S, E, C.wave); } }
            else { pg8::Gemm g{(const bf16*)(ws + R_O), (const bf16*)(ws + W_NOUT + (size_t)(L & 1) * 1024 * 1024 * 2), 512, 512, 0};
                pg8::EpiResB<false> E{nullptr, (bf16*)(ws + WS_XR), 1.f / (16.f * pg8::FP8_SW1)};
                pg8::gemm_phase<pg8::EpiResB<false>, pg8::GenOrder, true, true, true>(ring, g, S, E, C.wave); } } PH_END
        PH_BEGIN { if (L & 1) p_norm<false, true, true, true>(C, C.inp(I_MR) + (size_t)li * 1024 * 8, C.inp(I_NFFN) + L * 1024); else if (L == 2) p_norm<false, false, true, true>(C, nullptr, nullptr); else p_norm<false, false, true, false>(C, nullptr, nullptr); } PH_END
        if (L & 1) { PH_BEGIN p_gather(C); PH_END }
        if (L == 0) {
            PH_BEGIN { pg8::Gemm g{XN, (const bf16*)(ws + W_FGU), 1024, 1024, 0};
                pg8::GenOrder S; S.init(256, 22, C.G, C.bid, nullptr);
                pg8::EpiSwiGLU E{(bf16*)(ws + R_HF), DFF};
                pg8::gemm_phase<pg8::EpiSwiGLU, pg8::GenOrder, true, true>(ring, g, S, E, C.wave); } PH_END
            PH_BEGIN { pg8::Gemm g{(const bf16*)(ws + R_HF), (const bf16*)(ws + W_FDN), DFF, DFF, 0}; pg8::GenOrder S; S.init(256, 4, C.G, C.bid, nullptr);
                pg8::EpiResB<false> E{nullptr, (bf16*)(ws + WS_XR), 1.f};
                pg8::gemm_phase<pg8::EpiResB<false>, pg8::GenOrder, true, true>(ring, g, S, E, C.wave); } PH_END
            PH_BEGIN p_norm<false, false, true>(C, nullptr, nullptr); PH_END
        } else {
        PH_BEGIN { const bool moe = (L & 1) != 0;
            pg8::Gemm g{(const bf16*)(ws + (moe ? R_XP : WS_XN)), (const bf16*)(ws + (moe ? W_MGU + (size_t)li * 8 * 2 * DFE * 1024 : W_FGU + (size_t)li * 2 * DFF * 2048)), 512, 512, moe ? (size_t)2 * DFE * 1024 : 0};
            pg8::GenOrder S; S.init(moe ? RTAB[1024] : 256, moe ? 28 : 22, C.G, C.bid, moe ? RTAB : nullptr);
            pg8::EpiSwiGLU8 E{ws + (moe ? R_HM : R_HF), moe ? DFE : DFF};
            pg8::gemm_phase<pg8::EpiSwiGLU8, pg8::GenOrder, true, true, true>(ring, g, S, E, C.wave); } PH_END
        if (!(L & 1)) {
            PH_BEGIN { pg8::Gemm g{(const bf16*)(ws + R_HF), (const bf16*)(ws + W_FDN + (size_t)li * 1024 * DFF * 2), DFF / 2, DFF / 2, 0}; pg8::GenOrder S; S.init(256, 4, C.G, C.bid, nullptr);
                pg8::EpiResB<false> E{nullptr, (bf16*)(ws + WS_XR), 1.f / (pg8::FP8_SH * pg8::FP8_SW2)};
                pg8::gemm_phase<pg8::EpiResB<false>, pg8::GenOrder, true, true, true>(ring, g, S, E, C.wave); } PH_END
            PH_BEGIN p_norm<false, false, true, true>(C, nullptr, nullptr); PH_END
        } else {
            PH_BEGIN { pg8::Gemm g{(const bf16*)(ws + R_HM), (const bf16*)(ws + W_MDN + (size_t)li * 8 * 1024 * DFE), DFE / 2, DFE / 2, (size_t)1024 * DFE}; pg8::GenOrder S; S.init(RTAB[1024], 4, C.G, C.bid, RTAB);
                pg8::EpiBf16 E{(bf16*)(ws + R_XP), 1024, nullptr, 0, 0, 1.f / (pg8::FP8_SH * pg8::FP8_SW2)};
                pg8::gemm_phase<pg8::EpiBf16, pg8::GenOrder, true, true, true>(ring, g, S, E, C.wave); } PH_END
            PH_BEGIN { if (L == 1) p_norm<true, false, true, true>(C, nullptr, nullptr); else p_norm<true, false, false>(C, nullptr, nullptr); } PH_END
        }
        }
    }

struct Args { const float* in[24]; float* out; unsigned char* ws; int ph_lo, ph_hi; };
constexpr int N_PHASES = 34;

__global__ void __launch_bounds__(NWAVES * 64, 2) yoco_fwd(Args args) {
    extern __shared__ __attribute__((aligned(16))) unsigned char lds_raw[];
    Ctx C;
    C.lds = (LAS unsigned char*)lds_raw;
    C.wave = __builtin_amdgcn_readfirstlane((int)(threadIdx.x >> 6)); C.tid = threadIdx.x; C.lane = C.tid & 63;
    C.G = gridDim.x; C.bid = blockIdx.x;
    C.out = args.out; C.ws = args.ws;
    unsigned char* const ws = args.ws;
    volatile LAS unsigned* MISC = (volatile LAS unsigned*)(C.lds + MISC_OFF);
    if (C.tid < 32) MISC[C.tid] = 0u;
    __syncthreads();
    XcdBarrier bar = xcd_barrier_post((unsigned*)(ws + WS_CTL) + 4096, MISC + 8);
    const int lo = args.ph_lo, hi = args.ph_hi;
    int pid = 0;
    PG8_LAS unsigned char* ring = (PG8_LAS unsigned char*)lds_raw;
    PH_BEGIN p_prologue(C); PH_END

    run_layer<0>(C, bar, pid, lo, hi, ring); run_layer<1>(C, bar, pid, lo, hi, ring); run_layer<2>(C, bar, pid, lo, hi, ring); run_layer<3>(C, bar, pid, lo, hi, ring);
#undef PH_BEGIN
#undef PH_END
#undef XN
#undef RTAB
}

extern "C" void kernel_launch(void* const* d_in, const int* in_sizes, int n_in, void* d_out, int out_size, void* d_ws, size_t ws_size, hipStream_t stream) {
    static int grid = 0;
    if (grid == 0) {
        if (n_in != 24 || in_sizes[0] != NT * DM || out_size != NT * DM || ws_size < WS_NEED) { fprintf(stderr, "kernel_launch: unexpected shapes / workspace (n_in %d, ws %zu, need %zu)\n", n_in, ws_size, (size_t)WS_NEED); grid = -1; return; }
        int dev = 0, cus = 0;
        if (hipGetDevice(&dev) != hipSuccess || hipDeviceGetAttribute(&cus, hipDeviceAttributeMultiprocessorCount, dev) != hipSuccess) { grid = -1; return; }
        if (hipFuncSetAttribute((const void*)yoco_fwd, hipFuncAttributeMaxDynamicSharedMemorySize, LDS_BYTES) != hipSuccess) { fprintf(stderr, "kernel_launch: hipFuncSetAttribute failed\n"); grid = -1; return; }
        int per_cu = 0;
        if (hipOccupancyMaxActiveBlocksPerMultiprocessor(&per_cu, (const void*)yoco_fwd, NWAVES * 64, LDS_BYTES) != hipSuccess || per_cu < 1) { fprintf(stderr, "kernel_launch: occupancy query says %d\n", per_cu); }
        (void)hipGetLastError();
        grid = cus;
    }
    if (grid < 0) return;
    (void)hipMemsetAsync((char*)d_ws + WS_CTL, 0, CTL_ZERO_BYTES, stream);
    Args a{};
    for (int i = 0; i < 24; ++i) a.in[i] = (const float*)d_in[i];
    a.out = (float*)d_out; a.ws = (unsigned char*)d_ws;
#if MK_SINGLE
    a.ph_lo = 0; a.ph_hi = N_PHASES;
    hipLaunchKernelGGL(yoco_fwd, dim3(grid), dim3(NWAVES * 64), LDS_BYTES, stream, a);
#else
    for (int k = 0; k < N_PHASES; ++k) { a.ph_lo = k; a.ph_hi = k + 1; hipLaunchKernelGGL(yoco_fwd, dim3(grid), dim3(NWAVES * 64), LDS_BYTES, stream, a); }
#endif
}
```

```cpp
#include <hip/hip_runtime.h>
#include <cstdio>
#include <cstdint>

#ifndef MK_SINGLE
#define MK_SINGLE 1
#endif

namespace pg8 {
#define PG8_LAS __attribute__((address_space(3)))
typedef unsigned short bf16_t;
typedef short bf16x8 __attribute__((ext_vector_type(8)));
typedef float f32x4 __attribute__((ext_vector_type(4)));
typedef unsigned u32x4 __attribute__((ext_vector_type(4)));
constexpr int BM = 256, BK = 64, HALF = 128, HTB = HALF * BK * 2  , STAGE_BYTES = 8 * HTB, NXCD = 8, WGM = 8;

__host__ __device__ __forceinline__ int lds_byte(int r, int c) { const int st = (r >> 4) * 2 + (c >> 5), rr = r & 15, cc = c & 31, ob = rr * 64 + cc * 2; return st * 1024 + (ob ^ (((ob >> 9) & 1) << 5)); }
__host__ __device__ __forceinline__ void stage_rc(int b, int& R, int& C) { const int st = b / 1024, sb = b % 1024, swz = sb ^ (((sb >> 9) & 1) << 5); R = (st >> 1) * 16 + swz / 64; C = (st & 1) * 32 + (swz % 64) / 2; }
__host__ __device__ __forceinline__ int perm32(int rho) { const int n = rho >> 4, i = rho & 15; return 8 * (i >> 2) + 4 * n + (i & 3); }

struct Unit { int pm, pn, e; };
struct Gemm { const bf16_t* A; const bf16_t* Bt; int K; int lda; size_t estride; };

struct GenOrder {
    int nM, nN, nwg, G, c; const int* tile_e;
    __device__ void init(int nM_, int nN_, int G_, int c_, const int* te) { nM = nM_; nN = nN_; nwg = nM * nN; G = G_; c = c_; tile_e = te; }
    __device__ bool next(int i, Unit& u) const {
        const long L = (long)i * G + c; if (L >= nwg) return false;
        int wgid = (int)L; { const int q = nwg / NXCD, r = nwg % NXCD, xcd = wgid % NXCD, off = wgid / NXCD; wgid = (xcd < r ? xcd * (q + 1) : r * (q + 1) + (xcd - r) * q) + off; }
        const int nig = WGM * nN, gid = wgid / nig, fm = gid * WGM, gsz = (nM - fm) < WGM ? (nM - fm) : WGM;
        u.pm = fm + ((wgid % nig) % gsz); u.pn = (wgid % nig) / gsz; u.e = tile_e ? tile_e[u.pm] : 0; return true;
    }
    __device__ __forceinline__ void a_ready(const Unit&) const {}
    __device__ __forceinline__ void done(const Unit&) const {}
};

__device__ __forceinline__ unsigned cvt_pk_bf16(float lo, float hi) { unsigned r; asm volatile("v_cvt_pk_bf16_f32 %0, %1, %2" : "=v"(r) : "v"(lo), "v"(hi)); return r; }
__device__ __forceinline__ float silu_f(float v) { return v * __builtin_amdgcn_rcpf(1.0f + __expf(-v)); }
__device__ __forceinline__ float clamp448(float v) { return __builtin_amdgcn_fmed3f(v, -448.f, 448.f); }
__device__ __forceinline__ unsigned pk4_fp8(float a, float b, float c, float d) {
    int w = __builtin_amdgcn_cvt_pk_fp8_f32(clamp448(a), clamp448(b), 0, false); w = __builtin_amdgcn_cvt_pk_fp8_f32(clamp448(c), clamp448(d), w, true); return (unsigned)w; }
constexpr float FP8_SW1 = 32.f, FP8_SW2 = 64.f, FP8_SH = 8.f;

struct EpiBf16 {
    static constexpr bool PERM = true, AFTER_DRAIN = false;
    bf16_t* O; int ldc; const float* bias; int act; int bias_es; float oscale;
    __device__ __forceinline__ void operator()(const f32x4 (&acc)[2][2][4][2], const Unit& u, int wr, int wc, int fr, int fq) const {
        const int row0 = u.pm * BM + wr * 64 + fr, col0 = u.pn * BM + wc * 32 + 8 * fq;
        f32x4 bv[2][2];
#pragma unroll
        for (int bj = 0; bj < 2; ++bj)
#pragma unroll
            for (int n = 0; n < 2; ++n) bv[bj][n] = bias ? *(const f32x4*)(bias + u.e * bias_es + col0 + bj * HALF + 4 * n) : (f32x4){0.f, 0.f, 0.f, 0.f};
#pragma unroll
        for (int ai = 0; ai < 2; ++ai)
#pragma unroll
            for (int m = 0; m < 4; ++m) { bf16_t* rowp = O + (size_t)(row0 + ai * HALF + m * 16) * ldc + col0;
#pragma unroll
                for (int bj = 0; bj < 2; ++bj) { f32x4 v0 = acc[ai][bj][m][0] * oscale + bv[bj][0], v1 = acc[ai][bj][m][1] * oscale + bv[bj][1];
                    if (act == 1) {
#pragma unroll
                        for (int i = 0; i < 4; ++i) { v0[i] = silu_f(v0[i]); v1[i] = silu_f(v1[i]); } }
                    u32x4 w; w.x = cvt_pk_bf16(v0[0], v0[1]); w.y = cvt_pk_bf16(v0[2], v0[3]); w.z = cvt_pk_bf16(v1[0], v1[1]); w.w = cvt_pk_bf16(v1[2], v1[3]);
                    *(u32x4*)(rowp + bj * HALF) = w; } }
    }
};
struct EpiRes {
    static constexpr bool PERM = false, AFTER_DRAIN = false;
    const float* base; float* out; int ldc; float oscale;
    __device__ __forceinline__ void operator()(const f32x4 (&acc)[2][2][4][2], const Unit& u, int wr, int wc, int fr, int fq) const {
        const int row0 = u.pm * BM + wr * 64 + fr, col0 = u.pn * BM + wc * 32 + 4 * fq;
#pragma unroll
        for (int ai = 0; ai < 2; ++ai)
#pragma unroll
            for (int m = 0; m < 4; ++m) { const size_t off = (size_t)(row0 + ai * HALF + m * 16) * ldc + col0;
#pragma unroll
                for (int bj = 0; bj < 2; ++bj)
#pragma unroll
                    for (int n = 0; n < 2; ++n) { const f32x4 b = *(const f32x4*)(base + off + bj * HALF + n * 16); *(f32x4*)(out + off + bj * HALF + n * 16) = b + acc[ai][bj][m][n] * oscale; } }
    }
};
template <bool BASE_F32>
struct EpiResB {
    static constexpr bool PERM = true, AFTER_DRAIN = false;
    const float* basef; bf16_t* xr; float oscale;
    __device__ __forceinline__ void operator()(const f32x4 (&acc)[2][2][4][2], const Unit& u, int wr, int wc, int fr, int fq) const {
        const int row0 = u.pm * BM + wr * 64 + fr, col0 = u.pn * BM + wc * 32 + 8 * fq;
#pragma unroll
        for (int ai = 0; ai < 2; ++ai) {
            u32x4 wb[4][2]; f32x4 fb[BASE_F32 ? 4 : 1][2][2];
#pragma unroll
            for (int m = 0; m < 4; ++m) { const size_t off = (size_t)(row0 + ai * HALF + m * 16) * 1024 + col0;
#pragma unroll
                for (int bj = 0; bj < 2; ++bj) {
                    if constexpr (BASE_F32) { fb[m][bj][0] = *(const f32x4*)(basef + off + bj * HALF); fb[m][bj][1] = *(const f32x4*)(basef + off + bj * HALF + 4); }
                    else wb[m][bj] = *(const u32x4*)(xr + off + bj * HALF); } }
#pragma unroll
            for (int m = 0; m < 4; ++m) { const size_t off = (size_t)(row0 + ai * HALF + m * 16) * 1024 + col0;
#pragma unroll
                for (int bj = 0; bj < 2; ++bj) { f32x4 b0, b1;
                    if constexpr (BASE_F32) { b0 = fb[m][bj][0]; b1 = fb[m][bj][1]; }
                    else { const u32x4 w = wb[m][bj];
                        b0 = (f32x4){__builtin_bit_cast(float, w.x << 16), __builtin_bit_cast(float, w.x & 0xffff0000u), __builtin_bit_cast(float, w.y << 16), __builtin_bit_cast(float, w.y & 0xffff0000u)};
                        b1 = (f32x4){__builtin_bit_cast(float, w.z << 16), __builtin_bit_cast(float, w.z & 0xffff0000u), __builtin_bit_cast(float, w.w << 16), __builtin_bit_cast(float, w.w & 0xffff0000u)}; }
                    const f32x4 v0 = b0 + acc[ai][bj][m][0] * oscale, v1 = b1 + acc[ai][bj][m][1] * oscale;
                    u32x4 o; o.x = cvt_pk_bf16(v0[0], v0[1]); o.y = cvt_pk_bf16(v0[2], v0[3]); o.z = cvt_pk_bf16(v1[0], v1[1]); o.w = cvt_pk_bf16(v1[2], v1[3]);
                    *(u32x4*)(xr + off + bj * HALF) = o; } } }
    }
};
struct EpiSwiGLU {
    static constexpr bool PERM = true, AFTER_DRAIN = false;
    bf16_t* O; int ldc;
    __device__ __forceinline__ void operator()(const f32x4 (&acc)[2][2][4][2], const Unit& u, int wr, int wc, int fr, int fq) const {
        const int row0 = u.pm * BM + wr * 64 + fr, col0 = u.pn * HALF + wc * 32 + 8 * fq;
#pragma unroll
        for (int ai = 0; ai < 2; ++ai)
#pragma unroll
            for (int m = 0; m < 4; ++m) { bf16_t* rowp = O + (size_t)(row0 + ai * HALF + m * 16) * ldc + col0;
                f32x4 v0, v1;
#pragma unroll
                for (int i = 0; i < 4; ++i) { v0[i] = silu_f(acc[ai][0][m][0][i]) * acc[ai][1][m][0][i]; v1[i] = silu_f(acc[ai][0][m][1][i]) * acc[ai][1][m][1][i]; }
                u32x4 w; w.x = cvt_pk_bf16(v0[0], v0[1]); w.y = cvt_pk_bf16(v0[2], v0[3]); w.z = cvt_pk_bf16(v1[0], v1[1]); w.w = cvt_pk_bf16(v1[2], v1[3]);
                *(u32x4*)rowp = w; }
    }
};
struct EpiSwiGLU8 {
    static constexpr bool PERM = true, AFTER_DRAIN = false;
    static constexpr int WSCALE0 = 0x7a7a7a7a, WSCALE1 = 0x7d7d7d7d;
    unsigned char* O; int ldc;
    __device__ __forceinline__ void operator()(const f32x4 (&acc)[2][2][4][2], const Unit& u, int wr, int wc, int fr, int fq) const {
        const int row0 = u.pm * BM + wr * 64 + fr, col0 = u.pn * HALF + wc * 32 + 8 * fq;
        typedef float f32x2 __attribute__((ext_vector_type(2)));
#pragma unroll
        for (int ai = 0; ai < 2; ++ai)
#pragma unroll
            for (int m = 0; m < 4; ++m) { unsigned char* rowp = O + (size_t)(row0 + ai * HALF + m * 16) * ldc + col0;
                f32x2 o[2][2];
#pragma unroll
                for (int n = 0; n < 2; ++n)
#pragma unroll
                    for (int hh = 0; hh < 2; ++hh) {
                        const f32x2 g = {acc[ai][0][m][n][2 * hh], acc[ai][0][m][n][2 * hh + 1]}, up = {acc[ai][1][m][n][2 * hh], acc[ai][1][m][n][2 * hh + 1]};
                        const f32x2 t = g * (f32x2){-1.4426950408889634f, -1.4426950408889634f};
                        const f32x2 a = (f32x2){__builtin_amdgcn_exp2f(t.x), __builtin_amdgcn_exp2f(t.y)} + (f32x2){1.f, 1.f};
                        o[n][hh] = (g * up) * (f32x2){__builtin_amdgcn_rcpf(a.x), __builtin_amdgcn_rcpf(a.y)}; }
                typedef unsigned u32x2 __attribute__((ext_vector_type(2))); u32x2 w; w.x = pk4_fp8(o[0][0].x, o[0][0].y, o[0][1].x, o[0][1].y); w.y = pk4_fp8(o[1][0].x, o[1][0].y, o[1][1].x, o[1][1].y);
                *(u32x2*)rowp = w; }
    }
};
__device__ __forceinline__ float logf_gate(float x, float lb, float omlb) {
    const float sg = __builtin_amdgcn_rcpf(1.0f + __builtin_amdgcn_exp2f(x * -1.4426950408889634f));
    return __builtin_amdgcn_logf(lb + omlb * sg) * 0.6931471805599453f;
}
struct EpiHgrnIn {
    static constexpr bool PERM = true, AFTER_DRAIN = false;
    unsigned char* ws; int layer;
    static constexpr size_t O_PQ = 580ull << 20, O_PI = O_PQ + (128ull << 20), O_PG = O_PQ + (256ull << 20), O_LF = O_PQ + (384ull << 20), O_LA = 1ull << 20, O_L1 = O_LA + 8192;
    __device__ __forceinline__ void operator()(const f32x4 (&acc)[2][2][4][2], const Unit& u, int wr, int wc, int fr, int fq) const {
        const int quarter = u.pn >> 2;
        const int row0 = u.pm * BM + wr * 64 + fr, col0 = (u.pn & 3) * BM + wc * 32 + 8 * fq;
        if (quarter == 1) {
            const float* la = (const float*)(ws + O_LA) + layer * 1024; const float* l1 = (const float*)(ws + O_L1) + layer * 1024; _Float16* LF = (_Float16*)(ws + O_LF);
            f32x4 A0[2][2], A1[2][2];
#pragma unroll
            for (int bj = 0; bj < 2; ++bj)
#pragma unroll
                for (int n = 0; n < 2; ++n) { A0[bj][n] = *(const f32x4*)(la + col0 + bj * HALF + 4 * n); A1[bj][n] = *(const f32x4*)(l1 + col0 + bj * HALF + 4 * n); }
#pragma unroll
            for (int ai = 0; ai < 2; ++ai)
#pragma unroll
                for (int m = 0; m < 4; ++m) { _Float16* rowp = LF + (size_t)(row0 + ai * HALF + m * 16) * 1024 + col0;
#pragma unroll
                    for (int bj = 0; bj < 2; ++bj) { typedef _Float16 h8 __attribute__((ext_vector_type(8))); h8 o;
#pragma unroll
                        for (int n = 0; n < 2; ++n)
#pragma unroll
                            for (int i = 0; i < 4; ++i) o[4 * n + i] = (_Float16)logf_gate(acc[ai][bj][m][n][i], A0[bj][n][i], A1[bj][n][i]);
                        *(h8*)(rowp + bj * HALF) = o; } }
        } else {
            bf16_t* O = (bf16_t*)(ws + (quarter == 0 ? O_PQ : (quarter == 2 ? O_PI : O_PG)));
#pragma unroll
            for (int ai = 0; ai < 2; ++ai)
#pragma unroll
                for (int m = 0; m < 4; ++m) { bf16_t* rowp = O + (size_t)(row0 + ai * HALF + m * 16) * 1024 + col0;
#pragma unroll
                    for (int bj = 0; bj < 2; ++bj) { f32x4 v0 = acc[ai][bj][m][0], v1 = acc[ai][bj][m][1];
                        if (quarter != 2) {
#pragma unroll
                            for (int i = 0; i < 4; ++i) { v0[i] = silu_f(v0[i]); v1[i] = silu_f(v1[i]); } }
                        u32x4 w; w.x = cvt_pk_bf16(v0[0], v0[1]); w.y = cvt_pk_bf16(v0[2], v0[3]); w.z = cvt_pk_bf16(v1[0], v1[1]); w.w = cvt_pk_bf16(v1[2], v1[3]);
                        *(u32x4*)(rowp + bj * HALF) = w; } }
        }
    }
};

template <class E> constexpr int epi_wscale(int bj) { if constexpr (__is_same(E, EpiSwiGLU8)) return bj ? E::WSCALE1 : E::WSCALE0; else return 0x7f7f7f7f; }
template <class Epi, class Sched, bool ALIGN_EPI = false, bool SP2 = false, bool FP8 = false>
__device__ __forceinline__ void gemm_phase(PG8_LAS unsigned char* lds, const Gemm g, const Sched& S, const Epi& E, const int wave_id) {
    int lane_; asm volatile("v_mbcnt_lo_u32_b32 %0, -1, 0\n\tv_mbcnt_hi_u32_b32 %0, -1, %0" : "=v"(lane_));
    const int wid = wave_id, lane = lane_, tid = wid * 64 + lane, wr = wid >> 2, wc = wid & 3, fr = lane & 15, fq = lane >> 4;
    const int K = g.K, nt = K / BK, lda = g.lda;
    unsigned voffA[2], voffB[2];
#pragma unroll
    for (int i = 0; i < 2; ++i) { int R, C; stage_rc(tid * 16 + i * 8192, R, C); const int Rb = Epi::PERM ? ((R & ~31) + perm32(R & 31)) : R;
        voffA[i] = (unsigned)(R * lda + C) * 2u; voffB[i] = (unsigned)(Rb * K + C) * 2u; }
    const size_t kstep = (size_t)(BK * 2);
    const size_t hstep = (size_t)HALF * K * 2;
    const size_t tstep = 2 * hstep;
    const size_t hstepA = (size_t)HALF * lda * 2, tstepA = 2 * hstepA;
    const unsigned ldsw = (unsigned)wid * 1024u;
    const int aoff = lds_byte(wr * 64 + fr, fq * 8), boff = lds_byte(wc * 32 + fr, fq * 8);
#define PG8_SA(b, h) (((b) * 2 + (h)) * HTB)
#define PG8_SB(b, h) ((4 + (b) * 2 + (h)) * HTB)
#define PG8_STAGE(bufoff, gbase, voff) do { _Pragma("unroll") for (int _i = 0; _i < 2; ++_i) \
        __builtin_amdgcn_global_load_lds((const unsigned*)((const char*)(gbase) + (voff)[_i]), (PG8_LAS unsigned*)(lds + (bufoff) + ldsw + _i * 8192), 16, 0, 0); } while (0)
    typedef int i32x4_ __attribute__((ext_vector_type(4))); typedef int i32x8_ __attribute__((ext_vector_type(8)));
#define PG8_CAT(x, y) __builtin_shufflevector((x), (y), 0, 1, 2, 3, 4, 5, 6, 7)
#define PG8_LDA(dst, b, h) do { _Pragma("unroll") for (int m = 0; m < 4; ++m) { \
        if constexpr (FP8) dst##8[m] = PG8_CAT(*(const PG8_LAS i32x4_*)(lds + PG8_SA(b, h) + aoff + m * 2048), *(const PG8_LAS i32x4_*)(lds + PG8_SA(b, h) + aoff + m * 2048 + 1024)); \
        else { _Pragma("unroll") for (int k = 0; k < 2; ++k) dst[m][k] = *(const PG8_LAS bf16x8*)(lds + PG8_SA(b, h) + aoff + m * 2048 + k * 1024); } } } while (0)
#define PG8_LDB(dst, b, h) do { _Pragma("unroll") for (int n = 0; n < 2; ++n) { \
        if constexpr (FP8) dst##8[n] = PG8_CAT(*(const PG8_LAS i32x4_*)(lds + PG8_SB(b, h) + boff + n * 2048), *(const PG8_LAS i32x4_*)(lds + PG8_SB(b, h) + boff + n * 2048 + 1024)); \
        else { _Pragma("unroll") for (int k = 0; k < 2; ++k) dst[n][k] = *(const PG8_LAS bf16x8*)(lds + PG8_SB(b, h) + boff + n * 2048 + k * 1024); } } } while (0)
#define PG8_MMA(ai, bj, At, Bt) do { __builtin_amdgcn_s_setprio(1); _Pragma("unroll") for (int m = 0; m < 4; ++m) _Pragma("unroll") for (int n = 0; n < 2; ++n) { \
        if constexpr (FP8) asm volatile("v_mfma_scale_f32_16x16x128_f8f6f4 %0, %1, %2, %0, %3, %4 op_sel_hi:[0,0,0]" : "+v"(acc[ai][bj][m][n]) : "v"(Bt##8[n]), "v"(At##8[m]), "v"((bj) ? wscale1_ : wscale0_), "v"(f8scale_)); \
        else { _Pragma("unroll") for (int k = 0; k < 2; ++k) acc[ai][bj][m][n] = __builtin_amdgcn_mfma_f32_16x16x32_bf16(Bt[n][k], At[m][k], acc[ai][bj][m][n], 0, 0, 0); } } \
        __builtin_amdgcn_s_setprio(0); } while (0)
#define PG8_WAIT_V(n) asm volatile("s_waitcnt vmcnt(" #n ")" ::: "memory")
#define PG8_WAIT_L(n) asm volatile("s_waitcnt lgkmcnt(" #n ")" ::: "memory")
#define PG8_BAR __builtin_amdgcn_s_barrier()
#define PG8_SCHED __builtin_amdgcn_sched_barrier(0)
    Unit cur, nxt; int ui = 0;
    if (!S.next(0, cur)) return;
    f32x4 acc[2][2][4][2];
#pragma unroll
    for (int a = 0; a < 2; ++a)
#pragma unroll
        for (int b = 0; b < 2; ++b)
#pragma unroll
            for (int m = 0; m < 4; ++m)
#pragma unroll
                for (int n = 0; n < 2; ++n) acc[a][b][m][n] = (f32x4){0.f, 0.f, 0.f, 0.f};
    const int f8scale_ = 0x7f7f7f7f, wscale0_ = epi_wscale<Epi>(0), wscale1_ = epi_wscale<Epi>(1);
    bf16x8 At[4][2], B0[2][2], B1[2][2]; i32x8_ At8[4], B08[2], B18[2];
    const char* cA = (const char*)g.A + (size_t)cur.pm * tstepA; const char* cB = (const char*)g.Bt + (size_t)cur.e * g.estride + (size_t)cur.pn * tstep;
    S.a_ready(cur);
    if constexpr (SP2) {
        PG8_STAGE(PG8_SB(0, 0), cB, voffB); PG8_STAGE(PG8_SB(0, 1), cB + hstep, voffB); PG8_STAGE(PG8_SA(0, 0), cA, voffA); PG8_STAGE(PG8_SA(0, 1), cA + hstepA, voffA);
        if (wr == 1) PG8_BAR;
        PG8_WAIT_V(2); PG8_BAR;
        PG8_STAGE(PG8_SB(1, 0), cB + kstep, voffB); PG8_STAGE(PG8_SA(1, 0), cA + kstep, voffA); PG8_STAGE(PG8_SB(1, 1), cB + hstep + kstep, voffB);
        PG8_WAIT_V(6); PG8_BAR;
    } else {
        PG8_STAGE(PG8_SB(0, 0), cB, voffB); PG8_STAGE(PG8_SA(0, 0), cA, voffA); PG8_STAGE(PG8_SB(0, 1), cB + hstep, voffB); PG8_STAGE(PG8_SA(0, 1), cA + hstepA, voffA);
        if (wr == 1) PG8_BAR;
        PG8_WAIT_V(4); PG8_BAR;
        PG8_STAGE(PG8_SB(1, 0), cB + kstep, voffB); PG8_STAGE(PG8_SA(1, 0), cA + kstep, voffA); PG8_STAGE(PG8_SB(1, 1), cB + hstep + kstep, voffB);
        PG8_WAIT_V(6); PG8_BAR;
    }
    for (;;) {
        const bool has_next = S.next(ui + 1, nxt);
        const char* nA = has_next ? (const char*)g.A + (size_t)nxt.pm * tstepA : cA; const char* nB = has_next ? (const char*)g.Bt + (size_t)nxt.e * g.estride + (size_t)nxt.pn * tstep : cB;
        for (int t = 0; t < nt; t += 2) {
            const bool last = (t == nt - 2);
            const char* a1 = cA + (size_t)(t + 1) * kstep;
            const char* a2 = last ? nA : cA + (size_t)(t + 2) * kstep; const char* b2 = last ? nB : cB + (size_t)(t + 2) * kstep;
            const char* a3 = a2 + kstep; const char* b3 = b2 + kstep;
            if (last && has_next) S.a_ready(nxt);
            if constexpr (SP2) {
            PG8_STAGE(PG8_SA(1, 1), a1 + hstepA, voffA); PG8_SCHED; PG8_LDB(B0, 0, 0); PG8_LDB(B1, 0, 1); PG8_SCHED; PG8_LDA(At, 0, 0);
            PG8_WAIT_V(8); PG8_WAIT_L(0); PG8_BAR; PG8_MMA(0, 0, At, B0); PG8_MMA(0, 1, At, B1); PG8_BAR; PG8_SCHED;
            PG8_STAGE(PG8_SB(0, 0), b2, voffB); PG8_STAGE(PG8_SB(0, 1), b2 + hstep, voffB); PG8_STAGE(PG8_SA(0, 0), a2, voffA); PG8_SCHED; PG8_LDA(At, 0, 1);
            PG8_WAIT_V(8); PG8_WAIT_L(0); PG8_BAR; PG8_MMA(1, 0, At, B0); PG8_MMA(1, 1, At, B1); PG8_BAR; PG8_SCHED;
            PG8_STAGE(PG8_SA(0, 1), a2 + hstepA, voffA); PG8_SCHED; PG8_LDB(B0, 1, 0); PG8_LDB(B1, 1, 1); PG8_SCHED; PG8_LDA(At, 1, 0);
            PG8_WAIT_V(8); PG8_WAIT_L(0); PG8_BAR; PG8_MMA(0, 0, At, B0); PG8_MMA(0, 1, At, B1); PG8_BAR; PG8_SCHED;
            PG8_STAGE(PG8_SB(1, 0), b3, voffB); PG8_STAGE(PG8_SB(1, 1), b3 + hstep, voffB); PG8_STAGE(PG8_SA(1, 0), a3, voffA); PG8_SCHED; PG8_LDA(At, 1, 1);
            PG8_WAIT_V(8); PG8_WAIT_L(0); PG8_BAR; PG8_MMA(1, 0, At, B0); PG8_MMA(1, 1, At, B1); PG8_BAR; PG8_SCHED;
            } else {
            PG8_LDB(B0, 0, 0); PG8_SCHED; PG8_LDA(At, 0, 0); PG8_STAGE(PG8_SA(1, 1), a1 + hstepA, voffA);
            PG8_WAIT_L(8); PG8_BAR; PG8_WAIT_L(0); PG8_MMA(0, 0, At, B0); PG8_BAR; PG8_SCHED;
            PG8_LDB(B1, 0, 1); PG8_STAGE(PG8_SB(0, 0), b2, voffB);
            PG8_BAR; PG8_WAIT_L(0); PG8_MMA(0, 1, At, B1); PG8_BAR;
            PG8_LDA(At, 0, 1); PG8_STAGE(PG8_SA(0, 0), a2, voffA);
            PG8_BAR; PG8_WAIT_L(0); PG8_MMA(1, 0, At, B0); PG8_BAR; PG8_SCHED;
            PG8_STAGE(PG8_SB(0, 1), b2 + hstep, voffB);
            PG8_WAIT_V(6); PG8_BAR; PG8_MMA(1, 1, At, B1); PG8_BAR;
            PG8_LDB(B0, 1, 0); PG8_SCHED; PG8_LDA(At, 1, 0); PG8_STAGE(PG8_SA(0, 1), a2 + hstepA, voffA);
            PG8_WAIT_L(8); PG8_BAR; PG8_WAIT_L(0); PG8_MMA(0, 0, At, B0); PG8_BAR; PG8_SCHED;
            PG8_LDB(B1, 1, 1); PG8_STAGE(PG8_SB(1, 0), b3, voffB);
            PG8_BAR; PG8_WAIT_L(0); PG8_MMA(0, 1, At, B1); PG8_BAR;
            PG8_LDA(At, 1, 1); PG8_STAGE(PG8_SA(1, 0), a3, voffA);
            PG8_BAR; PG8_WAIT_L(0); PG8_MMA(1, 0, At, B0); PG8_BAR; PG8_SCHED;
            PG8_STAGE(PG8_SB(1, 1), b3 + hstep, voffB);
            PG8_WAIT_V(6); PG8_BAR; PG8_MMA(1, 1, At, B1); PG8_BAR;
            }
        }
        if constexpr (FP8) asm volatile("s_nop 15\n\ts_nop 15" ::: "memory");
        if constexpr (ALIGN_EPI) { if (wr == 0) PG8_BAR; }
        if constexpr (!Epi::AFTER_DRAIN) { E(acc, cur, wr, wc, fr, fq); S.done(cur); }
        if (!has_next) break;
#pragma unroll
        for (int a = 0; a < 2; ++a)
#pragma unroll
            for (int b = 0; b < 2; ++b)
#pragma unroll
                for (int m = 0; m < 4; ++m)
#pragma unroll
                    for (int n = 0; n < 2; ++n) acc[a][b][m][n] = (f32x4){0.f, 0.f, 0.f, 0.f};
        cur = nxt; cA = nA; cB = nB; ++ui;
        if constexpr (ALIGN_EPI) { if (wr == 1) PG8_BAR; }
    }
    PG8_WAIT_V(0);
    if constexpr (!ALIGN_EPI) { if (wr == 0) PG8_BAR; }
    PG8_BAR;
    if constexpr (Epi::AFTER_DRAIN) { E.fused(acc, cur, wr, wc, fr, fq, lds, wid, lane); S.done(cur); }
#undef PG8_SA
#undef PG8_SB
#undef PG8_STAGE
#undef PG8_LDA
#undef PG8_LDB
#undef PG8_MMA
#undef PG8_CAT
#undef PG8_WAIT_V
#undef PG8_WAIT_L
#undef PG8_BAR
#undef PG8_SCHED
}
}

constexpr int NT = 65536, DM = 1024, NBATCH = 32, SEQ = 2048;
constexpr int DFF = 2816, DFE = 3584, NEXP = 8;
constexpr int MOE_ROWS = 133120;
constexpr float EPS = 1e-6f;
constexpr size_t MiB = 1u << 20;
constexpr size_t WS_CTL = 0, CTL_ZERO_BYTES = 1 * MiB;
constexpr size_t WS_LA = 1 * MiB;
constexpr size_t WS_L1 = WS_LA + 8192;
constexpr size_t WS_CB = WS_LA + 16384;
constexpr size_t WS_RCNT = WS_LA + 32768;
constexpr size_t WS_RTAB = WS_LA + 65536;
constexpr size_t WS_ROUTE = 2 * MiB;
constexpr size_t WS_SLOT = 3 * MiB;
constexpr size_t WS_SELM = 4 * MiB;
constexpr size_t WS_GATES = 8 * MiB;
constexpr size_t WS_KC = 20 * MiB;
constexpr size_t WS_VCT = 22 * MiB;
constexpr size_t WS_HC = 24 * MiB;
constexpr size_t WS_W = 48 * MiB;
constexpr size_t W_HIN = WS_W, W_HOUT = WS_W + 16 * MiB, W_KVQ = WS_W + 20 * MiB, W_Q3 = WS_W + 26 * MiB, W_CMP1 = WS_W + 29 * MiB, W_NOUT = WS_W + 31 * MiB,
                 W_FGU = WS_W + 35 * MiB, W_FDN = WS_W + 57 * MiB, W_MGU = WS_W + 68 * MiB, W_MDN = WS_W + 292 * MiB;
constexpr size_t WS_XN = 452 * MiB;
constexpr size_t WS_R = 580 * MiB;
constexpr size_t R_PQ = WS_R, R_PI = WS_R + 128 * MiB, R_PG = WS_R + 256 * MiB, R_LF = WS_R + 384 * MiB, R_O2 = WS_R + 640 * MiB;
constexpr size_t R_HF = WS_R + 256 * MiB;
constexpr size_t R_KS = WS_R, R_KW = WS_R + 32 * MiB, R_VST = WS_R + 64 * MiB, R_VWT = WS_R + 96 * MiB, R_KCR = WS_R + 128 * MiB, R_VCR = WS_R + 160 * MiB;
constexpr size_t R_QKV = WS_R + 256 * MiB;
constexpr size_t R_Q = WS_R + 608 * MiB, R_O = WS_R + 736 * MiB;
constexpr size_t R_XP = WS_R, R_HM = WS_R + 260 * MiB;
constexpr size_t WS_XR = 1408 * MiB;
constexpr size_t WS_NEED = R_HM + (size_t)MOE_ROWS * DFE * 2;
static_assert(R_O + 64 * MiB <= WS_XR && R_O2 + 128 * MiB <= WS_XR && R_HM + (size_t)MOE_ROWS * DFE <= WS_XR && R_HF + (size_t)NT * DFF * 2 <= WS_XR && WS_XR + 128 * MiB <= WS_NEED, "residual rows");
static_assert(WS_NEED <= 1792 * MiB, "workspace map");
static_assert(W_MDN + 112 * MiB <= WS_XN, "weights map");
static_assert(pg8::EpiHgrnIn::O_PQ == R_PQ && pg8::EpiHgrnIn::O_PI == R_PI && pg8::EpiHgrnIn::O_PG == R_PG && pg8::EpiHgrnIn::O_LF == R_LF && pg8::EpiHgrnIn::O_LA == WS_LA && pg8::EpiHgrnIn::O_L1 == WS_L1, "EpiHgrnIn offsets");

constexpr int LDS_BYTES = 147456;
constexpr int MISC_OFF = 131072 + 320;
constexpr int NWAVES = 8;

#define GAS __attribute__((address_space(1)))
#define LAS __attribute__((address_space(3)))
typedef unsigned short bf16;
typedef unsigned v4u __attribute__((ext_vector_type(4)));
typedef unsigned v2u __attribute__((ext_vector_type(2)));
typedef float f32x4 __attribute__((ext_vector_type(4)));
#define LDS_WAIT() asm volatile("s_waitcnt lgkmcnt(0)" ::: "memory")
__device__ __forceinline__ unsigned f2bf(float f) { unsigned r; asm("v_cvt_pk_bf16_f32 %0, %1, 0" : "=v"(r) : "v"(f)); return r; }
__device__ __forceinline__ unsigned pk2(float lo, float hi) { unsigned r; asm("v_cvt_pk_bf16_f32 %0, %1, %2" : "=v"(r) : "v"(lo), "v"(hi)); return r; }
__device__ __forceinline__ float bf2f(unsigned b) { return __builtin_bit_cast(float, b << 16); }
__device__ __forceinline__ float bflo(unsigned w) { return __builtin_bit_cast(float, w << 16); }
__device__ __forceinline__ float bfhi(unsigned w) { return __builtin_bit_cast(float, w & 0xffff0000u); }
__device__ __forceinline__ float wave_sum(float v) {
#pragma unroll
    for (int o = 32; o >= 1; o >>= 1) v += __shfl_xor(v, o);
    return v;
}
__device__ __forceinline__ float wave_max(float v) {
#pragma unroll
    for (int o = 32; o >= 1; o >>= 1) v = fmaxf(v, __shfl_xor(v, o));
    return v;
}

#define XB_TMO      128
#define XB_XCNT(j)  (256  + 64 * (j))
#define XB_XSUB(j)  (1280 + 64 * (j))
#define XB_XGEN(j)  (2304 + 64 * (j))
#define XB_TOP      3328
#define XB_TOPGEN   3392
#define XCD_BAR_WORDS 3456
#define XB_SPIN_CAP (1u << 22)
__device__ __forceinline__ unsigned xb_ld(unsigned* p)              { return __hip_atomic_load(p, __ATOMIC_RELAXED, __HIP_MEMORY_SCOPE_AGENT); }
__device__ __forceinline__ unsigned xb_add(unsigned* p, unsigned v) { return __hip_atomic_fetch_add(p, v, __ATOMIC_RELAXED, __HIP_MEMORY_SCOPE_AGENT); }
__device__ __forceinline__ unsigned xb_xcc_id() { return (unsigned)__builtin_amdgcn_s_getreg((3 << 11) | 20) & 0xFu; }
#define XB_SPIN(cond, bar) do { unsigned _sp = 0; while (cond) { __builtin_amdgcn_s_sleep(1); \
    if ((++_sp & 255u) == 0u) { if (xb_ld(&(bar)[XB_TMO])) break; if (_sp > XB_SPIN_CAP) { atomicAdd(&(bar)[XB_TMO], 1u); break; } } } } while (0)
struct XcdBarrier { unsigned* bar; unsigned x; volatile LAS unsigned* st; };
__device__ __forceinline__ XcdBarrier xcd_barrier_post(unsigned* bar, volatile LAS unsigned* st) {
    XcdBarrier b; b.bar = bar; b.x = xb_xcc_id(); b.st = st;
    if (threadIdx.x == 0) (void)xb_add(&bar[XB_XCNT(b.x)], 1u);
    return b;
}
__device__ __forceinline__ void xcd_barrier_complete(unsigned* bar, unsigned x, unsigned& nloc, unsigned& nx) {
    const unsigned G = gridDim.x * gridDim.y * gridDim.z;
    unsigned sum, cnt, mine, sp = 0u;
    for (;;) {
        sum = 0u; cnt = 0u; mine = 0u;
#pragma unroll
        for (unsigned j = 0; j < 16; ++j) { const unsigned c = xb_ld(&bar[XB_XCNT(j)]); sum += c; cnt += (c > 0u) ? 1u : 0u; mine = (j == x) ? c : mine; }
        if (sum == G) break;
        __builtin_amdgcn_s_sleep(1);
        if ((++sp & 255u) == 0u) { if (xb_ld(&bar[XB_TMO])) break; if (sp > XB_SPIN_CAP) { atomicAdd(&bar[XB_TMO], 1u); break; } }
    }
    nloc = mine > 0u ? mine : 1u; nx = cnt > 0u ? cnt : 1u;
}
__device__ __forceinline__ void xcd_barrier(const XcdBarrier& b) {
    asm volatile("s_waitcnt vmcnt(0)" ::: "memory");
    __syncthreads();
    if (threadIdx.x == 0) {
        unsigned* bar = b.bar; unsigned bx_ = b.x; asm volatile("" : "+s"(bar), "+s"(bx_));
        __builtin_amdgcn_s_waitcnt(0);
        unsigned nloc = b.st[0], nx = b.st[1];
        if (nloc == 0u) { xcd_barrier_complete(bar, bx_, nloc, nx); b.st[0] = nloc; b.st[1] = nx; }
        const unsigned old = xb_add(&bar[XB_XSUB(bx_)], 1u);
        const unsigned gen = old / nloc;
        if (old + 1u == (gen + 1u) * nloc) {
            __builtin_amdgcn_fence(__ATOMIC_RELEASE, "agent");
            asm volatile("s_waitcnt vmcnt(0)" ::: "memory");
            const unsigned og = xb_add(&bar[XB_TOP], 1u);
            const unsigned tg = og / nx;
            if (og + 1u == (tg + 1u) * nx) xb_add(&bar[XB_TOPGEN], 1u);
            else XB_SPIN(xb_ld(&bar[XB_TOPGEN]) == tg, bar);
            __builtin_amdgcn_fence(__ATOMIC_ACQUIRE, "agent");
            xb_add(&bar[XB_XGEN(bx_)], 1u);
            asm volatile("s_waitcnt vmcnt(0)" ::: "memory");
        } else {
            XB_SPIN(xb_ld(&bar[XB_XGEN(bx_)]) == gen, bar);
            __builtin_amdgcn_fence(__ATOMIC_ACQUIRE, "agent");
            asm volatile("s_waitcnt vmcnt(0)" ::: "memory");
        }
    }
    __syncthreads();
}

struct Ctx {
    LAS unsigned char* lds;
    int tid, lane, wave, G, bid;
    float* out; unsigned char* ws;
    __device__ __forceinline__ const float* inp(int i) const {
        const __attribute__((address_space(4))) unsigned char* kp = (const __attribute__((address_space(4))) unsigned char*)__builtin_amdgcn_kernarg_segment_ptr();
        asm volatile("" : "+s"(kp));
        return ((const float* const __attribute__((address_space(4)))*)kp)[i];
    }
};
enum { I_X = 0, I_NMIX, I_NFFN, I_HWIN, I_HWOUT, I_HGN, I_HLB, I_KVN, I_KVW, I_CPK, I_CW1K, I_CW2K, I_CPV, I_CW1V, I_CW2V, I_KN, I_NWIN, I_NWOUT, I_NQN, I_FGU, I_FDN, I_MR, I_MGU, I_MDN };

constexpr int MAXJOB = 64;
struct JobTab { unsigned long long src[MAXJOB], gain[MAXJOB], dst[MAXJOB]; int K[MAXJOB], Nsrc[MAXJOB], npb[MAXJOB], F[MAXJOB], rowoff[MAXJOB], istart[MAXJOB + 1]; float f8s[MAXJOB]; int njobs; };
__device__ __forceinline__ void add_job(LAS JobTab* J, const float* src, const float* gain, bf16* dst, int K, int Nsrc, int Npad, int F, int rowoff, float f8s = 0.f) {
    const int j = J->njobs; J->src[j] = (unsigned long long)src; J->gain[j] = (unsigned long long)gain; J->dst[j] = (unsigned long long)dst;
    J->K[j] = K; J->Nsrc[j] = Nsrc; J->npb[j] = Npad / 32; J->F[j] = F; J->rowoff[j] = rowoff; J->f8s[j] = f8s; J->istart[j + 1] = J->istart[j] + (K / 64) * (Npad / 32); J->njobs = j + 1;
}
struct TrItem { const float* W; const float* gain; bf16* WT; int K, Nsrc, drow, k0, n0; float f8s; };
__device__ __forceinline__ void tr_load(const TrItem& p, f32x4 (&v)[8], int lane) {
    const int c4 = lane & 7, kr = lane >> 3, n = p.n0 + 4 * c4; const bool okn = n < p.Nsrc;
#pragma unroll
    for (int i = 0; i < 8; ++i) { const int kk = 8 * i + kr; v[i] = okn ? *(const f32x4*)(p.W + (size_t)(p.k0 + kk) * p.Nsrc + n) : (f32x4){0.f, 0.f, 0.f, 0.f}; }
}
__device__ __forceinline__ void tr_finish(const TrItem& p, f32x4 (&v)[8], LAS float* scr, int lane) {
    const int c4 = lane & 7, kr = lane >> 3;
#pragma unroll
    for (int i = 0; i < 8; ++i) { const int kk = 8 * i + kr; if (p.gain) v[i] = v[i] * p.gain[p.k0 + kk]; *(LAS f32x4*)(scr + kk * 36 + 4 * c4) = v[i]; }
    LDS_WAIT();
    const int c = lane & 7; const float f8s = p.f8s;
#pragma unroll
    for (int j = 0; j < 4; ++j) { const int nn = (lane >> 3) + 8 * j; const LAS float* s = scr + (8 * c) * 36 + nn;
        if (f8s != 0.f) { v2u o; o.x = pg8::pk4_fp8(s[0 * 36] * f8s, s[1 * 36] * f8s, s[2 * 36] * f8s, s[3 * 36] * f8s); o.y = pg8::pk4_fp8(s[4 * 36] * f8s, s[5 * 36] * f8s, s[6 * 36] * f8s, s[7 * 36] * f8s);
            *(v2u*)((unsigned char*)p.WT + (size_t)(p.drow + nn) * p.K + p.k0 + 8 * c) = o; }
        else { v4u o; o.x = pk2(s[0 * 36], s[1 * 36]); o.y = pk2(s[2 * 36], s[3 * 36]); o.z = pk2(s[4 * 36], s[5 * 36]); o.w = pk2(s[6 * 36], s[7 * 36]);
            *(v4u*)(p.WT + (size_t)(p.drow + nn) * p.K + p.k0 + 8 * c) = o; } }
    LDS_WAIT();
}
__device__ __forceinline__ void norm_row_store(const f32x4 (&v)[4], bf16* orow, int lane) {
    float s = 0.f;
#pragma unroll
    for (int j = 0; j < 4; ++j) s += (v[j].x * v[j].x + v[j].y * v[j].y) + (v[j].z * v[j].z + v[j].w * v[j].w);
    const float rstd = rsqrtf(wave_sum(s) * (1.f / DM) + EPS);
    v2u* o8 = (v2u*)orow + lane;
#pragma unroll
    for (int j = 0; j < 4; ++j) { v2u w; w.x = pk2(v[j].x * rstd, v[j].y * rstd); w.y = pk2(v[j].z * rstd, v[j].w * rstd); o8[64 * j] = w; }
}
__device__ __forceinline__ void p_prologue(Ctx& C) {
    LAS JobTab* J = (LAS JobTab*)(C.lds + 73728);
    unsigned char* ws = C.ws;
    if (C.tid == 0) {
        J->njobs = 0; J->istart[0] = 0;
        for (int l = 0; l < 2; ++l) add_job(J, C.inp(I_HWIN) + (size_t)l * 1024 * 4096, C.inp(I_NMIX) + l * 1024, (bf16*)(ws + W_HIN) + (size_t)l * 4096 * 1024, 1024, 4096, 4096, 0, 0);
        for (int l = 0; l < 2; ++l) add_job(J, C.inp(I_HWOUT) + (size_t)l * 1024 * 1024, nullptr, (bf16*)(ws + W_HOUT) + (size_t)l * 1024 * 1024, 1024, 1024, 1024, 0, 0);
        add_job(J, C.inp(I_KVW), C.inp(I_KVN), (bf16*)(ws + W_KVQ), 1024, 1536, 1536, 0, 0, pg8::FP8_SW1);
        add_job(J, C.inp(I_NWIN), C.inp(I_NMIX) + 2048, (bf16*)(ws + W_KVQ), 1024, 1072, 1280, 0, 1536, pg8::FP8_SW1);
        add_job(J, C.inp(I_NWIN) + (size_t)1024 * 1072, C.inp(I_NMIX) + 3072, (bf16*)(ws + W_Q3), 1024, 1072, 1280, 0, 0, pg8::FP8_SW1);
        add_job(J, C.inp(I_CW1K), nullptr, (bf16*)(ws + W_CMP1), 2048, 256, 256, 0, 0);
        add_job(J, C.inp(I_CW1V), nullptr, (bf16*)(ws + W_CMP1) + (size_t)256 * 2048, 2048, 256, 256, 0, 0);
        for (int l = 0; l < 2; ++l) add_job(J, C.inp(I_NWOUT) + (size_t)l * 1024 * 1024, nullptr, (bf16*)(ws + W_NOUT) + (size_t)l * 1024 * 1024, 1024, 1024, 1024, 0, 0, pg8::FP8_SW1);
        for (int l = 0; l < 2; ++l) add_job(J, C.inp(I_FGU) + (size_t)l * 1024 * 2 * DFF, C.inp(I_NFFN) + (2 * l) * 1024, (bf16*)(ws + W_FGU + (size_t)l * 2 * DFF * 2048), 1024, 2 * DFF, 2 * DFF, DFF, 0, l ? pg8::FP8_SW1 : 0.f);
        for (int l = 0; l < 2; ++l) add_job(J, C.inp(I_FDN) + (size_t)l * DFF * 1024, nullptr, (bf16*)(ws + W_FDN + (size_t)l * 1024 * DFF * 2), DFF, 1024, 1024, 0, 0, l ? pg8::FP8_SW2 : 0.f);
        for (int l = 0; l < 16; ++l) add_job(J, C.inp(I_MGU) + (size_t)l * 1024 * 2 * DFE, C.inp(I_NFFN) + (2 * (l >> 3) + 1) * 1024, (bf16*)(ws + W_MGU + (size_t)l * 2 * DFE * 1024), 1024, 2 * DFE, 2 * DFE, DFE, 0, pg8::FP8_SW1);
        for (int l = 0; l < 16; ++l) add_job(J, C.inp(I_MDN) + (size_t)l * DFE * 1024, nullptr, (bf16*)(ws + W_MDN + (size_t)l * 1024 * DFE), DFE, 1024, 1024, 0, 0, pg8::FP8_SW2);
    }
    __syncthreads();
    LAS float* scr = (LAS float*)(C.lds + C.wave * 9216);
    const int gw = C.bid * NWAVES + C.wave, NGW = C.G * NWAVES;
    const int nj = J->njobs, total = J->istart[nj];
#define TR_SETUP(it_, P) do { int j = 0; while (j + 1 < nj && J->istart[j + 1] <= (it_)) ++j; \
        const int r = (it_) - J->istart[j], npb = J->npb[j], kb = r / npb, nb = r % npb, n0 = 32 * nb, F = J->F[j]; \
        int drow = J->rowoff[j] + n0; \
        if (F) drow = (n0 < F) ? 256 * (n0 / 128) + (n0 % 128) : 256 * ((n0 - F) / 128) + 128 + ((n0 - F) % 128); \
        P.W = (const float*)J->src[j]; P.gain = (const float*)J->gain[j]; P.WT = (bf16*)J->dst[j]; P.K = J->K[j]; P.Nsrc = J->Nsrc[j]; P.drow = drow; P.k0 = 64 * kb; P.n0 = n0; P.f8s = J->f8s[j]; } while (0)
    {
        TrItem pa, pb; f32x4 va[8], vb[8]; int it = gw;
        if (it < total) { TR_SETUP(it, pa); tr_load(pa, va, C.lane); }
        while (it < total) {
            int itn = it + NGW; bool hn = itn < total;
            if (hn) { TR_SETUP(itn, pb); tr_load(pb, vb, C.lane); }
            tr_finish(pa, va, scr, C.lane);
            if (!hn) break;
            it = itn; itn = it + NGW; hn = itn < total;
            if (hn) { TR_SETUP(itn, pa); tr_load(pa, va, C.lane); }
            tr_finish(pb, vb, scr, C.lane);
            if (!hn) break;
            it = itn; }
    }
#undef TR_SETUP
    { const int gt = C.bid * 512 + C.tid;
      if (gt < 1024) { const float a0 = C.inp(I_HLB)[gt], a1 = C.inp(I_HLB)[1024 + gt]; const float mx = fmaxf(a0, a1), e0 = expf(a0 - mx), e1 = expf(a1 - mx), s = e0 + e1;
          const float s0 = e0 / s, s1 = e1 / s, lb1 = (s0 + s1) - s0;
          float* la = (float*)(ws + WS_LA); float* l1 = (float*)(ws + WS_L1);
          la[gt] = 0.f; l1[gt] = 1.f; la[1024 + gt] = lb1; l1[1024 + gt] = 1.f - lb1; } }
    if (C.bid == 0 && C.tid < 128) ((int*)(ws + WS_RTAB))[2048 + C.tid] = C.tid >> 6;
    if (C.G >= 8 && C.bid >= C.G - 8) { const int ob = (C.bid - (C.G - 8)) * 64 + C.lane, which = ob >> 8, j = ob & 255; const float* pos = C.inp(which ? I_CPV : I_CPK); const float* w1 = C.inp(which ? I_CW1V : I_CW1K);
        float a = 0.f;
#pragma unroll 8
        for (int i = C.wave * 256; i < C.wave * 256 + 256; ++i) a += pos[i] * w1[(size_t)i * 256 + j];
        __syncthreads();
        LAS float* red = (LAS float*)(C.lds + 80 * 1024); red[C.wave * 64 + C.lane] = a;
        __syncthreads();
        if (C.wave == 0) { float t = 0.f;
#pragma unroll
            for (int w = 0; w < 8; ++w) t += red[w * 64 + C.lane];
            ((float*)(ws + WS_CB))[ob] = t; } }
    for (int c = C.bid; c < 256; c += C.G)
        for (int i = 0; i < 32; i += 4) { f32x4 v[4][4]; const float* xb = C.inp(I_X);
#pragma unroll
            for (int r = 0; r < 4; ++r) { const f32x4* xr = (const f32x4*)(xb + (size_t)(c * 256 + C.wave * 32 + i + r) * DM) + C.lane;
#pragma unroll
                for (int j = 0; j < 4; ++j) v[r][j] = xr[64 * j]; }
#pragma unroll
            for (int r = 0; r < 4; ++r) norm_row_store(v[r], (bf16*)(ws + WS_XN) + (size_t)(c * 256 + C.wave * 32 + i + r) * DM, C.lane); }
}

#define DPP_ADD(v, ctrl) ((v) + __builtin_bit_cast(float, __builtin_amdgcn_update_dpp(0, __builtin_bit_cast(int, (v)), (ctrl), 0xf, 0xf, true)))
__device__ __forceinline__ float wave_sum_fast(float v) {
    v = DPP_ADD(v, 0xB1);  v = DPP_ADD(v, 0x4E);
    v = DPP_ADD(v, 0x141); v = DPP_ADD(v, 0x140);
    float t;
    asm volatile("v_mov_b32 %1, %0\n\ts_nop 1\n\tv_permlane16_swap_b32 %0, %1\n\ts_nop 1\n\tv_add_f32 %0, %0, %1\n\tv_mov_b32 %1, %0\n\ts_nop 1\n\tv_permlane32_swap_b32 %0, %1\n\ts_nop 1\n\tv_add_f32 %0, %0, %1" : "+v"(v), "=&v"(t));
    return v;
}
__device__ __forceinline__ unsigned pk4_fp8_nc(float a, float b, float c, float d) {
    int w = __builtin_amdgcn_cvt_pk_fp8_f32(a, b, 0, false); w = __builtin_amdgcn_cvt_pk_fp8_f32(c, d, w, true); return (unsigned)w; }

template <bool MOE_ADD, bool ROUTER, bool WRITE_XN, bool XN_FP8>
__device__ __forceinline__ void norm_one_row(Ctx& C, const v4u (&raw)[2], const v4u (&ya)[2], const v4u (&yb)[2], const float p, const float q, const int row, const LAS f32x4* wl, LAS int* cnt8) {
    unsigned char* ws = C.ws;
    constexpr bool FINAL = MOE_ADD && !WRITE_XN;
    f32x4 v[4];
#pragma unroll
    for (int j2 = 0; j2 < 2; ++j2) { const v4u w = raw[j2];
        v[2 * j2] = (f32x4){bflo(w.x), bfhi(w.x), bflo(w.y), bfhi(w.y)}; v[2 * j2 + 1] = (f32x4){bflo(w.z), bfhi(w.z), bflo(w.w), bfhi(w.w)}; }
    if (MOE_ADD) {
#pragma unroll
        for (int j2 = 0; j2 < 2; ++j2) { const v4u a = ya[j2], b = yb[j2];
            v[2 * j2] += (f32x4){p * bflo(a.x) + q * bflo(b.x), p * bfhi(a.x) + q * bfhi(b.x), p * bflo(a.y) + q * bflo(b.y), p * bfhi(a.y) + q * bfhi(b.y)};
            v[2 * j2 + 1] += (f32x4){p * bflo(a.z) + q * bflo(b.z), p * bfhi(a.z) + q * bfhi(b.z), p * bflo(a.w) + q * bflo(b.w), p * bfhi(a.w) + q * bfhi(b.w)};
            if (FINAL) { f32x4* o = (f32x4*)(C.out + (size_t)row * DM + 8 * C.lane + 512 * j2); o[0] = v[2 * j2]; o[1] = v[2 * j2 + 1]; }
            else { v4u o; o.x = pg8::cvt_pk_bf16(v[2 * j2].x, v[2 * j2].y); o.y = pg8::cvt_pk_bf16(v[2 * j2].z, v[2 * j2].w); o.z = pg8::cvt_pk_bf16(v[2 * j2 + 1].x, v[2 * j2 + 1].y); o.w = pg8::cvt_pk_bf16(v[2 * j2 + 1].z, v[2 * j2 + 1].w);
                ((v4u*)(ws + WS_XR + (size_t)row * (DM * 2)) + C.lane)[64 * j2] = o; } }
    }
    if (WRITE_XN || ROUTER) {
        float s = 0.f;
#pragma unroll
        for (int j = 0; j < 4; ++j) s += (v[j].x * v[j].x + v[j].y * v[j].y) + (v[j].z * v[j].z + v[j].w * v[j].w);
        const float rstd = rsqrtf(wave_sum_fast(s) * (1.f / DM) + EPS);
        if (WRITE_XN && XN_FP8) { v2u* o8 = (v2u*)(ws + WS_XN + (size_t)row * DM) + C.lane;
#pragma unroll
            for (int j2 = 0; j2 < 2; ++j2) { v2u w; w.x = pk4_fp8_nc(v[2 * j2].x * rstd, v[2 * j2].y * rstd, v[2 * j2].z * rstd, v[2 * j2].w * rstd);
                w.y = pk4_fp8_nc(v[2 * j2 + 1].x * rstd, v[2 * j2 + 1].y * rstd, v[2 * j2 + 1].z * rstd, v[2 * j2 + 1].w * rstd); o8[64 * j2] = w; } }
        if (WRITE_XN && !XN_FP8) { v4u* o16 = (v4u*)((bf16*)(ws + WS_XN) + (size_t)row * DM) + C.lane;
#pragma unroll
            for (int j2 = 0; j2 < 2; ++j2) { v4u w; w.x = pg8::cvt_pk_bf16(v[2 * j2].x * rstd, v[2 * j2].y * rstd); w.y = pg8::cvt_pk_bf16(v[2 * j2].z * rstd, v[2 * j2].w * rstd);
                w.z = pg8::cvt_pk_bf16(v[2 * j2 + 1].x * rstd, v[2 * j2 + 1].y * rstd); w.w = pg8::cvt_pk_bf16(v[2 * j2 + 1].z * rstd, v[2 * j2 + 1].w * rstd); o16[64 * j2] = w; } }
        if (ROUTER) {
            float a8[8];
#pragma unroll
            for (int e = 0; e < 8; ++e) a8[e] = 0.f;
#pragma unroll
            for (int j = 0; j < 4; ++j)
#pragma unroll
                for (int qq = 0; qq < 4; ++qq) { const int cc = 4 * j + qq; const float xv = v[j][qq] * rstd; const f32x4 wa = wl[(cc * 2) * 64 + C.lane], wb = wl[(cc * 2 + 1) * 64 + C.lane];
                    a8[0] += xv * wa.x; a8[1] += xv * wa.y; a8[2] += xv * wa.z; a8[3] += xv * wa.w; a8[4] += xv * wb.x; a8[5] += xv * wb.y; a8[6] += xv * wb.z; a8[7] += xv * wb.w; }
#pragma unroll
            for (int e = 0; e < 4; ++e) asm volatile("s_nop 1\n\tv_permlane32_swap_b32 %0, %1\n\ts_nop 1\n\tv_add_f32 %0, %0, %1" : "+v"(a8[e]), "+v"(a8[e + 4]));
#pragma unroll
            for (int e = 0; e < 2; ++e) asm volatile("s_nop 1\n\tv_permlane16_swap_b32 %0, %1\n\ts_nop 1\n\tv_add_f32 %0, %0, %1" : "+v"(a8[e]), "+v"(a8[e + 2]));
#pragma unroll
            for (int e = 0; e < 2; ++e) { float t = a8[e]; t = DPP_ADD(t, 0xB1); t = DPP_ADD(t, 0x4E); t = DPP_ADD(t, 0x141); t = DPP_ADD(t, 0x140); a8[e] = t; }
            float lg[8];
#pragma unroll
            for (int e = 0; e < 8; ++e) lg[e] = __builtin_bit_cast(float, __builtin_amdgcn_readlane(__builtin_bit_cast(int, a8[e & 1]), 16 * (((e >> 1) & 1) + 2 * (e >> 2))));
            int e0 = 0; float v0 = lg[0];
#pragma unroll
            for (int e = 1; e < 8; ++e) if (lg[e] > v0) { v0 = lg[e]; e0 = e; }
            int e1 = -1; float v1 = -INFINITY;
#pragma unroll
            for (int e = 0; e < 8; ++e) if (e != e0 && (e1 < 0 || lg[e] > v1)) { v1 = lg[e]; e1 = e; }
            const float ex = expf(v1 - v0), w0_ = 1.f / (1.f + ex), w1_ = ex / (1.f + ex);
            if (C.lane == 0) { ((int4*)(ws + WS_ROUTE))[row] = make_int4(e0 | (e1 << 8), __builtin_bit_cast(int, w0_), __builtin_bit_cast(int, w1_), 0);
                atomicAdd((int*)&cnt8[e0], 1); atomicAdd((int*)&cnt8[e1], 1); }
        }
    }
}

template <bool MOE_ADD, bool ROUTER, bool WRITE_XN, bool XN_FP8 = false>
__device__ __forceinline__ void p_norm(Ctx& C, const float* rw, const float* rgain) {
    unsigned char* ws = C.ws;
    LAS int* cnt8 = (LAS int*)(C.lds + 1024);
    const bf16* Y = (const bf16*)(ws + R_XP);
    constexpr int NB = MOE_ADD ? 2 : 4;
    const LAS f32x4* wl = (const LAS f32x4*)(C.lds + 2048);
    if (ROUTER) { LAS f32x4* wst = (LAS f32x4*)(C.lds + 2048);
        for (int idx = C.tid; idx < 2048; idx += 512) { const int cc = idx >> 7, h = (idx >> 6) & 1, l = idx & 63, k = 8 * l + 512 * (cc >> 3) + (cc & 7);
            wst[idx] = *(const f32x4*)(rw + (size_t)k * 8 + 4 * h) * rgain[k]; }
        __syncthreads(); }
    for (int c = C.bid; c < 256; c += C.G) {
        if (ROUTER) { __syncthreads(); if (C.tid < 8) cnt8[C.tid] = 0; __syncthreads(); }
        const int row0 = c * 256 + C.wave * 32;
        int sx = 0, sy = 0, pw = 0, qw = 0;
        if (MOE_ADD) { const int rr = row0 + (C.lane & 31); const int4 rt = ((const int4*)(ws + WS_ROUTE))[rr]; const int2 sl = ((const int2*)(ws + WS_SLOT))[rr]; sx = sl.x; sy = sl.y; pw = rt.y; qw = rt.z; }
        v4u raw[2][NB][2], ya[2][MOE_ADD ? NB : 1][2], yb[2][MOE_ADD ? NB : 1][2];
#define NLOAD(b, i0) do { _Pragma("unroll") for (int r = 0; r < NB; ++r) { const v4u* hr = (const v4u*)(ws + WS_XR + (size_t)(row0 + (i0) + r) * (DM * 2)) + C.lane; \
            _Pragma("unroll") for (int j2 = 0; j2 < 2; ++j2) raw[b][r][j2] = __builtin_nontemporal_load(hr + 64 * j2); \
            if (MOE_ADD) { const v4u* y0 = (const v4u*)(Y + (size_t)__builtin_amdgcn_readlane(sx, (i0) + r) * DM) + C.lane; const v4u* y1 = (const v4u*)(Y + (size_t)__builtin_amdgcn_readlane(sy, (i0) + r) * DM) + C.lane; \
                _Pragma("unroll") for (int j2 = 0; j2 < 2; ++j2) { ya[b][r][j2] = y0[64 * j2]; yb[b][r][j2] = y1[64 * j2]; } } } } while (0)
#define NPROC(b, i0) do { _Pragma("unroll") for (int r = 0; r < NB; ++r) { \
            const float p_ = MOE_ADD ? __builtin_bit_cast(float, __builtin_amdgcn_readlane(pw, (i0) + r)) : 0.f, q_ = MOE_ADD ? __builtin_bit_cast(float, __builtin_amdgcn_readlane(qw, (i0) + r)) : 0.f; \
            norm_one_row<MOE_ADD, ROUTER, WRITE_XN, XN_FP8>(C, raw[b][r], ya[b][MOE_ADD ? r : 0], yb[b][MOE_ADD ? r : 0], p_, q_, row0 + (i0) + r, wl, cnt8); } } while (0)
        NLOAD(0, 0);
#pragma unroll 1
        for (int i = 0; i < 32; i += 2 * NB) {
            NLOAD(1, i + NB);
            NPROC(0, i);
            if (i + 2 * NB < 32) NLOAD(0, i + 2 * NB);
            NPROC(1, i + NB);
        }
#undef NLOAD
#undef NPROC
        if (ROUTER) { __syncthreads(); if (C.tid < 8) ((int*)(ws + WS_RCNT))[c * 8 + C.tid] = cnt8[C.tid]; }
    }
}

__device__ __forceinline__ void p_gather(Ctx& C) {
    unsigned char* ws = C.ws;
    LAS int* tot = (LAS int*)(C.lds + 0);
    LAS int* pre = tot + 8;
    LAS int* base = tot + 16;
    LAS int* ee = tot + 32;
    LAS int* sl = tot + 32 + 256;
    const int* rcnt = (const int*)(ws + WS_RCNT);
    const int4* route = (const int4*)(ws + WS_ROUTE);
    for (int c = C.bid; c < 256; c += C.G) {
        __syncthreads();
        { const int e = C.wave; int t = 0, p = 0;
          for (int i = C.lane; i < 256; i += 64) { const int v = rcnt[i * 8 + e]; t += v; if (i < c) p += v; }
#pragma unroll
          for (int o = 32; o >= 1; o >>= 1) { t += __shfl_xor(t, o); p += __shfl_xor(p, o); }
          if (C.lane == 0) { tot[e] = t; pre[e] = p; } }
        if (C.tid < 256) ee[C.tid] = route[c * 256 + C.tid].x;
        __syncthreads();
        if (C.tid == 0) { int off = 0; for (int e = 0; e < 8; ++e) { base[e] = off + pre[e]; const int nt = (tot[e] + 255) >> 8;
                if (c == 0) { int* te = (int*)(ws + WS_RTAB); for (int q = 0; q < nt; ++q) te[(off >> 8) + q] = e; }
                off += nt << 8; }
            if (c == 0) ((int*)(ws + WS_RTAB))[1024] = off >> 8; }
        __syncthreads();
        { const int e = C.wave; int run = base[e];
#pragma unroll
          for (int blk = 0; blk < 4; ++blk) { const int i = blk * 64 + C.lane; const int pk = ee[i]; const bool m0 = (pk & 255) == e, m1 = (pk >> 8) == e;
              const unsigned long long bal = __ballot(m0 || m1); const int rank = __popcll(bal & ((1ull << C.lane) - 1ull));
              if (m0) sl[2 * i] = run + rank; if (m1) sl[2 * i + 1] = run + rank;
              run += __popcll(bal); } }
        __syncthreads();
        if (C.tid < 256) ((int2*)(ws + WS_SLOT))[c * 256 + C.tid] = make_int2(sl[2 * C.tid], sl[2 * C.tid + 1]);
        for (int i = 0; i < 32; i += 4) { v4u a[4];
#pragma unroll
            for (int r = 0; r < 4; ++r) a[r] = *((const v4u*)(ws + WS_XN + (size_t)(c * 256 + C.wave * 32 + i + r) * DM) + C.lane);
#pragma unroll
            for (int r = 0; r < 4; ++r) { const int tl = C.wave * 32 + i + r;
                *((v4u*)(ws + R_XP + (size_t)sl[2 * tl] * DM) + C.lane) = a[r]; *((v4u*)(ws + R_XP + (size_t)sl[2 * tl + 1] * DM) + C.lane) = a[r]; } }
    }
}

__device__ __forceinline__ void p_post_kv(Ctx& C) {
    unsigned char* ws = C.ws;
    const bf16* raw = (const bf16*)(ws + R_QKV);
    const float* kn = C.inp(I_KN);
    LAS unsigned char* tl = C.lds + C.wave * 4608;
    const int l = C.lane, c8 = l & 7, r8 = l >> 3, gw = C.bid * NWAVES + C.wave, NGW = C.G * NWAVES;
    for (int it = gw; it < 128 * 64; it += NGW) {
        const int bg = it >> 6, blk = it & 63, b = bg >> 2, g = bg & 3;
        const bf16* rb = raw + (size_t)(b * SEQ + blk * 32) * 2816 + g * 64 + 8 * c8;
        const size_t dst0 = ((size_t)bg * SEQ + blk * 32) * 64 + 8 * c8;
        v4u xall[6][4];
#pragma unroll
        for (int j = 0; j < 6; ++j)
#pragma unroll
            for (int i = 0; i < 4; ++i) xall[j][i] = *(const v4u*)(rb + (size_t)(r8 + 8 * i) * 2816 + j * 256);
#pragma unroll
        for (int j = 0; j < 6; ++j) {
            const v4u (&x)[4] = xall[j];
            if (j == 0 || j == 1) {
                bf16* d = (bf16*)(ws + (j == 0 ? R_KCR : R_VCR)) + dst0;
#pragma unroll
                for (int i = 0; i < 4; ++i) *(v4u*)(d + (size_t)(r8 + 8 * i) * 64) = x[i];
            } else if (j == 2 || j == 4) {
                unsigned char* d = ws + (j == 2 ? R_KS : R_KW) + ((size_t)bg * SEQ + blk * 32) * 64 + (c8 >> 2) * 1024 + (c8 & 3) * 8; const float* gk = kn + (j == 2 ? 64 : 128) + 8 * c8;
                const f32x4 ga = *(const f32x4*)gk, gb = *(const f32x4*)(gk + 4);
#pragma unroll
                for (int i = 0; i < 4; ++i) { const float f[8] = {bflo(x[i].x), bfhi(x[i].x), bflo(x[i].y), bfhi(x[i].y), bflo(x[i].z), bfhi(x[i].z), bflo(x[i].w), bfhi(x[i].w)};
                    float ss = (f[0] * f[0] + f[1] * f[1]) + (f[2] * f[2] + f[3] * f[3]) + (f[4] * f[4] + f[5] * f[5]) + (f[6] * f[6] + f[7] * f[7]);
                    ss += __shfl_xor(ss, 1); ss += __shfl_xor(ss, 2); ss += __shfl_xor(ss, 4);
                    const float rs = rsqrtf(ss * (1.f / 64.f) + EPS);
                    v2u o; o.x = pg8::pk4_fp8(f[0] * rs * ga.x, f[1] * rs * ga.y, f[2] * rs * ga.z, f[3] * rs * ga.w); o.y = pg8::pk4_fp8(f[4] * rs * gb.x, f[5] * rs * gb.y, f[6] * rs * gb.z, f[7] * rs * gb.w);
                    *(v2u*)(d + (size_t)(r8 + 8 * i) * 32) = o; }
            } else {
#pragma unroll
                for (int i = 0; i < 4; ++i) *(LAS v4u*)(tl + (r8 + 8 * i) * 144 + 16 * c8) = x[i];
                LDS_WAIT();
                unsigned wv[8];
#pragma unroll
                for (int t4 = 0; t4 < 8; ++t4) { const float a0 = bf2f(*(const LAS bf16*)(tl + (4 * t4) * 144 + 2 * l)), a1 = bf2f(*(const LAS bf16*)(tl + (4 * t4 + 1) * 144 + 2 * l)),
                                                             a2 = bf2f(*(const LAS bf16*)(tl + (4 * t4 + 2) * 144 + 2 * l)), a3 = bf2f(*(const LAS bf16*)(tl + (4 * t4 + 3) * 144 + 2 * l)); wv[t4] = pg8::pk4_fp8(a0, a1, a2, a3); }
                unsigned char* d = ws + (j == 3 ? R_VST : R_VWT) + (((size_t)bg * 64 + blk) * 64 + l) * 32;
#pragma unroll
                for (int q = 0; q < 2; ++q) { const v4u o = {wv[4 * q], wv[4 * q + 1], wv[4 * q + 2], wv[4 * q + 3]}; *(v4u*)(d + 16 * q) = o; }
                LDS_WAIT();
            }
        }
    }
}

__device__ __forceinline__ void p_cmp2(Ctx& C) {
    unsigned char* ws = C.ws;
    const bf16* Hk = (const bf16*)(ws + WS_HC); const bf16* Hv = Hk + (size_t)16384 * 256;
    const float* w2k = C.inp(I_CW2K); const float* w2v = C.inp(I_CW2V); const float* kn = C.inp(I_KN);
    constexpr int RW = 4;
    LAS float* hk = (LAS float*)(C.lds + C.wave * (RW * 2048)); LAS float* hv = hk + RW * 256;
    const int l = C.lane, gw = C.bid * NWAVES + C.wave, NGW = C.G * NWAVES;
    for (int r0 = gw * RW; r0 < 16384; r0 += NGW * RW) {
#pragma unroll
        for (int q = 0; q < RW; ++q) { const v2u a = *((const v2u*)(Hk + (size_t)(r0 + q) * 256) + l), bq = *((const v2u*)(Hv + (size_t)(r0 + q) * 256) + l);
            *(LAS f32x4*)(hk + q * 256 + 4 * l) = (f32x4){bflo(a.x), bfhi(a.x), bflo(a.y), bfhi(a.y)}; *(LAS f32x4*)(hv + q * 256 + 4 * l) = (f32x4){bflo(bq.x), bfhi(bq.x), bflo(bq.y), bfhi(bq.y)}; }
        LDS_WAIT();
        float ak[RW], av[RW];
#pragma unroll
        for (int q = 0; q < RW; ++q) { ak[q] = 0.f; av[q] = 0.f; }
#pragma unroll 2
        for (int j = 0; j < 256; j += 4) { float wk[4], wv[4];
#pragma unroll
            for (int i = 0; i < 4; ++i) { wk[i] = w2k[(j + i) * 64 + l]; wv[i] = w2v[(j + i) * 64 + l]; }
#pragma unroll
            for (int q = 0; q < RW; ++q) { const f32x4 xk = *(const LAS f32x4*)(hk + q * 256 + j), xv = *(const LAS f32x4*)(hv + q * 256 + j);
                ak[q] += xk.x * wk[0]; ak[q] += xk.y * wk[1]; ak[q] += xk.z * wk[2]; ak[q] += xk.w * wk[3]; av[q] += xv.x * wv[0]; av[q] += xv.y * wv[1]; av[q] += xv.z * wv[2]; av[q] += xv.w * wv[3]; } }
        const float knl = kn[l];
#pragma unroll
        for (int q = 0; q < RW; ++q) { const int r = r0 + q, bg = r >> 7, c = r & 127;
            float a = ak[q], v = av[q];
            if (c == 127) { a = 0.f; v = 0.f; }
            const float rs = rsqrtf(wave_sum(a * a) * (1.f / 64.f) + EPS);
            ((bf16*)(ws + WS_KC))[((size_t)bg * 128 + 32 * (c >> 5)) * 64 + (l >> 5) * 1024 + (c & 31) * 32 + (l & 31)] = (bf16)f2bf(a * rs * knl);
            ((bf16*)(ws + WS_VCT))[(((size_t)bg * 4 + (c >> 5)) * 64 + l) * 32 + (c & 31)] = (bf16)f2bf(v); }
        LDS_WAIT();
    }
}

typedef short bf16x8v __attribute__((ext_vector_type(8)));
#define MFMA16(a, b, c) __builtin_amdgcn_mfma_f32_16x16x32_bf16((a), (b), (c), 0, 0, 0)
constexpr float LOG2E = 1.4426950408889634f;
__device__ __forceinline__ float xmax_q4(float v) {
    float t;
    asm volatile("v_mov_b32 %1, %0\n\ts_nop 1\n\tv_permlane16_swap_b32 %0, %1\n\ts_nop 1\n\tv_max_f32 %0, %0, %1\n\tv_mov_b32 %1, %0\n\ts_nop 1\n\tv_permlane32_swap_b32 %0, %1\n\ts_nop 1\n\tv_max_f32 %0, %0, %1" : "+v"(v), "=&v"(t));
    return v;
}
#define XQ4_ASM(op) "v_mov_b32 %1, %0\n\ts_nop 1\n\tv_permlane16_swap_b32 %0, %1\n\ts_nop 1\n\t" op " %0, %0, %1\n\tv_mov_b32 %1, %0\n\ts_nop 1\n\tv_permlane32_swap_b32 %0, %1\n\ts_nop 1\n\t" op " %0, %0, %1"
__device__ __forceinline__ float xsum_q4(float v) { float t; asm volatile(XQ4_ASM("v_add_f32") : "+v"(v), "=&v"(t)); return v; }
__device__ __forceinline__ unsigned xor_q4(unsigned v) { unsigned t; asm volatile(XQ4_ASM("v_or_b32") : "+v"(v), "=&v"(t)); return v; }
__device__ __forceinline__ unsigned xpart16(unsigned v, int q4) { unsigned a = v, b; asm volatile("v_mov_b32 %1, %0\n\ts_nop 1\n\tv_permlane16_swap_b32 %0, %1\n\ts_nop 1" : "+v"(a), "=&v"(b)); return (q4 & 1) ? a : b; }
__device__ __forceinline__ unsigned xpart32(unsigned v, int q4) { unsigned a = v, b; asm volatile("v_mov_b32 %1, %0\n\ts_nop 1\n\tv_permlane32_swap_b32 %0, %1\n\ts_nop 1" : "+v"(a), "=&v"(b)); return (q4 & 2) ? a : b; }
__device__ __forceinline__ unsigned xor_r16(unsigned v) {
    v |= (unsigned)__builtin_amdgcn_ds_swizzle((int)v, (1 << 10) | 0x1f); v |= (unsigned)__builtin_amdgcn_ds_swizzle((int)v, (2 << 10) | 0x1f);
    v |= (unsigned)__builtin_amdgcn_ds_swizzle((int)v, (4 << 10) | 0x1f); v |= (unsigned)__builtin_amdgcn_ds_swizzle((int)v, (8 << 10) | 0x1f); return v; }
__device__ __forceinline__ f32x4 att_mma(bf16x8v a, bf16x8v b, f32x4 c) { return __builtin_amdgcn_mfma_f32_16x16x32_bf16(a, b, c, 0, 0, 0); }
__device__ __forceinline__ f32x4 att_mma(long a, long b, f32x4 c) { return __builtin_amdgcn_mfma_f32_16x16x32_fp8_fp8(a, b, c, 0, 0, 0); }
__device__ __forceinline__ float fmax2(float a, float b) { return __builtin_amdgcn_fmed3f(a, b, INFINITY); }
__device__ __forceinline__ void att_pack(bf16x8v& pf, const float (&p)[8], bool keep) {
    unsigned w0 = pg8::cvt_pk_bf16(p[0], p[1]), w1 = pg8::cvt_pk_bf16(p[2], p[3]), w2 = pg8::cvt_pk_bf16(p[4], p[5]), w3 = pg8::cvt_pk_bf16(p[6], p[7]);
    if (!keep) { w0 = 0u; w1 = 0u; w2 = 0u; w3 = 0u; }
    const v4u w = {w0, w1, w2, w3}; pf = __builtin_bit_cast(bf16x8v, w); }
__device__ __forceinline__ unsigned pk4_fp8_raw(float a, float b, float c, float d) { int w = __builtin_amdgcn_cvt_pk_fp8_f32(a, b, 0, false); w = __builtin_amdgcn_cvt_pk_fp8_f32(c, d, w, true); return (unsigned)w; }
__device__ __forceinline__ void att_pack(long& pf, const float (&p)[8], bool keep) {
    unsigned w0 = pk4_fp8_raw(p[0], p[1], p[2], p[3]), w1 = pk4_fp8_raw(p[4], p[5], p[6], p[7]);
    if (!keep) { w0 = 0u; w1 = 0u; }
    const v2u w = {w0, w1}; pf = __builtin_bit_cast(long, w); }
template <class FR> struct AttKV { FR ka[2], kb[2], vf[4]; };
template <class FR, bool NOPV>
__device__ __forceinline__ void attn_kv_load(AttKV<FR>& f, const void* __restrict__ Kb, unsigned koff, const void* __restrict__ Vb, unsigned voff, int k0) {
    constexpr int SH = sizeof(FR) == 16 ? 0 : 1;
    const char* kblk = (const char*)Kb + (((size_t)k0 * 128) >> SH); const char* vblk = (const char*)Vb + (((size_t)k0 * 128) >> SH);
#pragma unroll
    for (int ks = 0; ks < 2; ++ks) { f.ka[ks] = *(const FR*)(kblk + koff + ((2048 * ks) >> SH)); f.kb[ks] = *(const FR*)(kblk + koff + ((256 + 2048 * ks) >> SH)); }
    if (!NOPV) {
#pragma unroll
        for (int dt = 0; dt < 4; ++dt) f.vf[dt] = *(const FR*)(vblk + voff + ((1024 * dt) >> SH)); }
}
template <int MODE, int PATH, class FR, bool NOPV = false, bool FAST = false>
__device__ __forceinline__ void attn_step(const AttKV<FR>& f, int k0, int trel, bool tk, int cmax,
                                          const FR (&qf)[2][2], float (&m)[2], float (&ls)[2], f32x4 (&o)[2][4], const float (&sl2)[2], int q4, bool& bad) {
    constexpr int DMUL = (MODE == 0) ? 16 : 1;
    const float trelf = (float)trel;
    const float kb_ = (float)(8 * q4); const f32x4 bv[2] = {(f32x4){kb_, kb_ + 1.f, kb_ + 2.f, kb_ + 3.f}, (f32x4){kb_ + 4.f, kb_ + 5.f, kb_ + 6.f, kb_ + 7.f}};
    bool ok[8];
    if (PATH == 2) {
#pragma unroll
        for (int i = 0; i < 8; ++i) { const int kk = 8 * q4 + i; const int d = trel - DMUL * kk; ok[i] = (MODE == 0) ? (k0 + kk <= cmax) : (MODE == 1 ? (tk && d >= 0) : (d >= 0 && d < 512)); } }
    if constexpr (sizeof(FR) == 16) {
#pragma unroll
    for (int h = 0; h < 2; ++h) {
        f32x4 sa = att_mma(f.ka[0], qf[h][0], bv[0] * ((float)DMUL * sl2[h])), sb = att_mma(f.kb[0], qf[h][0], bv[1] * ((float)DMUL * sl2[h])); sa = att_mma(f.ka[1], qf[h][1], sa); sb = att_mma(f.kb[1], qf[h][1], sb);
        float mref = m[h] + sl2[h] * trelf;
        float mx;
        if (PATH == 2) { mx = -1e30f;
#pragma unroll
            for (int i = 0; i < 8; ++i) { const float v = i < 4 ? sa[i] : sb[i - 4]; mx = ok[i] ? fmaxf(mx, v) : mx; } }
        else { mx = fmaxf(fmaxf(fmaxf(sa[0], sa[1]), fmaxf(sa[2], sa[3])), fmaxf(fmaxf(sb[0], sb[1]), fmaxf(sb[2], sb[3]))); if (PATH == 1) mx = tk ? mx : -1e30f; }
        mx = xmax_q4(mx);
        if (__any(mx > mref + 8.f)) { const float mn = fmaxf(mref, mx), alpha = __builtin_amdgcn_exp2f(mref - mn); m[h] = mn - sl2[h] * trelf; mref = mn; ls[h] *= alpha;
            if (!NOPV) {
#pragma unroll
                for (int dt = 0; dt < 4; ++dt) o[h][dt] = o[h][dt] * alpha; } }
        float p[8]; float psum = 0.f;
#pragma unroll
        for (int i = 0; i < 8; ++i) { const float e = __builtin_amdgcn_exp2f((i < 4 ? sa[i] : sb[i - 4]) - mref); p[i] = (PATH == 2) ? (ok[i] ? e : 0.f) : e; psum += p[i]; }
        if (PATH == 1) psum = tk ? psum : 0.f;
        ls[h] += psum;
        FR pf; att_pack(pf, p, PATH == 1 ? tk : true);
        if (!NOPV) {
#pragma unroll
            for (int dt = 0; dt < 4; ++dt) o[h][dt] = att_mma(f.vf[dt], pf, o[h][dt]); }
    }
    } else {
    f32x4 sa[2], sb[2]; float mref[2], mx[2];
#pragma unroll
    for (int h = 0; h < 2; ++h) { sa[h] = att_mma(f.ka[0], qf[h][0], bv[0] * ((float)DMUL * sl2[h])); sb[h] = att_mma(f.kb[0], qf[h][0], bv[1] * ((float)DMUL * sl2[h])); }
#pragma unroll
    for (int h = 0; h < 2; ++h) { sa[h] = att_mma(f.ka[1], qf[h][1], sa[h]); sb[h] = att_mma(f.kb[1], qf[h][1], sb[h]); }
#pragma unroll
    for (int h = 0; h < 2; ++h) { mref[h] = m[h] + sl2[h] * trelf;
        if (PATH == 4) mref[h] = tk ? mref[h] : INFINITY;
        const f32x4 mr4 = {mref[h], mref[h], mref[h], mref[h]}; sa[h] = sa[h] - mr4; sb[h] = sb[h] - mr4;
        if (PATH == 2) { mx[h] = -1e30f;
#pragma unroll
            for (int i = 0; i < 8; ++i) { const float v = i < 4 ? sa[h][i] : sb[h][i - 4]; mx[h] = ok[i] ? fmaxf(mx[h], v) : mx[h]; } }
        else { mx[h] = fmaxf(fmaxf(fmaxf(sa[h][0], sa[h][1]), fmaxf(sa[h][2], sa[h][3])), fmaxf(fmaxf(sb[h][0], sb[h][1]), fmaxf(sb[h][2], sb[h][3]))); if (PATH == 1) mx[h] = tk ? mx[h] : -1e30f; } }
    if (__any(mx[0] > 8.f || mx[1] > 8.f)) {
        if (FAST) bad = true; else
#pragma unroll
        for (int h = 0; h < 2; ++h) { const float d = fmaxf(xmax_q4(mx[h]), 0.f), alpha = __builtin_amdgcn_exp2f(-d); m[h] += d; ls[h] *= alpha;
            const f32x4 d4 = {d, d, d, d}; sa[h] = sa[h] - d4; sb[h] = sb[h] - d4;
            if (!NOPV) {
#pragma unroll
                for (int dt = 0; dt < 4; ++dt) o[h][dt] = o[h][dt] * alpha; } } }
    FR pf[2];
#pragma unroll
    for (int h = 0; h < 2; ++h) { float p[8]; float psum = 0.f;
#pragma unroll
        for (int i = 0; i < 8; ++i) { const float e = __builtin_amdgcn_exp2f(i < 4 ? sa[h][i] : sb[h][i - 4]); p[i] = (PATH == 2) ? (ok[i] ? e : 0.f) : e; psum += p[i]; }
        if (PATH == 1) psum = tk ? psum : 0.f;
        ls[h] += psum;
        att_pack(pf[h], p, PATH == 1 ? tk : true); }
    if (!NOPV) {
#pragma unroll
        for (int dt = 0; dt < 4; ++dt)
#pragma unroll
            for (int h = 0; h < 2; ++h) o[h][dt] = att_mma(f.vf[dt], pf[h], o[h][dt]); }
    }
}
template <int MODE, int PATH, class FR, bool NOPV = false>
__device__ __forceinline__ void attn_step(const AttKV<FR>& f, int k0, int trel, bool tk, int cmax, const FR (&qf)[2][2], float (&m)[2], float (&ls)[2], f32x4 (&o)[2][4], const float (&sl2)[2], int q4) {
    bool dummy = false; attn_step<MODE, PATH, FR, NOPV, false>(f, k0, trel, tk, cmax, qf, m, ls, o, sl2, q4, dummy); }
constexpr int PSW = 132;
__device__ __forceinline__ void p_attn_fast(Ctx& C, unsigned* queue, const int ld, const int qo, const float* qn) {
    unsigned char* ws = C.ws;
    const bf16* Qraw = (const bf16*)(ws + R_QKV);
    const bf16* KC = (const bf16*)(ws + WS_KC); const bf16* VCT = (const bf16*)(ws + WS_VCT);
    const unsigned char* KS = ws + R_KS; const unsigned char* VST = ws + R_VST; const unsigned char* KW = ws + R_KW; const unsigned char* VWT = ws + R_VWT;
    bf16* O = (bf16*)(ws + R_O);
    LAS float* psl = (LAS float*)(C.lds + C.wave * (16 * PSW * 4));
    int qsel = (int)(xb_xcc_id() & 7u), qtry = 0;
    for (;;) {
        int l = C.lane; asm volatile("" : "+v"(l));
        const int r16 = l & 15, q4 = l >> 4;
        const unsigned koff = (unsigned)((8 * (r16 >> 2) + (r16 & 3)) * 64 + 16 * q4), voff = (unsigned)((r16 * 32 + 8 * q4) * 2);
        unsigned u = 0; if (l == 0) u = __hip_atomic_fetch_add(queue + 64 * qsel, 1u, __ATOMIC_RELAXED, __HIP_MEMORY_SCOPE_AGENT);
        u = (unsigned)__builtin_amdgcn_readfirstlane((int)u);
        if (u >= 2048u) { if (++qtry >= 8) break; qsel = (qsel + 1) & 7; continue; }
        u = ((u >> 7) * 8 + (unsigned)qsel) * 128 + (u & 127);
        const int bg = (int)(u >> 7), tile = 127 - (int)(u & 127), g = bg & 3, b = bg >> 2, t0 = tile * 16, t = t0 + r16, row = b * SEQ + t;
#define qrow (Qraw + (size_t)row * ld + qo)
#define gtp (qrow + 1024 + g * 12)
#define orow ((unsigned char*)O + (size_t)row * DM + g * 256 + 4 * q4)
        bf16x8v qf[2][2]; long qf8[2][2]; float sl2[2]; f32x4 bv[2]; float m[2]; float ls[2]; f32x4 o[2][4];
#define ATT_LOADQ(hp, DM_) do { _Pragma("unroll") for (int i_ = 0; i_ < 4; ++i_) { bv[0][i_] = (float)(8 * q4 + i_); bv[1][i_] = (float)(8 * q4 + 4 + i_); } \
            _Pragma("unroll") for (int h = 0; h < 2; ++h) { sl2[h] = exp2f(-0.5f * (float)(g * 4 + 2 * (hp) + h + 1)) * LOG2E; \
            float xq_[2][8]; float ssq_ = 0.f; \
            _Pragma("unroll") for (int ks = 0; ks < 2; ++ks) { const v4u r_ = *(const v4u*)(qrow + (g * 4 + 2 * (hp) + h) * 64 + 32 * ks + 8 * q4); \
                xq_[ks][0] = bflo(r_.x); xq_[ks][1] = bfhi(r_.x); xq_[ks][2] = bflo(r_.y); xq_[ks][3] = bfhi(r_.y); xq_[ks][4] = bflo(r_.z); xq_[ks][5] = bfhi(r_.z); xq_[ks][6] = bflo(r_.w); xq_[ks][7] = bfhi(r_.w); \
                _Pragma("unroll") for (int j_ = 0; j_ < 8; ++j_) ssq_ += xq_[ks][j_] * xq_[ks][j_]; } \
            ssq_ = xsum_q4(ssq_); \
            const float rq_ = rsqrtf(ssq_ * (1.f / 64.f) + EPS) * (0.125f * LOG2E); \
            _Pragma("unroll") for (int ks = 0; ks < 2; ++ks) { const f32x4 ga_ = *(const f32x4*)(qn + 32 * ks + 8 * q4), gb_ = *(const f32x4*)(qn + 32 * ks + 8 * q4 + 4); \
                const v4u w_ = {pg8::cvt_pk_bf16(xq_[ks][0] * rq_ * ga_.x, xq_[ks][1] * rq_ * ga_.y), pg8::cvt_pk_bf16(xq_[ks][2] * rq_ * ga_.z, xq_[ks][3] * rq_ * ga_.w), \
                                pg8::cvt_pk_bf16(xq_[ks][4] * rq_ * gb_.x, xq_[ks][5] * rq_ * gb_.y), pg8::cvt_pk_bf16(xq_[ks][6] * rq_ * gb_.z, xq_[ks][7] * rq_ * gb_.w)}; \
                qf[h][ks] = __builtin_bit_cast(bf16x8v, w_); \
                const v2u w8_ = {pg8::pk4_fp8(xq_[ks][0] * rq_ * ga_.x, xq_[ks][1] * rq_ * ga_.y, xq_[ks][2] * rq_ * ga_.z, xq_[ks][3] * rq_ * ga_.w), pg8::pk4_fp8(xq_[ks][4] * rq_ * gb_.x, xq_[ks][5] * rq_ * gb_.y, xq_[ks][6] * rq_ * gb_.z, xq_[ks][7] * rq_ * gb_.w)}; \
                qf8[h][ks] = __builtin_bit_cast(long, w8_); } } } while (0)
#define ATT_RESET() do { _Pragma("unroll") for (int h = 0; h < 2; ++h) { m[h] = -1e4f; ls[h] = 0.f; _Pragma("unroll") for (int dt = 0; dt < 4; ++dt) o[h][dt] = (f32x4){0.f, 0.f, 0.f, 0.f}; } } while (0)
        const int cmax = t >= 31 ? (((t - 31) >> 4) < 126 ? ((t - 31) >> 4) : 126) : -1;
        const int cmax0 = t0 >= 31 ? (((t0 - 31) >> 4) < 126 ? ((t0 - 31) >> 4) : 126) : -1;
        const bf16* KCb = KC + (size_t)bg * 128 * 64; const bf16* VCb = VCT + (size_t)bg * 128 * 64;
        const int ncs = ((t0 + 15 - 31) >> 4) < 0 ? 0 : ((((t0 + 15 - 31) >> 4) < 126 ? ((t0 + 15 - 31) >> 4) : 126) >> 5) + 1;
        bf16x8v kfa[4][2], kfb[4][2];
#pragma unroll
        for (int st = 0; st < 4; ++st) { const char* kblk = (const char*)(KCb + (size_t)(32 * st) * 64);
#pragma unroll
            for (int ks = 0; ks < 2; ++ks) { kfa[st][ks] = *(const bf16x8v*)(kblk + koff + 2048 * ks); kfb[st][ks] = *(const bf16x8v*)(kblk + koff + 256 + 2048 * ks); } }
#pragma unroll 1
        for (int hp = 0; hp < 2; ++hp) {
            ATT_LOADQ(hp, 16); ATT_RESET();
#pragma unroll
            for (int st = 3; st >= 0; --st) {
                if (st < ncs) { AttKV<bf16x8v> fc; fc.ka[0] = kfa[st][0]; fc.ka[1] = kfa[st][1]; fc.kb[0] = kfb[st][0]; fc.kb[1] = kfb[st][1];
                    if (32 * st + 31 <= cmax0) attn_step<0, 0, bf16x8v, true>(fc, 32 * st, t - 31 - 16 * 32 * st, true, cmax, qf, m, ls, o, sl2, q4);
                    else attn_step<0, 2, bf16x8v, true>(fc, 32 * st, t - 31 - 16 * 32 * st, true, cmax, qf, m, ls, o, sl2, q4); } }
#pragma unroll
            for (int h = 0; h < 2; ++h) ls[h] = xsum_q4(ls[h]);
            float ps[4][8];
#pragma unroll
            for (int st = 0; st < 4; ++st)
#pragma unroll
                for (int i = 0; i < 8; ++i) ps[st][i] = 0.f;
#pragma unroll
            for (int st = 0; st < 4; ++st) {
                if (st < ncs) {
                    const int k0 = 32 * st;
                    const bf16x8v (&ka)[2] = kfa[st]; const bf16x8v (&kb)[2] = kfb[st];
#pragma unroll
                    for (int h = 0; h < 2; ++h) {
                        f32x4 sa = MFMA16(ka[0], qf[h][0], bv[0] * (16.f * sl2[h])), sb = MFMA16(kb[0], qf[h][0], bv[1] * (16.f * sl2[h])); sa = MFMA16(ka[1], qf[h][1], sa); sb = MFMA16(kb[1], qf[h][1], sb);
                        const float lt = ls[h], inv = lt > 0.f ? 1.f / lt : 0.f, mref = m[h] + sl2[h] * (float)(t - 31 - 16 * k0);
#pragma unroll
                        for (int i = 0; i < 8; ++i) { const int c = k0 + 8 * q4 + i; ps[st][i] += (c <= cmax) ? __builtin_amdgcn_exp2f((i < 4 ? sa[i] : sb[i - 4]) - mref) * inv : 0.f; }
                    }
                }
            }
#pragma unroll
            for (int st = 0; st < 4; ++st) { LAS f32x4* p0 = (LAS f32x4*)(psl + r16 * PSW + 32 * st + 8 * q4);
                f32x4 a = {ps[st][0], ps[st][1], ps[st][2], ps[st][3]}, bq = {ps[st][4], ps[st][5], ps[st][6], ps[st][7]};
                if (hp) { a = a + p0[0]; bq = bq + p0[1]; }
                p0[0] = a; p0[1] = bq; }
            LDS_WAIT();
        }
        unsigned mlo, mhi;
        {
            float sc[16]; const LAS float* pr = psl + r16 * PSW + 32 * q4; const int cur = t >> 5;
            float prev = q4 > 0 ? pr[-1] : 0.f;
#pragma unroll
            for (int jj = 0; jj < 16; ++jj) { const float a = pr[2 * jj], bq = pr[2 * jj + 1]; const float imp = prev + a + bq; prev = bq;
                const int j = 16 * q4 + jj; const bool valid = 32 * j <= t; const bool forced = valid && (j == 0 || j == cur || j == cur - 1);
                sc[jj] = forced ? 1e9f : (valid ? imp : -1e9f); }
            unsigned my = 0u;
#pragma unroll 1
            for (int r = 0; r < 8; ++r) {
                float best = sc[0]; int bi = 0;
#pragma unroll
                for (int jj = 1; jj < 16; ++jj) if (sc[jj] > best) { best = sc[jj]; bi = jj; }
                bi += 16 * q4;
                { const float ov = __builtin_bit_cast(float, xpart16(__builtin_bit_cast(unsigned, best), q4)); const int oi = (int)xpart16((unsigned)bi, q4); if (ov > best || (ov == best && oi < bi)) { best = ov; bi = oi; } }
                { const float ov = __builtin_bit_cast(float, xpart32(__builtin_bit_cast(unsigned, best), q4)); const int oi = (int)xpart32((unsigned)bi, q4); if (ov > best || (ov == best && oi < bi)) { best = ov; bi = oi; } }
                if ((bi >> 4) == q4) { const int jj0 = bi & 15; if (best > -0.5e9f) my |= 1u << jj0;
#pragma unroll
                    for (int jj = 0; jj < 16; ++jj) if (jj == jj0) sc[jj] = -INFINITY; }
            }
            mlo = (q4 == 0 ? my : 0u) | (q4 == 1 ? my << 16 : 0u); mhi = (q4 == 2 ? my : 0u) | (q4 == 3 ? my << 16 : 0u);
            mlo = xor_q4(mlo); mhi = xor_q4(mhi);
        }
        LDS_WAIT();
        unsigned ulo = mlo, uhi = mhi;
        ulo = xor_r16(ulo); uhi = xor_r16(uhi);
        const unsigned long long un0 = ((unsigned long long)(unsigned)__builtin_amdgcn_readfirstlane((int)uhi) << 32) | (unsigned)__builtin_amdgcn_readfirstlane((int)ulo);
        const unsigned long long mine = ((unsigned long long)mhi << 32) | mlo;
#pragma unroll 1
        for (int hp = 0; hp < 2; ++hp) {
            const v2u g6raw = *(const v2u*)(gtp + 6 * hp); const unsigned g6x = gtp[6 * hp + 4], g6y = gtp[6 * hp + 5];
            v2u oacc[2][4];
#define ATT_GLOG(i) ((i) == 0 ? bflo(g6raw.x) : (i) == 1 ? bfhi(g6raw.x) : (i) == 2 ? bflo(g6raw.y) : (i) == 3 ? bfhi(g6raw.y) : (i) == 4 ? bf2f(g6x) : bf2f(g6y))
#define ATT_FOLD(br, first) do { _Pragma("unroll") for (int h = 0; h < 2; ++h) { const float lt = xsum_q4(ls[h]); const float sc_ = lt > 0.f ? (1.f / (1.f + __expf(-ATT_GLOG(h * 3 + (br))))) / lt : 0.f; \
            _Pragma("unroll") for (int dt = 0; dt < 4; ++dt) { f32x4 r_ = o[h][dt] * sc_; \
                if (!(first)) { r_[0] += bflo(oacc[h][dt].x); r_[1] += bfhi(oacc[h][dt].x); r_[2] += bflo(oacc[h][dt].y); r_[3] += bfhi(oacc[h][dt].y); } \
                oacc[h][dt].x = pg8::cvt_pk_bf16(r_[0], r_[1]); oacc[h][dt].y = pg8::cvt_pk_bf16(r_[2], r_[3]); } } } while (0)
            ATT_LOADQ(hp, 16); ATT_RESET();
            for (int st = ncs - 1; st >= 0; --st) {
                AttKV<bf16x8v> fc; attn_kv_load<bf16x8v, false>(fc, KCb, koff, VCb, voff, 32 * st);
                if (32 * st + 31 <= cmax0) attn_step<0, 0, bf16x8v>(fc, 32 * st, t - 31 - 16 * 32 * st, true, cmax, qf, m, ls, o, sl2, q4);
                else attn_step<0, 2, bf16x8v>(fc, 32 * st, t - 31 - 16 * 32 * st, true, cmax, qf, m, ls, o, sl2, q4); }
            ATT_FOLD(0, true);
            {
                const unsigned char* Kb = KS + (size_t)bg * SEQ * 64; const unsigned char* Vb = VST + (size_t)bg * SEQ * 64;
                ATT_RESET();
                unsigned kof_ = koff >> 1, vof_ = voff >> 1; asm volatile("" : "+v"(kof_), "+v"(vof_));
                unsigned long long un = un0;
                const int cur0 = t0 >> 5;
                AttKV<long> fa, fb; int ja = 63 - __builtin_clzll(un), jb; un &= ~(1ull << ja); attn_kv_load<long, false>(fa, Kb, kof_, Vb, vof_, 32 * ja);
                bool bad = false;
                bool more = un != 0ull; jb = ja;
                if (more) { jb = 63 - __builtin_clzll(un); un &= ~(1ull << jb); }
                attn_kv_load<long, false>(fb, Kb, kof_, Vb, vof_, 32 * jb);
                { const bool tk = ((mine >> ja) & 1ull) != 0ull; attn_step<1, 2, long>(fa, 32 * ja, t - 32 * ja, tk, 0, qf8, m, ls, o, sl2, q4); }
#define ATT_SSTEP(fc_, j_) do { const bool tk = ((mine >> (j_)) & 1ull) != 0ull; attn_step<1, 4, long, false, true>(fc_, 32 * (j_), t - 32 * (j_), tk, 0, qf8, m, ls, o, sl2, q4, bad); } while (0)
                if (more) {
#pragma unroll 1
                    for (;;) { more = un != 0ull; ja = jb;
                        if (more) { ja = 63 - __builtin_clzll(un); un &= ~(1ull << ja); }
                        attn_kv_load<long, false>(fa, Kb, kof_, Vb, vof_, 32 * ja);
                        ATT_SSTEP(fb, jb); __builtin_amdgcn_sched_barrier(0);
                        if (!more) break;
                        more = un != 0ull; jb = ja;
                        if (more) { jb = 63 - __builtin_clzll(un); un &= ~(1ull << jb); }
                        attn_kv_load<long, false>(fb, Kb, kof_, Vb, vof_, 32 * jb);
                        ATT_SSTEP(fa, ja); __builtin_amdgcn_sched_barrier(0);
                        if (!more) break; } }
                if (bad) {
                    ATT_RESET(); un = un0; bool dmy = false;
#pragma unroll 1
                    while (un != 0ull) { const int j = 63 - __builtin_clzll(un); un &= ~(1ull << j);
                        attn_kv_load<long, false>(fa, Kb, kof_, Vb, vof_, 32 * j);
                        { const bool tk = ((mine >> j) & 1ull) != 0ull; attn_step<1, 2, long, false, false>(fa, 32 * j, t - 32 * j, tk, 0, qf8, m, ls, o, sl2, q4, dmy); } } }
#undef ATT_SSTEP
                ATT_FOLD(1, false);
            }
            {
                const unsigned char* Kb = KW + (size_t)bg * SEQ * 64; const unsigned char* Vb = VWT + (size_t)bg * SEQ * 64;
                const int sb = t0 >= 511 ? (t0 - 511) >> 5 : 0, se = t0 >> 5;
                ATT_RESET();
                unsigned kof_ = koff >> 1, vof_ = voff >> 1; asm volatile("" : "+v"(kof_), "+v"(vof_));
                AttKV<long> fa, fb; attn_kv_load<long, false>(fa, Kb, kof_, Vb, vof_, 32 * se);
                bool bad = false;
                int st = se;
                attn_kv_load<long, false>(fb, Kb, kof_, Vb, vof_, 32 * (st > sb ? st - 1 : st));
                attn_step<2, 2, long>(fa, 32 * st, t - 32 * st, true, 0, qf8, m, ls, o, sl2, q4);
                --st;
#define ATT_WIN_UNM(st_) ((st_) >= sb && 32 * (st_) + 31 <= t0 && 32 * (st_) > t0 - 497)
#pragma unroll 1
                for (;;) { if (!ATT_WIN_UNM(st)) break;
                    attn_kv_load<long, false>(fa, Kb, kof_, Vb, vof_, 32 * (st > sb ? st - 1 : st));
                    attn_step<2, 0, long, false, true>(fb, 32 * st, t - 32 * st, true, 0, qf8, m, ls, o, sl2, q4, bad); --st; __builtin_amdgcn_sched_barrier(0);
                    if (!ATT_WIN_UNM(st)) break;
                    attn_kv_load<long, false>(fb, Kb, kof_, Vb, vof_, 32 * (st > sb ? st - 1 : st));
                    attn_step<2, 0, long, false, true>(fa, 32 * st, t - 32 * st, true, 0, qf8, m, ls, o, sl2, q4, bad); --st; __builtin_amdgcn_sched_barrier(0); }
#undef ATT_WIN_UNM
#pragma unroll 1
                for (; st >= sb; --st) { attn_kv_load<long, false>(fa, Kb, kof_, Vb, vof_, 32 * st);
                    attn_step<2, 2, long, false, true>(fa, 32 * st, t - 32 * st, true, 0, qf8, m, ls, o, sl2, q4, bad); }
                if (bad) { ATT_RESET(); bool dmy = false;
#pragma unroll 1
                    for (int st = se; st >= sb; --st) { attn_kv_load<long, false>(fa, Kb, kof_, Vb, vof_, 32 * st);
                        attn_step<2, 2, long, false, false>(fa, 32 * st, t - 32 * st, true, 0, qf8, m, ls, o, sl2, q4, dmy); } }
                ATT_FOLD(2, false);
            }
#pragma unroll
            for (int h = 0; h < 2; ++h)
#pragma unroll
                for (int dt = 0; dt < 4; ++dt) *(unsigned*)(orow + (2 * hp + h) * 64 + 16 * dt) = pg8::pk4_fp8(16.f * bflo(oacc[h][dt].x), 16.f * bfhi(oacc[h][dt].x), 16.f * bflo(oacc[h][dt].y), 16.f * bfhi(oacc[h][dt].y));
        }
#undef ATT_FOLD
#undef ATT_GLOG
#undef ATT_LOADQ
#undef ATT_RESET
#undef qrow
#undef gtp
#undef orow
    }
}

constexpr int SCQ = 272, SCT = 144;
constexpr int LQ_ = 0, LK_ = 17408, LKT_ = 34816, LVT_ = 53248, LP_ = 71680, LO_ = 80896, LE_ = 114688, LT_ = 115712;
#define SC_BAR() do { asm volatile("s_waitcnt lgkmcnt(0)" ::: "memory"); __builtin_amdgcn_s_barrier(); asm volatile("" ::: "memory"); } while (0)
__device__ __forceinline__ void p_scan_fast(Ctx& C, int layer) {
    unsigned char* ws = C.ws;
    const bf16* Pq = (const bf16*)(ws + R_PQ); const bf16* Pi = (const bf16*)(ws + R_PI); const bf16* Pg = (const bf16*)(ws + R_PG); const _Float16* LF = (const _Float16*)(ws + R_LF);
    bf16* O2 = (bf16*)(ws + R_O2);
    const float* gn = C.inp(I_HGN) + layer * 128;
    LAS unsigned char* L = C.lds;
    const int tid = C.tid, lane = C.lane, w = C.wave, r16 = lane & 15, q4 = lane >> 4, k = tid & 127, seg = tid >> 7;
    LAS float* tot = (LAS float*)(L + LT_); LAS float* eref = (LAS float*)(L + LE_); LAS float* elr = eref + 128;
    { const int tile = tid >> 8, e = tid & 255, row = e >> 4, col = e & 15;
      *(LAS bf16*)(L + LP_ + ((tile ? 32 : 0) + row) * SCT + ((tile ? 48 : 16) + col) * 2) = 0; }
    for (int bh = C.bid; bh < 256; bh += C.G) {
        const int b = bh >> 3, h = bh & 7;
        const size_t base = (size_t)(b * SEQ) * DM + h * 128;
        f32x4 S[8];
#pragma unroll
        for (int i = 0; i < 8; ++i) S[i] = (f32x4){0.f, 0.f, 0.f, 0.f};
        bf16 qv[16], vv[16]; float lf[16];
#define SC_LOAD(t0) do { _Pragma("unroll") for (int i = 0; i < 16; ++i) { const size_t off = base + (size_t)((t0) + 16 * seg + i) * DM + k; qv[i] = Pq[off]; vv[i] = Pi[off]; lf[i] = (float)LF[off]; } } while (0)
        SC_LOAD(0);
#pragma unroll 1
        for (int c = 0; c < SEQ / 64; ++c) {
            const int t0 = c * 64;
            float cs[16]; { float run = 0.f;
#pragma unroll
                for (int i = 0; i < 16; ++i) { run += lf[i]; cs[i] = run; }
                tot[seg * 128 + k] = run; }
            SC_BAR();
            { const float a0 = tot[k], a1 = tot[128 + k], a2 = tot[256 + k], a3 = tot[384 + k];
              const float off = seg == 0 ? 0.f : (seg == 1 ? a0 : (seg == 2 ? a0 + a1 : a0 + a1 + a2)), ref = a0 + a1, last = ref + a2 + a3;
              unsigned kt[16];
#pragma unroll
              for (int i = 0; i < 16; ++i) { const float d = off + cs[i] - ref; const float qt = bf2f(qv[i]) * __expf(fminf(d, 80.f)), ktv = (1.f - __expf(lf[i])) * __expf(fminf(-d, 80.f));
                  const int s = 16 * seg + i; kt[i] = f2bf(ktv);
                  *(LAS bf16*)(L + LQ_ + s * SCQ + k * 2) = (bf16)f2bf(qt); *(LAS bf16*)(L + LK_ + s * SCQ + k * 2) = (bf16)kt[i]; }
              v4u w0, w1, x0, x1;
              w0.x = kt[0] | (kt[1] << 16); w0.y = kt[2] | (kt[3] << 16); w0.z = kt[4] | (kt[5] << 16); w0.w = kt[6] | (kt[7] << 16);
              w1.x = kt[8] | (kt[9] << 16); w1.y = kt[10] | (kt[11] << 16); w1.z = kt[12] | (kt[13] << 16); w1.w = kt[14] | (kt[15] << 16);
              x0.x = vv[0] | ((unsigned)vv[1] << 16); x0.y = vv[2] | ((unsigned)vv[3] << 16); x0.z = vv[4] | ((unsigned)vv[5] << 16); x0.w = vv[6] | ((unsigned)vv[7] << 16);
              x1.x = vv[8] | ((unsigned)vv[9] << 16); x1.y = vv[10] | ((unsigned)vv[11] << 16); x1.z = vv[12] | ((unsigned)vv[13] << 16); x1.w = vv[14] | ((unsigned)vv[15] << 16);
              *(LAS v4u*)(L + LKT_ + k * SCT + seg * 32) = w0; *(LAS v4u*)(L + LKT_ + k * SCT + seg * 32 + 16) = w1;
              *(LAS v4u*)(L + LVT_ + k * SCT + seg * 32) = x0; *(LAS v4u*)(L + LVT_ + k * SCT + seg * 32 + 16) = x1;
              if (seg == 0) { eref[k] = __expf(ref); elr[k] = __expf(last - ref); } }
            SC_BAR();
            if (c + 1 < SEQ / 64) SC_LOAD(t0 + 64);
            v4u g8p[2];
#pragma unroll
            for (int rep = 0; rep < 2; ++rep) g8p[rep] = *(const v4u*)(Pg + base + (size_t)(t0 + (tid >> 4) + 32 * rep) * DM + (tid & 15) * 8);
#pragma unroll 1
            for (int ti = w; ti < 10; ti += 8) {
                const int rt = ti < 1 ? 0 : (ti < 3 ? 1 : (ti < 6 ? 2 : 3)), ct = ti - (rt * (rt + 1)) / 2;
                f32x4 acc = {0.f, 0.f, 0.f, 0.f};
#pragma unroll
                for (int p = 0; p < 4; ++p) { const bf16x8v a = *(const LAS bf16x8v*)(L + LQ_ + (16 * rt + r16) * SCQ + (32 * p + 8 * q4) * 2), bq = *(const LAS bf16x8v*)(L + LK_ + (16 * ct + r16) * SCQ + (32 * p + 8 * q4) * 2);
                    acc = MFMA16(a, bq, acc); }
#pragma unroll
                for (int i = 0; i < 4; ++i) { const int t = 16 * rt + 4 * q4 + i, s = 16 * ct + r16; *(LAS bf16*)(L + LP_ + t * SCT + s * 2) = (bf16)f2bf(s <= t ? acc[i] : 0.f); }
            }
            SC_BAR();
            bf16x8v sfrag[4]; f32x4 e8[4][2];
#pragma unroll
            for (int p = 0; p < 4; ++p) { e8[p][0] = *(const LAS f32x4*)(eref + 32 * p + 8 * q4); e8[p][1] = *(const LAS f32x4*)(eref + 32 * p + 8 * q4 + 4);
                S[2 * p] = S[2 * p] * e8[p][0]; S[2 * p + 1] = S[2 * p + 1] * e8[p][1];
                const v4u wv = {pg8::cvt_pk_bf16(S[2 * p][0], S[2 * p][1]), pg8::cvt_pk_bf16(S[2 * p][2], S[2 * p][3]), pg8::cvt_pk_bf16(S[2 * p + 1][0], S[2 * p + 1][1]), pg8::cvt_pk_bf16(S[2 * p + 1][2], S[2 * p + 1][3])};
                sfrag[p] = __builtin_bit_cast(bf16x8v, wv); }
            bf16x8v vfr[2];
#pragma unroll
            for (int ss = 0; ss < 2; ++ss) vfr[ss] = *(const LAS bf16x8v*)(L + LVT_ + (16 * w + r16) * SCT + (32 * ss + 8 * q4) * 2);
#pragma unroll
            for (int rt = 0; rt < 4; ++rt) { f32x4 o = {0.f, 0.f, 0.f, 0.f};
#pragma unroll
                for (int p = 0; p < 4; ++p) { const bf16x8v a = *(const LAS bf16x8v*)(L + LQ_ + (16 * rt + r16) * SCQ + (32 * p + 8 * q4) * 2); o = MFMA16(a, sfrag[p], o); }
#pragma unroll
                for (int ss = 0; ss < 2; ++ss) if (ss <= rt / 2) { const bf16x8v a = *(const LAS bf16x8v*)(L + LP_ + (16 * rt + r16) * SCT + (32 * ss + 8 * q4) * 2); o = MFMA16(a, vfr[ss], o); }
#pragma unroll
                for (int i = 0; i < 4; ++i) *(LAS float*)(L + LO_ + (16 * rt + 4 * q4 + i) * 528 + (16 * w + r16) * 4) = o[i]; }
#pragma unroll
            for (int p = 0; p < 4; ++p)
#pragma unroll
                for (int ab = 0; ab < 2; ++ab) { const int krow = 32 * p + 8 * (r16 >> 2) + (r16 & 3) + 4 * ab;
#pragma unroll
                    for (int ss = 0; ss < 2; ++ss) { const bf16x8v a = *(const LAS bf16x8v*)(L + LKT_ + krow * SCT + (32 * ss + 8 * q4) * 2); S[2 * p + ab] = MFMA16(a, vfr[ss], S[2 * p + ab]); } }
#pragma unroll
            for (int p = 0; p < 4; ++p) { const f32x4 l0 = *(const LAS f32x4*)(elr + 32 * p + 8 * q4), l1 = *(const LAS f32x4*)(elr + 32 * p + 8 * q4 + 4); S[2 * p] = S[2 * p] * l0; S[2 * p + 1] = S[2 * p + 1] * l1; }
            SC_BAR();
#pragma unroll
            for (int rep = 0; rep < 2; ++rep) { const int tok = (tid >> 4) + 32 * rep, part = tid & 15;
                const f32x4 oa = *(const LAS f32x4*)(L + LO_ + tok * 528 + part * 32), ob = *(const LAS f32x4*)(L + LO_ + tok * 528 + part * 32 + 16);
                float ss = (oa.x * oa.x + oa.y * oa.y) + (oa.z * oa.z + oa.w * oa.w) + (ob.x * ob.x + ob.y * ob.y) + (ob.z * ob.z + ob.w * ob.w);
                ss = DPP_ADD(ss, 0xB1); ss = DPP_ADD(ss, 0x4E); ss = DPP_ADD(ss, 0x141); ss = DPP_ADD(ss, 0x140);
                const float rstd = rsqrtf(ss * (1.f / 128.f) + EPS);
                const size_t off = base + (size_t)(t0 + tok) * DM + part * 8; const v4u g8 = g8p[rep];
                const f32x4 ga = *(const f32x4*)(gn + part * 8), gb = *(const f32x4*)(gn + part * 8 + 4);
                v4u wv; wv.x = pk2(oa.x * rstd * ga.x * bflo(g8.x), oa.y * rstd * ga.y * bfhi(g8.x)); wv.y = pk2(oa.z * rstd * ga.z * bflo(g8.y), oa.w * rstd * ga.w * bfhi(g8.y));
                wv.z = pk2(ob.x * rstd * gb.x * bflo(g8.z), ob.y * rstd * gb.y * bfhi(g8.z)); wv.w = pk2(ob.z * rstd * gb.z * bflo(g8.w), ob.w * rstd * gb.w * bfhi(g8.w));
                *(v4u*)(O2 + off) = wv; }
        }
#undef SC_LOAD
        __syncthreads();
    }
}

#undef SC_BAR
#define PH_BEGIN { const bool run_ = (pid >= lo && pid < hi); ++pid; if (run_) { { int ln_; asm volatile("v_mbcnt_lo_u32_b32 %0, -1, 0\n\tv_mbcnt_hi_u32_b32 %0, -1, %0" : "=v"(ln_)); C.lane = ln_; C.tid = C.wave * 64 + ln_; }
#define PH_END   if (pid < hi) xcd_barrier(bar); } }
#define XN ((const bf16*)(ws + WS_XN))
#define RTAB ((const int*)(ws + WS_RTAB))

template <int L>
__device__ __forceinline__ void run_layer(Ctx& C, const XcdBarrier& bar, int& pid, const int lo, const int hi, PG8_LAS unsigned char* ring) {
    unsigned char* const ws = C.ws;

        const int li = L >> 1;
        if (L < 2) {
            PH_BEGIN { pg8::Gemm g{XN, (const bf16*)(ws + W_HIN) + (size_t)L * 4096 * 1024, 1024, 1024, 0}; pg8::GenOrder S; S.init(256, 16, C.G, C.bid, nullptr);
                pg8::EpiHgrnIn E{ws, L};
                pg8::gemm_phase<pg8::EpiHgrnIn, pg8::GenOrder, true, true>(ring, g, S, E, C.wave); } PH_END
            PH_BEGIN p_scan_fast(C, L); PH_END
        } else {
            PH_BEGIN { const bool first = (L == 2); pg8::Gemm g{XN, (const bf16*)(ws + (first ? W_KVQ : W_Q3)), 512, 512, 0}; pg8::GenOrder S; S.init(256, first ? 11 : 5, C.G, C.bid, nullptr);
                pg8::EpiBf16 E{(bf16*)(ws + R_QKV), first ? 2816 : 1280, nullptr, 0, 0, 1.f / pg8::FP8_SW1};
                pg8::gemm_phase<pg8::EpiBf16, pg8::GenOrder, true, true, true>(ring, g, S, E, C.wave); } PH_END
            if (L == 2) {
                PH_BEGIN p_post_kv(C); PH_END
                PH_BEGIN { pg8::Gemm g{(const bf16*)(ws + R_KCR), (const bf16*)(ws + W_CMP1), 2048, 1024, (size_t)256 * 2048 * 2}; pg8::GenOrder S; S.init(128, 1, C.G, C.bid, RTAB + 2048);
                    pg8::EpiBf16 E{(bf16*)(ws + WS_HC), 256, (const float*)(ws + WS_CB), 1, 256, 1.f};
                    pg8::gemm_phase<pg8::EpiBf16, pg8::GenOrder, true, true>(ring, g, S, E, C.wave); } PH_END
                PH_BEGIN p_cmp2(C); PH_END
            }
            PH_BEGIN p_attn_fast(C, (unsigned*)(ws + WS_CTL) + 8192 + 2048 * (L - 2), L == 2 ? 2816 : 1280, L == 2 ? 1536 : 0, C.inp(I_NQN) + (L - 2) * 64); PH_END
        }
        PH_BEGIN { pg8::GenOrder S; S.init(256, 4, C.G, C.bid, nullptr);
            if (L < 2) { pg8::Gemm g{(const bf16*)(ws + R_O2), (const bf16*)(ws + W_HOUT) + (size_t)(L & 1) * 1024 * 1024, 1024, 1024, 0};
                if (L == 0) { pg8::EpiResB<true> E{C.inp(I_X), (bf16*)(ws + WS_XR), 1.f}; pg8::gemm_phase<pg8::EpiResB<true>, pg8::GenOrder, true, true>(ring, g, S, E, C.wave); }
                else { pg8::EpiResB<false> E{nullptr, (bf16*)(ws + WS_XR), 1.f}; pg8::gemm_phase<pg8::EpiResB<false>, pg8::GenOrder, true, true>(ring, g, S, E, C.wave); } }
            else { pg8::Gemm g{(const bf16*)(ws + R_O), (const bf16*)(ws + W_NOUT + (size_t)(L & 1) * 1024 * 1024 * 2), 512, 512, 0};
                pg8::EpiResB<false> E{nullptr, (bf16*)(ws + WS_XR), 1.f / (16.f * pg8::FP8_SW1)};
                pg8::gemm_phase<pg8::EpiResB<false>, pg8::GenOrder, true, true, true>(ring, g, S, E, C.wave); } } PH_END
        PH_BEGIN { if (L & 1) p_norm<false, true, true, true>(C, C.inp(I_MR) + (size_t)li * 1024 * 8, C.inp(I_NFFN) + L * 1024); else if (L == 2) p_norm<false, false, true, true>(C, nullptr, nullptr); else p_norm<false, false, true, false>(C, nullptr, nullptr); } PH_END
        if (L & 1) { PH_BEGIN p_gather(C); PH_END }
        if (L == 0) {
            PH_BEGIN { pg8::Gemm g{XN, (const bf16*)(ws + W_FGU), 1024, 1024, 0};
                pg8::GenOrder S; S.init(256, 22, C.G, C.bid, nullptr);
                pg8::EpiSwiGLU E{(bf16*)(ws + R_HF), DFF};
                pg8::gemm_phase<pg8::EpiSwiGLU, pg8::GenOrder, true, true>(ring, g, S, E, C.wave); } PH_END
            PH_BEGIN { pg8::Gemm g{(const bf16*)(ws + R_HF), (const bf16*)(ws + W_FDN), DFF, DFF, 0}; pg8::GenOrder S; S.init(256, 4, C.G, C.bid, nullptr);
                pg8::EpiResB<false> E{nullptr, (bf16*)(ws + WS_XR), 1.f};
                pg8::gemm_phase<pg8::EpiResB<false>, pg8::GenOrder, true, true>(ring, g, S, E, C.wave); } PH_END
            PH_BEGIN p_norm<false, false, true>(C, nullptr, nullptr); PH_END
        } else {
        PH_BEGIN { const bool moe = (L & 1) != 0;
            pg8::Gemm g{(const bf16*)(ws + (moe ? R_XP : WS_XN)), (const bf16*)(ws + (moe ? W_MGU + (size_t)li * 8 * 2 * DFE * 1024 : W_FGU + (size_t)li * 2 * DFF * 2048)), 512, 512, moe ? (size_t)2 * DFE * 1024 : 0};
            pg8::GenOrder S; S.init(moe ? RTAB[1024] : 256, moe ? 28 : 22, C.G, C.bid, moe ? RTAB : nullptr);
            pg8::EpiSwiGLU8 E{ws + (moe ? R_HM : R_HF), moe ? DFE : DFF};
            pg8::gemm_phase<pg8::EpiSwiGLU8, pg8::GenOrder, true, true, true>(ring, g, S, E, C.wave); } PH_END
        if (!(L & 1)) {
            PH_BEGIN { pg8::Gemm g{(const bf16*)(ws + R_HF), (const bf16*)(ws + W_FDN + (size_t)li * 1024 * DFF * 2), DFF / 2, DFF / 2, 0}; pg8::GenOrder S; S.init(256, 4, C.G, C.bid, nullptr);
                pg8::EpiResB<false> E{nullptr, (bf16*)(ws + WS_XR), 1.f / (pg8::FP8_SH * pg8::FP8_SW2)};
                pg8::gemm_phase<pg8::EpiResB<false>, pg8::GenOrder, true, true, true>(ring, g, S, E, C.wave); } PH_END
            PH_BEGIN p_norm<false, false, true, true>(C, nullptr, nullptr); PH_END
        } else {
            PH_BEGIN { pg8::Gemm g{(const bf16*)(ws + R_HM), (const bf16*)(ws + W_MDN + (size_t)li * 8 * 1024 * DFE), DFE / 2, DFE / 2, (size_t)1024 * DFE}; pg8::GenOrder S; S.init(RTAB[1024], 4, C.G, C.bid, RTAB);
                pg8::EpiBf16 E{(bf16*)(ws + R_XP), 1024, nullptr, 0, 0, 1.f / (pg8::FP8_SH * pg8::FP8_SW2)};
                pg8::gemm_phase<pg8::EpiBf16, pg8::GenOrder, true, true, true>(ring, g, S, E, C.wave); } PH_END
            PH_BEGIN { if (L == 1) p_norm<true, false, true, true>(C, nullptr, nullptr); else p_norm<true, false, false>(C, nullptr, nullptr); } PH_END
        }
        }
    }

struct Args { const float* in[24]; float* out; unsigned char* ws; int ph_lo, ph_hi; };
constexpr int N_PHASES = 34;

__global__ void __launch_bounds__(NWAVES * 64, 2) yoco_fwd(Args args) {
    extern __shared__ __attribute__((aligned(16))) unsigned char lds_raw[];
    Ctx C;
    C.lds = (LAS unsigned char*)lds_raw;
    C.wave = __builtin_amdgcn_readfirstlane((int)(threadIdx.x >> 6)); C.tid = threadIdx.x; C.lane = C.tid & 63;
    C.G = gridDim.x; C.bid = blockIdx.x;
    C.out = args.out; C.ws = args.ws;
    unsigned char* const ws = args.ws;
    volatile LAS unsigned* MISC = (volatile LAS unsigned*)(C.lds + MISC_OFF);
    if (C.tid < 32) MISC[C.tid] = 0u;
    __syncthreads();
    XcdBarrier bar = xcd_barrier_post((unsigned*)(ws + WS_CTL) + 4096, MISC + 8);
    const int lo = args.ph_lo, hi = args.ph_hi;
    int pid = 0;
    PG8_LAS unsigned char* ring = (PG8_LAS unsigned char*)lds_raw;
    PH_BEGIN p_prologue(C); PH_END

    run_layer<0>(C, bar, pid, lo, hi, ring); run_layer<1>(C, bar, pid, lo, hi, ring); run_layer<2>(C, bar, pid, lo, hi, ring); run_layer<3>(C, bar, pid, lo, hi, ring);
#undef PH_BEGIN
#undef PH_END
#undef XN
#undef RTAB
}

extern "C" void kernel_launch(void* const* d_in, const int* in_sizes, int n_in, void* d_out, int out_size, void* d_ws, size_t ws_size, hipStream_t stream) {
    static int grid = 0;
    if (grid == 0) {
        if (n_in != 24 || in_sizes[0] != NT * DM || out_size != NT * DM || ws_size < WS_NEED) { fprintf(stderr, "kernel_launch: unexpected shapes / workspace (n_in %d, ws %zu, need %zu)\n", n_in, ws_size, (size_t)WS_NEED); grid = -1; return; }
        int dev = 0, cus = 0;
        if (hipGetDevice(&dev) != hipSuccess || hipDeviceGetAttribute(&cus, hipDeviceAttributeMultiprocessorCount, dev) != hipSuccess) { grid = -1; return; }
        if (hipFuncSetAttribute((const void*)yoco_fwd, hipFuncAttributeMaxDynamicSharedMemorySize, LDS_BYTES) != hipSuccess) { fprintf(stderr, "kernel_launch: hipFuncSetAttribute failed\n"); grid = -1; return; }
        int per_cu = 0;
        if (hipOccupancyMaxActiveBlocksPerMultiprocessor(&per_cu, (const void*)yoco_fwd, NWAVES * 64, LDS_BYTES) != hipSuccess || per_cu < 1) { fprintf(stderr, "kernel_launch: occupancy query says %d\n", per_cu); }
        (void)hipGetLastError();
        grid = cus;
    }
    if (grid < 0) return;
    (void)hipMemsetAsync((char*)d_ws + WS_CTL, 0, CTL_ZERO_BYTES, stream);
    Args a{};
    for (int i = 0; i < 24; ++i) a.in[i] = (const float*)d_in[i];
    a.out = (float*)d_out; a.ws = (unsigned char*)d_ws;
#if MK_SINGLE
    a.ph_lo = 0; a.ph_hi = N_PHASES;
    hipLaunchKernelGGL(yoco_fwd, dim3(grid), dim3(NWAVES * 64), LDS_BYTES, stream, a);
#else
    for (int k = 0; k < N_PHASES; ++k) { a.ph_lo = k; a.ph_hi = k + 1; hipLaunchKernelGGL(yoco_fwd, dim3(grid), dim3(NWAVES * 64), LDS_BYTES, stream, a); }
#endif
}
```
